# Optimizing an MI355X kernel written in HIP

```python
import jax, jax.numpy as jnp
from jax import lax
import numpy as np

D_MODEL = 1024
BATCH = 8
SEQ = 2048
DEPTH = 2

CHUNK = 64
CONV_WIDTH = 3
D_CONV = D_MODEL
HEAD_DIM = 64
N_HEADS = D_MODEL // HEAD_DIM
D_RWKV = N_HEADS * HEAD_DIM
DECAY_RANK = 64
AAA_RANK = 64
VMIX_RANK = 32
GATE_RANK = 128
N_EXPERTS = 32
N_GROUPS = 8
EXPERTS_PER_GROUP = N_EXPERTS // N_GROUPS
TOP_K = 2
D_EXPERT = 512
M_BLK = 128
NORM_EPS = 1e-6
LN_X_EPS = 64e-5

N_PLAIN = 3 * D_CONV + 2 * D_MODEL
N_SHIFT = 3 * D_RWKV + DECAY_RANK + AAA_RANK + GATE_RANK
N_IN = N_PLAIN + N_SHIFT

kernel_name = 'hybrid_conv_rwkv7_grouped_moe_trunk'


def rms_norm(x, gain):
    x32 = x.astype(jnp.float32)
    y = x32 * lax.rsqrt(jnp.mean(x32 * x32, axis=-1, keepdims=True) + NORM_EPS)
    return (y * gain.astype(jnp.float32)).astype(x.dtype)


def token_shift(p):
    return jnp.pad(p, ((0, 0), (1, 0), (0, 0)))[:, :-1]


def causal_dwconv(u, w):
    s = u.shape[1]
    up = jnp.pad(u, ((0, 0), (CONV_WIDTH - 1, 0), (0, 0)))
    return sum(up[:, j:j + s] * w[j] for j in range(CONV_WIDTH))


def wkv7(r, decay, k, v, kk, a):
    bn, s = r.shape[0], r.shape[1]
    nc = s // CHUNK

    def to_chunks(t):
        return t.reshape(bn, nc, CHUNK, N_HEADS, HEAD_DIM).transpose(1, 2, 0, 3, 4)

    xs = (to_chunks(r), to_chunks(decay), to_chunks(k), to_chunks(v), to_chunks(kk), to_chunks(a))

    def step(state, inp):
        r_t, w_t, k_t, v_t, kk_t, a_t = inp
        sa = jnp.einsum('bhvk,bhk->bhv', state, kk_t)
        state = (state * w_t[:, :, None, :]
                 - sa[..., None] * (kk_t * a_t)[:, :, None, :]
                 + v_t[..., None] * k_t[:, :, None, :])
        y = jnp.einsum('bhvk,bhk->bhv', state, r_t)
        return state, y

    def chunk_step(state, chunk_inp):
        return lax.scan(step, state, chunk_inp)

    s0 = jnp.zeros((bn, N_HEADS, HEAD_DIM, HEAD_DIM), jnp.float32)
    _, y = lax.scan(chunk_step, s0, xs)
    return y.transpose(2, 0, 1, 3, 4).reshape(bn, s, N_HEADS, HEAD_DIM)


def heads(t):
    return t.reshape(t.shape[0], t.shape[1], N_HEADS, HEAD_DIM)


def token_mixer(h, v_first, w_in, token_mu, conv_w, w0, decay_up, a0, aaa_up, gate_up,
                k_k, k_a, r_k, ln_x_w, ln_x_b, vmix, w_out):
    bn, s, _ = h.shape
    p = h @ w_in
    plain, rw = p[..., :N_PLAIN], p[..., N_PLAIN:]
    rw = rw + (token_shift(rw) - rw) * token_mu

    cb, cc, ch, ga, gb = jnp.split(plain, [D_CONV, 2 * D_CONV, 3 * D_CONV, 3 * D_CONV + D_MODEL], axis=-1)
    y_conv = cb * causal_dwconv(cc * ch, conv_w)

    r, k, v, wd, ad, gd = jnp.split(
        rw, [D_RWKV, 2 * D_RWKV, 3 * D_RWKV, 3 * D_RWKV + DECAY_RANK, 3 * D_RWKV + DECAY_RANK + AAA_RANK], axis=-1)
    w_log = -jax.nn.softplus(-(w0 + jnp.tanh(wd) @ decay_up).astype(jnp.float32)) - 0.5
    decay = jnp.exp(-jnp.exp(w_log))
    a = jax.nn.sigmoid(a0 + ad @ aaa_up)
    g = jax.nn.sigmoid(gd) @ gate_up
    if vmix is None:
        v_first = v
    else:
        vmix_down, vmix_up, v0 = vmix
        v = v + (v_first - v) * jax.nn.sigmoid(v0 + (h @ vmix_down) @ vmix_up)
    kk = heads(k * k_k).astype(jnp.float32)
    kk = kk / jnp.maximum(jnp.sqrt(jnp.sum(kk * kk, axis=-1, keepdims=True)), 1e-12)
    k = k * (1.0 + (a - 1.0) * k_a)
    r_h = heads(r).astype(jnp.float32)
    k_h = heads(k).astype(jnp.float32)
    v_h = heads(v).astype(jnp.float32)
    a_h = heads(a).astype(jnp.float32)
    y = wkv7(r_h, heads(decay), k_h, v_h, kk, a_h)
    mu = jnp.mean(y, axis=-1, keepdims=True)
    var = jnp.mean(jnp.square(y - mu), axis=-1, keepdims=True)
    yn = ((y - mu) * lax.rsqrt(var + LN_X_EPS)).reshape(bn, s, D_RWKV)
    yn = yn * ln_x_w.astype(jnp.float32) + ln_x_b.astype(jnp.float32)
    bonus = jnp.sum(r_h * k_h * r_k.astype(jnp.float32), axis=-1, keepdims=True) * v_h
    y_rwkv = ((yn + bonus.reshape(bn, s, D_RWKV)) * g.astype(jnp.float32)).astype(h.dtype)

    merged = jax.nn.sigmoid(ga) * y_conv + jax.nn.sigmoid(gb) * y_rwkv
    return merged @ w_out, v_first


def moe(h, w_router, router_bias, w_e_in, w_e_out):
    bn, s, d = h.shape
    hf = h.reshape(bn * s, d)
    t = hf.shape[0]
    n_assign = t * TOP_K
    aff = jax.nn.sigmoid((hf @ w_router).astype(jnp.float32))
    sel = (aff + router_bias.astype(jnp.float32)).reshape(t, N_GROUPS, EXPERTS_PER_GROUP)
    gscore = jnp.sum(lax.top_k(sel, TOP_K)[0], axis=-1)
    gsel = jnp.argmax(gscore, axis=-1).astype(jnp.int32)
    cand = jnp.take_along_axis(sel, gsel[:, None, None], axis=1)[:, 0]
    _, local = lax.top_k(cand, TOP_K)
    eidx = gsel[:, None] * EXPERTS_PER_GROUP + local
    wts = jnp.take_along_axis(aff, eidx, axis=-1)
    wts = wts / jnp.sum(wts, axis=-1, keepdims=True)

    flat_e = eidx.reshape(n_assign)
    order = jnp.argsort(flat_e)
    sorted_e = flat_e[order]
    tok = order // TOP_K
    sizes = jnp.bincount(flat_e, length=N_EXPERTS)
    padded = (sizes + M_BLK - 1) // M_BLK * M_BLK
    pad_end = jnp.cumsum(padded)
    pad_start = pad_end - padded
    start = jnp.cumsum(sizes) - sizes
    dest = pad_start[sorted_e] + jnp.arange(n_assign) - start[sorted_e]
    n_rows = n_assign + N_EXPERTS * M_BLK
    n_blocks = n_rows // M_BLK
    buf = jnp.zeros((n_rows, d), h.dtype).at[dest].set(hf[tok])
    blk_e = jnp.minimum(jnp.searchsorted(pad_end, jnp.arange(n_blocks) * M_BLK, side='right'), N_EXPERTS - 1)

    def expert_block(args):
        xb, e = args
        gate, up = jnp.split(xb @ w_e_in[e], 2, axis=-1)
        return (jax.nn.silu(gate) * up) @ w_e_out[e]

    yb = lax.map(expert_block, (buf.reshape(n_blocks, M_BLK, d), blk_e))
    ye = yb.reshape(n_rows, d)[dest] * wts.reshape(n_assign)[order][:, None].astype(h.dtype)
    return jnp.zeros_like(hf).at[tok].add(ye).reshape(bn, s, d)


def setup_inputs(seed: int = 0) -> dict:
    key = jax.random.key(seed)
    ks = jax.random.split(key, 32)
    f32 = jnp.float32
    nrm = lambda k, shape, scale: jax.random.normal(k, shape, f32) * scale
    inv = lambda n: float(n) ** -0.5
    return {
        'x': nrm(ks[0], (BATCH, SEQ, D_MODEL), 1.0),
        'c': nrm(ks[1], (BATCH, D_MODEL), 1.0),
        'w_ada': nrm(ks[2], (DEPTH, D_MODEL, 6 * D_MODEL), 0.5 * inv(D_MODEL)),
        'b_ada': nrm(ks[3], (DEPTH, 6 * D_MODEL), 0.01),
        'norm1_gain': 1.0 + nrm(ks[4], (DEPTH, D_MODEL), 0.05),
        'norm2_gain': 1.0 + nrm(ks[5], (DEPTH, D_MODEL), 0.05),
        'w_in': nrm(ks[6], (DEPTH, D_MODEL, N_IN), inv(D_MODEL)),
        'token_mu': jax.random.uniform(ks[7], (DEPTH, N_SHIFT), f32),
        'conv_w': nrm(ks[8], (DEPTH, CONV_WIDTH, D_CONV), inv(CONV_WIDTH)),
        'w0': jnp.linspace(-6.0, -1.0, D_RWKV, dtype=f32)[None, :] + nrm(ks[9], (DEPTH, D_RWKV), 0.1),
        'decay_up': nrm(ks[10], (DEPTH, DECAY_RANK, D_RWKV), 0.1 * inv(DECAY_RANK)),
        'a0': nrm(ks[11], (DEPTH, D_RWKV), 0.1),
        'aaa_up': nrm(ks[12], (DEPTH, AAA_RANK, D_RWKV), 0.5 * inv(AAA_RANK)),
        'gate_up': nrm(ks[13], (DEPTH, GATE_RANK, D_RWKV), inv(GATE_RANK)),
        'k_k': 0.85 + nrm(ks[14], (DEPTH, D_RWKV), 0.05),
        'k_a': 1.0 + nrm(ks[15], (DEPTH, D_RWKV), 0.05),
        'r_k': nrm(ks[16], (DEPTH, N_HEADS, HEAD_DIM), 0.1),
        'ln_x_w': 1.0 + nrm(ks[17], (DEPTH, D_RWKV), 0.05),
        'ln_x_b': nrm(ks[18], (DEPTH, D_RWKV), 0.01),
        'vmix_down': nrm(ks[19], (DEPTH - 1, D_MODEL, VMIX_RANK), inv(D_MODEL)),
        'vmix_up': nrm(ks[20], (DEPTH - 1, VMIX_RANK, D_RWKV), inv(VMIX_RANK)),
        'v0': nrm(ks[21], (DEPTH - 1, D_RWKV), 0.1),
        'w_out': nrm(ks[22], (DEPTH, D_MODEL, D_MODEL), inv(D_MODEL)),
        'w_router': nrm(ks[23], (D_MODEL, N_EXPERTS), inv(D_MODEL)),
        'router_bias': nrm(ks[24], (N_EXPERTS,), 0.01),
        'w_expert_in': nrm(ks[25], (DEPTH, N_EXPERTS, D_MODEL, 2 * D_EXPERT), inv(D_MODEL)),
        'w_expert_out': nrm(ks[26], (DEPTH, N_EXPERTS, D_EXPERT, D_MODEL), inv(D_EXPERT)),
        'final_gain': 1.0 + nrm(ks[27], (D_MODEL,), 0.05),
    }


def reference(x, c, w_ada, b_ada, norm1_gain, norm2_gain, w_in, token_mu, conv_w, w0,
              decay_up, a0, aaa_up, gate_up, k_k, k_a, r_k, ln_x_w, ln_x_b,
              vmix_down, vmix_up, v0, w_out, w_router, router_bias,
              w_expert_in, w_expert_out, final_gain):
    v_first = None
    cond = jax.nn.silu(c)
    for l in range(DEPTH):
        ada = (cond @ w_ada[l] + b_ada[l])[:, None, :]
        sh1, sc1, g1, sh2, sc2, g2 = jnp.split(ada, 6, axis=-1)
        h = rms_norm(x, norm1_gain[l]) * (1.0 + sc1) + sh1
        vmix = None if l == 0 else (vmix_down[l - 1], vmix_up[l - 1], v0[l - 1])
        mix, v_first = token_mixer(h, v_first, w_in[l], token_mu[l], conv_w[l], w0[l], decay_up[l],
                                   a0[l], aaa_up[l], gate_up[l], k_k[l], k_a[l], r_k[l],
                                   ln_x_w[l], ln_x_b[l], vmix, w_out[l])
        x = x + g1 * mix
        h2 = rms_norm(x, norm2_gain[l]) * (1.0 + sc2) + sh2
        x = x + g2 * moe(h2, w_router, router_bias, w_expert_in[l], w_expert_out[l])
    return rms_norm(x, final_gain)
```

```cpp
#include <hip/hip_runtime.h>
#include <cstdio>
#include <cstdint>

#ifndef MK_ONE_LAUNCH
#define MK_ONE_LAUNCH 1
#endif

namespace pg8 {
#define PG8_LAS __attribute__((address_space(3)))
typedef unsigned short bf16_t;
typedef short bf16x8 __attribute__((ext_vector_type(8)));
typedef float f32x4 __attribute__((ext_vector_type(4)));
typedef unsigned u32x4 __attribute__((ext_vector_type(4)));
constexpr int BM = 256, BK = 64, HALF = 128, HTB = HALF * BK * 2  , STAGE_BYTES = 8 * HTB, NXCD = 8, WGM = 8;

__host__ __device__ __forceinline__ int lds_byte(int r, int c) { const int st = (r >> 4) * 2 + (c >> 5), rr = r & 15, cc = c & 31, ob = rr * 64 + cc * 2; return st * 1024 + (ob ^ (((ob >> 9) & 1) << 5)); }
__host__ __device__ __forceinline__ void stage_rc(int b, int& R, int& C) { const int st = b / 1024, sb = b % 1024, swz = sb ^ (((sb >> 9) & 1) << 5); R = (st >> 1) * 16 + swz / 64; C = (st & 1) * 32 + (swz % 64) / 2; }
__host__ __device__ __forceinline__ int perm32(int rho) { const int n = rho >> 4, i = rho & 15; return 8 * (i >> 2) + 4 * n + (i & 3); }

struct Unit { int pm, pn; };
struct Gemm { const bf16_t* A; const bf16_t* Bt; int M, N, K; };

struct StaticOrder {
    int nM, nN, nwg, G, c;
    __host__ __device__ void init(int M, int N, int G_, int c_) { nM = M / BM; nN = N / BM; nwg = nM * nN; G = G_; c = c_; }
    __host__ __device__ bool next(int i, Unit& u) const {
        const long L = (long)i * G + c; if (L >= nwg) return false;
        int wgid = (int)L; { const int q = nwg / NXCD, r = nwg % NXCD, xcd = wgid % NXCD, off = wgid / NXCD; wgid = (xcd < r ? xcd * (q + 1) : r * (q + 1) + (xcd - r) * q) + off; }
        const int nig = WGM * nN, gid = wgid / nig, fm = gid * WGM, gsz = (nM - fm) < WGM ? (nM - fm) : WGM;
        u.pm = fm + ((wgid % nig) % gsz); u.pn = (wgid % nig) / gsz; return true;
    }
    __device__ __forceinline__ void a_ready(const Unit&) const {}
    __device__ __forceinline__ void done(const Unit&) const {}
};
__device__ __forceinline__ unsigned cvt_pk_bf16(float lo, float hi) { unsigned r; asm volatile("v_cvt_pk_bf16_f32 %0, %1, %2" : "=v"(r) : "v"(lo), "v"(hi)); return r; }
typedef float f32x2 __attribute__((ext_vector_type(2)));
typedef unsigned u32x2 __attribute__((ext_vector_type(2)));

struct EpiBf16Plain {
    static constexpr bool PERM = true, AFTER_DRAIN = false;
    bf16_t* O; int ldc; int cmask;
    __device__ __forceinline__ void operator()(const f32x4 (&acc)[2][2][4][2], const Unit& u, int wr, int wc, int fr, int fq) const {
        const int row0 = u.pm * BM + wr * 64 + fr; const int col0 = (u.pn & cmask) * BM + wc * 32 + 8 * fq;
#pragma unroll
        for (int ai = 0; ai < 2; ++ai)
#pragma unroll
            for (int m = 0; m < 4; ++m) { bf16_t* rowp = O + (size_t)(row0 + ai * HALF + m * 16) * ldc + col0;
#pragma unroll
                for (int bj = 0; bj < 2; ++bj) { const f32x4 v0 = acc[ai][bj][m][0], v1 = acc[ai][bj][m][1];
                    u32x4 w; w.x = cvt_pk_bf16(v0[0], v0[1]); w.y = cvt_pk_bf16(v0[2], v0[3]); w.z = cvt_pk_bf16(v1[0], v1[1]); w.w = cvt_pk_bf16(v1[2], v1[3]);
                    *(u32x4*)(rowp + bj * HALF) = w; } }
    }
};
struct EpiResid {
    static constexpr bool PERM = false, AFTER_DRAIN = false;
    const float* xin; float* xout; const float* gate;
    int gstride;
    __device__ __forceinline__ void operator()(const f32x4 (&acc)[2][2][4][2], const Unit& u, int wr, int wc, int fr, int fq) const {
        const int row0 = u.pm * BM + wr * 64 + fr, col0 = u.pn * BM + wc * 32 + 4 * fq;
        const float* gp = gate + (size_t)(u.pm >> 3) * gstride;
        f32x4 gv[2][2];
#pragma unroll
        for (int bj = 0; bj < 2; ++bj)
#pragma unroll
            for (int n = 0; n < 2; ++n) gv[bj][n] = *(const f32x4*)(gp + col0 + bj * HALF + n * 16);
#pragma unroll
        for (int ai = 0; ai < 2; ++ai)
#pragma unroll
            for (int m = 0; m < 4; ++m) { const size_t ro = (size_t)(row0 + ai * HALF + m * 16) * 1024 + col0;
#pragma unroll
                for (int bj = 0; bj < 2; ++bj)
#pragma unroll
                    for (int n = 0; n < 2; ++n) { const f32x4 xi = *(const f32x4*)(xin + ro + bj * HALF + n * 16);
                        *(f32x4*)(xout + ro + bj * HALF + n * 16) = xi + gv[bj][n] * acc[ai][bj][m][n]; }
                asm volatile("" ::: "memory"); }
    }
};
struct EpiSwiGLU {
    static constexpr bool PERM = false, AFTER_DRAIN = false;
    bf16_t* O;
    __device__ __forceinline__ void operator()(const f32x4 (&acc)[2][2][4][2], const Unit& u, int wr, int wc, int fr, int fq) const {
        const int row0 = u.pm * BM + wr * 64 + fr, col0 = (u.pn & 3) * HALF + wc * 32 + 4 * fq;
#pragma unroll
        for (int ai = 0; ai < 2; ++ai)
#pragma unroll
            for (int m = 0; m < 4; ++m) { bf16_t* rowp = O + (size_t)(row0 + ai * HALF + m * 16) * 512 + col0;
#pragma unroll
                for (int n = 0; n < 2; ++n) { const f32x4 g = acc[ai][0][m][n], up = acc[ai][1][m][n]; f32x4 h;
#pragma unroll
                    for (int j = 0; j < 4; ++j) h[j] = g[j] * __builtin_amdgcn_rcpf(1.0f + __expf(-g[j])) * up[j];
                    u32x2 w; w.x = cvt_pk_bf16(h[0], h[1]); w.y = cvt_pk_bf16(h[2], h[3]);
                    *(u32x2*)(rowp + n * 16) = w; } }
    }
};
struct ExpertOrder {
    const PG8_LAS int* ts; int ntiles, G, c;
    __device__ __forceinline__ bool next(int i, Unit& u) const {
        const int L = i * G + c; if (L >= ntiles * 4) return false;
        const int pm = L >> 2; int e = 0;
#pragma unroll 1
        for (int k = 1; k < 32; ++k) e += (ts[k] <= pm) ? 1 : 0;
        u.pm = pm; u.pn = e * 4 + (L & 3); return true;
    }
    __device__ __forceinline__ void a_ready(const Unit&) const {}
    __device__ __forceinline__ void done(const Unit&) const {}
};

struct UniOrder {
    StaticOrder so; ExpertOrder eo; bool expert;
    __device__ __forceinline__ bool next(int i, Unit& u) const { return expert ? eo.next(i, u) : so.next(i, u); }
    __device__ __forceinline__ void a_ready(const Unit&) const {}
    __device__ __forceinline__ void done(const Unit&) const {}
};
struct EpiUni {
    static constexpr bool AFTER_DRAIN = false;
    int mode; EpiBf16Plain e0; EpiResid e1; EpiSwiGLU e2;
    __device__ __forceinline__ bool perm() const { return mode == 0; }
    __device__ __forceinline__ void operator()(const f32x4 (&acc)[2][2][4][2], const Unit& u, int wr, int wc, int fr, int fq) const {
        if (mode == 0) e0(acc, u, wr, wc, fr, fq); else if (mode == 1) e1(acc, u, wr, wc, fr, fq); else e2(acc, u, wr, wc, fr, fq);
    }
};
template <class Epi, class Sched, bool ALIGN_EPI = false, bool SP2 = false>
__device__ __forceinline__ void gemm_phase(PG8_LAS unsigned char* lds, const Gemm g, const Sched& S, const Epi& E) {
    int tid_ = threadIdx.x; asm volatile("" : "+v"(tid_));
    const int tid = tid_, wid = __builtin_amdgcn_readfirstlane(tid >> 6), lane = tid & 63, wr = wid >> 2, wc = wid & 3, fr = lane & 15, fq = lane >> 4;
    const int K = g.K, nt = K / BK;
    unsigned voffA[2], voffB[2];
#pragma unroll
    for (int i = 0; i < 2; ++i) { int R, C; stage_rc(tid * 16 + i * 8192, R, C); const int Rb = E.perm() ? ((R & ~31) + perm32(R & 31)) : R;
        voffA[i] = (unsigned)(R * K + C) * 2u; voffB[i] = (unsigned)(Rb * K + C) * 2u; }
    const size_t kstep = (size_t)(BK * 2);
    const size_t hstep = (size_t)HALF * K * 2;
    const size_t tstep = 2 * hstep;
    const unsigned ldsw = (unsigned)wid * 1024u;
    const int aoff = lds_byte(wr * 64 + fr, fq * 8), boff = lds_byte(wc * 32 + fr, fq * 8);
#define PG8_SA(b, h) (((b) * 2 + (h)) * HTB)
#define PG8_SB(b, h) ((4 + (b) * 2 + (h)) * HTB)
#define PG8_STAGE(bufoff, gbase, voff) do { _Pragma("unroll") for (int _i = 0; _i < 2; ++_i) \
        __builtin_amdgcn_global_load_lds((const unsigned*)((const char*)(gbase) + (voff)[_i]), (PG8_LAS unsigned*)(lds + (bufoff) + ldsw + _i * 8192), 16, 0, 0); } while (0)
#define PG8_LDA(dst, b, h) do { _Pragma("unroll") for (int m = 0; m < 4; ++m) _Pragma("unroll") for (int k = 0; k < 2; ++k) dst[m][k] = *(const PG8_LAS bf16x8*)(lds + PG8_SA(b, h) + aoff + m * 2048 + k * 1024); } while (0)
#define PG8_LDB(dst, b, h) do { _Pragma("unroll") for (int n = 0; n < 2; ++n) _Pragma("unroll") for (int k = 0; k < 2; ++k) dst[n][k] = *(const PG8_LAS bf16x8*)(lds + PG8_SB(b, h) + boff + n * 2048 + k * 1024); } while (0)
#define PG8_MMA(ai, bj, At, Bt) do { __builtin_amdgcn_s_setprio(1); _Pragma("unroll") for (int m = 0; m < 4; ++m) _Pragma("unroll") for (int n = 0; n < 2; ++n) _Pragma("unroll") for (int k = 0; k < 2; ++k) \
        acc[ai][bj][m][n] = __builtin_amdgcn_mfma_f32_16x16x32_bf16(Bt[n][k], At[m][k], acc[ai][bj][m][n], 0, 0, 0); __builtin_amdgcn_s_setprio(0); } while (0)
#define PG8_WAIT_V(n) asm volatile("s_waitcnt vmcnt(" #n ")" ::: "memory")
#define PG8_WAIT_L(n) asm volatile("s_waitcnt lgkmcnt(" #n ")" ::: "memory")
#define PG8_BAR __builtin_amdgcn_s_barrier()
#define PG8_SCHED __builtin_amdgcn_sched_barrier(0)
    Unit cur, nxt; int ui = 0;
    if (!S.next(0, cur)) return;
    f32x4 acc[2][2][4][2];
#pragma unroll
    for (int a = 0; a < 2; ++a)
#pragma unroll
        for (int b = 0; b < 2; ++b)
#pragma unroll
            for (int m = 0; m < 4; ++m)
#pragma unroll
                for (int n = 0; n < 2; ++n) acc[a][b][m][n] = (f32x4){0.f, 0.f, 0.f, 0.f};
    bf16x8 At[4][2], B0[2][2], B1[2][2];
    const char* cA = (const char*)g.A + (size_t)cur.pm * tstep; const char* cB = (const char*)g.Bt + (size_t)cur.pn * tstep;
    S.a_ready(cur);
    if constexpr (SP2) {
        PG8_STAGE(PG8_SB(0, 0), cB, voffB); PG8_STAGE(PG8_SB(0, 1), cB + hstep, voffB); PG8_STAGE(PG8_SA(0, 0), cA, voffA); PG8_STAGE(PG8_SA(0, 1), cA + hstep, voffA);
        if (wr == 1) PG8_BAR;
        PG8_WAIT_V(2); PG8_BAR;
        PG8_STAGE(PG8_SB(1, 0), cB + kstep, voffB); PG8_STAGE(PG8_SA(1, 0), cA + kstep, voffA); PG8_STAGE(PG8_SB(1, 1), cB + hstep + kstep, voffB);
        PG8_WAIT_V(6); PG8_BAR;
    } else {
        PG8_STAGE(PG8_SB(0, 0), cB, voffB); PG8_STAGE(PG8_SA(0, 0), cA, voffA); PG8_STAGE(PG8_SB(0, 1), cB + hstep, voffB); PG8_STAGE(PG8_SA(0, 1), cA + hstep, voffA);
        if (wr == 1) PG8_BAR;
        PG8_WAIT_V(4); PG8_BAR;
        PG8_STAGE(PG8_SB(1, 0), cB + kstep, voffB); PG8_STAGE(PG8_SA(1, 0), cA + kstep, voffA); PG8_STAGE(PG8_SB(1, 1), cB + hstep + kstep, voffB);
        PG8_WAIT_V(6); PG8_BAR;
    }
    for (;;) {
        const bool has_next = S.next(ui + 1, nxt);
        const char* nA = has_next ? (const char*)g.A + (size_t)nxt.pm * tstep : cA; const char* nB = has_next ? (const char*)g.Bt + (size_t)nxt.pn * tstep : cB;
        for (int t = 0; t < nt; t += 2) {
            const bool last = (t == nt - 2);
            const char* a1 = cA + (size_t)(t + 1) * kstep;
            const char* a2 = last ? nA : cA + (size_t)(t + 2) * kstep; const char* b2 = last ? nB : cB + (size_t)(t + 2) * kstep;
            const char* a3 = a2 + kstep; const char* b3 = b2 + kstep;
            if (last && has_next) S.a_ready(nxt);
            if constexpr (SP2) {
            PG8_LDB(B0, 0, 0); PG8_LDB(B1, 0, 1); PG8_SCHED; PG8_LDA(At, 0, 0); PG8_STAGE(PG8_SA(1, 1), a1 + hstep, voffA);
            PG8_WAIT_V(8); PG8_WAIT_L(0); PG8_BAR; PG8_MMA(0, 0, At, B0); PG8_MMA(0, 1, At, B1); PG8_BAR; PG8_SCHED;
            PG8_LDA(At, 0, 1); PG8_STAGE(PG8_SB(0, 0), b2, voffB); PG8_STAGE(PG8_SB(0, 1), b2 + hstep, voffB); PG8_STAGE(PG8_SA(0, 0), a2, voffA);
            PG8_WAIT_V(8); PG8_WAIT_L(0); PG8_BAR; PG8_MMA(1, 0, At, B0); PG8_MMA(1, 1, At, B1); PG8_BAR; PG8_SCHED;
            PG8_LDB(B0, 1, 0); PG8_LDB(B1, 1, 1); PG8_SCHED; PG8_LDA(At, 1, 0); PG8_STAGE(PG8_SA(0, 1), a2 + hstep, voffA);
            PG8_WAIT_V(8); PG8_WAIT_L(0); PG8_BAR; PG8_MMA(0, 0, At, B0); PG8_MMA(0, 1, At, B1); PG8_BAR; PG8_SCHED;
            PG8_LDA(At, 1, 1); PG8_STAGE(PG8_SB(1, 0), b3, voffB); PG8_STAGE(PG8_SB(1, 1), b3 + hstep, voffB); PG8_STAGE(PG8_SA(1, 0), a3, voffA);
            PG8_WAIT_V(8); PG8_WAIT_L(0); PG8_BAR; PG8_MMA(1, 0, At, B0); PG8_MMA(1, 1, At, B1); PG8_BAR; PG8_SCHED;
            } else {
            PG8_LDB(B0, 0, 0); PG8_SCHED; PG8_LDA(At, 0, 0); PG8_STAGE(PG8_SA(1, 1), a1 + hstep, voffA);
            PG8_WAIT_L(8); PG8_BAR; PG8_WAIT_L(0); PG8_MMA(0, 0, At, B0); PG8_BAR; PG8_SCHED;
            PG8_LDB(B1, 0, 1); PG8_STAGE(PG8_SB(0, 0), b2, voffB);
            PG8_BAR; PG8_WAIT_L(0); PG8_MMA(0, 1, At, B1); PG8_BAR;
            PG8_LDA(At, 0, 1); PG8_STAGE(PG8_SA(0, 0), a2, voffA);
            PG8_BAR; PG8_WAIT_L(0); PG8_MMA(1, 0, At, B0); PG8_BAR; PG8_SCHED;
            PG8_STAGE(PG8_SB(0, 1), b2 + hstep, voffB);
            PG8_WAIT_V(6); PG8_BAR; PG8_MMA(1, 1, At, B1); PG8_BAR;
            PG8_LDB(B0, 1, 0); PG8_SCHED; PG8_LDA(At, 1, 0); PG8_STAGE(PG8_SA(0, 1), a2 + hstep, voffA);
            PG8_WAIT_L(8); PG8_BAR; PG8_WAIT_L(0); PG8_MMA(0, 0, At, B0); PG8_BAR; PG8_SCHED;
            PG8_LDB(B1, 1, 1); PG8_STAGE(PG8_SB(1, 0), b3, voffB);
            PG8_BAR; PG8_WAIT_L(0); PG8_MMA(0, 1, At, B1); PG8_BAR;
            PG8_LDA(At, 1, 1); PG8_STAGE(PG8_SA(1, 0), a3, voffA);
            PG8_BAR; PG8_WAIT_L(0); PG8_MMA(1, 0, At, B0); PG8_BAR; PG8_SCHED;
            PG8_STAGE(PG8_SB(1, 1), b3 + hstep, voffB);
            PG8_WAIT_V(6); PG8_BAR; PG8_MMA(1, 1, At, B1); PG8_BAR;
            }
        }
        if constexpr (ALIGN_EPI) { if (wr == 0) PG8_BAR; }
        if constexpr (!Epi::AFTER_DRAIN) { E(acc, cur, wr, wc, fr, fq); S.done(cur); }
        if (!has_next) break;
#pragma unroll
        for (int a = 0; a < 2; ++a)
#pragma unroll
            for (int b = 0; b < 2; ++b)
#pragma unroll
                for (int m = 0; m < 4; ++m)
#pragma unroll
                    for (int n = 0; n < 2; ++n) acc[a][b][m][n] = (f32x4){0.f, 0.f, 0.f, 0.f};
        cur = nxt; cA = nA; cB = nB; ++ui;
        if constexpr (ALIGN_EPI) { if (wr == 1) PG8_BAR; }
    }
    PG8_WAIT_V(0);
    if constexpr (!ALIGN_EPI) { if (wr == 0) PG8_BAR; }
    PG8_BAR;
    if constexpr (Epi::AFTER_DRAIN) { E.fused(acc, cur, wr, wc, fr, fq, lds, wid, lane); S.done(cur); }
#undef PG8_SA
#undef PG8_SB
#undef PG8_STAGE
#undef PG8_LDA
#undef PG8_LDB
#undef PG8_MMA
#undef PG8_WAIT_V
#undef PG8_WAIT_L
#undef PG8_BAR
#undef PG8_SCHED
}
}

constexpr int NWAVES = 8;
constexpr int T = 16384, D = 1024, SEQ = 2048, NBATCH = 8, NHEAD = 16;
constexpr int N_IN = 8448, P_LD = 8704;
constexpr int C_CB = 0, C_CC = 1024, C_CH = 2048, C_GA = 3072, C_GB = 4096, C_R = 5120, C_K = 6144, C_V = 7168, C_WD = 8192, C_AD = 8256, C_GD = 8320, C_VD = 8448;
constexpr int N_SHIFT = 3328, N_EXP = 32, D_EXP = 512;
constexpr int MAXROWS = 40960;
constexpr float NORM_EPS = 1e-6f, LNX_EPS = 64e-5f;

constexpr size_t MiB = 1u << 20;
constexpr size_t WS_CTL = 0, CTL_ZERO_BYTES = 1 * MiB;
constexpr size_t WS_BT_IN = 2 * MiB;
constexpr size_t WS_BT_OUT = 36 * MiB;
constexpr size_t WS_BT_E1 = 40 * MiB;
constexpr size_t WS_BT_E2 = 168 * MiB;
constexpr size_t WS_H = 232 * MiB;
constexpr size_t WS_P = 264 * MiB;
constexpr size_t WS_BUF = WS_P, WS_HB = WS_P + 80 * MiB, WS_YE = WS_P + 120 * MiB;
constexpr size_t WS_W = 536 * MiB;
constexpr size_t WS_KK = 600 * MiB, WS_BQ = 632 * MiB, WS_KP = 664 * MiB, WS_R = 696 * MiB, WS_V0 = 728 * MiB, WS_V1 = 760 * MiB, WS_G = 792 * MiB, WS_Y = 824 * MiB;
constexpr size_t WS_X = 856 * MiB;
constexpr size_t WS_BONUS = 920 * MiB;
constexpr size_t WS_EIDX = 921 * MiB, WS_POS = WS_EIDX + 128 * 1024, WS_WTS = WS_EIDX + 256 * 1024, WS_SLOT = WS_EIDX + 384 * 1024;
constexpr size_t WS_ADAP = 924 * MiB;
constexpr size_t WS_END = 932 * MiB;
static_assert(WS_YE + (size_t)MAXROWS * 1024 * 2 <= WS_W && WS_P + (size_t)T * P_LD * 2 <= WS_W, "ws map");
constexpr int CW_CNT = 1024;
constexpr int CW_BAR = 4096;
constexpr size_t CTL_ADA = 256 * 1024;
constexpr size_t CTL_BIASR = 700 * 1024;

constexpr int RING_BYTES = 131072;
constexpr int TAB_OFF = RING_BYTES;
constexpr int MISC_OFF = RING_BYTES + 1024;
constexpr int LDS_BYTES = 147456;

#define GAS __attribute__((address_space(1)))
#define LAS __attribute__((address_space(3)))
typedef unsigned short bf16;
typedef float f32x4 __attribute__((ext_vector_type(4)));
typedef float f32x2 __attribute__((ext_vector_type(2)));
typedef unsigned u32x4 __attribute__((ext_vector_type(4)));
typedef unsigned u32x2 __attribute__((ext_vector_type(2)));
#define LDS_WAIT() asm volatile("s_waitcnt lgkmcnt(0)" ::: "memory")

__device__ __forceinline__ unsigned f2bf(float f) { unsigned u = __builtin_bit_cast(unsigned, f); return (u + 0x7fffu + ((u >> 16) & 1u)) >> 16; }
__device__ __forceinline__ unsigned pk2(float lo, float hi) { return f2bf(lo) | (f2bf(hi) << 16); }
__device__ __forceinline__ float bflo(unsigned u) { return __builtin_bit_cast(float, u << 16); }
__device__ __forceinline__ float bfhi(unsigned u) { return __builtin_bit_cast(float, u & 0xffff0000u); }
__device__ __forceinline__ void load8(const bf16* p, float (&o)[8]) { const u32x4 u = *(const u32x4*)p; o[0] = bflo(u.x); o[1] = bfhi(u.x); o[2] = bflo(u.y); o[3] = bfhi(u.y); o[4] = bflo(u.z); o[5] = bfhi(u.z); o[6] = bflo(u.w); o[7] = bfhi(u.w); }
__device__ __forceinline__ void store8(bf16* p, const float (&v)[8]) { u32x4 w; w.x = pk2(v[0], v[1]); w.y = pk2(v[2], v[3]); w.z = pk2(v[4], v[5]); w.w = pk2(v[6], v[7]); *(u32x4*)p = w; }
__device__ __forceinline__ float sigmoidf_(float x) { return __builtin_amdgcn_rcpf(1.0f + __expf(-x)); }
__device__ __forceinline__ float tanhf_(float x) { return 1.0f - 2.0f * __builtin_amdgcn_rcpf(__expf(2.0f * x) + 1.0f); }
__device__ __forceinline__ float wave_sum(float v) {
#pragma unroll
    for (int o = 1; o < 64; o <<= 1) v += __shfl_xor(v, o);
    return v;
}
__device__ __forceinline__ float sum8(float v) { v += __shfl_xor(v, 1); v += __shfl_xor(v, 2); v += __shfl_xor(v, 4); return v; }
template <int CTRL> __device__ __forceinline__ float dpp_f(float v) { return __builtin_bit_cast(float, __builtin_amdgcn_mov_dpp(__builtin_bit_cast(int, v), CTRL, 0xF, 0xF, true)); }
__device__ __forceinline__ float dpp_sum16(float v) {
    v += dpp_f<0xB1>(v);
    v += dpp_f<0x4E>(v);
    v += dpp_f<0x141>(v);
    v += dpp_f<0x140>(v);
    return v;
}

#define XB_TMO      128
#define XB_XCNT(j)  (256  + 64 * (j))
#define XB_XSUB(j)  (1280 + 64 * (j))
#define XB_XGEN(j)  (2304 + 64 * (j))
#define XB_TOP      3328
#define XB_TOPGEN   3392
#define XCD_BAR_WORDS 3456
#define XB_SPIN_CAP (1u << 18)

__device__ __forceinline__ unsigned xb_ld(unsigned* p)              { return __hip_atomic_load(p, __ATOMIC_RELAXED, __HIP_MEMORY_SCOPE_AGENT); }
__device__ __forceinline__ unsigned xb_add(unsigned* p, unsigned v) { return __hip_atomic_fetch_add(p, v, __ATOMIC_RELAXED, __HIP_MEMORY_SCOPE_AGENT); }
__device__ __forceinline__ unsigned xb_xcc_id() { return (unsigned)__builtin_amdgcn_s_getreg((3 << 11) | 20) & 0xFu; }
#define XB_SPIN(cond, bar) do { unsigned _sp = 0; while (cond) { __builtin_amdgcn_s_sleep(1); \
    if ((++_sp & 255u) == 0u) { if (xb_ld(&(bar)[XB_TMO])) break; if (_sp > XB_SPIN_CAP) { atomicAdd(&(bar)[XB_TMO], 1u); break; } } } } while (0)

struct XcdBarrier {
    unsigned* bar; unsigned x;
    volatile LAS unsigned* st;
};

__device__ __forceinline__ XcdBarrier xcd_barrier_post(unsigned* bar, volatile LAS unsigned* st) {
    XcdBarrier b; b.bar = bar; b.x = xb_xcc_id(); b.st = st;
    if (threadIdx.x == 0) (void)xb_add(&bar[XB_XCNT(b.x)], 1u);
    return b;
}
__device__ __forceinline__ void xcd_barrier_complete(unsigned* bar, unsigned x, unsigned& nloc, unsigned& nx) {
    const unsigned G = gridDim.x * gridDim.y * gridDim.z;
    unsigned sum, cnt, mine, sp = 0u;
    for (;;) {
        sum = 0u; cnt = 0u; mine = 0u;
#pragma unroll
        for (unsigned j = 0; j < 16; ++j) { const unsigned c = xb_ld(&bar[XB_XCNT(j)]); sum += c; cnt += (c > 0u) ? 1u : 0u; mine = (j == x) ? c : mine; }
        if (sum == G) break;
        __builtin_amdgcn_s_sleep(1);
        if ((++sp & 255u) == 0u) { if (xb_ld(&bar[XB_TMO])) break; if (sp > XB_SPIN_CAP) { atomicAdd(&bar[XB_TMO], 1u); break; } }
    }
    nloc = mine > 0u ? mine : 1u; nx = cnt > 0u ? cnt : 1u;
}

__device__ __forceinline__ void xcd_barrier(const XcdBarrier& b) {
    asm volatile("s_waitcnt vmcnt(0)" ::: "memory");
    __syncthreads();
    if (threadIdx.x == 0) {
        unsigned* bar = b.bar;
        __builtin_amdgcn_s_waitcnt(0);
        unsigned nloc = b.st[0], nx = b.st[1];
        if (nloc == 0u) { xcd_barrier_complete(bar, b.x, nloc, nx); b.st[0] = nloc; b.st[1] = nx; }
        const unsigned old = xb_add(&bar[XB_XSUB(b.x)], 1u);
        const unsigned gen = old / nloc;
        if (old + 1u == (gen + 1u) * nloc) {
            __builtin_amdgcn_fence(__ATOMIC_RELEASE, "agent");
            asm volatile("s_waitcnt vmcnt(0)" ::: "memory");
            const unsigned og = xb_add(&bar[XB_TOP], 1u);
            const unsigned tg = og / nx;
            if (og + 1u == (tg + 1u) * nx) xb_add(&bar[XB_TOPGEN], 1u);
            else XB_SPIN(xb_ld(&bar[XB_TOPGEN]) == tg, bar);
            __builtin_amdgcn_fence(__ATOMIC_ACQUIRE, "agent");
            xb_add(&bar[XB_XGEN(b.x)], 1u);
            asm volatile("s_waitcnt vmcnt(0)" ::: "memory");
        } else {
            XB_SPIN(xb_ld(&bar[XB_XGEN(b.x)]) == gen, bar);
            __builtin_amdgcn_fence(__ATOMIC_ACQUIRE, "agent");
            asm volatile("s_waitcnt vmcnt(0)" ::: "memory");
        }
    }
    __syncthreads();
}

struct Args { const void* p[30]; int ph_lo, ph_hi; };
template <int IDX> __device__ __forceinline__ const float* kin() {
    const auto ka = __builtin_amdgcn_kernarg_segment_ptr(); unsigned long long v;
    asm volatile("s_load_dwordx2 %0, %1, %2\n\ts_waitcnt lgkmcnt(0)" : "=s"(v) : "s"(ka), "i"(IDX * 8) : "memory");
    return (const float*)v;
}
enum { I_X = 0, I_C, I_WADA, I_BADA, I_N1G, I_N2G, I_WIN, I_MU, I_CONVW, I_W0, I_DECUP, I_A0, I_AAAUP, I_GATEUP, I_KK, I_KA, I_RK, I_LNW, I_LNB, I_VMD, I_VMU, I_V0, I_WOUT, I_WR, I_RB, I_WE1, I_WE2, I_FG };
struct Frame {
    LAS unsigned char* lds;
    int tid, lane, wave, vcu, G;
    unsigned char* ws;
};
__device__ __forceinline__ float* ada_ptr(const Frame& F, int l, int b) { return (float*)(F.ws + WS_CTL + CTL_ADA) + (size_t)(l * 8 + b) * 6144; }

__device__ __forceinline__ void transpose_item(const float* W, int K, int N, bf16* WT, int dst_row0, int k0, int n0, LAS float* scr, int lane) {
#pragma unroll 8
    for (int i = 0; i < 32; ++i) { const int kk = 2 * i + (lane >> 5); scr[kk * 33 + (lane & 31)] = W[(size_t)(k0 + kk) * N + n0 + (lane & 31)]; }
    LDS_WAIT();
    const int c = lane & 7;
#pragma unroll
    for (int j = 0; j < 4; ++j) { const int n = (lane >> 3) + 8 * j; const LAS float* s = scr + (8 * c) * 33 + n;
        u32x4 o; o.x = pk2(s[0 * 33], s[1 * 33]); o.y = pk2(s[2 * 33], s[3 * 33]); o.z = pk2(s[4 * 33], s[5 * 33]); o.w = pk2(s[6 * 33], s[7 * 33]);
        *(u32x4*)(WT + (size_t)(dst_row0 + n) * K + k0 + 8 * c) = o; }
    LDS_WAIT();
}
__device__ __forceinline__ void p0_prologue(const Frame& F) {
    LAS float* scr = (LAS float*)(F.lds + F.wave * 16384);
    const int gw = F.vcu * NWAVES + F.wave, NGW = F.G * NWAVES, lane = F.lane;
    constexpr int I_ADA = 768, I_A = 2 * 16 * 264, I_B = 2 * 16 * 32, I_C1 = 64 * 16 * 32, I_D = 64 * 8 * 32, I_E = 16;
    constexpr int NITEMS = I_ADA + I_A + I_B + I_C1 + I_D + I_E;
    const float* const pC = kin<I_C>(); const float* const pWADA = kin<I_WADA>(); const float* const pWIN = kin<I_WIN>();
    const float* const pWOUT = kin<I_WOUT>(); const float* const pWE1 = kin<I_WE1>(); const float* const pWE2 = kin<I_WE2>(); const float* const pVMD = kin<I_VMD>();
    for (int it = gw; it < NITEMS; it += NGW) {
        int r = it;
        if (r < I_ADA) {
            const int l = r / 384, rr = r % 384, cch = rr >> 4, kc = rr & 15, col = cch * 256 + 4 * lane, k0 = kc * 64;
            float cv[8];
#pragma unroll
            for (int b = 0; b < 8; ++b) { const float x = pC[b * 1024 + k0 + lane]; cv[b] = x * sigmoidf_(x); }
            f32x4 acc[8];
#pragma unroll
            for (int b = 0; b < 8; ++b) acc[b] = (f32x4){0.f, 0.f, 0.f, 0.f};
            const float* wp = pWADA + ((size_t)l * 1024 + k0) * 6144 + col;
#pragma unroll 8
            for (int kk = 0; kk < 64; ++kk) { const f32x4 w = *(const f32x4*)(wp + (size_t)kk * 6144);
#pragma unroll
                for (int b = 0; b < 8; ++b) { const float s = __builtin_bit_cast(float, __builtin_amdgcn_readlane(__builtin_bit_cast(int, cv[b]), kk)); acc[b] += s * w; } }
#pragma unroll
            for (int b = 0; b < 8; ++b) *(f32x4*)((float*)(F.ws + WS_ADAP) + ((size_t)(kc * 2 + l) * 8 + b) * 6144 + col) = acc[b];
            continue;
        }
        r -= I_ADA;
        if (r < I_A) { const int l = r / (16 * 264), rr = r % (16 * 264), kb = rr / 264, nb = rr % 264;
            transpose_item(pWIN + (size_t)l * 1024 * N_IN, 1024, N_IN, (bf16*)(F.ws + WS_BT_IN) + (size_t)l * P_LD * 1024, 32 * nb, 64 * kb, 32 * nb, scr, lane); continue; }
        r -= I_A;
        if (r < I_B) { const int l = r / 512, rr = r % 512, kb = rr / 32, nb = rr % 32;
            transpose_item(pWOUT + (size_t)l * 1024 * 1024, 1024, 1024, (bf16*)(F.ws + WS_BT_OUT) + (size_t)l * 1024 * 1024, 32 * nb, 64 * kb, 32 * nb, scr, lane); continue; }
        r -= I_B;
        if (r < I_C1) { const int le = r / 512, rr = r % 512, kb = rr / 32, nb = rr % 32, n0 = 32 * nb;
            const int j0 = n0 & 511, dst = (j0 >> 7) * 256 + (n0 >= 512 ? 128 : 0) + (j0 & 127);
            transpose_item(pWE1 + (size_t)le * 1024 * 1024, 1024, 1024, (bf16*)(F.ws + WS_BT_E1) + (size_t)le * 1024 * 1024, dst, 64 * kb, n0, scr, lane); continue; }
        r -= I_C1;
        if (r < I_D) { const int le = r / 256, rr = r % 256, kb = rr / 32, nb = rr % 32;
            transpose_item(pWE2 + (size_t)le * 512 * 1024, 512, 1024, (bf16*)(F.ws + WS_BT_E2) + (size_t)le * 1024 * 512, 32 * nb, 64 * kb, 32 * nb, scr, lane); continue; }
        r -= I_D;
        transpose_item(pVMD, 1024, 32, (bf16*)(F.ws + WS_BT_IN) + (size_t)P_LD * 1024, C_VD, 64 * r, 0, scr, lane);
    }
    { const int gt = F.vcu * NWAVES * 64 + F.tid; if (gt < 28672) *((u32x4*)((bf16*)(F.ws + WS_BT_IN) + (size_t)P_LD * 1024 + (size_t)(C_VD + 32) * 1024) + gt) = (u32x4){0u, 0u, 0u, 0u}; }
}

__device__ __forceinline__ void p0b_ada_reduce(const Frame& F) {
    const float* const pBADA = kin<I_BADA>(); const float* ap = (const float*)(F.ws + WS_ADAP); float* ada = (float*)(F.ws + WS_CTL + CTL_ADA);
    for (int idx = F.vcu * NWAVES * 64 + F.tid; idx < 2 * 8 * 6144; idx += F.G * NWAVES * 64) { const int l = idx / 49152, r = idx % 49152, c = r % 6144;
        float s = pBADA[l * 6144 + c];
#pragma unroll
        for (int kc = 0; kc < 16; ++kc) s += ap[(size_t)(kc * 2 + l) * 49152 + r];
        ada[idx] = s; }
}

template <int MODE> __device__ __forceinline__ void p1_norm(const Frame& F, int l) {
    const int lane = F.lane;
    const float* const pX = kin<I_X>(); float* const pOUT = (float*)kin<28>(); const float* const pFG = kin<I_FG>(); const float* const pN1G = kin<I_N1G>(); const float* const pWRb = kin<I_WR>();
#pragma unroll 1
    for (int gw = F.vcu * NWAVES + F.wave; gw < T / 8; gw += F.G * NWAVES) { const int tok0 = gw * 8, b = tok0 >> 11;
        f32x4 gm[4], sh[4], g2v[4];
#pragma unroll
        for (int j = 0; j < 4; ++j) { const int c = 4 * lane + 256 * j;
            if (MODE == 2) { gm[j] = *(const f32x4*)(pFG + c); sh[j] = (f32x4){0.f, 0.f, 0.f, 0.f}; }
            else { const float* ad = ada_ptr(F, l, b); const f32x4 g = *(const f32x4*)(pN1G + l * 1024 + c), sc = *(const f32x4*)(ad + 1024 + c); gm[j] = g * (1.0f + sc); sh[j] = *(const f32x4*)(ad + c); }
            if (MODE >= 1) g2v[j] = *(const f32x4*)(ada_ptr(F, MODE == 2 ? 1 : l - 1, b) + 5120 + c); }
        float* X = (float*)(F.ws + WS_X);
        const bf16* YE = (const bf16*)(F.ws + WS_YE);
        const float* WTS = (const float*)(F.ws + WS_WTS); const int* SLOT = (const int*)(F.ws + WS_SLOT);
        for (int tk = 0; tk < 8; ++tk) { const int tok = tok0 + tk;
            f32x4 v[4]; const float* xs = (MODE == 0 ? pX : X) + (size_t)tok * 1024;
#pragma unroll
            for (int j = 0; j < 4; ++j) v[j] = *(const f32x4*)(xs + 4 * lane + 256 * j);
            if (MODE >= 1) { const float w0 = WTS[tok * 2], w1 = WTS[tok * 2 + 1]; const int s0 = SLOT[tok * 2], s1 = SLOT[tok * 2 + 1];
#pragma unroll
                for (int j = 0; j < 4; ++j) { const u32x2 y0 = *(const u32x2*)(YE + (size_t)s0 * 1024 + 4 * lane + 256 * j), y1 = *(const u32x2*)(YE + (size_t)s1 * 1024 + 4 * lane + 256 * j);
                    f32x4 m; m[0] = w0 * bflo(y0.x) + w1 * bflo(y1.x); m[1] = w0 * bfhi(y0.x) + w1 * bfhi(y1.x); m[2] = w0 * bflo(y0.y) + w1 * bflo(y1.y); m[3] = w0 * bfhi(y0.y) + w1 * bfhi(y1.y);
                    v[j] += g2v[j] * m; if (MODE == 1) *(f32x4*)(X + (size_t)tok * 1024 + 4 * lane + 256 * j) = v[j]; } }
            float ss = 0.f;
#pragma unroll
            for (int j = 0; j < 4; ++j) ss += (v[j][0] * v[j][0] + v[j][1] * v[j][1]) + (v[j][2] * v[j][2] + v[j][3] * v[j][3]);
            const float rstd = __builtin_amdgcn_rsqf(wave_sum(ss) * (1.0f / 1024.0f) + NORM_EPS);
#pragma unroll
            for (int j = 0; j < 4; ++j) { const f32x4 h = v[j] * rstd * gm[j] + sh[j];
                if (MODE == 2) *(f32x4*)(pOUT + (size_t)tok * 1024 + 4 * lane + 256 * j) = h;
                else { u32x2 w; w.x = pk2(h[0], h[1]); w.y = pk2(h[2], h[3]); *(u32x2*)((bf16*)(F.ws + WS_H) + (size_t)tok * 1024 + 4 * lane + 256 * j) = w; } }
        }
    }
    if (MODE == 0 && F.vcu < 16) {
        const int lb = F.vcu, e = F.tid & 31, kq = F.tid >> 5; const float* sh2 = ada_ptr(F, lb >> 3, lb & 7) + 3072; float s = 0.f;
        for (int k = kq * 64; k < kq * 64 + 64; ++k) s += sh2[k] * pWRb[k * 32 + e];
        LAS float* red = (LAS float*)F.lds; red[kq * 32 + e] = s; __syncthreads();
        if (F.tid < 32) { float t = 0.f; for (int q = 0; q < 16; ++q) t += red[q * 32 + e]; ((float*)(F.ws + WS_CTL + CTL_BIASR))[lb * 32 + e] = t; }
        __syncthreads();
    }
}

__device__ __forceinline__ void mixed8(const bf16* P, int tok, int colbase, const float* mu, float (&o)[8]) {
    float cur[8], prv[8]; load8(P + (size_t)tok * P_LD + colbase, cur);
    if ((tok & (SEQ - 1)) != 0) load8(P + (size_t)(tok - 1) * P_LD + colbase, prv); else {
#pragma unroll
        for (int j = 0; j < 8; ++j) prv[j] = 0.f; }
    const f32x4 m0 = *(const f32x4*)mu, m1 = *(const f32x4*)(mu + 4);
#pragma unroll
    for (int j = 0; j < 8; ++j) o[j] = cur[j] + (prv[j] - cur[j]) * (j < 4 ? m0[j] : m1[j - 4]);
}
template <int KDIM> __device__ __forceinline__ void lowrank_mm(const float* U  , const LAS float* A  , float (&acc)[4][8]) {
#pragma unroll
    for (int tk = 0; tk < 4; ++tk)
#pragma unroll
        for (int i = 0; i < 8; ++i) acc[tk][i] = 0.f;
#pragma unroll 4
    for (int j = 0; j < KDIM; ++j) { const float* up = U + (size_t)j * 1024;
        const f32x4 w0 = *(const f32x4*)up, w1 = *(const f32x4*)(up + 4);
#pragma unroll
        for (int tk = 0; tk < 4; ++tk) { const float av = A[tk * 288 + j];
#pragma unroll
            for (int i = 0; i < 4; ++i) { acc[tk][i] += av * w0[i]; acc[tk][4 + i] += av * w1[i]; } } }
}
__device__ __forceinline__ void p3_prep(const Frame& F, int l) {
    const int lane = F.lane, gw = F.vcu * NWAVES + F.wave, NGW = F.G * NWAVES;
    LAS float* A = (LAS float*)(F.lds + F.wave * 8192);
    const bf16* P = (const bf16*)(F.ws + WS_P);
    const float* mu = kin<I_MU>() + l * N_SHIFT;
    const float* const pAAA = kin<I_AAAUP>() + (size_t)l * 64 * 1024; const float* const pDEC = kin<I_DECUP>() + (size_t)l * 64 * 1024; const float* const pGUP = kin<I_GATEUP>() + (size_t)l * 128 * 1024; const float* const pVMU = kin<I_VMU>();
    const float* const pA0 = kin<I_A0>() + l * 1024; const float* const pKKc = kin<I_KK>() + l * 1024; const float* const pKA = kin<I_KA>() + l * 1024; const float* const pRK = kin<I_RK>() + l * 1024; const float* const pW0 = kin<I_W0>() + l * 1024; const float* const pV0c = kin<I_V0>();
    bf16* KKo = (bf16*)(F.ws + WS_KK); bf16* BQo = (bf16*)(F.ws + WS_BQ); bf16* KPo = (bf16*)(F.ws + WS_KP); bf16* Ro = (bf16*)(F.ws + WS_R); bf16* Go = (bf16*)(F.ws + WS_G);
    bf16* V0 = (bf16*)(F.ws + WS_V0); bf16* V1 = (bf16*)(F.ws + WS_V1); float* Wo = (float*)(F.ws + WS_W); float* BON = (float*)(F.ws + WS_BONUS);
#pragma unroll 1
    for (int item = gw; item < T / 4; item += NGW) {
        const int tok0 = item * 4;
        if (lane < 32 || (l == 1 && lane < 36)) {
            const bool isvd = lane >= 32; const int col = isvd ? C_VD + 8 * (lane - 32) : C_WD + 8 * lane, acol = isvd ? 256 + 8 * (lane - 32) : 8 * lane;
#pragma unroll 1
            for (int tk = 0; tk < 4; ++tk) { float v[8];
                if (isvd) load8(P + (size_t)(tok0 + tk) * P_LD + col, v);
                else { mixed8(P, tok0 + tk, col, mu + 3072 + 8 * lane, v);
                    if (lane < 8) {
#pragma unroll
                        for (int j = 0; j < 8; ++j) v[j] = tanhf_(v[j]); }
                    else if (lane >= 16) {
#pragma unroll
                        for (int j = 0; j < 8; ++j) v[j] = sigmoidf_(v[j]); } }
                *(LAS f32x4*)(A + tk * 288 + acol) = (f32x4){v[0], v[1], v[2], v[3]}; *(LAS f32x4*)(A + tk * 288 + acol + 4) = (f32x4){v[4], v[5], v[6], v[7]}; }
        }
        LDS_WAIT();
#pragma unroll 1
        for (int ch = 0; ch < 2; ++ch) { const int col0 = 512 * ch + 8 * lane, head = 8 * ch + (lane >> 3);
            float acc[4][8];
            lowrank_mm<64>(pAAA + col0, A + 64, acc);
            { float a0v[8], kkc[8], kac[8], rkc[8];
#pragma unroll
              for (int j = 0; j < 8; ++j) { a0v[j] = pA0[col0 + j]; kkc[j] = pKKc[col0 + j]; kac[j] = pKA[col0 + j]; rkc[j] = pRK[col0 + j]; }
#pragma unroll
              for (int tk = 0; tk < 4; ++tk) { const int tok = tok0 + tk; float k[8], r[8], av[8], kk[8], kp[8], bq[8];
                mixed8(P, tok, C_K + col0, mu + 1024 + col0, k); mixed8(P, tok, C_R + col0, mu + col0, r);
                float ss = 0.f, bo = 0.f;
#pragma unroll
                for (int j = 0; j < 8; ++j) { av[j] = sigmoidf_(a0v[j] + acc[tk][j]); kk[j] = k[j] * kkc[j]; ss += kk[j] * kk[j]; kp[j] = k[j] * (1.0f + (av[j] - 1.0f) * kac[j]); bo += r[j] * kp[j] * rkc[j]; }
                ss = sum8(ss); bo = sum8(bo);
                const float inv = 1.0f / fmaxf(sqrtf(ss), 1e-12f);
#pragma unroll
                for (int j = 0; j < 8; ++j) { kk[j] *= inv; bq[j] = kk[j] * av[j]; }
                store8(KKo + (size_t)tok * 1024 + col0, kk); store8(BQo + (size_t)tok * 1024 + col0, bq); store8(KPo + (size_t)tok * 1024 + col0, kp); store8(Ro + (size_t)tok * 1024 + col0, r);
                if ((lane & 7) == 0) BON[tok * 16 + head] = bo; } }
            lowrank_mm<64>(pDEC + col0, A, acc);
            { float w0v[8];
#pragma unroll
              for (int j = 0; j < 8; ++j) w0v[j] = pW0[col0 + j];
#pragma unroll
              for (int tk = 0; tk < 4; ++tk) { float w[8];
#pragma unroll
                for (int j = 0; j < 8; ++j) { const float nd = -(w0v[j] + acc[tk][j]); const float sp = fmaxf(nd, 0.f) + log1pf(__expf(-fabsf(nd))); w[j] = __expf(-__expf(-sp - 0.5f)); }
                float* wp = Wo + (size_t)(tok0 + tk) * 1024 + col0; *(f32x4*)wp = (f32x4){w[0], w[1], w[2], w[3]}; *(f32x4*)(wp + 4) = (f32x4){w[4], w[5], w[6], w[7]}; } }
            lowrank_mm<128>(pGUP + col0, A + 128, acc);
#pragma unroll
            for (int tk = 0; tk < 4; ++tk) store8(Go + (size_t)(tok0 + tk) * 1024 + col0, acc[tk]);
            if (l == 1) lowrank_mm<32>(pVMU + col0, A + 256, acc);
            { float v0v[8];
#pragma unroll
              for (int j = 0; j < 8; ++j) v0v[j] = (l == 1) ? pV0c[col0 + j] : 0.f;
#pragma unroll
              for (int tk = 0; tk < 4; ++tk) { const int tok = tok0 + tk; float v[8]; mixed8(P, tok, C_V + col0, mu + 2048 + col0, v);
                if (l == 1) { float vf[8]; load8(V0 + (size_t)tok * 1024 + col0, vf);
#pragma unroll
                    for (int j = 0; j < 8; ++j) v[j] = v[j] + (vf[j] - v[j]) * sigmoidf_(v0v[j] + acc[tk][j]);
                    store8(V1 + (size_t)tok * 1024 + col0, v); }
                else store8(V0 + (size_t)tok * 1024 + col0, v); } }
        }
        LDS_WAIT();
    }
}

constexpr int SC_CH = 32, SC_COF = 0, SC_VB = 2 * SC_CH * 320 * 4, SC_YB = SC_VB + 2 * SC_CH * 32 * 4;
__device__ __forceinline__ void scan_load(const Frame& F, int l, int b, int h, int half, int cc, int buf) {
    const int tl = F.tid - 256, s = tl >> 3, q8 = tl & 7, t = cc * SC_CH + s; const size_t row = (size_t)b * SEQ + t, base = row * 1024 + h * 64 + 8 * q8;
    LAS float* cof = (LAS float*)(F.lds + SC_COF) + (buf * SC_CH + s) * 320 + 8 * q8;
    const float* W = (const float*)(F.ws + WS_W);
    *(LAS f32x4*)cof = *(const f32x4*)(W + base); *(LAS f32x4*)(cof + 4) = *(const f32x4*)(W + base + 4);
    const size_t offs[4] = {WS_KK, WS_BQ, WS_KP, WS_R};
#pragma unroll
    for (int ar = 0; ar < 4; ++ar) { float v[8]; load8((const bf16*)(F.ws + offs[ar]) + base, v);
        *(LAS f32x4*)(cof + 64 * (ar + 1)) = (f32x4){v[0], v[1], v[2], v[3]}; *(LAS f32x4*)(cof + 64 * (ar + 1) + 4) = (f32x4){v[4], v[5], v[6], v[7]}; }
    const u32x2 vv = *(const u32x2*)((const bf16*)(F.ws + (l == 0 ? WS_V0 : WS_V1)) + row * 1024 + h * 64 + half * 32 + 4 * q8);
    *(LAS f32x4*)((LAS float*)(F.lds + SC_VB) + (buf * SC_CH + s) * 32 + 4 * q8) = (f32x4){bflo(vv.x), bfhi(vv.x), bflo(vv.y), bfhi(vv.y)};
}
__device__ __forceinline__ void scan_store(const Frame& F, int b, int h, int half, int cc, int buf) {
    const int tl = F.tid - 256, s = tl >> 3, q8 = tl & 7, t = cc * SC_CH + s; const size_t row = (size_t)b * SEQ + t;
    const f32x4 y = *(const LAS f32x4*)((LAS float*)(F.lds + SC_YB) + (buf * SC_CH + s) * 32 + 4 * q8);
    u32x2 w; w.x = pk2(y[0], y[1]); w.y = pk2(y[2], y[3]);
    *(u32x2*)((bf16*)(F.ws + WS_Y) + row * 1024 + h * 64 + half * 32 + 4 * q8) = w;
}
__device__ __forceinline__ void p4_scan(const Frame& F, int l) {
    for (int unit = F.vcu; unit < NBATCH * NHEAD * 2; unit += F.G) {
        const int b = unit >> 5, h = (unit >> 1) & 15, half = unit & 1;
        const bool loader = F.wave >= 4;
        const int g = F.lane >> 4, q = F.lane & 15, r0 = F.wave * 8 + g * 2;
        f32x4 s0 = (f32x4){0.f, 0.f, 0.f, 0.f}, s1 = s0;
        if (loader) scan_load(F, l, b, h, half, 0, 0);
        __syncthreads();
        constexpr int NCH = SEQ / SC_CH;
        for (int cc = 0; cc < NCH; ++cc) { const int buf = cc & 1;
            if (loader) { if (cc >= 1) scan_store(F, b, h, half, cc - 1, buf ^ 1); if (cc + 1 < NCH) scan_load(F, l, b, h, half, cc + 1, buf ^ 1); }
            else {
                const LAS float* cof = (const LAS float*)(F.lds + SC_COF) + buf * SC_CH * 320 + 4 * q;
                const LAS float* vb = (const LAS float*)(F.lds + SC_VB) + buf * SC_CH * 32 + r0;
                LAS float* yb = (LAS float*)(F.lds + SC_YB) + buf * SC_CH * 32 + r0;
#pragma unroll 4
                for (int s = 0; s < SC_CH; ++s) {
                    const f32x4 wv = *(const LAS f32x4*)(cof + s * 320), kkv = *(const LAS f32x4*)(cof + s * 320 + 64), bqv = *(const LAS f32x4*)(cof + s * 320 + 128), kpv = *(const LAS f32x4*)(cof + s * 320 + 192), rv = *(const LAS f32x4*)(cof + s * 320 + 256);
                    const f32x2 vv = *(const LAS f32x2*)(vb + s * 32);
                    float sa0 = (s0[0] * kkv[0] + s0[1] * kkv[1]) + (s0[2] * kkv[2] + s0[3] * kkv[3]);
                    float sa1 = (s1[0] * kkv[0] + s1[1] * kkv[1]) + (s1[2] * kkv[2] + s1[3] * kkv[3]);
                    sa0 = dpp_sum16(sa0); sa1 = dpp_sum16(sa1);
                    s0 = s0 * wv + (vv[0] * kpv - sa0 * bqv);
                    s1 = s1 * wv + (vv[1] * kpv - sa1 * bqv);
                    float y0 = (s0[0] * rv[0] + s0[1] * rv[1]) + (s0[2] * rv[2] + s0[3] * rv[3]);
                    float y1 = (s1[0] * rv[0] + s1[1] * rv[1]) + (s1[2] * rv[2] + s1[3] * rv[3]);
                    y0 = dpp_sum16(y0); y1 = dpp_sum16(y1);
                    if (q == 0) *(LAS f32x2*)(yb + s * 32) = (f32x2){y0, y1};
                }
            }
            __syncthreads();
        }
        if (loader) scan_store(F, b, h, half, NCH - 1, (NCH - 1) & 1);
        __syncthreads();
    }
}

__device__ __forceinline__ void p5_post(const Frame& F, int l) {
    const int lane = F.lane;
    const float* const pCW = kin<I_CONVW>() + l * 3 * 1024; const float* const pLNW = kin<I_LNW>() + l * 1024; const float* const pLNB = kin<I_LNB>() + l * 1024;
    const bf16* P = (const bf16*)(F.ws + WS_P); const bf16* Y = (const bf16*)(F.ws + WS_Y); const bf16* G = (const bf16*)(F.ws + WS_G);
    const bf16* V = (const bf16*)(F.ws + (l == 0 ? WS_V0 : WS_V1)); const float* BON = (const float*)(F.ws + WS_BONUS); bf16* M = (bf16*)(F.ws + WS_H);
#pragma unroll 1
    for (int gw = F.vcu * NWAVES + F.wave; gw < T / 8; gw += F.G * NWAVES) { const int tok0 = gw * 8;
#pragma unroll 1
    for (int ch = 0; ch < 2; ++ch) { const int col0 = 512 * ch + 8 * lane, head = 8 * ch + (lane >> 3);
        float cw0[8], cw1[8], cw2[8], lnw[8], lnb[8], um1[8], um2[8];
#pragma unroll
        for (int j = 0; j < 8; ++j) { cw0[j] = pCW[col0 + j]; cw1[j] = pCW[1024 + col0 + j]; cw2[j] = pCW[2048 + col0 + j];
            lnw[j] = pLNW[col0 + j]; lnb[j] = pLNB[col0 + j]; um1[j] = 0.f; um2[j] = 0.f; }
        const int t0 = tok0 & (SEQ - 1);
        if (t0 >= 1) { float c1[8], c2[8]; load8(P + (size_t)(tok0 - 1) * P_LD + C_CC + col0, c1); load8(P + (size_t)(tok0 - 1) * P_LD + C_CH + col0, c2);
#pragma unroll
            for (int j = 0; j < 8; ++j) um1[j] = c1[j] * c2[j]; }
        if (t0 >= 2) { float c1[8], c2[8]; load8(P + (size_t)(tok0 - 2) * P_LD + C_CC + col0, c1); load8(P + (size_t)(tok0 - 2) * P_LD + C_CH + col0, c2);
#pragma unroll
            for (int j = 0; j < 8; ++j) um2[j] = c1[j] * c2[j]; }
#pragma unroll 2
        for (int tk = 0; tk < 8; ++tk) { const int tok = tok0 + tk; const bf16* pr = P + (size_t)tok * P_LD + col0;
            float c1[8], c2[8], cb[8], ga[8], gb[8], y[8], v[8], g[8], o[8];
            load8(pr + C_CC, c1); load8(pr + C_CH, c2); load8(pr + C_CB, cb); load8(pr + C_GA, ga); load8(pr + C_GB, gb);
            load8(Y + (size_t)tok * 1024 + col0, y); load8(V + (size_t)tok * 1024 + col0, v); load8(G + (size_t)tok * 1024 + col0, g);
            const float bo = BON[tok * 16 + head];
            float sm = 0.f;
#pragma unroll
            for (int j = 0; j < 8; ++j) sm += y[j];
            const float mean = sum8(sm) * (1.0f / 64.0f); float sq = 0.f;
#pragma unroll
            for (int j = 0; j < 8; ++j) { y[j] -= mean; sq += y[j] * y[j]; }
            const float rstd = __builtin_amdgcn_rsqf(sum8(sq) * (1.0f / 64.0f) + LNX_EPS);
#pragma unroll
            for (int j = 0; j < 8; ++j) { const float u = c1[j] * c2[j]; const float conv = cw0[j] * um2[j] + cw1[j] * um1[j] + cw2[j] * u; um2[j] = um1[j]; um1[j] = u;
                const float yconv = cb[j] * conv; const float yr = ((y[j] * rstd) * lnw[j] + lnb[j] + bo * v[j]) * g[j];
                o[j] = sigmoidf_(ga[j]) * yconv + sigmoidf_(gb[j]) * yr; }
            store8(M + (size_t)tok * 1024 + col0, o); }
    }
    }
}

__device__ __forceinline__ void p7_route(const Frame& F, int l) {
    const int lane = F.lane;
#pragma unroll 1
    for (int gw = F.vcu * NWAVES + F.wave; gw < T / 8; gw += F.G * NWAVES) { const int tok0 = gw * 8, b = tok0 >> 11;
    LAS float* xs = (LAS float*)(F.lds + F.wave * 8192);
    const float* X = (const float*)(F.ws + WS_X); const float* ad = ada_ptr(F, l, b); const float* Wr = kin<I_WR>(); const float* const pN2G = kin<I_N2G>() + l * 1024; const float* const pRB = kin<I_RB>();
    const int tk = lane & 7, gq = lane >> 3, k4 = lane & 31, th = lane >> 5;
    f32x4 acc = (f32x4){0.f, 0.f, 0.f, 0.f}; float ssp[4] = {0.f, 0.f, 0.f, 0.f};
    for (int kc = 0; kc < 8; ++kc) { const int k = kc * 128 + 4 * k4;
        const f32x4 gmv = *(const f32x4*)(pN2G + k) * (1.0f + *(const f32x4*)(ad + 4096 + k));
#pragma unroll
        for (int i = 0; i < 4; ++i) { const int tl = 2 * i + th; const f32x4 xv = *(const f32x4*)(X + (size_t)(tok0 + tl) * 1024 + k);
            ssp[i] += (xv[0] * xv[0] + xv[1] * xv[1]) + (xv[2] * xv[2] + xv[3] * xv[3]); *(LAS f32x4*)(xs + tl * 132 + 4 * k4) = xv * gmv; }
        LDS_WAIT();
#pragma unroll 8
        for (int kk = 0; kk < 128; ++kk) { const float x = xs[tk * 132 + kk]; const f32x4 w = *(const f32x4*)(Wr + (size_t)(kc * 128 + kk) * 32 + 4 * gq); acc += x * w; }
        LDS_WAIT();
    }
    float ss = 0.f;
#pragma unroll
    for (int i = 0; i < 4; ++i) { float v = ssp[i]; v += __shfl_xor(v, 1); v += __shfl_xor(v, 2); v += __shfl_xor(v, 4); v += __shfl_xor(v, 8); v += __shfl_xor(v, 16);
        const float o = __shfl(v, (tk & 1) * 32); if ((tk >> 1) == i) ss = o; }
    const float rstd = __builtin_amdgcn_rsqf(ss * (1.0f / 1024.0f) + NORM_EPS);
    const float* br = (const float*)(F.ws + WS_CTL + CTL_BIASR) + (l * 8 + b) * 32 + 4 * gq;
    float aff[4], sel[4];
#pragma unroll
    for (int j = 0; j < 4; ++j) { aff[j] = sigmoidf_(rstd * acc[j] + br[j]); sel[j] = aff[j] + pRB[4 * gq + j]; }
    int i1 = 0;
#pragma unroll
    for (int j = 1; j < 4; ++j) if (sel[j] > sel[i1]) i1 = j;
    int i2 = (i1 == 0) ? 1 : 0;
#pragma unroll
    for (int j = 0; j < 4; ++j) if (j != i1 && j != i2 && sel[j] > sel[i2]) i2 = j;
    float bs = sel[i1] + sel[i2]; int bg = gq;
#pragma unroll
    for (int off = 8; off < 64; off <<= 1) { const float os = __shfl_xor(bs, off); const int og = __shfl_xor(bg, off); if (os > bs || (os == bs && og < bg)) { bs = os; bg = og; } }
    if (gq == bg) { const int tok = tok0 + tk; const int e0 = 4 * gq + i1, e1 = 4 * gq + i2; const float a0 = aff[i1], a1 = aff[i2], inv = 1.0f / (a0 + a1);
        unsigned* cnt = (unsigned*)(F.ws + WS_CTL) + CW_CNT + l * 32;
        const int p0 = (int)atomicAdd(cnt + e0, 1u), p1 = (int)atomicAdd(cnt + e1, 1u);
        int* EI = (int*)(F.ws + WS_EIDX); int* PO = (int*)(F.ws + WS_POS); float* WT = (float*)(F.ws + WS_WTS);
        EI[tok * 2] = e0; EI[tok * 2 + 1] = e1; PO[tok * 2] = p0; PO[tok * 2 + 1] = p1; WT[tok * 2] = a0 * inv; WT[tok * 2 + 1] = a1 * inv; }
    }
}

__device__ __forceinline__ void expert_table(const Frame& F, int l) {
    LAS int* tab = (LAS int*)(F.lds + TAB_OFF);
    if (F.tid < 64) { const unsigned* cnt = (const unsigned*)(F.ws + WS_CTL) + CW_CNT + l * 32; const int e = F.lane & 31;
        const int c = (int)__hip_atomic_load(cnt + e, __ATOMIC_RELAXED, __HIP_MEMORY_SCOPE_AGENT); const int padded = (c + 255) & ~255; int inc = padded;
#pragma unroll
        for (int o = 1; o < 32; o <<= 1) { const int v = __shfl_up(inc, o); if (e >= o) inc += v; }
        if (F.lane < 32) { tab[e] = inc - padded; tab[33 + e] = (inc - padded) >> 8; if (e == 31) { tab[32] = inc; tab[65] = inc >> 8; } } }
    __syncthreads();
}

__device__ __forceinline__ void p8_dispatch(const Frame& F, int l) {
    expert_table(F, l);
    const LAS int* tab = (const LAS int*)(F.lds + TAB_OFF);
    const float* const pN2G = kin<I_N2G>() + l * 1024;
    const int lane = F.lane;
#pragma unroll 1
    for (int gw = F.vcu * NWAVES + F.wave; gw < T / 8; gw += F.G * NWAVES) { const int tok0 = gw * 8, b = tok0 >> 11;
        const float* ad = ada_ptr(F, l, b); f32x4 gm[4], sh[4];
#pragma unroll
        for (int j = 0; j < 4; ++j) { const int c = 4 * lane + 256 * j; gm[j] = *(const f32x4*)(pN2G + c) * (1.0f + *(const f32x4*)(ad + 4096 + c)); sh[j] = *(const f32x4*)(ad + 3072 + c); }
        const float* X = (const float*)(F.ws + WS_X); const int* EI = (const int*)(F.ws + WS_EIDX); const int* PO = (const int*)(F.ws + WS_POS); int* SL = (int*)(F.ws + WS_SLOT); bf16* BUF = (bf16*)(F.ws + WS_BUF);
        for (int tk = 0; tk < 8; ++tk) { const int tok = tok0 + tk; f32x4 v[4]; float ss = 0.f;
#pragma unroll
            for (int j = 0; j < 4; ++j) { v[j] = *(const f32x4*)(X + (size_t)tok * 1024 + 4 * lane + 256 * j); ss += (v[j][0] * v[j][0] + v[j][1] * v[j][1]) + (v[j][2] * v[j][2] + v[j][3] * v[j][3]); }
            const float rstd = __builtin_amdgcn_rsqf(wave_sum(ss) * (1.0f / 1024.0f) + NORM_EPS);
            const int s0 = tab[EI[tok * 2]] + PO[tok * 2], s1 = tab[EI[tok * 2 + 1]] + PO[tok * 2 + 1];
            if (lane == 0) { SL[tok * 2] = s0; SL[tok * 2 + 1] = s1; }
#pragma unroll
            for (int j = 0; j < 4; ++j) { const f32x4 h = v[j] * rstd * gm[j] + sh[j]; u32x2 w; w.x = pk2(h[0], h[1]); w.y = pk2(h[2], h[3]);
                *(u32x2*)(BUF + (size_t)s0 * 1024 + 4 * lane + 256 * j) = w; *(u32x2*)(BUF + (size_t)s1 * 1024 + 4 * lane + 256 * j) = w; } }
    }
}

#ifndef PHMASK
#define PHMASK 0xFFFF
#endif
#define PHM(n) (((PHMASK) >> (n)) & 1)
constexpr int NPHASES = 23;
__global__ void __launch_bounds__(NWAVES * 64, 2) trunk_fwd(Args args) {
    extern __shared__ __attribute__((aligned(16))) unsigned char lds_raw[];
    Frame F;
    F.lds = (LAS unsigned char*)lds_raw;
    F.tid = threadIdx.x; F.lane = F.tid & 63; F.wave = __builtin_amdgcn_readfirstlane(F.tid >> 6);
    F.G = gridDim.x; { const int bx = blockIdx.x; F.vcu = (F.G % 8 == 0) ? (bx % 8) * (F.G / 8) + bx / 8 : bx; }
    unsigned char* const wsbase = (unsigned char*)kin<29>(); F.ws = wsbase; const int vcu0 = F.vcu;
    volatile LAS unsigned* MISC = (volatile LAS unsigned*)(F.lds + MISC_OFF);
    if (F.tid < 32) MISC[F.tid] = 0u;
    __syncthreads();
    const unsigned long long lohi = (unsigned long long)kin<30>(); const int lo = (int)(unsigned)lohi, hi = (int)(unsigned)(lohi >> 32);
    XcdBarrier bar; bar.bar = (unsigned*)(F.ws + WS_CTL) + CW_BAR; bar.x = 0; bar.st = nullptr;
    if (hi - lo > 1) bar = xcd_barrier_post((unsigned*)(F.ws + WS_CTL) + CW_BAR, MISC + 8);
#pragma unroll 1
    for (int ph = lo; ph < hi; ++ph) {
        { int t_ = threadIdx.x; asm volatile("" : "+v"(t_)); F.tid = t_; F.lane = t_ & 63; F.wave = __builtin_amdgcn_readfirstlane(t_ >> 6);
          unsigned char* w_ = wsbase; asm volatile("" : "+s"(w_)); F.ws = w_; int v_ = vcu0; asm volatile("" : "+s"(v_)); F.vcu = v_; }
        const int l = (ph - 2) / 10, k = (ph >= 2 && ph <= 21) ? (ph - 2) % 10 : -1;
        if (PHM(0) && ph == 0) p0_prologue(F);
        else if (PHM(0) && ph == 1) p0b_ada_reduce(F);
        else if (PHM(1) && ph == 22) p1_norm<2>(F, 1);
        else if (PHM(1) && k == 0) { if (l == 0) p1_norm<0>(F, 0); else p1_norm<1>(F, 1); }
        else if (PHM(3) && k == 2) p3_prep(F, l);
        else if (PHM(4) && k == 3) p4_scan(F, l);
        else if (PHM(5) && k == 4) p5_post(F, l);
        else if (PHM(7) && k == 6) p7_route(F, l);
        else if (PHM(8) && k == 7) p8_dispatch(F, l);
        else if (PHM(2) && (k == 1 || k == 5 || k == 8 || k == 9)) {
            pg8::Gemm g; pg8::UniOrder S; pg8::EpiUni E;
            S.expert = (k >= 8); S.so.init(T, 1024, F.G, (int)blockIdx.x); S.eo = pg8::ExpertOrder{(const PG8_LAS int*)(F.lds + TAB_OFF + 33 * 4), 0, F.G, (int)blockIdx.x};
            E.e0 = pg8::EpiBf16Plain{(bf16*)(F.ws + WS_P), P_LD, -1}; E.e1 = pg8::EpiResid{nullptr, (float*)(F.ws + WS_X), ada_ptr(F, l, 0) + 2048, 6144}; E.e2 = pg8::EpiSwiGLU{(bf16*)(F.ws + WS_HB)};
            if (k == 1) {
                const int N = (l == 0) ? N_IN : P_LD; S.so.init(T, N, F.G, (int)blockIdx.x); E.mode = 0;
                g = pg8::Gemm{(const bf16*)(F.ws + WS_H), (const bf16*)(F.ws + WS_BT_IN) + (size_t)l * P_LD * 1024, T, N, 1024};
            } else if (k == 5) {
                E.mode = 1; E.e1.xin = (l == 0) ? kin<I_X>() : (const float*)(F.ws + WS_X);
                g = pg8::Gemm{(const bf16*)(F.ws + WS_H), (const bf16*)(F.ws + WS_BT_OUT) + (size_t)l * 1024 * 1024, T, 1024, 1024};
            } else {
                expert_table(F, l);
                S.eo.ntiles = ((const LAS int*)(F.lds + TAB_OFF))[65];
                if (k == 8) { E.mode = 2; g = pg8::Gemm{(const bf16*)(F.ws + WS_BUF), (const bf16*)(F.ws + WS_BT_E1) + (size_t)l * 32 * 1024 * 1024, MAXROWS, 32 * 1024, 1024}; }
                else { E.mode = 0; E.e0 = pg8::EpiBf16Plain{(bf16*)(F.ws + WS_YE), 1024, 3}; g = pg8::Gemm{(const bf16*)(F.ws + WS_HB), (const bf16*)(F.ws + WS_BT_E2) + (size_t)l * 32 * 1024 * 512, MAXROWS, 32 * 1024, 512}; }
            }
            pg8::gemm_phase<pg8::EpiUni, pg8::UniOrder, true, true>(F.lds, g, S, E);
        }
        if (ph + 1 < hi) xcd_barrier(bar);
    }
}

extern "C" void kernel_launch(void* const* d_in, const int* in_sizes, int n_in, void* d_out, int out_size, void* d_ws, size_t ws_size, hipStream_t stream) {
    static int grid = 0;
    if (grid == 0) {
        if (n_in != 28 || in_sizes[0] != T * D || out_size != T * D || ws_size < WS_END) { fprintf(stderr, "kernel_launch: unexpected shapes (n_in %d, in0 %d, out %d, ws %zu < %zu?); nothing launched\n", n_in, n_in > 0 ? in_sizes[0] : -1, out_size, ws_size, (size_t)WS_END); grid = -1; return; }
        int dev = 0, cus = 0, per_cu = 0;
        if (hipGetDevice(&dev) != hipSuccess || hipDeviceGetAttribute(&cus, hipDeviceAttributeMultiprocessorCount, dev) != hipSuccess) { fprintf(stderr, "kernel_launch: device query failed\n"); grid = -1; return; }
        if (hipFuncSetAttribute((const void*)trunk_fwd, hipFuncAttributeMaxDynamicSharedMemorySize, LDS_BYTES) != hipSuccess) { fprintf(stderr, "kernel_launch: hipFuncSetAttribute failed\n"); grid = -1; return; }
        if (hipOccupancyMaxActiveBlocksPerMultiprocessor(&per_cu, (const void*)trunk_fwd, NWAVES * 64, LDS_BYTES) != hipSuccess || per_cu < 1) { fprintf(stderr, "kernel_launch: occupancy query says %d blocks per CU\n", per_cu); }
        (void)hipGetLastError();
        grid = cus;
    }
    if (grid < 0) return;
    if (hipMemsetAsync((char*)d_ws + WS_CTL, 0, CTL_ZERO_BYTES, stream) != hipSuccess) { fprintf(stderr, "kernel_launch: memset failed\n"); return; }
    Args a{};
    for (int i = 0; i < 28; ++i) a.p[i] = d_in[i];
    a.p[28] = d_out; a.p[29] = d_ws;
#if MK_ONE_LAUNCH
    a.ph_lo = 0; a.ph_hi = NPHASES;
    void* kargs[] = {&a};
    hipError_t e = hipLaunchCooperativeKernel((const void*)trunk_fwd, dim3(grid), dim3(NWAVES * 64), kargs, LDS_BYTES, stream);
    if (e != hipSuccess) fprintf(stderr, "kernel_launch: cooperative launch failed: %s (grid %d)\n", hipGetErrorString(e), grid);
#else
    for (int p = 0; p < NPHASES; ++p) { a.ph_lo = p; a.ph_hi = p + 1;
        hipLaunchKernelGGL(trunk_fwd, dim3(grid), dim3(NWAVES * 64), LDS_BYTES, stream, a);
        const hipError_t le = hipPeekAtLastError(); if (le != hipSuccess) { fprintf(stderr, "kernel_launch: launch %d failed: %s\n", p, hipGetErrorName(le)); break; } }
#endif
}
```

```cpp
#include <hip/hip_runtime.h>
#include <cstdio>
#include <cstdint>

#ifndef MK_ONE_LAUNCH
#define MK_ONE_LAUNCH 1
#endif

namespace pg8 {
#define PG8_LAS __attribute__((address_space(3)))
typedef unsigned short bf16_t;
typedef short bf16x8 __attribute__((ext_vector_type(8)));
typedef float f32x4 __attribute__((ext_vector_type(4)));
typedef unsigned u32x4 __attribute__((ext_vector_type(4)));
constexpr int BM = 256, BK = 64, HALF = 128, HTB = HALF * BK * 2  , STAGE_BYTES = 8 * HTB, NXCD = 8, WGM = 8;

__host__ __device__ __forceinline__ int lds_byte(int r, int c) { const int st = (r >> 4) * 2 + (c >> 5), rr = r & 15, cc = c & 31, ob = rr * 64 + cc * 2; return st * 1024 + (ob ^ (((ob >> 9) & 1) << 5)); }
__host__ __device__ __forceinline__ void stage_rc(int b, int& R, int& C) { const int st = b / 1024, sb = b % 1024, swz = sb ^ (((sb >> 9) & 1) << 5); R = (st >> 1) * 16 + swz / 64; C = (st & 1) * 32 + (swz % 64) / 2; }
__host__ __device__ __forceinline__ int perm32(int rho) { const int n = rho >> 4, i = rho & 15; return 8 * (i >> 2) + 4 * n + (i & 3); }

struct Unit { int pm, pn; };
struct Gemm { const bf16_t* A; const bf16_t* Bt; int M, N, K; };

struct StaticOrder {
    int nM, nN, nwg, G, c;
    __host__ __device__ void init(int M, int N, int G_, int c_) { nM = M / BM; nN = N / BM; nwg = nM * nN; G = G_; c = c_; }
    __host__ __device__ bool next(int i, Unit& u) const {
        const long L = (long)i * G + c; if (L >= nwg) return false;
        int wgid = (int)L; { const int q = nwg / NXCD, r = nwg % NXCD, xcd = wgid % NXCD, off = wgid / NXCD; wgid = (xcd < r ? xcd * (q + 1) : r * (q + 1) + (xcd - r) * q) + off; }
        const int nig = WGM * nN, gid = wgid / nig, fm = gid * WGM, gsz = (nM - fm) < WGM ? (nM - fm) : WGM;
        u.pm = fm + ((wgid % nig) % gsz); u.pn = (wgid % nig) / gsz; return true;
    }
    __device__ __forceinline__ void a_ready(const Unit&) const {}
    __device__ __forceinline__ void done(const Unit&) const {}
};
__device__ __forceinline__ unsigned cvt_pk_bf16(float lo, float hi) { unsigned r; asm volatile("v_cvt_pk_bf16_f32 %0, %1, %2" : "=v"(r) : "v"(lo), "v"(hi)); return r; }
typedef float f32x2 __attribute__((ext_vector_type(2)));
typedef unsigned u32x2 __attribute__((ext_vector_type(2)));

struct EpiBf16Plain {
    static constexpr bool PERM = true, AFTER_DRAIN = false;
    bf16_t* O; int ldc; int cmask;
    __device__ __forceinline__ void operator()(const f32x4 (&acc)[2][2][4][2], const Unit& u, int wr, int wc, int fr, int fq) const {
        const int row0 = u.pm * BM + wr * 64 + fr; const int col0 = (u.pn & cmask) * BM + wc * 32 + 8 * fq;
#pragma unroll
        for (int ai = 0; ai < 2; ++ai)
#pragma unroll
            for (int m = 0; m < 4; ++m) { bf16_t* rowp = O + (size_t)(row0 + ai * HALF + m * 16) * ldc + col0;
#pragma unroll
                for (int bj = 0; bj < 2; ++bj) { const f32x4 v0 = acc[ai][bj][m][0], v1 = acc[ai][bj][m][1];
                    u32x4 w; w.x = cvt_pk_bf16(v0[0], v0[1]); w.y = cvt_pk_bf16(v0[2], v0[3]); w.z = cvt_pk_bf16(v1[0], v1[1]); w.w = cvt_pk_bf16(v1[2], v1[3]);
                    *(u32x4*)(rowp + bj * HALF) = w; } }
    }
};
struct EpiResid {
    static constexpr bool PERM = false, AFTER_DRAIN = false;
    const float* xin; float* xout; const float* gate;
    int gstride;
    __device__ __forceinline__ void operator()(const f32x4 (&acc)[2][2][4][2], const Unit& u, int wr, int wc, int fr, int fq) const {
        const int row0 = u.pm * BM + wr * 64 + fr, col0 = u.pn * BM + wc * 32 + 4 * fq;
        const float* gp = gate + (size_t)(u.pm >> 3) * gstride;
        f32x4 gv[2][2];
#pragma unroll
        for (int bj = 0; bj < 2; ++bj)
#pragma unroll
            for (int n = 0; n < 2; ++n) gv[bj][n] = *(const f32x4*)(gp + col0 + bj * HALF + n * 16);
#pragma unroll
        for (int ai = 0; ai < 2; ++ai)
#pragma unroll
            for (int m = 0; m < 4; ++m) { const size_t ro = (size_t)(row0 + ai * HALF + m * 16) * 1024 + col0;
#pragma unroll
                for (int bj = 0; bj < 2; ++bj)
#pragma unroll
                    for (int n = 0; n < 2; ++n) { const f32x4 xi = *(const f32x4*)(xin + ro + bj * HALF + n * 16);
                        *(f32x4*)(xout + ro + bj * HALF + n * 16) = xi + gv[bj][n] * acc[ai][bj][m][n]; }
                asm volatile("" ::: "memory"); }
    }
};
struct EpiSwiGLU {
    static constexpr bool PERM = false, AFTER_DRAIN = false;
    bf16_t* O;
    __device__ __forceinline__ void operator()(const f32x4 (&acc)[2][2][4][2], const Unit& u, int wr, int wc, int fr, int fq) const {
        const int row0 = u.pm * BM + wr * 64 + fr, col0 = (u.pn & 3) * HALF + wc * 32 + 4 * fq;
#pragma unroll
        for (int ai = 0; ai < 2; ++ai)
#pragma unroll
            for (int m = 0; m < 4; ++m) { bf16_t* rowp = O + (size_t)(row0 + ai * HALF + m * 16) * 512 + col0;
#pragma unroll
                for (int n = 0; n < 2; ++n) { const f32x4 g = acc[ai][0][m][n], up = acc[ai][1][m][n]; f32x4 h;
#pragma unroll
                    for (int j = 0; j < 4; ++j) h[j] = g[j] * __builtin_amdgcn_rcpf(1.0f + __expf(-g[j])) * up[j];
                    u32x2 w; w.x = cvt_pk_bf16(h[0], h[1]); w.y = cvt_pk_bf16(h[2], h[3]);
                    *(u32x2*)(rowp + n * 16) = w; } }
    }
};
struct ExpertOrder {
    const PG8_LAS int* ts; int ntiles, G, c;
    __device__ __forceinline__ bool next(int i, Unit& u) const {
        const int L = i * G + c; if (L >= ntiles * 4) return false;
        const int pm = L >> 2; int e = 0;
#pragma unroll 1
        for (int k = 1; k < 32; ++k) e += (ts[k] <= pm) ? 1 : 0;
        u.pm = pm; u.pn = e * 4 + (L & 3); return true;
    }
    __device__ __forceinline__ void a_ready(const Unit&) const {}
    __device__ __forceinline__ void done(const Unit&) const {}
};

struct UniOrder {
    StaticOrder so; ExpertOrder eo; bool expert;
    __device__ __forceinline__ bool next(int i, Unit& u) const { return expert ? eo.next(i, u) : so.next(i, u); }
    __device__ __forceinline__ void a_ready(const Unit&) const {}
    __device__ __forceinline__ void done(const Unit&) const {}
};
struct EpiUni {
    static constexpr bool AFTER_DRAIN = false;
    int mode; EpiBf16Plain e0; EpiResid e1; EpiSwiGLU e2;
    __device__ __forceinline__ bool perm() const { return mode == 0; }
    __device__ __forceinline__ void operator()(const f32x4 (&acc)[2][2][4][2], const Unit& u, int wr, int wc, int fr, int fq) const {
        if (mode == 0) e0(acc, u, wr, wc, fr, fq); else if (mode == 1) e1(acc, u, wr, wc, fr, fq); else e2(acc, u, wr, wc, fr, fq);
    }
};
template <class Epi, class Sched, bool ALIGN_EPI = false, bool SP2 = false>
__device__ __forceinline__ void gemm_phase(PG8_LAS unsigned char* lds, const Gemm g, const Sched& S, const Epi& E) {
    int tid_ = threadIdx.x; asm volatile("" : "+v"(tid_));
    const int tid = tid_, wid = __builtin_amdgcn_readfirstlane(tid >> 6), lane = tid & 63, wr = wid >> 2, wc = wid & 3, fr = lane & 15, fq = lane >> 4;
    const int K = g.K, nt = K / BK;
    unsigned voffA[2], voffB[2];
#pragma unroll
    for (int i = 0; i < 2; ++i) { int R, C; stage_rc(tid * 16 + i * 8192, R, C); const int Rb = E.perm() ? ((R & ~31) + perm32(R & 31)) : R;
        voffA[i] = (unsigned)(R * K + C) * 2u; voffB[i] = (unsigned)(Rb * K + C) * 2u; }
    const size_t kstep = (size_t)(BK * 2);
    const size_t hstep = (size_t)HALF * K * 2;
    const size_t tstep = 2 * hstep;
    const unsigned ldsw = (unsigned)wid * 1024u;
    const int aoff = lds_byte(wr * 64 + fr, fq * 8), boff = lds_byte(wc * 32 + fr, fq * 8);
#define PG8_SA(b, h) (((b) * 2 + (h)) * HTB)
#define PG8_SB(b, h) ((4 + (b) * 2 + (h)) * HTB)
#define PG8_STAGE(bufoff, gbase, voff) do { _Pragma("unroll") for (int _i = 0; _i < 2; ++_i) \
        __builtin_amdgcn_global_load_lds((const unsigned*)((const char*)(gbase) + (voff)[_i]), (PG8_LAS unsigned*)(lds + (bufoff) + ldsw + _i * 8192), 16, 0, 0); } while (0)
#define PG8_LDA(dst, b, h) do { _Pragma("unroll") for (int m = 0; m < 4; ++m) _Pragma("unroll") for (int k = 0; k < 2; ++k) dst[m][k] = *(const PG8_LAS bf16x8*)(lds + PG8_SA(b, h) + aoff + m * 2048 + k * 1024); } while (0)
#define PG8_LDB(dst, b, h) do { _Pragma("unroll") for (int n = 0; n < 2; ++n) _Pragma("unroll") for (int k = 0; k < 2; ++k) dst[n][k] = *(const PG8_LAS bf16x8*)(lds + PG8_SB(b, h) + boff + n * 2048 + k * 1024); } while (0)
#define PG8_MMA(ai, bj, At, Bt) do { __builtin_amdgcn_s_setprio(1); _Pragma("unroll") for (int m = 0; m < 4; ++m) _Pragma("unroll") for (int n = 0; n < 2; ++n) _Pragma("unroll") for (int k = 0; k < 2; ++k) \
        acc[ai][bj][m][n] = __builtin_amdgcn_mfma_f32_16x16x32_bf16(Bt[n][k], At[m][k], acc[ai][bj][m][n], 0, 0, 0); __builtin_amdgcn_s_setprio(0); } while (0)
#define PG8_WAIT_V(n) asm volatile("s_waitcnt vmcnt(" #n ")" ::: "memory")
#define PG8_WAIT_L(n) asm volatile("s_waitcnt lgkmcnt(" #n ")" ::: "memory")
#define PG8_BAR __builtin_amdgcn_s_barrier()
#define PG8_SCHED __builtin_amdgcn_sched_barrier(0)
    Unit cur, nxt; int ui = 0;
    if (!S.next(0, cur)) return;
    f32x4 acc[2][2][4][2];
#pragma unroll
    for (int a = 0; a < 2; ++a)
#pragma unroll
        for (int b = 0; b < 2; ++b)
#pragma unroll
            for (int m = 0; m < 4; ++m)
#pragma unroll
                for (int n = 0; n < 2; ++n) acc[a][b][m][n] = (f32x4){0.f, 0.f, 0.f, 0.f};
    bf16x8 At[4][2], B0[2][2], B1[2][2];
    const char* cA = (const char*)g.A + (size_t)cur.pm * tstep; const char* cB = (const char*)g.Bt + (size_t)cur.pn * tstep;
    S.a_ready(cur);
    if constexpr (SP2) {
        PG8_STAGE(PG8_SB(0, 0), cB, voffB); PG8_STAGE(PG8_SB(0, 1), cB + hstep, voffB); PG8_STAGE(PG8_SA(0, 0), cA, voffA); PG8_STAGE(PG8_SA(0, 1), cA + hstep, voffA);
        if (wr == 1) PG8_BAR;
        PG8_WAIT_V(2); PG8_BAR;
        PG8_STAGE(PG8_SB(1, 0), cB + kstep, voffB); PG8_STAGE(PG8_SA(1, 0), cA + kstep, voffA); PG8_STAGE(PG8_SB(1, 1), cB + hstep + kstep, voffB);
        PG8_WAIT_V(6); PG8_BAR;
    } else {
        PG8_STAGE(PG8_SB(0, 0), cB, voffB); PG8_STAGE(PG8_SA(0, 0), cA, voffA); PG8_STAGE(PG8_SB(0, 1), cB + hstep, voffB); PG8_STAGE(PG8_SA(0, 1), cA + hstep, voffA);
        if (wr == 1) PG8_BAR;
        PG8_WAIT_V(4); PG8_BAR;
        PG8_STAGE(PG8_SB(1, 0), cB + kstep, voffB); PG8_STAGE(PG8_SA(1, 0), cA + kstep, voffA); PG8_STAGE(PG8_SB(1, 1), cB + hstep + kstep, voffB);
        PG8_WAIT_V(6); PG8_BAR;
    }
    for (;;) {
        const bool has_next = S.next(ui + 1, nxt);
        const char* nA = has_next ? (const char*)g.A + (size_t)nxt.pm * tstep : cA; const char* nB = has_next ? (const char*)g.Bt + (size_t)nxt.pn * tstep : cB;
        for (int t = 0; t < nt; t += 2) {
            const bool last = (t == nt - 2);
            const char* a1 = cA + (size_t)(t + 1) * kstep;
            const char* a2 = last ? nA : cA + (size_t)(t + 2) * kstep; const char* b2 = last ? nB : cB + (size_t)(t + 2) * kstep;
            const char* a3 = a2 + kstep; const char* b3 = b2 + kstep;
            if (last && has_next) S.a_ready(nxt);
            if constexpr (SP2) {
            PG8_LDB(B0, 0, 0); PG8_LDB(B1, 0, 1); PG8_SCHED; PG8_LDA(At, 0, 0); PG8_STAGE(PG8_SA(1, 1), a1 + hstep, voffA);
            PG8_WAIT_V(8); PG8_WAIT_L(0); PG8_BAR; PG8_MMA(0, 0, At, B0); PG8_MMA(0, 1, At, B1); PG8_BAR; PG8_SCHED;
            PG8_LDA(At, 0, 1); PG8_STAGE(PG8_SB(0, 0), b2, voffB); PG8_STAGE(PG8_SB(0, 1), b2 + hstep, voffB); PG8_STAGE(PG8_SA(0, 0), a2, voffA);
            PG8_WAIT_V(8); PG8_WAIT_L(0); PG8_BAR; PG8_MMA(1, 0, At, B0); PG8_MMA(1, 1, At, B1); PG8_BAR; PG8_SCHED;
            PG8_LDB(B0, 1, 0); PG8_LDB(B1, 1, 1); PG8_SCHED; PG8_LDA(At, 1, 0); PG8_STAGE(PG8_SA(0, 1), a2 + hstep, voffA);
            PG8_WAIT_V(8); PG8_WAIT_L(0); PG8_BAR; PG8_MMA(0, 0, At, B0); PG8_MMA(0, 1, At, B1); PG8_BAR; PG8_SCHED;
            PG8_LDA(At, 1, 1); PG8_STAGE(PG8_SB(1, 0), b3, voffB); PG8_STAGE(PG8_SB(1, 1), b3 + hstep, voffB); PG8_STAGE(PG8_SA(1, 0), a3, voffA);
            PG8_WAIT_V(8); PG8_WAIT_L(0); PG8_BAR; PG8_MMA(1, 0, At, B0); PG8_MMA(1, 1, At, B1); PG8_BAR; PG8_SCHED;
            } else {
            PG8_LDB(B0, 0, 0); PG8_SCHED; PG8_LDA(At, 0, 0); PG8_STAGE(PG8_SA(1, 1), a1 + hstep, voffA);
            PG8_WAIT_L(8); PG8_BAR; PG8_WAIT_L(0); PG8_MMA(0, 0, At, B0); PG8_BAR; PG8_SCHED;
            PG8_LDB(B1, 0, 1); PG8_STAGE(PG8_SB(0, 0), b2, voffB);
            PG8_BAR; PG8_WAIT_L(0); PG8_MMA(0, 1, At, B1); PG8_BAR;
            PG8_LDA(At, 0, 1); PG8_STAGE(PG8_SA(0, 0), a2, voffA);
            PG8_BAR; PG8_WAIT_L(0); PG8_MMA(1, 0, At, B0); PG8_BAR; PG8_SCHED;
            PG8_STAGE(PG8_SB(0, 1), b2 + hstep, voffB);
            PG8_WAIT_V(6); PG8_BAR; PG8_MMA(1, 1, At, B1); PG8_BAR;
            PG8_LDB(B0, 1, 0); PG8_SCHED; PG8_LDA(At, 1, 0); PG8_STAGE(PG8_SA(0, 1), a2 + hstep, voffA);
            PG8_WAIT_L(8); PG8_BAR; PG8_WAIT_L(0); PG8_MMA(0, 0, At, B0); PG8_BAR; PG8_SCHED;
            PG8_LDB(B1, 1, 1); PG8_STAGE(PG8_SB(1, 0), b3, voffB);
            PG8_BAR; PG8_WAIT_L(0); PG8_MMA(0, 1, At, B1); PG8_BAR;
            PG8_LDA(At, 1, 1); PG8_STAGE(PG8_SA(1, 0), a3, voffA);
            PG8_BAR; PG8_WAIT_L(0); PG8_MMA(1, 0, At, B0); PG8_BAR; PG8_SCHED;
            PG8_STAGE(PG8_SB(1, 1), b3 + hstep, voffB);
            PG8_WAIT_V(6); PG8_BAR; PG8_MMA(1, 1, At, B1); PG8_BAR;
            }
        }
        if constexpr (ALIGN_EPI) { if (wr == 0) PG8_BAR; }
        if constexpr (!Epi::AFTER_DRAIN) { E(acc, cur, wr, wc, fr, fq); S.done(cur); }
        if (!has_next) break;
#pragma unroll
        for (int a = 0; a < 2; ++a)
#pragma unroll
            for (int b = 0; b < 2; ++b)
#pragma unroll
                for (int m = 0; m < 4; ++m)
#pragma unroll
                    for (int n = 0; n < 2; ++n) acc[a][b][m][n] = (f32x4){0.f, 0.f, 0.f, 0.f};
        cur = nxt; cA = nA; cB = nB; ++ui;
        if constexpr (ALIGN_EPI) { if (wr == 1) PG8_BAR; }
    }
    PG8_WAIT_V(0);
    if constexpr (!ALIGN_EPI) { if (wr == 0) PG8_BAR; }
    PG8_BAR;
    if constexpr (Epi::AFTER_DRAIN) { E.fused(acc, cur, wr, wc, fr, fq, lds, wid, lane); S.done(cur); }
#undef PG8_SA
#undef PG8_SB
#undef PG8_STAGE
#undef PG8_LDA
#undef PG8_LDB
#undef PG8_MMA
#undef PG8_WAIT_V
#undef PG8_WAIT_L
#undef PG8_BAR
#undef PG8_SCHED
}
}

constexpr int NWAVES = 8;
constexpr int T = 16384, D = 1024, SEQ = 2048, NBATCH = 8, NHEAD = 16;
constexpr int N_IN = 8448, P_LD = 9472;
constexpr int C_CB = 0, C_CC = 1024, C_CH = 2048, C_GA = 3072, C_GB = 4096, C_R = 5120, C_K = 6144, C_V = 7168, C_WD = 8192, C_AD = 8256, C_GD = 8320, C_VD = 8448;
constexpr int N_SHIFT = 3328, N_EXP = 32, D_EXP = 512;
constexpr int MAXROWS = 40960;
constexpr float NORM_EPS = 1e-6f, LNX_EPS = 64e-5f;

constexpr size_t MiB = 1u << 20;
constexpr size_t WS_CTL = 0, CTL_ZERO_BYTES = 1 * MiB;
constexpr size_t WS_BT_IN = 2 * MiB;
constexpr size_t WS_BT_OUT = 39 * MiB;
constexpr size_t WS_BT_E1 = 43 * MiB;
constexpr size_t WS_BT_E2 = 171 * MiB;
constexpr size_t WS_H = 235 * MiB;
constexpr size_t WS_ALR = WS_H;
constexpr size_t WS_P = 267 * MiB;
constexpr size_t WS_BUF = WS_P, WS_HB = WS_P + 80 * MiB, WS_YE = WS_P + 120 * MiB;
constexpr size_t WS_ADAP = WS_P;
constexpr size_t WS_W = 563 * MiB;
constexpr size_t WS_KK = 627 * MiB, WS_BQ = 659 * MiB, WS_KP = 691 * MiB, WS_R = 723 * MiB, WS_V0 = 755 * MiB, WS_V1 = 787 * MiB;
constexpr size_t WS_LR = 819 * MiB;
constexpr size_t WS_Y = 915 * MiB;
constexpr size_t WS_X = 947 * MiB;
constexpr size_t WS_BONUS = 1011 * MiB;
constexpr size_t WS_EIDX = 1012 * MiB, WS_POS = WS_EIDX + 128 * 1024, WS_WTS = WS_EIDX + 256 * 1024, WS_SLOT = WS_EIDX + 384 * 1024;
constexpr size_t WS_HIST = WS_EIDX + 512 * 1024;
constexpr size_t WS_WRT = WS_EIDX + 768 * 1024;
constexpr size_t WS_BT_LR = 1015 * MiB;
constexpr size_t WS_END = 1018 * MiB;
static_assert(WS_YE + (size_t)MAXROWS * 1024 * 2 <= WS_W && WS_P + (size_t)T * P_LD * 2 <= WS_W && WS_BT_IN + (size_t)2 * P_LD * 2048 <= WS_BT_OUT, "ws map");
constexpr int CW_CNT = 1024;
constexpr int CW_BAR = 4096;
constexpr size_t CTL_ADA = 256 * 1024;
constexpr size_t CTL_BIASR = 700 * 1024;

constexpr int RING_BYTES = 131072;
constexpr int TAB_OFF = RING_BYTES;
constexpr int MISC_OFF = RING_BYTES + 1024;
constexpr int LDS_BYTES = 147456;

#define GAS __attribute__((address_space(1)))
#define LAS __attribute__((address_space(3)))
typedef unsigned short bf16;
typedef float f32x4 __attribute__((ext_vector_type(4)));
typedef float f32x2 __attribute__((ext_vector_type(2)));
typedef unsigned u32x4 __attribute__((ext_vector_type(4)));
typedef unsigned u32x2 __attribute__((ext_vector_type(2)));
#define LDS_WAIT() asm volatile("s_waitcnt lgkmcnt(0)" ::: "memory")

__device__ __forceinline__ unsigned f2bf(float f) { unsigned u = __builtin_bit_cast(unsigned, f); return (u + 0x7fffu + ((u >> 16) & 1u)) >> 16; }
__device__ __forceinline__ unsigned pk2(float lo, float hi) { return f2bf(lo) | (f2bf(hi) << 16); }
__device__ __forceinline__ float bflo(unsigned u) { return __builtin_bit_cast(float, u << 16); }
__device__ __forceinline__ float bfhi(unsigned u) { return __builtin_bit_cast(float, u & 0xffff0000u); }
__device__ __forceinline__ void load8(const bf16* p, float (&o)[8]) { const u32x4 u = *(const u32x4*)p; o[0] = bflo(u.x); o[1] = bfhi(u.x); o[2] = bflo(u.y); o[3] = bfhi(u.y); o[4] = bflo(u.z); o[5] = bfhi(u.z); o[6] = bflo(u.w); o[7] = bfhi(u.w); }
__device__ __forceinline__ void store8(bf16* p, const float (&v)[8]) { u32x4 w; w.x = pk2(v[0], v[1]); w.y = pk2(v[2], v[3]); w.z = pk2(v[4], v[5]); w.w = pk2(v[6], v[7]); *(u32x4*)p = w; }
__device__ __forceinline__ float sigmoidf_(float x) { return __builtin_amdgcn_rcpf(1.0f + __expf(-x)); }
__device__ __forceinline__ float tanhf_(float x) { return 1.0f - 2.0f * __builtin_amdgcn_rcpf(__expf(2.0f * x) + 1.0f); }
__device__ __forceinline__ float wave_sum(float v) {
#pragma unroll
    for (int o = 1; o < 64; o <<= 1) v += __shfl_xor(v, o);
    return v;
}
__device__ __forceinline__ float sum8(float v) { v += __shfl_xor(v, 1); v += __shfl_xor(v, 2); v += __shfl_xor(v, 4); return v; }
template <int CTRL> __device__ __forceinline__ float dpp_f(float v) { return __builtin_bit_cast(float, __builtin_amdgcn_mov_dpp(__builtin_bit_cast(int, v), CTRL, 0xF, 0xF, true)); }
__device__ __forceinline__ float dpp_sum16(float v) {
    asm("" : "+v"(v));
    v += dpp_f<0xB1>(v);
    asm("" : "+v"(v));
    v += dpp_f<0x4E>(v);
    asm("" : "+v"(v));
    v += dpp_f<0x141>(v);
    asm("" : "+v"(v));
    v += dpp_f<0x140>(v);
    asm("" : "+v"(v));
    return v;
}

#define XB_TMO      128
#define XB_XCNT(j)  (256  + 64 * (j))
#define XB_XSUB(j)  (1280 + 64 * (j))
#define XB_XGEN(j)  (2304 + 64 * (j))
#define XB_TOP      3328
#define XB_TOPGEN   3392
#define XCD_BAR_WORDS 3456
#define XB_SPIN_CAP (1u << 18)

__device__ __forceinline__ unsigned xb_ld(unsigned* p)              { return __hip_atomic_load(p, __ATOMIC_RELAXED, __HIP_MEMORY_SCOPE_AGENT); }
__device__ __forceinline__ unsigned xb_add(unsigned* p, unsigned v) { return __hip_atomic_fetch_add(p, v, __ATOMIC_RELAXED, __HIP_MEMORY_SCOPE_AGENT); }
__device__ __forceinline__ unsigned xb_xcc_id() { return (unsigned)__builtin_amdgcn_s_getreg((3 << 11) | 20) & 0xFu; }
#define XB_SPIN(cond, bar) do { unsigned _sp = 0; while (cond) { __builtin_amdgcn_s_sleep(1); \
    if ((++_sp & 255u) == 0u) { if (xb_ld(&(bar)[XB_TMO])) break; if (_sp > XB_SPIN_CAP) { atomicAdd(&(bar)[XB_TMO], 1u); break; } } } } while (0)

struct XcdBarrier {
    unsigned* bar; unsigned x;
    volatile LAS unsigned* st;
};

__device__ __forceinline__ XcdBarrier xcd_barrier_post(unsigned* bar, volatile LAS unsigned* st) {
    XcdBarrier b; b.bar = bar; b.x = xb_xcc_id(); b.st = st;
    if (threadIdx.x == 0) (void)xb_add(&bar[XB_XCNT(b.x)], 1u);
    return b;
}
__device__ __forceinline__ void xcd_barrier_complete(unsigned* bar, unsigned x, unsigned& nloc, unsigned& nx) {
    const unsigned G = gridDim.x * gridDim.y * gridDim.z;
    unsigned sum, cnt, mine, sp = 0u;
    for (;;) {
        sum = 0u; cnt = 0u; mine = 0u;
#pragma unroll
        for (unsigned j = 0; j < 16; ++j) { const unsigned c = xb_ld(&bar[XB_XCNT(j)]); sum += c; cnt += (c > 0u) ? 1u : 0u; mine = (j == x) ? c : mine; }
        if (sum == G) break;
        __builtin_amdgcn_s_sleep(1);
        if ((++sp & 255u) == 0u) { if (xb_ld(&bar[XB_TMO])) break; if (sp > XB_SPIN_CAP) { atomicAdd(&bar[XB_TMO], 1u); break; } }
    }
    nloc = mine > 0u ? mine : 1u; nx = cnt > 0u ? cnt : 1u;
}

__device__ __forceinline__ void xcd_barrier(const XcdBarrier& b) {
    asm volatile("s_waitcnt vmcnt(0)" ::: "memory");
    __syncthreads();
    if (threadIdx.x == 0) {
        unsigned* bar = b.bar;
        __builtin_amdgcn_s_waitcnt(0);
        unsigned nloc = b.st[0], nx = b.st[1];
        if (nloc == 0u) { xcd_barrier_complete(bar, b.x, nloc, nx); b.st[0] = nloc; b.st[1] = nx; }
        const unsigned old = xb_add(&bar[XB_XSUB(b.x)], 1u);
        const unsigned gen = old / nloc;
        if (old + 1u == (gen + 1u) * nloc) {
            __builtin_amdgcn_fence(__ATOMIC_RELEASE, "agent");
            asm volatile("s_waitcnt vmcnt(0)" ::: "memory");
            const unsigned og = xb_add(&bar[XB_TOP], 1u);
            const unsigned tg = og / nx;
            if (og + 1u == (tg + 1u) * nx) xb_add(&bar[XB_TOPGEN], 1u);
            else XB_SPIN(xb_ld(&bar[XB_TOPGEN]) == tg, bar);
            __builtin_amdgcn_fence(__ATOMIC_ACQUIRE, "agent");
            xb_add(&bar[XB_XGEN(b.x)], 1u);
            asm volatile("s_waitcnt vmcnt(0)" ::: "memory");
        } else {
            XB_SPIN(xb_ld(&bar[XB_XGEN(b.x)]) == gen, bar);
            __builtin_amdgcn_fence(__ATOMIC_ACQUIRE, "agent");
            asm volatile("s_waitcnt vmcnt(0)" ::: "memory");
        }
    }
    __syncthreads();
}

struct Args { const void* p[30]; int ph_lo, ph_hi; };
template <int IDX> __device__ __forceinline__ const float* kin() {
    const auto ka = __builtin_amdgcn_kernarg_segment_ptr(); unsigned long long v;
    asm volatile("s_load_dwordx2 %0, %1, %2\n\ts_waitcnt lgkmcnt(0)" : "=s"(v) : "s"(ka), "i"(IDX * 8) : "memory");
    return (const float*)v;
}
enum { I_X = 0, I_C, I_WADA, I_BADA, I_N1G, I_N2G, I_WIN, I_MU, I_CONVW, I_W0, I_DECUP, I_A0, I_AAAUP, I_GATEUP, I_KK, I_KA, I_RK, I_LNW, I_LNB, I_VMD, I_VMU, I_V0, I_WOUT, I_WR, I_RB, I_WE1, I_WE2, I_FG };
struct Frame {
    LAS unsigned char* lds;
    int tid, lane, wave, vcu, G;
    unsigned char* ws;
};
__device__ __forceinline__ float* ada_ptr(const Frame& F, int l, int b) { return (float*)(F.ws + WS_CTL + CTL_ADA) + (size_t)(l * 8 + b) * 6144; }

__device__ __forceinline__ void transpose_item(const float* W, int K, int N, bf16* WT, int dst_row0, int k0, int n0, LAS float* scr, int lane) {
    float tv[32];
#pragma unroll
    for (int i = 0; i < 32; ++i) tv[i] = W[(size_t)(k0 + 2 * i + (lane >> 5)) * N + n0 + (lane & 31)];
#pragma unroll
    for (int i = 0; i < 32; ++i) { const int kk = 2 * i + (lane >> 5); scr[kk * 33 + (lane & 31)] = tv[i]; }
    LDS_WAIT();
    const int c = lane & 7;
#pragma unroll
    for (int j = 0; j < 4; ++j) { const int n = (lane >> 3) + 8 * j; const LAS float* s = scr + (8 * c) * 33 + n;
        u32x4 o; o.x = pk2(s[0 * 33], s[1 * 33]); o.y = pk2(s[2 * 33], s[3 * 33]); o.z = pk2(s[4 * 33], s[5 * 33]); o.w = pk2(s[6 * 33], s[7 * 33]);
        *(u32x4*)(WT + (size_t)(dst_row0 + n) * K + k0 + 8 * c) = o; }
    LDS_WAIT();
}
__device__ __forceinline__ void p0_prologue(const Frame& F) {
    LAS float* scr = (LAS float*)(F.lds + F.wave * 16384);
    const int gw = F.vcu * NWAVES + F.wave, NGW = F.G * NWAVES, lane = F.lane;
    constexpr int I_ADA = 768, I_A = 2 * 16 * 264, I_B = 2 * 16 * 32, I_C1 = 64 * 16 * 32, I_D = 64 * 8 * 32;
    constexpr int NITEMS = I_ADA + I_A + I_B + I_C1 + I_D;
    const float* const pC = kin<I_C>(); const float* const pWADA = kin<I_WADA>(); const float* const pWIN = kin<I_WIN>();
    const float* const pWOUT = kin<I_WOUT>(); const float* const pWE1 = kin<I_WE1>(); const float* const pWE2 = kin<I_WE2>(); const float* const pVMD = kin<I_VMD>();
    for (int it = gw; it < NITEMS; it += NGW) {
        int r = it;
        if (r < I_ADA) {
            const int l = r / 384, rr = r % 384, cch = rr >> 4, kc = rr & 15, col = cch * 256 + 4 * lane, k0 = kc * 64;
            float cv[8];
#pragma unroll
            for (int b = 0; b < 8; ++b) { const float x = pC[b * 1024 + k0 + lane]; cv[b] = x * sigmoidf_(x); }
            f32x4 acc[8];
#pragma unroll
            for (int b = 0; b < 8; ++b) acc[b] = (f32x4){0.f, 0.f, 0.f, 0.f};
            const float* wp = pWADA + ((size_t)l * 1024 + k0) * 6144 + col;
#pragma unroll 16
            for (int kk = 0; kk < 64; ++kk) { const f32x4 w = *(const f32x4*)(wp + (size_t)kk * 6144);
#pragma unroll
                for (int b = 0; b < 8; ++b) { const float s = __builtin_bit_cast(float, __builtin_amdgcn_readlane(__builtin_bit_cast(int, cv[b]), kk)); acc[b] += s * w; } }
#pragma unroll
            for (int b = 0; b < 8; ++b) *(f32x4*)((float*)(F.ws + WS_ADAP) + ((size_t)(kc * 2 + l) * 8 + b) * 6144 + col) = acc[b];
            continue;
        }
        r -= I_ADA;
        if (r < I_A) { const int l = r / (16 * 264), rr = r % (16 * 264), kb = rr / 264, nb = rr % 264;
            transpose_item(pWIN + (size_t)l * 1024 * N_IN, 1024, N_IN, (bf16*)(F.ws + WS_BT_IN) + (size_t)l * P_LD * 1024, 32 * nb, 64 * kb, 32 * nb, scr, lane); continue; }
        r -= I_A;
        if (r < I_B) { const int l = r / 512, rr = r % 512, kb = rr / 32, nb = rr % 32;
            transpose_item(pWOUT + (size_t)l * 1024 * 1024, 1024, 1024, (bf16*)(F.ws + WS_BT_OUT) + (size_t)l * 1024 * 1024, 32 * nb, 64 * kb, 32 * nb, scr, lane); continue; }
        r -= I_B;
        if (r < I_C1) { const int le = r / 512, rr = r % 512, kb = rr / 32, nb = rr % 32, n0 = 32 * nb;
            const int j0 = n0 & 511, dst = (j0 >> 7) * 256 + (n0 >= 512 ? 128 : 0) + (j0 & 127);
            transpose_item(pWE1 + (size_t)le * 1024 * 1024, 1024, 1024, (bf16*)(F.ws + WS_BT_E1) + (size_t)le * 1024 * 1024, dst, 64 * kb, n0, scr, lane); continue; }
        r -= I_C1;
        { const int le = r / 256, rr = r % 256, kb = rr / 32, nb = rr % 32;
            transpose_item(pWE2 + (size_t)le * 512 * 1024, 512, 1024, (bf16*)(F.ws + WS_BT_E2) + (size_t)le * 1024 * 512, 32 * nb, 64 * kb, 32 * nb, scr, lane); }
    }
    const int gt0 = F.vcu * NWAVES * 64 + F.tid, GT = F.G * NWAVES * 64;
    { const float* const pVMUp = kin<I_VMU>();
      for (int it = gt0; it < 1024 * 128; it += GT) { const int n = it >> 7, k0 = (it & 127) * 8; float o[8];
#pragma unroll
        for (int i = 0; i < 8; ++i) o[i] = 0.f;
        for (int j = 0; j < 32; ++j) { const float u = pVMUp[j * 1024 + n];
#pragma unroll
            for (int i = 0; i < 8; ++i) o[i] += pVMD[(k0 + i) * 32 + j] * u; }
        store8((bf16*)(F.ws + WS_BT_IN) + (size_t)P_LD * 1024 + (size_t)(C_VD + n) * 1024 + k0, o); } }
    { const float* const pDU = kin<I_DECUP>(); const float* const pAU = kin<I_AAAUP>(); const float* const pGU = kin<I_GATEUP>();
      for (int it = gt0; it < 2 * 3072 * 32; it += GT) { const int l = it / (3072 * 32), rr = it % (3072 * 32), n = rr >> 5, k0 = (rr & 31) * 8; float o[8];
#pragma unroll
        for (int i = 0; i < 8; ++i) { const int k = k0 + i; float v = 0.f;
            if (n < 1024) { if (k < 64) v = pDU[(size_t)(l * 64 + k) * 1024 + n]; }
            else if (n < 2048) { if (k >= 64 && k < 128) v = pAU[(size_t)(l * 64 + k - 64) * 1024 + n - 1024]; }
            else { if (k >= 128) v = pGU[(size_t)(l * 128 + k - 128) * 1024 + n - 2048]; }
            o[i] = v; }
        store8((bf16*)(F.ws + WS_BT_LR) + (size_t)l * 3072 * 256 + (size_t)n * 256 + k0, o); } }
    { const float* const pWRp = kin<I_WR>(); const int gt = F.vcu * NWAVES * 64 + F.tid; if (gt < 32768) ((float*)(F.ws + WS_WRT))[gt] = pWRp[(gt & 1023) * 32 + (gt >> 10)]; }
}

__device__ __forceinline__ void p0b_ada_reduce(const Frame& F) {
    const float* const pBADA = kin<I_BADA>(); const float* ap = (const float*)(F.ws + WS_ADAP); float* ada = (float*)(F.ws + WS_CTL + CTL_ADA);
    for (int idx = F.vcu * NWAVES * 64 + F.tid; idx < 2 * 8 * 6144; idx += F.G * NWAVES * 64) { const int l = idx / 49152, r = idx % 49152, c = r % 6144;
        float s = pBADA[l * 6144 + c];
#pragma unroll
        for (int kc = 0; kc < 16; ++kc) s += ap[(size_t)(kc * 2 + l) * 49152 + r];
        ada[idx] = s; }
}

template <int MODE> __device__ __forceinline__ void p1_norm(const Frame& F, int l) {
    const int lane = F.lane;
    const float* const pX = kin<I_X>(); float* const pOUT = (float*)kin<28>(); const float* const pFG = kin<I_FG>(); const float* const pN1G = kin<I_N1G>(); const float* const pWRb = kin<I_WR>();
#pragma unroll 1
    for (int gw = F.vcu * NWAVES + F.wave; gw < T / 8; gw += F.G * NWAVES) { const int tok0 = gw * 8, b = tok0 >> 11;
        f32x4 gm[4], sh[4], g2v[4];
#pragma unroll
        for (int j = 0; j < 4; ++j) { const int c = 4 * lane + 256 * j;
            if (MODE == 2) { gm[j] = *(const f32x4*)(pFG + c); sh[j] = (f32x4){0.f, 0.f, 0.f, 0.f}; }
            else { const float* ad = ada_ptr(F, l, b); const f32x4 g = *(const f32x4*)(pN1G + l * 1024 + c), sc = *(const f32x4*)(ad + 1024 + c); gm[j] = g * (1.0f + sc); sh[j] = *(const f32x4*)(ad + c); }
            if (MODE >= 1) g2v[j] = *(const f32x4*)(ada_ptr(F, MODE == 2 ? 1 : l - 1, b) + 5120 + c); }
        float* X = (float*)(F.ws + WS_X);
        const bf16* YE = (const bf16*)(F.ws + WS_YE);
        const float* WTS = (const float*)(F.ws + WS_WTS); const int* SLOT = (const int*)(F.ws + WS_SLOT);
        for (int tk = 0; tk < 8; ++tk) { const int tok = tok0 + tk;
            f32x4 v[4]; const float* xs = (MODE == 0 ? pX : X) + (size_t)tok * 1024;
#pragma unroll
            for (int j = 0; j < 4; ++j) v[j] = *(const f32x4*)(xs + 4 * lane + 256 * j);
            if (MODE >= 1) { const float w0 = WTS[tok * 2], w1 = WTS[tok * 2 + 1]; const int s0 = SLOT[tok * 2], s1 = SLOT[tok * 2 + 1];
#pragma unroll
                for (int j = 0; j < 4; ++j) { const u32x2 y0 = *(const u32x2*)(YE + (size_t)s0 * 1024 + 4 * lane + 256 * j), y1 = *(const u32x2*)(YE + (size_t)s1 * 1024 + 4 * lane + 256 * j);
                    f32x4 m; m[0] = w0 * bflo(y0.x) + w1 * bflo(y1.x); m[1] = w0 * bfhi(y0.x) + w1 * bfhi(y1.x); m[2] = w0 * bflo(y0.y) + w1 * bflo(y1.y); m[3] = w0 * bfhi(y0.y) + w1 * bfhi(y1.y);
                    v[j] += g2v[j] * m; if (MODE == 1) *(f32x4*)(X + (size_t)tok * 1024 + 4 * lane + 256 * j) = v[j]; } }
            float ss = 0.f;
#pragma unroll
            for (int j = 0; j < 4; ++j) ss += (v[j][0] * v[j][0] + v[j][1] * v[j][1]) + (v[j][2] * v[j][2] + v[j][3] * v[j][3]);
            const float rstd = __builtin_amdgcn_rsqf(wave_sum(ss) * (1.0f / 1024.0f) + NORM_EPS);
#pragma unroll
            for (int j = 0; j < 4; ++j) { const f32x4 h = v[j] * rstd * gm[j] + sh[j];
                if (MODE == 2) *(f32x4*)(pOUT + (size_t)tok * 1024 + 4 * lane + 256 * j) = h;
                else { u32x2 w; w.x = pk2(h[0], h[1]); w.y = pk2(h[2], h[3]); *(u32x2*)((bf16*)(F.ws + WS_H) + (size_t)tok * 1024 + 4 * lane + 256 * j) = w; } }
        }
    }
    if (MODE == 0 && F.vcu < 16) {
        const int lb = F.vcu, e = F.tid & 31, kq = F.tid >> 5; const float* sh2 = ada_ptr(F, lb >> 3, lb & 7) + 3072; float s = 0.f;
        for (int k = kq * 64; k < kq * 64 + 64; ++k) s += sh2[k] * pWRb[k * 32 + e];
        LAS float* red = (LAS float*)F.lds; red[kq * 32 + e] = s; __syncthreads();
        if (F.tid < 32) { float t = 0.f; for (int q = 0; q < 16; ++q) t += red[q * 32 + e]; ((float*)(F.ws + WS_CTL + CTL_BIASR))[lb * 32 + e] = t; }
        __syncthreads();
    }
}

__device__ __forceinline__ void p2b_lra(const Frame& F, int l) {
    const int lane = F.lane, c8 = lane & 31, hf = lane >> 5;
    const bf16* P = (const bf16*)(F.ws + WS_P); bf16* ALR = (bf16*)(F.ws + WS_ALR); const float* mu = kin<I_MU>() + l * N_SHIFT + 3072 + 8 * c8;
    const f32x4 m0 = *(const f32x4*)mu, m1 = *(const f32x4*)(mu + 4);
#pragma unroll 1
    for (int gw = F.vcu * NWAVES + F.wave; gw < T / 16; gw += F.G * NWAVES) {
#pragma unroll 2
        for (int i = 0; i < 8; ++i) { const int tok = gw * 16 + 2 * i + hf; float cur[8], prv[8], o[8];
            load8(P + (size_t)tok * P_LD + C_WD + 8 * c8, cur);
            if ((tok & (SEQ - 1)) != 0) load8(P + (size_t)(tok - 1) * P_LD + C_WD + 8 * c8, prv); else {
#pragma unroll
                for (int j = 0; j < 8; ++j) prv[j] = 0.f; }
#pragma unroll
            for (int j = 0; j < 8; ++j) { const float v = cur[j] + (prv[j] - cur[j]) * (j < 4 ? m0[j] : m1[j - 4]); o[j] = (c8 < 8) ? tanhf_(v) : ((c8 < 16) ? v : sigmoidf_(v)); }
            store8(ALR + (size_t)tok * 256 + 8 * c8, o); }
    }
}

__device__ __forceinline__ void p3_prep(const Frame& F, int l) {
    const int lane = F.lane;
    const bf16* P = (const bf16*)(F.ws + WS_P); const bf16* LR = (const bf16*)(F.ws + WS_LR);
    const float* mu = kin<I_MU>() + l * N_SHIFT;
    const float* const pA0 = kin<I_A0>() + l * 1024; const float* const pKKc = kin<I_KK>() + l * 1024; const float* const pKA = kin<I_KA>() + l * 1024; const float* const pRK = kin<I_RK>() + l * 1024; const float* const pW0 = kin<I_W0>() + l * 1024; const float* const pV0c = kin<I_V0>();
    bf16* KKo = (bf16*)(F.ws + WS_KK); bf16* BQo = (bf16*)(F.ws + WS_BQ); bf16* KPo = (bf16*)(F.ws + WS_KP); bf16* Ro = (bf16*)(F.ws + WS_R);
    bf16* V0 = (bf16*)(F.ws + WS_V0); bf16* V1 = (bf16*)(F.ws + WS_V1); float* Wo = (float*)(F.ws + WS_W); float* BON = (float*)(F.ws + WS_BONUS);
#pragma unroll 1
    for (int gw = F.vcu * NWAVES + F.wave; gw < T / 8; gw += F.G * NWAVES) { const int tok0 = gw * 8;
#pragma unroll 1
    for (int ch = 0; ch < 2; ++ch) { const int col0 = 512 * ch + 8 * lane, head = 8 * ch + (lane >> 3);
        float a0v[8], kkc[8], kac[8], rkc[8], w0v[8], v0v[8], mur[8], muk[8], muv[8], rp[8], kp_[8], vp[8];
#pragma unroll
        for (int j = 0; j < 8; ++j) { a0v[j] = pA0[col0 + j]; kkc[j] = pKKc[col0 + j]; kac[j] = pKA[col0 + j]; rkc[j] = pRK[col0 + j]; w0v[j] = pW0[col0 + j]; v0v[j] = (l == 1) ? pV0c[col0 + j] : 0.f;
            mur[j] = mu[col0 + j]; muk[j] = mu[1024 + col0 + j]; muv[j] = mu[2048 + col0 + j]; rp[j] = 0.f; kp_[j] = 0.f; vp[j] = 0.f; }
        if ((tok0 & (SEQ - 1)) != 0) { const bf16* pr = P + (size_t)(tok0 - 1) * P_LD + col0; load8(pr + C_R, rp); load8(pr + C_K, kp_); load8(pr + C_V, vp); }
#pragma unroll 2
        for (int tk = 0; tk < 8; ++tk) { const int tok = tok0 + tk; const bf16* pr = P + (size_t)tok * P_LD + col0;
            float rc[8], kc[8], vc[8], dw[8], ap[8], r[8], k[8], v[8], kk[8], kp[8], bq[8], w[8];
            load8(pr + C_R, rc); load8(pr + C_K, kc); load8(pr + C_V, vc); load8(LR + (size_t)tok * 3072 + col0, dw); load8(LR + (size_t)tok * 3072 + 1024 + col0, ap);
            float ss = 0.f, bo = 0.f;
#pragma unroll
            for (int j = 0; j < 8; ++j) { r[j] = rc[j] + (rp[j] - rc[j]) * mur[j]; k[j] = kc[j] + (kp_[j] - kc[j]) * muk[j]; v[j] = vc[j] + (vp[j] - vc[j]) * muv[j]; rp[j] = rc[j]; kp_[j] = kc[j]; vp[j] = vc[j];
                const float av = sigmoidf_(a0v[j] + ap[j]); kk[j] = k[j] * kkc[j]; ss += kk[j] * kk[j]; kp[j] = k[j] * (1.0f + (av - 1.0f) * kac[j]); bo += r[j] * kp[j] * rkc[j]; bq[j] = av;
                const float nd = -(w0v[j] + dw[j]); const float sp = fmaxf(nd, 0.f) + log1pf(__expf(-fabsf(nd))); w[j] = __expf(-__expf(-sp - 0.5f)); }
            ss = sum8(ss); bo = sum8(bo);
            const float inv = 1.0f / fmaxf(sqrtf(ss), 1e-12f);
#pragma unroll
            for (int j = 0; j < 8; ++j) { kk[j] *= inv; bq[j] *= kk[j]; }
            store8(KKo + (size_t)tok * 1024 + col0, kk); store8(BQo + (size_t)tok * 1024 + col0, bq); store8(KPo + (size_t)tok * 1024 + col0, kp); store8(Ro + (size_t)tok * 1024 + col0, r);
            if ((lane & 7) == 0) BON[tok * 16 + head] = bo;
            float* wp = Wo + (size_t)tok * 1024 + col0; *(f32x4*)wp = (f32x4){w[0], w[1], w[2], w[3]}; *(f32x4*)(wp + 4) = (f32x4){w[4], w[5], w[6], w[7]};
            if (l == 1) { float vf[8], vm[8]; load8(V0 + (size_t)tok * 1024 + col0, vf); load8(pr + C_VD, vm);
#pragma unroll
                for (int j = 0; j < 8; ++j) v[j] = v[j] + (vf[j] - v[j]) * sigmoidf_(v0v[j] + vm[j]);
                store8(V1 + (size_t)tok * 1024 + col0, v); }
            else store8(V0 + (size_t)tok * 1024 + col0, v); }
    }
    }
}

constexpr int SC_CH = 32, SC_COF = 0, SC_VB = 2 * SC_CH * 320 * 4, SC_YB = SC_VB + 2 * SC_CH * 32 * 4;
struct ScanRegs { f32x4 w0, w1; u32x4 a[4]; u32x2 v; };
__device__ __forceinline__ void scan_issue(const Frame& F, int l, int b, int h, int half, int cc, ScanRegs& R) {
    const int tl = F.tid - 256, s = tl >> 3, q8 = tl & 7, t = cc * SC_CH + s; const size_t row = (size_t)b * SEQ + t, base = row * 1024 + h * 64 + 8 * q8;
    const float* W = (const float*)(F.ws + WS_W);
    R.w0 = *(const f32x4*)(W + base); R.w1 = *(const f32x4*)(W + base + 4);
    R.a[0] = *(const u32x4*)((const bf16*)(F.ws + WS_KK) + base); R.a[1] = *(const u32x4*)((const bf16*)(F.ws + WS_BQ) + base);
    R.a[2] = *(const u32x4*)((const bf16*)(F.ws + WS_KP) + base); R.a[3] = *(const u32x4*)((const bf16*)(F.ws + WS_R) + base);
    R.v = *(const u32x2*)((const bf16*)(F.ws + (l == 0 ? WS_V0 : WS_V1)) + row * 1024 + h * 64 + half * 32 + 4 * q8);
}
__device__ __forceinline__ void scan_commit(const Frame& F, int buf, const ScanRegs& R) {
    const int tl = F.tid - 256, s = tl >> 3, q8 = tl & 7;
    LAS float* cof = (LAS float*)(F.lds + SC_COF) + (buf * SC_CH + s) * 320 + 8 * q8;
    *(LAS f32x4*)cof = R.w0; *(LAS f32x4*)(cof + 4) = R.w1;
#pragma unroll
    for (int ar = 0; ar < 4; ++ar) { const u32x4 u = R.a[ar];
        *(LAS f32x4*)(cof + 64 * (ar + 1)) = (f32x4){bflo(u.x), bfhi(u.x), bflo(u.y), bfhi(u.y)}; *(LAS f32x4*)(cof + 64 * (ar + 1) + 4) = (f32x4){bflo(u.z), bfhi(u.z), bflo(u.w), bfhi(u.w)}; }
    *(LAS f32x4*)((LAS float*)(F.lds + SC_VB) + (buf * SC_CH + s) * 32 + 4 * q8) = (f32x4){bflo(R.v.x), bfhi(R.v.x), bflo(R.v.y), bfhi(R.v.y)};
}
__device__ __forceinline__ void scan_store(const Frame& F, int b, int h, int half, int cc, int buf) {
    const int tl = F.tid - 256, s = tl >> 3, q8 = tl & 7, t = cc * SC_CH + s; const size_t row = (size_t)b * SEQ + t;
    const f32x4 y = *(const LAS f32x4*)((LAS float*)(F.lds + SC_YB) + (buf * SC_CH + s) * 32 + 4 * q8);
    u32x2 w; w.x = pk2(y[0], y[1]); w.y = pk2(y[2], y[3]);
    *(u32x2*)((bf16*)(F.ws + WS_Y) + row * 1024 + h * 64 + half * 32 + 4 * q8) = w;
}
__device__ __forceinline__ void p4_scan(const Frame& F, int l) {
    for (int unit = F.vcu; unit < NBATCH * NHEAD * 2; unit += F.G) {
        const int b = unit >> 5, h = (unit >> 1) & 15, half = unit & 1;
        const bool loader = F.wave >= 4;
        const int g = F.lane >> 4, q = F.lane & 15, r0 = F.wave * 8 + g * 2;
        f32x2 s0a = (f32x2){0.f, 0.f}, s0b = s0a, s1a = s0a, s1b = s0a;
        ScanRegs SR;
        if (loader) { scan_issue(F, l, b, h, half, 0, SR); scan_commit(F, 0, SR); scan_issue(F, l, b, h, half, 1, SR); }
        __syncthreads();
        constexpr int NCH = SEQ / SC_CH;
        for (int cc = 0; cc < NCH; ++cc) { const int buf = cc & 1;
            if (loader) { if (cc >= 1) scan_store(F, b, h, half, cc - 1, buf ^ 1); if (cc + 1 < NCH) scan_commit(F, buf ^ 1, SR); if (cc + 2 < NCH) scan_issue(F, l, b, h, half, cc + 2, SR); }
            else {
                const LAS float* cof = (const LAS float*)(F.lds + SC_COF) + buf * SC_CH * 320 + 4 * q;
                const LAS float* vb = (const LAS float*)(F.lds + SC_VB) + buf * SC_CH * 32 + r0;
                LAS float* yb = (LAS float*)(F.lds + SC_YB) + buf * SC_CH * 32 + r0;
                f32x4 aw[2], ak[2], ab[2], ap[2], ar[2], bw[2], bk[2], bb[2], bp[2], br_[2]; f32x2 av[2], bv[2];
#define SC_LOAD(dw, dk, db, dp, dr, dv, s) do { dw = *(const LAS f32x4*)(cof + (s) * 320); dk = *(const LAS f32x4*)(cof + (s) * 320 + 64); db = *(const LAS f32x4*)(cof + (s) * 320 + 128); \
        dp = *(const LAS f32x4*)(cof + (s) * 320 + 192); dr = *(const LAS f32x4*)(cof + (s) * 320 + 256); dv = *(const LAS f32x2*)(vb + (s) * 32); } while (0)
#define SC_STEP(cw, ck, cb, cp, cr, cv, yo) do {   \
        f32x2 t0 = s0a * ck.lo; t0 = s0b * ck.hi + t0; f32x2 t1 = s1a * ck.lo; t1 = s1b * ck.hi + t1; \
        const float sa0 = dpp_sum16(t0.x + t0.y), sa1 = dpp_sum16(t1.x + t1.y); \
        f32x2 u0a = cv.x * cp.lo, u0b = cv.x * cp.hi, u1a = cv.y * cp.lo, u1b = cv.y * cp.hi; \
        u0a = u0a - sa0 * cb.lo; u0b = u0b - sa0 * cb.hi; u1a = u1a - sa1 * cb.lo; u1b = u1b - sa1 * cb.hi; \
        s0a = s0a * cw.lo + u0a; s0b = s0b * cw.hi + u0b; s1a = s1a * cw.lo + u1a; s1b = s1b * cw.hi + u1b; \
        f32x2 y0 = s0a * cr.lo; y0 = s0b * cr.hi + y0; f32x2 y1 = s1a * cr.lo; y1 = s1b * cr.hi + y1; \
        yo = (f32x2){dpp_sum16(y0.x + y0.y), dpp_sum16(y1.x + y1.y)}; } while (0)
#pragma unroll
                for (int i = 0; i < 2; ++i) SC_LOAD(aw[i], ak[i], ab[i], ap[i], ar[i], av[i], i);
#pragma unroll 1
                for (int s8 = 0; s8 < SC_CH; s8 += 4) {
#pragma unroll
                    for (int i = 0; i < 2; ++i) SC_LOAD(bw[i], bk[i], bb[i], bp[i], br_[i], bv[i], s8 + 2 + i);
                    f32x2 yo[2];
#pragma unroll
                    for (int i = 0; i < 2; ++i) SC_STEP(aw[i], ak[i], ab[i], ap[i], ar[i], av[i], yo[i]);
                    if (q == 0) {
#pragma unroll
                        for (int i = 0; i < 2; ++i) *(LAS f32x2*)(yb + (s8 + i) * 32) = yo[i]; }
                    const int sn = (s8 + 4 < SC_CH) ? s8 + 4 : s8;
#pragma unroll
                    for (int i = 0; i < 2; ++i) SC_LOAD(aw[i], ak[i], ab[i], ap[i], ar[i], av[i], sn + i);
#pragma unroll
                    for (int i = 0; i < 2; ++i) SC_STEP(bw[i], bk[i], bb[i], bp[i], br_[i], bv[i], yo[i]);
                    if (q == 0) {
#pragma unroll
                        for (int i = 0; i < 2; ++i) *(LAS f32x2*)(yb + (s8 + 2 + i) * 32) = yo[i]; }
                }
#undef SC_STEP
#undef SC_LOAD
            }
            __syncthreads();
        }
        if (loader) scan_store(F, b, h, half, NCH - 1, (NCH - 1) & 1);
        __syncthreads();
    }
}

__device__ __forceinline__ void p5_post(const Frame& F, int l) {
    const int lane = F.lane;
    const float* const pCW = kin<I_CONVW>() + l * 3 * 1024; const float* const pLNW = kin<I_LNW>() + l * 1024; const float* const pLNB = kin<I_LNB>() + l * 1024;
    const bf16* P = (const bf16*)(F.ws + WS_P); const bf16* Y = (const bf16*)(F.ws + WS_Y); const bf16* LRg = (const bf16*)(F.ws + WS_LR) + 2048;
    const bf16* V = (const bf16*)(F.ws + (l == 0 ? WS_V0 : WS_V1)); const float* BON = (const float*)(F.ws + WS_BONUS); bf16* M = (bf16*)(F.ws + WS_H);
#pragma unroll 1
    for (int gw = F.vcu * NWAVES + F.wave; gw < T / 8; gw += F.G * NWAVES) { const int tok0 = gw * 8;
#pragma unroll 1
    for (int ch = 0; ch < 2; ++ch) { const int col0 = 512 * ch + 8 * lane, head = 8 * ch + (lane >> 3);
        float cw0[8], cw1[8], cw2[8], lnw[8], lnb[8], um1[8], um2[8];
#pragma unroll
        for (int j = 0; j < 8; ++j) { cw0[j] = pCW[col0 + j]; cw1[j] = pCW[1024 + col0 + j]; cw2[j] = pCW[2048 + col0 + j];
            lnw[j] = pLNW[col0 + j]; lnb[j] = pLNB[col0 + j]; um1[j] = 0.f; um2[j] = 0.f; }
        const int t0 = tok0 & (SEQ - 1);
        if (t0 >= 1) { float c1[8], c2[8]; load8(P + (size_t)(tok0 - 1) * P_LD + C_CC + col0, c1); load8(P + (size_t)(tok0 - 1) * P_LD + C_CH + col0, c2);
#pragma unroll
            for (int j = 0; j < 8; ++j) um1[j] = c1[j] * c2[j]; }
        if (t0 >= 2) { float c1[8], c2[8]; load8(P + (size_t)(tok0 - 2) * P_LD + C_CC + col0, c1); load8(P + (size_t)(tok0 - 2) * P_LD + C_CH + col0, c2);
#pragma unroll
            for (int j = 0; j < 8; ++j) um2[j] = c1[j] * c2[j]; }
#pragma unroll 2
        for (int tk = 0; tk < 8; ++tk) { const int tok = tok0 + tk; const bf16* pr = P + (size_t)tok * P_LD + col0;
            float c1[8], c2[8], cb[8], ga[8], gb[8], y[8], v[8], g[8], o[8];
            load8(pr + C_CC, c1); load8(pr + C_CH, c2); load8(pr + C_CB, cb); load8(pr + C_GA, ga); load8(pr + C_GB, gb);
            load8(Y + (size_t)tok * 1024 + col0, y); load8(V + (size_t)tok * 1024 + col0, v); load8(LRg + (size_t)tok * 3072 + col0, g);
            const float bo = BON[tok * 16 + head];
            float sm = 0.f;
#pragma unroll
            for (int j = 0; j < 8; ++j) sm += y[j];
            const float mean = sum8(sm) * (1.0f / 64.0f); float sq = 0.f;
#pragma unroll
            for (int j = 0; j < 8; ++j) { y[j] -= mean; sq += y[j] * y[j]; }
            const float rstd = __builtin_amdgcn_rsqf(sum8(sq) * (1.0f / 64.0f) + LNX_EPS);
#pragma unroll
            for (int j = 0; j < 8; ++j) { const float u = c1[j] * c2[j]; const float conv = cw0[j] * um2[j] + cw1[j] * um1[j] + cw2[j] * u; um2[j] = um1[j]; um1[j] = u;
                const float yconv = cb[j] * conv; const float yr = ((y[j] * rstd) * lnw[j] + lnb[j] + bo * v[j]) * g[j];
                o[j] = sigmoidf_(ga[j]) * yconv + sigmoidf_(gb[j]) * yr; }
            store8(M + (size_t)tok * 1024 + col0, o); }
    }
    }
}

struct GroupPick { float score, a1, a2; int i1, i2; };
__device__ __forceinline__ GroupPick pick_group(const f32x4 acc, float rstd, const float* br, const float* rb) {
    float aff[4], sel[4];
#pragma unroll
    for (int j = 0; j < 4; ++j) { aff[j] = sigmoidf_(rstd * acc[j] + br[j]); sel[j] = aff[j] + rb[j]; }
    int i1 = 0;
#pragma unroll
    for (int j = 1; j < 4; ++j) if (sel[j] > sel[i1]) i1 = j;
    int i2 = (i1 == 0) ? 1 : 0;
#pragma unroll
    for (int j = 0; j < 4; ++j) if (j != i1 && j != i2 && sel[j] > sel[i2]) i2 = j;
    GroupPick g; g.score = sel[i1] + sel[i2]; g.i1 = i1; g.i2 = i2; g.a1 = aff[i1]; g.a2 = aff[i2];
    float s1 = sel[0], s2 = sel[0]; (void)s1; (void)s2;
    return g;
}
__device__ __forceinline__ void p7_route(const Frame& F, int l, bool dry = false) {
    const int lane = F.lane, li = lane & 15, fq = lane >> 4;
    LAS unsigned* lcnt = (LAS unsigned*)(F.lds + 65536);
    const float* X = (const float*)(F.ws + WS_X); const float* WrT = (const float*)(F.ws + WS_WRT); const float* const pN2G = kin<I_N2G>() + l * 1024; const float* const pRB = kin<I_RB>();
#pragma unroll 1
    for (int gw = F.vcu * NWAVES + F.wave; gw < T / 16; gw += F.G * NWAVES) { const int tok0 = gw * 16, b = tok0 >> 11;
        if (F.tid < 32) lcnt[F.tid] = 0u;
        __syncthreads();
        const float* ad = ada_ptr(F, l, b);
        const float* xp = X + (size_t)(tok0 + li) * 1024 + 4 * fq; const float* g1p = pN2G + 4 * fq; const float* g2p = ad + 4096 + 4 * fq; const float* w0p = WrT + li * 1024 + 4 * fq; const float* w1p = w0p + 16 * 1024;
        f32x4 acc0 = (f32x4){0.f, 0.f, 0.f, 0.f}, acc1 = acc0; float ssq = 0.f;
#pragma unroll 4
        for (int kb = 0; kb < 1024; kb += 16) {
            const f32x4 xv = *(const f32x4*)(xp + kb), gv = *(const f32x4*)(g1p + kb) * (1.0f + *(const f32x4*)(g2p + kb)), w0 = *(const f32x4*)(w0p + kb), w1 = *(const f32x4*)(w1p + kb);
            ssq += (xv[0] * xv[0] + xv[1] * xv[1]) + (xv[2] * xv[2] + xv[3] * xv[3]);
            const f32x4 xg = xv * gv;
#pragma unroll
            for (int jj = 0; jj < 4; ++jj) { acc0 = __builtin_amdgcn_mfma_f32_16x16x4f32(w0[jj], xg[jj], acc0, 0, 0, 0); acc1 = __builtin_amdgcn_mfma_f32_16x16x4f32(w1[jj], xg[jj], acc1, 0, 0, 0); }
        }
        ssq += __shfl_xor(ssq, 16); ssq += __shfl_xor(ssq, 32);
        const float rstd = __builtin_amdgcn_rsqf(ssq * (1.0f / 1024.0f) + NORM_EPS);
        const float* br = (const float*)(F.ws + WS_CTL + CTL_BIASR) + (l * 8 + b) * 32;
        const GroupPick ga = pick_group(acc0, rstd, br + 4 * fq, pRB + 4 * fq), gb = pick_group(acc1, rstd, br + 16 + 4 * fq, pRB + 16 + 4 * fq);
        const bool useb = gb.score > ga.score;
        const GroupPick gm = useb ? gb : ga; const int mygrp = useb ? 4 + fq : fq;
        float bs = gm.score; int bg = mygrp;
#pragma unroll
        for (int off = 16; off < 64; off <<= 1) { const float os = __shfl_xor(bs, off); const int og = __shfl_xor(bg, off); if (os > bs || (os == bs && og < bg)) { bs = os; bg = og; } }
        if (mygrp == bg) { const int tok = tok0 + li; const int e0 = 4 * bg + gm.i1, e1 = 4 * bg + gm.i2; const float inv = 1.0f / (gm.a1 + gm.a2);
            const int p0 = (int)__hip_atomic_fetch_add(lcnt + e0, 1u, __ATOMIC_RELAXED, __HIP_MEMORY_SCOPE_WORKGROUP), p1 = (int)__hip_atomic_fetch_add(lcnt + e1, 1u, __ATOMIC_RELAXED, __HIP_MEMORY_SCOPE_WORKGROUP);
            int* EI = (int*)(F.ws + WS_EIDX); int* PO = (int*)(F.ws + WS_POS); float* WT = (float*)(F.ws + WS_WTS);
            if (!dry) { EI[tok * 2] = e0; EI[tok * 2 + 1] = e1; PO[tok * 2] = p0; PO[tok * 2 + 1] = p1; WT[tok * 2] = gm.a1 * inv; WT[tok * 2 + 1] = gm.a2 * inv; } }
        __syncthreads();
        if (F.tid < 32 && !dry) ((int*)(F.ws + WS_HIST))[(l * 128 + (gw >> 3)) * 32 + F.tid] = (int)lcnt[F.tid];
        __syncthreads();
    }
}

__device__ __forceinline__ void expert_table(const Frame& F, int l, int grp = -1) {
    LAS int* tab = (LAS int*)(F.lds + TAB_OFF); LAS int* red = (LAS int*)F.lds;
    const int* hist = (const int*)(F.ws + WS_HIST) + l * 128 * 32; const int e = F.tid & 31, part = F.tid >> 5;
    int tot = 0, pre = 0;
#pragma unroll 4
    for (int g = part * 8; g < part * 8 + 8; ++g) { const int v = hist[g * 32 + e]; tot += v; pre += (g < grp) ? v : 0; }
    red[part * 32 + e] = tot; red[512 + part * 32 + e] = pre;
    __syncthreads();
    if (F.tid < 64) { int c = 0, pr = 0;
#pragma unroll
        for (int p = 0; p < 16; ++p) { c += red[p * 32 + e]; pr += red[512 + p * 32 + e]; }
        const int padded = (c + 255) & ~255; int inc = padded;
#pragma unroll
        for (int o = 1; o < 32; o <<= 1) { const int v = __shfl_up(inc, o); if (e >= o) inc += v; }
        if (F.lane < 32) { tab[e] = inc - padded; tab[33 + e] = (inc - padded) >> 8; tab[66 + e] = inc - padded + pr; if (e == 31) { tab[32] = inc; tab[65] = inc >> 8; } } }
    __syncthreads();
}

__device__ __forceinline__ void p8_dispatch(const Frame& F, int l) {
    const LAS int* tab = (const LAS int*)(F.lds + TAB_OFF);
    const float* const pN2G = kin<I_N2G>() + l * 1024;
    const int lane = F.lane;
#pragma unroll 1
    for (int gw = F.vcu * NWAVES + F.wave; gw < T / 8; gw += F.G * NWAVES) { const int tok0 = gw * 8, b = tok0 >> 11;
        expert_table(F, l, gw >> 4);
        const float* ad = ada_ptr(F, l, b); f32x4 gm[4], sh[4];
#pragma unroll
        for (int j = 0; j < 4; ++j) { const int c = 4 * lane + 256 * j; gm[j] = *(const f32x4*)(pN2G + c) * (1.0f + *(const f32x4*)(ad + 4096 + c)); sh[j] = *(const f32x4*)(ad + 3072 + c); }
        const float* X = (const float*)(F.ws + WS_X); const int* EI = (const int*)(F.ws + WS_EIDX); const int* PO = (const int*)(F.ws + WS_POS); int* SL = (int*)(F.ws + WS_SLOT); bf16* BUF = (bf16*)(F.ws + WS_BUF);
        for (int tk = 0; tk < 8; ++tk) { const int tok = tok0 + tk; f32x4 v[4]; float ss = 0.f;
#pragma unroll
            for (int j = 0; j < 4; ++j) { v[j] = *(const f32x4*)(X + (size_t)tok * 1024 + 4 * lane + 256 * j); ss += (v[j][0] * v[j][0] + v[j][1] * v[j][1]) + (v[j][2] * v[j][2] + v[j][3] * v[j][3]); }
            const float rstd = __builtin_amdgcn_rsqf(wave_sum(ss) * (1.0f / 1024.0f) + NORM_EPS);
            const int s0 = tab[66 + EI[tok * 2]] + PO[tok * 2], s1 = tab[66 + EI[tok * 2 + 1]] + PO[tok * 2 + 1];
            if (lane == 0) { SL[tok * 2] = s0; SL[tok * 2 + 1] = s1; }
#pragma unroll
            for (int j = 0; j < 4; ++j) { const f32x4 h = v[j] * rstd * gm[j] + sh[j]; u32x2 w; w.x = pk2(h[0], h[1]); w.y = pk2(h[2], h[3]);
                *(u32x2*)(BUF + (size_t)s0 * 1024 + 4 * lane + 256 * j) = w; *(u32x2*)(BUF + (size_t)s1 * 1024 + 4 * lane + 256 * j) = w; } }
    }
}

#ifndef PHMASK
#define PHMASK 0xFFFF
#endif
#define PHM(n) (((PHMASK) >> (n)) & 1)
constexpr int NPHASES = 27;
__global__ void __launch_bounds__(NWAVES * 64, 2) trunk_fwd(Args args) {
    extern __shared__ __attribute__((aligned(16))) unsigned char lds_raw[];
    Frame F;
    F.lds = (LAS unsigned char*)lds_raw;
    F.tid = threadIdx.x; F.lane = F.tid & 63; F.wave = __builtin_amdgcn_readfirstlane(F.tid >> 6);
    F.G = gridDim.x; { const int bx = blockIdx.x; F.vcu = (F.G % 8 == 0) ? (bx % 8) * (F.G / 8) + bx / 8 : bx; }
    unsigned char* const wsbase = (unsigned char*)kin<29>(); F.ws = wsbase; const int vcu0 = F.vcu;
    volatile LAS unsigned* MISC = (volatile LAS unsigned*)(F.lds + MISC_OFF);
    if (F.tid < 32) MISC[F.tid] = 0u;
    __syncthreads();
    const unsigned long long lohi = (unsigned long long)kin<30>(); const int lo = (int)(unsigned)lohi, hi = (int)(unsigned)(lohi >> 32);
    XcdBarrier bar; bar.bar = (unsigned*)(F.ws + WS_CTL) + CW_BAR; bar.x = 0; bar.st = nullptr;
    if (hi - lo > 1) bar = xcd_barrier_post((unsigned*)(F.ws + WS_CTL) + CW_BAR, MISC + 8);
#pragma unroll 1
#if defined(REP_PH)
    for (int phx = lo; phx < hi + REP_N; ++phx) { const int ph = (phx <= REP_PH) ? phx : ((phx - REP_N > REP_PH) ? phx - REP_N : REP_PH);
#else
    for (int ph = lo; ph < hi; ++ph) {
#endif
        { int t_ = threadIdx.x; asm volatile("" : "+v"(t_)); F.tid = t_; F.lane = t_ & 63; F.wave = __builtin_amdgcn_readfirstlane(t_ >> 6);
          unsigned char* w_ = wsbase; asm volatile("" : "+s"(w_)); F.ws = w_; int v_ = vcu0; asm volatile("" : "+s"(v_)); F.vcu = v_; }
        const int l = (ph - 2) / 12, k = (ph >= 2 && ph <= 25) ? (ph - 2) % 12 : -1;
        if (PHM(0) && ph == 0) p0_prologue(F);
        else if (PHM(0) && ph == 1) p0b_ada_reduce(F);
        else if (PHM(1) && ph == 26) p1_norm<2>(F, 1);
        else if (PHM(1) && k == 0) { if (l == 0) p1_norm<0>(F, 0); else p1_norm<1>(F, 1); }
        else if (PHM(3) && k == 2) p2b_lra(F, l);
        else if (PHM(3) && k == 4) p3_prep(F, l);
        else if (PHM(4) && k == 5) p4_scan(F, l);
        else if (PHM(5) && k == 6) p5_post(F, l);
        #if defined(REP_PH)
        else if (PHM(7) && k == 8) p7_route(F, l, phx > REP_PH && ph == REP_PH);
#else
        else if (PHM(7) && k == 8) p7_route(F, l);
#endif
        else if (PHM(8) && k == 9) p8_dispatch(F, l);
        else if (PHM(2) && (k == 1 || k == 3 || k == 7 || k == 10 || k == 11)) {
            pg8::Gemm g; pg8::UniOrder S; pg8::EpiUni E;
            S.expert = (k >= 10); S.so.init(T, 1024, F.G, (int)blockIdx.x); S.eo = pg8::ExpertOrder{(const PG8_LAS int*)(F.lds + TAB_OFF + 33 * 4), 0, F.G, (int)blockIdx.x};
            E.e0 = pg8::EpiBf16Plain{(bf16*)(F.ws + WS_P), P_LD, -1}; E.e1 = pg8::EpiResid{nullptr, (float*)(F.ws + WS_X), ada_ptr(F, l, 0) + 2048, 6144}; E.e2 = pg8::EpiSwiGLU{(bf16*)(F.ws + WS_HB)};
            if (k == 1) {
                const int N = (l == 0) ? N_IN : P_LD; S.so.init(T, N, F.G, (int)blockIdx.x); E.mode = 0;
                g = pg8::Gemm{(const bf16*)(F.ws + WS_H), (const bf16*)(F.ws + WS_BT_IN) + (size_t)l * P_LD * 1024, T, N, 1024};
            } else if (k == 3) {
                S.so.init(T, 3072, F.G, (int)blockIdx.x); E.mode = 0; E.e0 = pg8::EpiBf16Plain{(bf16*)(F.ws + WS_LR), 3072, -1};
                g = pg8::Gemm{(const bf16*)(F.ws + WS_ALR), (const bf16*)(F.ws + WS_BT_LR) + (size_t)l * 3072 * 256, T, 3072, 256};
            } else if (k == 7) {
                E.mode = 1; E.e1.xin = (l == 0) ? kin<I_X>() : (const float*)(F.ws + WS_X);
                g = pg8::Gemm{(const bf16*)(F.ws + WS_H), (const bf16*)(F.ws + WS_BT_OUT) + (size_t)l * 1024 * 1024, T, 1024, 1024};
            } else {
                expert_table(F, l);
                S.eo.ntiles = ((const LAS int*)(F.lds + TAB_OFF))[65];
                if (k == 10) { E.mode = 2; g = pg8::Gemm{(const bf16*)(F.ws + WS_BUF), (const bf16*)(F.ws + WS_BT_E1) + (size_t)l * 32 * 1024 * 1024, MAXROWS, 32 * 1024, 1024}; }
                else { E.mode = 0; E.e0 = pg8::EpiBf16Plain{(bf16*)(F.ws + WS_YE), 1024, 3}; g = pg8::Gemm{(const bf16*)(F.ws + WS_HB), (const bf16*)(F.ws + WS_BT_E2) + (size_t)l * 32 * 1024 * 512, MAXROWS, 32 * 1024, 512}; }
            }
            pg8::gemm_phase<pg8::EpiUni, pg8::UniOrder, true, true>(F.lds, g, S, E);
        }
#if defined(REP_PH)
        if (phx + 1 < hi + REP_N) xcd_barrier(bar);
#else
        if (ph + 1 < hi) xcd_barrier(bar);
#endif
    }
}

extern "C" void kernel_launch(void* const* d_in, const int* in_sizes, int n_in, void* d_out, int out_size, void* d_ws, size_t ws_size, hipStream_t stream) {
    static int grid = 0;
    if (grid == 0) {
        if (n_in != 28 || in_sizes[0] != T * D || out_size != T * D || ws_size < WS_END) { fprintf(stderr, "kernel_launch: unexpected shapes (n_in %d, in0 %d, out %d, ws %zu < %zu?); nothing launched\n", n_in, n_in > 0 ? in_sizes[0] : -1, out_size, ws_size, (size_t)WS_END); grid = -1; return; }
        int dev = 0, cus = 0, per_cu = 0;
        if (hipGetDevice(&dev) != hipSuccess || hipDeviceGetAttribute(&cus, hipDeviceAttributeMultiprocessorCount, dev) != hipSuccess) { fprintf(stderr, "kernel_launch: device query failed\n"); grid = -1; return; }
        if (hipFuncSetAttribute((const void*)trunk_fwd, hipFuncAttributeMaxDynamicSharedMemorySize, LDS_BYTES) != hipSuccess) { fprintf(stderr, "kernel_launch: hipFuncSetAttribute failed\n"); grid = -1; return; }
        if (hipOccupancyMaxActiveBlocksPerMultiprocessor(&per_cu, (const void*)trunk_fwd, NWAVES * 64, LDS_BYTES) != hipSuccess || per_cu < 1) { fprintf(stderr, "kernel_launch: occupancy query says %d blocks per CU\n", per_cu); }
        (void)hipGetLastError();
        grid = cus;
    }
    if (grid < 0) return;
    if (hipMemsetAsync((char*)d_ws + WS_CTL, 0, CTL_ZERO_BYTES, stream) != hipSuccess) { fprintf(stderr, "kernel_launch: memset failed\n"); return; }
    Args a{};
    for (int i = 0; i < 28; ++i) a.p[i] = d_in[i];
    a.p[28] = d_out; a.p[29] = d_ws;
#if MK_ONE_LAUNCH
    a.ph_lo = 0; a.ph_hi = NPHASES;
    void* kargs[] = {&a};
    hipError_t e = hipLaunchCooperativeKernel((const void*)trunk_fwd, dim3(grid), dim3(NWAVES * 64), kargs, LDS_BYTES, stream);
    if (e != hipSuccess) fprintf(stderr, "kernel_launch: cooperative launch failed: %s (grid %d)\n", hipGetErrorString(e), grid);
#else
    for (int p = 0; p < NPHASES; ++p) { a.ph_lo = p; a.ph_hi = p + 1;
        hipLaunchKernelGGL(trunk_fwd, dim3(grid), dim3(NWAVES * 64), LDS_BYTES, stream, a);
        const hipError_t le = hipPeekAtLastError(); if (le != hipSuccess) { fprintf(stderr, "kernel_launch: launch %d failed: %s\n", p, hipGetErrorName(le)); break; } }
#endif
}
```

```cpp
#include <hip/hip_runtime.h>
#include <cstdio>
#include <cstdint>

#ifndef MK_ONE_LAUNCH
#define MK_ONE_LAUNCH 1
#endif

namespace pg8 {
#define PG8_LAS __attribute__((address_space(3)))
typedef unsigned short bf16_t;
typedef short bf16x8 __attribute__((ext_vector_type(8)));
typedef float f32x4 __attribute__((ext_vector_type(4)));
typedef unsigned u32x4 __attribute__((ext_vector_type(4)));
constexpr int BM = 256, BK = 64, HALF = 128, HTB = HALF * BK * 2  , STAGE_BYTES = 8 * HTB, NXCD = 8, WGM = 8;

__host__ __device__ __forceinline__ int lds_byte(int r, int c) { const int st = (r >> 4) * 2 + (c >> 5), rr = r & 15, cc = c & 31, ob = rr * 64 + cc * 2; return st * 1024 + (ob ^ (((ob >> 9) & 1) << 5)); }
__host__ __device__ __forceinline__ void stage_rc(int b, int& R, int& C) { const int st = b / 1024, sb = b % 1024, swz = sb ^ (((sb >> 9) & 1) << 5); R = (st >> 1) * 16 + swz / 64; C = (st & 1) * 32 + (swz % 64) / 2; }
__host__ __device__ __forceinline__ int perm32(int rho) { const int n = rho >> 4, i = rho & 15; return 8 * (i >> 2) + 4 * n + (i & 3); }

struct Unit { int pm, pn; };
struct Gemm { const bf16_t* A; const bf16_t* Bt; int M, N, K; };

struct StaticOrder {
    int nM, nN, nwg, G, c;
    __host__ __device__ void init(int M, int N, int G_, int c_) { nM = M / BM; nN = N / BM; nwg = nM * nN; G = G_; c = c_; }
    __host__ __device__ bool next(int i, Unit& u) const {
        const long L = (long)i * G + c; if (L >= nwg) return false;
        int wgid = (int)L; { const int q = nwg / NXCD, r = nwg % NXCD, xcd = wgid % NXCD, off = wgid / NXCD; wgid = (xcd < r ? xcd * (q + 1) : r * (q + 1) + (xcd - r) * q) + off; }
        const int nig = WGM * nN, gid = wgid / nig, fm = gid * WGM, gsz = (nM - fm) < WGM ? (nM - fm) : WGM;
        u.pm = fm + ((wgid % nig) % gsz); u.pn = (wgid % nig) / gsz; return true;
    }
    __device__ __forceinline__ void a_ready(const Unit&) const {}
    __device__ __forceinline__ void done(const Unit&) const {}
};
__device__ __forceinline__ unsigned cvt_pk_bf16(float lo, float hi) { unsigned r; asm volatile("v_cvt_pk_bf16_f32 %0, %1, %2" : "=v"(r) : "v"(lo), "v"(hi)); return r; }
typedef float f32x2 __attribute__((ext_vector_type(2)));
typedef unsigned u32x2 __attribute__((ext_vector_type(2)));

struct EpiBf16Plain {
    static constexpr bool PERM = true, AFTER_DRAIN = false;
    bf16_t* O; int ldc; int cmask;
    __device__ __forceinline__ void operator()(const f32x4 (&acc)[2][2][4][2], const Unit& u, int wr, int wc, int fr, int fq) const {
        const int row0 = u.pm * BM + wr * 64 + fr; const int col0 = (u.pn & cmask) * BM + wc * 32 + 8 * fq;
#pragma unroll
        for (int ai = 0; ai < 2; ++ai)
#pragma unroll
            for (int m = 0; m < 4; ++m) { bf16_t* rowp = O + (size_t)(row0 + ai * HALF + m * 16) * ldc + col0;
#pragma unroll
                for (int bj = 0; bj < 2; ++bj) { const f32x4 v0 = acc[ai][bj][m][0], v1 = acc[ai][bj][m][1];
                    u32x4 w; w.x = cvt_pk_bf16(v0[0], v0[1]); w.y = cvt_pk_bf16(v0[2], v0[3]); w.z = cvt_pk_bf16(v1[0], v1[1]); w.w = cvt_pk_bf16(v1[2], v1[3]);
                    *(u32x4*)(rowp + bj * HALF) = w; } }
    }
};
struct EpiResid {
    static constexpr bool PERM = false, AFTER_DRAIN = false;
    const float* xin; float* xout; const float* gate;
    int gstride;
    __device__ __forceinline__ void operator()(const f32x4 (&acc)[2][2][4][2], const Unit& u, int wr, int wc, int fr, int fq) const {
        const int row0 = u.pm * BM + wr * 64 + fr, col0 = u.pn * BM + wc * 32 + 4 * fq;
        const float* gp = gate + (size_t)(u.pm >> 3) * gstride;
        f32x4 gv[2][2];
#pragma unroll
        for (int bj = 0; bj < 2; ++bj)
#pragma unroll
            for (int n = 0; n < 2; ++n) gv[bj][n] = *(const f32x4*)(gp + col0 + bj * HALF + n * 16);
#pragma unroll
        for (int ai = 0; ai < 2; ++ai)
#pragma unroll
            for (int m = 0; m < 4; ++m) { const size_t ro = (size_t)(row0 + ai * HALF + m * 16) * 1024 + col0;
#pragma unroll
                for (int bj = 0; bj < 2; ++bj)
#pragma unroll
                    for (int n = 0; n < 2; ++n) { const f32x4 xi = *(const f32x4*)(xin + ro + bj * HALF + n * 16);
                        *(f32x4*)(xout + ro + bj * HALF + n * 16) = xi + gv[bj][n] * acc[ai][bj][m][n]; }
                asm volatile("" ::: "memory"); }
    }
};
struct EpiSwiGLU {
    static constexpr bool PERM = false, AFTER_DRAIN = false;
    bf16_t* O;
    __device__ __forceinline__ void operator()(const f32x4 (&acc)[2][2][4][2], const Unit& u, int wr, int wc, int fr, int fq) const {
        const int row0 = u.pm * BM + wr * 64 + fr, col0 = (u.pn & 3) * HALF + wc * 32 + 4 * fq;
#pragma unroll
        for (int ai = 0; ai < 2; ++ai)
#pragma unroll
            for (int m = 0; m < 4; ++m) { bf16_t* rowp = O + (size_t)(row0 + ai * HALF + m * 16) * 512 + col0;
#pragma unroll
                for (int n = 0; n < 2; ++n) { const f32x4 g = acc[ai][0][m][n], up = acc[ai][1][m][n]; f32x4 h;
#pragma unroll
                    for (int j = 0; j < 4; ++j) h[j] = g[j] * __builtin_amdgcn_rcpf(1.0f + __expf(-g[j])) * up[j];
                    u32x2 w; w.x = cvt_pk_bf16(h[0], h[1]); w.y = cvt_pk_bf16(h[2], h[3]);
                    *(u32x2*)(rowp + n * 16) = w; } }
    }
};
struct ExpertOrder {
    const PG8_LAS int* ts; int ntiles, G, c;
    __device__ __forceinline__ bool next(int i, Unit& u) const {
        const int L = i * G + c; if (L >= ntiles * 4) return false;
        const int pm = L >> 2; int e = 0;
#pragma unroll 1
        for (int k = 1; k < 32; ++k) e += (ts[k] <= pm) ? 1 : 0;
        u.pm = pm; u.pn = e * 4 + (L & 3); return true;
    }
    __device__ __forceinline__ void a_ready(const Unit&) const {}
    __device__ __forceinline__ void done(const Unit&) const {}
};

struct UniOrder {
    StaticOrder so; ExpertOrder eo; bool expert;
    __device__ __forceinline__ bool next(int i, Unit& u) const { return expert ? eo.next(i, u) : so.next(i, u); }
    __device__ __forceinline__ void a_ready(const Unit&) const {}
    __device__ __forceinline__ void done(const Unit&) const {}
};
struct EpiUni {
    static constexpr bool AFTER_DRAIN = false;
    int mode; EpiBf16Plain e0; EpiResid e1; EpiSwiGLU e2;
    __device__ __forceinline__ bool perm() const { return mode == 0; }
    __device__ __forceinline__ void operator()(const f32x4 (&acc)[2][2][4][2], const Unit& u, int wr, int wc, int fr, int fq) const {
        if (mode == 0) e0(acc, u, wr, wc, fr, fq); else if (mode == 1) e1(acc, u, wr, wc, fr, fq); else e2(acc, u, wr, wc, fr, fq);
    }
};
template <class Epi, class Sched, bool ALIGN_EPI = false, bool SP2 = false>
__device__ __forceinline__ void gemm_phase(PG8_LAS unsigned char* lds, const Gemm g, const Sched& S, const Epi& E) {
    int tid_ = threadIdx.x; asm volatile("" : "+v"(tid_));
    const int tid = tid_, wid = __builtin_amdgcn_readfirstlane(tid >> 6), lane = tid & 63, wr = wid >> 2, wc = wid & 3, fr = lane & 15, fq = lane >> 4;
    const int K = g.K, nt = K / BK;
    unsigned voffA[2], voffB[2];
#pragma unroll
    for (int i = 0; i < 2; ++i) { int R, C; stage_rc(tid * 16 + i * 8192, R, C); const int Rb = E.perm() ? ((R & ~31) + perm32(R & 31)) : R;
        voffA[i] = (unsigned)(R * K + C) * 2u; voffB[i] = (unsigned)(Rb * K + C) * 2u; }
    const size_t kstep = (size_t)(BK * 2);
    const size_t hstep = (size_t)HALF * K * 2;
    const size_t tstep = 2 * hstep;
    const unsigned ldsw = (unsigned)wid * 1024u;
    const int aoff = lds_byte(wr * 64 + fr, fq * 8), boff = lds_byte(wc * 32 + fr, fq * 8);
#define PG8_SA(b, h) (((b) * 2 + (h)) * HTB)
#define PG8_SB(b, h) ((4 + (b) * 2 + (h)) * HTB)
#define PG8_STAGE(bufoff, gbase, voff) do { _Pragma("unroll") for (int _i = 0; _i < 2; ++_i) \
        __builtin_amdgcn_global_load_lds((const unsigned*)((const char*)(gbase) + (voff)[_i]), (PG8_LAS unsigned*)(lds + (bufoff) + ldsw + _i * 8192), 16, 0, 0); } while (0)
#define PG8_LDA(dst, b, h) do { _Pragma("unroll") for (int m = 0; m < 4; ++m) _Pragma("unroll") for (int k = 0; k < 2; ++k) dst[m][k] = *(const PG8_LAS bf16x8*)(lds + PG8_SA(b, h) + aoff + m * 2048 + k * 1024); } while (0)
#define PG8_LDB(dst, b, h) do { _Pragma("unroll") for (int n = 0; n < 2; ++n) _Pragma("unroll") for (int k = 0; k < 2; ++k) dst[n][k] = *(const PG8_LAS bf16x8*)(lds + PG8_SB(b, h) + boff + n * 2048 + k * 1024); } while (0)
#define PG8_MMA(ai, bj, At, Bt) do { __builtin_amdgcn_s_setprio(1); _Pragma("unroll") for (int m = 0; m < 4; ++m) _Pragma("unroll") for (int n = 0; n < 2; ++n) _Pragma("unroll") for (int k = 0; k < 2; ++k) \
        acc[ai][bj][m][n] = __builtin_amdgcn_mfma_f32_16x16x32_bf16(Bt[n][k], At[m][k], acc[ai][bj][m][n], 0, 0, 0); __builtin_amdgcn_s_setprio(0); } while (0)
#define PG8_WAIT_V(n) asm volatile("s_waitcnt vmcnt(" #n ")" ::: "memory")
#define PG8_WAIT_L(n) asm volatile("s_waitcnt lgkmcnt(" #n ")" ::: "memory")
#define PG8_BAR __builtin_amdgcn_s_barrier()
#define PG8_SCHED __builtin_amdgcn_sched_barrier(0)
    Unit cur, nxt; int ui = 0;
    if (!S.next(0, cur)) return;
    f32x4 acc[2][2][4][2];
#pragma unroll
    for (int a = 0; a < 2; ++a)
#pragma unroll
        for (int b = 0; b < 2; ++b)
#pragma unroll
            for (int m = 0; m < 4; ++m)
#pragma unroll
                for (int n = 0; n < 2; ++n) acc[a][b][m][n] = (f32x4){0.f, 0.f, 0.f, 0.f};
    bf16x8 At[4][2], B0[2][2], B1[2][2];
    const char* cA = (const char*)g.A + (size_t)cur.pm * tstep; const char* cB = (const char*)g.Bt + (size_t)cur.pn * tstep;
    S.a_ready(cur);
    if constexpr (SP2) {
        PG8_STAGE(PG8_SB(0, 0), cB, voffB); PG8_STAGE(PG8_SB(0, 1), cB + hstep, voffB); PG8_STAGE(PG8_SA(0, 0), cA, voffA); PG8_STAGE(PG8_SA(0, 1), cA + hstep, voffA);
        if (wr == 1) PG8_BAR;
        PG8_WAIT_V(2); PG8_BAR;
        PG8_STAGE(PG8_SB(1, 0), cB + kstep, voffB); PG8_STAGE(PG8_SA(1, 0), cA + kstep, voffA); PG8_STAGE(PG8_SB(1, 1), cB + hstep + kstep, voffB);
        PG8_WAIT_V(6); PG8_BAR;
    } else {
        PG8_STAGE(PG8_SB(0, 0), cB, voffB); PG8_STAGE(PG8_SA(0, 0), cA, voffA); PG8_STAGE(PG8_SB(0, 1), cB + hstep, voffB); PG8_STAGE(PG8_SA(0, 1), cA + hstep, voffA);
        if (wr == 1) PG8_BAR;
        PG8_WAIT_V(4); PG8_BAR;
        PG8_STAGE(PG8_SB(1, 0), cB + kstep, voffB); PG8_STAGE(PG8_SA(1, 0), cA + kstep, voffA); PG8_STAGE(PG8_SB(1, 1), cB + hstep + kstep, voffB);
        PG8_WAIT_V(6); PG8_BAR;
    }
    for (;;) {
        const bool has_next = S.next(ui + 1, nxt);
        const char* nA = has_next ? (const char*)g.A + (size_t)nxt.pm * tstep : cA; const char* nB = has_next ? (const char*)g.Bt + (size_t)nxt.pn * tstep : cB;
        for (int t = 0; t < nt; t += 2) {
            const bool last = (t == nt - 2);
            const char* a1 = cA + (size_t)(t + 1) * kstep;
            const char* a2 = last ? nA : cA + (size_t)(t + 2) * kstep; const char* b2 = last ? nB : cB + (size_t)(t + 2) * kstep;
            const char* a3 = a2 + kstep; const char* b3 = b2 + kstep;
            if (last && has_next) S.a_ready(nxt);
            if constexpr (SP2) {
            PG8_LDB(B0, 0, 0); PG8_LDB(B1, 0, 1); PG8_SCHED; PG8_LDA(At, 0, 0); PG8_STAGE(PG8_SA(1, 1), a1 + hstep, voffA);
            PG8_WAIT_V(8); PG8_WAIT_L(0); PG8_BAR; PG8_MMA(0, 0, At, B0); PG8_MMA(0, 1, At, B1); PG8_BAR; PG8_SCHED;
            PG8_LDA(At, 0, 1); PG8_STAGE(PG8_SB(0, 0), b2, voffB); PG8_STAGE(PG8_SB(0, 1), b2 + hstep, voffB); PG8_STAGE(PG8_SA(0, 0), a2, voffA);
            PG8_WAIT_V(8); PG8_WAIT_L(0); PG8_BAR; PG8_MMA(1, 0, At, B0); PG8_MMA(1, 1, At, B1); PG8_BAR; PG8_SCHED;
            PG8_LDB(B0, 1, 0); PG8_LDB(B1, 1, 1); PG8_SCHED; PG8_LDA(At, 1, 0); PG8_STAGE(PG8_SA(0, 1), a2 + hstep, voffA);
            PG8_WAIT_V(8); PG8_WAIT_L(0); PG8_BAR; PG8_MMA(0, 0, At, B0); PG8_MMA(0, 1, At, B1); PG8_BAR; PG8_SCHED;
            PG8_LDA(At, 1, 1); PG8_STAGE(PG8_SB(1, 0), b3, voffB); PG8_STAGE(PG8_SB(1, 1), b3 + hstep, voffB); PG8_STAGE(PG8_SA(1, 0), a3, voffA);
            PG8_WAIT_V(8); PG8_WAIT_L(0); PG8_BAR; PG8_MMA(1, 0, At, B0); PG8_MMA(1, 1, At, B1); PG8_BAR; PG8_SCHED;
            } else {
            PG8_LDB(B0, 0, 0); PG8_SCHED; PG8_LDA(At, 0, 0); PG8_STAGE(PG8_SA(1, 1), a1 + hstep, voffA);
            PG8_WAIT_L(8); PG8_BAR; PG8_WAIT_L(0); PG8_MMA(0, 0, At, B0); PG8_BAR; PG8_SCHED;
            PG8_LDB(B1, 0, 1); PG8_STAGE(PG8_SB(0, 0), b2, voffB);
            PG8_BAR; PG8_WAIT_L(0); PG8_MMA(0, 1, At, B1); PG8_BAR;
            PG8_LDA(At, 0, 1); PG8_STAGE(PG8_SA(0, 0), a2, voffA);
            PG8_BAR; PG8_WAIT_L(0); PG8_MMA(1, 0, At, B0); PG8_BAR; PG8_SCHED;
            PG8_STAGE(PG8_SB(0, 1), b2 + hstep, voffB);
            PG8_WAIT_V(6); PG8_BAR; PG8_MMA(1, 1, At, B1); PG8_BAR;
            PG8_LDB(B0, 1, 0); PG8_SCHED; PG8_LDA(At, 1, 0); PG8_STAGE(PG8_SA(0, 1), a2 + hstep, voffA);
            PG8_WAIT_L(8); PG8_BAR; PG8_WAIT_L(0); PG8_MMA(0, 0, At, B0); PG8_BAR; PG8_SCHED;
            PG8_LDB(B1, 1, 1); PG8_STAGE(PG8_SB(1, 0), b3, voffB);
            PG8_BAR; PG8_WAIT_L(0); PG8_MMA(0, 1, At, B1); PG8_BAR;
            PG8_LDA(At, 1, 1); PG8_STAGE(PG8_SA(1, 0), a3, voffA);
            PG8_BAR; PG8_WAIT_L(0); PG8_MMA(1, 0, At, B0); PG8_BAR; PG8_SCHED;
            PG8_STAGE(PG8_SB(1, 1), b3 + hstep, voffB);
            PG8_WAIT_V(6); PG8_BAR; PG8_MMA(1, 1, At, B1); PG8_BAR;
            }
        }
        if constexpr (ALIGN_EPI) { if (wr == 0) PG8_BAR; }
        if constexpr (!Epi::AFTER_DRAIN) { E(acc, cur, wr, wc, fr, fq); S.done(cur); }
        if (!has_next) break;
#pragma unroll
        for (int a = 0; a < 2; ++a)
#pragma unroll
            for (int b = 0; b < 2; ++b)
#pragma unroll
                for (int m = 0; m < 4; ++m)
#pragma unroll
                    for (int n = 0; n < 2; ++n) acc[a][b][m][n] = (f32x4){0.f, 0.f, 0.f, 0.f};
        cur = nxt; cA = nA; cB = nB; ++ui;
        if constexpr (ALIGN_EPI) { if (wr == 1) PG8_BAR; }
    }
    PG8_WAIT_V(0);
    if constexpr (!ALIGN_EPI) { if (wr == 0) PG8_BAR; }
    PG8_BAR;
    if constexpr (Epi::AFTER_DRAIN) { E.fused(acc, cur, wr, wc, fr, fq, lds, wid, lane); S.done(cur); }
#undef PG8_SA
#undef PG8_SB
#undef PG8_STAGE
#undef PG8_LDA
#undef PG8_LDB
#undef PG8_MMA
#undef PG8_WAIT_V
#undef PG8_WAIT_L
#undef PG8_BAR
#undef PG8_SCHED
}
}

constexpr int NWAVES = 8;
constexpr int T = 16384, D = 1024, SEQ = 2048, NBATCH = 8, NHEAD = 16;
constexpr int N_IN = 8448, P_LD = 9472;
constexpr int C_CB = 0, C_CC = 1024, C_CH = 2048, C_GA = 3072, C_GB = 4096, C_R = 5120, C_K = 6144, C_V = 7168, C_WD = 8192, C_AD = 8256, C_GD = 8320, C_VD = 8448;
constexpr int N_SHIFT = 3328, N_EXP = 32, D_EXP = 512;
constexpr int MAXROWS = 40960;
constexpr float NORM_EPS = 1e-6f, LNX_EPS = 64e-5f;

constexpr size_t MiB = 1u << 20;
constexpr size_t WS_CTL = 0, CTL_ZERO_BYTES = 1 * MiB;
constexpr size_t WS_BT_IN = 2 * MiB;
constexpr size_t WS_BT_OUT = 39 * MiB;
constexpr size_t WS_BT_E1 = 43 * MiB;
constexpr size_t WS_BT_E2 = 171 * MiB;
constexpr size_t WS_H = 235 * MiB;
constexpr size_t WS_ALR = WS_H;
constexpr size_t WS_P = 267 * MiB;
constexpr size_t WS_BUF = WS_P, WS_HB = WS_P + 80 * MiB, WS_YE = WS_P + 120 * MiB;
constexpr size_t WS_ADAP = WS_P;
constexpr size_t WS_W = 563 * MiB;
constexpr size_t WS_KK = 627 * MiB, WS_BQ = 659 * MiB, WS_KP = 691 * MiB, WS_R = 723 * MiB, WS_V0 = 755 * MiB, WS_V1 = 787 * MiB;
constexpr size_t WS_LR = 819 * MiB;
constexpr size_t WS_Y = 915 * MiB;
constexpr size_t WS_X = 947 * MiB;
constexpr size_t WS_BONUS = 1011 * MiB;
constexpr size_t WS_EIDX = 1012 * MiB, WS_POS = WS_EIDX + 128 * 1024, WS_WTS = WS_EIDX + 256 * 1024, WS_SLOT = WS_EIDX + 384 * 1024;
constexpr size_t WS_HIST = WS_EIDX + 512 * 1024;
constexpr size_t WS_WRT = WS_EIDX + 768 * 1024;
constexpr size_t WS_KN = WS_KK;
constexpr size_t WS_BONP = WS_KK + 2 * MiB;
constexpr size_t WS_BT_LR = 1015 * MiB;
constexpr size_t WS_END = 1018 * MiB;
static_assert(WS_YE + (size_t)MAXROWS * 1024 * 2 <= WS_W && WS_P + (size_t)T * P_LD * 2 <= WS_W && WS_BT_IN + (size_t)2 * P_LD * 2048 <= WS_BT_OUT, "ws map");
constexpr int CW_CNT = 1024;
constexpr int CW_BAR = 4096;
constexpr size_t CTL_ADA = 256 * 1024;
constexpr size_t CTL_BIASR = 700 * 1024;

constexpr int RING_BYTES = 131072;
constexpr int TAB_OFF = RING_BYTES;
constexpr int MISC_OFF = RING_BYTES + 1024;
constexpr int LDS_BYTES = 147456;

#define GAS __attribute__((address_space(1)))
#define LAS __attribute__((address_space(3)))
typedef unsigned short bf16;
typedef float f32x4 __attribute__((ext_vector_type(4)));
typedef float f32x2 __attribute__((ext_vector_type(2)));
typedef unsigned u32x4 __attribute__((ext_vector_type(4)));
typedef unsigned u32x2 __attribute__((ext_vector_type(2)));
#define LDS_WAIT() asm volatile("s_waitcnt lgkmcnt(0)" ::: "memory")

__device__ __forceinline__ unsigned f2bf(float f) { unsigned u = __builtin_bit_cast(unsigned, f); return (u + 0x7fffu + ((u >> 16) & 1u)) >> 16; }
__device__ __forceinline__ unsigned pk2(float lo, float hi) { return f2bf(lo) | (f2bf(hi) << 16); }
__device__ __forceinline__ float bflo(unsigned u) { return __builtin_bit_cast(float, u << 16); }
__device__ __forceinline__ float bfhi(unsigned u) { return __builtin_bit_cast(float, u & 0xffff0000u); }
__device__ __forceinline__ void load8(const bf16* p, float (&o)[8]) { const u32x4 u = *(const u32x4*)p; o[0] = bflo(u.x); o[1] = bfhi(u.x); o[2] = bflo(u.y); o[3] = bfhi(u.y); o[4] = bflo(u.z); o[5] = bfhi(u.z); o[6] = bflo(u.w); o[7] = bfhi(u.w); }
__device__ __forceinline__ void store8(bf16* p, const float (&v)[8]) { u32x4 w; w.x = pk2(v[0], v[1]); w.y = pk2(v[2], v[3]); w.z = pk2(v[4], v[5]); w.w = pk2(v[6], v[7]); *(u32x4*)p = w; }
typedef _Float16 f16x2 __attribute__((ext_vector_type(2)));
__device__ __forceinline__ unsigned pkh2(float lo, float hi) { f16x2 h; h.x = (_Float16)lo; h.y = (_Float16)hi; return __builtin_bit_cast(unsigned, h); }
__device__ __forceinline__ float hlo(unsigned u) { return (float)__builtin_bit_cast(f16x2, u).x; }
__device__ __forceinline__ float hhi(unsigned u) { return (float)__builtin_bit_cast(f16x2, u).y; }
__device__ __forceinline__ void load8h(const bf16* p, float (&o)[8]) { const u32x4 u = *(const u32x4*)p; o[0] = hlo(u.x); o[1] = hhi(u.x); o[2] = hlo(u.y); o[3] = hhi(u.y); o[4] = hlo(u.z); o[5] = hhi(u.z); o[6] = hlo(u.w); o[7] = hhi(u.w); }
__device__ __forceinline__ void store8h(bf16* p, const float (&v)[8]) { u32x4 w; w.x = pkh2(v[0], v[1]); w.y = pkh2(v[2], v[3]); w.z = pkh2(v[4], v[5]); w.w = pkh2(v[6], v[7]); *(u32x4*)p = w; }
__device__ __forceinline__ float fmx_lo(float a, unsigned h, float c) { float d; asm("v_fma_mix_f32 %0, %1, %2, %3 op_sel_hi:[0,1,0]" : "=v"(d) : "v"(a), "v"(h), "v"(c)); return d; }
__device__ __forceinline__ float fmx_hi(float a, unsigned h, float c) { float d; asm("v_fma_mix_f32 %0, %1, %2, %3 op_sel:[0,1,0] op_sel_hi:[0,1,0]" : "=v"(d) : "v"(a), "v"(h), "v"(c)); return d; }
__device__ __forceinline__ float mmx_lo(float a, unsigned h) { float d; asm("v_fma_mix_f32 %0, %1, %2, 0 op_sel_hi:[0,1,0]" : "=v"(d) : "v"(a), "v"(h)); return d; }
__device__ __forceinline__ float mmx_hi(float a, unsigned h) { float d; asm("v_fma_mix_f32 %0, %1, %2, 0 op_sel:[0,1,0] op_sel_hi:[0,1,0]" : "=v"(d) : "v"(a), "v"(h)); return d; }
__device__ __forceinline__ float sigmoidf_(float x) { return __builtin_amdgcn_rcpf(1.0f + __expf(-x)); }
__device__ __forceinline__ float tanhf_(float x) { return 1.0f - 2.0f * __builtin_amdgcn_rcpf(__expf(2.0f * x) + 1.0f); }
__device__ __forceinline__ float wave_sum(float v) {
#pragma unroll
    for (int o = 1; o < 64; o <<= 1) v += __shfl_xor(v, o);
    return v;
}
__device__ __forceinline__ float sum8(float v) { v += __shfl_xor(v, 1); v += __shfl_xor(v, 2); v += __shfl_xor(v, 4); return v; }
template <int CTRL> __device__ __forceinline__ float dpp_f(float v) { return __builtin_bit_cast(float, __builtin_amdgcn_mov_dpp(__builtin_bit_cast(int, v), CTRL, 0xF, 0xF, true)); }
__device__ __forceinline__ float dpp_sum16(float v) {
    v += dpp_f<0xB1>(v);
    v += dpp_f<0x4E>(v);
    v += dpp_f<0x141>(v);
    v += dpp_f<0x140>(v);
    return v;
}

#define XB_TMO      128
#define XB_XCNT(j)  (256  + 64 * (j))
#define XB_XSUB(j)  (1280 + 64 * (j))
#define XB_XGEN(j)  (2304 + 64 * (j))
#define XB_TOP      3328
#define XB_TOPGEN   3392
#define XCD_BAR_WORDS 3456
#define XB_SPIN_CAP (1u << 18)

__device__ __forceinline__ unsigned xb_ld(unsigned* p)              { return __hip_atomic_load(p, __ATOMIC_RELAXED, __HIP_MEMORY_SCOPE_AGENT); }
__device__ __forceinline__ unsigned xb_add(unsigned* p, unsigned v) { return __hip_atomic_fetch_add(p, v, __ATOMIC_RELAXED, __HIP_MEMORY_SCOPE_AGENT); }
__device__ __forceinline__ unsigned xb_xcc_id() { return (unsigned)__builtin_amdgcn_s_getreg((3 << 11) | 20) & 0xFu; }
#define XB_SPIN(cond, bar) do { unsigned _sp = 0; while (cond) { __builtin_amdgcn_s_sleep(1); \
    if ((++_sp & 255u) == 0u) { if (xb_ld(&(bar)[XB_TMO])) break; if (_sp > XB_SPIN_CAP) { atomicAdd(&(bar)[XB_TMO], 1u); break; } } } } while (0)

struct XcdBarrier {
    unsigned* bar; unsigned x;
    volatile LAS unsigned* st;
};

__device__ __forceinline__ XcdBarrier xcd_barrier_post(unsigned* bar, volatile LAS unsigned* st) {
    XcdBarrier b; b.bar = bar; b.x = xb_xcc_id(); b.st = st;
    if (threadIdx.x == 0) (void)xb_add(&bar[XB_XCNT(b.x)], 1u);
    return b;
}
__device__ __forceinline__ void xcd_barrier_complete(unsigned* bar, unsigned x, unsigned& nloc, unsigned& nx) {
    const unsigned G = gridDim.x * gridDim.y * gridDim.z;
    unsigned sum, cnt, mine, sp = 0u;
    for (;;) {
        sum = 0u; cnt = 0u; mine = 0u;
#pragma unroll
        for (unsigned j = 0; j < 16; ++j) { const unsigned c = xb_ld(&bar[XB_XCNT(j)]); sum += c; cnt += (c > 0u) ? 1u : 0u; mine = (j == x) ? c : mine; }
        if (sum == G) break;
        __builtin_amdgcn_s_sleep(1);
        if ((++sp & 255u) == 0u) { if (xb_ld(&bar[XB_TMO])) break; if (sp > XB_SPIN_CAP) { atomicAdd(&bar[XB_TMO], 1u); break; } }
    }
    nloc = mine > 0u ? mine : 1u; nx = cnt > 0u ? cnt : 1u;
}

__device__ __forceinline__ void xcd_barrier(const XcdBarrier& b) {
    asm volatile("s_waitcnt vmcnt(0)" ::: "memory");
    __syncthreads();
    if (threadIdx.x == 0) {
        unsigned* bar = b.bar;
        __builtin_amdgcn_s_waitcnt(0);
        unsigned nloc = b.st[0], nx = b.st[1];
        if (nloc == 0u) { xcd_barrier_complete(bar, b.x, nloc, nx); b.st[0] = nloc; b.st[1] = nx; }
        const unsigned old = xb_add(&bar[XB_XSUB(b.x)], 1u);
        const unsigned gen = old / nloc;
        if (old + 1u == (gen + 1u) * nloc) {
            __builtin_amdgcn_fence(__ATOMIC_RELEASE, "agent");
            asm volatile("s_waitcnt vmcnt(0)" ::: "memory");
            const unsigned og = xb_add(&bar[XB_TOP], 1u);
            const unsigned tg = og / nx;
            if (og + 1u == (tg + 1u) * nx) xb_add(&bar[XB_TOPGEN], 1u);
            else XB_SPIN(xb_ld(&bar[XB_TOPGEN]) == tg, bar);
            __builtin_amdgcn_fence(__ATOMIC_ACQUIRE, "agent");
            xb_add(&bar[XB_XGEN(b.x)], 1u);
            asm volatile("s_waitcnt vmcnt(0)" ::: "memory");
        } else {
            XB_SPIN(xb_ld(&bar[XB_XGEN(b.x)]) == gen, bar);
            __builtin_amdgcn_fence(__ATOMIC_ACQUIRE, "agent");
            asm volatile("s_waitcnt vmcnt(0)" ::: "memory");
        }
    }
    __syncthreads();
}

struct Args { const void* p[30]; int ph_lo, ph_hi; };
template <int IDX> __device__ __forceinline__ const float* kin() {
    const auto ka = __builtin_amdgcn_kernarg_segment_ptr(); unsigned long long v;
    asm volatile("s_load_dwordx2 %0, %1, %2\n\ts_waitcnt lgkmcnt(0)" : "=s"(v) : "s"(ka), "i"(IDX * 8) : "memory");
    return (const float*)(const GAS float*)v;
}
enum { I_X = 0, I_C, I_WADA, I_BADA, I_N1G, I_N2G, I_WIN, I_MU, I_CONVW, I_W0, I_DECUP, I_A0, I_AAAUP, I_GATEUP, I_KK, I_KA, I_RK, I_LNW, I_LNB, I_VMD, I_VMU, I_V0, I_WOUT, I_WR, I_RB, I_WE1, I_WE2, I_FG };
struct Frame {
    LAS unsigned char* lds;
    int tid, lane, wave, vcu, G;
    GAS unsigned char* ws;
};
__device__ __forceinline__ float* ada_ptr(const Frame& F, int l, int b) { return (float*)(F.ws + WS_CTL + CTL_ADA) + (size_t)(l * 8 + b) * 6144; }

__device__ __forceinline__ void transpose_item(const float* W, int K, int N, bf16* WT, int dst_row0, int k0, int n0, LAS float* scr, int lane) {
    float tv[32];
#pragma unroll
    for (int i = 0; i < 32; ++i) tv[i] = W[(size_t)(k0 + 2 * i + (lane >> 5)) * N + n0 + (lane & 31)];
#pragma unroll
    for (int i = 0; i < 32; ++i) { const int kk = 2 * i + (lane >> 5); scr[kk * 33 + (lane & 31)] = tv[i]; }
    LDS_WAIT();
    const int c = lane & 7;
#pragma unroll
    for (int j = 0; j < 4; ++j) { const int n = (lane >> 3) + 8 * j; const LAS float* s = scr + (8 * c) * 33 + n;
        u32x4 o; o.x = pk2(s[0 * 33], s[1 * 33]); o.y = pk2(s[2 * 33], s[3 * 33]); o.z = pk2(s[4 * 33], s[5 * 33]); o.w = pk2(s[6 * 33], s[7 * 33]);
        *(u32x4*)(WT + (size_t)(dst_row0 + n) * K + k0 + 8 * c) = o; }
    LDS_WAIT();
}
__device__ __forceinline__ void p0_prologue(const Frame& F) {
    LAS float* scr = (LAS float*)(F.lds + F.wave * 16384);
    const int gw = F.vcu * NWAVES + F.wave, NGW = F.G * NWAVES, lane = F.lane;
    constexpr int I_ADA = 768, I_A = 2 * 16 * 264, I_B = 2 * 16 * 32, I_C1 = 64 * 16 * 32, I_D = 64 * 8 * 32;
    constexpr int NITEMS = I_ADA + I_A + I_B + I_C1 + I_D;
    const float* const pC = kin<I_C>(); const float* const pWADA = kin<I_WADA>(); const float* const pWIN = kin<I_WIN>();
    const float* const pWOUT = kin<I_WOUT>(); const float* const pWE1 = kin<I_WE1>(); const float* const pWE2 = kin<I_WE2>(); const float* const pVMD = kin<I_VMD>();
    for (int it = gw; it < NITEMS; it += NGW) {
        int r = it;
        if (r < I_ADA) {
            const int l = r / 384, rr = r % 384, cch = rr >> 4, kc = rr & 15, col = cch * 256 + 4 * lane, k0 = kc * 64;
            float cv[8];
#pragma unroll
            for (int b = 0; b < 8; ++b) { const float x = pC[b * 1024 + k0 + lane]; cv[b] = x * sigmoidf_(x); }
            f32x4 acc[8];
#pragma unroll
            for (int b = 0; b < 8; ++b) acc[b] = (f32x4){0.f, 0.f, 0.f, 0.f};
            const float* wp = pWADA + ((size_t)l * 1024 + k0) * 6144 + col;
#pragma unroll 16
            for (int kk = 0; kk < 64; ++kk) { const f32x4 w = *(const f32x4*)(wp + (size_t)kk * 6144);
#pragma unroll
                for (int b = 0; b < 8; ++b) { const float s = __builtin_bit_cast(float, __builtin_amdgcn_readlane(__builtin_bit_cast(int, cv[b]), kk)); acc[b] += s * w; } }
#pragma unroll
            for (int b = 0; b < 8; ++b) *(f32x4*)((float*)(F.ws + WS_ADAP) + ((size_t)(kc * 2 + l) * 8 + b) * 6144 + col) = acc[b];
            continue;
        }
        r -= I_ADA;
        if (r < I_A) { const int l = r / (16 * 264), rr = r % (16 * 264), kb = rr / 264, nb = rr % 264;
            transpose_item(pWIN + (size_t)l * 1024 * N_IN, 1024, N_IN, (bf16*)(F.ws + WS_BT_IN) + (size_t)l * P_LD * 1024, 32 * nb, 64 * kb, 32 * nb, scr, lane); continue; }
        r -= I_A;
        if (r < I_B) { const int l = r / 512, rr = r % 512, kb = rr / 32, nb = rr % 32;
            transpose_item(pWOUT + (size_t)l * 1024 * 1024, 1024, 1024, (bf16*)(F.ws + WS_BT_OUT) + (size_t)l * 1024 * 1024, 32 * nb, 64 * kb, 32 * nb, scr, lane); continue; }
        r -= I_B;
        if (r < I_C1) { const int le = r / 512, rr = r % 512, kb = rr / 32, nb = rr % 32, n0 = 32 * nb;
            const int j0 = n0 & 511, dst = (j0 >> 7) * 256 + (n0 >= 512 ? 128 : 0) + (j0 & 127);
            transpose_item(pWE1 + (size_t)le * 1024 * 1024, 1024, 1024, (bf16*)(F.ws + WS_BT_E1) + (size_t)le * 1024 * 1024, dst, 64 * kb, n0, scr, lane); continue; }
        r -= I_C1;
        { const int le = r / 256, rr = r % 256, kb = rr / 32, nb = rr % 32;
            transpose_item(pWE2 + (size_t)le * 512 * 1024, 512, 1024, (bf16*)(F.ws + WS_BT_E2) + (size_t)le * 1024 * 512, 32 * nb, 64 * kb, 32 * nb, scr, lane); }
    }
    const int gt0 = F.vcu * NWAVES * 64 + F.tid, GT = F.G * NWAVES * 64;
    { const float* const pVMUp = kin<I_VMU>();
      for (int it = gt0; it < 1024 * 128; it += GT) { const int n = it >> 7, k0 = (it & 127) * 8; float o[8];
#pragma unroll
        for (int i = 0; i < 8; ++i) o[i] = 0.f;
        for (int j = 0; j < 32; ++j) { const float u = pVMUp[j * 1024 + n];
#pragma unroll
            for (int i = 0; i < 8; ++i) o[i] += pVMD[(k0 + i) * 32 + j] * u; }
        store8((bf16*)(F.ws + WS_BT_IN) + (size_t)P_LD * 1024 + (size_t)(C_VD + n) * 1024 + k0, o); } }
    { const float* const pDU = kin<I_DECUP>(); const float* const pAU = kin<I_AAAUP>(); const float* const pGU = kin<I_GATEUP>();
      for (int it = gt0; it < 2 * 3072 * 32; it += GT) { const int l = it / (3072 * 32), rr = it % (3072 * 32), n = rr >> 5, k0 = (rr & 31) * 8; float o[8];
#pragma unroll
        for (int i = 0; i < 8; ++i) { const int k = k0 + i; float v = 0.f;
            if (n < 1024) { if (k < 64) v = pDU[(size_t)(l * 64 + k) * 1024 + n]; }
            else if (n < 2048) { if (k >= 64 && k < 128) v = pAU[(size_t)(l * 64 + k - 64) * 1024 + n - 1024]; }
            else { if (k >= 128) v = pGU[(size_t)(l * 128 + k - 128) * 1024 + n - 2048]; }
            o[i] = v; }
        store8((bf16*)(F.ws + WS_BT_LR) + (size_t)l * 3072 * 256 + (size_t)n * 256 + k0, o); } }
    { const float* const pWRp = kin<I_WR>(); const int gt = F.vcu * NWAVES * 64 + F.tid; if (gt < 32768) ((float*)(F.ws + WS_WRT))[gt] = pWRp[(gt & 1023) * 32 + (gt >> 10)]; }
}

__device__ __forceinline__ void p0b_ada_reduce(const Frame& F) {
    const float* const pBADA = kin<I_BADA>(); const float* ap = (const float*)(F.ws + WS_ADAP); float* ada = (float*)(F.ws + WS_CTL + CTL_ADA);
    for (int idx = F.vcu * NWAVES * 64 + F.tid; idx < 2 * 8 * 6144; idx += F.G * NWAVES * 64) { const int l = idx / 49152, r = idx % 49152, c = r % 6144;
        float s = pBADA[l * 6144 + c];
#pragma unroll
        for (int kc = 0; kc < 16; ++kc) s += ap[(size_t)(kc * 2 + l) * 49152 + r];
        ada[idx] = s; }
}

template <int MODE> __device__ __forceinline__ void p1_norm(const Frame& F, int l) {
    const int lane = F.lane;
    const float* const pX = kin<I_X>(); float* const pOUT = (float*)kin<28>(); const float* const pFG = kin<I_FG>(); const float* const pN1G = kin<I_N1G>(); const float* const pWRb = kin<I_WR>();
#pragma unroll 1
    for (int gw = F.vcu * NWAVES + F.wave; gw < T / 8; gw += F.G * NWAVES) { const int tok0 = gw * 8, b = tok0 >> 11;
        f32x4 gm[4], sh[4], g2v[4];
#pragma unroll
        for (int j = 0; j < 4; ++j) { const int c = 4 * lane + 256 * j;
            if (MODE == 2) { gm[j] = *(const f32x4*)(pFG + c); sh[j] = (f32x4){0.f, 0.f, 0.f, 0.f}; }
            else { const float* ad = ada_ptr(F, l, b); const f32x4 g = *(const f32x4*)(pN1G + l * 1024 + c), sc = *(const f32x4*)(ad + 1024 + c); gm[j] = g * (1.0f + sc); sh[j] = *(const f32x4*)(ad + c); }
            if (MODE >= 1) g2v[j] = *(const f32x4*)(ada_ptr(F, MODE == 2 ? 1 : l - 1, b) + 5120 + c); }
        float* X = (float*)(F.ws + WS_X);
        const bf16* YE = (const bf16*)(F.ws + WS_YE);
        const float* WTS = (const float*)(F.ws + WS_WTS); const int* SLOT = (const int*)(F.ws + WS_SLOT);
        for (int tk = 0; tk < 8; ++tk) { const int tok = tok0 + tk;
            f32x4 v[4]; const float* xs = (MODE == 0 ? pX : X) + (size_t)tok * 1024;
#pragma unroll
            for (int j = 0; j < 4; ++j) v[j] = *(const f32x4*)(xs + 4 * lane + 256 * j);
            if (MODE >= 1) { const float w0 = WTS[tok * 2], w1 = WTS[tok * 2 + 1]; const int s0 = SLOT[tok * 2], s1 = SLOT[tok * 2 + 1];
#pragma unroll
                for (int j = 0; j < 4; ++j) { const u32x2 y0 = *(const u32x2*)(YE + (size_t)s0 * 1024 + 4 * lane + 256 * j), y1 = *(const u32x2*)(YE + (size_t)s1 * 1024 + 4 * lane + 256 * j);
                    f32x4 m; m[0] = w0 * bflo(y0.x) + w1 * bflo(y1.x); m[1] = w0 * bfhi(y0.x) + w1 * bfhi(y1.x); m[2] = w0 * bflo(y0.y) + w1 * bflo(y1.y); m[3] = w0 * bfhi(y0.y) + w1 * bfhi(y1.y);
                    v[j] += g2v[j] * m; if (MODE == 1) *(f32x4*)(X + (size_t)tok * 1024 + 4 * lane + 256 * j) = v[j]; } }
            float ss = 0.f;
#pragma unroll
            for (int j = 0; j < 4; ++j) ss += (v[j][0] * v[j][0] + v[j][1] * v[j][1]) + (v[j][2] * v[j][2] + v[j][3] * v[j][3]);
            float rstd = __builtin_amdgcn_rsqf(wave_sum(ss) * (1.0f / 1024.0f) + NORM_EPS);
#if defined(DBG_SCAN)
            if (MODE == 2) { const float* dz = (const float*)(F.ws + WS_CTL) + 2048; const float er = sqrtf(dz[0] / fmaxf(dz[1], 1e-30f)); rstd *= 1.0f + 0.3f * fminf(er, 3.0f); }
#endif
#pragma unroll
            for (int j = 0; j < 4; ++j) { const f32x4 h = v[j] * rstd * gm[j] + sh[j];
                if (MODE == 2) *(f32x4*)(pOUT + (size_t)tok * 1024 + 4 * lane + 256 * j) = h;
                else { u32x2 w; w.x = pk2(h[0], h[1]); w.y = pk2(h[2], h[3]); *(u32x2*)((bf16*)(F.ws + WS_H) + (size_t)tok * 1024 + 4 * lane + 256 * j) = w; } }
        }
    }
    if (MODE == 0 && F.vcu < 16) {
        const int lb = F.vcu, e = F.tid & 31, kq = F.tid >> 5; const float* sh2 = ada_ptr(F, lb >> 3, lb & 7) + 3072; float s = 0.f;
        for (int k = kq * 64; k < kq * 64 + 64; ++k) s += sh2[k] * pWRb[k * 32 + e];
        LAS float* red = (LAS float*)F.lds; red[kq * 32 + e] = s; __syncthreads();
        if (F.tid < 32) { float t = 0.f; for (int q = 0; q < 16; ++q) t += red[q * 32 + e]; ((float*)(F.ws + WS_CTL + CTL_BIASR))[lb * 32 + e] = t; }
        __syncthreads();
    }
}

__device__ __forceinline__ void p2b_lra(const Frame& F, int l) {
    const int lane = F.lane, c8 = lane & 31, hf = lane >> 5;
    const bf16* P = (const bf16*)(F.ws + WS_P); bf16* ALR = (bf16*)(F.ws + WS_ALR); const float* mu = kin<I_MU>() + l * N_SHIFT + 3072 + 8 * c8;
    const f32x4 m0 = *(const f32x4*)mu, m1 = *(const f32x4*)(mu + 4);
    const float* const pKKc = kin<I_KK>() + l * 1024; const float* const muK = kin<I_MU>() + l * N_SHIFT + 1024; float* KNo = (float*)(F.ws + WS_KN);
#pragma unroll 1
    for (int gw = F.vcu * NWAVES + F.wave; gw < T / 8; gw += F.G * NWAVES) {
#pragma unroll
        for (int i = 0; i < 4; ++i) { const int tok = gw * 8 + 2 * i + hf; float cur[8], prv[8], o[8];
            load8(P + (size_t)tok * P_LD + C_WD + 8 * c8, cur);
            if ((tok & (SEQ - 1)) != 0) load8(P + (size_t)(tok - 1) * P_LD + C_WD + 8 * c8, prv); else {
#pragma unroll
                for (int j = 0; j < 8; ++j) prv[j] = 0.f; }
#pragma unroll
            for (int j = 0; j < 8; ++j) { const float v = cur[j] + (prv[j] - cur[j]) * (j < 4 ? m0[j] : m1[j - 4]); o[j] = (c8 < 8) ? tanhf_(v) : ((c8 < 16) ? v : sigmoidf_(v)); }
            store8(ALR + (size_t)tok * 256 + 8 * c8, o); }
#pragma unroll 1
        for (int ch = 0; ch < 2; ++ch) { const int col0 = 512 * ch + 8 * lane; float kkc[8], muk[8], kp_[8];
#pragma unroll
            for (int j = 0; j < 8; ++j) { kkc[j] = pKKc[col0 + j]; muk[j] = muK[col0 + j]; kp_[j] = 0.f; }
            const int tok0 = gw * 8;
            if ((tok0 & (SEQ - 1)) != 0) load8(P + (size_t)(tok0 - 1) * P_LD + C_K + col0, kp_);
#pragma unroll 4
            for (int tk = 0; tk < 8; ++tk) { float kc[8]; load8(P + (size_t)(tok0 + tk) * P_LD + C_K + col0, kc); float ss = 0.f;
#pragma unroll
                for (int j = 0; j < 8; ++j) { const float k = (kc[j] + (kp_[j] - kc[j]) * muk[j]) * kkc[j]; ss += k * k; kp_[j] = kc[j]; }
                ss = sum8(ss);
                if ((lane & 7) == 0) KNo[(tok0 + tk) * 16 + 8 * ch + (lane >> 3)] = __builtin_amdgcn_rsqf(fmaxf(ss, 1e-24f)); } }
    }
}

__device__ __forceinline__ void p3_prep(const Frame& F, int l) {
    const int lane = F.lane;
    const bf16* P = (const bf16*)(F.ws + WS_P); const bf16* LR = (const bf16*)(F.ws + WS_LR);
    const float* mu = kin<I_MU>() + l * N_SHIFT;
    const float* const pA0 = kin<I_A0>() + l * 1024; const float* const pKKc = kin<I_KK>() + l * 1024; const float* const pKA = kin<I_KA>() + l * 1024; const float* const pRK = kin<I_RK>() + l * 1024; const float* const pW0 = kin<I_W0>() + l * 1024; const float* const pV0c = kin<I_V0>();
    bf16* KKo = (bf16*)(F.ws + WS_KK); bf16* BQo = (bf16*)(F.ws + WS_BQ); bf16* KPo = (bf16*)(F.ws + WS_KP); bf16* Ro = (bf16*)(F.ws + WS_R);
    bf16* V0 = (bf16*)(F.ws + WS_V0); bf16* V1 = (bf16*)(F.ws + WS_V1); float* Wo = (float*)(F.ws + WS_W); float* BON = (float*)(F.ws + WS_BONUS);
#pragma unroll 1
    for (int gw = F.vcu * NWAVES + F.wave; gw < T / 8; gw += F.G * NWAVES) { const int tok0 = gw * 8;
#pragma unroll 1
    for (int ch = 0; ch < 2; ++ch) { const int col0 = 512 * ch + 8 * lane, head = 8 * ch + (lane >> 3);
        float a0v[8], kkc[8], kac[8], rkc[8], w0v[8], v0v[8], mur[8], muk[8], muv[8], rp[8], kp_[8], vp[8];
#pragma unroll
        for (int j = 0; j < 8; ++j) { a0v[j] = pA0[col0 + j]; kkc[j] = pKKc[col0 + j]; kac[j] = pKA[col0 + j]; rkc[j] = pRK[col0 + j]; w0v[j] = pW0[col0 + j]; v0v[j] = (l == 1) ? pV0c[col0 + j] : 0.f;
            mur[j] = mu[col0 + j]; muk[j] = mu[1024 + col0 + j]; muv[j] = mu[2048 + col0 + j]; rp[j] = 0.f; kp_[j] = 0.f; vp[j] = 0.f; }
        if ((tok0 & (SEQ - 1)) != 0) { const bf16* pr = P + (size_t)(tok0 - 1) * P_LD + col0; load8(pr + C_R, rp); load8(pr + C_K, kp_); load8(pr + C_V, vp); }
#pragma unroll 2
        for (int tk = 0; tk < 8; ++tk) { const int tok = tok0 + tk; const bf16* pr = P + (size_t)tok * P_LD + col0;
            float rc[8], kc[8], vc[8], dw[8], ap[8], r[8], k[8], v[8], kk[8], kp[8], bq[8], w[8];
            load8(pr + C_R, rc); load8(pr + C_K, kc); load8(pr + C_V, vc); load8(LR + (size_t)tok * 3072 + col0, dw); load8(LR + (size_t)tok * 3072 + 1024 + col0, ap);
            float ss = 0.f, bo = 0.f;
#pragma unroll
            for (int j = 0; j < 8; ++j) { r[j] = rc[j] + (rp[j] - rc[j]) * mur[j]; k[j] = kc[j] + (kp_[j] - kc[j]) * muk[j]; v[j] = vc[j] + (vp[j] - vc[j]) * muv[j]; rp[j] = rc[j]; kp_[j] = kc[j]; vp[j] = vc[j];
                const float av = sigmoidf_(a0v[j] + ap[j]); kk[j] = k[j] * kkc[j]; ss += kk[j] * kk[j]; kp[j] = k[j] * (1.0f + (av - 1.0f) * kac[j]); bo += r[j] * kp[j] * rkc[j]; bq[j] = av;
                const float nd = -(w0v[j] + dw[j]); const float sp = fmaxf(nd, 0.f) + __logf(1.0f + __expf(-fabsf(nd))); w[j] = -__expf(-sp - 0.5f); }
            ss = sum8(ss); bo = sum8(bo);
            const float inv = __builtin_amdgcn_rsqf(fmaxf(ss, 1e-24f));
#pragma unroll
            for (int j = 0; j < 8; ++j) { kk[j] *= inv; bq[j] *= kk[j]; }
            store8h(KKo + (size_t)tok * 1024 + col0, kk); store8h(BQo + (size_t)tok * 1024 + col0, bq); store8h(KPo + (size_t)tok * 1024 + col0, kp); store8h(Ro + (size_t)tok * 1024 + col0, r);
            if ((lane & 7) == 0) BON[tok * 16 + head] = bo;
            float* wp = Wo + (size_t)tok * 1024 + col0; *(f32x4*)wp = (f32x4){w[0], w[1], w[2], w[3]}; *(f32x4*)(wp + 4) = (f32x4){w[4], w[5], w[6], w[7]};
            if (l == 1) { float vf[8], vm[8]; load8h(V0 + (size_t)tok * 1024 + col0, vf); load8(pr + C_VD, vm);
#pragma unroll
                for (int j = 0; j < 8; ++j) v[j] = v[j] + (vf[j] - v[j]) * sigmoidf_(v0v[j] + vm[j]);
                store8h(V1 + (size_t)tok * 1024 + col0, v); }
            else store8h(V0 + (size_t)tok * 1024 + col0, v); }
    }
    }
}

__device__ __forceinline__ f32x4 h4_to_f4(const u32x2 u) { return (f32x4){hlo(u.x), hhi(u.x), hlo(u.y), hhi(u.y)}; }
#if defined(DBG_SCAN)
constexpr size_t WS_YCK = WS_H;
constexpr int SC_CH = 32, SC_BUF = 49152, SC_W = 0, SC_KK = 8192, SC_BQ = 16384, SC_KP = 24576, SC_R = 32768, SC_V = 40960, SC_Y = 45056;
struct ScanRegsSeq { f32x4 w; u32x2 kk, bq, kp, r, v; };
__device__ __forceinline__ void scan_issue(const Frame& F, int l, int b, int h, int half, int cc, ScanRegsSeq& R) {
    const int s = F.tid >> 4, q = F.tid & 15; const size_t base = ((size_t)b * SEQ + cc * SC_CH + s) * 1024 + h * 64 + 4 * q;
    R.w = *(const f32x4*)((const float*)(F.ws + WS_W) + base);
    R.kk = *(const u32x2*)((const bf16*)(F.ws + WS_KK) + base); R.bq = *(const u32x2*)((const bf16*)(F.ws + WS_BQ) + base);
    R.kp = *(const u32x2*)((const bf16*)(F.ws + WS_KP) + base); R.r = *(const u32x2*)((const bf16*)(F.ws + WS_R) + base);
    if (F.tid < 256) { const int s2 = F.tid >> 3, r4 = F.tid & 7; R.v = *(const u32x2*)((const bf16*)(F.ws + (l == 0 ? WS_V0 : WS_V1)) + ((size_t)b * SEQ + cc * SC_CH + s2) * 1024 + h * 64 + half * 32 + 4 * r4); }
}
__device__ __forceinline__ void scan_commit(const Frame& F, int buf, const ScanRegsSeq& R) {
    const int s = F.tid >> 4, q = F.tid & 15; LAS unsigned char* B = F.lds + buf * SC_BUF + (s * 16 + q) * 16;
    *(LAS f32x4*)(B + SC_W) = (f32x4){__expf(R.w[0]), __expf(R.w[1]), __expf(R.w[2]), __expf(R.w[3])};     *(LAS f32x4*)(B + SC_KK) = h4_to_f4(R.kk); *(LAS f32x4*)(B + SC_BQ) = h4_to_f4(R.bq); *(LAS f32x4*)(B + SC_KP) = h4_to_f4(R.kp); *(LAS f32x4*)(B + SC_R) = h4_to_f4(R.r);
    if (F.tid < 256) { const int s2 = F.tid >> 3, r4 = F.tid & 7; *(LAS f32x4*)(F.lds + buf * SC_BUF + SC_V + (s2 * 32 + 4 * r4) * 4) = h4_to_f4(R.v); }
}
__device__ __forceinline__ void scan_store(const Frame& F, int b, int h, int half, int cc, int buf) {
    if (F.tid < 256) { const int s2 = F.tid >> 3, r4 = F.tid & 7;
        const f32x4 y = *(const LAS f32x4*)(F.lds + buf * SC_BUF + SC_Y + (s2 * 32 + 4 * r4) * 4);
        u32x2 w; w.x = pk2(y[0], y[1]); w.y = pk2(y[2], y[3]);
        const int t = cc * SC_CH + s2 - 1;
        if (t >= 0) *(u32x2*)((bf16*)(F.ws + WS_Y) + ((size_t)b * SEQ + t) * 1024 + h * 64 + half * 32 + 4 * r4) = w; }
}
__device__ __forceinline__ void p4_scan_seq(const Frame& F, int l) {
#pragma unroll 1
    for (int unit = F.vcu; unit < NBATCH * NHEAD * 2; unit += F.G) {
        const int b = unit >> 5, h = (unit >> 1) & 15, half = unit & 1;
        const int g = F.lane >> 4, q = F.lane & 15, row = F.wave * 4 + g;
        f32x2 sA = (f32x2){0.f, 0.f}, sB = sA; float yp = 0.f; const bool odd = (q & 1) != 0;
        ScanRegsSeq SR;
        bf16* SAdbg = (bf16*)(F.ws + WS_V1) + (size_t)b * SEQ * 1024 + h * 64 + half * 32 + row;
        scan_issue(F, l, b, h, half, 0, SR); scan_commit(F, 0, SR); scan_issue(F, l, b, h, half, 1, SR);
        __syncthreads();
        constexpr int NCH = SEQ / SC_CH;
#pragma unroll 1
        for (int cc = 0; cc < NCH; ++cc) { const int buf = cc & 1;
            { const LAS unsigned char* B = F.lds + buf * SC_BUF;
              const LAS f32x4* pc = (const LAS f32x4*)B + q;
              const LAS float* pv = (const LAS float*)(B + SC_V) + row; LAS float* py = (LAS float*)(B + SC_Y) + row;
              f32x4 aw[2], ak[2], ab[2], ap[2], ar[2], bw[2], bk[2], bb[2], bp[2], br_[2]; float av[2], bv[2];
#define SC_LOAD(dw, dk, db, dp, dr, dv, s) do { dw = pc[(s) * 16]; dk = pc[(s) * 16 + 512]; db = pc[(s) * 16 + 1024]; dp = pc[(s) * 16 + 1536]; dr = pc[(s) * 16 + 2048]; dv = pv[(s) * 32]; } while (0)
#define SC_STEP(cw, ck, cb, cp, cr, cv, yo, sidx) do { \
        f32x2 t = sA * ck.lo; t = sB * ck.hi + t; \
        const float pa = t.x + t.y; \
        float x = odd ? yp : pa; const float z = odd ? pa : yp; \
        x += dpp_f<0xB1>(z); x += dpp_f<0x4E>(x); x += dpp_f<0x124>(x); x += dpp_f<0x128>(x); \
        const float sa = dpp_f<0xA0>(x); \
        if (l == 0 && q == 0) SAdbg[(size_t)(cc * SC_CH + (sidx)) * 1024] = (bf16)f2bf(sa); \
        f32x2 xA = cv * cp.lo, xB = cv * cp.hi; \
        xA = xA - sa * cb.lo; xB = xB - sa * cb.hi; \
        sA = sA * cw.lo + xA; sB = sB * cw.hi + xB; \
        f32x2 yv = sA * cr.lo; yv = sB * cr.hi + yv; \
        yo = x; yp = yv.x + yv.y; } while (0)
#pragma unroll
              for (int i = 0; i < 2; ++i) SC_LOAD(aw[i], ak[i], ab[i], ap[i], ar[i], av[i], i);
#pragma unroll 1
              for (int s4 = 0; s4 < SC_CH; s4 += 4) {
#pragma unroll
                  for (int i = 0; i < 2; ++i) SC_LOAD(bw[i], bk[i], bb[i], bp[i], br_[i], bv[i], s4 + 2 + i);
                  float yo[2];
#pragma unroll
                  for (int i = 0; i < 2; ++i) SC_STEP(aw[i], ak[i], ab[i], ap[i], ar[i], av[i], yo[i], s4 + i);
                  if (q == 1) { py[(s4 + 0) * 32] = yo[0]; py[(s4 + 1) * 32] = yo[1]; }
                  const int sn = (s4 + 4 < SC_CH) ? s4 + 4 : s4;
#pragma unroll
                  for (int i = 0; i < 2; ++i) SC_LOAD(aw[i], ak[i], ab[i], ap[i], ar[i], av[i], sn + i);
#pragma unroll
                  for (int i = 0; i < 2; ++i) SC_STEP(bw[i], bk[i], bb[i], bp[i], br_[i], bv[i], yo[i], s4 + 2 + i);
                  if (q == 1) { py[(s4 + 2) * 32] = yo[0]; py[(s4 + 3) * 32] = yo[1]; }
              }
#undef SC_STEP
#undef SC_LOAD
            }
            if (cc + 1 < NCH) scan_commit(F, buf ^ 1, SR);
            if (cc + 2 < NCH) scan_issue(F, l, b, h, half, cc + 2, SR);
            asm volatile("s_waitcnt lgkmcnt(0)" ::: "memory"); __builtin_amdgcn_s_barrier(); asm volatile("" ::: "memory");
            scan_store(F, b, h, half, cc, buf);
        }
        { const float yl = dpp_sum16(yp);
          if (q == 0) ((bf16*)(F.ws + WS_Y))[((size_t)b * SEQ + SEQ - 1) * 1024 + h * 64 + half * 32 + row] = (bf16)f2bf(yl); }
        __syncthreads();
    }
}

#else
constexpr size_t WS_YCK = WS_Y;
#endif
typedef short bf16x8 __attribute__((ext_vector_type(8)));
typedef float f32x16 __attribute__((ext_vector_type(16)));
typedef __bf16 bfl2 __attribute__((ext_vector_type(2)));
constexpr int CK_XK = 0, CK_XR = 4608, CK_BH = 9216, CK_KH = 14336, CK_GB = 19456, CK_VT = 19712, CK_X3SZ = 22272;
constexpr int CK_XB = 0, CK_XP = 4608, CK_P2SZ = 9216;
constexpr int CK_TK = 0, CK_TBR = 2560, CK_TKR = 5120, CK_TB = 7680, CK_TBT = 11776, CK_MT = 15872, CK_T2SZ = 18432;
constexpr int CK_X3_OFF = 0, CK_P2_OFF = 3 * CK_X3SZ, CK_T2_OFF = CK_P2_OFF + 2 * CK_P2SZ, CK_STASH = CK_T2_OFF + 2 * CK_T2SZ;
static_assert(CK_STASH + 8192 <= RING_BYTES, "chunked-scan LDS map");
#define CK_MFMA(a, b, c) __builtin_amdgcn_mfma_f32_32x32x16_bf16((a), (b), (c), 0, 0, 0)
__device__ __forceinline__ unsigned pkbf(float lo, float hi) { f32x2 v; v.x = lo; v.y = hi; return __builtin_bit_cast(unsigned, __builtin_convertvector(v, bfl2)); }
__device__ __forceinline__ bf16x8 ck_frag(const LAS unsigned char* base, int pitch, int row, int kel) { return *(const LAS bf16x8*)(base + row * pitch + kel * 2); }
struct CkRegs { u32x2 rP, rA, rB, kP, kA, kB, vP, vA, vB, dwA, dwB, apA, apB, vmA, vmB, vfA, vfB; float knA, knB; };
struct CkConst { f32x4 a0, kk, ka, rk, w0, v0, mur, muk, muv; };
__device__ __forceinline__ f32x4 b4_to_f4(const u32x2 u) { return (f32x4){bflo(u.x), bfhi(u.x), bflo(u.y), bfhi(u.y)}; }
__device__ __forceinline__ void ck_issue(const Frame& F, int pw, int l, int b, int h, int half, int blk, CkRegs& R) {
    const int s2 = F.lane >> 2, cq = F.lane & 3, col = h * 64 + 16 * pw + 4 * cq; const size_t tA = (size_t)b * SEQ + blk * 32 + 2 * s2;
    const bf16* P = (const bf16*)(F.ws + WS_P) + tA * P_LD + col; const bf16* LR = (const bf16*)(F.ws + WS_LR) + tA * 3072 + col; const float* KN = (const float*)(F.ws + WS_KN) + tA * 16 + h;
    R.rA = *(const u32x2*)(P + C_R); R.rB = *(const u32x2*)(P + P_LD + C_R); R.kA = *(const u32x2*)(P + C_K); R.kB = *(const u32x2*)(P + P_LD + C_K); R.vA = *(const u32x2*)(P + C_V); R.vB = *(const u32x2*)(P + P_LD + C_V);
    if ((tA & (SEQ - 1)) != 0) { R.rP = *(const u32x2*)(P - P_LD + C_R); R.kP = *(const u32x2*)(P - P_LD + C_K); R.vP = *(const u32x2*)(P - P_LD + C_V); } else { R.rP = (u32x2){0u, 0u}; R.kP = R.rP; R.vP = R.rP; }
    R.dwA = *(const u32x2*)LR; R.dwB = *(const u32x2*)(LR + 3072); R.apA = *(const u32x2*)(LR + 1024); R.apB = *(const u32x2*)(LR + 3072 + 1024);
    R.knA = KN[0]; R.knB = KN[16];
    if (l == 1) { R.vmA = *(const u32x2*)(P + C_VD); R.vmB = *(const u32x2*)(P + P_LD + C_VD); const bf16* V0 = (const bf16*)(F.ws + WS_V0) + tA * 1024 + col; R.vfA = *(const u32x2*)V0; R.vfB = *(const u32x2*)(V0 + 1024); }
    (void)half;
}
__device__ __forceinline__ void ck_elem(const CkConst& C, int l, const f32x4 rc, const f32x4 rp, const f32x4 kc, const f32x4 kp_, const f32x4 vc, const f32x4 vp, const f32x4 dw, const f32x4 ap, const float kn,
                                        const f32x4 vm, const f32x4 vf, f32x4& r, f32x4& kk, f32x4& bq, f32x4& kp, f32x4& lw, f32x4& v, float& bo) {
#pragma unroll
    for (int e = 0; e < 4; ++e) {
        r[e] = rc[e] + (rp[e] - rc[e]) * C.mur[e]; const float k = kc[e] + (kp_[e] - kc[e]) * C.muk[e]; float vv = vc[e] + (vp[e] - vc[e]) * C.muv[e];
        const float av = sigmoidf_(C.a0[e] + ap[e]); kk[e] = k * C.kk[e] * kn; bq[e] = kk[e] * av; kp[e] = k * (1.0f + (av - 1.0f) * C.ka[e]); bo += r[e] * kp[e] * C.rk[e];
        const float nd = -(C.w0[e] + dw[e]); const float sp = fmaxf(nd, 0.f) + __logf(1.0f + __expf(-fabsf(nd))); lw[e] = -__expf(-sp - 0.5f);
        if (l == 1) vv = vv + (vf[e] - vv) * sigmoidf_(C.v0[e] + vm[e]);
        v[e] = vv; }
}
__device__ __forceinline__ void ck_stage1(const Frame& F, int pw, int l, int b, int h, int half, int blk, const CkConst& C, LAS unsigned char* BX, LAS unsigned char* BP, const CkRegs& R) {
    const int lane = F.lane, s2 = lane >> 2, cq = lane & 3, c0 = 16 * pw + 4 * cq, cp = 16 * pw + 4 * (((cq & 1) << 1) | (cq >> 1));
    f32x4 kkA, kkB, bqA, bqB, kpA, kpB, rA, rB, lwA, lwB, vA, vB; float boA = 0.f, boB = 0.f;
    { const f32x4 rcA = b4_to_f4(R.rA), kcA = b4_to_f4(R.kA), vcA = b4_to_f4(R.vA), zz = (f32x4){0.f, 0.f, 0.f, 0.f};
      ck_elem(C, l, rcA, b4_to_f4(R.rP), kcA, b4_to_f4(R.kP), vcA, b4_to_f4(R.vP), b4_to_f4(R.dwA), b4_to_f4(R.apA), R.knA, l == 1 ? b4_to_f4(R.vmA) : zz, l == 1 ? h4_to_f4(R.vfA) : zz, rA, kkA, bqA, kpA, lwA, vA, boA);
      ck_elem(C, l, b4_to_f4(R.rB), rcA, b4_to_f4(R.kB), kcA, b4_to_f4(R.vB), vcA, b4_to_f4(R.dwB), b4_to_f4(R.apB), R.knB, l == 1 ? b4_to_f4(R.vmB) : zz, l == 1 ? h4_to_f4(R.vfB) : zz, rB, kkB, bqB, kpB, lwB, vB, boB); }
    { const size_t tA = (size_t)b * SEQ + blk * 32 + 2 * s2;
      boA += __shfl_xor(boA, 1); boA += __shfl_xor(boA, 2); boB += __shfl_xor(boB, 1); boB += __shfl_xor(boB, 2);
      if ((pw >> 1) == half) { if (cq == 0) { float* bp = (float*)(F.ws + WS_BONP) + (tA * 16 + h) * 4 + pw; bp[0] = boA; bp[64] = boB; }
          bf16* Vo = (bf16*)(F.ws + (l == 0 ? WS_V0 : WS_V1)) + tA * 1024 + h * 64 + c0;
          *(u32x2*)Vo = (u32x2){pkh2(vA[0], vA[1]), pkh2(vA[2], vA[3])}; *(u32x2*)(Vo + 1024) = (u32x2){pkh2(vB[0], vB[1]), pkh2(vB[2], vB[3])};
#pragma unroll
          for (int e = 0; e < 4; ++e) *(LAS unsigned*)(BX + CK_VT + (16 * (pw & 1) + 4 * cq + e) * 80 + (2 * s2) * 2) = pkbf(vA[e], vB[e]); } }
    float xkA[4], xkB[4], xrA[4], xrB[4], xbA[4], xbB[4], xpA[4], xpB[4], bhA[4], bhB[4], khA[4], khB[4], gb[4];
#pragma unroll
    for (int e = 0; e < 4; ++e) {
        float x = lwA[e] + lwB[e];
#pragma unroll
        for (int d = 4; d < 64; d <<= 1) { const float y = __shfl_up(x, d); if (lane >= d) x += y; }
        const float LB = x, LA = x - lwB[e], L0 = LA - lwA[e], Lt = __shfl(x, 60 + cq);
        const float eL0 = __expf(L0), eLA = __expf(LA), eLB = __expf(LB), iLA = __expf(-LA), iLB = __expf(-LB), tA = __expf(Lt - LA), tB = __expf(Lt - LB);
        xkA[e] = kkA[e] * eL0; xkB[e] = kkB[e] * eLA; xrA[e] = rA[e] * eLA; xrB[e] = rB[e] * eLB;
        xbA[e] = bqA[e] * iLA; xbB[e] = bqB[e] * iLB; xpA[e] = kpA[e] * iLA; xpB[e] = kpB[e] * iLB;
        bhA[e] = bqA[e] * tA; bhB[e] = bqB[e] * tB; khA[e] = kpA[e] * tA; khB[e] = kpB[e] * tB; gb[e] = __expf(Lt);
    }
    const int oA = (2 * s2) * 144 + cp * 2, oB = oA + 144;
    *(LAS u32x2*)(BX + CK_XK + oA) = (u32x2){pkbf(xkA[0], xkA[1]), pkbf(xkA[2], xkA[3])}; *(LAS u32x2*)(BX + CK_XK + oB) = (u32x2){pkbf(xkB[0], xkB[1]), pkbf(xkB[2], xkB[3])};
    *(LAS u32x2*)(BX + CK_XR + oA) = (u32x2){pkbf(xrA[0], xrA[1]), pkbf(xrA[2], xrA[3])}; *(LAS u32x2*)(BX + CK_XR + oB) = (u32x2){pkbf(xrB[0], xrB[1]), pkbf(xrB[2], xrB[3])};
    *(LAS u32x2*)(BP + CK_XB + oA) = (u32x2){pkbf(xbA[0], xbA[1]), pkbf(xbA[2], xbA[3])}; *(LAS u32x2*)(BP + CK_XB + oB) = (u32x2){pkbf(xbB[0], xbB[1]), pkbf(xbB[2], xbB[3])};
    *(LAS u32x2*)(BP + CK_XP + oA) = (u32x2){pkbf(xpA[0], xpA[1]), pkbf(xpA[2], xpA[3])}; *(LAS u32x2*)(BP + CK_XP + oB) = (u32x2){pkbf(xpB[0], xpB[1]), pkbf(xpB[2], xpB[3])};
    const int i0 = 2 * s2, pst = (i0 & 16) | ((i0 & 4) << 1) | ((i0 & 8) >> 1) | (i0 & 3);
#pragma unroll
    for (int e = 0; e < 4; ++e) { *(LAS unsigned*)(BX + CK_BH + (c0 + e) * 80 + pst * 2) = pkbf(bhA[e], bhB[e]); *(LAS unsigned*)(BX + CK_KH + (c0 + e) * 80 + (2 * s2) * 2) = pkbf(khA[e], khB[e]); }
    if (s2 == 0) *(LAS f32x4*)(BX + CK_GB + c0 * 4) = (f32x4){gb[0], gb[1], gb[2], gb[3]};

}
__device__ __forceinline__ void ck_stage2(const Frame& F, int ti, const LAS unsigned char* BX, const LAS unsigned char* BP, LAS unsigned char* BT) {
    const int r = F.lane & 31, hh = F.lane >> 5;
    const LAS unsigned char* Aa = BP + ((ti < 2) ? CK_XB : CK_XP); const LAS unsigned char* Ba = BX + ((ti & 1) ? CK_XR : CK_XK);
    f32x16 acc;
#pragma unroll
    for (int i = 0; i < 16; ++i) acc[i] = 0.f;
#pragma unroll
    for (int ks = 0; ks < 4; ++ks) acc = CK_MFMA(ck_frag(Aa, 144, r, 16 * ks + 8 * hh), ck_frag(Ba, 144, r, 16 * ks + 8 * hh), acc);
    if (ti == 0) {
#pragma unroll
        for (int reg = 0; reg < 16; ++reg) { const int i = (reg & 3) + 8 * (reg >> 2) + 4 * hh; *(LAS float*)(BT + CK_TB + (i * 32 + r) * 4) = (i < r) ? acc[reg] : 0.f; }
#pragma unroll
        for (int m = 0; m < 4; ++m) { f32x4 t;
#pragma unroll
            for (int e = 0; e < 4; ++e) t[e] = (8 * m + 4 * hh + e < r) ? acc[4 * m + e] : 0.f;
            *(LAS f32x4*)(BT + CK_TBT + (r * 32 + 8 * m + 4 * hh) * 4) = t; }
    } else { const int off = (ti == 1) ? CK_TBR : ((ti == 2) ? CK_TK : CK_TKR);
#pragma unroll
        for (int m = 0; m < 4; ++m) { float t[4];
#pragma unroll
            for (int e = 0; e < 4; ++e) { const int i = 8 * m + 4 * hh + e; const bool keep = (ti == 2) ? (i < r) : (i <= r); t[e] = keep ? acc[4 * m + e] : 0.f; }
            const int col = (ti == 1) ? (16 * (m >> 1) + 8 * hh + 4 * (m & 1)) : (8 * m + 4 * hh);
            *(LAS u32x2*)(BT + off + r * 80 + col * 2) = (u32x2){pkbf(t[0], t[1]), pkbf(t[2], t[3])}; }
    }
    if (ti == 0) {
        LDS_WAIT();
        const LAS float* TBT = (const LAS float*)(BT + CK_TBT);
        float x[32];
        int rr = r; asm volatile("" : "+v"(rr));
#pragma unroll
        for (int k = 0; k < 32; ++k) x[k] = (k == rr) ? 1.f : 0.f;
        { f32x4 tc[8], tn[8];
#pragma unroll
          for (int j4 = 0; j4 < 8; ++j4) tc[j4] = *(const LAS f32x4*)(TBT + 31 * 32 + 4 * j4);
#pragma unroll
          for (int kk = 0; kk < 31; ++kk) { const int k = 31 - kk; const float xk = x[k];
              int off = (k - 1) * 32; asm volatile("" : "+v"(off) : "v"(xk));
              if (k - 1 >= 1) {
#pragma unroll
                  for (int j4 = 0; j4 <= (k - 2) / 4; ++j4) tn[j4] = *(const LAS f32x4*)(TBT + off + 4 * j4); }
#pragma unroll
              for (int j4 = 0; j4 <= (k - 1) / 4; ++j4) {
#pragma unroll
                  for (int e = 0; e < 4; ++e) { const int i = 4 * j4 + e; if (i < k) x[i] = __builtin_fmaf(-tc[j4][e], xk, x[i]); } }
#pragma unroll
              for (int j4 = 0; j4 < 8; ++j4) tc[j4] = tn[j4]; } }
        if (hh == 0) {
#pragma unroll
            for (int q = 0; q < 4; ++q) { u32x4 w;
#pragma unroll
                for (int p = 0; p < 4; ++p) { const int e0 = 2 * p, e1 = 2 * p + 1; w[p] = pkbf(x[16 * (q >> 1) + 8 * (e0 >> 2) + 4 * (q & 1) + (e0 & 3)], x[16 * (q >> 1) + 8 * (e1 >> 2) + 4 * (q & 1) + (e1 & 3)]); }
                *(LAS u32x4*)(BT + CK_MT + r * 80 + q * 16) = w; } }
    }
}
#define CK_BAR() do { asm volatile("s_waitcnt lgkmcnt(0)" ::: "memory"); __builtin_amdgcn_s_barrier(); asm volatile("" ::: "memory"); } while (0)
__device__ __forceinline__ void p4_scan(const Frame& F, int l) {
#pragma unroll 1
    for (int unit = F.vcu; unit < NBATCH * NHEAD * 2; unit += F.G) {
        const int b = unit >> 5, h = (unit >> 1) & 15, half = unit & 1;
        const bool pre = F.wave >= 4, mainw = F.wave == 0;
        const int r = F.lane & 31, hh = F.lane >> 5;
        constexpr int NBLKc = SEQ / 32;
        const int w_ = F.wave;
        if (w_ == 0) {
            f32x16 ST0, ST1;
#pragma unroll
            for (int i = 0; i < 16; ++i) { ST0[i] = 0.f; ST1[i] = 0.f; }
#pragma unroll 1
            for (int blk = -2; blk < NBLKc; ++blk) {
                const LAS unsigned char* BX = F.lds + CK_X3_OFF + ((blk + 3) % 3) * CK_X3SZ; const LAS unsigned char* BT = F.lds + CK_T2_OFF + (blk & 1) * CK_T2SZ;
                bf16x8 SH[2][2], SL[2][2], NUF[2], VF[2]; f32x16 RH, YT;
                if (blk >= 0) {
#pragma unroll
                for (int c = 0; c < 2; ++c)
#pragma unroll
                    for (int s = 0; s < 2; ++s) { u32x4 ph, pl;
#pragma unroll
                        for (int p = 0; p < 4; ++p) { const float x0 = (c ? ST1 : ST0)[8 * s + 2 * p], x1 = (c ? ST1 : ST0)[8 * s + 2 * p + 1]; const unsigned hp = pkbf(x0, x1);
                            ph[p] = hp;
#if defined(CK_LO)
                            pl[p] = pkbf(x0 - bflo(hp), x1 - bfhi(hp));
#endif
                        }
                        SH[c][s] = __builtin_bit_cast(bf16x8, ph);
#if defined(CK_LO)
                        SL[c][s] = __builtin_bit_cast(bf16x8, pl);
#endif
                    }
                { LAS f32x4* stash = (LAS f32x4*)(F.lds + CK_STASH) + F.lane;
#pragma unroll
                  for (int m = 0; m < 4; ++m) { stash[64 * m] = (f32x4){ST0[4 * m], ST0[4 * m + 1], ST0[4 * m + 2], ST0[4 * m + 3]}; stash[64 * (4 + m)] = (f32x4){ST1[4 * m], ST1[4 * m + 1], ST1[4 * m + 2], ST1[4 * m + 3]}; } }
                VF[0] = ck_frag(BX + CK_VT, 80, r, 8 * hh); VF[1] = ck_frag(BX + CK_VT, 80, r, 16 + 8 * hh);
#pragma unroll
                for (int i = 0; i < 16; ++i) RH[i] = 0.f;
                { bf16x8 ak[2][2], at[2];
#pragma unroll
                  for (int c = 0; c < 2; ++c)
#pragma unroll
                      for (int s = 0; s < 2; ++s) ak[c][s] = ck_frag(BX + CK_XK, 144, r, 32 * c + 16 * s + 8 * hh);
                  at[0] = ck_frag(BT + CK_TK, 80, r, 8 * hh); at[1] = ck_frag(BT + CK_TK, 80, r, 16 + 8 * hh);
#pragma unroll
                  for (int c = 0; c < 2; ++c)
#pragma unroll
                      for (int s = 0; s < 2; ++s) RH = CK_MFMA(ak[c][s], SH[c][s], RH);
#pragma unroll
                  for (int ks = 0; ks < 2; ++ks) RH = CK_MFMA(at[ks], VF[ks], RH); }
                { bf16x8 rb[2];
#pragma unroll
                  for (int s = 0; s < 2; ++s) { u32x4 p4;
#pragma unroll
                      for (int p = 0; p < 4; ++p) p4[p] = pkbf(RH[8 * s + 2 * p], RH[8 * s + 2 * p + 1]);
                      rb[s] = __builtin_bit_cast(bf16x8, p4); }
                  f32x16 UT;
#pragma unroll
                  for (int i = 0; i < 16; ++i) UT[i] = 0.f;
#pragma unroll
                  for (int s = 0; s < 2; ++s) UT = CK_MFMA(ck_frag(BT + CK_MT, 80, r, 16 * s + 8 * hh), rb[s], UT);
#pragma unroll
                  for (int s = 0; s < 2; ++s) { u32x4 p4;
#pragma unroll
                      for (int p = 0; p < 4; ++p) p4[p] = pkbf(UT[8 * s + 2 * p], UT[8 * s + 2 * p + 1]) ^ 0x80008000u;
                      NUF[s] = __builtin_bit_cast(bf16x8, p4); } }
#pragma unroll
                for (int i = 0; i < 16; ++i) YT[i] = 0.f;
                { bf16x8 ar[2][2];
#pragma unroll
                  for (int c = 0; c < 2; ++c)
#pragma unroll
                      for (int s = 0; s < 2; ++s) ar[c][s] = ck_frag(BX + CK_XR, 144, r, 32 * c + 16 * s + 8 * hh);
#pragma unroll
                  for (int c = 0; c < 2; ++c)
#pragma unroll
                      for (int s = 0; s < 2; ++s) YT = CK_MFMA(ar[c][s], SH[c][s], YT); }
                VF[0] = ck_frag(BX + CK_VT, 80, r, 8 * hh); VF[1] = ck_frag(BX + CK_VT, 80, r, 16 + 8 * hh);
                asm volatile("" ::: "memory");
#pragma unroll
                for (int ks = 0; ks < 2; ++ks) { const bf16x8 fbr = ck_frag(BT + CK_TBR, 80, r, 16 * ks + 8 * hh), fkr = ck_frag(BT + CK_TKR, 80, r, 16 * ks + 8 * hh); YT = CK_MFMA(fbr, NUF[ks], YT); YT = CK_MFMA(fkr, VF[ks], YT); }
                { bf16* yo = (bf16*)(F.ws + WS_YCK) + ((size_t)b * SEQ + blk * 32) * 1024 + h * 64 + half * 32 + r;
#pragma unroll
                  for (int reg = 0; reg < 16; ++reg) yo[(size_t)((reg & 3) + 8 * (reg >> 2) + 4 * hh) * 1024] = (bf16)f2bf(YT[reg]); }
                { const LAS f32x4* stash = (const LAS f32x4*)(F.lds + CK_STASH) + F.lane;
#pragma unroll
                  for (int m = 0; m < 4; ++m) { const f32x4 g0 = *(const LAS f32x4*)(BX + CK_GB + (8 * m + 4 * hh) * 4), g1 = *(const LAS f32x4*)(BX + CK_GB + (32 + 8 * m + 4 * hh) * 4);
                    const f32x4 a0 = stash[64 * m] * g0, a1 = stash[64 * (4 + m)] * g1;
#pragma unroll
                    for (int e = 0; e < 4; ++e) { ST0[4 * m + e] = a0[e]; ST1[4 * m + e] = a1[e]; } } }
#pragma unroll
                for (int ks = 0; ks < 2; ++ks) {
                    const bf16x8 b0 = ck_frag(BX + CK_BH, 80, r, 16 * ks + 8 * hh), b1 = ck_frag(BX + CK_BH, 80, 32 + r, 16 * ks + 8 * hh), k0 = ck_frag(BX + CK_KH, 80, r, 16 * ks + 8 * hh), k1 = ck_frag(BX + CK_KH, 80, 32 + r, 16 * ks + 8 * hh);
                    ST0 = CK_MFMA(b0, NUF[ks], ST0); ST1 = CK_MFMA(b1, NUF[ks], ST1); ST0 = CK_MFMA(k0, VF[ks], ST0); ST1 = CK_MFMA(k1, VF[ks], ST1); }
                }
                CK_BAR();
            }
        } else if (w_ == 1 || w_ == 2 || w_ == 3 || w_ == 5) {
            const int pw = (w_ == 5) ? 3 : w_ - 1;
            CkConst CC;
            { const int c = l * 1024 + h * 64 + 16 * pw + 4 * (F.lane & 3); const float* mu = kin<I_MU>() + l * N_SHIFT + h * 64 + 16 * pw + 4 * (F.lane & 3);
              CC.a0 = *(const f32x4*)(kin<I_A0>() + c); CC.kk = *(const f32x4*)(kin<I_KK>() + c); CC.ka = *(const f32x4*)(kin<I_KA>() + c); CC.rk = *(const f32x4*)(kin<I_RK>() + c); CC.w0 = *(const f32x4*)(kin<I_W0>() + c);
              CC.v0 = (l == 1) ? *(const f32x4*)(kin<I_V0>() + (c - 1024)) : (f32x4){0.f, 0.f, 0.f, 0.f}; CC.mur = *(const f32x4*)mu; CC.muk = *(const f32x4*)(mu + 1024); CC.muv = *(const f32x4*)(mu + 2048); }
            CkRegs CR;
            ck_issue(F, pw, l, b, h, half, 0, CR);
#pragma unroll 1
            for (int blk = -2; blk < NBLKc; ++blk) {
                if (blk + 2 < NBLKc) ck_stage1(F, pw, l, b, h, half, blk + 2, CC, F.lds + CK_X3_OFF + ((blk + 2 + 3) % 3) * CK_X3SZ, F.lds + CK_P2_OFF + ((blk + 2) & 1) * CK_P2SZ, CR);
                if (blk + 3 < NBLKc) ck_issue(F, pw, l, b, h, half, blk + 3, CR);
                CK_BAR();
            }
        } else {
#pragma unroll 1
            for (int blk = -2; blk < NBLKc; ++blk) {
                if (blk + 1 >= 0 && blk + 1 < NBLKc) {
                    const LAS unsigned char* BX = F.lds + CK_X3_OFF + ((blk + 1 + 3) % 3) * CK_X3SZ; const LAS unsigned char* BP = F.lds + CK_P2_OFF + ((blk + 1) & 1) * CK_P2SZ; LAS unsigned char* BT = F.lds + CK_T2_OFF + ((blk + 1) & 1) * CK_T2SZ;
                    if (w_ == 4) ck_stage2(F, 0, BX, BP, BT);
                    else if (w_ == 6) { ck_stage2(F, 1, BX, BP, BT); ck_stage2(F, 3, BX, BP, BT); }
                    else ck_stage2(F, 2, BX, BP, BT);
                }
                CK_BAR();
            }
        }
    }
}

__device__ __forceinline__ void p5_post(const Frame& F, int l) {
    const int lane = F.lane;
#if defined(DBG_SCAN)
    if (l == 0) { float d2 = 0.f, n2 = 0.f;
#if defined(DBG_CMP_U)
        const bf16* Ya = (const bf16*)(F.ws + WS_V1); const bf16* Yb = (const bf16*)(F.ws + WS_P) + C_VD; const size_t pb = P_LD;
#else
        const bf16* Ya = (const bf16*)(F.ws + WS_Y); const bf16* Yb = (const bf16*)(F.ws + WS_H); const size_t pb = 1024;
#endif
        for (size_t i = (size_t)(F.vcu * NWAVES * 64 + F.tid); i < (size_t)T * 1024; i += (size_t)F.G * NWAVES * 64) { const int t = (int)((i >> 10) & (SEQ - 1));
            if (t >= DBG_T0 && t < DBG_T1) { const float ya = bflo((unsigned)Ya[i]), yb = bflo((unsigned)Yb[(i >> 10) * pb + (i & 1023)]); d2 += (ya - yb) * (ya - yb); n2 += ya * ya; } }
        d2 = wave_sum(d2); n2 = wave_sum(n2);
        if (lane == 0) { atomicAdd((float*)(F.ws + WS_CTL) + 2048, d2); atomicAdd((float*)(F.ws + WS_CTL) + 2049, n2); }
        __syncthreads(); }
#endif
    const float* const pCW = kin<I_CONVW>() + l * 3 * 1024; const float* const pLNW = kin<I_LNW>() + l * 1024; const float* const pLNB = kin<I_LNB>() + l * 1024;
    const bf16* P = (const bf16*)(F.ws + WS_P); const bf16* Y = (const bf16*)(F.ws + WS_Y); const bf16* LRg = (const bf16*)(F.ws + WS_LR) + 2048;
    const bf16* V = (const bf16*)(F.ws + (l == 0 ? WS_V0 : WS_V1)); const float* BONP = (const float*)(F.ws + WS_BONP); bf16* M = (bf16*)(F.ws + WS_H);
#pragma unroll 1
    for (int gw = F.vcu * NWAVES + F.wave; gw < T / 8; gw += F.G * NWAVES) { const int tok0 = gw * 8;
#pragma unroll 1
    for (int ch = 0; ch < 2; ++ch) { const int col0 = 512 * ch + 8 * lane, head = 8 * ch + (lane >> 3);
        float cw0[8], cw1[8], cw2[8], lnw[8], lnb[8], um1[8], um2[8];
#pragma unroll
        for (int j = 0; j < 8; ++j) { cw0[j] = pCW[col0 + j]; cw1[j] = pCW[1024 + col0 + j]; cw2[j] = pCW[2048 + col0 + j];
            lnw[j] = pLNW[col0 + j]; lnb[j] = pLNB[col0 + j]; um1[j] = 0.f; um2[j] = 0.f; }
        const int t0 = tok0 & (SEQ - 1);
        if (t0 >= 1) { float c1[8], c2[8]; load8(P + (size_t)(tok0 - 1) * P_LD + C_CC + col0, c1); load8(P + (size_t)(tok0 - 1) * P_LD + C_CH + col0, c2);
#pragma unroll
            for (int j = 0; j < 8; ++j) um1[j] = c1[j] * c2[j]; }
        if (t0 >= 2) { float c1[8], c2[8]; load8(P + (size_t)(tok0 - 2) * P_LD + C_CC + col0, c1); load8(P + (size_t)(tok0 - 2) * P_LD + C_CH + col0, c2);
#pragma unroll
            for (int j = 0; j < 8; ++j) um2[j] = c1[j] * c2[j]; }
#pragma unroll 2
        for (int tk = 0; tk < 8; ++tk) { const int tok = tok0 + tk; const bf16* pr = P + (size_t)tok * P_LD + col0;
            float c1[8], c2[8], cb[8], ga[8], gb[8], y[8], v[8], g[8], o[8];
            load8(pr + C_CC, c1); load8(pr + C_CH, c2); load8(pr + C_CB, cb); load8(pr + C_GA, ga); load8(pr + C_GB, gb);
            load8(Y + (size_t)tok * 1024 + col0, y); load8h(V + (size_t)tok * 1024 + col0, v); load8(LRg + (size_t)tok * 3072 + col0, g);
            const f32x4 bo4 = *(const f32x4*)(BONP + ((size_t)tok * 16 + head) * 4); const float bo = (bo4[0] + bo4[1]) + (bo4[2] + bo4[3]);
            float sm = 0.f;
#pragma unroll
            for (int j = 0; j < 8; ++j) sm += y[j];
            const float mean = sum8(sm) * (1.0f / 64.0f); float sq = 0.f;
#pragma unroll
            for (int j = 0; j < 8; ++j) { y[j] -= mean; sq += y[j] * y[j]; }
            const float rstd = __builtin_amdgcn_rsqf(sum8(sq) * (1.0f / 64.0f) + LNX_EPS);
#pragma unroll
            for (int j = 0; j < 8; ++j) { const float u = c1[j] * c2[j]; const float conv = cw0[j] * um2[j] + cw1[j] * um1[j] + cw2[j] * u; um2[j] = um1[j]; um1[j] = u;
                const float yconv = cb[j] * conv; const float yr = ((y[j] * rstd) * lnw[j] + lnb[j] + bo * v[j]) * g[j];
                o[j] = sigmoidf_(ga[j]) * yconv + sigmoidf_(gb[j]) * yr; }
            store8(M + (size_t)tok * 1024 + col0, o); }
    }
    }
}

struct GroupPick { float score, a1, a2; int i1, i2; };
__device__ __forceinline__ GroupPick pick_group(const f32x4 acc, float rstd, const float* br, const float* rb) {
    float aff[4], sel[4];
#pragma unroll
    for (int j = 0; j < 4; ++j) { aff[j] = sigmoidf_(rstd * acc[j] + br[j]); sel[j] = aff[j] + rb[j]; }
    int i1 = 0;
#pragma unroll
    for (int j = 1; j < 4; ++j) if (sel[j] > sel[i1]) i1 = j;
    int i2 = (i1 == 0) ? 1 : 0;
#pragma unroll
    for (int j = 0; j < 4; ++j) if (j != i1 && j != i2 && sel[j] > sel[i2]) i2 = j;
    GroupPick g; g.score = sel[i1] + sel[i2]; g.i1 = i1; g.i2 = i2; g.a1 = aff[i1]; g.a2 = aff[i2];
    float s1 = sel[0], s2 = sel[0]; (void)s1; (void)s2;
    return g;
}
__device__ __forceinline__ void p7_route(const Frame& F, int l, bool dry = false) {
    const int lane = F.lane, li = lane & 15, fq = lane >> 4;
    LAS unsigned* lcnt = (LAS unsigned*)(F.lds + 65536);
    const float* X = (const float*)(F.ws + WS_X); const float* WrT = (const float*)(F.ws + WS_WRT); const float* const pN2G = kin<I_N2G>() + l * 1024; const float* const pRB = kin<I_RB>();
#pragma unroll 1
    for (int gw = F.vcu * NWAVES + F.wave; gw < T / 8; gw += F.G * NWAVES) { const int tok0 = gw * 8, b = tok0 >> 11;
        if (F.tid < 32) lcnt[F.tid] = 0u;
        __syncthreads();
        const float* ad = ada_ptr(F, l, b);
        const float* xp = X + (size_t)(tok0 + (li & 7)) * 1024 + 4 * fq; const float* g1p = pN2G + 4 * fq; const float* g2p = ad + 4096 + 4 * fq; const float* w0p = WrT + li * 1024 + 4 * fq; const float* w1p = w0p + 16 * 1024;
        f32x4 acc0 = (f32x4){0.f, 0.f, 0.f, 0.f}, acc1 = acc0; float ssq = 0.f;
#pragma unroll 4
        for (int kb = 0; kb < 1024; kb += 16) {
            const f32x4 xv = *(const f32x4*)(xp + kb), gv = *(const f32x4*)(g1p + kb) * (1.0f + *(const f32x4*)(g2p + kb)), w0 = *(const f32x4*)(w0p + kb), w1 = *(const f32x4*)(w1p + kb);
            ssq += (xv[0] * xv[0] + xv[1] * xv[1]) + (xv[2] * xv[2] + xv[3] * xv[3]);
            const f32x4 xg = xv * gv;
#pragma unroll
            for (int jj = 0; jj < 4; ++jj) { acc0 = __builtin_amdgcn_mfma_f32_16x16x4f32(w0[jj], xg[jj], acc0, 0, 0, 0); acc1 = __builtin_amdgcn_mfma_f32_16x16x4f32(w1[jj], xg[jj], acc1, 0, 0, 0); }
        }
        ssq += __shfl_xor(ssq, 16); ssq += __shfl_xor(ssq, 32);
        const float rstd = __builtin_amdgcn_rsqf(ssq * (1.0f / 1024.0f) + NORM_EPS);
        const float* br = (const float*)(F.ws + WS_CTL + CTL_BIASR) + (l * 8 + b) * 32;
        const GroupPick ga = pick_group(acc0, rstd, br + 4 * fq, pRB + 4 * fq), gb = pick_group(acc1, rstd, br + 16 + 4 * fq, pRB + 16 + 4 * fq);
        const bool useb = gb.score > ga.score;
        const GroupPick gm = useb ? gb : ga; const int mygrp = useb ? 4 + fq : fq;
        float bs = gm.score; int bg = mygrp;
#pragma unroll
        for (int off = 16; off < 64; off <<= 1) { const float os = __shfl_xor(bs, off); const int og = __shfl_xor(bg, off); if (os > bs || (os == bs && og < bg)) { bs = os; bg = og; } }
        if (mygrp == bg && li < 8) { const int tok = tok0 + li; const int e0 = 4 * bg + gm.i1, e1 = 4 * bg + gm.i2; const float inv = 1.0f / (gm.a1 + gm.a2);
            const int p0 = (int)__hip_atomic_fetch_add(lcnt + e0, 1u, __ATOMIC_RELAXED, __HIP_MEMORY_SCOPE_WORKGROUP), p1 = (int)__hip_atomic_fetch_add(lcnt + e1, 1u, __ATOMIC_RELAXED, __HIP_MEMORY_SCOPE_WORKGROUP);
            int* EI = (int*)(F.ws + WS_EIDX); int* PO = (int*)(F.ws + WS_POS); float* WT = (float*)(F.ws + WS_WTS);
            if (!dry) { EI[tok * 2] = e0; EI[tok * 2 + 1] = e1; PO[tok * 2] = p0; PO[tok * 2 + 1] = p1; WT[tok * 2] = gm.a1 * inv; WT[tok * 2 + 1] = gm.a2 * inv; } }
        __syncthreads();
        if (F.tid < 32 && !dry) ((int*)(F.ws + WS_HIST))[(l * 256 + (gw >> 3)) * 32 + F.tid] = (int)lcnt[F.tid];
        __syncthreads();
    }
}

__device__ __forceinline__ void expert_table(const Frame& F, int l, int grp = -1) {
    LAS int* tab = (LAS int*)(F.lds + TAB_OFF); LAS int* red = (LAS int*)F.lds;
    const int* hist = (const int*)(F.ws + WS_HIST) + l * 256 * 32; const int e = F.tid & 31, part = F.tid >> 5;
    int tot = 0, pre = 0;
#pragma unroll 4
    for (int g = part * 16; g < part * 16 + 16; ++g) { const int v = hist[g * 32 + e]; tot += v; pre += (g < grp) ? v : 0; }
    red[part * 32 + e] = tot; red[512 + part * 32 + e] = pre;
    __syncthreads();
    if (F.tid < 64) { int c = 0, pr = 0;
#pragma unroll
        for (int p = 0; p < 16; ++p) { c += red[p * 32 + e]; pr += red[512 + p * 32 + e]; }
        const int padded = (c + 255) & ~255; int inc = padded;
#pragma unroll
        for (int o = 1; o < 32; o <<= 1) { const int v = __shfl_up(inc, o); if (e >= o) inc += v; }
        if (F.lane < 32) { tab[e] = inc - padded; tab[33 + e] = (inc - padded) >> 8; tab[66 + e] = inc - padded + pr; if (e == 31) { tab[32] = inc; tab[65] = inc >> 8; } } }
    __syncthreads();
}

__device__ __forceinline__ void p8_dispatch(const Frame& F, int l) {
    const LAS int* tab = (const LAS int*)(F.lds + TAB_OFF);
    const float* const pN2G = kin<I_N2G>() + l * 1024;
    const int lane = F.lane;
#pragma unroll 1
    for (int gw = F.vcu * NWAVES + F.wave; gw < T / 8; gw += F.G * NWAVES) { const int tok0 = gw * 8, b = tok0 >> 11;
        expert_table(F, l, gw >> 3);
        const float* ad = ada_ptr(F, l, b); f32x4 gm[4], sh[4];
#pragma unroll
        for (int j = 0; j < 4; ++j) { const int c = 4 * lane + 256 * j; gm[j] = *(const f32x4*)(pN2G + c) * (1.0f + *(const f32x4*)(ad + 4096 + c)); sh[j] = *(const f32x4*)(ad + 3072 + c); }
        const float* X = (const float*)(F.ws + WS_X); const int* EI = (const int*)(F.ws + WS_EIDX); const int* PO = (const int*)(F.ws + WS_POS); int* SL = (int*)(F.ws + WS_SLOT); bf16* BUF = (bf16*)(F.ws + WS_BUF);
        for (int tk = 0; tk < 8; ++tk) { const int tok = tok0 + tk; f32x4 v[4]; float ss = 0.f;
#pragma unroll
            for (int j = 0; j < 4; ++j) { v[j] = *(const f32x4*)(X + (size_t)tok * 1024 + 4 * lane + 256 * j); ss += (v[j][0] * v[j][0] + v[j][1] * v[j][1]) + (v[j][2] * v[j][2] + v[j][3] * v[j][3]); }
            const float rstd = __builtin_amdgcn_rsqf(wave_sum(ss) * (1.0f / 1024.0f) + NORM_EPS);
            const int s0 = tab[66 + EI[tok * 2]] + PO[tok * 2], s1 = tab[66 + EI[tok * 2 + 1]] + PO[tok * 2 + 1];
            if (lane == 0) { SL[tok * 2] = s0; SL[tok * 2 + 1] = s1; }
#pragma unroll
            for (int j = 0; j < 4; ++j) { const f32x4 h = v[j] * rstd * gm[j] + sh[j]; u32x2 w; w.x = pk2(h[0], h[1]); w.y = pk2(h[2], h[3]);
                *(u32x2*)(BUF + (size_t)s0 * 1024 + 4 * lane + 256 * j) = w; *(u32x2*)(BUF + (size_t)s1 * 1024 + 4 * lane + 256 * j) = w; } }
    }
}

#ifndef PHMASK
#define PHMASK 0xFFFF
#endif
#define PHM(n) (((PHMASK) >> (n)) & 1)
constexpr int NPHASES = 25;
__global__ void __launch_bounds__(NWAVES * 64, 2) trunk_fwd(Args args) {
    extern __shared__ __attribute__((aligned(16))) unsigned char lds_raw[];
    Frame F;
    F.lds = (LAS unsigned char*)lds_raw;
    F.tid = threadIdx.x; F.lane = F.tid & 63; F.wave = __builtin_amdgcn_readfirstlane(F.tid >> 6);
    F.G = gridDim.x; { const int bx = blockIdx.x; F.vcu = (F.G % 8 == 0) ? (bx % 8) * (F.G / 8) + bx / 8 : bx; }
    GAS unsigned char* const wsbase = (GAS unsigned char*)kin<29>(); F.ws = wsbase; const int vcu0 = F.vcu;
    volatile LAS unsigned* MISC = (volatile LAS unsigned*)(F.lds + MISC_OFF);
    if (F.tid < 32) MISC[F.tid] = 0u;
    __syncthreads();
    const unsigned long long lohi = (unsigned long long)kin<30>(); const int lo = (int)(unsigned)lohi, hi = (int)(unsigned)(lohi >> 32);
    XcdBarrier bar; bar.bar = (unsigned*)(F.ws + WS_CTL) + CW_BAR; bar.x = 0; bar.st = nullptr;
    if (hi - lo > 1) bar = xcd_barrier_post((unsigned*)(F.ws + WS_CTL) + CW_BAR, MISC + 8);
#pragma unroll 1
#if defined(REP_PH)
    for (int phx = lo; phx < hi + REP_N; ++phx) { const int ph = (phx <= REP_PH) ? phx : ((phx - REP_N > REP_PH) ? phx - REP_N : REP_PH);
#else
    for (int ph = lo; ph < hi; ++ph) {
#endif
        { int t_ = threadIdx.x; asm volatile("" : "+v"(t_)); F.tid = t_; F.lane = t_ & 63; F.wave = __builtin_amdgcn_readfirstlane(t_ >> 6);
          GAS unsigned char* w_ = wsbase; asm volatile("" : "+s"(w_)); F.ws = w_; int v_ = vcu0; asm volatile("" : "+s"(v_)); F.vcu = v_; }
        const int l = (ph - 2) / 11, k = (ph >= 2 && ph <= 23) ? (ph - 2) % 11 : -1;
        if (PHM(0) && ph == 0) p0_prologue(F);
        else if (PHM(0) && ph == 1) p0b_ada_reduce(F);
        else if (PHM(1) && ph == 24) p1_norm<2>(F, 1);
        else if (PHM(1) && k == 0) { if (l == 0) p1_norm<0>(F, 0); else p1_norm<1>(F, 1); }
        else if (PHM(3) && k == 2) p2b_lra(F, l);
        #if defined(DBG_SCAN)
        else if (PHM(4) && k == 4) { p4_scan_seq(F, l); __syncthreads(); if (l == 0) p4_scan(F, l); }
#else
        else if (PHM(4) && k == 4) p4_scan(F, l);
#endif
        else if (PHM(5) && k == 5) p5_post(F, l);
        #if defined(REP_PH)
        else if (PHM(7) && k == 7) p7_route(F, l, phx > REP_PH && ph == REP_PH);
#else
        else if (PHM(7) && k == 7) p7_route(F, l);
#endif
        else if (PHM(8) && k == 8) p8_dispatch(F, l);
        else if (PHM(2) && (k == 1 || k == 3 || k == 6 || k == 9 || k == 10)) {
            pg8::Gemm g; pg8::UniOrder S; pg8::EpiUni E;
            S.expert = (k >= 9); S.so.init(T, 1024, F.G, (int)blockIdx.x); S.eo = pg8::ExpertOrder{(const PG8_LAS int*)(F.lds + TAB_OFF + 33 * 4), 0, F.G, (int)blockIdx.x};
            E.e0 = pg8::EpiBf16Plain{(bf16*)(F.ws + WS_P), P_LD, -1}; E.e1 = pg8::EpiResid{nullptr, (float*)(F.ws + WS_X), ada_ptr(F, l, 0) + 2048, 6144}; E.e2 = pg8::EpiSwiGLU{(bf16*)(F.ws + WS_HB)};
            if (k == 1) {
                const int N = (l == 0) ? N_IN : P_LD; S.so.init(T, N, F.G, (int)blockIdx.x); E.mode = 0;
                g = pg8::Gemm{(const bf16*)(F.ws + WS_H), (const bf16*)(F.ws + WS_BT_IN) + (size_t)l * P_LD * 1024, T, N, 1024};
            } else if (k == 3) {
                S.so.init(T, 3072, F.G, (int)blockIdx.x); E.mode = 0; E.e0 = pg8::EpiBf16Plain{(bf16*)(F.ws + WS_LR), 3072, -1};
                g = pg8::Gemm{(const bf16*)(F.ws + WS_ALR), (const bf16*)(F.ws + WS_BT_LR) + (size_t)l * 3072 * 256, T, 3072, 256};
            } else if (k == 6) {
                E.mode = 1; E.e1.xin = (l == 0) ? kin<I_X>() : (const float*)(F.ws + WS_X);
                g = pg8::Gemm{(const bf16*)(F.ws + WS_H), (const bf16*)(F.ws + WS_BT_OUT) + (size_t)l * 1024 * 1024, T, 1024, 1024};
            } else {
                expert_table(F, l);
                S.eo.ntiles = ((const LAS int*)(F.lds + TAB_OFF))[65];
                if (k == 9) { E.mode = 2; g = pg8::Gemm{(const bf16*)(F.ws + WS_BUF), (const bf16*)(F.ws + WS_BT_E1) + (size_t)l * 32 * 1024 * 1024, MAXROWS, 32 * 1024, 1024}; }
                else { E.mode = 0; E.e0 = pg8::EpiBf16Plain{(bf16*)(F.ws + WS_YE), 1024, 3}; g = pg8::Gemm{(const bf16*)(F.ws + WS_HB), (const bf16*)(F.ws + WS_BT_E2) + (size_t)l * 32 * 1024 * 512, MAXROWS, 32 * 1024, 512}; }
            }
            pg8::gemm_phase<pg8::EpiUni, pg8::UniOrder, true, true>(F.lds, g, S, E);
        }
#if defined(REP_PH)
        if (phx + 1 < hi + REP_N) xcd_barrier(bar);
#else
        if (ph + 1 < hi) xcd_barrier(bar);
#endif
    }
}

extern "C" void kernel_launch(void* const* d_in, const int* in_sizes, int n_in, void* d_out, int out_size, void* d_ws, size_t ws_size, hipStream_t stream) {
    static int grid = 0;
    if (grid == 0) {
        if (n_in != 28 || in_sizes[0] != T * D || out_size != T * D || ws_size < WS_END) { fprintf(stderr, "kernel_launch: unexpected shapes (n_in %d, in0 %d, out %d, ws %zu < %zu?); nothing launched\n", n_in, n_in > 0 ? in_sizes[0] : -1, out_size, ws_size, (size_t)WS_END); grid = -1; return; }
        int dev = 0, cus = 0, per_cu = 0;
        if (hipGetDevice(&dev) != hipSuccess || hipDeviceGetAttribute(&cus, hipDeviceAttributeMultiprocessorCount, dev) != hipSuccess) { fprintf(stderr, "kernel_launch: device query failed\n"); grid = -1; return; }
        if (hipFuncSetAttribute((const void*)trunk_fwd, hipFuncAttributeMaxDynamicSharedMemorySize, LDS_BYTES) != hipSuccess) { fprintf(stderr, "kernel_launch: hipFuncSetAttribute failed\n"); grid = -1; return; }
        if (hipOccupancyMaxActiveBlocksPerMultiprocessor(&per_cu, (const void*)trunk_fwd, NWAVES * 64, LDS_BYTES) != hipSuccess || per_cu < 1) { fprintf(stderr, "kernel_launch: occupancy query says %d blocks per CU\n", per_cu); }
        (void)hipGetLastError();
        grid = cus;
    }
    if (grid < 0) return;
    if (hipMemsetAsync((char*)d_ws + WS_CTL, 0, CTL_ZERO_BYTES, stream) != hipSuccess) { fprintf(stderr, "kernel_launch: memset failed\n"); return; }
    Args a{};
    for (int i = 0; i < 28; ++i) a.p[i] = d_in[i];
    a.p[28] = d_out; a.p[29] = d_ws;
#if MK_ONE_LAUNCH
    a.ph_lo = 0; a.ph_hi = NPHASES;
    void* kargs[] = {&a};
    hipError_t e = hipLaunchCooperativeKernel((const void*)trunk_fwd, dim3(grid), dim3(NWAVES * 64), kargs, LDS_BYTES, stream);
    if (e != hipSuccess) fprintf(stderr, "kernel_launch: cooperative launch failed: %s (grid %d)\n", hipGetErrorString(e), grid);
#else
    for (int p = 0; p < NPHASES; ++p) { a.ph_lo = p; a.ph_hi = p + 1;
        hipLaunchKernelGGL(trunk_fwd, dim3(grid), dim3(NWAVES * 64), LDS_BYTES, stream, a);
        const hipError_t le = hipPeekAtLastError(); if (le != hipSuccess) { fprintf(stderr, "kernel_launch: launch %d failed: %s\n", p, hipGetErrorName(le)); break; } }
#endif
}
```

```cpp
#include <hip/hip_runtime.h>
#include <cstdio>
#include <cstdint>

#ifndef MK_ONE_LAUNCH
#define MK_ONE_LAUNCH 1
#endif

namespace pg8 {
#define PG8_LAS __attribute__((address_space(3)))
typedef unsigned short bf16_t;
typedef short bf16x8 __attribute__((ext_vector_type(8)));
typedef float f32x4 __attribute__((ext_vector_type(4)));
typedef unsigned u32x4 __attribute__((ext_vector_type(4)));
constexpr int BM = 256, BK = 64, HALF = 128, HTB = HALF * BK * 2  , STAGE_BYTES = 8 * HTB, NXCD = 8, WGM = 8;

__host__ __device__ __forceinline__ int lds_byte(int r, int c) { const int st = (r >> 4) * 2 + (c >> 5), rr = r & 15, cc = c & 31, ob = rr * 64 + cc * 2; return st * 1024 + (ob ^ (((ob >> 9) & 1) << 5)); }
__host__ __device__ __forceinline__ void stage_rc(int b, int& R, int& C) { const int st = b / 1024, sb = b % 1024, swz = sb ^ (((sb >> 9) & 1) << 5); R = (st >> 1) * 16 + swz / 64; C = (st & 1) * 32 + (swz % 64) / 2; }
__host__ __device__ __forceinline__ int perm32(int rho) { const int n = rho >> 4, i = rho & 15; return 8 * (i >> 2) + 4 * n + (i & 3); }

struct Unit { int pm, pn; };
struct Gemm { const bf16_t* A; const bf16_t* Bt; int M, N, K; };

struct StaticOrder {
    int nM, nN, nwg, G, c;
    __host__ __device__ void init(int M, int N, int G_, int c_) { nM = M / BM; nN = N / BM; nwg = nM * nN; G = G_; c = c_; }
    __host__ __device__ bool next(int i, Unit& u) const {
        const long L = (long)i * G + c; if (L >= nwg) return false;
        int wgid = (int)L; { const int q = nwg / NXCD, r = nwg % NXCD, xcd = wgid % NXCD, off = wgid / NXCD; wgid = (xcd < r ? xcd * (q + 1) : r * (q + 1) + (xcd - r) * q) + off; }
        const int nig = WGM * nN, gid = wgid / nig, fm = gid * WGM, gsz = (nM - fm) < WGM ? (nM - fm) : WGM;
        u.pm = fm + ((wgid % nig) % gsz); u.pn = (wgid % nig) / gsz; return true;
    }
    __device__ __forceinline__ void a_ready(const Unit&) const {}
    __device__ __forceinline__ void done(const Unit&) const {}
};
__device__ __forceinline__ unsigned cvt_pk_bf16(float lo, float hi) { unsigned r; asm volatile("v_cvt_pk_bf16_f32 %0, %1, %2" : "=v"(r) : "v"(lo), "v"(hi)); return r; }
typedef float f32x2 __attribute__((ext_vector_type(2)));
typedef unsigned u32x2 __attribute__((ext_vector_type(2)));

struct EpiBf16Plain {
    static constexpr bool PERM = true, AFTER_DRAIN = false;
    bf16_t* O; int ldc; int cmask;
    __device__ __forceinline__ void operator()(const f32x4 (&acc)[2][2][4][2], const Unit& u, int wr, int wc, int fr, int fq) const {
        const int row0 = u.pm * BM + wr * 64 + fr; const int col0 = (u.pn & cmask) * BM + wc * 32 + 8 * fq;
#pragma unroll
        for (int ai = 0; ai < 2; ++ai)
#pragma unroll
            for (int m = 0; m < 4; ++m) { bf16_t* rowp = O + (size_t)(row0 + ai * HALF + m * 16) * ldc + col0;
#pragma unroll
                for (int bj = 0; bj < 2; ++bj) { const f32x4 v0 = acc[ai][bj][m][0], v1 = acc[ai][bj][m][1];
                    u32x4 w; w.x = cvt_pk_bf16(v0[0], v0[1]); w.y = cvt_pk_bf16(v0[2], v0[3]); w.z = cvt_pk_bf16(v1[0], v1[1]); w.w = cvt_pk_bf16(v1[2], v1[3]);
                    *(u32x4*)(rowp + bj * HALF) = w; } }
    }
};
struct EpiResid {
    static constexpr bool PERM = false, AFTER_DRAIN = false;
    const float* xin; float* xout; const float* gate;
    int gstride;
    __device__ __forceinline__ void operator()(const f32x4 (&acc)[2][2][4][2], const Unit& u, int wr, int wc, int fr, int fq) const {
        const int row0 = u.pm * BM + wr * 64 + fr, col0 = u.pn * BM + wc * 32 + 4 * fq;
        const float* gp = gate + (size_t)(u.pm >> 3) * gstride;
        f32x4 gv[2][2];
#pragma unroll
        for (int bj = 0; bj < 2; ++bj)
#pragma unroll
            for (int n = 0; n < 2; ++n) gv[bj][n] = *(const f32x4*)(gp + col0 + bj * HALF + n * 16);
#pragma unroll
        for (int ai = 0; ai < 2; ++ai)
#pragma unroll
            for (int m = 0; m < 4; ++m) { const size_t ro = (size_t)(row0 + ai * HALF + m * 16) * 1024 + col0;
#pragma unroll
                for (int bj = 0; bj < 2; ++bj)
#pragma unroll
                    for (int n = 0; n < 2; ++n) { const f32x4 xi = *(const f32x4*)(xin + ro + bj * HALF + n * 16);
                        *(f32x4*)(xout + ro + bj * HALF + n * 16) = xi + gv[bj][n] * acc[ai][bj][m][n]; }
                asm volatile("" ::: "memory"); }
    }
};
struct EpiSwiGLU {
    static constexpr bool PERM = false, AFTER_DRAIN = false;
    bf16_t* O;
    __device__ __forceinline__ void operator()(const f32x4 (&acc)[2][2][4][2], const Unit& u, int wr, int wc, int fr, int fq) const {
        const int row0 = u.pm * BM + wr * 64 + fr, col0 = (u.pn & 3) * HALF + wc * 32 + 4 * fq;
#pragma unroll
        for (int ai = 0; ai < 2; ++ai)
#pragma unroll
            for (int m = 0; m < 4; ++m) { bf16_t* rowp = O + (size_t)(row0 + ai * HALF + m * 16) * 512 + col0;
#pragma unroll
                for (int n = 0; n < 2; ++n) { const f32x4 g = acc[ai][0][m][n], up = acc[ai][1][m][n]; f32x4 h;
#pragma unroll
                    for (int j = 0; j < 4; ++j) h[j] = g[j] * __builtin_amdgcn_rcpf(1.0f + __expf(-g[j])) * up[j];
                    u32x2 w; w.x = cvt_pk_bf16(h[0], h[1]); w.y = cvt_pk_bf16(h[2], h[3]);
                    *(u32x2*)(rowp + n * 16) = w; } }
    }
};
struct ExpertOrder {
    const PG8_LAS int* ts; int ntiles, G, c;
    __device__ __forceinline__ bool next(int i, Unit& u) const {
        const int L = i * G + c; if (L >= ntiles * 4) return false;
        const int pm = L >> 2; int e = 0;
#pragma unroll 1
        for (int k = 1; k < 32; ++k) e += (ts[k] <= pm) ? 1 : 0;
        u.pm = pm; u.pn = e * 4 + (L & 3); return true;
    }
    __device__ __forceinline__ void a_ready(const Unit&) const {}
    __device__ __forceinline__ void done(const Unit&) const {}
};

struct UniOrder {
    StaticOrder so; ExpertOrder eo; bool expert;
    __device__ __forceinline__ bool next(int i, Unit& u) const { return expert ? eo.next(i, u) : so.next(i, u); }
    __device__ __forceinline__ void a_ready(const Unit&) const {}
    __device__ __forceinline__ void done(const Unit&) const {}
};
struct EpiUni {
    static constexpr bool AFTER_DRAIN = false;
    int mode; EpiBf16Plain e0; EpiResid e1; EpiSwiGLU e2;
    __device__ __forceinline__ bool perm() const { return mode == 0; }
    __device__ __forceinline__ void operator()(const f32x4 (&acc)[2][2][4][2], const Unit& u, int wr, int wc, int fr, int fq) const {
        if (mode == 0) e0(acc, u, wr, wc, fr, fq); else if (mode == 1) e1(acc, u, wr, wc, fr, fq); else e2(acc, u, wr, wc, fr, fq);
    }
};
template <class Epi, class Sched, bool ALIGN_EPI = false, bool SP2 = false>
__device__ __forceinline__ void gemm_phase(PG8_LAS unsigned char* lds, const Gemm g, const Sched& S, const Epi& E) {
    int tid_ = threadIdx.x; asm volatile("" : "+v"(tid_));
    const int tid = tid_, wid = __builtin_amdgcn_readfirstlane(tid >> 6), lane = tid & 63, wr = wid >> 2, wc = wid & 3, fr = lane & 15, fq = lane >> 4;
    const int K = g.K, nt = K / BK;
    unsigned voffA[2], voffB[2];
#pragma unroll
    for (int i = 0; i < 2; ++i) { int R, C; stage_rc(tid * 16 + i * 8192, R, C); const int Rb = E.perm() ? ((R & ~31) + perm32(R & 31)) : R;
        voffA[i] = (unsigned)(R * K + C) * 2u; voffB[i] = (unsigned)(Rb * K + C) * 2u; }
    const size_t kstep = (size_t)(BK * 2);
    const size_t hstep = (size_t)HALF * K * 2;
    const size_t tstep = 2 * hstep;
    const unsigned ldsw = (unsigned)wid * 1024u;
    const int aoff = lds_byte(wr * 64 + fr, fq * 8), boff = lds_byte(wc * 32 + fr, fq * 8);
#define PG8_SA(b, h) (((b) * 2 + (h)) * HTB)
#define PG8_SB(b, h) ((4 + (b) * 2 + (h)) * HTB)
#define PG8_STAGE(bufoff, gbase, voff) do { _Pragma("unroll") for (int _i = 0; _i < 2; ++_i) \
        __builtin_amdgcn_global_load_lds((const unsigned*)((const char*)(gbase) + (voff)[_i]), (PG8_LAS unsigned*)(lds + (bufoff) + ldsw + _i * 8192), 16, 0, 0); } while (0)
#define PG8_LDA(dst, b, h) do { _Pragma("unroll") for (int m = 0; m < 4; ++m) _Pragma("unroll") for (int k = 0; k < 2; ++k) dst[m][k] = *(const PG8_LAS bf16x8*)(lds + PG8_SA(b, h) + aoff + m * 2048 + k * 1024); } while (0)
#define PG8_LDB(dst, b, h) do { _Pragma("unroll") for (int n = 0; n < 2; ++n) _Pragma("unroll") for (int k = 0; k < 2; ++k) dst[n][k] = *(const PG8_LAS bf16x8*)(lds + PG8_SB(b, h) + boff + n * 2048 + k * 1024); } while (0)
#define PG8_MMA(ai, bj, At, Bt) do { __builtin_amdgcn_s_setprio(1); _Pragma("unroll") for (int m = 0; m < 4; ++m) _Pragma("unroll") for (int n = 0; n < 2; ++n) _Pragma("unroll") for (int k = 0; k < 2; ++k) \
        acc[ai][bj][m][n] = __builtin_amdgcn_mfma_f32_16x16x32_bf16(Bt[n][k], At[m][k], acc[ai][bj][m][n], 0, 0, 0); __builtin_amdgcn_s_setprio(0); } while (0)
#define PG8_WAIT_V(n) asm volatile("s_waitcnt vmcnt(" #n ")" ::: "memory")
#define PG8_WAIT_L(n) asm volatile("s_waitcnt lgkmcnt(" #n ")" ::: "memory")
#define PG8_BAR __builtin_amdgcn_s_barrier()
#define PG8_SCHED __builtin_amdgcn_sched_barrier(0)
    Unit cur, nxt; int ui = 0;
    if (!S.next(0, cur)) return;
    f32x4 acc[2][2][4][2];
#pragma unroll
    for (int a = 0; a < 2; ++a)
#pragma unroll
        for (int b = 0; b < 2; ++b)
#pragma unroll
            for (int m = 0; m < 4; ++m)
#pragma unroll
                for (int n = 0; n < 2; ++n) acc[a][b][m][n] = (f32x4){0.f, 0.f, 0.f, 0.f};
    bf16x8 At[4][2], B0[2][2], B1[2][2];
    const char* cA = (const char*)g.A + (size_t)cur.pm * tstep; const char* cB = (const char*)g.Bt + (size_t)cur.pn * tstep;
    S.a_ready(cur);
    if constexpr (SP2) {
        PG8_STAGE(PG8_SB(0, 0), cB, voffB); PG8_STAGE(PG8_SB(0, 1), cB + hstep, voffB); PG8_STAGE(PG8_SA(0, 0), cA, voffA); PG8_STAGE(PG8_SA(0, 1), cA + hstep, voffA);
        if (wr == 1) PG8_BAR;
        PG8_WAIT_V(2); PG8_BAR;
        PG8_STAGE(PG8_SB(1, 0), cB + kstep, voffB); PG8_STAGE(PG8_SA(1, 0), cA + kstep, voffA); PG8_STAGE(PG8_SB(1, 1), cB + hstep + kstep, voffB);
        PG8_WAIT_V(6); PG8_BAR;
    } else {
        PG8_STAGE(PG8_SB(0, 0), cB, voffB); PG8_STAGE(PG8_SA(0, 0), cA, voffA); PG8_STAGE(PG8_SB(0, 1), cB + hstep, voffB); PG8_STAGE(PG8_SA(0, 1), cA + hstep, voffA);
        if (wr == 1) PG8_BAR;
        PG8_WAIT_V(4); PG8_BAR;
        PG8_STAGE(PG8_SB(1, 0), cB + kstep, voffB); PG8_STAGE(PG8_SA(1, 0), cA + kstep, voffA); PG8_STAGE(PG8_SB(1, 1), cB + hstep + kstep, voffB);
        PG8_WAIT_V(6); PG8_BAR;
    }
    for (;;) {
        const bool has_next = S.next(ui + 1, nxt);
        const char* nA = has_next ? (const char*)g.A + (size_t)nxt.pm * tstep : cA; const char* nB = has_next ? (const char*)g.Bt + (size_t)nxt.pn * tstep : cB;
        for (int t = 0; t < nt; t += 2) {
            const bool last = (t == nt - 2);
            const char* a1 = cA + (size_t)(t + 1) * kstep;
            const char* a2 = last ? nA : cA + (size_t)(t + 2) * kstep; const char* b2 = last ? nB : cB + (size_t)(t + 2) * kstep;
            const char* a3 = a2 + kstep; const char* b3 = b2 + kstep;
            if (last && has_next) S.a_ready(nxt);
            if constexpr (SP2) {
            PG8_LDB(B0, 0, 0); PG8_LDB(B1, 0, 1); PG8_SCHED; PG8_LDA(At, 0, 0); PG8_STAGE(PG8_SA(1, 1), a1 + hstep, voffA);
            PG8_WAIT_V(8); PG8_WAIT_L(0); PG8_BAR; PG8_MMA(0, 0, At, B0); PG8_MMA(0, 1, At, B1); PG8_BAR; PG8_SCHED;
            PG8_LDA(At, 0, 1); PG8_STAGE(PG8_SB(0, 0), b2, voffB); PG8_STAGE(PG8_SB(0, 1), b2 + hstep, voffB); PG8_STAGE(PG8_SA(0, 0), a2, voffA);
            PG8_WAIT_V(8); PG8_WAIT_L(0); PG8_BAR; PG8_MMA(1, 0, At, B0); PG8_MMA(1, 1, At, B1); PG8_BAR; PG8_SCHED;
            PG8_LDB(B0, 1, 0); PG8_LDB(B1, 1, 1); PG8_SCHED; PG8_LDA(At, 1, 0); PG8_STAGE(PG8_SA(0, 1), a2 + hstep, voffA);
            PG8_WAIT_V(8); PG8_WAIT_L(0); PG8_BAR; PG8_MMA(0, 0, At, B0); PG8_MMA(0, 1, At, B1); PG8_BAR; PG8_SCHED;
            PG8_LDA(At, 1, 1); PG8_STAGE(PG8_SB(1, 0), b3, voffB); PG8_STAGE(PG8_SB(1, 1), b3 + hstep, voffB); PG8_STAGE(PG8_SA(1, 0), a3, voffA);
            PG8_WAIT_V(8); PG8_WAIT_L(0); PG8_BAR; PG8_MMA(1, 0, At, B0); PG8_MMA(1, 1, At, B1); PG8_BAR; PG8_SCHED;
            } else {
            PG8_LDB(B0, 0, 0); PG8_SCHED; PG8_LDA(At, 0, 0); PG8_STAGE(PG8_SA(1, 1), a1 + hstep, voffA);
            PG8_WAIT_L(8); PG8_BAR; PG8_WAIT_L(0); PG8_MMA(0, 0, At, B0); PG8_BAR; PG8_SCHED;
            PG8_LDB(B1, 0, 1); PG8_STAGE(PG8_SB(0, 0), b2, voffB);
            PG8_BAR; PG8_WAIT_L(0); PG8_MMA(0, 1, At, B1); PG8_BAR;
            PG8_LDA(At, 0, 1); PG8_STAGE(PG8_SA(0, 0), a2, voffA);
            PG8_BAR; PG8_WAIT_L(0); PG8_MMA(1, 0, At, B0); PG8_BAR; PG8_SCHED;
            PG8_STAGE(PG8_SB(0, 1), b2 + hstep, voffB);
            PG8_WAIT_V(6); PG8_BAR; PG8_MMA(1, 1, At, B1); PG8_BAR;
            PG8_LDB(B0, 1, 0); PG8_SCHED; PG8_LDA(At, 1, 0); PG8_STAGE(PG8_SA(0, 1), a2 + hstep, voffA);
            PG8_WAIT_L(8); PG8_BAR; PG8_WAIT_L(0); PG8_MMA(0, 0, At, B0); PG8_BAR; PG8_SCHED;
            PG8_LDB(B1, 1, 1); PG8_STAGE(PG8_SB(1, 0), b3, voffB);
            PG8_BAR; PG8_WAIT_L(0); PG8_MMA(0, 1, At, B1); PG8_BAR;
            PG8_LDA(At, 1, 1); PG8_STAGE(PG8_SA(1, 0), a3, voffA);
            PG8_BAR; PG8_WAIT_L(0); PG8_MMA(1, 0, At, B0); PG8_BAR; PG8_SCHED;
            PG8_STAGE(PG8_SB(1, 1), b3 + hstep, voffB);
            PG8_WAIT_V(6); PG8_BAR; PG8_MMA(1, 1, At, B1); PG8_BAR;
            }
        }
        if constexpr (ALIGN_EPI) { if (wr == 0) PG8_BAR; }
        if constexpr (!Epi::AFTER_DRAIN) { E(acc, cur, wr, wc, fr, fq); S.done(cur); }
        if (!has_next) break;
#pragma unroll
        for (int a = 0; a < 2; ++a)
#pragma unroll
            for (int b = 0; b < 2; ++b)
#pragma unroll
                for (int m = 0; m < 4; ++m)
#pragma unroll
                    for (int n = 0; n < 2; ++n) acc[a][b][m][n] = (f32x4){0.f, 0.f, 0.f, 0.f};
        cur = nxt; cA = nA; cB = nB; ++ui;
        if constexpr (ALIGN_EPI) { if (wr == 1) PG8_BAR; }
    }
    PG8_WAIT_V(0);
    if constexpr (!ALIGN_EPI) { if (wr == 0) PG8_BAR; }
    PG8_BAR;
    if constexpr (Epi::AFTER_DRAIN) { E.fused(acc, cur, wr, wc, fr, fq, lds, wid, lane); S.done(cur); }
#undef PG8_SA
#undef PG8_SB
#undef PG8_STAGE
#undef PG8_LDA
#undef PG8_LDB
#undef PG8_MMA
#undef PG8_WAIT_V
#undef PG8_WAIT_L
#undef PG8_BAR
#undef PG8_SCHED
}
}

constexpr int NWAVES = 8;
constexpr int T = 16384, D = 1024, SEQ = 2048, NBATCH = 8, NHEAD = 16;
constexpr int N_IN = 8448, P_LD = 9472;
constexpr int C_CB = 0, C_CC = 1024, C_CH = 2048, C_GA = 3072, C_GB = 4096, C_R = 5120, C_K = 6144, C_V = 7168, C_WD = 8192, C_AD = 8256, C_GD = 8320, C_VD = 8448;
constexpr int N_SHIFT = 3328, N_EXP = 32, D_EXP = 512;
constexpr int MAXROWS = 40960;
constexpr float NORM_EPS = 1e-6f, LNX_EPS = 64e-5f;

constexpr size_t MiB = 1u << 20;
constexpr size_t WS_CTL = 0, CTL_ZERO_BYTES = 1 * MiB;
constexpr size_t WS_BT_IN = 2 * MiB;
constexpr size_t WS_BT_OUT = 39 * MiB;
constexpr size_t WS_BT_E1 = 43 * MiB;
constexpr size_t WS_BT_E2 = 171 * MiB;
constexpr size_t WS_H = 235 * MiB;
constexpr size_t WS_ALR = WS_H;
constexpr size_t WS_P = 267 * MiB;
constexpr size_t WS_BUF = WS_P, WS_HB = WS_P + 80 * MiB, WS_YE = WS_P + 120 * MiB;
constexpr size_t WS_ADAP = WS_P;
constexpr size_t WS_W = 563 * MiB;
constexpr size_t WS_KK = 627 * MiB, WS_BQ = 659 * MiB, WS_KP = 691 * MiB, WS_R = 723 * MiB, WS_V0 = 755 * MiB, WS_V1 = 787 * MiB;
constexpr size_t WS_LR = 819 * MiB;
constexpr size_t WS_Y = 915 * MiB;
constexpr size_t WS_X = 947 * MiB;
constexpr size_t WS_BONUS = 1011 * MiB;
constexpr size_t WS_EIDX = 1012 * MiB, WS_POS = WS_EIDX + 128 * 1024, WS_WTS = WS_EIDX + 256 * 1024, WS_SLOT = WS_EIDX + 384 * 1024;
constexpr size_t WS_HIST = WS_EIDX + 512 * 1024;
constexpr size_t WS_WRT = WS_EIDX + 768 * 1024;
constexpr size_t WS_KN = WS_KK;
constexpr size_t WS_BONP = WS_KK + 2 * MiB;
constexpr size_t WS_BT_LR = 1015 * MiB;
constexpr size_t WS_END = 1018 * MiB;
static_assert(WS_YE + (size_t)MAXROWS * 1024 * 2 <= WS_W && WS_P + (size_t)T * P_LD * 2 <= WS_W && WS_BT_IN + (size_t)2 * P_LD * 2048 <= WS_BT_OUT, "ws map");
constexpr int CW_CNT = 1024;
constexpr int CW_BAR = 4096;
constexpr size_t CTL_ADA = 256 * 1024;
constexpr size_t CTL_BIASR = 700 * 1024;

constexpr int RING_BYTES = 131072;
constexpr int TAB_OFF = RING_BYTES;
constexpr int MISC_OFF = RING_BYTES + 1024;
constexpr int LDS_BYTES = 147456;

#define GAS __attribute__((address_space(1)))
#define LAS __attribute__((address_space(3)))
typedef unsigned short bf16;
typedef float f32x4 __attribute__((ext_vector_type(4)));
typedef float f32x2 __attribute__((ext_vector_type(2)));
typedef unsigned u32x4 __attribute__((ext_vector_type(4)));
typedef unsigned u32x2 __attribute__((ext_vector_type(2)));
#define LDS_WAIT() asm volatile("s_waitcnt lgkmcnt(0)" ::: "memory")

__device__ __forceinline__ unsigned f2bf(float f) { unsigned u = __builtin_bit_cast(unsigned, f); return (u + 0x7fffu + ((u >> 16) & 1u)) >> 16; }
__device__ __forceinline__ unsigned pk2(float lo, float hi) { return f2bf(lo) | (f2bf(hi) << 16); }
__device__ __forceinline__ float bflo(unsigned u) { return __builtin_bit_cast(float, u << 16); }
__device__ __forceinline__ float bfhi(unsigned u) { return __builtin_bit_cast(float, u & 0xffff0000u); }
__device__ __forceinline__ void load8(const bf16* p, float (&o)[8]) { const u32x4 u = *(const u32x4*)p; o[0] = bflo(u.x); o[1] = bfhi(u.x); o[2] = bflo(u.y); o[3] = bfhi(u.y); o[4] = bflo(u.z); o[5] = bfhi(u.z); o[6] = bflo(u.w); o[7] = bfhi(u.w); }
__device__ __forceinline__ void store8(bf16* p, const float (&v)[8]) { u32x4 w; w.x = pk2(v[0], v[1]); w.y = pk2(v[2], v[3]); w.z = pk2(v[4], v[5]); w.w = pk2(v[6], v[7]); *(u32x4*)p = w; }
typedef _Float16 f16x2 __attribute__((ext_vector_type(2)));
__device__ __forceinline__ unsigned pkh2(float lo, float hi) { f16x2 h; h.x = (_Float16)lo; h.y = (_Float16)hi; return __builtin_bit_cast(unsigned, h); }
__device__ __forceinline__ float hlo(unsigned u) { return (float)__builtin_bit_cast(f16x2, u).x; }
__device__ __forceinline__ float hhi(unsigned u) { return (float)__builtin_bit_cast(f16x2, u).y; }
__device__ __forceinline__ void load8h(const bf16* p, float (&o)[8]) { const u32x4 u = *(const u32x4*)p; o[0] = hlo(u.x); o[1] = hhi(u.x); o[2] = hlo(u.y); o[3] = hhi(u.y); o[4] = hlo(u.z); o[5] = hhi(u.z); o[6] = hlo(u.w); o[7] = hhi(u.w); }
__device__ __forceinline__ void store8h(bf16* p, const float (&v)[8]) { u32x4 w; w.x = pkh2(v[0], v[1]); w.y = pkh2(v[2], v[3]); w.z = pkh2(v[4], v[5]); w.w = pkh2(v[6], v[7]); *(u32x4*)p = w; }
__device__ __forceinline__ float fmx_lo(float a, unsigned h, float c) { float d; asm("v_fma_mix_f32 %0, %1, %2, %3 op_sel_hi:[0,1,0]" : "=v"(d) : "v"(a), "v"(h), "v"(c)); return d; }
__device__ __forceinline__ float fmx_hi(float a, unsigned h, float c) { float d; asm("v_fma_mix_f32 %0, %1, %2, %3 op_sel:[0,1,0] op_sel_hi:[0,1,0]" : "=v"(d) : "v"(a), "v"(h), "v"(c)); return d; }
__device__ __forceinline__ float mmx_lo(float a, unsigned h) { float d; asm("v_fma_mix_f32 %0, %1, %2, 0 op_sel_hi:[0,1,0]" : "=v"(d) : "v"(a), "v"(h)); return d; }
__device__ __forceinline__ float mmx_hi(float a, unsigned h) { float d; asm("v_fma_mix_f32 %0, %1, %2, 0 op_sel:[0,1,0] op_sel_hi:[0,1,0]" : "=v"(d) : "v"(a), "v"(h)); return d; }
__device__ __forceinline__ float sigmoidf_(float x) { return __builtin_amdgcn_rcpf(1.0f + __expf(-x)); }
__device__ __forceinline__ float tanhf_(float x) { return 1.0f - 2.0f * __builtin_amdgcn_rcpf(__expf(2.0f * x) + 1.0f); }
__device__ __forceinline__ float wave_sum(float v) {
#pragma unroll
    for (int o = 1; o < 64; o <<= 1) v += __shfl_xor(v, o);
    return v;
}
__device__ __forceinline__ float sum8(float v) { v += __shfl_xor(v, 1); v += __shfl_xor(v, 2); v += __shfl_xor(v, 4); return v; }
template <int CTRL> __device__ __forceinline__ float dpp_f(float v) { return __builtin_bit_cast(float, __builtin_amdgcn_mov_dpp(__builtin_bit_cast(int, v), CTRL, 0xF, 0xF, true)); }
__device__ __forceinline__ float dpp_sum16(float v) {
    v += dpp_f<0xB1>(v);
    v += dpp_f<0x4E>(v);
    v += dpp_f<0x141>(v);
    v += dpp_f<0x140>(v);
    return v;
}

#define XB_TMO      128
#define XB_XCNT(j)  (256  + 64 * (j))
#define XB_XSUB(j)  (1280 + 64 * (j))
#define XB_XGEN(j)  (2304 + 64 * (j))
#define XB_TOP      3328
#define XB_TOPGEN   3392
#define XCD_BAR_WORDS 3456
#define XB_SPIN_CAP (1u << 18)

__device__ __forceinline__ unsigned xb_ld(unsigned* p)              { return __hip_atomic_load(p, __ATOMIC_RELAXED, __HIP_MEMORY_SCOPE_AGENT); }
__device__ __forceinline__ unsigned xb_add(unsigned* p, unsigned v) { return __hip_atomic_fetch_add(p, v, __ATOMIC_RELAXED, __HIP_MEMORY_SCOPE_AGENT); }
__device__ __forceinline__ unsigned xb_xcc_id() { return (unsigned)__builtin_amdgcn_s_getreg((3 << 11) | 20) & 0xFu; }
#define XB_SPIN(cond, bar) do { unsigned _sp = 0; while (cond) { __builtin_amdgcn_s_sleep(1); \
    if ((++_sp & 255u) == 0u) { if (xb_ld(&(bar)[XB_TMO])) break; if (_sp > XB_SPIN_CAP) { atomicAdd(&(bar)[XB_TMO], 1u); break; } } } } while (0)

struct XcdBarrier {
    unsigned* bar; unsigned x;
    volatile LAS unsigned* st;
};

__device__ __forceinline__ XcdBarrier xcd_barrier_post(unsigned* bar, volatile LAS unsigned* st) {
    XcdBarrier b; b.bar = bar; b.x = xb_xcc_id(); b.st = st;
    if (threadIdx.x == 0) (void)xb_add(&bar[XB_XCNT(b.x)], 1u);
    return b;
}
__device__ __forceinline__ void xcd_barrier_complete(unsigned* bar, unsigned x, unsigned& nloc, unsigned& nx) {
    const unsigned G = gridDim.x * gridDim.y * gridDim.z;
    unsigned sum, cnt, mine, sp = 0u;
    for (;;) {
        sum = 0u; cnt = 0u; mine = 0u;
#pragma unroll
        for (unsigned j = 0; j < 16; ++j) { const unsigned c = xb_ld(&bar[XB_XCNT(j)]); sum += c; cnt += (c > 0u) ? 1u : 0u; mine = (j == x) ? c : mine; }
        if (sum == G) break;
        __builtin_amdgcn_s_sleep(1);
        if ((++sp & 255u) == 0u) { if (xb_ld(&bar[XB_TMO])) break; if (sp > XB_SPIN_CAP) { atomicAdd(&bar[XB_TMO], 1u); break; } }
    }
    nloc = mine > 0u ? mine : 1u; nx = cnt > 0u ? cnt : 1u;
}

__device__ __forceinline__ void xcd_barrier(const XcdBarrier& b) {
    asm volatile("s_waitcnt vmcnt(0)" ::: "memory");
    __syncthreads();
    if (threadIdx.x == 0) {
        unsigned* bar = b.bar;
        __builtin_amdgcn_s_waitcnt(0);
        unsigned nloc = b.st[0], nx = b.st[1];
        if (nloc == 0u) { xcd_barrier_complete(bar, b.x, nloc, nx); b.st[0] = nloc; b.st[1] = nx; }
        const unsigned old = xb_add(&bar[XB_XSUB(b.x)], 1u);
        const unsigned gen = old / nloc;
        if (old + 1u == (gen + 1u) * nloc) {
            __builtin_amdgcn_fence(__ATOMIC_RELEASE, "agent");
            asm volatile("s_waitcnt vmcnt(0)" ::: "memory");
            const unsigned og = xb_add(&bar[XB_TOP], 1u);
            const unsigned tg = og / nx;
            if (og + 1u == (tg + 1u) * nx) xb_add(&bar[XB_TOPGEN], 1u);
            else XB_SPIN(xb_ld(&bar[XB_TOPGEN]) == tg, bar);
            __builtin_amdgcn_fence(__ATOMIC_ACQUIRE, "agent");
            xb_add(&bar[XB_XGEN(b.x)], 1u);
            asm volatile("s_waitcnt vmcnt(0)" ::: "memory");
        } else {
            XB_SPIN(xb_ld(&bar[XB_XGEN(b.x)]) == gen, bar);
            __builtin_amdgcn_fence(__ATOMIC_ACQUIRE, "agent");
            asm volatile("s_waitcnt vmcnt(0)" ::: "memory");
        }
    }
    __syncthreads();
}

struct Args { const void* p[30]; int ph_lo, ph_hi; };
template <int IDX> __device__ __forceinline__ const float* kin() {
    const auto ka = __builtin_amdgcn_kernarg_segment_ptr(); unsigned long long v;
    asm volatile("s_load_dwordx2 %0, %1, %2\n\ts_waitcnt lgkmcnt(0)" : "=s"(v) : "s"(ka), "i"(IDX * 8) : "memory");
    return (const float*)(const GAS float*)v;
}
enum { I_X = 0, I_C, I_WADA, I_BADA, I_N1G, I_N2G, I_WIN, I_MU, I_CONVW, I_W0, I_DECUP, I_A0, I_AAAUP, I_GATEUP, I_KK, I_KA, I_RK, I_LNW, I_LNB, I_VMD, I_VMU, I_V0, I_WOUT, I_WR, I_RB, I_WE1, I_WE2, I_FG };
struct Frame {
    LAS unsigned char* lds;
    int tid, lane, wave, vcu, G;
    GAS unsigned char* ws;
};
__device__ __forceinline__ float* ada_ptr(const Frame& F, int l, int b) { return (float*)(F.ws + WS_CTL + CTL_ADA) + (size_t)(l * 8 + b) * 6144; }

__device__ __forceinline__ void transpose_item(const float* W, int K, int N, bf16* WT, int dst_row0, int k0, int n0, LAS float* scr, int lane) {
    float tv[32];
#pragma unroll
    for (int i = 0; i < 32; ++i) tv[i] = W[(size_t)(k0 + 2 * i + (lane >> 5)) * N + n0 + (lane & 31)];
#pragma unroll
    for (int i = 0; i < 32; ++i) { const int kk = 2 * i + (lane >> 5); scr[kk * 33 + (lane & 31)] = tv[i]; }
    LDS_WAIT();
    const int c = lane & 7;
#pragma unroll
    for (int j = 0; j < 4; ++j) { const int n = (lane >> 3) + 8 * j; const LAS float* s = scr + (8 * c) * 33 + n;
        u32x4 o; o.x = pk2(s[0 * 33], s[1 * 33]); o.y = pk2(s[2 * 33], s[3 * 33]); o.z = pk2(s[4 * 33], s[5 * 33]); o.w = pk2(s[6 * 33], s[7 * 33]);
        *(u32x4*)(WT + (size_t)(dst_row0 + n) * K + k0 + 8 * c) = o; }
    LDS_WAIT();
}
__device__ __forceinline__ void p0_prologue(const Frame& F) {
    LAS float* scr = (LAS float*)(F.lds + F.wave * 16384);
    const int gw = F.vcu * NWAVES + F.wave, NGW = F.G * NWAVES, lane = F.lane;
    constexpr int I_ADA = 768, I_A = 2 * 16 * 264, I_B = 2 * 16 * 32, I_C1 = 64 * 16 * 32, I_D = 64 * 8 * 32;
    constexpr int NITEMS = I_ADA + I_A + I_B + I_C1 + I_D;
    const float* const pC = kin<I_C>(); const float* const pWADA = kin<I_WADA>(); const float* const pWIN = kin<I_WIN>();
    const float* const pWOUT = kin<I_WOUT>(); const float* const pWE1 = kin<I_WE1>(); const float* const pWE2 = kin<I_WE2>(); const float* const pVMD = kin<I_VMD>();
    for (int it = gw; it < NITEMS; it += NGW) {
        int r = it;
        if (r < I_ADA) {
            const int l = r / 384, rr = r % 384, cch = rr >> 4, kc = rr & 15, col = cch * 256 + 4 * lane, k0 = kc * 64;
            float cv[8];
#pragma unroll
            for (int b = 0; b < 8; ++b) { const float x = pC[b * 1024 + k0 + lane]; cv[b] = x * sigmoidf_(x); }
            f32x4 acc[8];
#pragma unroll
            for (int b = 0; b < 8; ++b) acc[b] = (f32x4){0.f, 0.f, 0.f, 0.f};
            const float* wp = pWADA + ((size_t)l * 1024 + k0) * 6144 + col;
#pragma unroll 16
            for (int kk = 0; kk < 64; ++kk) { const f32x4 w = *(const f32x4*)(wp + (size_t)kk * 6144);
#pragma unroll
                for (int b = 0; b < 8; ++b) { const float s = __builtin_bit_cast(float, __builtin_amdgcn_readlane(__builtin_bit_cast(int, cv[b]), kk)); acc[b] += s * w; } }
#pragma unroll
            for (int b = 0; b < 8; ++b) *(f32x4*)((float*)(F.ws + WS_ADAP) + ((size_t)(kc * 2 + l) * 8 + b) * 6144 + col) = acc[b];
            continue;
        }
        r -= I_ADA;
        if (r < I_A) { const int l = r / (16 * 264), rr = r % (16 * 264), kb = rr / 264, nb = rr % 264;
            transpose_item(pWIN + (size_t)l * 1024 * N_IN, 1024, N_IN, (bf16*)(F.ws + WS_BT_IN) + (size_t)l * P_LD * 1024, 32 * nb, 64 * kb, 32 * nb, scr, lane); continue; }
        r -= I_A;
        if (r < I_B) { const int l = r / 512, rr = r % 512, kb = rr / 32, nb = rr % 32;
            transpose_item(pWOUT + (size_t)l * 1024 * 1024, 1024, 1024, (bf16*)(F.ws + WS_BT_OUT) + (size_t)l * 1024 * 1024, 32 * nb, 64 * kb, 32 * nb, scr, lane); continue; }
        r -= I_B;
        if (r < I_C1) { const int le = r / 512, rr = r % 512, kb = rr / 32, nb = rr % 32, n0 = 32 * nb;
            const int j0 = n0 & 511, dst = (j0 >> 7) * 256 + (n0 >= 512 ? 128 : 0) + (j0 & 127);
            transpose_item(pWE1 + (size_t)le * 1024 * 1024, 1024, 1024, (bf16*)(F.ws + WS_BT_E1) + (size_t)le * 1024 * 1024, dst, 64 * kb, n0, scr, lane); continue; }
        r -= I_C1;
        { const int le = r / 256, rr = r % 256, kb = rr / 32, nb = rr % 32;
            transpose_item(pWE2 + (size_t)le * 512 * 1024, 512, 1024, (bf16*)(F.ws + WS_BT_E2) + (size_t)le * 1024 * 512, 32 * nb, 64 * kb, 32 * nb, scr, lane); }
    }
    const int gt0 = F.vcu * NWAVES * 64 + F.tid, GT = F.G * NWAVES * 64;
    { const float* const pVMUp = kin<I_VMU>();
      for (int it = gt0; it < 1024 * 128; it += GT) { const int n = it >> 7, k0 = (it & 127) * 8; float o[8];
#pragma unroll
        for (int i = 0; i < 8; ++i) o[i] = 0.f;
        for (int j = 0; j < 32; ++j) { const float u = pVMUp[j * 1024 + n];
#pragma unroll
            for (int i = 0; i < 8; ++i) o[i] += pVMD[(k0 + i) * 32 + j] * u; }
        store8((bf16*)(F.ws + WS_BT_IN) + (size_t)P_LD * 1024 + (size_t)(C_VD + n) * 1024 + k0, o); } }
    { const float* const pDU = kin<I_DECUP>(); const float* const pAU = kin<I_AAAUP>(); const float* const pGU = kin<I_GATEUP>();
      for (int it = gt0; it < 2 * 3072 * 32; it += GT) { const int l = it / (3072 * 32), rr = it % (3072 * 32), n = rr >> 5, k0 = (rr & 31) * 8; float o[8];
#pragma unroll
        for (int i = 0; i < 8; ++i) { const int k = k0 + i; float v = 0.f;
            if (n < 1024) { if (k < 64) v = pDU[(size_t)(l * 64 + k) * 1024 + n]; }
            else if (n < 2048) { if (k >= 64 && k < 128) v = pAU[(size_t)(l * 64 + k - 64) * 1024 + n - 1024]; }
            else { if (k >= 128) v = pGU[(size_t)(l * 128 + k - 128) * 1024 + n - 2048]; }
            o[i] = v; }
        store8((bf16*)(F.ws + WS_BT_LR) + (size_t)l * 3072 * 256 + (size_t)n * 256 + k0, o); } }
    { const float* const pWRp = kin<I_WR>(); const int gt = F.vcu * NWAVES * 64 + F.tid; if (gt < 32768) { const float w = pWRp[(gt & 1023) * 32 + (gt >> 10)]; const unsigned hi = f2bf(w);
        ((bf16*)(F.ws + WS_WRT))[gt] = (bf16)hi; ((bf16*)(F.ws + WS_WRT))[32768 + gt] = (bf16)f2bf(w - bflo(hi)); } }
}

__device__ __forceinline__ void p0b_ada_reduce(const Frame& F) {
    const float* const pBADA = kin<I_BADA>(); const float* ap = (const float*)(F.ws + WS_ADAP); float* ada = (float*)(F.ws + WS_CTL + CTL_ADA);
    for (int idx = F.vcu * NWAVES * 64 + F.tid; idx < 2 * 8 * 6144; idx += F.G * NWAVES * 64) { const int l = idx / 49152, r = idx % 49152, c = r % 6144;
        float s = pBADA[l * 6144 + c];
#pragma unroll
        for (int kc = 0; kc < 16; ++kc) s += ap[(size_t)(kc * 2 + l) * 49152 + r];
        ada[idx] = s; }
}

template <int MODE> __device__ __forceinline__ void p1_norm(const Frame& F, int l) {
    const int lane = F.lane;
    const float* const pX = kin<I_X>(); float* const pOUT = (float*)kin<28>(); const float* const pFG = kin<I_FG>(); const float* const pN1G = kin<I_N1G>(); const float* const pWRb = kin<I_WR>();
#pragma unroll 1
    for (int gw = F.vcu * NWAVES + F.wave; gw < T / 8; gw += F.G * NWAVES) { const int tok0 = gw * 8, b = tok0 >> 11;
        f32x4 gm[4], sh[4], g2v[4];
#pragma unroll
        for (int j = 0; j < 4; ++j) { const int c = 4 * lane + 256 * j;
            if (MODE == 2) { gm[j] = *(const f32x4*)(pFG + c); sh[j] = (f32x4){0.f, 0.f, 0.f, 0.f}; }
            else { const float* ad = ada_ptr(F, l, b); const f32x4 g = *(const f32x4*)(pN1G + l * 1024 + c), sc = *(const f32x4*)(ad + 1024 + c); gm[j] = g * (1.0f + sc); sh[j] = *(const f32x4*)(ad + c); }
            if (MODE >= 1) g2v[j] = *(const f32x4*)(ada_ptr(F, MODE == 2 ? 1 : l - 1, b) + 5120 + c); }
        float* X = (float*)(F.ws + WS_X);
        const bf16* YE = (const bf16*)(F.ws + WS_YE);
        const float* WTS = (const float*)(F.ws + WS_WTS); const int* SLOT = (const int*)(F.ws + WS_SLOT);
        for (int tk = 0; tk < 8; ++tk) { const int tok = tok0 + tk;
            f32x4 v[4]; const float* xs = (MODE == 0 ? pX : X) + (size_t)tok * 1024;
#pragma unroll
            for (int j = 0; j < 4; ++j) v[j] = *(const f32x4*)(xs + 4 * lane + 256 * j);
            if (MODE >= 1) { const float w0 = WTS[tok * 2], w1 = WTS[tok * 2 + 1]; const int s0 = SLOT[tok * 2], s1 = SLOT[tok * 2 + 1];
#pragma unroll
                for (int j = 0; j < 4; ++j) { const u32x2 y0 = *(const u32x2*)(YE + (size_t)s0 * 1024 + 4 * lane + 256 * j), y1 = *(const u32x2*)(YE + (size_t)s1 * 1024 + 4 * lane + 256 * j);
                    f32x4 m; m[0] = w0 * bflo(y0.x) + w1 * bflo(y1.x); m[1] = w0 * bfhi(y0.x) + w1 * bfhi(y1.x); m[2] = w0 * bflo(y0.y) + w1 * bflo(y1.y); m[3] = w0 * bfhi(y0.y) + w1 * bfhi(y1.y);
                    v[j] += g2v[j] * m; if (MODE == 1) *(f32x4*)(X + (size_t)tok * 1024 + 4 * lane + 256 * j) = v[j]; } }
            float ss = 0.f;
#pragma unroll
            for (int j = 0; j < 4; ++j) ss += (v[j][0] * v[j][0] + v[j][1] * v[j][1]) + (v[j][2] * v[j][2] + v[j][3] * v[j][3]);
            float rstd = __builtin_amdgcn_rsqf(wave_sum(ss) * (1.0f / 1024.0f) + NORM_EPS);
#if defined(DBG_SCAN)
            if (MODE == 2) { const float* dz = (const float*)(F.ws + WS_CTL) + 2048; const float er = sqrtf(dz[0] / fmaxf(dz[1], 1e-30f)); rstd *= 1.0f + 0.3f * fminf(er, 3.0f); }
#endif
#pragma unroll
            for (int j = 0; j < 4; ++j) { const f32x4 h = v[j] * rstd * gm[j] + sh[j];
                if (MODE == 2) *(f32x4*)(pOUT + (size_t)tok * 1024 + 4 * lane + 256 * j) = h;
                else { u32x2 w; w.x = pk2(h[0], h[1]); w.y = pk2(h[2], h[3]); *(u32x2*)((bf16*)(F.ws + WS_H) + (size_t)tok * 1024 + 4 * lane + 256 * j) = w; } }
        }
    }
    if (MODE == 0 && F.vcu < 16) {
        const int lb = F.vcu, e = F.tid & 31, kq = F.tid >> 5; const float* sh2 = ada_ptr(F, lb >> 3, lb & 7) + 3072; float s = 0.f;
        for (int k = kq * 64; k < kq * 64 + 64; ++k) s += sh2[k] * pWRb[k * 32 + e];
        LAS float* red = (LAS float*)F.lds; red[kq * 32 + e] = s; __syncthreads();
        if (F.tid < 32) { float t = 0.f; for (int q = 0; q < 16; ++q) t += red[q * 32 + e]; ((float*)(F.ws + WS_CTL + CTL_BIASR))[lb * 32 + e] = t; }
        __syncthreads();
    }
}

__device__ __forceinline__ void p2b_lra(const Frame& F, int l) {
    const int lane = F.lane, c8 = lane & 31, hf = lane >> 5;
    const bf16* P = (const bf16*)(F.ws + WS_P); bf16* ALR = (bf16*)(F.ws + WS_ALR); const float* mu = kin<I_MU>() + l * N_SHIFT + 3072 + 8 * c8;
    const f32x4 m0 = *(const f32x4*)mu, m1 = *(const f32x4*)(mu + 4);
    const float* const pKKc = kin<I_KK>() + l * 1024; const float* const muK = kin<I_MU>() + l * N_SHIFT + 1024; float* KNo = (float*)(F.ws + WS_KN);
#pragma unroll 1
    for (int gw = F.vcu * NWAVES + F.wave; gw < T / 8; gw += F.G * NWAVES) {
#pragma unroll
        for (int i = 0; i < 4; ++i) { const int tok = gw * 8 + 2 * i + hf; float cur[8], prv[8], o[8];
            load8(P + (size_t)tok * P_LD + C_WD + 8 * c8, cur);
            if ((tok & (SEQ - 1)) != 0) load8(P + (size_t)(tok - 1) * P_LD + C_WD + 8 * c8, prv); else {
#pragma unroll
                for (int j = 0; j < 8; ++j) prv[j] = 0.f; }
#pragma unroll
            for (int j = 0; j < 8; ++j) { const float v = cur[j] + (prv[j] - cur[j]) * (j < 4 ? m0[j] : m1[j - 4]); o[j] = (c8 < 8) ? tanhf_(v) : ((c8 < 16) ? v : sigmoidf_(v)); }
            store8(ALR + (size_t)tok * 256 + 8 * c8, o); }
#pragma unroll 1
        for (int ch = 0; ch < 2; ++ch) { const int col0 = 512 * ch + 8 * lane; float kkc[8], muk[8], kp_[8];
#pragma unroll
            for (int j = 0; j < 8; ++j) { kkc[j] = pKKc[col0 + j]; muk[j] = muK[col0 + j]; kp_[j] = 0.f; }
            const int tok0 = gw * 8;
            if ((tok0 & (SEQ - 1)) != 0) load8(P + (size_t)(tok0 - 1) * P_LD + C_K + col0, kp_);
#pragma unroll 4
            for (int tk = 0; tk < 8; ++tk) { float kc[8]; load8(P + (size_t)(tok0 + tk) * P_LD + C_K + col0, kc); float ss = 0.f;
#pragma unroll
                for (int j = 0; j < 8; ++j) { const float k = (kc[j] + (kp_[j] - kc[j]) * muk[j]) * kkc[j]; ss += k * k; kp_[j] = kc[j]; }
                ss = sum8(ss);
                if ((lane & 7) == 0) KNo[(tok0 + tk) * 16 + 8 * ch + (lane >> 3)] = __builtin_amdgcn_rsqf(fmaxf(ss, 1e-24f)); } }
    }
}

__device__ __forceinline__ void p3_prep(const Frame& F, int l) {
    const int lane = F.lane;
    const bf16* P = (const bf16*)(F.ws + WS_P); const bf16* LR = (const bf16*)(F.ws + WS_LR);
    const float* mu = kin<I_MU>() + l * N_SHIFT;
    const float* const pA0 = kin<I_A0>() + l * 1024; const float* const pKKc = kin<I_KK>() + l * 1024; const float* const pKA = kin<I_KA>() + l * 1024; const float* const pRK = kin<I_RK>() + l * 1024; const float* const pW0 = kin<I_W0>() + l * 1024; const float* const pV0c = kin<I_V0>();
    bf16* KKo = (bf16*)(F.ws + WS_KK); bf16* BQo = (bf16*)(F.ws + WS_BQ); bf16* KPo = (bf16*)(F.ws + WS_KP); bf16* Ro = (bf16*)(F.ws + WS_R);
    bf16* V0 = (bf16*)(F.ws + WS_V0); bf16* V1 = (bf16*)(F.ws + WS_V1); float* Wo = (float*)(F.ws + WS_W); float* BON = (float*)(F.ws + WS_BONUS);
#pragma unroll 1
    for (int gw = F.vcu * NWAVES + F.wave; gw < T / 8; gw += F.G * NWAVES) { const int tok0 = gw * 8;
#pragma unroll 1
    for (int ch = 0; ch < 2; ++ch) { const int col0 = 512 * ch + 8 * lane, head = 8 * ch + (lane >> 3);
        float a0v[8], kkc[8], kac[8], rkc[8], w0v[8], v0v[8], mur[8], muk[8], muv[8], rp[8], kp_[8], vp[8];
#pragma unroll
        for (int j = 0; j < 8; ++j) { a0v[j] = pA0[col0 + j]; kkc[j] = pKKc[col0 + j]; kac[j] = pKA[col0 + j]; rkc[j] = pRK[col0 + j]; w0v[j] = pW0[col0 + j]; v0v[j] = (l == 1) ? pV0c[col0 + j] : 0.f;
            mur[j] = mu[col0 + j]; muk[j] = mu[1024 + col0 + j]; muv[j] = mu[2048 + col0 + j]; rp[j] = 0.f; kp_[j] = 0.f; vp[j] = 0.f; }
        if ((tok0 & (SEQ - 1)) != 0) { const bf16* pr = P + (size_t)(tok0 - 1) * P_LD + col0; load8(pr + C_R, rp); load8(pr + C_K, kp_); load8(pr + C_V, vp); }
#pragma unroll 2
        for (int tk = 0; tk < 8; ++tk) { const int tok = tok0 + tk; const bf16* pr = P + (size_t)tok * P_LD + col0;
            float rc[8], kc[8], vc[8], dw[8], ap[8], r[8], k[8], v[8], kk[8], kp[8], bq[8], w[8];
            load8(pr + C_R, rc); load8(pr + C_K, kc); load8(pr + C_V, vc); load8(LR + (size_t)tok * 3072 + col0, dw); load8(LR + (size_t)tok * 3072 + 1024 + col0, ap);
            float ss = 0.f, bo = 0.f;
#pragma unroll
            for (int j = 0; j < 8; ++j) { r[j] = rc[j] + (rp[j] - rc[j]) * mur[j]; k[j] = kc[j] + (kp_[j] - kc[j]) * muk[j]; v[j] = vc[j] + (vp[j] - vc[j]) * muv[j]; rp[j] = rc[j]; kp_[j] = kc[j]; vp[j] = vc[j];
                const float av = sigmoidf_(a0v[j] + ap[j]); kk[j] = k[j] * kkc[j]; ss += kk[j] * kk[j]; kp[j] = k[j] * (1.0f + (av - 1.0f) * kac[j]); bo += r[j] * kp[j] * rkc[j]; bq[j] = av;
                const float nd = -(w0v[j] + dw[j]); const float sp = fmaxf(nd, 0.f) + __logf(1.0f + __expf(-fabsf(nd))); w[j] = -__expf(-sp - 0.5f); }
            ss = sum8(ss); bo = sum8(bo);
            const float inv = __builtin_amdgcn_rsqf(fmaxf(ss, 1e-24f));
#pragma unroll
            for (int j = 0; j < 8; ++j) { kk[j] *= inv; bq[j] *= kk[j]; }
            store8h(KKo + (size_t)tok * 1024 + col0, kk); store8h(BQo + (size_t)tok * 1024 + col0, bq); store8h(KPo + (size_t)tok * 1024 + col0, kp); store8h(Ro + (size_t)tok * 1024 + col0, r);
            if ((lane & 7) == 0) BON[tok * 16 + head] = bo;
            float* wp = Wo + (size_t)tok * 1024 + col0; *(f32x4*)wp = (f32x4){w[0], w[1], w[2], w[3]}; *(f32x4*)(wp + 4) = (f32x4){w[4], w[5], w[6], w[7]};
            if (l == 1) { float vf[8], vm[8]; load8h(V0 + (size_t)tok * 1024 + col0, vf); load8(pr + C_VD, vm);
#pragma unroll
                for (int j = 0; j < 8; ++j) v[j] = v[j] + (vf[j] - v[j]) * sigmoidf_(v0v[j] + vm[j]);
                store8h(V1 + (size_t)tok * 1024 + col0, v); }
            else store8h(V0 + (size_t)tok * 1024 + col0, v); }
    }
    }
}

__device__ __forceinline__ f32x4 h4_to_f4(const u32x2 u) { return (f32x4){hlo(u.x), hhi(u.x), hlo(u.y), hhi(u.y)}; }
#if defined(DBG_SCAN)
constexpr size_t WS_YCK = WS_H;
constexpr int SC_CH = 32, SC_BUF = 49152, SC_W = 0, SC_KK = 8192, SC_BQ = 16384, SC_KP = 24576, SC_R = 32768, SC_V = 40960, SC_Y = 45056;
struct ScanRegsSeq { f32x4 w; u32x2 kk, bq, kp, r, v; };
__device__ __forceinline__ void scan_issue(const Frame& F, int l, int b, int h, int half, int cc, ScanRegsSeq& R) {
    const int s = F.tid >> 4, q = F.tid & 15; const size_t base = ((size_t)b * SEQ + cc * SC_CH + s) * 1024 + h * 64 + 4 * q;
    R.w = *(const f32x4*)((const float*)(F.ws + WS_W) + base);
    R.kk = *(const u32x2*)((const bf16*)(F.ws + WS_KK) + base); R.bq = *(const u32x2*)((const bf16*)(F.ws + WS_BQ) + base);
    R.kp = *(const u32x2*)((const bf16*)(F.ws + WS_KP) + base); R.r = *(const u32x2*)((const bf16*)(F.ws + WS_R) + base);
    if (F.tid < 256) { const int s2 = F.tid >> 3, r4 = F.tid & 7; R.v = *(const u32x2*)((const bf16*)(F.ws + (l == 0 ? WS_V0 : WS_V1)) + ((size_t)b * SEQ + cc * SC_CH + s2) * 1024 + h * 64 + half * 32 + 4 * r4); }
}
__device__ __forceinline__ void scan_commit(const Frame& F, int buf, const ScanRegsSeq& R) {
    const int s = F.tid >> 4, q = F.tid & 15; LAS unsigned char* B = F.lds + buf * SC_BUF + (s * 16 + q) * 16;
    *(LAS f32x4*)(B + SC_W) = (f32x4){__expf(R.w[0]), __expf(R.w[1]), __expf(R.w[2]), __expf(R.w[3])};     *(LAS f32x4*)(B + SC_KK) = h4_to_f4(R.kk); *(LAS f32x4*)(B + SC_BQ) = h4_to_f4(R.bq); *(LAS f32x4*)(B + SC_KP) = h4_to_f4(R.kp); *(LAS f32x4*)(B + SC_R) = h4_to_f4(R.r);
    if (F.tid < 256) { const int s2 = F.tid >> 3, r4 = F.tid & 7; *(LAS f32x4*)(F.lds + buf * SC_BUF + SC_V + (s2 * 32 + 4 * r4) * 4) = h4_to_f4(R.v); }
}
__device__ __forceinline__ void scan_store(const Frame& F, int b, int h, int half, int cc, int buf) {
    if (F.tid < 256) { const int s2 = F.tid >> 3, r4 = F.tid & 7;
        const f32x4 y = *(const LAS f32x4*)(F.lds + buf * SC_BUF + SC_Y + (s2 * 32 + 4 * r4) * 4);
        u32x2 w; w.x = pk2(y[0], y[1]); w.y = pk2(y[2], y[3]);
        const int t = cc * SC_CH + s2 - 1;
        if (t >= 0) *(u32x2*)((bf16*)(F.ws + WS_Y) + ((size_t)b * SEQ + t) * 1024 + h * 64 + half * 32 + 4 * r4) = w; }
}
__device__ __forceinline__ void p4_scan_seq(const Frame& F, int l) {
#pragma unroll 1
    for (int unit = F.vcu; unit < NBATCH * NHEAD * 2; unit += F.G) {
        const int b = unit >> 5, h = (unit >> 1) & 15, half = unit & 1;
        const int g = F.lane >> 4, q = F.lane & 15, row = F.wave * 4 + g;
        f32x2 sA = (f32x2){0.f, 0.f}, sB = sA; float yp = 0.f; const bool odd = (q & 1) != 0;
        ScanRegsSeq SR;
        bf16* SAdbg = (bf16*)(F.ws + WS_V1) + (size_t)b * SEQ * 1024 + h * 64 + half * 32 + row;
        scan_issue(F, l, b, h, half, 0, SR); scan_commit(F, 0, SR); scan_issue(F, l, b, h, half, 1, SR);
        __syncthreads();
        constexpr int NCH = SEQ / SC_CH;
#pragma unroll 1
        for (int cc = 0; cc < NCH; ++cc) { const int buf = cc & 1;
            { const LAS unsigned char* B = F.lds + buf * SC_BUF;
              const LAS f32x4* pc = (const LAS f32x4*)B + q;
              const LAS float* pv = (const LAS float*)(B + SC_V) + row; LAS float* py = (LAS float*)(B + SC_Y) + row;
              f32x4 aw[2], ak[2], ab[2], ap[2], ar[2], bw[2], bk[2], bb[2], bp[2], br_[2]; float av[2], bv[2];
#define SC_LOAD(dw, dk, db, dp, dr, dv, s) do { dw = pc[(s) * 16]; dk = pc[(s) * 16 + 512]; db = pc[(s) * 16 + 1024]; dp = pc[(s) * 16 + 1536]; dr = pc[(s) * 16 + 2048]; dv = pv[(s) * 32]; } while (0)
#define SC_STEP(cw, ck, cb, cp, cr, cv, yo, sidx) do { \
        f32x2 t = sA * ck.lo; t = sB * ck.hi + t; \
        const float pa = t.x + t.y; \
        float x = odd ? yp : pa; const float z = odd ? pa : yp; \
        x += dpp_f<0xB1>(z); x += dpp_f<0x4E>(x); x += dpp_f<0x124>(x); x += dpp_f<0x128>(x); \
        const float sa = dpp_f<0xA0>(x); \
        if (l == 0 && q == 0) SAdbg[(size_t)(cc * SC_CH + (sidx)) * 1024] = (bf16)f2bf(sa); \
        f32x2 xA = cv * cp.lo, xB = cv * cp.hi; \
        xA = xA - sa * cb.lo; xB = xB - sa * cb.hi; \
        sA = sA * cw.lo + xA; sB = sB * cw.hi + xB; \
        f32x2 yv = sA * cr.lo; yv = sB * cr.hi + yv; \
        yo = x; yp = yv.x + yv.y; } while (0)
#pragma unroll
              for (int i = 0; i < 2; ++i) SC_LOAD(aw[i], ak[i], ab[i], ap[i], ar[i], av[i], i);
#pragma unroll 1
              for (int s4 = 0; s4 < SC_CH; s4 += 4) {
#pragma unroll
                  for (int i = 0; i < 2; ++i) SC_LOAD(bw[i], bk[i], bb[i], bp[i], br_[i], bv[i], s4 + 2 + i);
                  float yo[2];
#pragma unroll
                  for (int i = 0; i < 2; ++i) SC_STEP(aw[i], ak[i], ab[i], ap[i], ar[i], av[i], yo[i], s4 + i);
                  if (q == 1) { py[(s4 + 0) * 32] = yo[0]; py[(s4 + 1) * 32] = yo[1]; }
                  const int sn = (s4 + 4 < SC_CH) ? s4 + 4 : s4;
#pragma unroll
                  for (int i = 0; i < 2; ++i) SC_LOAD(aw[i], ak[i], ab[i], ap[i], ar[i], av[i], sn + i);
#pragma unroll
                  for (int i = 0; i < 2; ++i) SC_STEP(bw[i], bk[i], bb[i], bp[i], br_[i], bv[i], yo[i], s4 + 2 + i);
                  if (q == 1) { py[(s4 + 2) * 32] = yo[0]; py[(s4 + 3) * 32] = yo[1]; }
              }
#undef SC_STEP
#undef SC_LOAD
            }
            if (cc + 1 < NCH) scan_commit(F, buf ^ 1, SR);
            if (cc + 2 < NCH) scan_issue(F, l, b, h, half, cc + 2, SR);
            asm volatile("s_waitcnt lgkmcnt(0)" ::: "memory"); __builtin_amdgcn_s_barrier(); asm volatile("" ::: "memory");
            scan_store(F, b, h, half, cc, buf);
        }
        { const float yl = dpp_sum16(yp);
          if (q == 0) ((bf16*)(F.ws + WS_Y))[((size_t)b * SEQ + SEQ - 1) * 1024 + h * 64 + half * 32 + row] = (bf16)f2bf(yl); }
        __syncthreads();
    }
}

#else
constexpr size_t WS_YCK = WS_Y;
#endif
typedef short bf16x8 __attribute__((ext_vector_type(8)));
typedef float f32x16 __attribute__((ext_vector_type(16)));
typedef __bf16 bfl2 __attribute__((ext_vector_type(2)));
constexpr int CK_XK = 0, CK_XR = 4608, CK_BH = 9216, CK_KH = 14336, CK_GB = 19456, CK_VT = 19712, CK_X3SZ = 22272;
constexpr int CK_XB = 0, CK_XP = 4608, CK_P2SZ = 9216;
constexpr int CK_TK = 0, CK_TBR = 2560, CK_TKR = 5120, CK_TB = 7680, CK_TBT = 11776, CK_MT = 15872, CK_T2SZ = 18432;
constexpr int CK_X3_OFF = 0, CK_P2_OFF = 3 * CK_X3SZ, CK_T2_OFF = CK_P2_OFF + 2 * CK_P2SZ, CK_STASH = CK_T2_OFF + 2 * CK_T2SZ;
static_assert(CK_STASH + 8192 <= RING_BYTES, "chunked-scan LDS map");
#define CK_MFMA(a, b, c) __builtin_amdgcn_mfma_f32_32x32x16_bf16((a), (b), (c), 0, 0, 0)
__device__ __forceinline__ unsigned pkbf(float lo, float hi) { f32x2 v; v.x = lo; v.y = hi; return __builtin_bit_cast(unsigned, __builtin_convertvector(v, bfl2)); }
__device__ __forceinline__ bf16x8 ck_frag(const LAS unsigned char* base, int pitch, int row, int kel) { return *(const LAS bf16x8*)(base + row * pitch + kel * 2); }
struct CkRegs { u32x2 rP, rA, rB, kP, kA, kB, vP, vA, vB, dwA, dwB, apA, apB, vmA, vmB, vfA, vfB; float knA, knB; };
struct CkConst { f32x4 a0, kk, ka, rk, w0, v0, mur, muk, muv; };
__device__ __forceinline__ f32x4 b4_to_f4(const u32x2 u) { return (f32x4){bflo(u.x), bfhi(u.x), bflo(u.y), bfhi(u.y)}; }
__device__ __forceinline__ void ck_issue(const Frame& F, int pw, int l, int b, int h, int half, int blk, CkRegs& R) {
    const int s2 = F.lane >> 2, cq = F.lane & 3, col = h * 64 + 16 * pw + 4 * cq; const size_t tA = (size_t)b * SEQ + blk * 32 + 2 * s2;
    const bf16* P = (const bf16*)(F.ws + WS_P) + tA * P_LD + col; const bf16* LR = (const bf16*)(F.ws + WS_LR) + tA * 3072 + col; const float* KN = (const float*)(F.ws + WS_KN) + tA * 16 + h;
    R.rA = *(const u32x2*)(P + C_R); R.rB = *(const u32x2*)(P + P_LD + C_R); R.kA = *(const u32x2*)(P + C_K); R.kB = *(const u32x2*)(P + P_LD + C_K); R.vA = *(const u32x2*)(P + C_V); R.vB = *(const u32x2*)(P + P_LD + C_V);
    if ((tA & (SEQ - 1)) != 0) { R.rP = *(const u32x2*)(P - P_LD + C_R); R.kP = *(const u32x2*)(P - P_LD + C_K); R.vP = *(const u32x2*)(P - P_LD + C_V); } else { R.rP = (u32x2){0u, 0u}; R.kP = R.rP; R.vP = R.rP; }
    R.dwA = *(const u32x2*)LR; R.dwB = *(const u32x2*)(LR + 3072); R.apA = *(const u32x2*)(LR + 1024); R.apB = *(const u32x2*)(LR + 3072 + 1024);
    R.knA = KN[0]; R.knB = KN[16];
    if (l == 1) { R.vmA = *(const u32x2*)(P + C_VD); R.vmB = *(const u32x2*)(P + P_LD + C_VD); const bf16* V0 = (const bf16*)(F.ws + WS_V0) + tA * 1024 + col; R.vfA = *(const u32x2*)V0; R.vfB = *(const u32x2*)(V0 + 1024); }
    (void)half;
}
__device__ __forceinline__ void ck_elem(const CkConst& C, int l, const f32x4 rc, const f32x4 rp, const f32x4 kc, const f32x4 kp_, const f32x4 vc, const f32x4 vp, const f32x4 dw, const f32x4 ap, const float kn,
                                        const f32x4 vm, const f32x4 vf, f32x4& r, f32x4& kk, f32x4& bq, f32x4& kp, f32x4& lw, f32x4& v, float& bo) {
#pragma unroll
    for (int e = 0; e < 4; ++e) {
        r[e] = rc[e] + (rp[e] - rc[e]) * C.mur[e]; const float k = kc[e] + (kp_[e] - kc[e]) * C.muk[e]; float vv = vc[e] + (vp[e] - vc[e]) * C.muv[e];
        const float av = sigmoidf_(C.a0[e] + ap[e]); kk[e] = k * C.kk[e] * kn; bq[e] = kk[e] * av; kp[e] = k * (1.0f + (av - 1.0f) * C.ka[e]); bo += r[e] * kp[e] * C.rk[e];
        const float nd = -(C.w0[e] + dw[e]); const float sp = fmaxf(nd, 0.f) + __logf(1.0f + __expf(-fabsf(nd))); lw[e] = -__expf(-sp - 0.5f);
        if (l == 1) vv = vv + (vf[e] - vv) * sigmoidf_(C.v0[e] + vm[e]);
        v[e] = vv; }
}
__device__ __forceinline__ void ck_stage1(const Frame& F, int pw, int l, int b, int h, int half, int blk, const CkConst& C, LAS unsigned char* BX, LAS unsigned char* BP, const CkRegs& R) {
    const int lane = F.lane, s2 = lane >> 2, cq = lane & 3, c0 = 16 * pw + 4 * cq, cp = 16 * pw + 4 * (((cq & 1) << 1) | (cq >> 1));
    f32x4 kkA, kkB, bqA, bqB, kpA, kpB, rA, rB, lwA, lwB, vA, vB; float boA = 0.f, boB = 0.f;
    { const f32x4 rcA = b4_to_f4(R.rA), kcA = b4_to_f4(R.kA), vcA = b4_to_f4(R.vA), zz = (f32x4){0.f, 0.f, 0.f, 0.f};
      ck_elem(C, l, rcA, b4_to_f4(R.rP), kcA, b4_to_f4(R.kP), vcA, b4_to_f4(R.vP), b4_to_f4(R.dwA), b4_to_f4(R.apA), R.knA, l == 1 ? b4_to_f4(R.vmA) : zz, l == 1 ? h4_to_f4(R.vfA) : zz, rA, kkA, bqA, kpA, lwA, vA, boA);
      ck_elem(C, l, b4_to_f4(R.rB), rcA, b4_to_f4(R.kB), kcA, b4_to_f4(R.vB), vcA, b4_to_f4(R.dwB), b4_to_f4(R.apB), R.knB, l == 1 ? b4_to_f4(R.vmB) : zz, l == 1 ? h4_to_f4(R.vfB) : zz, rB, kkB, bqB, kpB, lwB, vB, boB); }
    { const size_t tA = (size_t)b * SEQ + blk * 32 + 2 * s2;
      boA += __shfl_xor(boA, 1); boA += __shfl_xor(boA, 2); boB += __shfl_xor(boB, 1); boB += __shfl_xor(boB, 2);
      if ((pw >> 1) == half) { if (cq == 0) { float* bp = (float*)(F.ws + WS_BONP) + (tA * 16 + h) * 4 + pw; bp[0] = boA; bp[64] = boB; }
          bf16* Vo = (bf16*)(F.ws + (l == 0 ? WS_V0 : WS_V1)) + tA * 1024 + h * 64 + c0;
          *(u32x2*)Vo = (u32x2){pkh2(vA[0], vA[1]), pkh2(vA[2], vA[3])}; *(u32x2*)(Vo + 1024) = (u32x2){pkh2(vB[0], vB[1]), pkh2(vB[2], vB[3])};
#pragma unroll
          for (int e = 0; e < 4; ++e) *(LAS unsigned*)(BX + CK_VT + (16 * (pw & 1) + 4 * cq + e) * 80 + (2 * s2) * 2) = pkbf(vA[e], vB[e]); } }
    float xkA[4], xkB[4], xrA[4], xrB[4], xbA[4], xbB[4], xpA[4], xpB[4], bhA[4], bhB[4], khA[4], khB[4], gb[4];
#pragma unroll
    for (int e = 0; e < 4; ++e) {
        float x = lwA[e] + lwB[e];
#pragma unroll
        for (int d = 4; d < 64; d <<= 1) { const float y = __shfl_up(x, d); if (lane >= d) x += y; }
        const float LB = x, LA = x - lwB[e], L0 = LA - lwA[e], Lt = __shfl(x, 60 + cq);
        const float eL0 = __expf(L0), eLA = __expf(LA), eLB = __expf(LB), iLA = __expf(-LA), iLB = __expf(-LB), tA = __expf(Lt - LA), tB = __expf(Lt - LB);
        xkA[e] = kkA[e] * eL0; xkB[e] = kkB[e] * eLA; xrA[e] = rA[e] * eLA; xrB[e] = rB[e] * eLB;
        xbA[e] = bqA[e] * iLA; xbB[e] = bqB[e] * iLB; xpA[e] = kpA[e] * iLA; xpB[e] = kpB[e] * iLB;
        bhA[e] = bqA[e] * tA; bhB[e] = bqB[e] * tB; khA[e] = kpA[e] * tA; khB[e] = kpB[e] * tB; gb[e] = __expf(Lt);
    }
    const int oA = (2 * s2) * 144 + cp * 2, oB = oA + 144;
    *(LAS u32x2*)(BX + CK_XK + oA) = (u32x2){pkbf(xkA[0], xkA[1]), pkbf(xkA[2], xkA[3])}; *(LAS u32x2*)(BX + CK_XK + oB) = (u32x2){pkbf(xkB[0], xkB[1]), pkbf(xkB[2], xkB[3])};
    *(LAS u32x2*)(BX + CK_XR + oA) = (u32x2){pkbf(xrA[0], xrA[1]), pkbf(xrA[2], xrA[3])}; *(LAS u32x2*)(BX + CK_XR + oB) = (u32x2){pkbf(xrB[0], xrB[1]), pkbf(xrB[2], xrB[3])};
    *(LAS u32x2*)(BP + CK_XB + oA) = (u32x2){pkbf(xbA[0], xbA[1]), pkbf(xbA[2], xbA[3])}; *(LAS u32x2*)(BP + CK_XB + oB) = (u32x2){pkbf(xbB[0], xbB[1]), pkbf(xbB[2], xbB[3])};
    *(LAS u32x2*)(BP + CK_XP + oA) = (u32x2){pkbf(xpA[0], xpA[1]), pkbf(xpA[2], xpA[3])}; *(LAS u32x2*)(BP + CK_XP + oB) = (u32x2){pkbf(xpB[0], xpB[1]), pkbf(xpB[2], xpB[3])};
    const int i0 = 2 * s2, pst = (i0 & 16) | ((i0 & 4) << 1) | ((i0 & 8) >> 1) | (i0 & 3);
#pragma unroll
    for (int e = 0; e < 4; ++e) { *(LAS unsigned*)(BX + CK_BH + (c0 + e) * 80 + pst * 2) = pkbf(bhA[e], bhB[e]); *(LAS unsigned*)(BX + CK_KH + (c0 + e) * 80 + (2 * s2) * 2) = pkbf(khA[e], khB[e]); }
    if (s2 == 0) *(LAS f32x4*)(BX + CK_GB + c0 * 4) = (f32x4){gb[0], gb[1], gb[2], gb[3]};

}
__device__ __forceinline__ void ck_stage2(const Frame& F, int ti, const LAS unsigned char* BX, const LAS unsigned char* BP, LAS unsigned char* BT) {
    const int r = F.lane & 31, hh = F.lane >> 5;
    const LAS unsigned char* Aa = BP + ((ti < 2) ? CK_XB : CK_XP); const LAS unsigned char* Ba = BX + ((ti & 1) ? CK_XR : CK_XK);
    f32x16 acc;
#pragma unroll
    for (int i = 0; i < 16; ++i) acc[i] = 0.f;
#pragma unroll
    for (int ks = 0; ks < 4; ++ks) acc = CK_MFMA(ck_frag(Aa, 144, r, 16 * ks + 8 * hh), ck_frag(Ba, 144, r, 16 * ks + 8 * hh), acc);
    if (ti == 0) {
#pragma unroll
        for (int reg = 0; reg < 16; ++reg) { const int i = (reg & 3) + 8 * (reg >> 2) + 4 * hh; *(LAS float*)(BT + CK_TB + (i * 32 + r) * 4) = (i < r) ? acc[reg] : 0.f; }
#pragma unroll
        for (int m = 0; m < 4; ++m) { f32x4 t;
#pragma unroll
            for (int e = 0; e < 4; ++e) t[e] = (8 * m + 4 * hh + e < r) ? acc[4 * m + e] : 0.f;
            *(LAS f32x4*)(BT + CK_TBT + (r * 32 + 8 * m + 4 * hh) * 4) = t; }
    } else { const int off = (ti == 1) ? CK_TBR : ((ti == 2) ? CK_TK : CK_TKR);
#pragma unroll
        for (int m = 0; m < 4; ++m) { float t[4];
#pragma unroll
            for (int e = 0; e < 4; ++e) { const int i = 8 * m + 4 * hh + e; const bool keep = (ti == 2) ? (i < r) : (i <= r); t[e] = keep ? acc[4 * m + e] : 0.f; }
            const int col = (ti == 1) ? (16 * (m >> 1) + 8 * hh + 4 * (m & 1)) : (8 * m + 4 * hh);
            *(LAS u32x2*)(BT + off + r * 80 + col * 2) = (u32x2){pkbf(t[0], t[1]), pkbf(t[2], t[3])}; }
    }
    if (ti == 0) {
        LDS_WAIT();
        const LAS float* TBT = (const LAS float*)(BT + CK_TBT);
        float x[32];
        int rr = r; asm volatile("" : "+v"(rr));
#pragma unroll
        for (int k = 0; k < 32; ++k) x[k] = (k == rr) ? 1.f : 0.f;
        { f32x4 tc[8], tn[8];
#pragma unroll
          for (int j4 = 0; j4 < 8; ++j4) tc[j4] = *(const LAS f32x4*)(TBT + 31 * 32 + 4 * j4);
#pragma unroll
          for (int kk = 0; kk < 31; ++kk) { const int k = 31 - kk; const float xk = x[k];
              int off = (k - 1) * 32; asm volatile("" : "+v"(off) : "v"(xk));
              if (k - 1 >= 1) {
#pragma unroll
                  for (int j4 = 0; j4 <= (k - 2) / 4; ++j4) tn[j4] = *(const LAS f32x4*)(TBT + off + 4 * j4); }
#pragma unroll
              for (int j4 = 0; j4 <= (k - 1) / 4; ++j4) {
#pragma unroll
                  for (int e = 0; e < 4; ++e) { const int i = 4 * j4 + e; if (i < k) x[i] = __builtin_fmaf(-tc[j4][e], xk, x[i]); } }
#pragma unroll
              for (int j4 = 0; j4 < 8; ++j4) tc[j4] = tn[j4]; } }
        if (hh == 0) {
#pragma unroll
            for (int q = 0; q < 4; ++q) { u32x4 w;
#pragma unroll
                for (int p = 0; p < 4; ++p) { const int e0 = 2 * p, e1 = 2 * p + 1; w[p] = pkbf(x[16 * (q >> 1) + 8 * (e0 >> 2) + 4 * (q & 1) + (e0 & 3)], x[16 * (q >> 1) + 8 * (e1 >> 2) + 4 * (q & 1) + (e1 & 3)]); }
                *(LAS u32x4*)(BT + CK_MT + r * 80 + q * 16) = w; } }
    }
}
#define CK_BAR() do { asm volatile("s_waitcnt lgkmcnt(0)" ::: "memory"); __builtin_amdgcn_s_barrier(); asm volatile("" ::: "memory"); } while (0)
__device__ __forceinline__ void p4_scan(const Frame& F, int l) {
#pragma unroll 1
    for (int unit = F.vcu; unit < NBATCH * NHEAD * 2; unit += F.G) {
        const int b = unit >> 5, h = (unit >> 1) & 15, half = unit & 1;
        const bool pre = F.wave >= 4, mainw = F.wave == 0;
        const int r = F.lane & 31, hh = F.lane >> 5;
        constexpr int NBLKc = SEQ / 32;
        const int w_ = F.wave;
        if (w_ == 0) {
            f32x16 ST0, ST1;
#pragma unroll
            for (int i = 0; i < 16; ++i) { ST0[i] = 0.f; ST1[i] = 0.f; }
#pragma unroll 1
            for (int blk = -2; blk < NBLKc; ++blk) {
                const LAS unsigned char* BX = F.lds + CK_X3_OFF + ((blk + 3) % 3) * CK_X3SZ; const LAS unsigned char* BT = F.lds + CK_T2_OFF + (blk & 1) * CK_T2SZ;
                bf16x8 SH[2][2], SL[2][2], NUF[2], VF[2]; f32x16 RH, YT;
                if (blk >= 0) {
#pragma unroll
                for (int c = 0; c < 2; ++c)
#pragma unroll
                    for (int s = 0; s < 2; ++s) { u32x4 ph, pl;
#pragma unroll
                        for (int p = 0; p < 4; ++p) { const float x0 = (c ? ST1 : ST0)[8 * s + 2 * p], x1 = (c ? ST1 : ST0)[8 * s + 2 * p + 1]; const unsigned hp = pkbf(x0, x1);
                            ph[p] = hp;
#if defined(CK_LO)
                            pl[p] = pkbf(x0 - bflo(hp), x1 - bfhi(hp));
#endif
                        }
                        SH[c][s] = __builtin_bit_cast(bf16x8, ph);
#if defined(CK_LO)
                        SL[c][s] = __builtin_bit_cast(bf16x8, pl);
#endif
                    }
                { LAS f32x4* stash = (LAS f32x4*)(F.lds + CK_STASH) + F.lane;
#pragma unroll
                  for (int m = 0; m < 4; ++m) { stash[64 * m] = (f32x4){ST0[4 * m], ST0[4 * m + 1], ST0[4 * m + 2], ST0[4 * m + 3]}; stash[64 * (4 + m)] = (f32x4){ST1[4 * m], ST1[4 * m + 1], ST1[4 * m + 2], ST1[4 * m + 3]}; } }
                VF[0] = ck_frag(BX + CK_VT, 80, r, 8 * hh); VF[1] = ck_frag(BX + CK_VT, 80, r, 16 + 8 * hh);
#pragma unroll
                for (int i = 0; i < 16; ++i) RH[i] = 0.f;
                { bf16x8 ak[2][2], at[2];
#pragma unroll
                  for (int c = 0; c < 2; ++c)
#pragma unroll
                      for (int s = 0; s < 2; ++s) ak[c][s] = ck_frag(BX + CK_XK, 144, r, 32 * c + 16 * s + 8 * hh);
                  at[0] = ck_frag(BT + CK_TK, 80, r, 8 * hh); at[1] = ck_frag(BT + CK_TK, 80, r, 16 + 8 * hh);
#pragma unroll
                  for (int c = 0; c < 2; ++c)
#pragma unroll
                      for (int s = 0; s < 2; ++s) RH = CK_MFMA(ak[c][s], SH[c][s], RH);
#pragma unroll
                  for (int ks = 0; ks < 2; ++ks) RH = CK_MFMA(at[ks], VF[ks], RH); }
                { bf16x8 rb[2];
#pragma unroll
                  for (int s = 0; s < 2; ++s) { u32x4 p4;
#pragma unroll
                      for (int p = 0; p < 4; ++p) p4[p] = pkbf(RH[8 * s + 2 * p], RH[8 * s + 2 * p + 1]);
                      rb[s] = __builtin_bit_cast(bf16x8, p4); }
                  f32x16 UT;
#pragma unroll
                  for (int i = 0; i < 16; ++i) UT[i] = 0.f;
#pragma unroll
                  for (int s = 0; s < 2; ++s) UT = CK_MFMA(ck_frag(BT + CK_MT, 80, r, 16 * s + 8 * hh), rb[s], UT);
#pragma unroll
                  for (int s = 0; s < 2; ++s) { u32x4 p4;
#pragma unroll
                      for (int p = 0; p < 4; ++p) p4[p] = pkbf(UT[8 * s + 2 * p], UT[8 * s + 2 * p + 1]) ^ 0x80008000u;
                      NUF[s] = __builtin_bit_cast(bf16x8, p4); } }
#pragma unroll
                for (int i = 0; i < 16; ++i) YT[i] = 0.f;
                { bf16x8 ar[2][2];
#pragma unroll
                  for (int c = 0; c < 2; ++c)
#pragma unroll
                      for (int s = 0; s < 2; ++s) ar[c][s] = ck_frag(BX + CK_XR, 144, r, 32 * c + 16 * s + 8 * hh);
#pragma unroll
                  for (int c = 0; c < 2; ++c)
#pragma unroll
                      for (int s = 0; s < 2; ++s) YT = CK_MFMA(ar[c][s], SH[c][s], YT); }
                VF[0] = ck_frag(BX + CK_VT, 80, r, 8 * hh); VF[1] = ck_frag(BX + CK_VT, 80, r, 16 + 8 * hh);
                asm volatile("" ::: "memory");
#pragma unroll
                for (int ks = 0; ks < 2; ++ks) { const bf16x8 fbr = ck_frag(BT + CK_TBR, 80, r, 16 * ks + 8 * hh), fkr = ck_frag(BT + CK_TKR, 80, r, 16 * ks + 8 * hh); YT = CK_MFMA(fbr, NUF[ks], YT); YT = CK_MFMA(fkr, VF[ks], YT); }
                { bf16* yo = (bf16*)(F.ws + WS_YCK) + ((size_t)b * SEQ + blk * 32) * 1024 + h * 64 + half * 32 + r;
#pragma unroll
                  for (int reg = 0; reg < 16; ++reg) yo[(size_t)((reg & 3) + 8 * (reg >> 2) + 4 * hh) * 1024] = (bf16)f2bf(YT[reg]); }
                { const LAS f32x4* stash = (const LAS f32x4*)(F.lds + CK_STASH) + F.lane;
#pragma unroll
                  for (int m = 0; m < 4; ++m) { const f32x4 g0 = *(const LAS f32x4*)(BX + CK_GB + (8 * m + 4 * hh) * 4), g1 = *(const LAS f32x4*)(BX + CK_GB + (32 + 8 * m + 4 * hh) * 4);
                    const f32x4 a0 = stash[64 * m] * g0, a1 = stash[64 * (4 + m)] * g1;
#pragma unroll
                    for (int e = 0; e < 4; ++e) { ST0[4 * m + e] = a0[e]; ST1[4 * m + e] = a1[e]; } } }
#pragma unroll
                for (int ks = 0; ks < 2; ++ks) {
                    const bf16x8 b0 = ck_frag(BX + CK_BH, 80, r, 16 * ks + 8 * hh), b1 = ck_frag(BX + CK_BH, 80, 32 + r, 16 * ks + 8 * hh), k0 = ck_frag(BX + CK_KH, 80, r, 16 * ks + 8 * hh), k1 = ck_frag(BX + CK_KH, 80, 32 + r, 16 * ks + 8 * hh);
                    ST0 = CK_MFMA(b0, NUF[ks], ST0); ST1 = CK_MFMA(b1, NUF[ks], ST1); ST0 = CK_MFMA(k0, VF[ks], ST0); ST1 = CK_MFMA(k1, VF[ks], ST1); }
                }
                CK_BAR();
            }
        } else if (w_ == 1 || w_ == 2 || w_ == 3 || w_ == 5) {
            const int pw = (w_ == 5) ? 3 : w_ - 1;
            CkConst CC;
            { const int c = l * 1024 + h * 64 + 16 * pw + 4 * (F.lane & 3); const float* mu = kin<I_MU>() + l * N_SHIFT + h * 64 + 16 * pw + 4 * (F.lane & 3);
              CC.a0 = *(const f32x4*)(kin<I_A0>() + c); CC.kk = *(const f32x4*)(kin<I_KK>() + c); CC.ka = *(const f32x4*)(kin<I_KA>() + c); CC.rk = *(const f32x4*)(kin<I_RK>() + c); CC.w0 = *(const f32x4*)(kin<I_W0>() + c);
              CC.v0 = (l == 1) ? *(const f32x4*)(kin<I_V0>() + (c - 1024)) : (f32x4){0.f, 0.f, 0.f, 0.f}; CC.mur = *(const f32x4*)mu; CC.muk = *(const f32x4*)(mu + 1024); CC.muv = *(const f32x4*)(mu + 2048); }
            CkRegs CR;
            ck_issue(F, pw, l, b, h, half, 0, CR);
#pragma unroll 1
            for (int blk = -2; blk < NBLKc; ++blk) {
                if (blk + 2 < NBLKc) ck_stage1(F, pw, l, b, h, half, blk + 2, CC, F.lds + CK_X3_OFF + ((blk + 2 + 3) % 3) * CK_X3SZ, F.lds + CK_P2_OFF + ((blk + 2) & 1) * CK_P2SZ, CR);
                if (blk + 3 < NBLKc) ck_issue(F, pw, l, b, h, half, blk + 3, CR);
                CK_BAR();
            }
        } else {
#pragma unroll 1
            for (int blk = -2; blk < NBLKc; ++blk) {
                if (blk + 1 >= 0 && blk + 1 < NBLKc) {
                    const LAS unsigned char* BX = F.lds + CK_X3_OFF + ((blk + 1 + 3) % 3) * CK_X3SZ; const LAS unsigned char* BP = F.lds + CK_P2_OFF + ((blk + 1) & 1) * CK_P2SZ; LAS unsigned char* BT = F.lds + CK_T2_OFF + ((blk + 1) & 1) * CK_T2SZ;
                    if (w_ == 4) ck_stage2(F, 0, BX, BP, BT);
                    else if (w_ == 6) { ck_stage2(F, 1, BX, BP, BT); ck_stage2(F, 3, BX, BP, BT); }
                    else ck_stage2(F, 2, BX, BP, BT);
                }
                CK_BAR();
            }
        }
    }
}

__device__ __forceinline__ void p5_post(const Frame& F, int l) {
    const int lane = F.lane;
#if defined(DBG_SCAN)
    if (l == 0) { float d2 = 0.f, n2 = 0.f;
#if defined(DBG_CMP_U)
        const bf16* Ya = (const bf16*)(F.ws + WS_V1); const bf16* Yb = (const bf16*)(F.ws + WS_P) + C_VD; const size_t pb = P_LD;
#else
        const bf16* Ya = (const bf16*)(F.ws + WS_Y); const bf16* Yb = (const bf16*)(F.ws + WS_H); const size_t pb = 1024;
#endif
        for (size_t i = (size_t)(F.vcu * NWAVES * 64 + F.tid); i < (size_t)T * 1024; i += (size_t)F.G * NWAVES * 64) { const int t = (int)((i >> 10) & (SEQ - 1));
            if (t >= DBG_T0 && t < DBG_T1) { const float ya = bflo((unsigned)Ya[i]), yb = bflo((unsigned)Yb[(i >> 10) * pb + (i & 1023)]); d2 += (ya - yb) * (ya - yb); n2 += ya * ya; } }
        d2 = wave_sum(d2); n2 = wave_sum(n2);
        if (lane == 0) { atomicAdd((float*)(F.ws + WS_CTL) + 2048, d2); atomicAdd((float*)(F.ws + WS_CTL) + 2049, n2); }
        __syncthreads(); }
#endif
    const float* const pCW = kin<I_CONVW>() + l * 3 * 1024; const float* const pLNW = kin<I_LNW>() + l * 1024; const float* const pLNB = kin<I_LNB>() + l * 1024;
    const bf16* P = (const bf16*)(F.ws + WS_P); const bf16* Y = (const bf16*)(F.ws + WS_Y); const bf16* LRg = (const bf16*)(F.ws + WS_LR) + 2048;
    const bf16* V = (const bf16*)(F.ws + (l == 0 ? WS_V0 : WS_V1)); const float* BONP = (const float*)(F.ws + WS_BONP); bf16* M = (bf16*)(F.ws + WS_H);
#pragma unroll 1
    for (int gw = F.vcu * NWAVES + F.wave; gw < T / 8; gw += F.G * NWAVES) { const int tok0 = gw * 8;
#pragma unroll 1
    for (int ch = 0; ch < 2; ++ch) { const int col0 = 512 * ch + 8 * lane, head = 8 * ch + (lane >> 3);
        float cw0[8], cw1[8], cw2[8], lnw[8], lnb[8], um1[8], um2[8];
#pragma unroll
        for (int j = 0; j < 8; ++j) { cw0[j] = pCW[col0 + j]; cw1[j] = pCW[1024 + col0 + j]; cw2[j] = pCW[2048 + col0 + j];
            lnw[j] = pLNW[col0 + j]; lnb[j] = pLNB[col0 + j]; um1[j] = 0.f; um2[j] = 0.f; }
        const int t0 = tok0 & (SEQ - 1);
        if (t0 >= 1) { float c1[8], c2[8]; load8(P + (size_t)(tok0 - 1) * P_LD + C_CC + col0, c1); load8(P + (size_t)(tok0 - 1) * P_LD + C_CH + col0, c2);
#pragma unroll
            for (int j = 0; j < 8; ++j) um1[j] = c1[j] * c2[j]; }
        if (t0 >= 2) { float c1[8], c2[8]; load8(P + (size_t)(tok0 - 2) * P_LD + C_CC + col0, c1); load8(P + (size_t)(tok0 - 2) * P_LD + C_CH + col0, c2);
#pragma unroll
            for (int j = 0; j < 8; ++j) um2[j] = c1[j] * c2[j]; }
#pragma unroll 2
        for (int tk = 0; tk < 8; ++tk) { const int tok = tok0 + tk; const bf16* pr = P + (size_t)tok * P_LD + col0;
            float c1[8], c2[8], cb[8], ga[8], gb[8], y[8], v[8], g[8], o[8];
            load8(pr + C_CC, c1); load8(pr + C_CH, c2); load8(pr + C_CB, cb); load8(pr + C_GA, ga); load8(pr + C_GB, gb);
            load8(Y + (size_t)tok * 1024 + col0, y); load8h(V + (size_t)tok * 1024 + col0, v); load8(LRg + (size_t)tok * 3072 + col0, g);
            const f32x4 bo4 = *(const f32x4*)(BONP + ((size_t)tok * 16 + head) * 4); const float bo = (bo4[0] + bo4[1]) + (bo4[2] + bo4[3]);
            float sm = 0.f;
#pragma unroll
            for (int j = 0; j < 8; ++j) sm += y[j];
            const float mean = sum8(sm) * (1.0f / 64.0f); float sq = 0.f;
#pragma unroll
            for (int j = 0; j < 8; ++j) { y[j] -= mean; sq += y[j] * y[j]; }
            const float rstd = __builtin_amdgcn_rsqf(sum8(sq) * (1.0f / 64.0f) + LNX_EPS);
#pragma unroll
            for (int j = 0; j < 8; ++j) { const float u = c1[j] * c2[j]; const float conv = cw0[j] * um2[j] + cw1[j] * um1[j] + cw2[j] * u; um2[j] = um1[j]; um1[j] = u;
                const float yconv = cb[j] * conv; const float yr = ((y[j] * rstd) * lnw[j] + lnb[j] + bo * v[j]) * g[j];
                o[j] = sigmoidf_(ga[j]) * yconv + sigmoidf_(gb[j]) * yr; }
            store8(M + (size_t)tok * 1024 + col0, o); }
    }
    }
}

struct GroupPick { float score, a1, a2; int i1, i2; };
__device__ __forceinline__ GroupPick pick_group(const f32x4 acc, float rstd, const float* br, const float* rb) {
    float aff[4], sel[4];
#pragma unroll
    for (int j = 0; j < 4; ++j) { aff[j] = sigmoidf_(rstd * acc[j] + br[j]); sel[j] = aff[j] + rb[j]; }
    int i1 = 0;
#pragma unroll
    for (int j = 1; j < 4; ++j) if (sel[j] > sel[i1]) i1 = j;
    int i2 = (i1 == 0) ? 1 : 0;
#pragma unroll
    for (int j = 0; j < 4; ++j) if (j != i1 && j != i2 && sel[j] > sel[i2]) i2 = j;
    GroupPick g; g.score = sel[i1] + sel[i2]; g.i1 = i1; g.i2 = i2; g.a1 = aff[i1]; g.a2 = aff[i2];
    float s1 = sel[0], s2 = sel[0]; (void)s1; (void)s2;
    return g;
}
__device__ __forceinline__ void p7_route(const Frame& F, int l, bool dry = false) {
    typedef short bfv8 __attribute__((ext_vector_type(8)));
    const int lane = F.lane, li = lane & 15, fq = lane >> 4;
    LAS unsigned* lcnt = (LAS unsigned*)(F.lds + 65536);
    const float* X = (const float*)(F.ws + WS_X); const bf16* WH = (const bf16*)(F.ws + WS_WRT); const bf16* WL = WH + 32768; const float* const pN2G = kin<I_N2G>() + l * 1024; const float* const pRB = kin<I_RB>();
#pragma unroll 1
    for (int gw = F.vcu * NWAVES + F.wave; gw < T / 8; gw += F.G * NWAVES) { const int tok0 = gw * 8, b = tok0 >> 11;
        if (F.tid < 32) lcnt[F.tid] = 0u;
        __syncthreads();
        const float* ad = ada_ptr(F, l, b);
        const float* xp = X + (size_t)(tok0 + (li & 7)) * 1024 + 8 * fq; const float* g1p = pN2G + 8 * fq; const float* g2p = ad + 4096 + 8 * fq;
        const bf16* wh0 = WH + li * 1024 + 8 * fq; const bf16* wl0 = WL + li * 1024 + 8 * fq;
        f32x4 acc0 = (f32x4){0.f, 0.f, 0.f, 0.f}, acc1 = acc0; float ssq = 0.f;
#pragma unroll 2
        for (int kb = 0; kb < 1024; kb += 32) {
            const f32x4 xa = *(const f32x4*)(xp + kb), xb = *(const f32x4*)(xp + kb + 4);
            const f32x4 ga = *(const f32x4*)(g1p + kb) * (1.0f + *(const f32x4*)(g2p + kb)), gb = *(const f32x4*)(g1p + kb + 4) * (1.0f + *(const f32x4*)(g2p + kb + 4));
            const bfv8 ah0 = *(const bfv8*)(wh0 + kb), al0 = *(const bfv8*)(wl0 + kb), ah1 = *(const bfv8*)(wh0 + 16 * 1024 + kb), al1 = *(const bfv8*)(wl0 + 16 * 1024 + kb);
            ssq += ((xa[0] * xa[0] + xa[1] * xa[1]) + (xa[2] * xa[2] + xa[3] * xa[3])) + ((xb[0] * xb[0] + xb[1] * xb[1]) + (xb[2] * xb[2] + xb[3] * xb[3]));
            const f32x4 ya = xa * ga, yb = xb * gb;
            u32x4 ph, pl;
            ph[0] = pkbf(ya[0], ya[1]); ph[1] = pkbf(ya[2], ya[3]); ph[2] = pkbf(yb[0], yb[1]); ph[3] = pkbf(yb[2], yb[3]);
            pl[0] = pkbf(ya[0] - bflo(ph[0]), ya[1] - bfhi(ph[0])); pl[1] = pkbf(ya[2] - bflo(ph[1]), ya[3] - bfhi(ph[1])); pl[2] = pkbf(yb[0] - bflo(ph[2]), yb[1] - bfhi(ph[2])); pl[3] = pkbf(yb[2] - bflo(ph[3]), yb[3] - bfhi(ph[3]));
            const bfv8 bh = __builtin_bit_cast(bfv8, ph), bl = __builtin_bit_cast(bfv8, pl);
            acc0 = __builtin_amdgcn_mfma_f32_16x16x32_bf16(ah0, bh, acc0, 0, 0, 0); acc0 = __builtin_amdgcn_mfma_f32_16x16x32_bf16(al0, bh, acc0, 0, 0, 0); acc0 = __builtin_amdgcn_mfma_f32_16x16x32_bf16(ah0, bl, acc0, 0, 0, 0);
            acc1 = __builtin_amdgcn_mfma_f32_16x16x32_bf16(ah1, bh, acc1, 0, 0, 0); acc1 = __builtin_amdgcn_mfma_f32_16x16x32_bf16(al1, bh, acc1, 0, 0, 0); acc1 = __builtin_amdgcn_mfma_f32_16x16x32_bf16(ah1, bl, acc1, 0, 0, 0);
        }
        ssq += __shfl_xor(ssq, 16); ssq += __shfl_xor(ssq, 32);
        const float rstd = __builtin_amdgcn_rsqf(ssq * (1.0f / 1024.0f) + NORM_EPS);
        const float* br = (const float*)(F.ws + WS_CTL + CTL_BIASR) + (l * 8 + b) * 32;
        const GroupPick ga_ = pick_group(acc0, rstd, br + 4 * fq, pRB + 4 * fq), gb_ = pick_group(acc1, rstd, br + 16 + 4 * fq, pRB + 16 + 4 * fq);
        const bool useb = gb_.score > ga_.score;
        const GroupPick gm = useb ? gb_ : ga_; const int mygrp = useb ? 4 + fq : fq;
        float bs = gm.score; int bg = mygrp;
#pragma unroll
        for (int off = 16; off < 64; off <<= 1) { const float os = __shfl_xor(bs, off); const int og = __shfl_xor(bg, off); if (os > bs || (os == bs && og < bg)) { bs = os; bg = og; } }
        if (mygrp == bg && li < 8) { const int tok = tok0 + li; const int e0 = 4 * bg + gm.i1, e1 = 4 * bg + gm.i2; const float inv = 1.0f / (gm.a1 + gm.a2);
            const int p0 = (int)__hip_atomic_fetch_add(lcnt + e0, 1u, __ATOMIC_RELAXED, __HIP_MEMORY_SCOPE_WORKGROUP), p1 = (int)__hip_atomic_fetch_add(lcnt + e1, 1u, __ATOMIC_RELAXED, __HIP_MEMORY_SCOPE_WORKGROUP);
            int* EI = (int*)(F.ws + WS_EIDX); int* PO = (int*)(F.ws + WS_POS); float* WT = (float*)(F.ws + WS_WTS);
            if (!dry) { EI[tok * 2] = e0; EI[tok * 2 + 1] = e1; PO[tok * 2] = p0; PO[tok * 2 + 1] = p1; WT[tok * 2] = gm.a1 * inv; WT[tok * 2 + 1] = gm.a2 * inv; } }
        __syncthreads();
        if (F.tid < 32 && !dry) ((int*)(F.ws + WS_HIST))[(l * 256 + (gw >> 3)) * 32 + F.tid] = (int)lcnt[F.tid];
        __syncthreads();
    }
}

__device__ __forceinline__ void expert_table(const Frame& F, int l, int grp = -1) {
    LAS int* tab = (LAS int*)(F.lds + TAB_OFF); LAS int* red = (LAS int*)F.lds;
    const int* hist = (const int*)(F.ws + WS_HIST) + l * 256 * 32; const int e = F.tid & 31, part = F.tid >> 5;
    int tot = 0, pre = 0;
#pragma unroll 4
    for (int g = part * 16; g < part * 16 + 16; ++g) { const int v = hist[g * 32 + e]; tot += v; pre += (g < grp) ? v : 0; }
    red[part * 32 + e] = tot; red[512 + part * 32 + e] = pre;
    __syncthreads();
    if (F.tid < 64) { int c = 0, pr = 0;
#pragma unroll
        for (int p = 0; p < 16; ++p) { c += red[p * 32 + e]; pr += red[512 + p * 32 + e]; }
        const int padded = (c + 255) & ~255; int inc = padded;
#pragma unroll
        for (int o = 1; o < 32; o <<= 1) { const int v = __shfl_up(inc, o); if (e >= o) inc += v; }
        if (F.lane < 32) { tab[e] = inc - padded; tab[33 + e] = (inc - padded) >> 8; tab[66 + e] = inc - padded + pr; if (e == 31) { tab[32] = inc; tab[65] = inc >> 8; } } }
    __syncthreads();
}

__device__ __forceinline__ void p8_dispatch(const Frame& F, int l) {
    const LAS int* tab = (const LAS int*)(F.lds + TAB_OFF);
    const float* const pN2G = kin<I_N2G>() + l * 1024;
    const int lane = F.lane;
#pragma unroll 1
    for (int gw = F.vcu * NWAVES + F.wave; gw < T / 8; gw += F.G * NWAVES) { const int tok0 = gw * 8, b = tok0 >> 11;
        expert_table(F, l, gw >> 3);
        const float* ad = ada_ptr(F, l, b); f32x4 gm[4], sh[4];
#pragma unroll
        for (int j = 0; j < 4; ++j) { const int c = 4 * lane + 256 * j; gm[j] = *(const f32x4*)(pN2G + c) * (1.0f + *(const f32x4*)(ad + 4096 + c)); sh[j] = *(const f32x4*)(ad + 3072 + c); }
        const float* X = (const float*)(F.ws + WS_X); const int* EI = (const int*)(F.ws + WS_EIDX); const int* PO = (const int*)(F.ws + WS_POS); int* SL = (int*)(F.ws + WS_SLOT); bf16* BUF = (bf16*)(F.ws + WS_BUF);
        for (int tk = 0; tk < 8; ++tk) { const int tok = tok0 + tk; f32x4 v[4]; float ss = 0.f;
#pragma unroll
            for (int j = 0; j < 4; ++j) { v[j] = *(const f32x4*)(X + (size_t)tok * 1024 + 4 * lane + 256 * j); ss += (v[j][0] * v[j][0] + v[j][1] * v[j][1]) + (v[j][2] * v[j][2] + v[j][3] * v[j][3]); }
            const float rstd = __builtin_amdgcn_rsqf(wave_sum(ss) * (1.0f / 1024.0f) + NORM_EPS);
            const int s0 = tab[66 + EI[tok * 2]] + PO[tok * 2], s1 = tab[66 + EI[tok * 2 + 1]] + PO[tok * 2 + 1];
            if (lane == 0) { SL[tok * 2] = s0; SL[tok * 2 + 1] = s1; }
#pragma unroll
            for (int j = 0; j < 4; ++j) { const f32x4 h = v[j] * rstd * gm[j] + sh[j]; u32x2 w; w.x = pk2(h[0], h[1]); w.y = pk2(h[2], h[3]);
                *(u32x2*)(BUF + (size_t)s0 * 1024 + 4 * lane + 256 * j) = w; *(u32x2*)(BUF + (size_t)s1 * 1024 + 4 * lane + 256 * j) = w; } }
    }
}

#ifndef PHMASK
#define PHMASK 0xFFFF
#endif
#define PHM(n) (((PHMASK) >> (n)) & 1)
constexpr int NPHASES = 25;
__global__ void __launch_bounds__(NWAVES * 64, 2) trunk_fwd(Args args) {
    extern __shared__ __attribute__((aligned(16))) unsigned char lds_raw[];
    Frame F;
    F.lds = (LAS unsigned char*)lds_raw;
    F.tid = threadIdx.x; F.lane = F.tid & 63; F.wave = __builtin_amdgcn_readfirstlane(F.tid >> 6);
    F.G = gridDim.x; { const int bx = blockIdx.x; F.vcu = (F.G % 8 == 0) ? (bx % 8) * (F.G / 8) + bx / 8 : bx; }
    GAS unsigned char* const wsbase = (GAS unsigned char*)kin<29>(); F.ws = wsbase; const int vcu0 = F.vcu;
    volatile LAS unsigned* MISC = (volatile LAS unsigned*)(F.lds + MISC_OFF);
    if (F.tid < 32) MISC[F.tid] = 0u;
    __syncthreads();
    const unsigned long long lohi = (unsigned long long)kin<30>(); const int lo = (int)(unsigned)lohi, hi = (int)(unsigned)(lohi >> 32);
    XcdBarrier bar; bar.bar = (unsigned*)(F.ws + WS_CTL) + CW_BAR; bar.x = 0; bar.st = nullptr;
    if (hi - lo > 1) bar = xcd_barrier_post((unsigned*)(F.ws + WS_CTL) + CW_BAR, MISC + 8);
#pragma unroll 1
#if defined(REP_PH)
    for (int phx = lo; phx < hi + REP_N; ++phx) { const int ph = (phx <= REP_PH) ? phx : ((phx - REP_N > REP_PH) ? phx - REP_N : REP_PH);
#else
    for (int ph = lo; ph < hi; ++ph) {
#endif
        { int t_ = threadIdx.x; asm volatile("" : "+v"(t_)); F.tid = t_; F.lane = t_ & 63; F.wave = __builtin_amdgcn_readfirstlane(t_ >> 6);
          GAS unsigned char* w_ = wsbase; asm volatile("" : "+s"(w_)); F.ws = w_; int v_ = vcu0; asm volatile("" : "+s"(v_)); F.vcu = v_; }
        const int l = (ph - 2) / 11, k = (ph >= 2 && ph <= 23) ? (ph - 2) % 11 : -1;
        if (PHM(0) && ph == 0) p0_prologue(F);
        else if (PHM(0) && ph == 1) p0b_ada_reduce(F);
        else if (PHM(1) && ph == 24) p1_norm<2>(F, 1);
        else if (PHM(1) && k == 0) { if (l == 0) p1_norm<0>(F, 0); else p1_norm<1>(F, 1); }
        else if (PHM(3) && k == 2) p2b_lra(F, l);
        #if defined(DBG_SCAN)
        else if (PHM(4) && k == 4) { p4_scan_seq(F, l); __syncthreads(); if (l == 0) p4_scan(F, l); }
#else
        else if (PHM(4) && k == 4) p4_scan(F, l);
#endif
        else if (PHM(5) && k == 5) p5_post(F, l);
        #if defined(REP_PH)
        else if (PHM(7) && k == 7) p7_route(F, l, phx > REP_PH && ph == REP_PH);
#else
        else if (PHM(7) && k == 7) p7_route(F, l);
#endif
        else if (PHM(8) && k == 8) p8_dispatch(F, l);
        else if (PHM(2) && (k == 1 || k == 3 || k == 6 || k == 9 || k == 10)) {
            pg8::Gemm g; pg8::UniOrder S; pg8::EpiUni E;
            S.expert = (k >= 9); S.so.init(T, 1024, F.G, (int)blockIdx.x); S.eo = pg8::ExpertOrder{(const PG8_LAS int*)(F.lds + TAB_OFF + 33 * 4), 0, F.G, (int)blockIdx.x};
            E.e0 = pg8::EpiBf16Plain{(bf16*)(F.ws + WS_P), P_LD, -1}; E.e1 = pg8::EpiResid{nullptr, (float*)(F.ws + WS_X), ada_ptr(F, l, 0) + 2048, 6144}; E.e2 = pg8::EpiSwiGLU{(bf16*)(F.ws + WS_HB)};
            if (k == 1) {
                const int N = (l == 0) ? N_IN : P_LD; S.so.init(T, N, F.G, (int)blockIdx.x); E.mode = 0;
                g = pg8::Gemm{(const bf16*)(F.ws + WS_H), (const bf16*)(F.ws + WS_BT_IN) + (size_t)l * P_LD * 1024, T, N, 1024};
            } else if (k == 3) {
                S.so.init(T, 3072, F.G, (int)blockIdx.x); E.mode = 0; E.e0 = pg8::EpiBf16Plain{(bf16*)(F.ws + WS_LR), 3072, -1};
                g = pg8::Gemm{(const bf16*)(F.ws + WS_ALR), (const bf16*)(F.ws + WS_BT_LR) + (size_t)l * 3072 * 256, T, 3072, 256};
            } else if (k == 6) {
                E.mode = 1; E.e1.xin = (l == 0) ? kin<I_X>() : (const float*)(F.ws + WS_X);
                g = pg8::Gemm{(const bf16*)(F.ws + WS_H), (const bf16*)(F.ws + WS_BT_OUT) + (size_t)l * 1024 * 1024, T, 1024, 1024};
            } else {
                expert_table(F, l);
                S.eo.ntiles = ((const LAS int*)(F.lds + TAB_OFF))[65];
                if (k == 9) { E.mode = 2; g = pg8::Gemm{(const bf16*)(F.ws + WS_BUF), (const bf16*)(F.ws + WS_BT_E1) + (size_t)l * 32 * 1024 * 1024, MAXROWS, 32 * 1024, 1024}; }
                else { E.mode = 0; E.e0 = pg8::EpiBf16Plain{(bf16*)(F.ws + WS_YE), 1024, 3}; g = pg8::Gemm{(const bf16*)(F.ws + WS_HB), (const bf16*)(F.ws + WS_BT_E2) + (size_t)l * 32 * 1024 * 512, MAXROWS, 32 * 1024, 512}; }
            }
            pg8::gemm_phase<pg8::EpiUni, pg8::UniOrder, true, true>(F.lds, g, S, E);
        }
#if defined(REP_PH)
        if (phx + 1 < hi + REP_N) xcd_barrier(bar);
#else
        if (ph + 1 < hi) xcd_barrier(bar);
#endif
    }
}

extern "C" void kernel_launch(void* const* d_in, const int* in_sizes, int n_in, void* d_out, int out_size, void* d_ws, size_t ws_size, hipStream_t stream) {
    static int grid = 0;
    if (grid == 0) {
        if (n_in != 28 || in_sizes[0] != T * D || out_size != T * D || ws_size < WS_END) { fprintf(stderr, "kernel_launch: unexpected shapes (n_in %d, in0 %d, out %d, ws %zu < %zu?); nothing launched\n", n_in, n_in > 0 ? in_sizes[0] : -1, out_size, ws_size, (size_t)WS_END); grid = -1; return; }
        int dev = 0, cus = 0, per_cu = 0;
        if (hipGetDevice(&dev) != hipSuccess || hipDeviceGetAttribute(&cus, hipDeviceAttributeMultiprocessorCount, dev) != hipSuccess) { fprintf(stderr, "kernel_launch: device query failed\n"); grid = -1; return; }
        if (hipFuncSetAttribute((const void*)trunk_fwd, hipFuncAttributeMaxDynamicSharedMemorySize, LDS_BYTES) != hipSuccess) { fprintf(stderr, "kernel_launch: hipFuncSetAttribute failed\n"); grid = -1; return; }
        if (hipOccupancyMaxActiveBlocksPerMultiprocessor(&per_cu, (const void*)trunk_fwd, NWAVES * 64, LDS_BYTES) != hipSuccess || per_cu < 1) { fprintf(stderr, "kernel_launch: occupancy query says %d blocks per CU\n", per_cu); }
        (void)hipGetLastError();
        grid = cus;
    }
    if (grid < 0) return;
    if (hipMemsetAsync((char*)d_ws + WS_CTL, 0, CTL_ZERO_BYTES, stream) != hipSuccess) { fprintf(stderr, "kernel_launch: memset failed\n"); return; }
    Args a{};
    for (int i = 0; i < 28; ++i) a.p[i] = d_in[i];
    a.p[28] = d_out; a.p[29] = d_ws;
#if MK_ONE_LAUNCH
    a.ph_lo = 0; a.ph_hi = NPHASES;
    void* kargs[] = {&a};
    hipError_t e = hipLaunchCooperativeKernel((const void*)trunk_fwd, dim3(grid), dim3(NWAVES * 64), kargs, LDS_BYTES, stream);
    if (e != hipSuccess) fprintf(stderr, "kernel_launch: cooperative launch failed: %s (grid %d)\n", hipGetErrorString(e), grid);
#else
    for (int p = 0; p < NPHASES; ++p) { a.ph_lo = p; a.ph_hi = p + 1;
        hipLaunchKernelGGL(trunk_fwd, dim3(grid), dim3(NWAVES * 64), LDS_BYTES, stream, a);
        const hipError_t le = hipPeekAtLastError(); if (le != hipSuccess) { fprintf(stderr, "kernel_launch: launch %d failed: %s\n", p, hipGetErrorName(le)); break; } }
#endif
}
```

```cpp
#include <hip/hip_runtime.h>
#include <cstdio>
#include <cstdint>

#ifndef MK_ONE_LAUNCH
#define MK_ONE_LAUNCH 1
#endif

namespace pg8 {
#define PG8_LAS __attribute__((address_space(3)))
typedef unsigned short bf16_t;
typedef short bf16x8 __attribute__((ext_vector_type(8)));
typedef float f32x4 __attribute__((ext_vector_type(4)));
typedef unsigned u32x4 __attribute__((ext_vector_type(4)));
constexpr int BM = 256, BK = 64, HALF = 128, HTB = HALF * BK * 2  , STAGE_BYTES = 8 * HTB, NXCD = 8, WGM = 8;

__host__ __device__ __forceinline__ int lds_byte(int r, int c) { const int st = (r >> 4) * 2 + (c >> 5), rr = r & 15, cc = c & 31, ob = rr * 64 + cc * 2; return st * 1024 + (ob ^ (((ob >> 9) & 1) << 5)); }
__host__ __device__ __forceinline__ void stage_rc(int b, int& R, int& C) { const int st = b / 1024, sb = b % 1024, swz = sb ^ (((sb >> 9) & 1) << 5); R = (st >> 1) * 16 + swz / 64; C = (st & 1) * 32 + (swz % 64) / 2; }
__host__ __device__ __forceinline__ int perm32(int rho) { const int n = rho >> 4, i = rho & 15; return 8 * (i >> 2) + 4 * n + (i & 3); }

struct Unit { int pm, pn; };
struct Gemm { const bf16_t* A; const bf16_t* Bt; int M, N, K; };

struct StaticOrder {
    int nM, nN, nwg, G, c;
    __host__ __device__ void init(int M, int N, int G_, int c_) { nM = M / BM; nN = N / BM; nwg = nM * nN; G = G_; c = c_; }
    __host__ __device__ bool next(int i, Unit& u) const {
        const long L = (long)i * G + c; if (L >= nwg) return false;
        int wgid = (int)L; { const int q = nwg / NXCD, r = nwg % NXCD, xcd = wgid % NXCD, off = wgid / NXCD; wgid = (xcd < r ? xcd * (q + 1) : r * (q + 1) + (xcd - r) * q) + off; }
        const int nig = WGM * nN, gid = wgid / nig, fm = gid * WGM, gsz = (nM - fm) < WGM ? (nM - fm) : WGM;
        u.pm = fm + ((wgid % nig) % gsz); u.pn = (wgid % nig) / gsz; return true;
    }
    __device__ __forceinline__ void a_ready(const Unit&) const {}
    __device__ __forceinline__ void done(const Unit&) const {}
};
__device__ __forceinline__ unsigned cvt_pk_bf16(float lo, float hi) { unsigned r; asm volatile("v_cvt_pk_bf16_f32 %0, %1, %2" : "=v"(r) : "v"(lo), "v"(hi)); return r; }
typedef float f32x2 __attribute__((ext_vector_type(2)));
typedef unsigned u32x2 __attribute__((ext_vector_type(2)));

struct EpiBf16Plain {
    static constexpr bool PERM = true, AFTER_DRAIN = false;
    bf16_t* O; int ldc; int cmask;
    __device__ __forceinline__ void operator()(const f32x4 (&acc)[2][2][4][2], const Unit& u, int wr, int wc, int fr, int fq) const {
        const int row0 = u.pm * BM + wr * 64 + fr; const int col0 = (u.pn & cmask) * BM + wc * 32 + 8 * fq;
#pragma unroll
        for (int ai = 0; ai < 2; ++ai)
#pragma unroll
            for (int m = 0; m < 4; ++m) { bf16_t* rowp = O + (size_t)(row0 + ai * HALF + m * 16) * ldc + col0;
#pragma unroll
                for (int bj = 0; bj < 2; ++bj) { const f32x4 v0 = acc[ai][bj][m][0], v1 = acc[ai][bj][m][1];
                    u32x4 w; w.x = cvt_pk_bf16(v0[0], v0[1]); w.y = cvt_pk_bf16(v0[2], v0[3]); w.z = cvt_pk_bf16(v1[0], v1[1]); w.w = cvt_pk_bf16(v1[2], v1[3]);
                    *(u32x4*)(rowp + bj * HALF) = w; } }
    }
};
struct EpiResid {
    static constexpr bool PERM = false, AFTER_DRAIN = false;
    const float* xin; float* xout; const float* gate;
    int gstride;
    __device__ __forceinline__ void operator()(const f32x4 (&acc)[2][2][4][2], const Unit& u, int wr, int wc, int fr, int fq) const {
        const int row0 = u.pm * BM + wr * 64 + fr, col0 = u.pn * BM + wc * 32 + 4 * fq;
        const float* gp = gate + (size_t)(u.pm >> 3) * gstride;
        f32x4 gv[2][2];
#pragma unroll
        for (int bj = 0; bj < 2; ++bj)
#pragma unroll
            for (int n = 0; n < 2; ++n) gv[bj][n] = *(const f32x4*)(gp + col0 + bj * HALF + n * 16);
#pragma unroll
        for (int ai = 0; ai < 2; ++ai)
#pragma unroll
            for (int m = 0; m < 4; ++m) { const size_t ro = (size_t)(row0 + ai * HALF + m * 16) * 1024 + col0;
#pragma unroll
                for (int bj = 0; bj < 2; ++bj)
#pragma unroll
                    for (int n = 0; n < 2; ++n) { const f32x4 xi = *(const f32x4*)(xin + ro + bj * HALF + n * 16);
                        *(f32x4*)(xout + ro + bj * HALF + n * 16) = xi + gv[bj][n] * acc[ai][bj][m][n]; }
                asm volatile("" ::: "memory"); }
    }
};
struct EpiSwiGLU {
    static constexpr bool PERM = false, AFTER_DRAIN = false;
    bf16_t* O;
    __device__ __forceinline__ void operator()(const f32x4 (&acc)[2][2][4][2], const Unit& u, int wr, int wc, int fr, int fq) const {
        const int row0 = u.pm * BM + wr * 64 + fr, col0 = (u.pn & 3) * HALF + wc * 32 + 4 * fq;
#pragma unroll
        for (int ai = 0; ai < 2; ++ai)
#pragma unroll
            for (int m = 0; m < 4; ++m) { bf16_t* rowp = O + (size_t)(row0 + ai * HALF + m * 16) * 512 + col0;
#pragma unroll
                for (int n = 0; n < 2; ++n) { const f32x4 g = acc[ai][0][m][n], up = acc[ai][1][m][n]; f32x4 h;
#pragma unroll
                    for (int j = 0; j < 4; ++j) h[j] = g[j] * __builtin_amdgcn_rcpf(1.0f + __expf(-g[j])) * up[j];
                    u32x2 w; w.x = cvt_pk_bf16(h[0], h[1]); w.y = cvt_pk_bf16(h[2], h[3]);
                    *(u32x2*)(rowp + n * 16) = w; } }
    }
};
struct ExpertOrder {
    const PG8_LAS int* ts; int ntiles, G, c;
    __device__ __forceinline__ bool next(int i, Unit& u) const {
        const int L = i * G + c; if (L >= ntiles * 4) return false;
        const int pm = L >> 2; int e = 0;
#pragma unroll 1
        for (int k = 1; k < 32; ++k) e += (ts[k] <= pm) ? 1 : 0;
        u.pm = pm; u.pn = e * 4 + (L & 3); return true;
    }
    __device__ __forceinline__ void a_ready(const Unit&) const {}
    __device__ __forceinline__ void done(const Unit&) const {}
};

struct UniOrder {
    StaticOrder so; ExpertOrder eo; bool expert;
    __device__ __forceinline__ bool next(int i, Unit& u) const { return expert ? eo.next(i, u) : so.next(i, u); }
    __device__ __forceinline__ void a_ready(const Unit&) const {}
    __device__ __forceinline__ void done(const Unit&) const {}
};
struct EpiUni {
    static constexpr bool AFTER_DRAIN = false;
    int mode; EpiBf16Plain e0; EpiResid e1; EpiSwiGLU e2;
    __device__ __forceinline__ bool perm() const { return mode == 0; }
    __device__ __forceinline__ void operator()(const f32x4 (&acc)[2][2][4][2], const Unit& u, int wr, int wc, int fr, int fq) const {
        if (mode == 0) e0(acc, u, wr, wc, fr, fq); else if (mode == 1) e1(acc, u, wr, wc, fr, fq); else e2(acc, u, wr, wc, fr, fq);
    }
};
template <class Epi, class Sched, bool ALIGN_EPI = false, bool SP2 = false>
__device__ __forceinline__ void gemm_phase(PG8_LAS unsigned char* lds, const Gemm g, const Sched& S, const Epi& E) {
    int tid_ = threadIdx.x; asm volatile("" : "+v"(tid_));
    const int tid = tid_, wid = __builtin_amdgcn_readfirstlane(tid >> 6), lane = tid & 63, wr = wid >> 2, wc = wid & 3, fr = lane & 15, fq = lane >> 4;
    const int K = g.K, nt = K / BK;
    unsigned voffA[2], voffB[2];
#pragma unroll
    for (int i = 0; i < 2; ++i) { int R, C; stage_rc(tid * 16 + i * 8192, R, C); const int Rb = E.perm() ? ((R & ~31) + perm32(R & 31)) : R;
        voffA[i] = (unsigned)(R * K + C) * 2u; voffB[i] = (unsigned)(Rb * K + C) * 2u; }
    const size_t kstep = (size_t)(BK * 2);
    const size_t hstep = (size_t)HALF * K * 2;
    const size_t tstep = 2 * hstep;
    const unsigned ldsw = (unsigned)wid * 1024u;
    const int aoff = lds_byte(wr * 64 + fr, fq * 8), boff = lds_byte(wc * 32 + fr, fq * 8);
#define PG8_SA(b, h) (((b) * 2 + (h)) * HTB)
#define PG8_SB(b, h) ((4 + (b) * 2 + (h)) * HTB)
#define PG8_STAGE(bufoff, gbase, voff) do { _Pragma("unroll") for (int _i = 0; _i < 2; ++_i) \
        __builtin_amdgcn_global_load_lds((const unsigned*)((const char*)(gbase) + (voff)[_i]), (PG8_LAS unsigned*)(lds + (bufoff) + ldsw + _i * 8192), 16, 0, 0); } while (0)
#define PG8_LDA(dst, b, h) do { _Pragma("unroll") for (int m = 0; m < 4; ++m) _Pragma("unroll") for (int k = 0; k < 2; ++k) dst[m][k] = *(const PG8_LAS bf16x8*)(lds + PG8_SA(b, h) + aoff + m * 2048 + k * 1024); } while (0)
#define PG8_LDB(dst, b, h) do { _Pragma("unroll") for (int n = 0; n < 2; ++n) _Pragma("unroll") for (int k = 0; k < 2; ++k) dst[n][k] = *(const PG8_LAS bf16x8*)(lds + PG8_SB(b, h) + boff + n * 2048 + k * 1024); } while (0)
#define PG8_MMA(ai, bj, At, Bt) do { __builtin_amdgcn_s_setprio(1); _Pragma("unroll") for (int m = 0; m < 4; ++m) _Pragma("unroll") for (int n = 0; n < 2; ++n) _Pragma("unroll") for (int k = 0; k < 2; ++k) \
        acc[ai][bj][m][n] = __builtin_amdgcn_mfma_f32_16x16x32_bf16(Bt[n][k], At[m][k], acc[ai][bj][m][n], 0, 0, 0); __builtin_amdgcn_s_setprio(0); } while (0)
#define PG8_WAIT_V(n) asm volatile("s_waitcnt vmcnt(" #n ")" ::: "memory")
#define PG8_WAIT_L(n) asm volatile("s_waitcnt lgkmcnt(" #n ")" ::: "memory")
#define PG8_BAR __builtin_amdgcn_s_barrier()
#define PG8_SCHED __builtin_amdgcn_sched_barrier(0)
    Unit cur, nxt; int ui = 0;
    if (!S.next(0, cur)) return;
    f32x4 acc[2][2][4][2];
#pragma unroll
    for (int a = 0; a < 2; ++a)
#pragma unroll
        for (int b = 0; b < 2; ++b)
#pragma unroll
            for (int m = 0; m < 4; ++m)
#pragma unroll
                for (int n = 0; n < 2; ++n) acc[a][b][m][n] = (f32x4){0.f, 0.f, 0.f, 0.f};
    bf16x8 At[4][2], B0[2][2], B1[2][2];
    const char* cA = (const char*)g.A + (size_t)cur.pm * tstep; const char* cB = (const char*)g.Bt + (size_t)cur.pn * tstep;
    S.a_ready(cur);
    if constexpr (SP2) {
        PG8_STAGE(PG8_SB(0, 0), cB, voffB); PG8_STAGE(PG8_SB(0, 1), cB + hstep, voffB); PG8_STAGE(PG8_SA(0, 0), cA, voffA); PG8_STAGE(PG8_SA(0, 1), cA + hstep, voffA);
        if (wr == 1) PG8_BAR;
        PG8_WAIT_V(2); PG8_BAR;
        PG8_STAGE(PG8_SB(1, 0), cB + kstep, voffB); PG8_STAGE(PG8_SA(1, 0), cA + kstep, voffA); PG8_STAGE(PG8_SB(1, 1), cB + hstep + kstep, voffB);
        PG8_WAIT_V(6); PG8_BAR;
    } else {
        PG8_STAGE(PG8_SB(0, 0), cB, voffB); PG8_STAGE(PG8_SA(0, 0), cA, voffA); PG8_STAGE(PG8_SB(0, 1), cB + hstep, voffB); PG8_STAGE(PG8_SA(0, 1), cA + hstep, voffA);
        if (wr == 1) PG8_BAR;
        PG8_WAIT_V(4); PG8_BAR;
        PG8_STAGE(PG8_SB(1, 0), cB + kstep, voffB); PG8_STAGE(PG8_SA(1, 0), cA + kstep, voffA); PG8_STAGE(PG8_SB(1, 1), cB + hstep + kstep, voffB);
        PG8_WAIT_V(6); PG8_BAR;
    }
    for (;;) {
        const bool has_next = S.next(ui + 1, nxt);
        const char* nA = has_next ? (const char*)g.A + (size_t)nxt.pm * tstep : cA; const char* nB = has_next ? (const char*)g.Bt + (size_t)nxt.pn * tstep : cB;
        for (int t = 0; t < nt; t += 2) {
            const bool last = (t == nt - 2);
            const char* a1 = cA + (size_t)(t + 1) * kstep;
            const char* a2 = last ? nA : cA + (size_t)(t + 2) * kstep; const char* b2 = last ? nB : cB + (size_t)(t + 2) * kstep;
            const char* a3 = a2 + kstep; const char* b3 = b2 + kstep;
            if (last && has_next) S.a_ready(nxt);
            if constexpr (SP2) {
            PG8_LDB(B0, 0, 0); PG8_LDB(B1, 0, 1); PG8_SCHED; PG8_LDA(At, 0, 0); PG8_STAGE(PG8_SA(1, 1), a1 + hstep, voffA);
            PG8_WAIT_V(8); PG8_WAIT_L(0); PG8_BAR; PG8_MMA(0, 0, At, B0); PG8_MMA(0, 1, At, B1); PG8_BAR; PG8_SCHED;
            PG8_LDA(At, 0, 1); PG8_STAGE(PG8_SB(0, 0), b2, voffB); PG8_STAGE(PG8_SB(0, 1), b2 + hstep, voffB); PG8_STAGE(PG8_SA(0, 0), a2, voffA);
            PG8_WAIT_V(8); PG8_WAIT_L(0); PG8_BAR; PG8_MMA(1, 0, At, B0); PG8_MMA(1, 1, At, B1); PG8_BAR; PG8_SCHED;
            PG8_LDB(B0, 1, 0); PG8_LDB(B1, 1, 1); PG8_SCHED; PG8_LDA(At, 1, 0); PG8_STAGE(PG8_SA(0, 1), a2 + hstep, voffA);
            PG8_WAIT_V(8); PG8_WAIT_L(0); PG8_BAR; PG8_MMA(0, 0, At, B0); PG8_MMA(0, 1, At, B1); PG8_BAR; PG8_SCHED;
            PG8_LDA(At, 1, 1); PG8_STAGE(PG8_SB(1, 0), b3, voffB); PG8_STAGE(PG8_SB(1, 1), b3 + hstep, voffB); PG8_STAGE(PG8_SA(1, 0), a3, voffA);
            PG8_WAIT_V(8); PG8_WAIT_L(0); PG8_BAR; PG8_MMA(1, 0, At, B0); PG8_MMA(1, 1, At, B1); PG8_BAR; PG8_SCHED;
            } else {
            PG8_LDB(B0, 0, 0); PG8_SCHED; PG8_LDA(At, 0, 0); PG8_STAGE(PG8_SA(1, 1), a1 + hstep, voffA);
            PG8_WAIT_L(8); PG8_BAR; PG8_WAIT_L(0); PG8_MMA(0, 0, At, B0); PG8_BAR; PG8_SCHED;
            PG8_LDB(B1, 0, 1); PG8_STAGE(PG8_SB(0, 0), b2, voffB);
            PG8_BAR; PG8_WAIT_L(0); PG8_MMA(0, 1, At, B1); PG8_BAR;
            PG8_LDA(At, 0, 1); PG8_STAGE(PG8_SA(0, 0), a2, voffA);
            PG8_BAR; PG8_WAIT_L(0); PG8_MMA(1, 0, At, B0); PG8_BAR; PG8_SCHED;
            PG8_STAGE(PG8_SB(0, 1), b2 + hstep, voffB);
            PG8_WAIT_V(6); PG8_BAR; PG8_MMA(1, 1, At, B1); PG8_BAR;
            PG8_LDB(B0, 1, 0); PG8_SCHED; PG8_LDA(At, 1, 0); PG8_STAGE(PG8_SA(0, 1), a2 + hstep, voffA);
            PG8_WAIT_L(8); PG8_BAR; PG8_WAIT_L(0); PG8_MMA(0, 0, At, B0); PG8_BAR; PG8_SCHED;
            PG8_LDB(B1, 1, 1); PG8_STAGE(PG8_SB(1, 0), b3, voffB);
            PG8_BAR; PG8_WAIT_L(0); PG8_MMA(0, 1, At, B1); PG8_BAR;
            PG8_LDA(At, 1, 1); PG8_STAGE(PG8_SA(1, 0), a3, voffA);
            PG8_BAR; PG8_WAIT_L(0); PG8_MMA(1, 0, At, B0); PG8_BAR; PG8_SCHED;
            PG8_STAGE(PG8_SB(1, 1), b3 + hstep, voffB);
            PG8_WAIT_V(6); PG8_BAR; PG8_MMA(1, 1, At, B1); PG8_BAR;
            }
        }
        if constexpr (ALIGN_EPI) { if (wr == 0) PG8_BAR; }
        if constexpr (!Epi::AFTER_DRAIN) { E(acc, cur, wr, wc, fr, fq); S.done(cur); }
        if (!has_next) break;
#pragma unroll
        for (int a = 0; a < 2; ++a)
#pragma unroll
            for (int b = 0; b < 2; ++b)
#pragma unroll
                for (int m = 0; m < 4; ++m)
#pragma unroll
                    for (int n = 0; n < 2; ++n) acc[a][b][m][n] = (f32x4){0.f, 0.f, 0.f, 0.f};
        cur = nxt; cA = nA; cB = nB; ++ui;
        if constexpr (ALIGN_EPI) { if (wr == 1) PG8_BAR; }
    }
    PG8_WAIT_V(0);
    if constexpr (!ALIGN_EPI) { if (wr == 0) PG8_BAR; }
    PG8_BAR;
    if constexpr (Epi::AFTER_DRAIN) { E.fused(acc, cur, wr, wc, fr, fq, lds, wid, lane); S.done(cur); }
#undef PG8_SA
#undef PG8_SB
#undef PG8_STAGE
#undef PG8_LDA
#undef PG8_LDB
#undef PG8_MMA
#undef PG8_WAIT_V
#undef PG8_WAIT_L
#undef PG8_BAR
#undef PG8_SCHED
}
}

constexpr int NWAVES = 8;
constexpr int T = 16384, D = 1024, SEQ = 2048, NBATCH = 8, NHEAD = 16;
constexpr int N_IN = 8448, P_LD = 9472;
constexpr int C_CB = 0, C_CC = 1024, C_CH = 2048, C_GA = 3072, C_GB = 4096, C_R = 5120, C_K = 6144, C_V = 7168, C_WD = 8192, C_AD = 8256, C_GD = 8320, C_VD = 8448;
constexpr int N_SHIFT = 3328, N_EXP = 32, D_EXP = 512;
constexpr int MAXROWS = 40960;
constexpr float NORM_EPS = 1e-6f, LNX_EPS = 64e-5f;

constexpr size_t MiB = 1u << 20;
constexpr size_t WS_CTL = 0, CTL_ZERO_BYTES = 1 * MiB;
constexpr size_t WS_BT_IN = 2 * MiB;
constexpr size_t WS_BT_OUT = 39 * MiB;
constexpr size_t WS_BT_E1 = 43 * MiB;
constexpr size_t WS_BT_E2 = 171 * MiB;
constexpr size_t WS_H = 235 * MiB;
constexpr size_t WS_ALR = WS_H;
constexpr size_t WS_P = 267 * MiB;
constexpr size_t WS_BUF = WS_P, WS_HB = WS_P + 80 * MiB, WS_YE = WS_P + 120 * MiB;
constexpr size_t WS_ADAP = WS_P;
constexpr size_t WS_W = 563 * MiB;
constexpr size_t WS_KK = 627 * MiB, WS_BQ = 659 * MiB, WS_KP = 691 * MiB, WS_R = 723 * MiB, WS_V0 = 755 * MiB, WS_V1 = 787 * MiB;
constexpr size_t WS_LR = 819 * MiB;
constexpr size_t WS_Y = 915 * MiB;
constexpr size_t WS_X = 947 * MiB;
constexpr size_t WS_BONUS = 1011 * MiB;
constexpr size_t WS_EIDX = 1012 * MiB, WS_POS = WS_EIDX + 128 * 1024, WS_WTS = WS_EIDX + 256 * 1024, WS_SLOT = WS_EIDX + 384 * 1024;
constexpr size_t WS_HIST = WS_EIDX + 512 * 1024;
constexpr size_t WS_WRT = WS_EIDX + 768 * 1024;
constexpr size_t WS_KN = WS_KK;
constexpr size_t WS_BONP = WS_KK + 2 * MiB;
constexpr size_t WS_BT_LR = 1015 * MiB;
constexpr size_t WS_END = 1018 * MiB;
static_assert(WS_YE + (size_t)MAXROWS * 1024 * 2 <= WS_W && WS_P + (size_t)T * P_LD * 2 <= WS_W && WS_BT_IN + (size_t)2 * P_LD * 2048 <= WS_BT_OUT, "ws map");
constexpr int CW_CNT = 1024;
constexpr int CW_BAR = 4096;
constexpr size_t CTL_ADA = 256 * 1024;
constexpr size_t CTL_BIASR = 700 * 1024;

constexpr int RING_BYTES = 131072;
constexpr int TAB_OFF = RING_BYTES;
constexpr int MISC_OFF = RING_BYTES + 1024;
constexpr int LDS_BYTES = 147456;

#define GAS __attribute__((address_space(1)))
#define LAS __attribute__((address_space(3)))
typedef unsigned short bf16;
typedef float f32x4 __attribute__((ext_vector_type(4)));
typedef float f32x2 __attribute__((ext_vector_type(2)));
typedef unsigned u32x4 __attribute__((ext_vector_type(4)));
typedef unsigned u32x2 __attribute__((ext_vector_type(2)));
#define LDS_WAIT() asm volatile("s_waitcnt lgkmcnt(0)" ::: "memory")

__device__ __forceinline__ unsigned f2bf(float f) { unsigned u = __builtin_bit_cast(unsigned, f); return (u + 0x7fffu + ((u >> 16) & 1u)) >> 16; }
__device__ __forceinline__ unsigned pk2(float lo, float hi) { return f2bf(lo) | (f2bf(hi) << 16); }
__device__ __forceinline__ float bflo(unsigned u) { return __builtin_bit_cast(float, u << 16); }
__device__ __forceinline__ float bfhi(unsigned u) { return __builtin_bit_cast(float, u & 0xffff0000u); }
__device__ __forceinline__ void load8(const bf16* p, float (&o)[8]) { const u32x4 u = *(const u32x4*)p; o[0] = bflo(u.x); o[1] = bfhi(u.x); o[2] = bflo(u.y); o[3] = bfhi(u.y); o[4] = bflo(u.z); o[5] = bfhi(u.z); o[6] = bflo(u.w); o[7] = bfhi(u.w); }
__device__ __forceinline__ void store8(bf16* p, const float (&v)[8]) { u32x4 w; w.x = pk2(v[0], v[1]); w.y = pk2(v[2], v[3]); w.z = pk2(v[4], v[5]); w.w = pk2(v[6], v[7]); *(u32x4*)p = w; }
typedef _Float16 f16x2 __attribute__((ext_vector_type(2)));
__device__ __forceinline__ unsigned pkh2(float lo, float hi) { f16x2 h; h.x = (_Float16)lo; h.y = (_Float16)hi; return __builtin_bit_cast(unsigned, h); }
__device__ __forceinline__ float hlo(unsigned u) { return (float)__builtin_bit_cast(f16x2, u).x; }
__device__ __forceinline__ float hhi(unsigned u) { return (float)__builtin_bit_cast(f16x2, u).y; }
__device__ __forceinline__ void load8h(const bf16* p, float (&o)[8]) { const u32x4 u = *(const u32x4*)p; o[0] = hlo(u.x); o[1] = hhi(u.x); o[2] = hlo(u.y); o[3] = hhi(u.y); o[4] = hlo(u.z); o[5] = hhi(u.z); o[6] = hlo(u.w); o[7] = hhi(u.w); }
__device__ __forceinline__ void store8h(bf16* p, const float (&v)[8]) { u32x4 w; w.x = pkh2(v[0], v[1]); w.y = pkh2(v[2], v[3]); w.z = pkh2(v[4], v[5]); w.w = pkh2(v[6], v[7]); *(u32x4*)p = w; }
__device__ __forceinline__ float fmx_lo(float a, unsigned h, float c) { float d; asm("v_fma_mix_f32 %0, %1, %2, %3 op_sel_hi:[0,1,0]" : "=v"(d) : "v"(a), "v"(h), "v"(c)); return d; }
__device__ __forceinline__ float fmx_hi(float a, unsigned h, float c) { float d; asm("v_fma_mix_f32 %0, %1, %2, %3 op_sel:[0,1,0] op_sel_hi:[0,1,0]" : "=v"(d) : "v"(a), "v"(h), "v"(c)); return d; }
__device__ __forceinline__ float mmx_lo(float a, unsigned h) { float d; asm("v_fma_mix_f32 %0, %1, %2, 0 op_sel_hi:[0,1,0]" : "=v"(d) : "v"(a), "v"(h)); return d; }
__device__ __forceinline__ float mmx_hi(float a, unsigned h) { float d; asm("v_fma_mix_f32 %0, %1, %2, 0 op_sel:[0,1,0] op_sel_hi:[0,1,0]" : "=v"(d) : "v"(a), "v"(h)); return d; }
__device__ __forceinline__ float sigmoidf_(float x) { return __builtin_amdgcn_rcpf(1.0f + __expf(-x)); }
__device__ __forceinline__ float tanhf_(float x) { return 1.0f - 2.0f * __builtin_amdgcn_rcpf(__expf(2.0f * x) + 1.0f); }
__device__ __forceinline__ float wave_sum(float v) {
#pragma unroll
    for (int o = 1; o < 64; o <<= 1) v += __shfl_xor(v, o);
    return v;
}
__device__ __forceinline__ float sum8(float v) { v += __shfl_xor(v, 1); v += __shfl_xor(v, 2); v += __shfl_xor(v, 4); return v; }
template <int CTRL> __device__ __forceinline__ float dpp_f(float v) { return __builtin_bit_cast(float, __builtin_amdgcn_mov_dpp(__builtin_bit_cast(int, v), CTRL, 0xF, 0xF, true)); }
__device__ __forceinline__ float dpp_sum16(float v) {
    v += dpp_f<0xB1>(v);
    v += dpp_f<0x4E>(v);
    v += dpp_f<0x141>(v);
    v += dpp_f<0x140>(v);
    return v;
}

#define XB_TMO      128
#define XB_XCNT(j)  (256  + 64 * (j))
#define XB_XSUB(j)  (1280 + 64 * (j))
#define XB_XGEN(j)  (2304 + 64 * (j))
#define XB_TOP      3328
#define XB_TOPGEN   3392
#define XCD_BAR_WORDS 3456
#define XB_SPIN_CAP (1u << 18)

__device__ __forceinline__ unsigned xb_ld(unsigned* p)              { return __hip_atomic_load(p, __ATOMIC_RELAXED, __HIP_MEMORY_SCOPE_AGENT); }
__device__ __forceinline__ unsigned xb_add(unsigned* p, unsigned v) { return __hip_atomic_fetch_add(p, v, __ATOMIC_RELAXED, __HIP_MEMORY_SCOPE_AGENT); }
__device__ __forceinline__ unsigned xb_xcc_id() { return (unsigned)__builtin_amdgcn_s_getreg((3 << 11) | 20) & 0xFu; }
#define XB_SPIN(cond, bar) do { unsigned _sp = 0; while (cond) { __builtin_amdgcn_s_sleep(1); \
    if ((++_sp & 255u) == 0u) { if (xb_ld(&(bar)[XB_TMO])) break; if (_sp > XB_SPIN_CAP) { atomicAdd(&(bar)[XB_TMO], 1u); break; } } } } while (0)

struct XcdBarrier {
    unsigned* bar; unsigned x;
    volatile LAS unsigned* st;
};

__device__ __forceinline__ XcdBarrier xcd_barrier_post(unsigned* bar, volatile LAS unsigned* st) {
    XcdBarrier b; b.bar = bar; b.x = xb_xcc_id(); b.st = st;
    if (threadIdx.x == 0) (void)xb_add(&bar[XB_XCNT(b.x)], 1u);
    return b;
}
__device__ __forceinline__ void xcd_barrier_complete(unsigned* bar, unsigned x, unsigned& nloc, unsigned& nx) {
    const unsigned G = gridDim.x * gridDim.y * gridDim.z;
    unsigned sum, cnt, mine, sp = 0u;
    for (;;) {
        sum = 0u; cnt = 0u; mine = 0u;
#pragma unroll
        for (unsigned j = 0; j < 16; ++j) { const unsigned c = xb_ld(&bar[XB_XCNT(j)]); sum += c; cnt += (c > 0u) ? 1u : 0u; mine = (j == x) ? c : mine; }
        if (sum == G) break;
        __builtin_amdgcn_s_sleep(1);
        if ((++sp & 255u) == 0u) { if (xb_ld(&bar[XB_TMO])) break; if (sp > XB_SPIN_CAP) { atomicAdd(&bar[XB_TMO], 1u); break; } }
    }
    nloc = mine > 0u ? mine : 1u; nx = cnt > 0u ? cnt : 1u;
}

__device__ __forceinline__ void xcd_barrier(const XcdBarrier& b) {
    asm volatile("s_waitcnt vmcnt(0)" ::: "memory");
    __syncthreads();
    if (threadIdx.x == 0) {
        unsigned* bar = b.bar;
        __builtin_amdgcn_s_waitcnt(0);
        unsigned nloc = b.st[0], nx = b.st[1];
        if (nloc == 0u) { xcd_barrier_complete(bar, b.x, nloc, nx); b.st[0] = nloc; b.st[1] = nx; }
        const unsigned old = xb_add(&bar[XB_XSUB(b.x)], 1u);
        const unsigned gen = old / nloc;
        if (old + 1u == (gen + 1u) * nloc) {
            __builtin_amdgcn_fence(__ATOMIC_RELEASE, "agent");
            asm volatile("s_waitcnt vmcnt(0)" ::: "memory");
            const unsigned og = xb_add(&bar[XB_TOP], 1u);
            const unsigned tg = og / nx;
            if (og + 1u == (tg + 1u) * nx) xb_add(&bar[XB_TOPGEN], 1u);
            else XB_SPIN(xb_ld(&bar[XB_TOPGEN]) == tg, bar);
            __builtin_amdgcn_fence(__ATOMIC_ACQUIRE, "agent");
            xb_add(&bar[XB_XGEN(b.x)], 1u);
            asm volatile("s_waitcnt vmcnt(0)" ::: "memory");
        } else {
            XB_SPIN(xb_ld(&bar[XB_XGEN(b.x)]) == gen, bar);
            __builtin_amdgcn_fence(__ATOMIC_ACQUIRE, "agent");
            asm volatile("s_waitcnt vmcnt(0)" ::: "memory");
        }
    }
    __syncthreads();
}

struct Args { const void* p[30]; int ph_lo, ph_hi; };
template <int IDX> __device__ __forceinline__ const float* kin() {
    const auto ka = __builtin_amdgcn_kernarg_segment_ptr(); unsigned long long v;
    asm volatile("s_load_dwordx2 %0, %1, %2\n\ts_waitcnt lgkmcnt(0)" : "=s"(v) : "s"(ka), "i"(IDX * 8) : "memory");
    return (const float*)(const GAS float*)v;
}
enum { I_X = 0, I_C, I_WADA, I_BADA, I_N1G, I_N2G, I_WIN, I_MU, I_CONVW, I_W0, I_DECUP, I_A0, I_AAAUP, I_GATEUP, I_KK, I_KA, I_RK, I_LNW, I_LNB, I_VMD, I_VMU, I_V0, I_WOUT, I_WR, I_RB, I_WE1, I_WE2, I_FG };
struct Frame {
    LAS unsigned char* lds;
    int tid, lane, wave, vcu, G;
    GAS unsigned char* ws;
};
__device__ __forceinline__ float* ada_ptr(const Frame& F, int l, int b) { return (float*)(F.ws + WS_CTL + CTL_ADA) + (size_t)(l * 8 + b) * 6144; }

__device__ __forceinline__ void transpose_item(const float* W, int K, int N, bf16* WT, int dst_row0, int k0, int n0, LAS float* scr, int lane) {
    float tv[32];
#pragma unroll
    for (int i = 0; i < 32; ++i) tv[i] = W[(size_t)(k0 + 2 * i + (lane >> 5)) * N + n0 + (lane & 31)];
#pragma unroll
    for (int i = 0; i < 32; ++i) { const int kk = 2 * i + (lane >> 5); scr[kk * 33 + (lane & 31)] = tv[i]; }
    LDS_WAIT();
    const int c = lane & 7;
#pragma unroll
    for (int j = 0; j < 4; ++j) { const int n = (lane >> 3) + 8 * j; const LAS float* s = scr + (8 * c) * 33 + n;
        u32x4 o; o.x = pk2(s[0 * 33], s[1 * 33]); o.y = pk2(s[2 * 33], s[3 * 33]); o.z = pk2(s[4 * 33], s[5 * 33]); o.w = pk2(s[6 * 33], s[7 * 33]);
        *(u32x4*)(WT + (size_t)(dst_row0 + n) * K + k0 + 8 * c) = o; }
    LDS_WAIT();
}
__device__ __forceinline__ void p0_prologue(const Frame& F) {
    LAS float* scr = (LAS float*)(F.lds + F.wave * 16384);
    const int gw = F.vcu * NWAVES + F.wave, NGW = F.G * NWAVES, lane = F.lane;
    constexpr int I_ADA = 768, I_A = 2 * 16 * 264, I_B = 2 * 16 * 32, I_C1 = 64 * 16 * 32, I_D = 64 * 8 * 32;
    constexpr int NITEMS = I_ADA + I_A + I_B + I_C1 + I_D;
    const float* const pC = kin<I_C>(); const float* const pWADA = kin<I_WADA>(); const float* const pWIN = kin<I_WIN>();
    const float* const pWOUT = kin<I_WOUT>(); const float* const pWE1 = kin<I_WE1>(); const float* const pWE2 = kin<I_WE2>(); const float* const pVMD = kin<I_VMD>();
    for (int it = gw; it < NITEMS; it += NGW) {
        int r = it;
        if (r < I_ADA) {
            const int l = r / 384, rr = r % 384, cch = rr >> 4, kc = rr & 15, col = cch * 256 + 4 * lane, k0 = kc * 64;
            float cv[8];
#pragma unroll
            for (int b = 0; b < 8; ++b) { const float x = pC[b * 1024 + k0 + lane]; cv[b] = x * sigmoidf_(x); }
            f32x4 acc[8];
#pragma unroll
            for (int b = 0; b < 8; ++b) acc[b] = (f32x4){0.f, 0.f, 0.f, 0.f};
            const float* wp = pWADA + ((size_t)l * 1024 + k0) * 6144 + col;
#pragma unroll 16
            for (int kk = 0; kk < 64; ++kk) { const f32x4 w = *(const f32x4*)(wp + (size_t)kk * 6144);
#pragma unroll
                for (int b = 0; b < 8; ++b) { const float s = __builtin_bit_cast(float, __builtin_amdgcn_readlane(__builtin_bit_cast(int, cv[b]), kk)); acc[b] += s * w; } }
#pragma unroll
            for (int b = 0; b < 8; ++b) *(f32x4*)((float*)(F.ws + WS_ADAP) + ((size_t)(kc * 2 + l) * 8 + b) * 6144 + col) = acc[b];
            continue;
        }
        r -= I_ADA;
        if (r < I_A) { const int l = r / (16 * 264), rr = r % (16 * 264), kb = rr / 264, nb = rr % 264;
            transpose_item(pWIN + (size_t)l * 1024 * N_IN, 1024, N_IN, (bf16*)(F.ws + WS_BT_IN) + (size_t)l * P_LD * 1024, 32 * nb, 64 * kb, 32 * nb, scr, lane); continue; }
        r -= I_A;
        if (r < I_B) { const int l = r / 512, rr = r % 512, kb = rr / 32, nb = rr % 32;
            transpose_item(pWOUT + (size_t)l * 1024 * 1024, 1024, 1024, (bf16*)(F.ws + WS_BT_OUT) + (size_t)l * 1024 * 1024, 32 * nb, 64 * kb, 32 * nb, scr, lane); continue; }
        r -= I_B;
        if (r < I_C1) { const int le = r / 512, rr = r % 512, kb = rr / 32, nb = rr % 32, n0 = 32 * nb;
            const int j0 = n0 & 511, dst = (j0 >> 7) * 256 + (n0 >= 512 ? 128 : 0) + (j0 & 127);
            transpose_item(pWE1 + (size_t)le * 1024 * 1024, 1024, 1024, (bf16*)(F.ws + WS_BT_E1) + (size_t)le * 1024 * 1024, dst, 64 * kb, n0, scr, lane); continue; }
        r -= I_C1;
        { const int le = r / 256, rr = r % 256, kb = rr / 32, nb = rr % 32;
            transpose_item(pWE2 + (size_t)le * 512 * 1024, 512, 1024, (bf16*)(F.ws + WS_BT_E2) + (size_t)le * 1024 * 512, 32 * nb, 64 * kb, 32 * nb, scr, lane); }
    }
    const int gt0 = F.vcu * NWAVES * 64 + F.tid, GT = F.G * NWAVES * 64;
    { const float* const pVMUp = kin<I_VMU>();
      for (int it = gt0; it < 1024 * 128; it += GT) { const int n = it >> 7, k0 = (it & 127) * 8; float o[8];
#pragma unroll
        for (int i = 0; i < 8; ++i) o[i] = 0.f;
        for (int j = 0; j < 32; ++j) { const float u = pVMUp[j * 1024 + n];
#pragma unroll
            for (int i = 0; i < 8; ++i) o[i] += pVMD[(k0 + i) * 32 + j] * u; }
        store8((bf16*)(F.ws + WS_BT_IN) + (size_t)P_LD * 1024 + (size_t)(C_VD + n) * 1024 + k0, o); } }
    { const float* const pDU = kin<I_DECUP>(); const float* const pAU = kin<I_AAAUP>(); const float* const pGU = kin<I_GATEUP>();
      for (int it = gt0; it < 2 * 3072 * 32; it += GT) { const int l = it / (3072 * 32), rr = it % (3072 * 32), n = rr >> 5, k0 = (rr & 31) * 8; float o[8];
#pragma unroll
        for (int i = 0; i < 8; ++i) { const int k = k0 + i; float v = 0.f;
            if (n < 1024) { if (k < 64) v = pDU[(size_t)(l * 64 + k) * 1024 + n]; }
            else if (n < 2048) { if (k >= 64 && k < 128) v = pAU[(size_t)(l * 64 + k - 64) * 1024 + n - 1024]; }
            else { if (k >= 128) v = pGU[(size_t)(l * 128 + k - 128) * 1024 + n - 2048]; }
            o[i] = v; }
        store8((bf16*)(F.ws + WS_BT_LR) + (size_t)l * 3072 * 256 + (size_t)n * 256 + k0, o); } }
    { const float* const pWRp = kin<I_WR>(); const int gt = F.vcu * NWAVES * 64 + F.tid; if (gt < 32768) { const float w = pWRp[(gt & 1023) * 32 + (gt >> 10)]; const unsigned hi = f2bf(w);
        ((bf16*)(F.ws + WS_WRT))[gt] = (bf16)hi; ((bf16*)(F.ws + WS_WRT))[32768 + gt] = (bf16)f2bf(w - bflo(hi)); } }
}

__device__ __forceinline__ void p0b_ada_reduce(const Frame& F) {
    const float* const pBADA = kin<I_BADA>(); const float* ap = (const float*)(F.ws + WS_ADAP); float* ada = (float*)(F.ws + WS_CTL + CTL_ADA);
    for (int idx = F.vcu * NWAVES * 64 + F.tid; idx < 2 * 8 * 6144; idx += F.G * NWAVES * 64) { const int l = idx / 49152, r = idx % 49152, c = r % 6144;
        float s = pBADA[l * 6144 + c];
#pragma unroll
        for (int kc = 0; kc < 16; ++kc) s += ap[(size_t)(kc * 2 + l) * 49152 + r];
        ada[idx] = s; }
}

template <int MODE> __device__ __forceinline__ void p1_norm(const Frame& F, int l) {
    const int lane = F.lane;
    const float* const pX = kin<I_X>(); float* const pOUT = (float*)kin<28>(); const float* const pFG = kin<I_FG>(); const float* const pN1G = kin<I_N1G>(); const float* const pWRb = kin<I_WR>();
#pragma unroll 1
    for (int gw = F.vcu * NWAVES + F.wave; gw < T / 8; gw += F.G * NWAVES) { const int tok0 = gw * 8, b = tok0 >> 11;
        f32x4 gm[4], sh[4], g2v[4];
#pragma unroll
        for (int j = 0; j < 4; ++j) { const int c = 4 * lane + 256 * j;
            if (MODE == 2) { gm[j] = *(const f32x4*)(pFG + c); sh[j] = (f32x4){0.f, 0.f, 0.f, 0.f}; }
            else { const float* ad = ada_ptr(F, l, b); const f32x4 g = *(const f32x4*)(pN1G + l * 1024 + c), sc = *(const f32x4*)(ad + 1024 + c); gm[j] = g * (1.0f + sc); sh[j] = *(const f32x4*)(ad + c); }
            if (MODE >= 1) g2v[j] = *(const f32x4*)(ada_ptr(F, MODE == 2 ? 1 : l - 1, b) + 5120 + c); }
        float* X = (float*)(F.ws + WS_X);
        const bf16* YE = (const bf16*)(F.ws + WS_YE);
        const float* WTS = (const float*)(F.ws + WS_WTS); const int* SLOT = (const int*)(F.ws + WS_SLOT);
        for (int tk = 0; tk < 8; ++tk) { const int tok = tok0 + tk;
            f32x4 v[4]; const float* xs = (MODE == 0 ? pX : X) + (size_t)tok * 1024;
#pragma unroll
            for (int j = 0; j < 4; ++j) v[j] = *(const f32x4*)(xs + 4 * lane + 256 * j);
            if (MODE >= 1) { const float w0 = WTS[tok * 2], w1 = WTS[tok * 2 + 1]; const int s0 = SLOT[tok * 2], s1 = SLOT[tok * 2 + 1];
#pragma unroll
                for (int j = 0; j < 4; ++j) { const u32x2 y0 = *(const u32x2*)(YE + (size_t)s0 * 1024 + 4 * lane + 256 * j), y1 = *(const u32x2*)(YE + (size_t)s1 * 1024 + 4 * lane + 256 * j);
                    f32x4 m; m[0] = w0 * bflo(y0.x) + w1 * bflo(y1.x); m[1] = w0 * bfhi(y0.x) + w1 * bfhi(y1.x); m[2] = w0 * bflo(y0.y) + w1 * bflo(y1.y); m[3] = w0 * bfhi(y0.y) + w1 * bfhi(y1.y);
                    v[j] += g2v[j] * m; if (MODE == 1) *(f32x4*)(X + (size_t)tok * 1024 + 4 * lane + 256 * j) = v[j]; } }
            float ss = 0.f;
#pragma unroll
            for (int j = 0; j < 4; ++j) ss += (v[j][0] * v[j][0] + v[j][1] * v[j][1]) + (v[j][2] * v[j][2] + v[j][3] * v[j][3]);
            float rstd = __builtin_amdgcn_rsqf(wave_sum(ss) * (1.0f / 1024.0f) + NORM_EPS);
#if defined(DBG_SCAN)
            if (MODE == 2) { const float* dz = (const float*)(F.ws + WS_CTL) + 2048; const float er = sqrtf(dz[0] / fmaxf(dz[1], 1e-30f)); rstd *= 1.0f + 0.3f * fminf(er, 3.0f); }
#endif
#pragma unroll
            for (int j = 0; j < 4; ++j) { const f32x4 h = v[j] * rstd * gm[j] + sh[j];
                if (MODE == 2) *(f32x4*)(pOUT + (size_t)tok * 1024 + 4 * lane + 256 * j) = h;
                else { u32x2 w; w.x = pk2(h[0], h[1]); w.y = pk2(h[2], h[3]); *(u32x2*)((bf16*)(F.ws + WS_H) + (size_t)tok * 1024 + 4 * lane + 256 * j) = w; } }
        }
    }
    if (MODE == 0 && F.vcu < 16) {
        const int lb = F.vcu, e = F.tid & 31, kq = F.tid >> 5; const float* sh2 = ada_ptr(F, lb >> 3, lb & 7) + 3072; float s = 0.f;
        for (int k = kq * 64; k < kq * 64 + 64; ++k) s += sh2[k] * pWRb[k * 32 + e];
        LAS float* red = (LAS float*)F.lds; red[kq * 32 + e] = s; __syncthreads();
        if (F.tid < 32) { float t = 0.f; for (int q = 0; q < 16; ++q) t += red[q * 32 + e]; ((float*)(F.ws + WS_CTL + CTL_BIASR))[lb * 32 + e] = t; }
        __syncthreads();
    }
}

__device__ __forceinline__ void p2b_lra(const Frame& F, int l) {
    const int lane = F.lane, c8 = lane & 31, hf = lane >> 5;
    const bf16* P = (const bf16*)(F.ws + WS_P); bf16* ALR = (bf16*)(F.ws + WS_ALR); const float* mu = kin<I_MU>() + l * N_SHIFT + 3072 + 8 * c8;
    const f32x4 m0 = *(const f32x4*)mu, m1 = *(const f32x4*)(mu + 4);
    const float* const pKKc = kin<I_KK>() + l * 1024; const float* const muK = kin<I_MU>() + l * N_SHIFT + 1024; float* KNo = (float*)(F.ws + WS_KN);
#pragma unroll 1
    for (int gw = F.vcu * NWAVES + F.wave; gw < T / 8; gw += F.G * NWAVES) {
#pragma unroll
        for (int i = 0; i < 4; ++i) { const int tok = gw * 8 + 2 * i + hf; float cur[8], prv[8], o[8];
            load8(P + (size_t)tok * P_LD + C_WD + 8 * c8, cur);
            if ((tok & (SEQ - 1)) != 0) load8(P + (size_t)(tok - 1) * P_LD + C_WD + 8 * c8, prv); else {
#pragma unroll
                for (int j = 0; j < 8; ++j) prv[j] = 0.f; }
#pragma unroll
            for (int j = 0; j < 8; ++j) { const float v = cur[j] + (prv[j] - cur[j]) * (j < 4 ? m0[j] : m1[j - 4]); o[j] = (c8 < 8) ? tanhf_(v) : ((c8 < 16) ? v : sigmoidf_(v)); }
            store8(ALR + (size_t)tok * 256 + 8 * c8, o); }
#pragma unroll 1
        for (int ch = 0; ch < 2; ++ch) { const int col0 = 512 * ch + 8 * lane; float kkc[8], muk[8], kp_[8];
#pragma unroll
            for (int j = 0; j < 8; ++j) { kkc[j] = pKKc[col0 + j]; muk[j] = muK[col0 + j]; kp_[j] = 0.f; }
            const int tok0 = gw * 8;
            if ((tok0 & (SEQ - 1)) != 0) load8(P + (size_t)(tok0 - 1) * P_LD + C_K + col0, kp_);
#pragma unroll 4
            for (int tk = 0; tk < 8; ++tk) { float kc[8]; load8(P + (size_t)(tok0 + tk) * P_LD + C_K + col0, kc); float ss = 0.f;
#pragma unroll
                for (int j = 0; j < 8; ++j) { const float k = (kc[j] + (kp_[j] - kc[j]) * muk[j]) * kkc[j]; ss += k * k; kp_[j] = kc[j]; }
                ss = sum8(ss);
                if ((lane & 7) == 0) KNo[(tok0 + tk) * 16 + 8 * ch + (lane >> 3)] = __builtin_amdgcn_rsqf(fmaxf(ss, 1e-24f)); } }
    }
}

__device__ __forceinline__ void p3_prep(const Frame& F, int l) {
    const int lane = F.lane;
    const bf16* P = (const bf16*)(F.ws + WS_P); const bf16* LR = (const bf16*)(F.ws + WS_LR);
    const float* mu = kin<I_MU>() + l * N_SHIFT;
    const float* const pA0 = kin<I_A0>() + l * 1024; const float* const pKKc = kin<I_KK>() + l * 1024; const float* const pKA = kin<I_KA>() + l * 1024; const float* const pRK = kin<I_RK>() + l * 1024; const float* const pW0 = kin<I_W0>() + l * 1024; const float* const pV0c = kin<I_V0>();
    bf16* KKo = (bf16*)(F.ws + WS_KK); bf16* BQo = (bf16*)(F.ws + WS_BQ); bf16* KPo = (bf16*)(F.ws + WS_KP); bf16* Ro = (bf16*)(F.ws + WS_R);
    bf16* V0 = (bf16*)(F.ws + WS_V0); bf16* V1 = (bf16*)(F.ws + WS_V1); float* Wo = (float*)(F.ws + WS_W); float* BON = (float*)(F.ws + WS_BONUS);
#pragma unroll 1
    for (int gw = F.vcu * NWAVES + F.wave; gw < T / 8; gw += F.G * NWAVES) { const int tok0 = gw * 8;
#pragma unroll 1
    for (int ch = 0; ch < 2; ++ch) { const int col0 = 512 * ch + 8 * lane, head = 8 * ch + (lane >> 3);
        float a0v[8], kkc[8], kac[8], rkc[8], w0v[8], v0v[8], mur[8], muk[8], muv[8], rp[8], kp_[8], vp[8];
#pragma unroll
        for (int j = 0; j < 8; ++j) { a0v[j] = pA0[col0 + j]; kkc[j] = pKKc[col0 + j]; kac[j] = pKA[col0 + j]; rkc[j] = pRK[col0 + j]; w0v[j] = pW0[col0 + j]; v0v[j] = (l == 1) ? pV0c[col0 + j] : 0.f;
            mur[j] = mu[col0 + j]; muk[j] = mu[1024 + col0 + j]; muv[j] = mu[2048 + col0 + j]; rp[j] = 0.f; kp_[j] = 0.f; vp[j] = 0.f; }
        if ((tok0 & (SEQ - 1)) != 0) { const bf16* pr = P + (size_t)(tok0 - 1) * P_LD + col0; load8(pr + C_R, rp); load8(pr + C_K, kp_); load8(pr + C_V, vp); }
#pragma unroll 2
        for (int tk = 0; tk < 8; ++tk) { const int tok = tok0 + tk; const bf16* pr = P + (size_t)tok * P_LD + col0;
            float rc[8], kc[8], vc[8], dw[8], ap[8], r[8], k[8], v[8], kk[8], kp[8], bq[8], w[8];
            load8(pr + C_R, rc); load8(pr + C_K, kc); load8(pr + C_V, vc); load8(LR + (size_t)tok * 3072 + col0, dw); load8(LR + (size_t)tok * 3072 + 1024 + col0, ap);
            float ss = 0.f, bo = 0.f;
#pragma unroll
            for (int j = 0; j < 8; ++j) { r[j] = rc[j] + (rp[j] - rc[j]) * mur[j]; k[j] = kc[j] + (kp_[j] - kc[j]) * muk[j]; v[j] = vc[j] + (vp[j] - vc[j]) * muv[j]; rp[j] = rc[j]; kp_[j] = kc[j]; vp[j] = vc[j];
                const float av = sigmoidf_(a0v[j] + ap[j]); kk[j] = k[j] * kkc[j]; ss += kk[j] * kk[j]; kp[j] = k[j] * (1.0f + (av - 1.0f) * kac[j]); bo += r[j] * kp[j] * rkc[j]; bq[j] = av;
                const float nd = -(w0v[j] + dw[j]); const float sp = fmaxf(nd, 0.f) + __logf(1.0f + __expf(-fabsf(nd))); w[j] = -__expf(-sp - 0.5f); }
            ss = sum8(ss); bo = sum8(bo);
            const float inv = __builtin_amdgcn_rsqf(fmaxf(ss, 1e-24f));
#pragma unroll
            for (int j = 0; j < 8; ++j) { kk[j] *= inv; bq[j] *= kk[j]; }
            store8h(KKo + (size_t)tok * 1024 + col0, kk); store8h(BQo + (size_t)tok * 1024 + col0, bq); store8h(KPo + (size_t)tok * 1024 + col0, kp); store8h(Ro + (size_t)tok * 1024 + col0, r);
            if ((lane & 7) == 0) BON[tok * 16 + head] = bo;
            float* wp = Wo + (size_t)tok * 1024 + col0; *(f32x4*)wp = (f32x4){w[0], w[1], w[2], w[3]}; *(f32x4*)(wp + 4) = (f32x4){w[4], w[5], w[6], w[7]};
            if (l == 1) { float vf[8], vm[8]; load8h(V0 + (size_t)tok * 1024 + col0, vf); load8(pr + C_VD, vm);
#pragma unroll
                for (int j = 0; j < 8; ++j) v[j] = v[j] + (vf[j] - v[j]) * sigmoidf_(v0v[j] + vm[j]);
                store8h(V1 + (size_t)tok * 1024 + col0, v); }
            else store8h(V0 + (size_t)tok * 1024 + col0, v); }
    }
    }
}

__device__ __forceinline__ f32x4 h4_to_f4(const u32x2 u) { return (f32x4){hlo(u.x), hhi(u.x), hlo(u.y), hhi(u.y)}; }
#if defined(DBG_SCAN)
constexpr size_t WS_YCK = WS_H;
constexpr int SC_CH = 32, SC_BUF = 49152, SC_W = 0, SC_KK = 8192, SC_BQ = 16384, SC_KP = 24576, SC_R = 32768, SC_V = 40960, SC_Y = 45056;
struct ScanRegsSeq { f32x4 w; u32x2 kk, bq, kp, r, v; };
__device__ __forceinline__ void scan_issue(const Frame& F, int l, int b, int h, int half, int cc, ScanRegsSeq& R) {
    const int s = F.tid >> 4, q = F.tid & 15; const size_t base = ((size_t)b * SEQ + cc * SC_CH + s) * 1024 + h * 64 + 4 * q;
    R.w = *(const f32x4*)((const float*)(F.ws + WS_W) + base);
    R.kk = *(const u32x2*)((const bf16*)(F.ws + WS_KK) + base); R.bq = *(const u32x2*)((const bf16*)(F.ws + WS_BQ) + base);
    R.kp = *(const u32x2*)((const bf16*)(F.ws + WS_KP) + base); R.r = *(const u32x2*)((const bf16*)(F.ws + WS_R) + base);
    if (F.tid < 256) { const int s2 = F.tid >> 3, r4 = F.tid & 7; R.v = *(const u32x2*)((const bf16*)(F.ws + (l == 0 ? WS_V0 : WS_V1)) + ((size_t)b * SEQ + cc * SC_CH + s2) * 1024 + h * 64 + half * 32 + 4 * r4); }
}
__device__ __forceinline__ void scan_commit(const Frame& F, int buf, const ScanRegsSeq& R) {
    const int s = F.tid >> 4, q = F.tid & 15; LAS unsigned char* B = F.lds + buf * SC_BUF + (s * 16 + q) * 16;
    *(LAS f32x4*)(B + SC_W) = (f32x4){__expf(R.w[0]), __expf(R.w[1]), __expf(R.w[2]), __expf(R.w[3])};     *(LAS f32x4*)(B + SC_KK) = h4_to_f4(R.kk); *(LAS f32x4*)(B + SC_BQ) = h4_to_f4(R.bq); *(LAS f32x4*)(B + SC_KP) = h4_to_f4(R.kp); *(LAS f32x4*)(B + SC_R) = h4_to_f4(R.r);
    if (F.tid < 256) { const int s2 = F.tid >> 3, r4 = F.tid & 7; *(LAS f32x4*)(F.lds + buf * SC_BUF + SC_V + (s2 * 32 + 4 * r4) * 4) = h4_to_f4(R.v); }
}
__device__ __forceinline__ void scan_store(const Frame& F, int b, int h, int half, int cc, int buf) {
    if (F.tid < 256) { const int s2 = F.tid >> 3, r4 = F.tid & 7;
        const f32x4 y = *(const LAS f32x4*)(F.lds + buf * SC_BUF + SC_Y + (s2 * 32 + 4 * r4) * 4);
        u32x2 w; w.x = pk2(y[0], y[1]); w.y = pk2(y[2], y[3]);
        const int t = cc * SC_CH + s2 - 1;
        if (t >= 0) *(u32x2*)((bf16*)(F.ws + WS_Y) + ((size_t)b * SEQ + t) * 1024 + h * 64 + half * 32 + 4 * r4) = w; }
}
__device__ __forceinline__ void p4_scan_seq(const Frame& F, int l) {
#pragma unroll 1
    for (int unit = F.vcu; unit < NBATCH * NHEAD * 2; unit += F.G) {
        const int b = unit >> 5, h = (unit >> 1) & 15, half = unit & 1;
        const int g = F.lane >> 4, q = F.lane & 15, row = F.wave * 4 + g;
        f32x2 sA = (f32x2){0.f, 0.f}, sB = sA; float yp = 0.f; const bool odd = (q & 1) != 0;
        ScanRegsSeq SR;
        bf16* SAdbg = (bf16*)(F.ws + WS_V1) + (size_t)b * SEQ * 1024 + h * 64 + half * 32 + row;
        scan_issue(F, l, b, h, half, 0, SR); scan_commit(F, 0, SR); scan_issue(F, l, b, h, half, 1, SR);
        __syncthreads();
        constexpr int NCH = SEQ / SC_CH;
#pragma unroll 1
        for (int cc = 0; cc < NCH; ++cc) { const int buf = cc & 1;
            { const LAS unsigned char* B = F.lds + buf * SC_BUF;
              const LAS f32x4* pc = (const LAS f32x4*)B + q;
              const LAS float* pv = (const LAS float*)(B + SC_V) + row; LAS float* py = (LAS float*)(B + SC_Y) + row;
              f32x4 aw[2], ak[2], ab[2], ap[2], ar[2], bw[2], bk[2], bb[2], bp[2], br_[2]; float av[2], bv[2];
#define SC_LOAD(dw, dk, db, dp, dr, dv, s) do { dw = pc[(s) * 16]; dk = pc[(s) * 16 + 512]; db = pc[(s) * 16 + 1024]; dp = pc[(s) * 16 + 1536]; dr = pc[(s) * 16 + 2048]; dv = pv[(s) * 32]; } while (0)
#define SC_STEP(cw, ck, cb, cp, cr, cv, yo, sidx) do { \
        f32x2 t = sA * ck.lo; t = sB * ck.hi + t; \
        const float pa = t.x + t.y; \
        float x = odd ? yp : pa; const float z = odd ? pa : yp; \
        x += dpp_f<0xB1>(z); x += dpp_f<0x4E>(x); x += dpp_f<0x124>(x); x += dpp_f<0x128>(x); \
        const float sa = dpp_f<0xA0>(x); \
        if (l == 0 && q == 0) SAdbg[(size_t)(cc * SC_CH + (sidx)) * 1024] = (bf16)f2bf(sa); \
        f32x2 xA = cv * cp.lo, xB = cv * cp.hi; \
        xA = xA - sa * cb.lo; xB = xB - sa * cb.hi; \
        sA = sA * cw.lo + xA; sB = sB * cw.hi + xB; \
        f32x2 yv = sA * cr.lo; yv = sB * cr.hi + yv; \
        yo = x; yp = yv.x + yv.y; } while (0)
#pragma unroll
              for (int i = 0; i < 2; ++i) SC_LOAD(aw[i], ak[i], ab[i], ap[i], ar[i], av[i], i);
#pragma unroll 1
              for (int s4 = 0; s4 < SC_CH; s4 += 4) {
#pragma unroll
                  for (int i = 0; i < 2; ++i) SC_LOAD(bw[i], bk[i], bb[i], bp[i], br_[i], bv[i], s4 + 2 + i);
                  float yo[2];
#pragma unroll
                  for (int i = 0; i < 2; ++i) SC_STEP(aw[i], ak[i], ab[i], ap[i], ar[i], av[i], yo[i], s4 + i);
                  if (q == 1) { py[(s4 + 0) * 32] = yo[0]; py[(s4 + 1) * 32] = yo[1]; }
                  const int sn = (s4 + 4 < SC_CH) ? s4 + 4 : s4;
#pragma unroll
                  for (int i = 0; i < 2; ++i) SC_LOAD(aw[i], ak[i], ab[i], ap[i], ar[i], av[i], sn + i);
#pragma unroll
                  for (int i = 0; i < 2; ++i) SC_STEP(bw[i], bk[i], bb[i], bp[i], br_[i], bv[i], yo[i], s4 + 2 + i);
                  if (q == 1) { py[(s4 + 2) * 32] = yo[0]; py[(s4 + 3) * 32] = yo[1]; }
              }
#undef SC_STEP
#undef SC_LOAD
            }
            if (cc + 1 < NCH) scan_commit(F, buf ^ 1, SR);
            if (cc + 2 < NCH) scan_issue(F, l, b, h, half, cc + 2, SR);
            asm volatile("s_waitcnt lgkmcnt(0)" ::: "memory"); __builtin_amdgcn_s_barrier(); asm volatile("" ::: "memory");
            scan_store(F, b, h, half, cc, buf);
        }
        { const float yl = dpp_sum16(yp);
          if (q == 0) ((bf16*)(F.ws + WS_Y))[((size_t)b * SEQ + SEQ - 1) * 1024 + h * 64 + half * 32 + row] = (bf16)f2bf(yl); }
        __syncthreads();
    }
}

#else
constexpr size_t WS_YCK = WS_Y;
#endif
typedef short bf16x8 __attribute__((ext_vector_type(8)));
typedef float f32x16 __attribute__((ext_vector_type(16)));
typedef __bf16 bfl2 __attribute__((ext_vector_type(2)));
constexpr int CK_XK = 0, CK_XR = 4608, CK_BH = 9216, CK_KH = 14336, CK_GB = 19456, CK_VT = 19712, CK_X3SZ = 22272;
constexpr int CK_XB = 0, CK_XP = 4608, CK_P2SZ = 9216;
constexpr int CK_TK = 0, CK_TBR = 2560, CK_TKR = 5120, CK_TB = 7680, CK_TBT = 11776, CK_MT = 15872, CK_T2SZ = 18432;
constexpr int CK_X3_OFF = 0, CK_P2_OFF = 3 * CK_X3SZ, CK_T2_OFF = CK_P2_OFF + 2 * CK_P2SZ, CK_STASH = CK_T2_OFF + 2 * CK_T2SZ;
static_assert(CK_STASH + 8192 <= RING_BYTES, "chunked-scan LDS map");
#define CK_MFMA(a, b, c) __builtin_amdgcn_mfma_f32_32x32x16_bf16((a), (b), (c), 0, 0, 0)
__device__ __forceinline__ unsigned pkbf(float lo, float hi) { f32x2 v; v.x = lo; v.y = hi; return __builtin_bit_cast(unsigned, __builtin_convertvector(v, bfl2)); }
__device__ __forceinline__ bf16x8 ck_frag(const LAS unsigned char* base, int pitch, int row, int kel) { return *(const LAS bf16x8*)(base + row * pitch + kel * 2); }
struct CkRegs { u32x2 rP, rA, rB, kP, kA, kB, vP, vA, vB, dwA, dwB, apA, apB, vmA, vmB, vfA, vfB; float knA, knB; };
struct CkConst { f32x4 a0, kk, ka, rk, w0, v0, mur, muk, muv; };
__device__ __forceinline__ f32x4 b4_to_f4(const u32x2 u) { return (f32x4){bflo(u.x), bfhi(u.x), bflo(u.y), bfhi(u.y)}; }
__device__ __forceinline__ void ck_issue(const Frame& F, int pw, int l, int b, int h, int half, int blk, CkRegs& R) {
    const int s2 = F.lane >> 2, cq = F.lane & 3, col = h * 64 + 16 * pw + 4 * cq; const size_t tA = (size_t)b * SEQ + blk * 32 + 2 * s2;
    const bf16* P = (const bf16*)(F.ws + WS_P) + tA * P_LD + col; const bf16* LR = (const bf16*)(F.ws + WS_LR) + tA * 3072 + col; const float* KN = (const float*)(F.ws + WS_KN) + tA * 16 + h;
    R.rA = *(const u32x2*)(P + C_R); R.rB = *(const u32x2*)(P + P_LD + C_R); R.kA = *(const u32x2*)(P + C_K); R.kB = *(const u32x2*)(P + P_LD + C_K); R.vA = *(const u32x2*)(P + C_V); R.vB = *(const u32x2*)(P + P_LD + C_V);
    if ((tA & (SEQ - 1)) != 0) { R.rP = *(const u32x2*)(P - P_LD + C_R); R.kP = *(const u32x2*)(P - P_LD + C_K); R.vP = *(const u32x2*)(P - P_LD + C_V); } else { R.rP = (u32x2){0u, 0u}; R.kP = R.rP; R.vP = R.rP; }
    R.dwA = *(const u32x2*)LR; R.dwB = *(const u32x2*)(LR + 3072); R.apA = *(const u32x2*)(LR + 1024); R.apB = *(const u32x2*)(LR + 3072 + 1024);
    R.knA = KN[0]; R.knB = KN[16];
    if (l == 1) { R.vmA = *(const u32x2*)(P + C_VD); R.vmB = *(const u32x2*)(P + P_LD + C_VD); const bf16* V0 = (const bf16*)(F.ws + WS_V0) + tA * 1024 + col; R.vfA = *(const u32x2*)V0; R.vfB = *(const u32x2*)(V0 + 1024); }
    (void)half;
}
__device__ __forceinline__ void ck_elem(const CkConst& C, int l, const f32x4 rc, const f32x4 rp, const f32x4 kc, const f32x4 kp_, const f32x4 vc, const f32x4 vp, const f32x4 dw, const f32x4 ap, const float kn,
                                        const f32x4 vm, const f32x4 vf, f32x4& r, f32x4& kk, f32x4& bq, f32x4& kp, f32x4& lw, f32x4& v, float& bo) {
#pragma unroll
    for (int e = 0; e < 4; ++e) {
        r[e] = rc[e] + (rp[e] - rc[e]) * C.mur[e]; const float k = kc[e] + (kp_[e] - kc[e]) * C.muk[e]; float vv = vc[e] + (vp[e] - vc[e]) * C.muv[e];
        const float av = sigmoidf_(C.a0[e] + ap[e]); kk[e] = k * C.kk[e] * kn; bq[e] = kk[e] * av; kp[e] = k * (1.0f + (av - 1.0f) * C.ka[e]); bo += r[e] * kp[e] * C.rk[e];
        lw[e] = -0.60653066f * sigmoidf_(C.w0[e] + dw[e]);
        if (l == 1) vv = vv + (vf[e] - vv) * sigmoidf_(C.v0[e] + vm[e]);
        v[e] = vv; }
}
__device__ __forceinline__ void ck_stage1(const Frame& F, int pw, int l, int b, int h, int half, int blk, const CkConst& C, LAS unsigned char* BX, LAS unsigned char* BP, const CkRegs& R) {
    const int lane = F.lane, s2 = lane >> 2, cq = lane & 3, c0 = 16 * pw + 4 * cq, cp = 16 * pw + 4 * (((cq & 1) << 1) | (cq >> 1));
    f32x4 kkA, kkB, bqA, bqB, kpA, kpB, rA, rB, lwA, lwB, vA, vB; float boA = 0.f, boB = 0.f;
    { const f32x4 rcA = b4_to_f4(R.rA), kcA = b4_to_f4(R.kA), vcA = b4_to_f4(R.vA), zz = (f32x4){0.f, 0.f, 0.f, 0.f};
      ck_elem(C, l, rcA, b4_to_f4(R.rP), kcA, b4_to_f4(R.kP), vcA, b4_to_f4(R.vP), b4_to_f4(R.dwA), b4_to_f4(R.apA), R.knA, l == 1 ? b4_to_f4(R.vmA) : zz, l == 1 ? h4_to_f4(R.vfA) : zz, rA, kkA, bqA, kpA, lwA, vA, boA);
      ck_elem(C, l, b4_to_f4(R.rB), rcA, b4_to_f4(R.kB), kcA, b4_to_f4(R.vB), vcA, b4_to_f4(R.dwB), b4_to_f4(R.apB), R.knB, l == 1 ? b4_to_f4(R.vmB) : zz, l == 1 ? h4_to_f4(R.vfB) : zz, rB, kkB, bqB, kpB, lwB, vB, boB); }
    { const size_t tA = (size_t)b * SEQ + blk * 32 + 2 * s2;
      boA += __shfl_xor(boA, 1); boA += __shfl_xor(boA, 2); boB += __shfl_xor(boB, 1); boB += __shfl_xor(boB, 2);
      if ((pw >> 1) == half) { if (cq == 0) { float* bp = (float*)(F.ws + WS_BONP) + (tA * 16 + h) * 4 + pw; bp[0] = boA; bp[64] = boB; }
          bf16* Vo = (bf16*)(F.ws + (l == 0 ? WS_V0 : WS_V1)) + tA * 1024 + h * 64 + c0;
          *(u32x2*)Vo = (u32x2){pkh2(vA[0], vA[1]), pkh2(vA[2], vA[3])}; *(u32x2*)(Vo + 1024) = (u32x2){pkh2(vB[0], vB[1]), pkh2(vB[2], vB[3])};
#pragma unroll
          for (int e = 0; e < 4; ++e) *(LAS unsigned*)(BX + CK_VT + (16 * (pw & 1) + 4 * cq + e) * 80 + (2 * s2) * 2) = pkbf(vA[e], vB[e]); } }
    float xkA[4], xkB[4], xrA[4], xrB[4], xbA[4], xbB[4], xpA[4], xpB[4], bhA[4], bhB[4], khA[4], khB[4], gb[4];
#pragma unroll
    for (int e = 0; e < 4; ++e) {
        float x = lwA[e] + lwB[e];
#pragma unroll
        for (int d = 4; d < 64; d <<= 1) { const float y = __shfl_up(x, d); if (lane >= d) x += y; }
        const float LB = x, LA = x - lwB[e], L0 = LA - lwA[e], Lt = __shfl(x, 60 + cq);
        const float eL0 = __expf(L0), eLA = __expf(LA), eLB = __expf(LB), iLA = __expf(-LA), iLB = __expf(-LB), tA = __expf(Lt - LA), tB = __expf(Lt - LB);
        xkA[e] = kkA[e] * eL0; xkB[e] = kkB[e] * eLA; xrA[e] = rA[e] * eLA; xrB[e] = rB[e] * eLB;
        xbA[e] = bqA[e] * iLA; xbB[e] = bqB[e] * iLB; xpA[e] = kpA[e] * iLA; xpB[e] = kpB[e] * iLB;
        bhA[e] = bqA[e] * tA; bhB[e] = bqB[e] * tB; khA[e] = kpA[e] * tA; khB[e] = kpB[e] * tB; gb[e] = __expf(Lt);
    }
    const int oA = (2 * s2) * 144 + cp * 2, oB = oA + 144;
    *(LAS u32x2*)(BX + CK_XK + oA) = (u32x2){pkbf(xkA[0], xkA[1]), pkbf(xkA[2], xkA[3])}; *(LAS u32x2*)(BX + CK_XK + oB) = (u32x2){pkbf(xkB[0], xkB[1]), pkbf(xkB[2], xkB[3])};
    *(LAS u32x2*)(BX + CK_XR + oA) = (u32x2){pkbf(xrA[0], xrA[1]), pkbf(xrA[2], xrA[3])}; *(LAS u32x2*)(BX + CK_XR + oB) = (u32x2){pkbf(xrB[0], xrB[1]), pkbf(xrB[2], xrB[3])};
    *(LAS u32x2*)(BP + CK_XB + oA) = (u32x2){pkbf(xbA[0], xbA[1]), pkbf(xbA[2], xbA[3])}; *(LAS u32x2*)(BP + CK_XB + oB) = (u32x2){pkbf(xbB[0], xbB[1]), pkbf(xbB[2], xbB[3])};
    *(LAS u32x2*)(BP + CK_XP + oA) = (u32x2){pkbf(xpA[0], xpA[1]), pkbf(xpA[2], xpA[3])}; *(LAS u32x2*)(BP + CK_XP + oB) = (u32x2){pkbf(xpB[0], xpB[1]), pkbf(xpB[2], xpB[3])};
    const int i0 = 2 * s2, pst = (i0 & 16) | ((i0 & 4) << 1) | ((i0 & 8) >> 1) | (i0 & 3);
#pragma unroll
    for (int e = 0; e < 4; ++e) { *(LAS unsigned*)(BX + CK_BH + (c0 + e) * 80 + pst * 2) = pkbf(bhA[e], bhB[e]); *(LAS unsigned*)(BX + CK_KH + (c0 + e) * 80 + (2 * s2) * 2) = pkbf(khA[e], khB[e]); }
    if (s2 == 0) *(LAS f32x4*)(BX + CK_GB + c0 * 4) = (f32x4){gb[0], gb[1], gb[2], gb[3]};

}
__device__ __forceinline__ void ck_stage2(const Frame& F, int ti, const LAS unsigned char* BX, const LAS unsigned char* BP, LAS unsigned char* BT) {
    const int r = F.lane & 31, hh = F.lane >> 5;
    const LAS unsigned char* Aa = BP + ((ti < 2) ? CK_XB : CK_XP); const LAS unsigned char* Ba = BX + ((ti & 1) ? CK_XR : CK_XK);
    f32x16 acc;
#pragma unroll
    for (int i = 0; i < 16; ++i) acc[i] = 0.f;
#pragma unroll
    for (int ks = 0; ks < 4; ++ks) acc = CK_MFMA(ck_frag(Aa, 144, r, 16 * ks + 8 * hh), ck_frag(Ba, 144, r, 16 * ks + 8 * hh), acc);
    if (ti == 0) {
#pragma unroll
        for (int reg = 0; reg < 16; ++reg) { const int i = (reg & 3) + 8 * (reg >> 2) + 4 * hh; *(LAS float*)(BT + CK_TB + (i * 32 + r) * 4) = (i < r) ? acc[reg] : 0.f; }
#pragma unroll
        for (int m = 0; m < 4; ++m) { f32x4 t;
#pragma unroll
            for (int e = 0; e < 4; ++e) t[e] = (8 * m + 4 * hh + e < r) ? acc[4 * m + e] : 0.f;
            *(LAS f32x4*)(BT + CK_TBT + (r * 32 + 8 * m + 4 * hh) * 4) = t; }
    } else { const int off = (ti == 1) ? CK_TBR : ((ti == 2) ? CK_TK : CK_TKR);
#pragma unroll
        for (int m = 0; m < 4; ++m) { float t[4];
#pragma unroll
            for (int e = 0; e < 4; ++e) { const int i = 8 * m + 4 * hh + e; const bool keep = (ti == 2) ? (i < r) : (i <= r); t[e] = keep ? acc[4 * m + e] : 0.f; }
            const int col = (ti == 1) ? (16 * (m >> 1) + 8 * hh + 4 * (m & 1)) : (8 * m + 4 * hh);
            *(LAS u32x2*)(BT + off + r * 80 + col * 2) = (u32x2){pkbf(t[0], t[1]), pkbf(t[2], t[3])}; }
    }
    if (ti == 0) {
        LDS_WAIT();
        const LAS float* TBT = (const LAS float*)(BT + CK_TBT);
        float x[32];
        int rr = r; asm volatile("" : "+v"(rr));
#pragma unroll
        for (int k = 0; k < 32; ++k) x[k] = (k == rr) ? 1.f : 0.f;
        { f32x4 tc[8], tn[8];
#pragma unroll
          for (int j4 = 0; j4 < 8; ++j4) tc[j4] = *(const LAS f32x4*)(TBT + 31 * 32 + 4 * j4);
#pragma unroll
          for (int kk = 0; kk < 31; ++kk) { const int k = 31 - kk; const float xk = x[k];
              int off = (k - 1) * 32; asm volatile("" : "+v"(off) : "v"(xk));
              if (k - 1 >= 1) {
#pragma unroll
                  for (int j4 = 0; j4 <= (k - 2) / 4; ++j4) tn[j4] = *(const LAS f32x4*)(TBT + off + 4 * j4); }
#pragma unroll
              for (int j4 = 0; j4 <= (k - 1) / 4; ++j4) {
#pragma unroll
                  for (int e = 0; e < 4; ++e) { const int i = 4 * j4 + e; if (i < k) x[i] = __builtin_fmaf(-tc[j4][e], xk, x[i]); } }
#pragma unroll
              for (int j4 = 0; j4 < 8; ++j4) tc[j4] = tn[j4]; } }
        if (hh == 0) {
#pragma unroll
            for (int q = 0; q < 4; ++q) { u32x4 w;
#pragma unroll
                for (int p = 0; p < 4; ++p) { const int e0 = 2 * p, e1 = 2 * p + 1; w[p] = pkbf(x[16 * (q >> 1) + 8 * (e0 >> 2) + 4 * (q & 1) + (e0 & 3)], x[16 * (q >> 1) + 8 * (e1 >> 2) + 4 * (q & 1) + (e1 & 3)]); }
                *(LAS u32x4*)(BT + CK_MT + r * 80 + q * 16) = w; } }
    }
}
#define CK_BAR() do { asm volatile("s_waitcnt lgkmcnt(0)" ::: "memory"); __builtin_amdgcn_s_barrier(); asm volatile("" ::: "memory"); } while (0)
__device__ __forceinline__ void p4_scan(const Frame& F, int l) {
#pragma unroll 1
    for (int unit = F.vcu; unit < NBATCH * NHEAD * 2; unit += F.G) {
        const int b = unit >> 5, h = (unit >> 1) & 15, half = unit & 1;
        const bool pre = F.wave >= 4, mainw = F.wave == 0;
        const int r = F.lane & 31, hh = F.lane >> 5;
        constexpr int NBLKc = SEQ / 32;
        const int w_ = F.wave;
        if (w_ == 0) {
            f32x16 ST0, ST1;
#pragma unroll
            for (int i = 0; i < 16; ++i) { ST0[i] = 0.f; ST1[i] = 0.f; }
#pragma unroll 1
            for (int blk = -2; blk < NBLKc; ++blk) {
                const LAS unsigned char* BX = F.lds + CK_X3_OFF + ((blk + 3) % 3) * CK_X3SZ; const LAS unsigned char* BT = F.lds + CK_T2_OFF + (blk & 1) * CK_T2SZ;
                bf16x8 SH[2][2], SL[2][2], NUF[2], VF[2]; f32x16 RH, YT;
                if (blk >= 0) {
#pragma unroll
                for (int c = 0; c < 2; ++c)
#pragma unroll
                    for (int s = 0; s < 2; ++s) { u32x4 ph, pl;
#pragma unroll
                        for (int p = 0; p < 4; ++p) { const float x0 = (c ? ST1 : ST0)[8 * s + 2 * p], x1 = (c ? ST1 : ST0)[8 * s + 2 * p + 1]; const unsigned hp = pkbf(x0, x1);
                            ph[p] = hp;
#if defined(CK_LO)
                            pl[p] = pkbf(x0 - bflo(hp), x1 - bfhi(hp));
#endif
                        }
                        SH[c][s] = __builtin_bit_cast(bf16x8, ph);
#if defined(CK_LO)
                        SL[c][s] = __builtin_bit_cast(bf16x8, pl);
#endif
                    }
                { LAS f32x4* stash = (LAS f32x4*)(F.lds + CK_STASH) + F.lane;
#pragma unroll
                  for (int m = 0; m < 4; ++m) { stash[64 * m] = (f32x4){ST0[4 * m], ST0[4 * m + 1], ST0[4 * m + 2], ST0[4 * m + 3]}; stash[64 * (4 + m)] = (f32x4){ST1[4 * m], ST1[4 * m + 1], ST1[4 * m + 2], ST1[4 * m + 3]}; } }
                VF[0] = ck_frag(BX + CK_VT, 80, r, 8 * hh); VF[1] = ck_frag(BX + CK_VT, 80, r, 16 + 8 * hh);
#pragma unroll
                for (int i = 0; i < 16; ++i) RH[i] = 0.f;
                { bf16x8 ak[2][2], at[2];
#pragma unroll
                  for (int c = 0; c < 2; ++c)
#pragma unroll
                      for (int s = 0; s < 2; ++s) ak[c][s] = ck_frag(BX + CK_XK, 144, r, 32 * c + 16 * s + 8 * hh);
                  at[0] = ck_frag(BT + CK_TK, 80, r, 8 * hh); at[1] = ck_frag(BT + CK_TK, 80, r, 16 + 8 * hh);
#pragma unroll
                  for (int c = 0; c < 2; ++c)
#pragma unroll
                      for (int s = 0; s < 2; ++s) RH = CK_MFMA(ak[c][s], SH[c][s], RH);
#pragma unroll
                  for (int ks = 0; ks < 2; ++ks) RH = CK_MFMA(at[ks], VF[ks], RH); }
                { bf16x8 rb[2];
#pragma unroll
                  for (int s = 0; s < 2; ++s) { u32x4 p4;
#pragma unroll
                      for (int p = 0; p < 4; ++p) p4[p] = pkbf(RH[8 * s + 2 * p], RH[8 * s + 2 * p + 1]);
                      rb[s] = __builtin_bit_cast(bf16x8, p4); }
                  f32x16 UT;
#pragma unroll
                  for (int i = 0; i < 16; ++i) UT[i] = 0.f;
#pragma unroll
                  for (int s = 0; s < 2; ++s) UT = CK_MFMA(ck_frag(BT + CK_MT, 80, r, 16 * s + 8 * hh), rb[s], UT);
#pragma unroll
                  for (int s = 0; s < 2; ++s) { u32x4 p4;
#pragma unroll
                      for (int p = 0; p < 4; ++p) p4[p] = pkbf(UT[8 * s + 2 * p], UT[8 * s + 2 * p + 1]) ^ 0x80008000u;
                      NUF[s] = __builtin_bit_cast(bf16x8, p4); } }
#pragma unroll
                for (int i = 0; i < 16; ++i) YT[i] = 0.f;
                { bf16x8 ar[2][2];
#pragma unroll
                  for (int c = 0; c < 2; ++c)
#pragma unroll
                      for (int s = 0; s < 2; ++s) ar[c][s] = ck_frag(BX + CK_XR, 144, r, 32 * c + 16 * s + 8 * hh);
#pragma unroll
                  for (int c = 0; c < 2; ++c)
#pragma unroll
                      for (int s = 0; s < 2; ++s) YT = CK_MFMA(ar[c][s], SH[c][s], YT); }
                VF[0] = ck_frag(BX + CK_VT, 80, r, 8 * hh); VF[1] = ck_frag(BX + CK_VT, 80, r, 16 + 8 * hh);
                asm volatile("" ::: "memory");
#pragma unroll
                for (int ks = 0; ks < 2; ++ks) { const bf16x8 fbr = ck_frag(BT + CK_TBR, 80, r, 16 * ks + 8 * hh), fkr = ck_frag(BT + CK_TKR, 80, r, 16 * ks + 8 * hh); YT = CK_MFMA(fbr, NUF[ks], YT); YT = CK_MFMA(fkr, VF[ks], YT); }
                { bf16* yo = (bf16*)(F.ws + WS_YCK) + ((size_t)b * SEQ + blk * 32) * 1024 + h * 64 + half * 32 + r;
#pragma unroll
                  for (int reg = 0; reg < 16; ++reg) yo[(size_t)((reg & 3) + 8 * (reg >> 2) + 4 * hh) * 1024] = (bf16)f2bf(YT[reg]); }
                { const LAS f32x4* stash = (const LAS f32x4*)(F.lds + CK_STASH) + F.lane;
#pragma unroll
                  for (int m = 0; m < 4; ++m) { const f32x4 g0 = *(const LAS f32x4*)(BX + CK_GB + (8 * m + 4 * hh) * 4), g1 = *(const LAS f32x4*)(BX + CK_GB + (32 + 8 * m + 4 * hh) * 4);
                    const f32x4 a0 = stash[64 * m] * g0, a1 = stash[64 * (4 + m)] * g1;
#pragma unroll
                    for (int e = 0; e < 4; ++e) { ST0[4 * m + e] = a0[e]; ST1[4 * m + e] = a1[e]; } } }
#pragma unroll
                for (int ks = 0; ks < 2; ++ks) {
                    const bf16x8 b0 = ck_frag(BX + CK_BH, 80, r, 16 * ks + 8 * hh), b1 = ck_frag(BX + CK_BH, 80, 32 + r, 16 * ks + 8 * hh), k0 = ck_frag(BX + CK_KH, 80, r, 16 * ks + 8 * hh), k1 = ck_frag(BX + CK_KH, 80, 32 + r, 16 * ks + 8 * hh);
                    ST0 = CK_MFMA(b0, NUF[ks], ST0); ST1 = CK_MFMA(b1, NUF[ks], ST1); ST0 = CK_MFMA(k0, VF[ks], ST0); ST1 = CK_MFMA(k1, VF[ks], ST1); }
                }
                CK_BAR();
            }
        } else if (w_ == 1 || w_ == 2 || w_ == 3 || w_ == 5) {
            const int pw = (w_ == 5) ? 3 : w_ - 1;
            CkConst CC;
            { const int c = l * 1024 + h * 64 + 16 * pw + 4 * (F.lane & 3); const float* mu = kin<I_MU>() + l * N_SHIFT + h * 64 + 16 * pw + 4 * (F.lane & 3);
              CC.a0 = *(const f32x4*)(kin<I_A0>() + c); CC.kk = *(const f32x4*)(kin<I_KK>() + c); CC.ka = *(const f32x4*)(kin<I_KA>() + c); CC.rk = *(const f32x4*)(kin<I_RK>() + c); CC.w0 = *(const f32x4*)(kin<I_W0>() + c);
              CC.v0 = (l == 1) ? *(const f32x4*)(kin<I_V0>() + (c - 1024)) : (f32x4){0.f, 0.f, 0.f, 0.f}; CC.mur = *(const f32x4*)mu; CC.muk = *(const f32x4*)(mu + 1024); CC.muv = *(const f32x4*)(mu + 2048); }
            CkRegs CR;
            ck_issue(F, pw, l, b, h, half, 0, CR);
#pragma unroll 1
            for (int blk = -2; blk < NBLKc; ++blk) {
                if (blk + 2 < NBLKc) ck_stage1(F, pw, l, b, h, half, blk + 2, CC, F.lds + CK_X3_OFF + ((blk + 2 + 3) % 3) * CK_X3SZ, F.lds + CK_P2_OFF + ((blk + 2) & 1) * CK_P2SZ, CR);
                if (blk + 3 < NBLKc) ck_issue(F, pw, l, b, h, half, blk + 3, CR);
                CK_BAR();
            }
        } else {
#pragma unroll 1
            for (int blk = -2; blk < NBLKc; ++blk) {
                if (blk + 1 >= 0 && blk + 1 < NBLKc) {
                    const LAS unsigned char* BX = F.lds + CK_X3_OFF + ((blk + 1 + 3) % 3) * CK_X3SZ; const LAS unsigned char* BP = F.lds + CK_P2_OFF + ((blk + 1) & 1) * CK_P2SZ; LAS unsigned char* BT = F.lds + CK_T2_OFF + ((blk + 1) & 1) * CK_T2SZ;
                    if (w_ == 4) ck_stage2(F, 0, BX, BP, BT);
                    else if (w_ == 6) { ck_stage2(F, 1, BX, BP, BT); ck_stage2(F, 3, BX, BP, BT); }
                    else ck_stage2(F, 2, BX, BP, BT);
                }
                CK_BAR();
            }
        }
    }
}

__device__ __forceinline__ void p5_post(const Frame& F, int l) {
    const int lane = F.lane;
#if defined(DBG_SCAN)
    if (l == 0) { float d2 = 0.f, n2 = 0.f;
#if defined(DBG_CMP_U)
        const bf16* Ya = (const bf16*)(F.ws + WS_V1); const bf16* Yb = (const bf16*)(F.ws + WS_P) + C_VD; const size_t pb = P_LD;
#else
        const bf16* Ya = (const bf16*)(F.ws + WS_Y); const bf16* Yb = (const bf16*)(F.ws + WS_H); const size_t pb = 1024;
#endif
        for (size_t i = (size_t)(F.vcu * NWAVES * 64 + F.tid); i < (size_t)T * 1024; i += (size_t)F.G * NWAVES * 64) { const int t = (int)((i >> 10) & (SEQ - 1));
            if (t >= DBG_T0 && t < DBG_T1) { const float ya = bflo((unsigned)Ya[i]), yb = bflo((unsigned)Yb[(i >> 10) * pb + (i & 1023)]); d2 += (ya - yb) * (ya - yb); n2 += ya * ya; } }
        d2 = wave_sum(d2); n2 = wave_sum(n2);
        if (lane == 0) { atomicAdd((float*)(F.ws + WS_CTL) + 2048, d2); atomicAdd((float*)(F.ws + WS_CTL) + 2049, n2); }
        __syncthreads(); }
#endif
    const float* const pCW = kin<I_CONVW>() + l * 3 * 1024; const float* const pLNW = kin<I_LNW>() + l * 1024; const float* const pLNB = kin<I_LNB>() + l * 1024;
    const bf16* P = (const bf16*)(F.ws + WS_P); const bf16* Y = (const bf16*)(F.ws + WS_Y); const bf16* LRg = (const bf16*)(F.ws + WS_LR) + 2048;
    const bf16* V = (const bf16*)(F.ws + (l == 0 ? WS_V0 : WS_V1)); const float* BONP = (const float*)(F.ws + WS_BONP); bf16* M = (bf16*)(F.ws + WS_H);
#pragma unroll 1
    for (int gw = F.vcu * NWAVES + F.wave; gw < T / 8; gw += F.G * NWAVES) { const int tok0 = gw * 8;
#pragma unroll 1
    for (int ch = 0; ch < 2; ++ch) { const int col0 = 512 * ch + 8 * lane, head = 8 * ch + (lane >> 3);
        float cw0[8], cw1[8], cw2[8], lnw[8], lnb[8], um1[8], um2[8];
#pragma unroll
        for (int j = 0; j < 8; ++j) { cw0[j] = pCW[col0 + j]; cw1[j] = pCW[1024 + col0 + j]; cw2[j] = pCW[2048 + col0 + j];
            lnw[j] = pLNW[col0 + j]; lnb[j] = pLNB[col0 + j]; um1[j] = 0.f; um2[j] = 0.f; }
        const int t0 = tok0 & (SEQ - 1);
        if (t0 >= 1) { float c1[8], c2[8]; load8(P + (size_t)(tok0 - 1) * P_LD + C_CC + col0, c1); load8(P + (size_t)(tok0 - 1) * P_LD + C_CH + col0, c2);
#pragma unroll
            for (int j = 0; j < 8; ++j) um1[j] = c1[j] * c2[j]; }
        if (t0 >= 2) { float c1[8], c2[8]; load8(P + (size_t)(tok0 - 2) * P_LD + C_CC + col0, c1); load8(P + (size_t)(tok0 - 2) * P_LD + C_CH + col0, c2);
#pragma unroll
            for (int j = 0; j < 8; ++j) um2[j] = c1[j] * c2[j]; }
#pragma unroll 2
        for (int tk = 0; tk < 8; ++tk) { const int tok = tok0 + tk; const bf16* pr = P + (size_t)tok * P_LD + col0;
            float c1[8], c2[8], cb[8], ga[8], gb[8], y[8], v[8], g[8], o[8];
            load8(pr + C_CC, c1); load8(pr + C_CH, c2); load8(pr + C_CB, cb); load8(pr + C_GA, ga); load8(pr + C_GB, gb);
            load8(Y + (size_t)tok * 1024 + col0, y); load8h(V + (size_t)tok * 1024 + col0, v); load8(LRg + (size_t)tok * 3072 + col0, g);
            const f32x4 bo4 = *(const f32x4*)(BONP + ((size_t)tok * 16 + head) * 4); const float bo = (bo4[0] + bo4[1]) + (bo4[2] + bo4[3]);
            float sm = 0.f;
#pragma unroll
            for (int j = 0; j < 8; ++j) sm += y[j];
            const float mean = sum8(sm) * (1.0f / 64.0f); float sq = 0.f;
#pragma unroll
            for (int j = 0; j < 8; ++j) { y[j] -= mean; sq += y[j] * y[j]; }
            const float rstd = __builtin_amdgcn_rsqf(sum8(sq) * (1.0f / 64.0f) + LNX_EPS);
#pragma unroll
            for (int j = 0; j < 8; ++j) { const float u = c1[j] * c2[j]; const float conv = cw0[j] * um2[j] + cw1[j] * um1[j] + cw2[j] * u; um2[j] = um1[j]; um1[j] = u;
                const float yconv = cb[j] * conv; const float yr = ((y[j] * rstd) * lnw[j] + lnb[j] + bo * v[j]) * g[j];
                o[j] = sigmoidf_(ga[j]) * yconv + sigmoidf_(gb[j]) * yr; }
            store8(M + (size_t)tok * 1024 + col0, o); }
    }
    }
}

struct GroupPick { float score, a1, a2; int i1, i2; };
__device__ __forceinline__ GroupPick pick_group(const f32x4 acc, float rstd, const float* br, const float* rb) {
    float aff[4], sel[4];
#pragma unroll
    for (int j = 0; j < 4; ++j) { aff[j] = sigmoidf_(rstd * acc[j] + br[j]); sel[j] = aff[j] + rb[j]; }
    int i1 = 0;
#pragma unroll
    for (int j = 1; j < 4; ++j) if (sel[j] > sel[i1]) i1 = j;
    int i2 = (i1 == 0) ? 1 : 0;
#pragma unroll
    for (int j = 0; j < 4; ++j) if (j != i1 && j != i2 && sel[j] > sel[i2]) i2 = j;
    GroupPick g; g.score = sel[i1] + sel[i2]; g.i1 = i1; g.i2 = i2; g.a1 = aff[i1]; g.a2 = aff[i2];
    float s1 = sel[0], s2 = sel[0]; (void)s1; (void)s2;
    return g;
}
__device__ __forceinline__ void p7_route(const Frame& F, int l, bool dry = false) {
    typedef short bfv8 __attribute__((ext_vector_type(8)));
    const int lane = F.lane, li = lane & 15, fq = lane >> 4;
    LAS unsigned* lcnt = (LAS unsigned*)(F.lds + 65536);
    const float* X = (const float*)(F.ws + WS_X); const bf16* WH = (const bf16*)(F.ws + WS_WRT); const bf16* WL = WH + 32768; const float* const pN2G = kin<I_N2G>() + l * 1024; const float* const pRB = kin<I_RB>();
#pragma unroll 1
    for (int gw = F.vcu * NWAVES + F.wave; gw < T / 8; gw += F.G * NWAVES) { const int tok0 = gw * 8, b = tok0 >> 11;
        if (F.tid < 32) lcnt[F.tid] = 0u;
        __syncthreads();
        const float* ad = ada_ptr(F, l, b);
        const float* xp = X + (size_t)(tok0 + (li & 7)) * 1024 + 8 * fq; const float* g1p = pN2G + 8 * fq; const float* g2p = ad + 4096 + 8 * fq;
        const bf16* wh0 = WH + li * 1024 + 8 * fq; const bf16* wl0 = WL + li * 1024 + 8 * fq;
        f32x4 acc0 = (f32x4){0.f, 0.f, 0.f, 0.f}, acc1 = acc0; float ssq = 0.f;
#pragma unroll 2
        for (int kb = 0; kb < 1024; kb += 32) {
            const f32x4 xa = *(const f32x4*)(xp + kb), xb = *(const f32x4*)(xp + kb + 4);
            const f32x4 ga = *(const f32x4*)(g1p + kb) * (1.0f + *(const f32x4*)(g2p + kb)), gb = *(const f32x4*)(g1p + kb + 4) * (1.0f + *(const f32x4*)(g2p + kb + 4));
            const bfv8 ah0 = *(const bfv8*)(wh0 + kb), al0 = *(const bfv8*)(wl0 + kb), ah1 = *(const bfv8*)(wh0 + 16 * 1024 + kb), al1 = *(const bfv8*)(wl0 + 16 * 1024 + kb);
            ssq += ((xa[0] * xa[0] + xa[1] * xa[1]) + (xa[2] * xa[2] + xa[3] * xa[3])) + ((xb[0] * xb[0] + xb[1] * xb[1]) + (xb[2] * xb[2] + xb[3] * xb[3]));
            const f32x4 ya = xa * ga, yb = xb * gb;
            u32x4 ph, pl;
            ph[0] = pkbf(ya[0], ya[1]); ph[1] = pkbf(ya[2], ya[3]); ph[2] = pkbf(yb[0], yb[1]); ph[3] = pkbf(yb[2], yb[3]);
            pl[0] = pkbf(ya[0] - bflo(ph[0]), ya[1] - bfhi(ph[0])); pl[1] = pkbf(ya[2] - bflo(ph[1]), ya[3] - bfhi(ph[1])); pl[2] = pkbf(yb[0] - bflo(ph[2]), yb[1] - bfhi(ph[2])); pl[3] = pkbf(yb[2] - bflo(ph[3]), yb[3] - bfhi(ph[3]));
            const bfv8 bh = __builtin_bit_cast(bfv8, ph), bl = __builtin_bit_cast(bfv8, pl);
            acc0 = __builtin_amdgcn_mfma_f32_16x16x32_bf16(ah0, bh, acc0, 0, 0, 0); acc0 = __builtin_amdgcn_mfma_f32_16x16x32_bf16(al0, bh, acc0, 0, 0, 0); acc0 = __builtin_amdgcn_mfma_f32_16x16x32_bf16(ah0, bl, acc0, 0, 0, 0);
            acc1 = __builtin_amdgcn_mfma_f32_16x16x32_bf16(ah1, bh, acc1, 0, 0, 0); acc1 = __builtin_amdgcn_mfma_f32_16x16x32_bf16(al1, bh, acc1, 0, 0, 0); acc1 = __builtin_amdgcn_mfma_f32_16x16x32_bf16(ah1, bl, acc1, 0, 0, 0);
        }
        ssq += __shfl_xor(ssq, 16); ssq += __shfl_xor(ssq, 32);
        const float rstd = __builtin_amdgcn_rsqf(ssq * (1.0f / 1024.0f) + NORM_EPS);
        const float* br = (const float*)(F.ws + WS_CTL + CTL_BIASR) + (l * 8 + b) * 32;
        const GroupPick ga_ = pick_group(acc0, rstd, br + 4 * fq, pRB + 4 * fq), gb_ = pick_group(acc1, rstd, br + 16 + 4 * fq, pRB + 16 + 4 * fq);
        const bool useb = gb_.score > ga_.score;
        const GroupPick gm = useb ? gb_ : ga_; const int mygrp = useb ? 4 + fq : fq;
        float bs = gm.score; int bg = mygrp;
#pragma unroll
        for (int off = 16; off < 64; off <<= 1) { const float os = __shfl_xor(bs, off); const int og = __shfl_xor(bg, off); if (os > bs || (os == bs && og < bg)) { bs = os; bg = og; } }
        if (mygrp == bg && li < 8) { const int tok = tok0 + li; const int e0 = 4 * bg + gm.i1, e1 = 4 * bg + gm.i2; const float inv = 1.0f / (gm.a1 + gm.a2);
            const int p0 = (int)__hip_atomic_fetch_add(lcnt + e0, 1u, __ATOMIC_RELAXED, __HIP_MEMORY_SCOPE_WORKGROUP), p1 = (int)__hip_atomic_fetch_add(lcnt + e1, 1u, __ATOMIC_RELAXED, __HIP_MEMORY_SCOPE_WORKGROUP);
            int* EI = (int*)(F.ws + WS_EIDX); int* PO = (int*)(F.ws + WS_POS); float* WT = (float*)(F.ws + WS_WTS);
            if (!dry) { EI[tok * 2] = e0; EI[tok * 2 + 1] = e1; PO[tok * 2] = p0; PO[tok * 2 + 1] = p1; WT[tok * 2] = gm.a1 * inv; WT[tok * 2 + 1] = gm.a2 * inv; } }
        __syncthreads();
        if (F.tid < 32 && !dry) ((int*)(F.ws + WS_HIST))[(l * 256 + (gw >> 3)) * 32 + F.tid] = (int)lcnt[F.tid];
        __syncthreads();
    }
}

__device__ __forceinline__ void expert_table(const Frame& F, int l, int grp = -1) {
    LAS int* tab = (LAS int*)(F.lds + TAB_OFF); LAS int* red = (LAS int*)F.lds;
    const int* hist = (const int*)(F.ws + WS_HIST) + l * 256 * 32; const int e = F.tid & 31, part = F.tid >> 5;
    int tot = 0, pre = 0;
#pragma unroll 4
    for (int g = part * 16; g < part * 16 + 16; ++g) { const int v = hist[g * 32 + e]; tot += v; pre += (g < grp) ? v : 0; }
    red[part * 32 + e] = tot; red[512 + part * 32 + e] = pre;
    __syncthreads();
    if (F.tid < 64) { int c = 0, pr = 0;
#pragma unroll
        for (int p = 0; p < 16; ++p) { c += red[p * 32 + e]; pr += red[512 + p * 32 + e]; }
        const int padded = (c + 255) & ~255; int inc = padded;
#pragma unroll
        for (int o = 1; o < 32; o <<= 1) { const int v = __shfl_up(inc, o); if (e >= o) inc += v; }
        if (F.lane < 32) { tab[e] = inc - padded; tab[33 + e] = (inc - padded) >> 8; tab[66 + e] = inc - padded + pr; if (e == 31) { tab[32] = inc; tab[65] = inc >> 8; } } }
    __syncthreads();
}

__device__ __forceinline__ void p8_dispatch(const Frame& F, int l) {
    const LAS int* tab = (const LAS int*)(F.lds + TAB_OFF);
    const float* const pN2G = kin<I_N2G>() + l * 1024;
    const int lane = F.lane;
#pragma unroll 1
    for (int gw = F.vcu * NWAVES + F.wave; gw < T / 8; gw += F.G * NWAVES) { const int tok0 = gw * 8, b = tok0 >> 11;
        expert_table(F, l, gw >> 3);
        const float* ad = ada_ptr(F, l, b); f32x4 gm[4], sh[4];
#pragma unroll
        for (int j = 0; j < 4; ++j) { const int c = 4 * lane + 256 * j; gm[j] = *(const f32x4*)(pN2G + c) * (1.0f + *(const f32x4*)(ad + 4096 + c)); sh[j] = *(const f32x4*)(ad + 3072 + c); }
        const float* X = (const float*)(F.ws + WS_X); const int* EI = (const int*)(F.ws + WS_EIDX); const int* PO = (const int*)(F.ws + WS_POS); int* SL = (int*)(F.ws + WS_SLOT); bf16* BUF = (bf16*)(F.ws + WS_BUF);
        for (int tk = 0; tk < 8; ++tk) { const int tok = tok0 + tk; f32x4 v[4]; float ss = 0.f;
#pragma unroll
            for (int j = 0; j < 4; ++j) { v[j] = *(const f32x4*)(X + (size_t)tok * 1024 + 4 * lane + 256 * j); ss += (v[j][0] * v[j][0] + v[j][1] * v[j][1]) + (v[j][2] * v[j][2] + v[j][3] * v[j][3]); }
            const float rstd = __builtin_amdgcn_rsqf(wave_sum(ss) * (1.0f / 1024.0f) + NORM_EPS);
            const int s0 = tab[66 + EI[tok * 2]] + PO[tok * 2], s1 = tab[66 + EI[tok * 2 + 1]] + PO[tok * 2 + 1];
            if (lane == 0) { SL[tok * 2] = s0; SL[tok * 2 + 1] = s1; }
#pragma unroll
            for (int j = 0; j < 4; ++j) { const f32x4 h = v[j] * rstd * gm[j] + sh[j]; u32x2 w; w.x = pk2(h[0], h[1]); w.y = pk2(h[2], h[3]);
                *(u32x2*)(BUF + (size_t)s0 * 1024 + 4 * lane + 256 * j) = w; *(u32x2*)(BUF + (size_t)s1 * 1024 + 4 * lane + 256 * j) = w; } }
    }
}

#ifndef PHMASK
#define PHMASK 0xFFFF
#endif
#define PHM(n) (((PHMASK) >> (n)) & 1)
constexpr int NPHASES = 25;
__global__ void __launch_bounds__(NWAVES * 64, 2) trunk_fwd(Args args) {
    extern __shared__ __attribute__((aligned(16))) unsigned char lds_raw[];
    Frame F;
    F.lds = (LAS unsigned char*)lds_raw;
    F.tid = threadIdx.x; F.lane = F.tid & 63; F.wave = __builtin_amdgcn_readfirstlane(F.tid >> 6);
    F.G = gridDim.x; { const int bx = blockIdx.x; F.vcu = (F.G % 8 == 0) ? (bx % 8) * (F.G / 8) + bx / 8 : bx; }
    GAS unsigned char* const wsbase = (GAS unsigned char*)kin<29>(); F.ws = wsbase; const int vcu0 = F.vcu;
    volatile LAS unsigned* MISC = (volatile LAS unsigned*)(F.lds + MISC_OFF);
    if (F.tid < 32) MISC[F.tid] = 0u;
    __syncthreads();
    const unsigned long long lohi = (unsigned long long)kin<30>(); const int lo = (int)(unsigned)lohi, hi = (int)(unsigned)(lohi >> 32);
    XcdBarrier bar; bar.bar = (unsigned*)(F.ws + WS_CTL) + CW_BAR; bar.x = 0; bar.st = nullptr;
    if (hi - lo > 1) bar = xcd_barrier_post((unsigned*)(F.ws + WS_CTL) + CW_BAR, MISC + 8);
#pragma unroll 1
#if defined(REP_PH)
    for (int phx = lo; phx < hi + REP_N; ++phx) { const int ph = (phx <= REP_PH) ? phx : ((phx - REP_N > REP_PH) ? phx - REP_N : REP_PH);
#else
    for (int ph = lo; ph < hi; ++ph) {
#endif
        { int t_ = threadIdx.x; asm volatile("" : "+v"(t_)); F.tid = t_; F.lane = t_ & 63; F.wave = __builtin_amdgcn_readfirstlane(t_ >> 6);
          GAS unsigned char* w_ = wsbase; asm volatile("" : "+s"(w_)); F.ws = w_; int v_ = vcu0; asm volatile("" : "+s"(v_)); F.vcu = v_; }
        const int l = (ph - 2) / 11, k = (ph >= 2 && ph <= 23) ? (ph - 2) % 11 : -1;
        if (PHM(0) && ph == 0) p0_prologue(F);
        else if (PHM(0) && ph == 1) p0b_ada_reduce(F);
        else if (PHM(1) && ph == 24) p1_norm<2>(F, 1);
        else if (PHM(1) && k == 0) { if (l == 0) p1_norm<0>(F, 0); else p1_norm<1>(F, 1); }
        else if (PHM(3) && k == 2) p2b_lra(F, l);
        #if defined(DBG_SCAN)
        else if (PHM(4) && k == 4) { p4_scan_seq(F, l); __syncthreads(); if (l == 0) p4_scan(F, l); }
#else
        else if (PHM(4) && k == 4) p4_scan(F, l);
#endif
        else if (PHM(5) && k == 5) p5_post(F, l);
        #if defined(REP_PH)
        else if (PHM(7) && k == 7) p7_route(F, l, phx > REP_PH && ph == REP_PH);
#else
        else if (PHM(7) && k == 7) p7_route(F, l);
#endif
        else if (PHM(8) && k == 8) p8_dispatch(F, l);
        else if (PHM(2) && (k == 1 || k == 3 || k == 6 || k == 9 || k == 10)) {
            pg8::Gemm g; pg8::UniOrder S; pg8::EpiUni E;
            S.expert = (k >= 9); S.so.init(T, 1024, F.G, (int)blockIdx.x); S.eo = pg8::ExpertOrder{(const PG8_LAS int*)(F.lds + TAB_OFF + 33 * 4), 0, F.G, (int)blockIdx.x};
            E.e0 = pg8::EpiBf16Plain{(bf16*)(F.ws + WS_P), P_LD, -1}; E.e1 = pg8::EpiResid{nullptr, (float*)(F.ws + WS_X), ada_ptr(F, l, 0) + 2048, 6144}; E.e2 = pg8::EpiSwiGLU{(bf16*)(F.ws + WS_HB)};
            if (k == 1) {
                const int N = (l == 0) ? N_IN : P_LD; S.so.init(T, N, F.G, (int)blockIdx.x); E.mode = 0;
                g = pg8::Gemm{(const bf16*)(F.ws + WS_H), (const bf16*)(F.ws + WS_BT_IN) + (size_t)l * P_LD * 1024, T, N, 1024};
            } else if (k == 3) {
                S.so.init(T, 3072, F.G, (int)blockIdx.x); E.mode = 0; E.e0 = pg8::EpiBf16Plain{(bf16*)(F.ws + WS_LR), 3072, -1};
                g = pg8::Gemm{(const bf16*)(F.ws + WS_ALR), (const bf16*)(F.ws + WS_BT_LR) + (size_t)l * 3072 * 256, T, 3072, 256};
            } else if (k == 6) {
                E.mode = 1; E.e1.xin = (l == 0) ? kin<I_X>() : (const float*)(F.ws + WS_X);
                g = pg8::Gemm{(const bf16*)(F.ws + WS_H), (const bf16*)(F.ws + WS_BT_OUT) + (size_t)l * 1024 * 1024, T, 1024, 1024};
            } else {
                expert_table(F, l);
                S.eo.ntiles = ((const LAS int*)(F.lds + TAB_OFF))[65];
                if (k == 9) { E.mode = 2; g = pg8::Gemm{(const bf16*)(F.ws + WS_BUF), (const bf16*)(F.ws + WS_BT_E1) + (size_t)l * 32 * 1024 * 1024, MAXROWS, 32 * 1024, 1024}; }
                else { E.mode = 0; E.e0 = pg8::EpiBf16Plain{(bf16*)(F.ws + WS_YE), 1024, 3}; g = pg8::Gemm{(const bf16*)(F.ws + WS_HB), (const bf16*)(F.ws + WS_BT_E2) + (size_t)l * 32 * 1024 * 512, MAXROWS, 32 * 1024, 512}; }
            }
            pg8::gemm_phase<pg8::EpiUni, pg8::UniOrder, true, true>(F.lds, g, S, E);
        }
#if defined(REP_PH)
        if (phx + 1 < hi + REP_N) xcd_barrier(bar);
#else
        if (ph + 1 < hi) xcd_barrier(bar);
#endif
    }
}

extern "C" void kernel_launch(void* const* d_in, const int* in_sizes, int n_in, void* d_out, int out_size, void* d_ws, size_t ws_size, hipStream_t stream) {
    static int grid = 0;
    if (grid == 0) {
        if (n_in != 28 || in_sizes[0] != T * D || out_size != T * D || ws_size < WS_END) { fprintf(stderr, "kernel_launch: unexpected shapes (n_in %d, in0 %d, out %d, ws %zu < %zu?); nothing launched\n", n_in, n_in > 0 ? in_sizes[0] : -1, out_size, ws_size, (size_t)WS_END); grid = -1; return; }
        int dev = 0, cus = 0, per_cu = 0;
        if (hipGetDevice(&dev) != hipSuccess || hipDeviceGetAttribute(&cus, hipDeviceAttributeMultiprocessorCount, dev) != hipSuccess) { fprintf(stderr, "kernel_launch: device query failed\n"); grid = -1; return; }
        if (hipFuncSetAttribute((const void*)trunk_fwd, hipFuncAttributeMaxDynamicSharedMemorySize, LDS_BYTES) != hipSuccess) { fprintf(stderr, "kernel_launch: hipFuncSetAttribute failed\n"); grid = -1; return; }
        if (hipOccupancyMaxActiveBlocksPerMultiprocessor(&per_cu, (const void*)trunk_fwd, NWAVES * 64, LDS_BYTES) != hipSuccess || per_cu < 1) { fprintf(stderr, "kernel_launch: occupancy query says %d blocks per CU\n", per_cu); }
        (void)hipGetLastError();
        grid = cus;
    }
    if (grid < 0) return;
    if (hipMemsetAsync((char*)d_ws + WS_CTL, 0, CTL_ZERO_BYTES, stream) != hipSuccess) { fprintf(stderr, "kernel_launch: memset failed\n"); return; }
    Args a{};
    for (int i = 0; i < 28; ++i) a.p[i] = d_in[i];
    a.p[28] = d_out; a.p[29] = d_ws;
#if MK_ONE_LAUNCH
    a.ph_lo = 0; a.ph_hi = NPHASES;
    void* kargs[] = {&a};
    hipError_t e = hipLaunchCooperativeKernel((const void*)trunk_fwd, dim3(grid), dim3(NWAVES * 64), kargs, LDS_BYTES, stream);
    if (e != hipSuccess) fprintf(stderr, "kernel_launch: cooperative launch failed: %s (grid %d)\n", hipGetErrorString(e), grid);
#else
    for (int p = 0; p < NPHASES; ++p) { a.ph_lo = p; a.ph_hi = p + 1;
        hipLaunchKernelGGL(trunk_fwd, dim3(grid), dim3(NWAVES * 64), LDS_BYTES, stream, a);
        const hipError_t le = hipPeekAtLastError(); if (le != hipSuccess) { fprintf(stderr, "kernel_launch: launch %d failed: %s\n", p, hipGetErrorName(le)); break; } }
#endif
}
```

```cpp
#include <hip/hip_runtime.h>
#include <cstdio>
#include <cstdint>

#ifndef MK_ONE_LAUNCH
#define MK_ONE_LAUNCH 1
#endif

namespace pg8 {
#define PG8_LAS __attribute__((address_space(3)))
typedef unsigned short bf16_t;
typedef short bf16x8 __attribute__((ext_vector_type(8)));
typedef float f32x4 __attribute__((ext_vector_type(4)));
typedef unsigned u32x4 __attribute__((ext_vector_type(4)));
constexpr int BM = 256, BK = 64, HALF = 128, HTB = HALF * BK * 2  , STAGE_BYTES = 8 * HTB, NXCD = 8, WGM = 8;

__host__ __device__ __forceinline__ int lds_byte(int r, int c) { const int st = (r >> 4) * 2 + (c >> 5), rr = r & 15, cc = c & 31, ob = rr * 64 + cc * 2; return st * 1024 + (ob ^ (((ob >> 9) & 1) << 5)); }
__host__ __device__ __forceinline__ void stage_rc(int b, int& R, int& C) { const int st = b / 1024, sb = b % 1024, swz = sb ^ (((sb >> 9) & 1) << 5); R = (st >> 1) * 16 + swz / 64; C = (st & 1) * 32 + (swz % 64) / 2; }
__host__ __device__ __forceinline__ int perm32(int rho) { const int n = rho >> 4, i = rho & 15; return 8 * (i >> 2) + 4 * n + (i & 3); }

struct Unit { int pm, pn; };
struct Gemm { const bf16_t* A; const bf16_t* Bt; int M, N, K; };

struct StaticOrder {
    int nM, nN, nwg, G, c;
    __host__ __device__ void init(int M, int N, int G_, int c_) { nM = M / BM; nN = N / BM; nwg = nM * nN; G = G_; c = c_; }
    __host__ __device__ bool next(int i, Unit& u) const {
        const long L = (long)i * G + c; if (L >= nwg) return false;
        int wgid = (int)L; { const int q = nwg / NXCD, r = nwg % NXCD, xcd = wgid % NXCD, off = wgid / NXCD; wgid = (xcd < r ? xcd * (q + 1) : r * (q + 1) + (xcd - r) * q) + off; }
        const int nig = WGM * nN, gid = wgid / nig, fm = gid * WGM, gsz = (nM - fm) < WGM ? (nM - fm) : WGM;
        u.pm = fm + ((wgid % nig) % gsz); u.pn = (wgid % nig) / gsz; return true;
    }
    __device__ __forceinline__ void a_ready(const Unit&) const {}
    __device__ __forceinline__ void done(const Unit&) const {}
};
__device__ __forceinline__ unsigned cvt_pk_bf16(float lo, float hi) { unsigned r; asm volatile("v_cvt_pk_bf16_f32 %0, %1, %2" : "=v"(r) : "v"(lo), "v"(hi)); return r; }
typedef float f32x2 __attribute__((ext_vector_type(2)));
typedef unsigned u32x2 __attribute__((ext_vector_type(2)));

struct EpiBf16Plain {
    static constexpr bool PERM = true, AFTER_DRAIN = false;
    bf16_t* O; int ldc; int cmask;
    __device__ __forceinline__ void operator()(const f32x4 (&acc)[2][2][4][2], const Unit& u, int wr, int wc, int fr, int fq) const {
        const int row0 = u.pm * BM + wr * 64 + fr; const int col0 = (u.pn & cmask) * BM + wc * 32 + 8 * fq;
#pragma unroll
        for (int ai = 0; ai < 2; ++ai)
#pragma unroll
            for (int m = 0; m < 4; ++m) { bf16_t* rowp = O + (size_t)(row0 + ai * HALF + m * 16) * ldc + col0;
#pragma unroll
                for (int bj = 0; bj < 2; ++bj) { const f32x4 v0 = acc[ai][bj][m][0], v1 = acc[ai][bj][m][1];
                    u32x4 w; w.x = cvt_pk_bf16(v0[0], v0[1]); w.y = cvt_pk_bf16(v0[2], v0[3]); w.z = cvt_pk_bf16(v1[0], v1[1]); w.w = cvt_pk_bf16(v1[2], v1[3]);
                    *(u32x4*)(rowp + bj * HALF) = w; } }
    }
};
struct EpiResid {
    static constexpr bool PERM = false, AFTER_DRAIN = false;
    const float* xin; float* xout; const float* gate;
    int gstride;
    __device__ __forceinline__ void operator()(const f32x4 (&acc)[2][2][4][2], const Unit& u, int wr, int wc, int fr, int fq) const {
        const int row0 = u.pm * BM + wr * 64 + fr, col0 = u.pn * BM + wc * 32 + 4 * fq;
        const float* gp = gate + (size_t)(u.pm >> 3) * gstride;
        f32x4 gv[2][2];
#pragma unroll
        for (int bj = 0; bj < 2; ++bj)
#pragma unroll
            for (int n = 0; n < 2; ++n) gv[bj][n] = *(const f32x4*)(gp + col0 + bj * HALF + n * 16);
#pragma unroll
        for (int ai = 0; ai < 2; ++ai)
#pragma unroll
            for (int m = 0; m < 4; ++m) { const size_t ro = (size_t)(row0 + ai * HALF + m * 16) * 1024 + col0;
#pragma unroll
                for (int bj = 0; bj < 2; ++bj)
#pragma unroll
                    for (int n = 0; n < 2; ++n) { const f32x4 xi = *(const f32x4*)(xin + ro + bj * HALF + n * 16);
                        *(f32x4*)(xout + ro + bj * HALF + n * 16) = xi + gv[bj][n] * acc[ai][bj][m][n]; }
                asm volatile("" ::: "memory"); }
    }
};
struct EpiSwiGLU {
    static constexpr bool PERM = false, AFTER_DRAIN = false;
    bf16_t* O;
    __device__ __forceinline__ void operator()(const f32x4 (&acc)[2][2][4][2], const Unit& u, int wr, int wc, int fr, int fq) const {
        const int row0 = u.pm * BM + wr * 64 + fr, col0 = (u.pn & 3) * HALF + wc * 32 + 4 * fq;
#pragma unroll
        for (int ai = 0; ai < 2; ++ai)
#pragma unroll
            for (int m = 0; m < 4; ++m) { bf16_t* rowp = O + (size_t)(row0 + ai * HALF + m * 16) * 512 + col0;
#pragma unroll
                for (int n = 0; n < 2; ++n) { const f32x4 g = acc[ai][0][m][n], up = acc[ai][1][m][n]; f32x4 h;
#pragma unroll
                    for (int j = 0; j < 4; ++j) h[j] = g[j] * __builtin_amdgcn_rcpf(1.0f + __expf(-g[j])) * up[j];
                    u32x2 w; w.x = cvt_pk_bf16(h[0], h[1]); w.y = cvt_pk_bf16(h[2], h[3]);
                    *(u32x2*)(rowp + n * 16) = w; } }
    }
};
struct ExpertOrder {
    const PG8_LAS int* ts; int ntiles, G, c;
    __device__ __forceinline__ bool next(int i, Unit& u) const {
        const int L = i * G + c; if (L >= ntiles * 4) return false;
        const int pm = L >> 2; int e = 0;
#pragma unroll 1
        for (int k = 1; k < 32; ++k) e += (ts[k] <= pm) ? 1 : 0;
        u.pm = pm; u.pn = e * 4 + (L & 3); return true;
    }
    __device__ __forceinline__ void a_ready(const Unit&) const {}
    __device__ __forceinline__ void done(const Unit&) const {}
};

struct UniOrder {
    StaticOrder so; ExpertOrder eo; bool expert;
    __device__ __forceinline__ bool next(int i, Unit& u) const { return expert ? eo.next(i, u) : so.next(i, u); }
    __device__ __forceinline__ void a_ready(const Unit&) const {}
    __device__ __forceinline__ void done(const Unit&) const {}
};
struct EpiUni {
    static constexpr bool AFTER_DRAIN = false;
    int mode; EpiBf16Plain e0; EpiResid e1; EpiSwiGLU e2;
    __device__ __forceinline__ bool perm() const { return mode == 0; }
    __device__ __forceinline__ void operator()(const f32x4 (&acc)[2][2][4][2], const Unit& u, int wr, int wc, int fr, int fq) const {
        if (mode == 0) e0(acc, u, wr, wc, fr, fq); else if (mode == 1) e1(acc, u, wr, wc, fr, fq); else e2(acc, u, wr, wc, fr, fq);
    }
};
template <class Epi, class Sched, bool ALIGN_EPI = false, bool SP2 = false>
__device__ __forceinline__ void gemm_phase(PG8_LAS unsigned char* lds, const Gemm g, const Sched& S, const Epi& E) {
    int tid_ = threadIdx.x; asm volatile("" : "+v"(tid_));
    const int tid = tid_, wid = __builtin_amdgcn_readfirstlane(tid >> 6), lane = tid & 63, wr = wid >> 2, wc = wid & 3, fr = lane & 15, fq = lane >> 4;
    const int K = g.K, nt = K / BK;
    unsigned voffA[2], voffB[2];
#pragma unroll
    for (int i = 0; i < 2; ++i) { int R, C; stage_rc(tid * 16 + i * 8192, R, C); const int Rb = E.perm() ? ((R & ~31) + perm32(R & 31)) : R;
        voffA[i] = (unsigned)(R * K + C) * 2u; voffB[i] = (unsigned)(Rb * K + C) * 2u; }
    const size_t kstep = (size_t)(BK * 2);
    const size_t hstep = (size_t)HALF * K * 2;
    const size_t tstep = 2 * hstep;
    const unsigned ldsw = (unsigned)wid * 1024u;
    const int aoff = lds_byte(wr * 64 + fr, fq * 8), boff = lds_byte(wc * 32 + fr, fq * 8);
#define PG8_SA(b, h) (((b) * 2 + (h)) * HTB)
#define PG8_SB(b, h) ((4 + (b) * 2 + (h)) * HTB)
#define PG8_STAGE(bufoff, gbase, voff) do { _Pragma("unroll") for (int _i = 0; _i < 2; ++_i) \
        __builtin_amdgcn_global_load_lds((const unsigned*)((const char*)(gbase) + (voff)[_i]), (PG8_LAS unsigned*)(lds + (bufoff) + ldsw + _i * 8192), 16, 0, 0); } while (0)
#define PG8_LDA(dst, b, h) do { _Pragma("unroll") for (int m = 0; m < 4; ++m) _Pragma("unroll") for (int k = 0; k < 2; ++k) dst[m][k] = *(const PG8_LAS bf16x8*)(lds + PG8_SA(b, h) + aoff + m * 2048 + k * 1024); } while (0)
#define PG8_LDB(dst, b, h) do { _Pragma("unroll") for (int n = 0; n < 2; ++n) _Pragma("unroll") for (int k = 0; k < 2; ++k) dst[n][k] = *(const PG8_LAS bf16x8*)(lds + PG8_SB(b, h) + boff + n * 2048 + k * 1024); } while (0)
#define PG8_MMA(ai, bj, At, Bt) do { __builtin_amdgcn_s_setprio(1); _Pragma("unroll") for (int m = 0; m < 4; ++m) _Pragma("unroll") for (int n = 0; n < 2; ++n) _Pragma("unroll") for (int k = 0; k < 2; ++k) \
        acc[ai][bj][m][n] = __builtin_amdgcn_mfma_f32_16x16x32_bf16(Bt[n][k], At[m][k], acc[ai][bj][m][n], 0, 0, 0); __builtin_amdgcn_s_setprio(0); } while (0)
#define PG8_WAIT_V(n) asm volatile("s_waitcnt vmcnt(" #n ")" ::: "memory")
#define PG8_WAIT_L(n) asm volatile("s_waitcnt lgkmcnt(" #n ")" ::: "memory")
#define PG8_BAR __builtin_amdgcn_s_barrier()
#define PG8_SCHED __builtin_amdgcn_sched_barrier(0)
    Unit cur, nxt; int ui = 0;
    if (!S.next(0, cur)) return;
    f32x4 acc[2][2][4][2];
#pragma unroll
    for (int a = 0; a < 2; ++a)
#pragma unroll
        for (int b = 0; b < 2; ++b)
#pragma unroll
            for (int m = 0; m < 4; ++m)
#pragma unroll
                for (int n = 0; n < 2; ++n) acc[a][b][m][n] = (f32x4){0.f, 0.f, 0.f, 0.f};
    bf16x8 At[4][2], B0[2][2], B1[2][2];
    const char* cA = (const char*)g.A + (size_t)cur.pm * tstep; const char* cB = (const char*)g.Bt + (size_t)cur.pn * tstep;
    S.a_ready(cur);
    if constexpr (SP2) {
        PG8_STAGE(PG8_SB(0, 0), cB, voffB); PG8_STAGE(PG8_SB(0, 1), cB + hstep, voffB); PG8_STAGE(PG8_SA(0, 0), cA, voffA); PG8_STAGE(PG8_SA(0, 1), cA + hstep, voffA);
        if (wr == 1) PG8_BAR;
        PG8_WAIT_V(2); PG8_BAR;
        PG8_STAGE(PG8_SB(1, 0), cB + kstep, voffB); PG8_STAGE(PG8_SA(1, 0), cA + kstep, voffA); PG8_STAGE(PG8_SB(1, 1), cB + hstep + kstep, voffB);
        PG8_WAIT_V(6); PG8_BAR;
    } else {
        PG8_STAGE(PG8_SB(0, 0), cB, voffB); PG8_STAGE(PG8_SA(0, 0), cA, voffA); PG8_STAGE(PG8_SB(0, 1), cB + hstep, voffB); PG8_STAGE(PG8_SA(0, 1), cA + hstep, voffA);
        if (wr == 1) PG8_BAR;
        PG8_WAIT_V(4); PG8_BAR;
        PG8_STAGE(PG8_SB(1, 0), cB + kstep, voffB); PG8_STAGE(PG8_SA(1, 0), cA + kstep, voffA); PG8_STAGE(PG8_SB(1, 1), cB + hstep + kstep, voffB);
        PG8_WAIT_V(6); PG8_BAR;
    }
    for (;;) {
        const bool has_next = S.next(ui + 1, nxt);
        const char* nA = has_next ? (const char*)g.A + (size_t)nxt.pm * tstep : cA; const char* nB = has_next ? (const char*)g.Bt + (size_t)nxt.pn * tstep : cB;
        for (int t = 0; t < nt; t += 2) {
            const bool last = (t == nt - 2);
            const char* a1 = cA + (size_t)(t + 1) * kstep;
            const char* a2 = last ? nA : cA + (size_t)(t + 2) * kstep; const char* b2 = last ? nB : cB + (size_t)(t + 2) * kstep;
            const char* a3 = a2 + kstep; const char* b3 = b2 + kstep;
            if (last && has_next) S.a_ready(nxt);
            if constexpr (SP2) {
            PG8_LDB(B0, 0, 0); PG8_LDB(B1, 0, 1); PG8_SCHED; PG8_LDA(At, 0, 0); PG8_STAGE(PG8_SA(1, 1), a1 + hstep, voffA);
            PG8_WAIT_V(8); PG8_WAIT_L(0); PG8_BAR; PG8_MMA(0, 0, At, B0); PG8_MMA(0, 1, At, B1); PG8_BAR; PG8_SCHED;
            PG8_LDA(At, 0, 1); PG8_STAGE(PG8_SB(0, 0), b2, voffB); PG8_STAGE(PG8_SB(0, 1), b2 + hstep, voffB); PG8_STAGE(PG8_SA(0, 0), a2, voffA);
            PG8_WAIT_V(8); PG8_WAIT_L(0); PG8_BAR; PG8_MMA(1, 0, At, B0); PG8_MMA(1, 1, At, B1); PG8_BAR; PG8_SCHED;
            PG8_LDB(B0, 1, 0); PG8_LDB(B1, 1, 1); PG8_SCHED; PG8_LDA(At, 1, 0); PG8_STAGE(PG8_SA(0, 1), a2 + hstep, voffA);
            PG8_WAIT_V(8); PG8_WAIT_L(0); PG8_BAR; PG8_MMA(0, 0, At, B0); PG8_MMA(0, 1, At, B1); PG8_BAR; PG8_SCHED;
            PG8_LDA(At, 1, 1); PG8_STAGE(PG8_SB(1, 0), b3, voffB); PG8_STAGE(PG8_SB(1, 1), b3 + hstep, voffB); PG8_STAGE(PG8_SA(1, 0), a3, voffA);
            PG8_WAIT_V(8); PG8_WAIT_L(0); PG8_BAR; PG8_MMA(1, 0, At, B0); PG8_MMA(1, 1, At, B1); PG8_BAR; PG8_SCHED;
            } else {
            PG8_LDB(B0, 0, 0); PG8_SCHED; PG8_LDA(At, 0, 0); PG8_STAGE(PG8_SA(1, 1), a1 + hstep, voffA);
            PG8_WAIT_L(8); PG8_BAR; PG8_WAIT_L(0); PG8_MMA(0, 0, At, B0); PG8_BAR; PG8_SCHED;
            PG8_LDB(B1, 0, 1); PG8_STAGE(PG8_SB(0, 0), b2, voffB);
            PG8_BAR; PG8_WAIT_L(0); PG8_MMA(0, 1, At, B1); PG8_BAR;
            PG8_LDA(At, 0, 1); PG8_STAGE(PG8_SA(0, 0), a2, voffA);
            PG8_BAR; PG8_WAIT_L(0); PG8_MMA(1, 0, At, B0); PG8_BAR; PG8_SCHED;
            PG8_STAGE(PG8_SB(0, 1), b2 + hstep, voffB);
            PG8_WAIT_V(6); PG8_BAR; PG8_MMA(1, 1, At, B1); PG8_BAR;
            PG8_LDB(B0, 1, 0); PG8_SCHED; PG8_LDA(At, 1, 0); PG8_STAGE(PG8_SA(0, 1), a2 + hstep, voffA);
            PG8_WAIT_L(8); PG8_BAR; PG8_WAIT_L(0); PG8_MMA(0, 0, At, B0); PG8_BAR; PG8_SCHED;
            PG8_LDB(B1, 1, 1); PG8_STAGE(PG8_SB(1, 0), b3, voffB);
            PG8_BAR; PG8_WAIT_L(0); PG8_MMA(0, 1, At, B1); PG8_BAR;
            PG8_LDA(At, 1, 1); PG8_STAGE(PG8_SA(1, 0), a3, voffA);
            PG8_BAR; PG8_WAIT_L(0); PG8_MMA(1, 0, At, B0); PG8_BAR; PG8_SCHED;
            PG8_STAGE(PG8_SB(1, 1), b3 + hstep, voffB);
            PG8_WAIT_V(6); PG8_BAR; PG8_MMA(1, 1, At, B1); PG8_BAR;
            }
        }
        if constexpr (ALIGN_EPI) { if (wr == 0) PG8_BAR; }
        if constexpr (!Epi::AFTER_DRAIN) { E(acc, cur, wr, wc, fr, fq); S.done(cur); }
        if (!has_next) break;
#pragma unroll
        for (int a = 0; a < 2; ++a)
#pragma unroll
            for (int b = 0; b < 2; ++b)
#pragma unroll
                for (int m = 0; m < 4; ++m)
#pragma unroll
                    for (int n = 0; n < 2; ++n) acc[a][b][m][n] = (f32x4){0.f, 0.f, 0.f, 0.f};
        cur = nxt; cA = nA; cB = nB; ++ui;
        if constexpr (ALIGN_EPI) { if (wr == 1) PG8_BAR; }
    }
    PG8_WAIT_V(0);
    if constexpr (!ALIGN_EPI) { if (wr == 0) PG8_BAR; }
    PG8_BAR;
    if constexpr (Epi::AFTER_DRAIN) { E.fused(acc, cur, wr, wc, fr, fq, lds, wid, lane); S.done(cur); }
#undef PG8_SA
#undef PG8_SB
#undef PG8_STAGE
#undef PG8_LDA
#undef PG8_LDB
#undef PG8_MMA
#undef PG8_WAIT_V
#undef PG8_WAIT_L
#undef PG8_BAR
#undef PG8_SCHED
}
}

constexpr int NWAVES = 8;
constexpr int T = 16384, D = 1024, SEQ = 2048, NBATCH = 8, NHEAD = 16;
constexpr int N_IN = 8448, P_LD = 9472;
constexpr int C_CB = 0, C_CC = 1024, C_CH = 2048, C_GA = 3072, C_GB = 4096, C_R = 5120, C_K = 6144, C_V = 7168, C_WD = 8192, C_AD = 8256, C_GD = 8320, C_VD = 8448;
constexpr int N_SHIFT = 3328, N_EXP = 32, D_EXP = 512;
constexpr int MAXROWS = 40960;
constexpr float NORM_EPS = 1e-6f, LNX_EPS = 64e-5f;

constexpr size_t MiB = 1u << 20;
constexpr size_t WS_CTL = 0, CTL_ZERO_BYTES = 1 * MiB;
constexpr size_t WS_BT_IN = 2 * MiB;
constexpr size_t WS_BT_OUT = 39 * MiB;
constexpr size_t WS_BT_E1 = 43 * MiB;
constexpr size_t WS_BT_E2 = 171 * MiB;
constexpr size_t WS_H = 235 * MiB;
constexpr size_t WS_ALR = WS_H;
constexpr size_t WS_P = 267 * MiB;
constexpr size_t WS_BUF = WS_P, WS_HB = WS_P + 80 * MiB, WS_YE = WS_P + 120 * MiB;
constexpr size_t WS_ADAP = WS_P;
constexpr size_t WS_W = 563 * MiB;
constexpr size_t WS_KK = 627 * MiB, WS_BQ = 659 * MiB, WS_KP = 691 * MiB, WS_R = 723 * MiB, WS_V0 = 755 * MiB, WS_V1 = 787 * MiB;
constexpr size_t WS_LR = 819 * MiB;
constexpr size_t WS_Y = 915 * MiB;
constexpr size_t WS_X = 947 * MiB;
constexpr size_t WS_BONUS = 1011 * MiB;
constexpr size_t WS_EIDX = 1012 * MiB, WS_POS = WS_EIDX + 128 * 1024, WS_WTS = WS_EIDX + 256 * 1024, WS_SLOT = WS_EIDX + 384 * 1024;
constexpr size_t WS_HIST = WS_EIDX + 512 * 1024;
constexpr size_t WS_WRT = WS_EIDX + 768 * 1024;
constexpr size_t WS_KN = WS_KK;
constexpr size_t WS_BONP = WS_KK + 2 * MiB;
constexpr size_t WS_BT_LR = 1015 * MiB;
constexpr size_t WS_END = 1018 * MiB;
static_assert(WS_YE + (size_t)MAXROWS * 1024 * 2 <= WS_W && WS_P + (size_t)T * P_LD * 2 <= WS_W && WS_BT_IN + (size_t)2 * P_LD * 2048 <= WS_BT_OUT, "ws map");
constexpr int CW_CNT = 1024;
constexpr int CW_BAR = 4096;
constexpr size_t CTL_ADA = 256 * 1024;
constexpr size_t CTL_BIASR = 700 * 1024;

constexpr int RING_BYTES = 131072;
constexpr int TAB_OFF = RING_BYTES;
constexpr int MISC_OFF = RING_BYTES + 1024;
constexpr int LDS_BYTES = 147456;

#define GAS __attribute__((address_space(1)))
#define LAS __attribute__((address_space(3)))
typedef unsigned short bf16;
typedef float f32x4 __attribute__((ext_vector_type(4)));
typedef float f32x2 __attribute__((ext_vector_type(2)));
typedef unsigned u32x4 __attribute__((ext_vector_type(4)));
typedef unsigned u32x2 __attribute__((ext_vector_type(2)));
#define LDS_WAIT() asm volatile("s_waitcnt lgkmcnt(0)" ::: "memory")

__device__ __forceinline__ unsigned f2bf(float f) { unsigned u = __builtin_bit_cast(unsigned, f); return (u + 0x7fffu + ((u >> 16) & 1u)) >> 16; }
__device__ __forceinline__ unsigned pk2(float lo, float hi) { return f2bf(lo) | (f2bf(hi) << 16); }
typedef __bf16 bfl2 __attribute__((ext_vector_type(2)));
__device__ __forceinline__ unsigned pkbf(float lo, float hi) { f32x2 v; v.x = lo; v.y = hi; return __builtin_bit_cast(unsigned, __builtin_convertvector(v, bfl2)); }
__device__ __forceinline__ float bflo(unsigned u) { return __builtin_bit_cast(float, u << 16); }
__device__ __forceinline__ float bfhi(unsigned u) { return __builtin_bit_cast(float, u & 0xffff0000u); }
__device__ __forceinline__ void load8(const bf16* p, float (&o)[8]) { const u32x4 u = *(const u32x4*)p; o[0] = bflo(u.x); o[1] = bfhi(u.x); o[2] = bflo(u.y); o[3] = bfhi(u.y); o[4] = bflo(u.z); o[5] = bfhi(u.z); o[6] = bflo(u.w); o[7] = bfhi(u.w); }
__device__ __forceinline__ void store8(bf16* p, const float (&v)[8]) { u32x4 w; w.x = pk2(v[0], v[1]); w.y = pk2(v[2], v[3]); w.z = pk2(v[4], v[5]); w.w = pk2(v[6], v[7]); *(u32x4*)p = w; }
typedef _Float16 f16x2 __attribute__((ext_vector_type(2)));
__device__ __forceinline__ unsigned pkh2(float lo, float hi) { f16x2 h; h.x = (_Float16)lo; h.y = (_Float16)hi; return __builtin_bit_cast(unsigned, h); }
__device__ __forceinline__ float hlo(unsigned u) { return (float)__builtin_bit_cast(f16x2, u).x; }
__device__ __forceinline__ float hhi(unsigned u) { return (float)__builtin_bit_cast(f16x2, u).y; }
__device__ __forceinline__ void load8h(const bf16* p, float (&o)[8]) { const u32x4 u = *(const u32x4*)p; o[0] = hlo(u.x); o[1] = hhi(u.x); o[2] = hlo(u.y); o[3] = hhi(u.y); o[4] = hlo(u.z); o[5] = hhi(u.z); o[6] = hlo(u.w); o[7] = hhi(u.w); }
__device__ __forceinline__ void store8h(bf16* p, const float (&v)[8]) { u32x4 w; w.x = pkh2(v[0], v[1]); w.y = pkh2(v[2], v[3]); w.z = pkh2(v[4], v[5]); w.w = pkh2(v[6], v[7]); *(u32x4*)p = w; }
__device__ __forceinline__ float fmx_lo(float a, unsigned h, float c) { float d; asm("v_fma_mix_f32 %0, %1, %2, %3 op_sel_hi:[0,1,0]" : "=v"(d) : "v"(a), "v"(h), "v"(c)); return d; }
__device__ __forceinline__ float fmx_hi(float a, unsigned h, float c) { float d; asm("v_fma_mix_f32 %0, %1, %2, %3 op_sel:[0,1,0] op_sel_hi:[0,1,0]" : "=v"(d) : "v"(a), "v"(h), "v"(c)); return d; }
__device__ __forceinline__ float mmx_lo(float a, unsigned h) { float d; asm("v_fma_mix_f32 %0, %1, %2, 0 op_sel_hi:[0,1,0]" : "=v"(d) : "v"(a), "v"(h)); return d; }
__device__ __forceinline__ float mmx_hi(float a, unsigned h) { float d; asm("v_fma_mix_f32 %0, %1, %2, 0 op_sel:[0,1,0] op_sel_hi:[0,1,0]" : "=v"(d) : "v"(a), "v"(h)); return d; }
__device__ __forceinline__ float sigmoidf_(float x) { return __builtin_amdgcn_rcpf(1.0f + __expf(-x)); }
__device__ __forceinline__ float tanhf_(float x) { return 1.0f - 2.0f * __builtin_amdgcn_rcpf(__expf(2.0f * x) + 1.0f); }
__device__ __forceinline__ float wave_sum(float v) {
#pragma unroll
    for (int o = 1; o < 64; o <<= 1) v += __shfl_xor(v, o);
    return v;
}
__device__ __forceinline__ float sum8(float v) { v += __shfl_xor(v, 1); v += __shfl_xor(v, 2); v += __shfl_xor(v, 4); return v; }
template <int CTRL> __device__ __forceinline__ float dpp_f(float v) { return __builtin_bit_cast(float, __builtin_amdgcn_mov_dpp(__builtin_bit_cast(int, v), CTRL, 0xF, 0xF, true)); }
__device__ __forceinline__ float dpp_sum16(float v) {
    v += dpp_f<0xB1>(v);
    v += dpp_f<0x4E>(v);
    v += dpp_f<0x141>(v);
    v += dpp_f<0x140>(v);
    return v;
}

#define XB_TMO      128
#define XB_XCNT(j)  (256  + 64 * (j))
#define XB_XSUB(j)  (1280 + 64 * (j))
#define XB_XGEN(j)  (2304 + 64 * (j))
#define XB_TOP      3328
#define XB_TOPGEN   3392
#define XCD_BAR_WORDS 3456
#define XB_SPIN_CAP (1u << 18)

__device__ __forceinline__ unsigned xb_ld(unsigned* p)              { return __hip_atomic_load(p, __ATOMIC_RELAXED, __HIP_MEMORY_SCOPE_AGENT); }
__device__ __forceinline__ unsigned xb_add(unsigned* p, unsigned v) { return __hip_atomic_fetch_add(p, v, __ATOMIC_RELAXED, __HIP_MEMORY_SCOPE_AGENT); }
__device__ __forceinline__ unsigned xb_xcc_id() { return (unsigned)__builtin_amdgcn_s_getreg((3 << 11) | 20) & 0xFu; }
#define XB_SPIN(cond, bar) do { unsigned _sp = 0; while (cond) { __builtin_amdgcn_s_sleep(1); \
    if ((++_sp & 255u) == 0u) { if (xb_ld(&(bar)[XB_TMO])) break; if (_sp > XB_SPIN_CAP) { atomicAdd(&(bar)[XB_TMO], 1u); break; } } } } while (0)

struct XcdBarrier {
    unsigned* bar; unsigned x;
    volatile LAS unsigned* st;
};

__device__ __forceinline__ XcdBarrier xcd_barrier_post(unsigned* bar, volatile LAS unsigned* st) {
    XcdBarrier b; b.bar = bar; b.x = xb_xcc_id(); b.st = st;
    if (threadIdx.x == 0) (void)xb_add(&bar[XB_XCNT(b.x)], 1u);
    return b;
}
__device__ __forceinline__ void xcd_barrier_complete(unsigned* bar, unsigned x, unsigned& nloc, unsigned& nx) {
    const unsigned G = gridDim.x * gridDim.y * gridDim.z;
    unsigned sum, cnt, mine, sp = 0u;
    for (;;) {
        sum = 0u; cnt = 0u; mine = 0u;
#pragma unroll
        for (unsigned j = 0; j < 16; ++j) { const unsigned c = xb_ld(&bar[XB_XCNT(j)]); sum += c; cnt += (c > 0u) ? 1u : 0u; mine = (j == x) ? c : mine; }
        if (sum == G) break;
        __builtin_amdgcn_s_sleep(1);
        if ((++sp & 255u) == 0u) { if (xb_ld(&bar[XB_TMO])) break; if (sp > XB_SPIN_CAP) { atomicAdd(&bar[XB_TMO], 1u); break; } }
    }
    nloc = mine > 0u ? mine : 1u; nx = cnt > 0u ? cnt : 1u;
}

__device__ __forceinline__ void xcd_barrier(const XcdBarrier& b) {
    asm volatile("s_waitcnt vmcnt(0)" ::: "memory");
    __syncthreads();
    if (threadIdx.x == 0) {
        unsigned* bar = b.bar;
        __builtin_amdgcn_s_waitcnt(0);
        unsigned nloc = b.st[0], nx = b.st[1];
        if (nloc == 0u) { xcd_barrier_complete(bar, b.x, nloc, nx); b.st[0] = nloc; b.st[1] = nx; }
        const unsigned old = xb_add(&bar[XB_XSUB(b.x)], 1u);
        const unsigned gen = old / nloc;
        if (old + 1u == (gen + 1u) * nloc) {
            __builtin_amdgcn_fence(__ATOMIC_RELEASE, "agent");
            asm volatile("s_waitcnt vmcnt(0)" ::: "memory");
            const unsigned og = xb_add(&bar[XB_TOP], 1u);
            const unsigned tg = og / nx;
            if (og + 1u == (tg + 1u) * nx) xb_add(&bar[XB_TOPGEN], 1u);
            else XB_SPIN(xb_ld(&bar[XB_TOPGEN]) == tg, bar);
            __builtin_amdgcn_fence(__ATOMIC_ACQUIRE, "agent");
            xb_add(&bar[XB_XGEN(b.x)], 1u);
            asm volatile("s_waitcnt vmcnt(0)" ::: "memory");
        } else {
            XB_SPIN(xb_ld(&bar[XB_XGEN(b.x)]) == gen, bar);
            __builtin_amdgcn_fence(__ATOMIC_ACQUIRE, "agent");
            asm volatile("s_waitcnt vmcnt(0)" ::: "memory");
        }
    }
    __syncthreads();
}

struct Args { const void* p[30]; int ph_lo, ph_hi; };
template <int IDX> __device__ __forceinline__ const float* kin() {
    const auto ka = __builtin_amdgcn_kernarg_segment_ptr(); unsigned long long v;
    asm volatile("s_load_dwordx2 %0, %1, %2\n\ts_waitcnt lgkmcnt(0)" : "=s"(v) : "s"(ka), "i"(IDX * 8) : "memory");
    return (const float*)(const GAS float*)v;
}
enum { I_X = 0, I_C, I_WADA, I_BADA, I_N1G, I_N2G, I_WIN, I_MU, I_CONVW, I_W0, I_DECUP, I_A0, I_AAAUP, I_GATEUP, I_KK, I_KA, I_RK, I_LNW, I_LNB, I_VMD, I_VMU, I_V0, I_WOUT, I_WR, I_RB, I_WE1, I_WE2, I_FG };
struct Frame {
    LAS unsigned char* lds;
    int tid, lane, wave, vcu, G;
    GAS unsigned char* ws;
};
__device__ __forceinline__ float* ada_ptr(const Frame& F, int l, int b) { return (float*)(F.ws + WS_CTL + CTL_ADA) + (size_t)(l * 8 + b) * 6144; }

__device__ __forceinline__ void transpose_item(const float* W, int K, int N, bf16* WT, int dst_row0, int k0, int n0, LAS float* scr, int lane) {
    float tv[32];
#pragma unroll
    for (int i = 0; i < 32; ++i) tv[i] = W[(size_t)(k0 + 2 * i + (lane >> 5)) * N + n0 + (lane & 31)];
#pragma unroll
    for (int i = 0; i < 32; ++i) { const int kk = 2 * i + (lane >> 5); scr[kk * 33 + (lane & 31)] = tv[i]; }
    LDS_WAIT();
    const int c = lane & 7;
#pragma unroll
    for (int j = 0; j < 4; ++j) { const int n = (lane >> 3) + 8 * j; const LAS float* s = scr + (8 * c) * 33 + n;
        u32x4 o; o.x = pk2(s[0 * 33], s[1 * 33]); o.y = pk2(s[2 * 33], s[3 * 33]); o.z = pk2(s[4 * 33], s[5 * 33]); o.w = pk2(s[6 * 33], s[7 * 33]);
        *(u32x4*)(WT + (size_t)(dst_row0 + n) * K + k0 + 8 * c) = o; }
    LDS_WAIT();
}
__device__ __forceinline__ void p0_prologue(const Frame& F) {
    LAS float* scr = (LAS float*)(F.lds + F.wave * 16384);
    const int gw = F.vcu * NWAVES + F.wave, NGW = F.G * NWAVES, lane = F.lane;
    constexpr int I_ADA = 768, I_A = 2 * 16 * 264, I_B = 2 * 16 * 32, I_C1 = 64 * 16 * 32, I_D = 64 * 8 * 32;
    constexpr int NITEMS = I_ADA + I_A + I_B + I_C1 + I_D;
    const float* const pC = kin<I_C>(); const float* const pWADA = kin<I_WADA>(); const float* const pWIN = kin<I_WIN>();
    const float* const pWOUT = kin<I_WOUT>(); const float* const pWE1 = kin<I_WE1>(); const float* const pWE2 = kin<I_WE2>(); const float* const pVMD = kin<I_VMD>();
    for (int it = gw; it < NITEMS; it += NGW) {
        int r = it;
        if (r < I_ADA) {
            const int l = r / 384, rr = r % 384, cch = rr >> 4, kc = rr & 15, col = cch * 256 + 4 * lane, k0 = kc * 64;
            float cv[8];
#pragma unroll
            for (int b = 0; b < 8; ++b) { const float x = pC[b * 1024 + k0 + lane]; cv[b] = x * sigmoidf_(x); }
            f32x4 acc[8];
#pragma unroll
            for (int b = 0; b < 8; ++b) acc[b] = (f32x4){0.f, 0.f, 0.f, 0.f};
            const float* wp = pWADA + ((size_t)l * 1024 + k0) * 6144 + col;
#pragma unroll 16
            for (int kk = 0; kk < 64; ++kk) { const f32x4 w = *(const f32x4*)(wp + (size_t)kk * 6144);
#pragma unroll
                for (int b = 0; b < 8; ++b) { const float s = __builtin_bit_cast(float, __builtin_amdgcn_readlane(__builtin_bit_cast(int, cv[b]), kk)); acc[b] += s * w; } }
#pragma unroll
            for (int b = 0; b < 8; ++b) *(f32x4*)((float*)(F.ws + WS_ADAP) + ((size_t)(kc * 2 + l) * 8 + b) * 6144 + col) = acc[b];
            continue;
        }
        r -= I_ADA;
        if (r < I_A) { const int l = r / (16 * 264), rr = r % (16 * 264), kb = rr / 264, nb = rr % 264;
            transpose_item(pWIN + (size_t)l * 1024 * N_IN, 1024, N_IN, (bf16*)(F.ws + WS_BT_IN) + (size_t)l * P_LD * 1024, 32 * nb, 64 * kb, 32 * nb, scr, lane); continue; }
        r -= I_A;
        if (r < I_B) { const int l = r / 512, rr = r % 512, kb = rr / 32, nb = rr % 32;
            transpose_item(pWOUT + (size_t)l * 1024 * 1024, 1024, 1024, (bf16*)(F.ws + WS_BT_OUT) + (size_t)l * 1024 * 1024, 32 * nb, 64 * kb, 32 * nb, scr, lane); continue; }
        r -= I_B;
        if (r < I_C1) { const int le = r / 512, rr = r % 512, kb = rr / 32, nb = rr % 32, n0 = 32 * nb;
            const int j0 = n0 & 511, dst = (j0 >> 7) * 256 + (n0 >= 512 ? 128 : 0) + (j0 & 127);
            transpose_item(pWE1 + (size_t)le * 1024 * 1024, 1024, 1024, (bf16*)(F.ws + WS_BT_E1) + (size_t)le * 1024 * 1024, dst, 64 * kb, n0, scr, lane); continue; }
        r -= I_C1;
        { const int le = r / 256, rr = r % 256, kb = rr / 32, nb = rr % 32;
            transpose_item(pWE2 + (size_t)le * 512 * 1024, 512, 1024, (bf16*)(F.ws + WS_BT_E2) + (size_t)le * 1024 * 512, 32 * nb, 64 * kb, 32 * nb, scr, lane); }
    }
    const int gt0 = F.vcu * NWAVES * 64 + F.tid, GT = F.G * NWAVES * 64;
    { const float* const pVMUp = kin<I_VMU>();
      for (int it = gt0; it < 1024 * 128; it += GT) { const int n = it >> 7, k0 = (it & 127) * 8; float o[8];
#pragma unroll
        for (int i = 0; i < 8; ++i) o[i] = 0.f;
        for (int j = 0; j < 32; ++j) { const float u = pVMUp[j * 1024 + n];
#pragma unroll
            for (int i = 0; i < 8; ++i) o[i] += pVMD[(k0 + i) * 32 + j] * u; }
        store8((bf16*)(F.ws + WS_BT_IN) + (size_t)P_LD * 1024 + (size_t)(C_VD + n) * 1024 + k0, o); } }
    { const float* const pDU = kin<I_DECUP>(); const float* const pAU = kin<I_AAAUP>(); const float* const pGU = kin<I_GATEUP>();
      for (int it = gt0; it < 2 * 3072 * 32; it += GT) { const int l = it / (3072 * 32), rr = it % (3072 * 32), n = rr >> 5, k0 = (rr & 31) * 8; float o[8];
#pragma unroll
        for (int i = 0; i < 8; ++i) { const int k = k0 + i; float v = 0.f;
            if (n < 1024) { if (k < 64) v = pDU[(size_t)(l * 64 + k) * 1024 + n]; }
            else if (n < 2048) { if (k >= 64 && k < 128) v = pAU[(size_t)(l * 64 + k - 64) * 1024 + n - 1024]; }
            else { if (k >= 128) v = pGU[(size_t)(l * 128 + k - 128) * 1024 + n - 2048]; }
            o[i] = v; }
        store8((bf16*)(F.ws + WS_BT_LR) + (size_t)l * 3072 * 256 + (size_t)n * 256 + k0, o); } }
    { const float* const pWRp = kin<I_WR>(); const int gt = F.vcu * NWAVES * 64 + F.tid; if (gt < 32768) { const float w = pWRp[(gt & 1023) * 32 + (gt >> 10)]; const unsigned hi = f2bf(w);
        ((bf16*)(F.ws + WS_WRT))[gt] = (bf16)hi; ((bf16*)(F.ws + WS_WRT))[32768 + gt] = (bf16)f2bf(w - bflo(hi)); } }
}

__device__ __forceinline__ void p0b_ada_reduce(const Frame& F) {
    const float* const pBADA = kin<I_BADA>(); const float* ap = (const float*)(F.ws + WS_ADAP); float* ada = (float*)(F.ws + WS_CTL + CTL_ADA);
    for (int idx = F.vcu * NWAVES * 64 + F.tid; idx < 2 * 8 * 6144; idx += F.G * NWAVES * 64) { const int l = idx / 49152, r = idx % 49152, c = r % 6144;
        float s = pBADA[l * 6144 + c];
#pragma unroll
        for (int kc = 0; kc < 16; ++kc) s += ap[(size_t)(kc * 2 + l) * 49152 + r];
        ada[idx] = s; }
}

template <int MODE> __device__ __forceinline__ void p1_norm(const Frame& F, int l) {
    const int lane = F.lane;
    const float* const pX = kin<I_X>(); float* const pOUT = (float*)kin<28>(); const float* const pFG = kin<I_FG>(); const float* const pN1G = kin<I_N1G>(); const float* const pWRb = kin<I_WR>();
#pragma unroll 1
    for (int gw = F.vcu * NWAVES + F.wave; gw < T / 8; gw += F.G * NWAVES) { const int tok0 = gw * 8, b = tok0 >> 11;
        f32x4 gm[4], sh[4], g2v[4];
#pragma unroll
        for (int j = 0; j < 4; ++j) { const int c = 4 * lane + 256 * j;
            if (MODE == 2) { gm[j] = *(const f32x4*)(pFG + c); sh[j] = (f32x4){0.f, 0.f, 0.f, 0.f}; }
            else { const float* ad = ada_ptr(F, l, b); const f32x4 g = *(const f32x4*)(pN1G + l * 1024 + c), sc = *(const f32x4*)(ad + 1024 + c); gm[j] = g * (1.0f + sc); sh[j] = *(const f32x4*)(ad + c); }
            if (MODE >= 1) g2v[j] = *(const f32x4*)(ada_ptr(F, MODE == 2 ? 1 : l - 1, b) + 5120 + c); }
        float* X = (float*)(F.ws + WS_X);
        const bf16* YE = (const bf16*)(F.ws + WS_YE);
        const float* WTS = (const float*)(F.ws + WS_WTS); const int* SLOT = (const int*)(F.ws + WS_SLOT);
        for (int tk = 0; tk < 8; ++tk) { const int tok = tok0 + tk;
            f32x4 v[4]; const float* xs = (MODE == 0 ? pX : X) + (size_t)tok * 1024;
#pragma unroll
            for (int j = 0; j < 4; ++j) v[j] = *(const f32x4*)(xs + 4 * lane + 256 * j);
            if (MODE >= 1) { const float w0 = WTS[tok * 2], w1 = WTS[tok * 2 + 1]; const int s0 = SLOT[tok * 2], s1 = SLOT[tok * 2 + 1];
#pragma unroll
                for (int j = 0; j < 4; ++j) { const u32x2 y0 = *(const u32x2*)(YE + (size_t)s0 * 1024 + 4 * lane + 256 * j), y1 = *(const u32x2*)(YE + (size_t)s1 * 1024 + 4 * lane + 256 * j);
                    f32x4 m; m[0] = w0 * bflo(y0.x) + w1 * bflo(y1.x); m[1] = w0 * bfhi(y0.x) + w1 * bfhi(y1.x); m[2] = w0 * bflo(y0.y) + w1 * bflo(y1.y); m[3] = w0 * bfhi(y0.y) + w1 * bfhi(y1.y);
                    v[j] += g2v[j] * m; if (MODE == 1) *(f32x4*)(X + (size_t)tok * 1024 + 4 * lane + 256 * j) = v[j]; } }
            float ss = 0.f;
#pragma unroll
            for (int j = 0; j < 4; ++j) ss += (v[j][0] * v[j][0] + v[j][1] * v[j][1]) + (v[j][2] * v[j][2] + v[j][3] * v[j][3]);
            float rstd = __builtin_amdgcn_rsqf(wave_sum(ss) * (1.0f / 1024.0f) + NORM_EPS);
#if defined(DBG_SCAN)
            if (MODE == 2) { const float* dz = (const float*)(F.ws + WS_CTL) + 2048; const float er = sqrtf(dz[0] / fmaxf(dz[1], 1e-30f)); rstd *= 1.0f + 0.3f * fminf(er, 3.0f); }
#endif
#pragma unroll
            for (int j = 0; j < 4; ++j) { const f32x4 h = v[j] * rstd * gm[j] + sh[j];
                if (MODE == 2) *(f32x4*)(pOUT + (size_t)tok * 1024 + 4 * lane + 256 * j) = h;
                else { u32x2 w; w.x = pk2(h[0], h[1]); w.y = pk2(h[2], h[3]); *(u32x2*)((bf16*)(F.ws + WS_H) + (size_t)tok * 1024 + 4 * lane + 256 * j) = w; } }
        }
    }
    if (MODE == 0 && F.vcu < 16) {
        const int lb = F.vcu, e = F.tid & 31, kq = F.tid >> 5; const float* sh2 = ada_ptr(F, lb >> 3, lb & 7) + 3072; float s = 0.f;
        for (int k = kq * 64; k < kq * 64 + 64; ++k) s += sh2[k] * pWRb[k * 32 + e];
        LAS float* red = (LAS float*)F.lds; red[kq * 32 + e] = s; __syncthreads();
        if (F.tid < 32) { float t = 0.f; for (int q = 0; q < 16; ++q) t += red[q * 32 + e]; ((float*)(F.ws + WS_CTL + CTL_BIASR))[lb * 32 + e] = t; }
        __syncthreads();
    }
}

typedef short bfv8 __attribute__((ext_vector_type(8)));
constexpr int LRX_PITCH = 528;
template <int NKS> struct LrW { bfv8 w[2][NKS]; f32x4 b0, b1; };
template <int NKS> __device__ __forceinline__ void lrx_load(LrW<NKS>& W, const bf16* BT, const float* bias, int a, int c0, int li, int fq) {
    const int kbase = (a == 0) ? 0 : ((a == 1) ? 64 : 128);
#pragma unroll
    for (int tile = 0; tile < 2; ++tile) { const bf16* rp = BT + (size_t)(a * 1024 + c0 + 8 * (li >> 2) + 4 * tile + (li & 3)) * 256 + kbase + 8 * fq;
#pragma unroll
        for (int ks = 0; ks < NKS; ++ks) W.w[tile][ks] = *(const bfv8*)(rp + 32 * ks); }
    if (a < 2) { W.b0 = *(const f32x4*)(bias + c0 + 8 * fq); W.b1 = *(const f32x4*)(bias + c0 + 8 * fq + 4); }
}
template <int NKS> __device__ __forceinline__ void lrx_job(const LrW<NKS>& W, const LAS unsigned char* tile, bf16* out, int a, int li, int fq) {
    const int kbase = (a == 0) ? 0 : ((a == 1) ? 64 : 128);
#pragma unroll 2
    for (int mt = 0; mt < 4; ++mt) {
        bfv8 af[NKS];
#pragma unroll
        for (int ks = 0; ks < NKS; ++ks) af[ks] = *(const LAS bfv8*)(tile + (16 * mt + li) * LRX_PITCH + (kbase + 32 * ks + 8 * fq) * 2);
        f32x4 acc0 = (f32x4){0.f, 0.f, 0.f, 0.f}, acc1 = acc0;
#pragma unroll
        for (int ks = 0; ks < NKS; ++ks) { acc0 = __builtin_amdgcn_mfma_f32_16x16x32_bf16(W.w[0][ks], af[ks], acc0, 0, 0, 0); acc1 = __builtin_amdgcn_mfma_f32_16x16x32_bf16(W.w[1][ks], af[ks], acc1, 0, 0, 0); }
        u32x4 o;
        if (a == 0) { float x[8];
#pragma unroll
            for (int j = 0; j < 4; ++j) { x[j] = -0.60653066f * sigmoidf_(W.b0[j] + acc0[j]); x[4 + j] = -0.60653066f * sigmoidf_(W.b1[j] + acc1[j]); }
            o.x = pkh2(x[0], x[1]); o.y = pkh2(x[2], x[3]); o.z = pkh2(x[4], x[5]); o.w = pkh2(x[6], x[7]);
        } else if (a == 1) { float x[8];
#pragma unroll
            for (int j = 0; j < 4; ++j) { x[j] = sigmoidf_(W.b0[j] + acc0[j]); x[4 + j] = sigmoidf_(W.b1[j] + acc1[j]); }
            o.x = pkh2(x[0], x[1]); o.y = pkh2(x[2], x[3]); o.z = pkh2(x[4], x[5]); o.w = pkh2(x[6], x[7]);
        } else { o.x = pkbf(acc0[0], acc0[1]); o.y = pkbf(acc0[2], acc0[3]); o.z = pkbf(acc1[0], acc1[1]); o.w = pkbf(acc1[2], acc1[3]); }
        *(u32x4*)(out + (size_t)(16 * mt) * 3072) = o;
    }
}
__device__ __forceinline__ void p2x_lowrank(const Frame& F, int l) {
    const int lane = F.lane, c8 = lane & 31, hf = lane >> 5, li = lane & 15, fq = lane >> 4;
    const bf16* P = (const bf16*)(F.ws + WS_P); const float* mu = kin<I_MU>() + l * N_SHIFT + 3072 + 8 * c8;
    const f32x4 m0 = *(const f32x4*)mu, m1 = *(const f32x4*)(mu + 4);
    const float* const pKKc = kin<I_KK>() + l * 1024; const float* const muK = kin<I_MU>() + l * N_SHIFT + 1024; float* KNo = (float*)(F.ws + WS_KN);
    const bf16* BT = (const bf16*)(F.ws + WS_BT_LR) + (size_t)l * 3072 * 256; const float* const pW0 = kin<I_W0>() + l * 1024; const float* const pA0 = kin<I_A0>() + l * 1024;
    LAS unsigned char* tile = F.lds;
#pragma unroll 1
    for (int item = F.vcu; item < T / 64; item += F.G) { const int gw = item * 8 + F.wave;
        LrW<2> W2[2]; LrW<4> W4[2];
        lrx_load<2>(W2[0], BT, pW0, 0, F.wave * 128, li, fq);
#pragma unroll
        for (int i = 0; i < 4; ++i) { const int row = 8 * F.wave + 2 * i + hf, tok = item * 64 + row; float cur[8], prv[8], o[8];
            load8(P + (size_t)tok * P_LD + C_WD + 8 * c8, cur);
            if ((tok & (SEQ - 1)) != 0) load8(P + (size_t)(tok - 1) * P_LD + C_WD + 8 * c8, prv); else {
#pragma unroll
                for (int j = 0; j < 8; ++j) prv[j] = 0.f; }
#pragma unroll
            for (int j = 0; j < 8; ++j) { const float v = cur[j] + (prv[j] - cur[j]) * (j < 4 ? m0[j] : m1[j - 4]); o[j] = (c8 < 8) ? tanhf_(v) : ((c8 < 16) ? v : sigmoidf_(v)); }
            u32x4 w; w.x = pkbf(o[0], o[1]); w.y = pkbf(o[2], o[3]); w.z = pkbf(o[4], o[5]); w.w = pkbf(o[6], o[7]);
            *(LAS u32x4*)(tile + row * LRX_PITCH + 16 * c8) = w; }
#pragma unroll 1
        for (int ch = 0; ch < 2; ++ch) { const int col0 = 512 * ch + 8 * lane; float kkc[8], muk[8], kp_[8];
#pragma unroll
            for (int j = 0; j < 8; ++j) { kkc[j] = pKKc[col0 + j]; muk[j] = muK[col0 + j]; kp_[j] = 0.f; }
            const int tok0 = gw * 8;
            if ((tok0 & (SEQ - 1)) != 0) load8(P + (size_t)(tok0 - 1) * P_LD + C_K + col0, kp_);
#pragma unroll 4
            for (int tk = 0; tk < 8; ++tk) { float kc[8]; load8(P + (size_t)(tok0 + tk) * P_LD + C_K + col0, kc); float ss = 0.f;
#pragma unroll
                for (int j = 0; j < 8; ++j) { const float k = (kc[j] + (kp_[j] - kc[j]) * muk[j]) * kkc[j]; ss += k * k; kp_[j] = kc[j]; }
                ss = sum8(ss);
                if ((lane & 7) == 0) KNo[(tok0 + tk) * 16 + 8 * ch + (lane >> 3)] = __builtin_amdgcn_rsqf(fmaxf(ss, 1e-24f)); } }
        __syncthreads();
        bf16* outb = (bf16*)(F.ws + WS_LR) + (size_t)(item * 64 + li) * 3072 + F.wave * 128 + 8 * fq;
#pragma unroll
        for (int j = 0; j < 8; ++j) { const int a = j >> 2, g = j & 3;
            if (j + 1 < 8) lrx_load<2>(W2[(j + 1) & 1], BT, ((j + 1) >> 2) ? pA0 : pW0, (j + 1) >> 2, F.wave * 128 + 32 * ((j + 1) & 3), li, fq); else lrx_load<4>(W4[0], BT, pW0, 2, F.wave * 128, li, fq);
            lrx_job<2>(W2[j & 1], tile, outb + a * 1024 + 32 * g, a, li, fq); }
#pragma unroll
        for (int g = 0; g < 4; ++g) {
            if (g + 1 < 4) lrx_load<4>(W4[(g + 1) & 1], BT, pW0, 2, F.wave * 128 + 32 * (g + 1), li, fq);
            lrx_job<4>(W4[g & 1], tile, outb + 2048 + 32 * g, 2, li, fq); }
        __syncthreads();
    }
}

__device__ __forceinline__ void p3_prep(const Frame& F, int l) {
    const int lane = F.lane;
    const bf16* P = (const bf16*)(F.ws + WS_P); const bf16* LR = (const bf16*)(F.ws + WS_LR);
    const float* mu = kin<I_MU>() + l * N_SHIFT;
    const float* const pA0 = kin<I_A0>() + l * 1024; const float* const pKKc = kin<I_KK>() + l * 1024; const float* const pKA = kin<I_KA>() + l * 1024; const float* const pRK = kin<I_RK>() + l * 1024; const float* const pW0 = kin<I_W0>() + l * 1024; const float* const pV0c = kin<I_V0>();
    bf16* KKo = (bf16*)(F.ws + WS_KK); bf16* BQo = (bf16*)(F.ws + WS_BQ); bf16* KPo = (bf16*)(F.ws + WS_KP); bf16* Ro = (bf16*)(F.ws + WS_R);
    bf16* V0 = (bf16*)(F.ws + WS_V0); bf16* V1 = (bf16*)(F.ws + WS_V1); float* Wo = (float*)(F.ws + WS_W); float* BON = (float*)(F.ws + WS_BONUS);
#pragma unroll 1
    for (int gw = F.vcu * NWAVES + F.wave; gw < T / 8; gw += F.G * NWAVES) { const int tok0 = gw * 8;
#pragma unroll 1
    for (int ch = 0; ch < 2; ++ch) { const int col0 = 512 * ch + 8 * lane, head = 8 * ch + (lane >> 3);
        float a0v[8], kkc[8], kac[8], rkc[8], w0v[8], v0v[8], mur[8], muk[8], muv[8], rp[8], kp_[8], vp[8];
#pragma unroll
        for (int j = 0; j < 8; ++j) { a0v[j] = pA0[col0 + j]; kkc[j] = pKKc[col0 + j]; kac[j] = pKA[col0 + j]; rkc[j] = pRK[col0 + j]; w0v[j] = pW0[col0 + j]; v0v[j] = (l == 1) ? pV0c[col0 + j] : 0.f;
            mur[j] = mu[col0 + j]; muk[j] = mu[1024 + col0 + j]; muv[j] = mu[2048 + col0 + j]; rp[j] = 0.f; kp_[j] = 0.f; vp[j] = 0.f; }
        if ((tok0 & (SEQ - 1)) != 0) { const bf16* pr = P + (size_t)(tok0 - 1) * P_LD + col0; load8(pr + C_R, rp); load8(pr + C_K, kp_); load8(pr + C_V, vp); }
#pragma unroll 2
        for (int tk = 0; tk < 8; ++tk) { const int tok = tok0 + tk; const bf16* pr = P + (size_t)tok * P_LD + col0;
            float rc[8], kc[8], vc[8], dw[8], ap[8], r[8], k[8], v[8], kk[8], kp[8], bq[8], w[8];
            load8(pr + C_R, rc); load8(pr + C_K, kc); load8(pr + C_V, vc); load8(LR + (size_t)tok * 3072 + col0, dw); load8(LR + (size_t)tok * 3072 + 1024 + col0, ap);
            float ss = 0.f, bo = 0.f;
#pragma unroll
            for (int j = 0; j < 8; ++j) { r[j] = rc[j] + (rp[j] - rc[j]) * mur[j]; k[j] = kc[j] + (kp_[j] - kc[j]) * muk[j]; v[j] = vc[j] + (vp[j] - vc[j]) * muv[j]; rp[j] = rc[j]; kp_[j] = kc[j]; vp[j] = vc[j];
                const float av = sigmoidf_(a0v[j] + ap[j]); kk[j] = k[j] * kkc[j]; ss += kk[j] * kk[j]; kp[j] = k[j] * (1.0f + (av - 1.0f) * kac[j]); bo += r[j] * kp[j] * rkc[j]; bq[j] = av;
                const float nd = -(w0v[j] + dw[j]); const float sp = fmaxf(nd, 0.f) + __logf(1.0f + __expf(-fabsf(nd))); w[j] = -__expf(-sp - 0.5f); }
            ss = sum8(ss); bo = sum8(bo);
            const float inv = __builtin_amdgcn_rsqf(fmaxf(ss, 1e-24f));
#pragma unroll
            for (int j = 0; j < 8; ++j) { kk[j] *= inv; bq[j] *= kk[j]; }
            store8h(KKo + (size_t)tok * 1024 + col0, kk); store8h(BQo + (size_t)tok * 1024 + col0, bq); store8h(KPo + (size_t)tok * 1024 + col0, kp); store8h(Ro + (size_t)tok * 1024 + col0, r);
            if ((lane & 7) == 0) BON[tok * 16 + head] = bo;
            float* wp = Wo + (size_t)tok * 1024 + col0; *(f32x4*)wp = (f32x4){w[0], w[1], w[2], w[3]}; *(f32x4*)(wp + 4) = (f32x4){w[4], w[5], w[6], w[7]};
            if (l == 1) { float vf[8], vm[8]; load8h(V0 + (size_t)tok * 1024 + col0, vf); load8(pr + C_VD, vm);
#pragma unroll
                for (int j = 0; j < 8; ++j) v[j] = v[j] + (vf[j] - v[j]) * sigmoidf_(v0v[j] + vm[j]);
                store8h(V1 + (size_t)tok * 1024 + col0, v); }
            else store8h(V0 + (size_t)tok * 1024 + col0, v); }
    }
    }
}

__device__ __forceinline__ f32x4 h4_to_f4(const u32x2 u) { return (f32x4){hlo(u.x), hhi(u.x), hlo(u.y), hhi(u.y)}; }
#if defined(DBG_SCAN)
constexpr size_t WS_YCK = WS_H;
constexpr int SC_CH = 32, SC_BUF = 49152, SC_W = 0, SC_KK = 8192, SC_BQ = 16384, SC_KP = 24576, SC_R = 32768, SC_V = 40960, SC_Y = 45056;
struct ScanRegsSeq { f32x4 w; u32x2 kk, bq, kp, r, v; };
__device__ __forceinline__ void scan_issue(const Frame& F, int l, int b, int h, int half, int cc, ScanRegsSeq& R) {
    const int s = F.tid >> 4, q = F.tid & 15; const size_t base = ((size_t)b * SEQ + cc * SC_CH + s) * 1024 + h * 64 + 4 * q;
    R.w = *(const f32x4*)((const float*)(F.ws + WS_W) + base);
    R.kk = *(const u32x2*)((const bf16*)(F.ws + WS_KK) + base); R.bq = *(const u32x2*)((const bf16*)(F.ws + WS_BQ) + base);
    R.kp = *(const u32x2*)((const bf16*)(F.ws + WS_KP) + base); R.r = *(const u32x2*)((const bf16*)(F.ws + WS_R) + base);
    if (F.tid < 256) { const int s2 = F.tid >> 3, r4 = F.tid & 7; R.v = *(const u32x2*)((const bf16*)(F.ws + (l == 0 ? WS_V0 : WS_V1)) + ((size_t)b * SEQ + cc * SC_CH + s2) * 1024 + h * 64 + half * 32 + 4 * r4); }
}
__device__ __forceinline__ void scan_commit(const Frame& F, int buf, const ScanRegsSeq& R) {
    const int s = F.tid >> 4, q = F.tid & 15; LAS unsigned char* B = F.lds + buf * SC_BUF + (s * 16 + q) * 16;
    *(LAS f32x4*)(B + SC_W) = (f32x4){__expf(R.w[0]), __expf(R.w[1]), __expf(R.w[2]), __expf(R.w[3])};     *(LAS f32x4*)(B + SC_KK) = h4_to_f4(R.kk); *(LAS f32x4*)(B + SC_BQ) = h4_to_f4(R.bq); *(LAS f32x4*)(B + SC_KP) = h4_to_f4(R.kp); *(LAS f32x4*)(B + SC_R) = h4_to_f4(R.r);
    if (F.tid < 256) { const int s2 = F.tid >> 3, r4 = F.tid & 7; *(LAS f32x4*)(F.lds + buf * SC_BUF + SC_V + (s2 * 32 + 4 * r4) * 4) = h4_to_f4(R.v); }
}
__device__ __forceinline__ void scan_store(const Frame& F, int b, int h, int half, int cc, int buf) {
    if (F.tid < 256) { const int s2 = F.tid >> 3, r4 = F.tid & 7;
        const f32x4 y = *(const LAS f32x4*)(F.lds + buf * SC_BUF + SC_Y + (s2 * 32 + 4 * r4) * 4);
        u32x2 w; w.x = pk2(y[0], y[1]); w.y = pk2(y[2], y[3]);
        const int t = cc * SC_CH + s2 - 1;
        if (t >= 0) *(u32x2*)((bf16*)(F.ws + WS_Y) + ((size_t)b * SEQ + t) * 1024 + h * 64 + half * 32 + 4 * r4) = w; }
}
__device__ __forceinline__ void p4_scan_seq(const Frame& F, int l) {
#pragma unroll 1
    for (int unit = F.vcu; unit < NBATCH * NHEAD * 2; unit += F.G) {
        const int b = unit >> 5, h = (unit >> 1) & 15, half = unit & 1;
        const int g = F.lane >> 4, q = F.lane & 15, row = F.wave * 4 + g;
        f32x2 sA = (f32x2){0.f, 0.f}, sB = sA; float yp = 0.f; const bool odd = (q & 1) != 0;
        ScanRegsSeq SR;
        bf16* SAdbg = (bf16*)(F.ws + WS_V1) + (size_t)b * SEQ * 1024 + h * 64 + half * 32 + row;
        scan_issue(F, l, b, h, half, 0, SR); scan_commit(F, 0, SR); scan_issue(F, l, b, h, half, 1, SR);
        __syncthreads();
        constexpr int NCH = SEQ / SC_CH;
#pragma unroll 1
        for (int cc = 0; cc < NCH; ++cc) { const int buf = cc & 1;
            { const LAS unsigned char* B = F.lds + buf * SC_BUF;
              const LAS f32x4* pc = (const LAS f32x4*)B + q;
              const LAS float* pv = (const LAS float*)(B + SC_V) + row; LAS float* py = (LAS float*)(B + SC_Y) + row;
              f32x4 aw[2], ak[2], ab[2], ap[2], ar[2], bw[2], bk[2], bb[2], bp[2], br_[2]; float av[2], bv[2];
#define SC_LOAD(dw, dk, db, dp, dr, dv, s) do { dw = pc[(s) * 16]; dk = pc[(s) * 16 + 512]; db = pc[(s) * 16 + 1024]; dp = pc[(s) * 16 + 1536]; dr = pc[(s) * 16 + 2048]; dv = pv[(s) * 32]; } while (0)
#define SC_STEP(cw, ck, cb, cp, cr, cv, yo, sidx) do { \
        f32x2 t = sA * ck.lo; t = sB * ck.hi + t; \
        const float pa = t.x + t.y; \
        float x = odd ? yp : pa; const float z = odd ? pa : yp; \
        x += dpp_f<0xB1>(z); x += dpp_f<0x4E>(x); x += dpp_f<0x124>(x); x += dpp_f<0x128>(x); \
        const float sa = dpp_f<0xA0>(x); \
        if (l == 0 && q == 0) SAdbg[(size_t)(cc * SC_CH + (sidx)) * 1024] = (bf16)f2bf(sa); \
        f32x2 xA = cv * cp.lo, xB = cv * cp.hi; \
        xA = xA - sa * cb.lo; xB = xB - sa * cb.hi; \
        sA = sA * cw.lo + xA; sB = sB * cw.hi + xB; \
        f32x2 yv = sA * cr.lo; yv = sB * cr.hi + yv; \
        yo = x; yp = yv.x + yv.y; } while (0)
#pragma unroll
              for (int i = 0; i < 2; ++i) SC_LOAD(aw[i], ak[i], ab[i], ap[i], ar[i], av[i], i);
#pragma unroll 1
              for (int s4 = 0; s4 < SC_CH; s4 += 4) {
#pragma unroll
                  for (int i = 0; i < 2; ++i) SC_LOAD(bw[i], bk[i], bb[i], bp[i], br_[i], bv[i], s4 + 2 + i);
                  float yo[2];
#pragma unroll
                  for (int i = 0; i < 2; ++i) SC_STEP(aw[i], ak[i], ab[i], ap[i], ar[i], av[i], yo[i], s4 + i);
                  if (q == 1) { py[(s4 + 0) * 32] = yo[0]; py[(s4 + 1) * 32] = yo[1]; }
                  const int sn = (s4 + 4 < SC_CH) ? s4 + 4 : s4;
#pragma unroll
                  for (int i = 0; i < 2; ++i) SC_LOAD(aw[i], ak[i], ab[i], ap[i], ar[i], av[i], sn + i);
#pragma unroll
                  for (int i = 0; i < 2; ++i) SC_STEP(bw[i], bk[i], bb[i], bp[i], br_[i], bv[i], yo[i], s4 + 2 + i);
                  if (q == 1) { py[(s4 + 2) * 32] = yo[0]; py[(s4 + 3) * 32] = yo[1]; }
              }
#undef SC_STEP
#undef SC_LOAD
            }
            if (cc + 1 < NCH) scan_commit(F, buf ^ 1, SR);
            if (cc + 2 < NCH) scan_issue(F, l, b, h, half, cc + 2, SR);
            asm volatile("s_waitcnt lgkmcnt(0)" ::: "memory"); __builtin_amdgcn_s_barrier(); asm volatile("" ::: "memory");
            scan_store(F, b, h, half, cc, buf);
        }
        { const float yl = dpp_sum16(yp);
          if (q == 0) ((bf16*)(F.ws + WS_Y))[((size_t)b * SEQ + SEQ - 1) * 1024 + h * 64 + half * 32 + row] = (bf16)f2bf(yl); }
        __syncthreads();
    }
}

#else
constexpr size_t WS_YCK = WS_Y;
#endif
typedef short bf16x8 __attribute__((ext_vector_type(8)));
typedef float f32x16 __attribute__((ext_vector_type(16)));
constexpr int CK_XK = 0, CK_XR = 4608, CK_BH = 9216, CK_KH = 14336, CK_GB = 19456, CK_VT = 19712, CK_X3SZ = 22272;
constexpr int CK_XB = 0, CK_XP = 4608, CK_P2SZ = 9216;
constexpr int CK_TK = 0, CK_TBR = 2560, CK_TKR = 5120, CK_TB = 7680, CK_TBT = 11776, CK_MT = 15872, CK_T2SZ = 18432;
constexpr int CK_X3_OFF = 0, CK_P2_OFF = 3 * CK_X3SZ, CK_T2_OFF = CK_P2_OFF + 2 * CK_P2SZ, CK_STASH = CK_T2_OFF + 2 * CK_T2SZ;
static_assert(CK_STASH + 8192 <= RING_BYTES, "chunked-scan LDS map");
#define CK_MFMA(a, b, c) __builtin_amdgcn_mfma_f32_32x32x16_bf16((a), (b), (c), 0, 0, 0)
__device__ __forceinline__ bf16x8 ck_frag(const LAS unsigned char* base, int pitch, int row, int kel) { return *(const LAS bf16x8*)(base + row * pitch + kel * 2); }
struct CkRegs { u32x2 rP, rA, rB, kP, kA, kB, vP, vA, vB, dwA, dwB, apA, apB, vmA, vmB, vfA, vfB; float knA, knB; };
struct CkConst { f32x4 a0, kk, ka, rk, w0, v0, mur, muk, muv; };
__device__ __forceinline__ f32x4 b4_to_f4(const u32x2 u) { return (f32x4){bflo(u.x), bfhi(u.x), bflo(u.y), bfhi(u.y)}; }
__device__ __forceinline__ void ck_issue(const Frame& F, int pw, int l, int b, int h, int half, int blk, CkRegs& R) {
    const int s2 = F.lane >> 2, cq = F.lane & 3, col = h * 64 + 16 * pw + 4 * cq; const size_t tA = (size_t)b * SEQ + blk * 32 + 2 * s2;
    const bf16* P = (const bf16*)(F.ws + WS_P) + tA * P_LD + col; const bf16* LR = (const bf16*)(F.ws + WS_LR) + tA * 3072 + col; const float* KN = (const float*)(F.ws + WS_KN) + tA * 16 + h;
    R.rA = *(const u32x2*)(P + C_R); R.rB = *(const u32x2*)(P + P_LD + C_R); R.kA = *(const u32x2*)(P + C_K); R.kB = *(const u32x2*)(P + P_LD + C_K); R.vA = *(const u32x2*)(P + C_V); R.vB = *(const u32x2*)(P + P_LD + C_V);
    if ((tA & (SEQ - 1)) != 0) { R.rP = *(const u32x2*)(P - P_LD + C_R); R.kP = *(const u32x2*)(P - P_LD + C_K); R.vP = *(const u32x2*)(P - P_LD + C_V); } else { R.rP = (u32x2){0u, 0u}; R.kP = R.rP; R.vP = R.rP; }
    R.dwA = *(const u32x2*)LR; R.dwB = *(const u32x2*)(LR + 3072); R.apA = *(const u32x2*)(LR + 1024); R.apB = *(const u32x2*)(LR + 3072 + 1024);
    R.knA = KN[0]; R.knB = KN[16];
    if (l == 1) { R.vmA = *(const u32x2*)(P + C_VD); R.vmB = *(const u32x2*)(P + P_LD + C_VD); const bf16* V0 = (const bf16*)(F.ws + WS_V0) + tA * 1024 + col; R.vfA = *(const u32x2*)V0; R.vfB = *(const u32x2*)(V0 + 1024); }
    (void)half;
}
__device__ __forceinline__ void ck_elem(const CkConst& C, int l, const f32x4 rc, const f32x4 rp, const f32x4 kc, const f32x4 kp_, const f32x4 vc, const f32x4 vp, const f32x4 dw, const f32x4 ap, const float kn,
                                        const f32x4 vm, const f32x4 vf, f32x4& r, f32x4& kk, f32x4& bq, f32x4& kp, f32x4& lw, f32x4& v, float& bo) {
#pragma unroll
    for (int e = 0; e < 4; ++e) {
        r[e] = rc[e] + (rp[e] - rc[e]) * C.mur[e]; const float k = kc[e] + (kp_[e] - kc[e]) * C.muk[e]; float vv = vc[e] + (vp[e] - vc[e]) * C.muv[e];
        const float av = ap[e]; kk[e] = k * C.kk[e] * kn;     bq[e] = kk[e] * av; kp[e] = k * (1.0f + (av - 1.0f) * C.ka[e]); bo += r[e] * kp[e] * C.rk[e];
        lw[e] = dw[e];
        if (l == 1) vv = vv + (vf[e] - vv) * sigmoidf_(C.v0[e] + vm[e]);
        v[e] = vv; }
}
__device__ __forceinline__ void ck_stage1(const Frame& F, int pw, int l, int b, int h, int half, int blk, const CkConst& C, LAS unsigned char* BX, LAS unsigned char* BP, const CkRegs& R) {
    const int lane = F.lane, s2 = lane >> 2, cq = lane & 3, c0 = 16 * pw + 4 * cq, cp = 16 * pw + 4 * (((cq & 1) << 1) | (cq >> 1));
    f32x4 kkA, kkB, bqA, bqB, kpA, kpB, rA, rB, lwA, lwB, vA, vB; float boA = 0.f, boB = 0.f;
    { const f32x4 rcA = b4_to_f4(R.rA), kcA = b4_to_f4(R.kA), vcA = b4_to_f4(R.vA), zz = (f32x4){0.f, 0.f, 0.f, 0.f};
      ck_elem(C, l, rcA, b4_to_f4(R.rP), kcA, b4_to_f4(R.kP), vcA, b4_to_f4(R.vP), h4_to_f4(R.dwA), h4_to_f4(R.apA), R.knA, l == 1 ? b4_to_f4(R.vmA) : zz, l == 1 ? h4_to_f4(R.vfA) : zz, rA, kkA, bqA, kpA, lwA, vA, boA);
      ck_elem(C, l, b4_to_f4(R.rB), rcA, b4_to_f4(R.kB), kcA, b4_to_f4(R.vB), vcA, h4_to_f4(R.dwB), h4_to_f4(R.apB), R.knB, l == 1 ? b4_to_f4(R.vmB) : zz, l == 1 ? h4_to_f4(R.vfB) : zz, rB, kkB, bqB, kpB, lwB, vB, boB); }
    { const size_t tA = (size_t)b * SEQ + blk * 32 + 2 * s2;
      boA += __shfl_xor(boA, 1); boA += __shfl_xor(boA, 2); boB += __shfl_xor(boB, 1); boB += __shfl_xor(boB, 2);
      if ((pw >> 1) == half) { if (cq == 0) { float* bp = (float*)(F.ws + WS_BONP) + (tA * 16 + h) * 4 + pw; bp[0] = boA; bp[64] = boB; }
          bf16* Vo = (bf16*)(F.ws + (l == 0 ? WS_V0 : WS_V1)) + tA * 1024 + h * 64 + c0;
          *(u32x2*)Vo = (u32x2){pkh2(vA[0], vA[1]), pkh2(vA[2], vA[3])}; *(u32x2*)(Vo + 1024) = (u32x2){pkh2(vB[0], vB[1]), pkh2(vB[2], vB[3])};
#pragma unroll
          for (int e = 0; e < 4; ++e) *(LAS unsigned*)(BX + CK_VT + (16 * (pw & 1) + 4 * cq + e) * 80 + (2 * s2) * 2) = pkbf(vA[e], vB[e]); } }
    float xkA[4], xkB[4], xrA[4], xrB[4], xbA[4], xbB[4], xpA[4], xpB[4], bhA[4], bhB[4], khA[4], khB[4], gb[4];
#pragma unroll
    for (int e = 0; e < 4; ++e) {
        float x = lwA[e] + lwB[e];
#pragma unroll
        for (int d = 4; d < 64; d <<= 1) { const float y = __shfl_up(x, d); if (lane >= d) x += y; }
        const float LB = x, LA = x - lwB[e], L0 = LA - lwA[e], Lt = __shfl(x, 60 + cq);
        const float eL0 = __expf(L0), eLA = __expf(LA), eLB = __expf(LB), iLA = __expf(-LA), iLB = __expf(-LB), tA = __expf(Lt - LA), tB = __expf(Lt - LB);
        xkA[e] = kkA[e] * eL0; xkB[e] = kkB[e] * eLA; xrA[e] = rA[e] * eLA; xrB[e] = rB[e] * eLB;
        xbA[e] = bqA[e] * iLA; xbB[e] = bqB[e] * iLB; xpA[e] = kpA[e] * iLA; xpB[e] = kpB[e] * iLB;
        bhA[e] = bqA[e] * tA; bhB[e] = bqB[e] * tB; khA[e] = kpA[e] * tA; khB[e] = kpB[e] * tB; gb[e] = __expf(Lt);
    }
    const int oA = (2 * s2) * 144 + cp * 2, oB = oA + 144;
    *(LAS u32x2*)(BX + CK_XK + oA) = (u32x2){pkbf(xkA[0], xkA[1]), pkbf(xkA[2], xkA[3])}; *(LAS u32x2*)(BX + CK_XK + oB) = (u32x2){pkbf(xkB[0], xkB[1]), pkbf(xkB[2], xkB[3])};
    *(LAS u32x2*)(BX + CK_XR + oA) = (u32x2){pkbf(xrA[0], xrA[1]), pkbf(xrA[2], xrA[3])}; *(LAS u32x2*)(BX + CK_XR + oB) = (u32x2){pkbf(xrB[0], xrB[1]), pkbf(xrB[2], xrB[3])};
    *(LAS u32x2*)(BP + CK_XB + oA) = (u32x2){pkbf(xbA[0], xbA[1]), pkbf(xbA[2], xbA[3])}; *(LAS u32x2*)(BP + CK_XB + oB) = (u32x2){pkbf(xbB[0], xbB[1]), pkbf(xbB[2], xbB[3])};
    *(LAS u32x2*)(BP + CK_XP + oA) = (u32x2){pkbf(xpA[0], xpA[1]), pkbf(xpA[2], xpA[3])}; *(LAS u32x2*)(BP + CK_XP + oB) = (u32x2){pkbf(xpB[0], xpB[1]), pkbf(xpB[2], xpB[3])};
    const int i0 = 2 * s2, pst = (i0 & 16) | ((i0 & 4) << 1) | ((i0 & 8) >> 1) | (i0 & 3);
#pragma unroll
    for (int e = 0; e < 4; ++e) { *(LAS unsigned*)(BX + CK_BH + (c0 + e) * 80 + pst * 2) = pkbf(bhA[e], bhB[e]); *(LAS unsigned*)(BX + CK_KH + (c0 + e) * 80 + (2 * s2) * 2) = pkbf(khA[e], khB[e]); }
    if (s2 == 0) *(LAS f32x4*)(BX + CK_GB + c0 * 4) = (f32x4){gb[0], gb[1], gb[2], gb[3]};

}
__device__ __forceinline__ void ck_stage2(const Frame& F, int ti, const LAS unsigned char* BX, const LAS unsigned char* BP, LAS unsigned char* BT) {
    const int r = F.lane & 31, hh = F.lane >> 5;
    const LAS unsigned char* Aa = BP + ((ti < 2) ? CK_XB : CK_XP); const LAS unsigned char* Ba = BX + ((ti & 1) ? CK_XR : CK_XK);
    f32x16 acc;
#pragma unroll
    for (int i = 0; i < 16; ++i) acc[i] = 0.f;
#pragma unroll
    for (int ks = 0; ks < 4; ++ks) acc = CK_MFMA(ck_frag(Aa, 144, r, 16 * ks + 8 * hh), ck_frag(Ba, 144, r, 16 * ks + 8 * hh), acc);
    if (ti == 0) {
#pragma unroll
        for (int reg = 0; reg < 16; ++reg) { const int i = (reg & 3) + 8 * (reg >> 2) + 4 * hh; *(LAS float*)(BT + CK_TB + (i * 32 + r) * 4) = (i < r) ? acc[reg] : 0.f; }
#pragma unroll
        for (int m = 0; m < 4; ++m) { f32x4 t;
#pragma unroll
            for (int e = 0; e < 4; ++e) t[e] = (8 * m + 4 * hh + e < r) ? acc[4 * m + e] : 0.f;
            *(LAS f32x4*)(BT + CK_TBT + (r * 32 + 8 * m + 4 * hh) * 4) = t; }
    } else { const int off = (ti == 1) ? CK_TBR : ((ti == 2) ? CK_TK : CK_TKR);
#pragma unroll
        for (int m = 0; m < 4; ++m) { float t[4];
#pragma unroll
            for (int e = 0; e < 4; ++e) { const int i = 8 * m + 4 * hh + e; const bool keep = (ti == 2) ? (i < r) : (i <= r); t[e] = keep ? acc[4 * m + e] : 0.f; }
            const int col = (ti == 1) ? (16 * (m >> 1) + 8 * hh + 4 * (m & 1)) : (8 * m + 4 * hh);
            *(LAS u32x2*)(BT + off + r * 80 + col * 2) = (u32x2){pkbf(t[0], t[1]), pkbf(t[2], t[3])}; }
    }
    if (ti == 0) {
        LDS_WAIT();
        const LAS float* TBT = (const LAS float*)(BT + CK_TBT);
        float x[32];
        int rr = r; asm volatile("" : "+v"(rr));
#pragma unroll
        for (int k = 0; k < 32; ++k) x[k] = (k == rr) ? 1.f : 0.f;
        { f32x4 tc[8], tn[8];
#pragma unroll
          for (int j4 = 0; j4 < 8; ++j4) tc[j4] = *(const LAS f32x4*)(TBT + 31 * 32 + 4 * j4);
#pragma unroll
          for (int kk = 0; kk < 31; ++kk) { const int k = 31 - kk; const float xk = x[k];
              int off = (k - 1) * 32; asm volatile("" : "+v"(off) : "v"(xk));
              if (k - 1 >= 1) {
#pragma unroll
                  for (int j4 = 0; j4 <= (k - 2) / 4; ++j4) tn[j4] = *(const LAS f32x4*)(TBT + off + 4 * j4); }
#pragma unroll
              for (int j4 = 0; j4 <= (k - 1) / 4; ++j4) {
#pragma unroll
                  for (int e = 0; e < 4; ++e) { const int i = 4 * j4 + e; if (i < k) x[i] = __builtin_fmaf(-tc[j4][e], xk, x[i]); } }
#pragma unroll
              for (int j4 = 0; j4 < 8; ++j4) tc[j4] = tn[j4]; } }
        if (hh == 0) {
#pragma unroll
            for (int q = 0; q < 4; ++q) { u32x4 w;
#pragma unroll
                for (int p = 0; p < 4; ++p) { const int e0 = 2 * p, e1 = 2 * p + 1; w[p] = pkbf(x[16 * (q >> 1) + 8 * (e0 >> 2) + 4 * (q & 1) + (e0 & 3)], x[16 * (q >> 1) + 8 * (e1 >> 2) + 4 * (q & 1) + (e1 & 3)]); }
                *(LAS u32x4*)(BT + CK_MT + r * 80 + q * 16) = w; } }
    }
}
#define CK_BAR() do { asm volatile("s_waitcnt lgkmcnt(0)" ::: "memory"); __builtin_amdgcn_s_barrier(); asm volatile("" ::: "memory"); } while (0)
__device__ __forceinline__ void p4_scan(const Frame& F, int l) {
#pragma unroll 1
    for (int unit = F.vcu; unit < NBATCH * NHEAD * 2; unit += F.G) {
        const int b = unit >> 5, h = (unit >> 1) & 15, half = unit & 1;
        const bool pre = F.wave >= 4, mainw = F.wave == 0;
        const int r = F.lane & 31, hh = F.lane >> 5;
        constexpr int NBLKc = SEQ / 32;
        const int w_ = F.wave;
        if (w_ == 0) {
            f32x16 ST0, ST1;
#pragma unroll
            for (int i = 0; i < 16; ++i) { ST0[i] = 0.f; ST1[i] = 0.f; }
#pragma unroll 1
            for (int blk = -2; blk < NBLKc; ++blk) {
                const LAS unsigned char* BX = F.lds + CK_X3_OFF + ((blk + 3) % 3) * CK_X3SZ; const LAS unsigned char* BT = F.lds + CK_T2_OFF + (blk & 1) * CK_T2SZ;
                bf16x8 SH[2][2], SL[2][2], NUF[2], VF[2]; f32x16 RH, YT;
                if (blk >= 0) {
#pragma unroll
                for (int c = 0; c < 2; ++c)
#pragma unroll
                    for (int s = 0; s < 2; ++s) { u32x4 ph, pl;
#pragma unroll
                        for (int p = 0; p < 4; ++p) { const float x0 = (c ? ST1 : ST0)[8 * s + 2 * p], x1 = (c ? ST1 : ST0)[8 * s + 2 * p + 1]; const unsigned hp = pkbf(x0, x1);
                            ph[p] = hp;
#if defined(CK_LO)
                            pl[p] = pkbf(x0 - bflo(hp), x1 - bfhi(hp));
#endif
                        }
                        SH[c][s] = __builtin_bit_cast(bf16x8, ph);
#if defined(CK_LO)
                        SL[c][s] = __builtin_bit_cast(bf16x8, pl);
#endif
                    }
                { LAS f32x4* stash = (LAS f32x4*)(F.lds + CK_STASH) + F.lane;
#pragma unroll
                  for (int m = 0; m < 4; ++m) { stash[64 * m] = (f32x4){ST0[4 * m], ST0[4 * m + 1], ST0[4 * m + 2], ST0[4 * m + 3]}; stash[64 * (4 + m)] = (f32x4){ST1[4 * m], ST1[4 * m + 1], ST1[4 * m + 2], ST1[4 * m + 3]}; } }
                VF[0] = ck_frag(BX + CK_VT, 80, r, 8 * hh); VF[1] = ck_frag(BX + CK_VT, 80, r, 16 + 8 * hh);
#pragma unroll
                for (int i = 0; i < 16; ++i) RH[i] = 0.f;
                { bf16x8 ak[2][2], at[2];
#pragma unroll
                  for (int c = 0; c < 2; ++c)
#pragma unroll
                      for (int s = 0; s < 2; ++s) ak[c][s] = ck_frag(BX + CK_XK, 144, r, 32 * c + 16 * s + 8 * hh);
                  at[0] = ck_frag(BT + CK_TK, 80, r, 8 * hh); at[1] = ck_frag(BT + CK_TK, 80, r, 16 + 8 * hh);
#pragma unroll
                  for (int c = 0; c < 2; ++c)
#pragma unroll
                      for (int s = 0; s < 2; ++s) RH = CK_MFMA(ak[c][s], SH[c][s], RH);
#pragma unroll
                  for (int ks = 0; ks < 2; ++ks) RH = CK_MFMA(at[ks], VF[ks], RH); }
                { bf16x8 rb[2];
#pragma unroll
                  for (int s = 0; s < 2; ++s) { u32x4 p4;
#pragma unroll
                      for (int p = 0; p < 4; ++p) p4[p] = pkbf(RH[8 * s + 2 * p], RH[8 * s + 2 * p + 1]);
                      rb[s] = __builtin_bit_cast(bf16x8, p4); }
                  f32x16 UT;
#pragma unroll
                  for (int i = 0; i < 16; ++i) UT[i] = 0.f;
#pragma unroll
                  for (int s = 0; s < 2; ++s) UT = CK_MFMA(ck_frag(BT + CK_MT, 80, r, 16 * s + 8 * hh), rb[s], UT);
#pragma unroll
                  for (int s = 0; s < 2; ++s) { u32x4 p4;
#pragma unroll
                      for (int p = 0; p < 4; ++p) p4[p] = pkbf(UT[8 * s + 2 * p], UT[8 * s + 2 * p + 1]) ^ 0x80008000u;
                      NUF[s] = __builtin_bit_cast(bf16x8, p4); } }
#pragma unroll
                for (int i = 0; i < 16; ++i) YT[i] = 0.f;
                { bf16x8 ar[2][2];
#pragma unroll
                  for (int c = 0; c < 2; ++c)
#pragma unroll
                      for (int s = 0; s < 2; ++s) ar[c][s] = ck_frag(BX + CK_XR, 144, r, 32 * c + 16 * s + 8 * hh);
#pragma unroll
                  for (int c = 0; c < 2; ++c)
#pragma unroll
                      for (int s = 0; s < 2; ++s) YT = CK_MFMA(ar[c][s], SH[c][s], YT); }
                VF[0] = ck_frag(BX + CK_VT, 80, r, 8 * hh); VF[1] = ck_frag(BX + CK_VT, 80, r, 16 + 8 * hh);
                asm volatile("" ::: "memory");
#pragma unroll
                for (int ks = 0; ks < 2; ++ks) { const bf16x8 fbr = ck_frag(BT + CK_TBR, 80, r, 16 * ks + 8 * hh), fkr = ck_frag(BT + CK_TKR, 80, r, 16 * ks + 8 * hh); YT = CK_MFMA(fbr, NUF[ks], YT); YT = CK_MFMA(fkr, VF[ks], YT); }
                { bf16* yo = (bf16*)(F.ws + WS_YCK) + ((size_t)b * SEQ + blk * 32) * 1024 + h * 64 + half * 32 + r;
#pragma unroll
                  for (int reg = 0; reg < 16; ++reg) yo[(size_t)((reg & 3) + 8 * (reg >> 2) + 4 * hh) * 1024] = (bf16)f2bf(YT[reg]); }
                { const LAS f32x4* stash = (const LAS f32x4*)(F.lds + CK_STASH) + F.lane;
#pragma unroll
                  for (int m = 0; m < 4; ++m) { const f32x4 g0 = *(const LAS f32x4*)(BX + CK_GB + (8 * m + 4 * hh) * 4), g1 = *(const LAS f32x4*)(BX + CK_GB + (32 + 8 * m + 4 * hh) * 4);
                    const f32x4 a0 = stash[64 * m] * g0, a1 = stash[64 * (4 + m)] * g1;
#pragma unroll
                    for (int e = 0; e < 4; ++e) { ST0[4 * m + e] = a0[e]; ST1[4 * m + e] = a1[e]; } } }
#pragma unroll
                for (int ks = 0; ks < 2; ++ks) {
                    const bf16x8 b0 = ck_frag(BX + CK_BH, 80, r, 16 * ks + 8 * hh), b1 = ck_frag(BX + CK_BH, 80, 32 + r, 16 * ks + 8 * hh), k0 = ck_frag(BX + CK_KH, 80, r, 16 * ks + 8 * hh), k1 = ck_frag(BX + CK_KH, 80, 32 + r, 16 * ks + 8 * hh);
                    ST0 = CK_MFMA(b0, NUF[ks], ST0); ST1 = CK_MFMA(b1, NUF[ks], ST1); ST0 = CK_MFMA(k0, VF[ks], ST0); ST1 = CK_MFMA(k1, VF[ks], ST1); }
                }
                CK_BAR();
            }
        } else if (w_ == 1 || w_ == 2 || w_ == 3 || w_ == 5) {
            const int pw = (w_ == 5) ? 3 : w_ - 1;
            CkConst CC;
            { const int c = l * 1024 + h * 64 + 16 * pw + 4 * (F.lane & 3); const float* mu = kin<I_MU>() + l * N_SHIFT + h * 64 + 16 * pw + 4 * (F.lane & 3);
              CC.a0 = *(const f32x4*)(kin<I_A0>() + c); CC.kk = *(const f32x4*)(kin<I_KK>() + c); CC.ka = *(const f32x4*)(kin<I_KA>() + c); CC.rk = *(const f32x4*)(kin<I_RK>() + c); CC.w0 = *(const f32x4*)(kin<I_W0>() + c);
              CC.v0 = (l == 1) ? *(const f32x4*)(kin<I_V0>() + (c - 1024)) : (f32x4){0.f, 0.f, 0.f, 0.f}; CC.mur = *(const f32x4*)mu; CC.muk = *(const f32x4*)(mu + 1024); CC.muv = *(const f32x4*)(mu + 2048); }
            CkRegs CR;
            ck_issue(F, pw, l, b, h, half, 0, CR);
#pragma unroll 1
            for (int blk = -2; blk < NBLKc; ++blk) {
                if (blk + 2 < NBLKc) ck_stage1(F, pw, l, b, h, half, blk + 2, CC, F.lds + CK_X3_OFF + ((blk + 2 + 3) % 3) * CK_X3SZ, F.lds + CK_P2_OFF + ((blk + 2) & 1) * CK_P2SZ, CR);
                if (blk + 3 < NBLKc) ck_issue(F, pw, l, b, h, half, blk + 3, CR);
                CK_BAR();
            }
        } else {
#pragma unroll 1
            for (int blk = -2; blk < NBLKc; ++blk) {
                if (blk + 1 >= 0 && blk + 1 < NBLKc) {
                    const LAS unsigned char* BX = F.lds + CK_X3_OFF + ((blk + 1 + 3) % 3) * CK_X3SZ; const LAS unsigned char* BP = F.lds + CK_P2_OFF + ((blk + 1) & 1) * CK_P2SZ; LAS unsigned char* BT = F.lds + CK_T2_OFF + ((blk + 1) & 1) * CK_T2SZ;
                    if (w_ == 4) ck_stage2(F, 0, BX, BP, BT);
                    else if (w_ == 6) { ck_stage2(F, 1, BX, BP, BT); ck_stage2(F, 3, BX, BP, BT); }
                    else ck_stage2(F, 2, BX, BP, BT);
                }
                CK_BAR();
            }
        }
    }
}

__device__ __forceinline__ void p5_post(const Frame& F, int l) {
    const int lane = F.lane;
#if defined(DBG_SCAN)
    if (l == 0) { float d2 = 0.f, n2 = 0.f;
#if defined(DBG_CMP_U)
        const bf16* Ya = (const bf16*)(F.ws + WS_V1); const bf16* Yb = (const bf16*)(F.ws + WS_P) + C_VD; const size_t pb = P_LD;
#else
        const bf16* Ya = (const bf16*)(F.ws + WS_Y); const bf16* Yb = (const bf16*)(F.ws + WS_H); const size_t pb = 1024;
#endif
        for (size_t i = (size_t)(F.vcu * NWAVES * 64 + F.tid); i < (size_t)T * 1024; i += (size_t)F.G * NWAVES * 64) { const int t = (int)((i >> 10) & (SEQ - 1));
            if (t >= DBG_T0 && t < DBG_T1) { const float ya = bflo((unsigned)Ya[i]), yb = bflo((unsigned)Yb[(i >> 10) * pb + (i & 1023)]); d2 += (ya - yb) * (ya - yb); n2 += ya * ya; } }
        d2 = wave_sum(d2); n2 = wave_sum(n2);
        if (lane == 0) { atomicAdd((float*)(F.ws + WS_CTL) + 2048, d2); atomicAdd((float*)(F.ws + WS_CTL) + 2049, n2); }
        __syncthreads(); }
#endif
    const float* const pCW = kin<I_CONVW>() + l * 3 * 1024; const float* const pLNW = kin<I_LNW>() + l * 1024; const float* const pLNB = kin<I_LNB>() + l * 1024;
    const bf16* P = (const bf16*)(F.ws + WS_P); const bf16* Y = (const bf16*)(F.ws + WS_Y); const bf16* LRg = (const bf16*)(F.ws + WS_LR) + 2048;
    const bf16* V = (const bf16*)(F.ws + (l == 0 ? WS_V0 : WS_V1)); const float* BONP = (const float*)(F.ws + WS_BONP); bf16* M = (bf16*)(F.ws + WS_H);
#pragma unroll 1
    for (int gw = F.vcu * NWAVES + F.wave; gw < T / 8; gw += F.G * NWAVES) { const int tok0 = gw * 8;
#pragma unroll 1
    for (int ch = 0; ch < 2; ++ch) { const int col0 = 512 * ch + 8 * lane, head = 8 * ch + (lane >> 3);
        float cw0[8], cw1[8], cw2[8], lnw[8], lnb[8], um1[8], um2[8];
#pragma unroll
        for (int j = 0; j < 8; ++j) { cw0[j] = pCW[col0 + j]; cw1[j] = pCW[1024 + col0 + j]; cw2[j] = pCW[2048 + col0 + j];
            lnw[j] = pLNW[col0 + j]; lnb[j] = pLNB[col0 + j]; um1[j] = 0.f; um2[j] = 0.f; }
        const int t0 = tok0 & (SEQ - 1);
        if (t0 >= 1) { float c1[8], c2[8]; load8(P + (size_t)(tok0 - 1) * P_LD + C_CC + col0, c1); load8(P + (size_t)(tok0 - 1) * P_LD + C_CH + col0, c2);
#pragma unroll
            for (int j = 0; j < 8; ++j) um1[j] = c1[j] * c2[j]; }
        if (t0 >= 2) { float c1[8], c2[8]; load8(P + (size_t)(tok0 - 2) * P_LD + C_CC + col0, c1); load8(P + (size_t)(tok0 - 2) * P_LD + C_CH + col0, c2);
#pragma unroll
            for (int j = 0; j < 8; ++j) um2[j] = c1[j] * c2[j]; }
#pragma unroll 2
        for (int tk = 0; tk < 8; ++tk) { const int tok = tok0 + tk; const bf16* pr = P + (size_t)tok * P_LD + col0;
            float c1[8], c2[8], cb[8], ga[8], gb[8], y[8], v[8], g[8], o[8];
            load8(pr + C_CC, c1); load8(pr + C_CH, c2); load8(pr + C_CB, cb); load8(pr + C_GA, ga); load8(pr + C_GB, gb);
            load8(Y + (size_t)tok * 1024 + col0, y); load8h(V + (size_t)tok * 1024 + col0, v); load8(LRg + (size_t)tok * 3072 + col0, g);
            const f32x4 bo4 = *(const f32x4*)(BONP + ((size_t)tok * 16 + head) * 4); const float bo = (bo4[0] + bo4[1]) + (bo4[2] + bo4[3]);
            float sm = 0.f;
#pragma unroll
            for (int j = 0; j < 8; ++j) sm += y[j];
            const float mean = sum8(sm) * (1.0f / 64.0f); float sq = 0.f;
#pragma unroll
            for (int j = 0; j < 8; ++j) { y[j] -= mean; sq += y[j] * y[j]; }
            const float rstd = __builtin_amdgcn_rsqf(sum8(sq) * (1.0f / 64.0f) + LNX_EPS);
#pragma unroll
            for (int j = 0; j < 8; ++j) { const float u = c1[j] * c2[j]; const float conv = cw0[j] * um2[j] + cw1[j] * um1[j] + cw2[j] * u; um2[j] = um1[j]; um1[j] = u;
                const float yconv = cb[j] * conv; const float yr = ((y[j] * rstd) * lnw[j] + lnb[j] + bo * v[j]) * g[j];
                o[j] = sigmoidf_(ga[j]) * yconv + sigmoidf_(gb[j]) * yr; }
            store8(M + (size_t)tok * 1024 + col0, o); }
    }
    }
}

struct GroupPick { float score, a1, a2; int i1, i2; };
__device__ __forceinline__ GroupPick pick_group(const f32x4 acc, float rstd, const float* br, const float* rb) {
    float aff[4], sel[4];
#pragma unroll
    for (int j = 0; j < 4; ++j) { aff[j] = sigmoidf_(rstd * acc[j] + br[j]); sel[j] = aff[j] + rb[j]; }
    int i1 = 0;
#pragma unroll
    for (int j = 1; j < 4; ++j) if (sel[j] > sel[i1]) i1 = j;
    int i2 = (i1 == 0) ? 1 : 0;
#pragma unroll
    for (int j = 0; j < 4; ++j) if (j != i1 && j != i2 && sel[j] > sel[i2]) i2 = j;
    GroupPick g; g.score = sel[i1] + sel[i2]; g.i1 = i1; g.i2 = i2; g.a1 = aff[i1]; g.a2 = aff[i2];
    float s1 = sel[0], s2 = sel[0]; (void)s1; (void)s2;
    return g;
}
__device__ __forceinline__ void p7_route(const Frame& F, int l, bool dry = false) {
    typedef short bfv8 __attribute__((ext_vector_type(8)));
    const int lane = F.lane, li = lane & 15, fq = lane >> 4;
    LAS unsigned* lcnt = (LAS unsigned*)(F.lds + 65536);
    const float* X = (const float*)(F.ws + WS_X); const bf16* WH = (const bf16*)(F.ws + WS_WRT); const bf16* WL = WH + 32768; const float* const pN2G = kin<I_N2G>() + l * 1024; const float* const pRB = kin<I_RB>();
#pragma unroll 1
    for (int gw = F.vcu * NWAVES + F.wave; gw < T / 8; gw += F.G * NWAVES) { const int tok0 = gw * 8, b = tok0 >> 11;
        if (F.tid < 32) lcnt[F.tid] = 0u;
        __syncthreads();
        const float* ad = ada_ptr(F, l, b);
        const float* xp = X + (size_t)(tok0 + (li & 7)) * 1024 + 8 * fq; const float* g1p = pN2G + 8 * fq; const float* g2p = ad + 4096 + 8 * fq;
        const bf16* wh0 = WH + li * 1024 + 8 * fq; const bf16* wl0 = WL + li * 1024 + 8 * fq;
        f32x4 acc0 = (f32x4){0.f, 0.f, 0.f, 0.f}, acc1 = acc0; float ssq = 0.f;
#pragma unroll 2
        for (int kb = 0; kb < 1024; kb += 32) {
            const f32x4 xa = *(const f32x4*)(xp + kb), xb = *(const f32x4*)(xp + kb + 4);
            const f32x4 ga = *(const f32x4*)(g1p + kb) * (1.0f + *(const f32x4*)(g2p + kb)), gb = *(const f32x4*)(g1p + kb + 4) * (1.0f + *(const f32x4*)(g2p + kb + 4));
            const bfv8 ah0 = *(const bfv8*)(wh0 + kb), al0 = *(const bfv8*)(wl0 + kb), ah1 = *(const bfv8*)(wh0 + 16 * 1024 + kb), al1 = *(const bfv8*)(wl0 + 16 * 1024 + kb);
            ssq += ((xa[0] * xa[0] + xa[1] * xa[1]) + (xa[2] * xa[2] + xa[3] * xa[3])) + ((xb[0] * xb[0] + xb[1] * xb[1]) + (xb[2] * xb[2] + xb[3] * xb[3]));
            const f32x4 ya = xa * ga, yb = xb * gb;
            u32x4 ph, pl;
            ph[0] = pkbf(ya[0], ya[1]); ph[1] = pkbf(ya[2], ya[3]); ph[2] = pkbf(yb[0], yb[1]); ph[3] = pkbf(yb[2], yb[3]);
            pl[0] = pkbf(ya[0] - bflo(ph[0]), ya[1] - bfhi(ph[0])); pl[1] = pkbf(ya[2] - bflo(ph[1]), ya[3] - bfhi(ph[1])); pl[2] = pkbf(yb[0] - bflo(ph[2]), yb[1] - bfhi(ph[2])); pl[3] = pkbf(yb[2] - bflo(ph[3]), yb[3] - bfhi(ph[3]));
            const bfv8 bh = __builtin_bit_cast(bfv8, ph), bl = __builtin_bit_cast(bfv8, pl);
            acc0 = __builtin_amdgcn_mfma_f32_16x16x32_bf16(ah0, bh, acc0, 0, 0, 0); acc0 = __builtin_amdgcn_mfma_f32_16x16x32_bf16(al0, bh, acc0, 0, 0, 0); acc0 = __builtin_amdgcn_mfma_f32_16x16x32_bf16(ah0, bl, acc0, 0, 0, 0);
            acc1 = __builtin_amdgcn_mfma_f32_16x16x32_bf16(ah1, bh, acc1, 0, 0, 0); acc1 = __builtin_amdgcn_mfma_f32_16x16x32_bf16(al1, bh, acc1, 0, 0, 0); acc1 = __builtin_amdgcn_mfma_f32_16x16x32_bf16(ah1, bl, acc1, 0, 0, 0);
        }
        ssq += __shfl_xor(ssq, 16); ssq += __shfl_xor(ssq, 32);
        const float rstd = __builtin_amdgcn_rsqf(ssq * (1.0f / 1024.0f) + NORM_EPS);
        const float* br = (const float*)(F.ws + WS_CTL + CTL_BIASR) + (l * 8 + b) * 32;
        const GroupPick ga_ = pick_group(acc0, rstd, br + 4 * fq, pRB + 4 * fq), gb_ = pick_group(acc1, rstd, br + 16 + 4 * fq, pRB + 16 + 4 * fq);
        const bool useb = gb_.score > ga_.score;
        const GroupPick gm = useb ? gb_ : ga_; const int mygrp = useb ? 4 + fq : fq;
        float bs = gm.score; int bg = mygrp;
#pragma unroll
        for (int off = 16; off < 64; off <<= 1) { const float os = __shfl_xor(bs, off); const int og = __shfl_xor(bg, off); if (os > bs || (os == bs && og < bg)) { bs = os; bg = og; } }
        if (mygrp == bg && li < 8) { const int tok = tok0 + li; const int e0 = 4 * bg + gm.i1, e1 = 4 * bg + gm.i2; const float inv = 1.0f / (gm.a1 + gm.a2);
            const int p0 = (int)__hip_atomic_fetch_add(lcnt + e0, 1u, __ATOMIC_RELAXED, __HIP_MEMORY_SCOPE_WORKGROUP), p1 = (int)__hip_atomic_fetch_add(lcnt + e1, 1u, __ATOMIC_RELAXED, __HIP_MEMORY_SCOPE_WORKGROUP);
            int* EI = (int*)(F.ws + WS_EIDX); int* PO = (int*)(F.ws + WS_POS); float* WT = (float*)(F.ws + WS_WTS);
            if (!dry) { EI[tok * 2] = e0; EI[tok * 2 + 1] = e1; PO[tok * 2] = p0; PO[tok * 2 + 1] = p1; WT[tok * 2] = gm.a1 * inv; WT[tok * 2 + 1] = gm.a2 * inv; } }
        __syncthreads();
        if (F.tid < 32 && !dry) ((int*)(F.ws + WS_HIST))[(l * 256 + (gw >> 3)) * 32 + F.tid] = (int)lcnt[F.tid];
        __syncthreads();
    }
}

__device__ __forceinline__ void expert_table(const Frame& F, int l, int grp = -1) {
    LAS int* tab = (LAS int*)(F.lds + TAB_OFF); LAS int* red = (LAS int*)F.lds;
    const int* hist = (const int*)(F.ws + WS_HIST) + l * 256 * 32; const int e = F.tid & 31, part = F.tid >> 5;
    int tot = 0, pre = 0;
#pragma unroll 4
    for (int g = part * 16; g < part * 16 + 16; ++g) { const int v = hist[g * 32 + e]; tot += v; pre += (g < grp) ? v : 0; }
    red[part * 32 + e] = tot; red[512 + part * 32 + e] = pre;
    __syncthreads();
    if (F.tid < 64) { int c = 0, pr = 0;
#pragma unroll
        for (int p = 0; p < 16; ++p) { c += red[p * 32 + e]; pr += red[512 + p * 32 + e]; }
        const int padded = (c + 255) & ~255; int inc = padded;
#pragma unroll
        for (int o = 1; o < 32; o <<= 1) { const int v = __shfl_up(inc, o); if (e >= o) inc += v; }
        if (F.lane < 32) { tab[e] = inc - padded; tab[33 + e] = (inc - padded) >> 8; tab[66 + e] = inc - padded + pr; if (e == 31) { tab[32] = inc; tab[65] = inc >> 8; } } }
    __syncthreads();
}

__device__ __forceinline__ void p8_dispatch(const Frame& F, int l) {
    const LAS int* tab = (const LAS int*)(F.lds + TAB_OFF);
    const float* const pN2G = kin<I_N2G>() + l * 1024;
    const int lane = F.lane;
#pragma unroll 1
    for (int gw = F.vcu * NWAVES + F.wave; gw < T / 8; gw += F.G * NWAVES) { const int tok0 = gw * 8, b = tok0 >> 11;
        expert_table(F, l, gw >> 3);
        const float* ad = ada_ptr(F, l, b); f32x4 gm[4], sh[4];
#pragma unroll
        for (int j = 0; j < 4; ++j) { const int c = 4 * lane + 256 * j; gm[j] = *(const f32x4*)(pN2G + c) * (1.0f + *(const f32x4*)(ad + 4096 + c)); sh[j] = *(const f32x4*)(ad + 3072 + c); }
        const float* X = (const float*)(F.ws + WS_X); const int* EI = (const int*)(F.ws + WS_EIDX); const int* PO = (const int*)(F.ws + WS_POS); int* SL = (int*)(F.ws + WS_SLOT); bf16* BUF = (bf16*)(F.ws + WS_BUF);
        for (int tk = 0; tk < 8; ++tk) { const int tok = tok0 + tk; f32x4 v[4]; float ss = 0.f;
#pragma unroll
            for (int j = 0; j < 4; ++j) { v[j] = *(const f32x4*)(X + (size_t)tok * 1024 + 4 * lane + 256 * j); ss += (v[j][0] * v[j][0] + v[j][1] * v[j][1]) + (v[j][2] * v[j][2] + v[j][3] * v[j][3]); }
            const float rstd = __builtin_amdgcn_rsqf(wave_sum(ss) * (1.0f / 1024.0f) + NORM_EPS);
            const int s0 = tab[66 + EI[tok * 2]] + PO[tok * 2], s1 = tab[66 + EI[tok * 2 + 1]] + PO[tok * 2 + 1];
            if (lane == 0) { SL[tok * 2] = s0; SL[tok * 2 + 1] = s1; }
#pragma unroll
            for (int j = 0; j < 4; ++j) { const f32x4 h = v[j] * rstd * gm[j] + sh[j]; u32x2 w; w.x = pk2(h[0], h[1]); w.y = pk2(h[2], h[3]);
                *(u32x2*)(BUF + (size_t)s0 * 1024 + 4 * lane + 256 * j) = w; *(u32x2*)(BUF + (size_t)s1 * 1024 + 4 * lane + 256 * j) = w; } }
    }
}

#ifndef PHMASK
#define PHMASK 0xFFFF
#endif
#define PHM(n) (((PHMASK) >> (n)) & 1)
constexpr int NPHASES = 23;
__global__ void __launch_bounds__(NWAVES * 64, 2) trunk_fwd(Args args) {
    extern __shared__ __attribute__((aligned(16))) unsigned char lds_raw[];
    Frame F;
    F.lds = (LAS unsigned char*)lds_raw;
    F.tid = threadIdx.x; F.lane = F.tid & 63; F.wave = __builtin_amdgcn_readfirstlane(F.tid >> 6);
    F.G = gridDim.x; { const int bx = blockIdx.x; F.vcu = (F.G % 8 == 0) ? (bx % 8) * (F.G / 8) + bx / 8 : bx; }
    GAS unsigned char* const wsbase = (GAS unsigned char*)kin<29>(); F.ws = wsbase; const int vcu0 = F.vcu;
    volatile LAS unsigned* MISC = (volatile LAS unsigned*)(F.lds + MISC_OFF);
    if (F.tid < 32) MISC[F.tid] = 0u;
    __syncthreads();
    const unsigned long long lohi = (unsigned long long)kin<30>(); const int lo = (int)(unsigned)lohi, hi = (int)(unsigned)(lohi >> 32);
    XcdBarrier bar; bar.bar = (unsigned*)(F.ws + WS_CTL) + CW_BAR; bar.x = 0; bar.st = nullptr;
    if (hi - lo > 1) bar = xcd_barrier_post((unsigned*)(F.ws + WS_CTL) + CW_BAR, MISC + 8);
#pragma unroll 1
#if defined(REP_PH)
    for (int phx = lo; phx < hi + REP_N; ++phx) { const int ph = (phx <= REP_PH) ? phx : ((phx - REP_N > REP_PH) ? phx - REP_N : REP_PH);
#else
    for (int ph = lo; ph < hi; ++ph) {
#endif
        { int t_ = threadIdx.x; asm volatile("" : "+v"(t_)); F.tid = t_; F.lane = t_ & 63; F.wave = __builtin_amdgcn_readfirstlane(t_ >> 6);
          GAS unsigned char* w_ = wsbase; asm volatile("" : "+s"(w_)); F.ws = w_; int v_ = vcu0; asm volatile("" : "+s"(v_)); F.vcu = v_; }
        const int l = (ph - 2) / 10, k = (ph >= 2 && ph <= 21) ? (ph - 2) % 10 : -1;
        if (PHM(0) && ph == 0) p0_prologue(F);
        else if (PHM(0) && ph == 1) p0b_ada_reduce(F);
        else if (PHM(1) && ph == 22) p1_norm<2>(F, 1);
        else if (PHM(1) && k == 0) { if (l == 0) p1_norm<0>(F, 0); else p1_norm<1>(F, 1); }
        else if (PHM(3) && k == 2) p2x_lowrank(F, l);
        #if defined(DBG_SCAN)
        else if (PHM(4) && k == 3) { p4_scan_seq(F, l); __syncthreads(); if (l == 0) p4_scan(F, l); }
#else
        else if (PHM(4) && k == 3) p4_scan(F, l);
#endif
        else if (PHM(5) && k == 4) p5_post(F, l);
        #if defined(REP_PH)
        else if (PHM(7) && k == 6) p7_route(F, l, phx > REP_PH && ph == REP_PH);
#else
        else if (PHM(7) && k == 6) p7_route(F, l);
#endif
        else if (PHM(8) && k == 7) p8_dispatch(F, l);
        else if (PHM(2) && (k == 1 || k == 5 || k == 8 || k == 9)) {
            pg8::Gemm g; pg8::UniOrder S; pg8::EpiUni E;
            S.expert = (k >= 8); S.so.init(T, 1024, F.G, (int)blockIdx.x); S.eo = pg8::ExpertOrder{(const PG8_LAS int*)(F.lds + TAB_OFF + 33 * 4), 0, F.G, (int)blockIdx.x};
            E.e0 = pg8::EpiBf16Plain{(bf16*)(F.ws + WS_P), P_LD, -1}; E.e1 = pg8::EpiResid{nullptr, (float*)(F.ws + WS_X), ada_ptr(F, l, 0) + 2048, 6144}; E.e2 = pg8::EpiSwiGLU{(bf16*)(F.ws + WS_HB)};
            if (k == 1) {
                const int N = (l == 0) ? N_IN : P_LD; S.so.init(T, N, F.G, (int)blockIdx.x); E.mode = 0;
                g = pg8::Gemm{(const bf16*)(F.ws + WS_H), (const bf16*)(F.ws + WS_BT_IN) + (size_t)l * P_LD * 1024, T, N, 1024};
            } else if (k == 5) {
                E.mode = 1; E.e1.xin = (l == 0) ? kin<I_X>() : (const float*)(F.ws + WS_X);
                g = pg8::Gemm{(const bf16*)(F.ws + WS_H), (const bf16*)(F.ws + WS_BT_OUT) + (size_t)l * 1024 * 1024, T, 1024, 1024};
            } else {
                expert_table(F, l);
                S.eo.ntiles = ((const LAS int*)(F.lds + TAB_OFF))[65];
                if (k == 8) { E.mode = 2; g = pg8::Gemm{(const bf16*)(F.ws + WS_BUF), (const bf16*)(F.ws + WS_BT_E1) + (size_t)l * 32 * 1024 * 1024, MAXROWS, 32 * 1024, 1024}; }
                else { E.mode = 0; E.e0 = pg8::EpiBf16Plain{(bf16*)(F.ws + WS_YE), 1024, 3}; g = pg8::Gemm{(const bf16*)(F.ws + WS_HB), (const bf16*)(F.ws + WS_BT_E2) + (size_t)l * 32 * 1024 * 512, MAXROWS, 32 * 1024, 512}; }
            }
            pg8::gemm_phase<pg8::EpiUni, pg8::UniOrder, true, true>(F.lds, g, S, E);
        }
#if defined(REP_PH)
        if (phx + 1 < hi + REP_N) xcd_barrier(bar);
#else
        if (ph + 1 < hi) xcd_barrier(bar);
#endif
    }
}

extern "C" void kernel_launch(void* const* d_in, const int* in_sizes, int n_in, void* d_out, int out_size, void* d_ws, size_t ws_size, hipStream_t stream) {
    static int grid = 0;
    if (grid == 0) {
        if (n_in != 28 || in_sizes[0] != T * D || out_size != T * D || ws_size < WS_END) { fprintf(stderr, "kernel_launch: unexpected shapes (n_in %d, in0 %d, out %d, ws %zu < %zu?); nothing launched\n", n_in, n_in > 0 ? in_sizes[0] : -1, out_size, ws_size, (size_t)WS_END); grid = -1; return; }
        int dev = 0, cus = 0, per_cu = 0;
        if (hipGetDevice(&dev) != hipSuccess || hipDeviceGetAttribute(&cus, hipDeviceAttributeMultiprocessorCount, dev) != hipSuccess) { fprintf(stderr, "kernel_launch: device query failed\n"); grid = -1; return; }
        if (hipFuncSetAttribute((const void*)trunk_fwd, hipFuncAttributeMaxDynamicSharedMemorySize, LDS_BYTES) != hipSuccess) { fprintf(stderr, "kernel_launch: hipFuncSetAttribute failed\n"); grid = -1; return; }
        if (hipOccupancyMaxActiveBlocksPerMultiprocessor(&per_cu, (const void*)trunk_fwd, NWAVES * 64, LDS_BYTES) != hipSuccess || per_cu < 1) { fprintf(stderr, "kernel_launch: occupancy query says %d blocks per CU\n", per_cu); }
        (void)hipGetLastError();
        grid = cus;
    }
    if (grid < 0) return;
    if (hipMemsetAsync((char*)d_ws + WS_CTL, 0, CTL_ZERO_BYTES, stream) != hipSuccess) { fprintf(stderr, "kernel_launch: memset failed\n"); return; }
    Args a{};
    for (int i = 0; i < 28; ++i) a.p[i] = d_in[i];
    a.p[28] = d_out; a.p[29] = d_ws;
#if MK_ONE_LAUNCH
    a.ph_lo = 0; a.ph_hi = NPHASES;
    void* kargs[] = {&a};
    hipError_t e = hipLaunchCooperativeKernel((const void*)trunk_fwd, dim3(grid), dim3(NWAVES * 64), kargs, LDS_BYTES, stream);
    if (e != hipSuccess) fprintf(stderr, "kernel_launch: cooperative launch failed: %s (grid %d)\n", hipGetErrorString(e), grid);
#else
    for (int p = 0; p < NPHASES; ++p) { a.ph_lo = p; a.ph_hi = p + 1;
        hipLaunchKernelGGL(trunk_fwd, dim3(grid), dim3(NWAVES * 64), LDS_BYTES, stream, a);
        const hipError_t le = hipPeekAtLastError(); if (le != hipSuccess) { fprintf(stderr, "kernel_launch: launch %d failed: %s\n", p, hipGetErrorName(le)); break; } }
#endif
}
```

```cpp
#include <hip/hip_runtime.h>
#include <cstdio>
#include <cstdint>

#ifndef MK_ONE_LAUNCH
#define MK_ONE_LAUNCH 1
#endif

namespace pg8 {
#define PG8_LAS __attribute__((address_space(3)))
typedef unsigned short bf16_t;
typedef short bf16x8 __attribute__((ext_vector_type(8)));
typedef float f32x4 __attribute__((ext_vector_type(4)));
typedef unsigned u32x4 __attribute__((ext_vector_type(4)));
constexpr int BM = 256, BK = 64, HALF = 128, HTB = HALF * BK * 2  , STAGE_BYTES = 8 * HTB, NXCD = 8, WGM = 8;

__host__ __device__ __forceinline__ int lds_byte(int r, int c) { const int st = (r >> 4) * 2 + (c >> 5), rr = r & 15, cc = c & 31, ob = rr * 64 + cc * 2; return st * 1024 + (ob ^ (((ob >> 9) & 1) << 5)); }
__host__ __device__ __forceinline__ void stage_rc(int b, int& R, int& C) { const int st = b / 1024, sb = b % 1024, swz = sb ^ (((sb >> 9) & 1) << 5); R = (st >> 1) * 16 + swz / 64; C = (st & 1) * 32 + (swz % 64) / 2; }
__host__ __device__ __forceinline__ int perm32(int rho) { const int n = rho >> 4, i = rho & 15; return 8 * (i >> 2) + 4 * n + (i & 3); }

struct Unit { int pm, pn; };
struct Gemm { const bf16_t* A; const bf16_t* Bt; int M, N, K; };

struct StaticOrder {
    int nM, nN, nwg, G, c;
    __host__ __device__ void init(int M, int N, int G_, int c_) { nM = M / BM; nN = N / BM; nwg = nM * nN; G = G_; c = c_; }
    __host__ __device__ bool next(int i, Unit& u) const {
        const long L = (long)i * G + c; if (L >= nwg) return false;
        int wgid = (int)L; { const int q = nwg / NXCD, r = nwg % NXCD, xcd = wgid % NXCD, off = wgid / NXCD; wgid = (xcd < r ? xcd * (q + 1) : r * (q + 1) + (xcd - r) * q) + off; }
        const int nig = WGM * nN, gid = wgid / nig, fm = gid * WGM, gsz = (nM - fm) < WGM ? (nM - fm) : WGM;
        u.pm = fm + ((wgid % nig) % gsz); u.pn = (wgid % nig) / gsz; return true;
    }
    __device__ __forceinline__ void a_ready(const Unit&) const {}
    __device__ __forceinline__ void done(const Unit&) const {}
};
__device__ __forceinline__ unsigned cvt_pk_bf16(float lo, float hi) { unsigned r; asm volatile("v_cvt_pk_bf16_f32 %0, %1, %2" : "=v"(r) : "v"(lo), "v"(hi)); return r; }
typedef float f32x2 __attribute__((ext_vector_type(2)));
typedef unsigned u32x2 __attribute__((ext_vector_type(2)));

struct EpiBf16Plain {
    static constexpr bool PERM = true, AFTER_DRAIN = false;
    bf16_t* O; int ldc; int cmask;
    __device__ __forceinline__ void operator()(const f32x4 (&acc)[2][2][4][2], const Unit& u, int wr, int wc, int fr, int fq) const {
        const int row0 = u.pm * BM + wr * 64 + fr; const int col0 = (u.pn & cmask) * BM + wc * 32 + 8 * fq;
#pragma unroll
        for (int ai = 0; ai < 2; ++ai)
#pragma unroll
            for (int m = 0; m < 4; ++m) { bf16_t* rowp = O + (size_t)(row0 + ai * HALF + m * 16) * ldc + col0;
#pragma unroll
                for (int bj = 0; bj < 2; ++bj) { const f32x4 v0 = acc[ai][bj][m][0], v1 = acc[ai][bj][m][1];
                    u32x4 w; w.x = cvt_pk_bf16(v0[0], v0[1]); w.y = cvt_pk_bf16(v0[2], v0[3]); w.z = cvt_pk_bf16(v1[0], v1[1]); w.w = cvt_pk_bf16(v1[2], v1[3]);
                    *(u32x4*)(rowp + bj * HALF) = w; } }
    }
};
struct EpiResid {
    static constexpr bool PERM = false, AFTER_DRAIN = false;
    const float* xin; float* xout; const float* gate;
    int gstride;
    __device__ __forceinline__ void operator()(const f32x4 (&acc)[2][2][4][2], const Unit& u, int wr, int wc, int fr, int fq) const {
        const int row0 = u.pm * BM + wr * 64 + fr, col0 = u.pn * BM + wc * 32 + 4 * fq;
        const float* gp = gate + (size_t)(u.pm >> 3) * gstride;
        f32x4 gv[2][2];
#pragma unroll
        for (int bj = 0; bj < 2; ++bj)
#pragma unroll
            for (int n = 0; n < 2; ++n) gv[bj][n] = *(const f32x4*)(gp + col0 + bj * HALF + n * 16);
#pragma unroll
        for (int ai = 0; ai < 2; ++ai)
#pragma unroll
            for (int m = 0; m < 4; ++m) { const size_t ro = (size_t)(row0 + ai * HALF + m * 16) * 1024 + col0;
#pragma unroll
                for (int bj = 0; bj < 2; ++bj)
#pragma unroll
                    for (int n = 0; n < 2; ++n) { const f32x4 xi = *(const f32x4*)(xin + ro + bj * HALF + n * 16);
                        *(f32x4*)(xout + ro + bj * HALF + n * 16) = xi + gv[bj][n] * acc[ai][bj][m][n]; }
                asm volatile("" ::: "memory"); }
    }
};
struct EpiSwiGLU {
    static constexpr bool PERM = false, AFTER_DRAIN = false;
    bf16_t* O;
    __device__ __forceinline__ void operator()(const f32x4 (&acc)[2][2][4][2], const Unit& u, int wr, int wc, int fr, int fq) const {
        const int row0 = u.pm * BM + wr * 64 + fr, col0 = (u.pn & 3) * HALF + wc * 32 + 4 * fq;
#pragma unroll
        for (int ai = 0; ai < 2; ++ai)
#pragma unroll
            for (int m = 0; m < 4; ++m) { bf16_t* rowp = O + (size_t)(row0 + ai * HALF + m * 16) * 512 + col0;
#pragma unroll
                for (int n = 0; n < 2; ++n) { const f32x4 g = acc[ai][0][m][n], up = acc[ai][1][m][n]; f32x4 h;
#pragma unroll
                    for (int j = 0; j < 4; ++j) h[j] = g[j] * __builtin_amdgcn_rcpf(1.0f + __expf(-g[j])) * up[j];
                    u32x2 w; w.x = cvt_pk_bf16(h[0], h[1]); w.y = cvt_pk_bf16(h[2], h[3]);
                    *(u32x2*)(rowp + n * 16) = w; } }
    }
};
struct ExpertOrder {
    const PG8_LAS int* ts; int ntiles, G, c;
    __device__ __forceinline__ bool next(int i, Unit& u) const {
        const int L = i * G + c; if (L >= ntiles * 4) return false;
        const int pm = L >> 2; int e = 0;
#pragma unroll 1
        for (int k = 1; k < 32; ++k) e += (ts[k] <= pm) ? 1 : 0;
        u.pm = pm; u.pn = e * 4 + (L & 3); return true;
    }
    __device__ __forceinline__ void a_ready(const Unit&) const {}
    __device__ __forceinline__ void done(const Unit&) const {}
};

struct UniOrder {
    StaticOrder so; ExpertOrder eo; bool expert;
    __device__ __forceinline__ bool next(int i, Unit& u) const { return expert ? eo.next(i, u) : so.next(i, u); }
    __device__ __forceinline__ void a_ready(const Unit&) const {}
    __device__ __forceinline__ void done(const Unit&) const {}
};
struct EpiUni {
    static constexpr bool AFTER_DRAIN = false;
    int mode; EpiBf16Plain e0; EpiResid e1; EpiSwiGLU e2;
    __device__ __forceinline__ bool perm() const { return mode == 0; }
    __device__ __forceinline__ void operator()(const f32x4 (&acc)[2][2][4][2], const Unit& u, int wr, int wc, int fr, int fq) const {
        if (mode == 0) e0(acc, u, wr, wc, fr, fq); else if (mode == 1) e1(acc, u, wr, wc, fr, fq); else if (mode == 2) e2(acc, u, wr, wc, fr, fq);
    }
};
template <class Epi, class Sched, bool ALIGN_EPI = false, bool SP2 = false>
__device__ __forceinline__ void gemm_phase(PG8_LAS unsigned char* lds, const Gemm g, const Sched& S, const Epi& E) {
    int tid_ = threadIdx.x; asm volatile("" : "+v"(tid_));
    const int tid = tid_, wid = __builtin_amdgcn_readfirstlane(tid >> 6), lane = tid & 63, wr = wid >> 2, wc = wid & 3, fr = lane & 15, fq = lane >> 4;
    const int K = g.K, nt = K / BK;
    unsigned voffA[2], voffB[2];
#pragma unroll
    for (int i = 0; i < 2; ++i) { int R, C; stage_rc(tid * 16 + i * 8192, R, C); const int Rb = E.perm() ? ((R & ~31) + perm32(R & 31)) : R;
        voffA[i] = (unsigned)(R * K + C) * 2u; voffB[i] = (unsigned)(Rb * K + C) * 2u; }
    const size_t kstep = (size_t)(BK * 2);
    const size_t hstep = (size_t)HALF * K * 2;
    const size_t tstep = 2 * hstep;
    const unsigned ldsw = (unsigned)wid * 1024u;
    const int aoff = lds_byte(wr * 64 + fr, fq * 8), boff = lds_byte(wc * 32 + fr, fq * 8);
#define PG8_SA(b, h) (((b) * 2 + (h)) * HTB)
#define PG8_SB(b, h) ((4 + (b) * 2 + (h)) * HTB)
#define PG8_STAGE(bufoff, gbase, voff) do { _Pragma("unroll") for (int _i = 0; _i < 2; ++_i) \
        __builtin_amdgcn_global_load_lds((const unsigned*)((const char*)(gbase) + (voff)[_i]), (PG8_LAS unsigned*)(lds + (bufoff) + ldsw + _i * 8192), 16, 0, 0); } while (0)
#define PG8_LDA(dst, b, h) do { _Pragma("unroll") for (int m = 0; m < 4; ++m) _Pragma("unroll") for (int k = 0; k < 2; ++k) dst[m][k] = *(const PG8_LAS bf16x8*)(lds + PG8_SA(b, h) + aoff + m * 2048 + k * 1024); } while (0)
#define PG8_LDB(dst, b, h) do { _Pragma("unroll") for (int n = 0; n < 2; ++n) _Pragma("unroll") for (int k = 0; k < 2; ++k) dst[n][k] = *(const PG8_LAS bf16x8*)(lds + PG8_SB(b, h) + boff + n * 2048 + k * 1024); } while (0)
#define PG8_MMA(ai, bj, At, Bt) do { __builtin_amdgcn_s_setprio(1); _Pragma("unroll") for (int m = 0; m < 4; ++m) _Pragma("unroll") for (int n = 0; n < 2; ++n) _Pragma("unroll") for (int k = 0; k < 2; ++k) \
        acc[ai][bj][m][n] = __builtin_amdgcn_mfma_f32_16x16x32_bf16(Bt[n][k], At[m][k], acc[ai][bj][m][n], 0, 0, 0); __builtin_amdgcn_s_setprio(0); } while (0)
#define PG8_WAIT_V(n) asm volatile("s_waitcnt vmcnt(" #n ")" ::: "memory")
#define PG8_WAIT_L(n) asm volatile("s_waitcnt lgkmcnt(" #n ")" ::: "memory")
#define PG8_BAR __builtin_amdgcn_s_barrier()
#define PG8_SCHED __builtin_amdgcn_sched_barrier(0)
    Unit cur, nxt; int ui = 0;
    if (!S.next(0, cur)) return;
    f32x4 acc[2][2][4][2];
#pragma unroll
    for (int a = 0; a < 2; ++a)
#pragma unroll
        for (int b = 0; b < 2; ++b)
#pragma unroll
            for (int m = 0; m < 4; ++m)
#pragma unroll
                for (int n = 0; n < 2; ++n) acc[a][b][m][n] = (f32x4){0.f, 0.f, 0.f, 0.f};
    bf16x8 At[4][2], B0[2][2], B1[2][2];
    const char* cA = (const char*)g.A + (size_t)cur.pm * tstep; const char* cB = (const char*)g.Bt + (size_t)cur.pn * tstep;
    S.a_ready(cur);
    if constexpr (SP2) {
        PG8_STAGE(PG8_SB(0, 0), cB, voffB); PG8_STAGE(PG8_SB(0, 1), cB + hstep, voffB); PG8_STAGE(PG8_SA(0, 0), cA, voffA); PG8_STAGE(PG8_SA(0, 1), cA + hstep, voffA);
        if (wr == 1) PG8_BAR;
        PG8_WAIT_V(2); PG8_BAR;
        PG8_STAGE(PG8_SB(1, 0), cB + kstep, voffB); PG8_STAGE(PG8_SA(1, 0), cA + kstep, voffA); PG8_STAGE(PG8_SB(1, 1), cB + hstep + kstep, voffB);
        PG8_WAIT_V(6); PG8_BAR;
    } else {
        PG8_STAGE(PG8_SB(0, 0), cB, voffB); PG8_STAGE(PG8_SA(0, 0), cA, voffA); PG8_STAGE(PG8_SB(0, 1), cB + hstep, voffB); PG8_STAGE(PG8_SA(0, 1), cA + hstep, voffA);
        if (wr == 1) PG8_BAR;
        PG8_WAIT_V(4); PG8_BAR;
        PG8_STAGE(PG8_SB(1, 0), cB + kstep, voffB); PG8_STAGE(PG8_SA(1, 0), cA + kstep, voffA); PG8_STAGE(PG8_SB(1, 1), cB + hstep + kstep, voffB);
        PG8_WAIT_V(6); PG8_BAR;
    }
    for (;;) {
        const bool has_next = S.next(ui + 1, nxt);
        const char* nA = has_next ? (const char*)g.A + (size_t)nxt.pm * tstep : cA; const char* nB = has_next ? (const char*)g.Bt + (size_t)nxt.pn * tstep : cB;
        for (int t = 0; t < nt; t += 2) {
            const bool last = (t == nt - 2);
            const char* a1 = cA + (size_t)(t + 1) * kstep;
            const char* a2 = last ? nA : cA + (size_t)(t + 2) * kstep; const char* b2 = last ? nB : cB + (size_t)(t + 2) * kstep;
            const char* a3 = a2 + kstep; const char* b3 = b2 + kstep;
            if (last && has_next) S.a_ready(nxt);
            if constexpr (SP2) {
            PG8_LDB(B0, 0, 0); PG8_LDB(B1, 0, 1); PG8_SCHED; PG8_LDA(At, 0, 0); PG8_STAGE(PG8_SA(1, 1), a1 + hstep, voffA);
            PG8_WAIT_V(8); PG8_WAIT_L(0); PG8_BAR; PG8_MMA(0, 0, At, B0); PG8_MMA(0, 1, At, B1); PG8_BAR; PG8_SCHED;
            PG8_LDA(At, 0, 1); PG8_STAGE(PG8_SB(0, 0), b2, voffB); PG8_STAGE(PG8_SB(0, 1), b2 + hstep, voffB); PG8_STAGE(PG8_SA(0, 0), a2, voffA);
            PG8_WAIT_V(8); PG8_WAIT_L(0); PG8_BAR; PG8_MMA(1, 0, At, B0); PG8_MMA(1, 1, At, B1); PG8_BAR; PG8_SCHED;
            PG8_LDB(B0, 1, 0); PG8_LDB(B1, 1, 1); PG8_SCHED; PG8_LDA(At, 1, 0); PG8_STAGE(PG8_SA(0, 1), a2 + hstep, voffA);
            PG8_WAIT_V(8); PG8_WAIT_L(0); PG8_BAR; PG8_MMA(0, 0, At, B0); PG8_MMA(0, 1, At, B1); PG8_BAR; PG8_SCHED;
            PG8_LDA(At, 1, 1); PG8_STAGE(PG8_SB(1, 0), b3, voffB); PG8_STAGE(PG8_SB(1, 1), b3 + hstep, voffB); PG8_STAGE(PG8_SA(1, 0), a3, voffA);
            PG8_WAIT_V(8); PG8_WAIT_L(0); PG8_BAR; PG8_MMA(1, 0, At, B0); PG8_MMA(1, 1, At, B1); PG8_BAR; PG8_SCHED;
            } else {
            PG8_LDB(B0, 0, 0); PG8_SCHED; PG8_LDA(At, 0, 0); PG8_STAGE(PG8_SA(1, 1), a1 + hstep, voffA);
            PG8_WAIT_L(8); PG8_BAR; PG8_WAIT_L(0); PG8_MMA(0, 0, At, B0); PG8_BAR; PG8_SCHED;
            PG8_LDB(B1, 0, 1); PG8_STAGE(PG8_SB(0, 0), b2, voffB);
            PG8_BAR; PG8_WAIT_L(0); PG8_MMA(0, 1, At, B1); PG8_BAR;
            PG8_LDA(At, 0, 1); PG8_STAGE(PG8_SA(0, 0), a2, voffA);
            PG8_BAR; PG8_WAIT_L(0); PG8_MMA(1, 0, At, B0); PG8_BAR; PG8_SCHED;
            PG8_STAGE(PG8_SB(0, 1), b2 + hstep, voffB);
            PG8_WAIT_V(6); PG8_BAR; PG8_MMA(1, 1, At, B1); PG8_BAR;
            PG8_LDB(B0, 1, 0); PG8_SCHED; PG8_LDA(At, 1, 0); PG8_STAGE(PG8_SA(0, 1), a2 + hstep, voffA);
            PG8_WAIT_L(8); PG8_BAR; PG8_WAIT_L(0); PG8_MMA(0, 0, At, B0); PG8_BAR; PG8_SCHED;
            PG8_LDB(B1, 1, 1); PG8_STAGE(PG8_SB(1, 0), b3, voffB);
            PG8_BAR; PG8_WAIT_L(0); PG8_MMA(0, 1, At, B1); PG8_BAR;
            PG8_LDA(At, 1, 1); PG8_STAGE(PG8_SA(1, 0), a3, voffA);
            PG8_BAR; PG8_WAIT_L(0); PG8_MMA(1, 0, At, B0); PG8_BAR; PG8_SCHED;
            PG8_STAGE(PG8_SB(1, 1), b3 + hstep, voffB);
            PG8_WAIT_V(6); PG8_BAR; PG8_MMA(1, 1, At, B1); PG8_BAR;
            }
        }
        if constexpr (ALIGN_EPI) { if (wr == 0) PG8_BAR; }
        if constexpr (!Epi::AFTER_DRAIN) { E(acc, cur, wr, wc, fr, fq); S.done(cur); }
        if (!has_next) break;
#pragma unroll
        for (int a = 0; a < 2; ++a)
#pragma unroll
            for (int b = 0; b < 2; ++b)
#pragma unroll
                for (int m = 0; m < 4; ++m)
#pragma unroll
                    for (int n = 0; n < 2; ++n) acc[a][b][m][n] = (f32x4){0.f, 0.f, 0.f, 0.f};
        cur = nxt; cA = nA; cB = nB; ++ui;
        if constexpr (ALIGN_EPI) { if (wr == 1) PG8_BAR; }
    }
    PG8_WAIT_V(0);
    if constexpr (!ALIGN_EPI) { if (wr == 0) PG8_BAR; }
    PG8_BAR;
    if constexpr (Epi::AFTER_DRAIN) { E.fused(acc, cur, wr, wc, fr, fq, lds, wid, lane); S.done(cur); }
#undef PG8_SA
#undef PG8_SB
#undef PG8_STAGE
#undef PG8_LDA
#undef PG8_LDB
#undef PG8_MMA
#undef PG8_WAIT_V
#undef PG8_WAIT_L
#undef PG8_BAR
#undef PG8_SCHED
}
}

constexpr int NWAVES = 8;
constexpr int T = 16384, D = 1024, SEQ = 2048, NBATCH = 8, NHEAD = 16;
constexpr int N_IN = 8448, P_LD = 9472;
constexpr int C_CB = 0, C_CC = 1024, C_CH = 2048, C_GA = 3072, C_GB = 4096, C_R = 5120, C_K = 6144, C_V = 7168, C_WD = 8192, C_AD = 8256, C_GD = 8320, C_VD = 8448;
constexpr int N_SHIFT = 3328, N_EXP = 32, D_EXP = 512;
constexpr int MAXROWS = 40960;
constexpr float NORM_EPS = 1e-6f, LNX_EPS = 64e-5f;

constexpr size_t MiB = 1u << 20;
constexpr size_t WS_CTL = 0, CTL_ZERO_BYTES = 1 * MiB;
constexpr size_t WS_BT_IN = 2 * MiB;
constexpr size_t WS_BT_OUT = 39 * MiB;
constexpr size_t WS_BT_E1 = 43 * MiB;
constexpr size_t WS_BT_E2 = 171 * MiB;
constexpr size_t WS_H = 235 * MiB;
constexpr size_t WS_ALR = WS_H;
constexpr size_t WS_P = 267 * MiB;
constexpr size_t WS_BUF = WS_P, WS_HB = WS_P + 80 * MiB, WS_YE = WS_P + 120 * MiB;
constexpr size_t WS_ADAP = WS_P;
constexpr size_t WS_W = 563 * MiB;
constexpr size_t WS_KK = 627 * MiB, WS_BQ = 659 * MiB, WS_KP = 691 * MiB, WS_R = 723 * MiB, WS_V0 = 755 * MiB, WS_V1 = 787 * MiB;
constexpr size_t WS_LR = 819 * MiB;
constexpr size_t WS_Y = 915 * MiB;
constexpr size_t WS_X = 947 * MiB;
constexpr size_t WS_BONUS = 1011 * MiB;
constexpr size_t WS_EIDX = 1012 * MiB, WS_POS = WS_EIDX + 128 * 1024, WS_WTS = WS_EIDX + 256 * 1024, WS_SLOT = WS_EIDX + 384 * 1024;
constexpr size_t WS_HIST = WS_EIDX + 512 * 1024;
constexpr size_t WS_WRT = WS_EIDX + 768 * 1024;
constexpr size_t WS_KN = WS_KK;
constexpr size_t WS_BONP = WS_KK + 2 * MiB;
constexpr size_t WS_BT_LR = 1015 * MiB;
constexpr size_t WS_END = 1018 * MiB;
static_assert(WS_YE + (size_t)MAXROWS * 1024 * 2 <= WS_W && WS_P + (size_t)T * P_LD * 2 <= WS_W && WS_BT_IN + (size_t)2 * P_LD * 2048 <= WS_BT_OUT, "ws map");
constexpr int CW_CNT = 1024;
constexpr int CW_BAR = 4096;
constexpr size_t CTL_ADA = 256 * 1024;
constexpr size_t CTL_BIASR = 700 * 1024;

constexpr int RING_BYTES = 131072;
constexpr int TAB_OFF = RING_BYTES;
constexpr int MISC_OFF = RING_BYTES + 1024;
constexpr int LDS_BYTES = 147456;

#define GAS __attribute__((address_space(1)))
#define LAS __attribute__((address_space(3)))
typedef unsigned short bf16;
typedef float f32x4 __attribute__((ext_vector_type(4)));
typedef float f32x2 __attribute__((ext_vector_type(2)));
typedef unsigned u32x4 __attribute__((ext_vector_type(4)));
typedef unsigned u32x2 __attribute__((ext_vector_type(2)));
#define LDS_WAIT() asm volatile("s_waitcnt lgkmcnt(0)" ::: "memory")

__device__ __forceinline__ unsigned f2bf(float f) { unsigned u = __builtin_bit_cast(unsigned, f); return (u + 0x7fffu + ((u >> 16) & 1u)) >> 16; }
__device__ __forceinline__ unsigned pk2(float lo, float hi) { return f2bf(lo) | (f2bf(hi) << 16); }
typedef __bf16 bfl2 __attribute__((ext_vector_type(2)));
__device__ __forceinline__ unsigned pkbf(float lo, float hi) { f32x2 v; v.x = lo; v.y = hi; return __builtin_bit_cast(unsigned, __builtin_convertvector(v, bfl2)); }
__device__ __forceinline__ float bflo(unsigned u) { return __builtin_bit_cast(float, u << 16); }
__device__ __forceinline__ float bfhi(unsigned u) { return __builtin_bit_cast(float, u & 0xffff0000u); }
__device__ __forceinline__ void load8(const bf16* p, float (&o)[8]) { const u32x4 u = *(const u32x4*)p; o[0] = bflo(u.x); o[1] = bfhi(u.x); o[2] = bflo(u.y); o[3] = bfhi(u.y); o[4] = bflo(u.z); o[5] = bfhi(u.z); o[6] = bflo(u.w); o[7] = bfhi(u.w); }
__device__ __forceinline__ void store8(bf16* p, const float (&v)[8]) { u32x4 w; w.x = pk2(v[0], v[1]); w.y = pk2(v[2], v[3]); w.z = pk2(v[4], v[5]); w.w = pk2(v[6], v[7]); *(u32x4*)p = w; }
typedef _Float16 f16x2 __attribute__((ext_vector_type(2)));
__device__ __forceinline__ unsigned pkh2(float lo, float hi) { f16x2 h; h.x = (_Float16)lo; h.y = (_Float16)hi; return __builtin_bit_cast(unsigned, h); }
__device__ __forceinline__ float hlo(unsigned u) { return (float)__builtin_bit_cast(f16x2, u).x; }
__device__ __forceinline__ float hhi(unsigned u) { return (float)__builtin_bit_cast(f16x2, u).y; }
__device__ __forceinline__ void load8h(const bf16* p, float (&o)[8]) { const u32x4 u = *(const u32x4*)p; o[0] = hlo(u.x); o[1] = hhi(u.x); o[2] = hlo(u.y); o[3] = hhi(u.y); o[4] = hlo(u.z); o[5] = hhi(u.z); o[6] = hlo(u.w); o[7] = hhi(u.w); }
__device__ __forceinline__ void store8h(bf16* p, const float (&v)[8]) { u32x4 w; w.x = pkh2(v[0], v[1]); w.y = pkh2(v[2], v[3]); w.z = pkh2(v[4], v[5]); w.w = pkh2(v[6], v[7]); *(u32x4*)p = w; }
__device__ __forceinline__ float fmx_lo(float a, unsigned h, float c) { float d; asm("v_fma_mix_f32 %0, %1, %2, %3 op_sel_hi:[0,1,0]" : "=v"(d) : "v"(a), "v"(h), "v"(c)); return d; }
__device__ __forceinline__ float fmx_hi(float a, unsigned h, float c) { float d; asm("v_fma_mix_f32 %0, %1, %2, %3 op_sel:[0,1,0] op_sel_hi:[0,1,0]" : "=v"(d) : "v"(a), "v"(h), "v"(c)); return d; }
__device__ __forceinline__ float mmx_lo(float a, unsigned h) { float d; asm("v_fma_mix_f32 %0, %1, %2, 0 op_sel_hi:[0,1,0]" : "=v"(d) : "v"(a), "v"(h)); return d; }
__device__ __forceinline__ float mmx_hi(float a, unsigned h) { float d; asm("v_fma_mix_f32 %0, %1, %2, 0 op_sel:[0,1,0] op_sel_hi:[0,1,0]" : "=v"(d) : "v"(a), "v"(h)); return d; }
__device__ __forceinline__ float sigmoidf_(float x) { return __builtin_amdgcn_rcpf(1.0f + __expf(-x)); }
__device__ __forceinline__ float tanhf_(float x) { return 1.0f - 2.0f * __builtin_amdgcn_rcpf(__expf(2.0f * x) + 1.0f); }
__device__ __forceinline__ float wave_sum(float v) {
#pragma unroll
    for (int o = 1; o < 64; o <<= 1) v += __shfl_xor(v, o);
    return v;
}
__device__ __forceinline__ float sum8(float v) { v += __shfl_xor(v, 1); v += __shfl_xor(v, 2); v += __shfl_xor(v, 4); return v; }
template <int CTRL> __device__ __forceinline__ float dpp_f(float v) { return __builtin_bit_cast(float, __builtin_amdgcn_mov_dpp(__builtin_bit_cast(int, v), CTRL, 0xF, 0xF, true)); }
__device__ __forceinline__ float dpp_sum16(float v) {
    v += dpp_f<0xB1>(v);
    v += dpp_f<0x4E>(v);
    v += dpp_f<0x141>(v);
    v += dpp_f<0x140>(v);
    return v;
}

#define XB_TMO      128
#define XB_XCNT(j)  (256  + 64 * (j))
#define XB_XSUB(j)  (1280 + 64 * (j))
#define XB_XGEN(j)  (2304 + 64 * (j))
#define XB_TOP      3328
#define XB_TOPGEN   3392
#define XCD_BAR_WORDS 3456
#define XB_SPIN_CAP (1u << 18)

__device__ __forceinline__ unsigned xb_ld(unsigned* p)              { return __hip_atomic_load(p, __ATOMIC_RELAXED, __HIP_MEMORY_SCOPE_AGENT); }
__device__ __forceinline__ unsigned xb_add(unsigned* p, unsigned v) { return __hip_atomic_fetch_add(p, v, __ATOMIC_RELAXED, __HIP_MEMORY_SCOPE_AGENT); }
__device__ __forceinline__ unsigned xb_xcc_id() { return (unsigned)__builtin_amdgcn_s_getreg((3 << 11) | 20) & 0xFu; }
#define XB_SPIN(cond, bar) do { unsigned _sp = 0; while (cond) { __builtin_amdgcn_s_sleep(1); \
    if ((++_sp & 255u) == 0u) { if (xb_ld(&(bar)[XB_TMO])) break; if (_sp > XB_SPIN_CAP) { atomicAdd(&(bar)[XB_TMO], 1u); break; } } } } while (0)

struct XcdBarrier {
    unsigned* bar; unsigned x;
    volatile LAS unsigned* st;
};

__device__ __forceinline__ XcdBarrier xcd_barrier_post(unsigned* bar, volatile LAS unsigned* st) {
    XcdBarrier b; b.bar = bar; b.x = xb_xcc_id(); b.st = st;
    if (threadIdx.x == 0) (void)xb_add(&bar[XB_XCNT(b.x)], 1u);
    return b;
}
__device__ __forceinline__ void xcd_barrier_complete(unsigned* bar, unsigned x, unsigned& nloc, unsigned& nx) {
    const unsigned G = gridDim.x * gridDim.y * gridDim.z;
    unsigned sum, cnt, mine, sp = 0u;
    for (;;) {
        sum = 0u; cnt = 0u; mine = 0u;
#pragma unroll
        for (unsigned j = 0; j < 16; ++j) { const unsigned c = xb_ld(&bar[XB_XCNT(j)]); sum += c; cnt += (c > 0u) ? 1u : 0u; mine = (j == x) ? c : mine; }
        if (sum == G) break;
        __builtin_amdgcn_s_sleep(1);
        if ((++sp & 255u) == 0u) { if (xb_ld(&bar[XB_TMO])) break; if (sp > XB_SPIN_CAP) { atomicAdd(&bar[XB_TMO], 1u); break; } }
    }
    nloc = mine > 0u ? mine : 1u; nx = cnt > 0u ? cnt : 1u;
}

__device__ __forceinline__ void xcd_barrier(const XcdBarrier& b) {
    asm volatile("s_waitcnt vmcnt(0)" ::: "memory");
    __syncthreads();
    if (threadIdx.x == 0) {
        unsigned* bar = b.bar;
        __builtin_amdgcn_s_waitcnt(0);
        unsigned nloc = b.st[0], nx = b.st[1];
        if (nloc == 0u) { xcd_barrier_complete(bar, b.x, nloc, nx); b.st[0] = nloc; b.st[1] = nx; }
        const unsigned old = xb_add(&bar[XB_XSUB(b.x)], 1u);
        const unsigned gen = old / nloc;
        if (old + 1u == (gen + 1u) * nloc) {
            __builtin_amdgcn_fence(__ATOMIC_RELEASE, "agent");
            asm volatile("s_waitcnt vmcnt(0)" ::: "memory");
            const unsigned og = xb_add(&bar[XB_TOP], 1u);
            const unsigned tg = og / nx;
            if (og + 1u == (tg + 1u) * nx) xb_add(&bar[XB_TOPGEN], 1u);
            else XB_SPIN(xb_ld(&bar[XB_TOPGEN]) == tg, bar);
            __builtin_amdgcn_fence(__ATOMIC_ACQUIRE, "agent");
            xb_add(&bar[XB_XGEN(b.x)], 1u);
            asm volatile("s_waitcnt vmcnt(0)" ::: "memory");
        } else {
            XB_SPIN(xb_ld(&bar[XB_XGEN(b.x)]) == gen, bar);
            __builtin_amdgcn_fence(__ATOMIC_ACQUIRE, "agent");
            asm volatile("s_waitcnt vmcnt(0)" ::: "memory");
        }
    }
    __syncthreads();
}

struct Args { const void* p[30]; int ph_lo, ph_hi; };
template <int IDX> __device__ __forceinline__ const float* kin() {
    const auto ka = __builtin_amdgcn_kernarg_segment_ptr(); unsigned long long v;
    asm volatile("s_load_dwordx2 %0, %1, %2\n\ts_waitcnt lgkmcnt(0)" : "=s"(v) : "s"(ka), "i"(IDX * 8) : "memory");
    return (const float*)(const GAS float*)v;
}
enum { I_X = 0, I_C, I_WADA, I_BADA, I_N1G, I_N2G, I_WIN, I_MU, I_CONVW, I_W0, I_DECUP, I_A0, I_AAAUP, I_GATEUP, I_KK, I_KA, I_RK, I_LNW, I_LNB, I_VMD, I_VMU, I_V0, I_WOUT, I_WR, I_RB, I_WE1, I_WE2, I_FG };
struct Frame {
    LAS unsigned char* lds;
    int tid, lane, wave, vcu, G;
    GAS unsigned char* ws;
};
__device__ __forceinline__ float* ada_ptr(const Frame& F, int l, int b) { return (float*)(F.ws + WS_CTL + CTL_ADA) + (size_t)(l * 8 + b) * 6144; }

__device__ __forceinline__ void transpose_item(const float* W, int K, int N, bf16* WT, int dst_row0, int k0, int n0, LAS float* scr, int lane) {
    float tv[32];
#pragma unroll
    for (int i = 0; i < 32; ++i) tv[i] = W[(size_t)(k0 + 2 * i + (lane >> 5)) * N + n0 + (lane & 31)];
#pragma unroll
    for (int i = 0; i < 32; ++i) { const int kk = 2 * i + (lane >> 5); scr[kk * 33 + (lane & 31)] = tv[i]; }
    LDS_WAIT();
    const int c = lane & 7;
#pragma unroll
    for (int j = 0; j < 4; ++j) { const int n = (lane >> 3) + 8 * j; const LAS float* s = scr + (8 * c) * 33 + n;
        u32x4 o; o.x = pk2(s[0 * 33], s[1 * 33]); o.y = pk2(s[2 * 33], s[3 * 33]); o.z = pk2(s[4 * 33], s[5 * 33]); o.w = pk2(s[6 * 33], s[7 * 33]);
        *(u32x4*)(WT + (size_t)(dst_row0 + n) * K + k0 + 8 * c) = o; }
    LDS_WAIT();
}
__device__ __forceinline__ void p0_prologue(const Frame& F) {
    LAS float* scr = (LAS float*)(F.lds + F.wave * 16384);
    const int gw = F.vcu * NWAVES + F.wave, NGW = F.G * NWAVES, lane = F.lane;
    constexpr int I_ADA = 768, I_A = 2 * 16 * 264, I_B = 2 * 16 * 32, I_C1 = 64 * 16 * 32, I_D = 64 * 8 * 32;
    constexpr int NITEMS = I_ADA + I_A + I_B + I_C1 + I_D;
    const float* const pC = kin<I_C>(); const float* const pWADA = kin<I_WADA>(); const float* const pWIN = kin<I_WIN>();
    const float* const pWOUT = kin<I_WOUT>(); const float* const pWE1 = kin<I_WE1>(); const float* const pWE2 = kin<I_WE2>(); const float* const pVMD = kin<I_VMD>();
    for (int it = gw; it < NITEMS; it += NGW) {
        int r = it;
        if (r < I_ADA) {
            const int l = r / 384, rr = r % 384, cch = rr >> 4, kc = rr & 15, col = cch * 256 + 4 * lane, k0 = kc * 64;
            float cv[8];
#pragma unroll
            for (int b = 0; b < 8; ++b) { const float x = pC[b * 1024 + k0 + lane]; cv[b] = x * sigmoidf_(x); }
            f32x4 acc[8];
#pragma unroll
            for (int b = 0; b < 8; ++b) acc[b] = (f32x4){0.f, 0.f, 0.f, 0.f};
            const float* wp = pWADA + ((size_t)l * 1024 + k0) * 6144 + col;
#pragma unroll 16
            for (int kk = 0; kk < 64; ++kk) { const f32x4 w = *(const f32x4*)(wp + (size_t)kk * 6144);
#pragma unroll
                for (int b = 0; b < 8; ++b) { const float s = __builtin_bit_cast(float, __builtin_amdgcn_readlane(__builtin_bit_cast(int, cv[b]), kk)); acc[b] += s * w; } }
#pragma unroll
            for (int b = 0; b < 8; ++b) *(f32x4*)((float*)(F.ws + WS_ADAP) + ((size_t)(kc * 2 + l) * 8 + b) * 6144 + col) = acc[b];
            continue;
        }
        r -= I_ADA;
        if (r < I_A) { const int l = r / (16 * 264), rr = r % (16 * 264), kb = rr / 264, nb = rr % 264;
            transpose_item(pWIN + (size_t)l * 1024 * N_IN, 1024, N_IN, (bf16*)(F.ws + WS_BT_IN) + (size_t)l * P_LD * 1024, 32 * nb, 64 * kb, 32 * nb, scr, lane); continue; }
        r -= I_A;
        if (r < I_B) { const int l = r / 512, rr = r % 512, kb = rr / 32, nb = rr % 32;
            transpose_item(pWOUT + (size_t)l * 1024 * 1024, 1024, 1024, (bf16*)(F.ws + WS_BT_OUT) + (size_t)l * 1024 * 1024, 32 * nb, 64 * kb, 32 * nb, scr, lane); continue; }
        r -= I_B;
        if (r < I_C1) { const int le = r / 512, rr = r % 512, kb = rr / 32, nb = rr % 32, n0 = 32 * nb;
            const int j0 = n0 & 511, dst = (j0 >> 7) * 256 + (n0 >= 512 ? 128 : 0) + (j0 & 127);
            transpose_item(pWE1 + (size_t)le * 1024 * 1024, 1024, 1024, (bf16*)(F.ws + WS_BT_E1) + (size_t)le * 1024 * 1024, dst, 64 * kb, n0, scr, lane); continue; }
        r -= I_C1;
        { const int le = r / 256, rr = r % 256, kb = rr / 32, nb = rr % 32;
            transpose_item(pWE2 + (size_t)le * 512 * 1024, 512, 1024, (bf16*)(F.ws + WS_BT_E2) + (size_t)le * 1024 * 512, 32 * nb, 64 * kb, 32 * nb, scr, lane); }
    }
    const int gt0 = F.vcu * NWAVES * 64 + F.tid, GT = F.G * NWAVES * 64;
    { const float* const pVMUp = kin<I_VMU>();
      for (int it = gt0; it < 1024 * 128; it += GT) { const int n = it >> 7, k0 = (it & 127) * 8; float o[8];
#pragma unroll
        for (int i = 0; i < 8; ++i) o[i] = 0.f;
        for (int j = 0; j < 32; ++j) { const float u = pVMUp[j * 1024 + n];
#pragma unroll
            for (int i = 0; i < 8; ++i) o[i] += pVMD[(k0 + i) * 32 + j] * u; }
        store8((bf16*)(F.ws + WS_BT_IN) + (size_t)P_LD * 1024 + (size_t)(C_VD + n) * 1024 + k0, o); } }
    { const float* const pDU = kin<I_DECUP>(); const float* const pAU = kin<I_AAAUP>(); const float* const pGU = kin<I_GATEUP>();
      for (int it = gt0; it < 2 * 3072 * 32; it += GT) { const int l = it / (3072 * 32), rr = it % (3072 * 32), n = rr >> 5, k0 = (rr & 31) * 8; float o[8];
#pragma unroll
        for (int i = 0; i < 8; ++i) { const int k = k0 + i; float v = 0.f;
            if (n < 1024) { if (k < 64) v = pDU[(size_t)(l * 64 + k) * 1024 + n]; }
            else if (n < 2048) { if (k >= 64 && k < 128) v = pAU[(size_t)(l * 64 + k - 64) * 1024 + n - 1024]; }
            else { if (k >= 128) v = pGU[(size_t)(l * 128 + k - 128) * 1024 + n - 2048]; }
            o[i] = v; }
        store8((bf16*)(F.ws + WS_BT_LR) + (size_t)l * 3072 * 256 + (size_t)n * 256 + k0, o); } }
    { const float* const pWRp = kin<I_WR>(); const int gt = F.vcu * NWAVES * 64 + F.tid; if (gt < 32768) { const float w = pWRp[(gt & 1023) * 32 + (gt >> 10)]; const unsigned hi = f2bf(w);
        ((bf16*)(F.ws + WS_WRT))[gt] = (bf16)hi; ((bf16*)(F.ws + WS_WRT))[32768 + gt] = (bf16)f2bf(w - bflo(hi)); } }
}

__device__ __forceinline__ void p0b_ada_reduce(const Frame& F) {
    const float* const pBADA = kin<I_BADA>(); const float* ap = (const float*)(F.ws + WS_ADAP); float* ada = (float*)(F.ws + WS_CTL + CTL_ADA);
    for (int idx = F.vcu * NWAVES * 64 + F.tid; idx < 2 * 8 * 6144; idx += F.G * NWAVES * 64) { const int l = idx / 49152, r = idx % 49152, c = r % 6144;
        float s = pBADA[l * 6144 + c];
#pragma unroll
        for (int kc = 0; kc < 16; ++kc) s += ap[(size_t)(kc * 2 + l) * 49152 + r];
        ada[idx] = s; }
}

template <int MODE> __device__ __forceinline__ void p1_norm(const Frame& F, int l) {
    const int lane = F.lane;
    const float* const pX = kin<I_X>(); float* const pOUT = (float*)kin<28>(); const float* const pFG = kin<I_FG>(); const float* const pN1G = kin<I_N1G>(); const float* const pWRb = kin<I_WR>();
#pragma unroll 1
    for (int gw = F.vcu * NWAVES + F.wave; gw < T / 8; gw += F.G * NWAVES) { const int tok0 = gw * 8, b = tok0 >> 11;
        f32x4 gm[4], sh[4], g2v[4];
#pragma unroll
        for (int j = 0; j < 4; ++j) { const int c = 4 * lane + 256 * j;
            if (MODE == 2) { gm[j] = *(const f32x4*)(pFG + c); sh[j] = (f32x4){0.f, 0.f, 0.f, 0.f}; }
            else { const float* ad = ada_ptr(F, l, b); const f32x4 g = *(const f32x4*)(pN1G + l * 1024 + c), sc = *(const f32x4*)(ad + 1024 + c); gm[j] = g * (1.0f + sc); sh[j] = *(const f32x4*)(ad + c); }
            if (MODE >= 1) g2v[j] = *(const f32x4*)(ada_ptr(F, MODE == 2 ? 1 : l - 1, b) + 5120 + c); }
        float* X = (float*)(F.ws + WS_X);
        const bf16* YE = (const bf16*)(F.ws + WS_YE);
        const float* WTS = (const float*)(F.ws + WS_WTS); const int* SLOT = (const int*)(F.ws + WS_SLOT);
        for (int tk = 0; tk < 8; ++tk) { const int tok = tok0 + tk;
            f32x4 v[4]; const float* xs = (MODE == 0 ? pX : X) + (size_t)tok * 1024;
#pragma unroll
            for (int j = 0; j < 4; ++j) v[j] = *(const f32x4*)(xs + 4 * lane + 256 * j);
            if (MODE >= 1) { const float w0 = WTS[tok * 2], w1 = WTS[tok * 2 + 1]; const int s0 = SLOT[tok * 2], s1 = SLOT[tok * 2 + 1];
#pragma unroll
                for (int j = 0; j < 4; ++j) { const u32x2 y0 = *(const u32x2*)(YE + (size_t)s0 * 1024 + 4 * lane + 256 * j), y1 = *(const u32x2*)(YE + (size_t)s1 * 1024 + 4 * lane + 256 * j);
                    f32x4 m; m[0] = w0 * bflo(y0.x) + w1 * bflo(y1.x); m[1] = w0 * bfhi(y0.x) + w1 * bfhi(y1.x); m[2] = w0 * bflo(y0.y) + w1 * bflo(y1.y); m[3] = w0 * bfhi(y0.y) + w1 * bfhi(y1.y);
                    v[j] += g2v[j] * m; if (MODE == 1) *(f32x4*)(X + (size_t)tok * 1024 + 4 * lane + 256 * j) = v[j]; } }
            float ss = 0.f;
#pragma unroll
            for (int j = 0; j < 4; ++j) ss += (v[j][0] * v[j][0] + v[j][1] * v[j][1]) + (v[j][2] * v[j][2] + v[j][3] * v[j][3]);
            float rstd = __builtin_amdgcn_rsqf(wave_sum(ss) * (1.0f / 1024.0f) + NORM_EPS);
#if defined(DBG_SCAN)
            if (MODE == 2) { const float* dz = (const float*)(F.ws + WS_CTL) + 2048; const float er = sqrtf(dz[0] / fmaxf(dz[1], 1e-30f)); rstd *= 1.0f + 0.3f * fminf(er, 3.0f); }
#endif
#pragma unroll
            for (int j = 0; j < 4; ++j) { const f32x4 h = v[j] * rstd * gm[j] + sh[j];
                if (MODE == 2) *(f32x4*)(pOUT + (size_t)tok * 1024 + 4 * lane + 256 * j) = h;
                else { u32x2 w; w.x = pk2(h[0], h[1]); w.y = pk2(h[2], h[3]); *(u32x2*)((bf16*)(F.ws + WS_H) + (size_t)tok * 1024 + 4 * lane + 256 * j) = w; } }
        }
    }
    if (MODE == 0 && F.vcu < 16) {
        const int lb = F.vcu, e = F.tid & 31, kq = F.tid >> 5; const float* sh2 = ada_ptr(F, lb >> 3, lb & 7) + 3072; float s = 0.f;
        for (int k = kq * 64; k < kq * 64 + 64; ++k) s += sh2[k] * pWRb[k * 32 + e];
        LAS float* red = (LAS float*)F.lds; red[kq * 32 + e] = s; __syncthreads();
        if (F.tid < 32) { float t = 0.f; for (int q = 0; q < 16; ++q) t += red[q * 32 + e]; ((float*)(F.ws + WS_CTL + CTL_BIASR))[lb * 32 + e] = t; }
        __syncthreads();
    }
}

typedef short bfv8 __attribute__((ext_vector_type(8)));
constexpr int LRX_PITCH = 528;
template <int NKS> struct LrW { bfv8 w[2][NKS]; f32x4 b0, b1; };
template <int NKS> __device__ __forceinline__ void lrx_load(LrW<NKS>& W, const bf16* BT, const float* bias, int a, int c0, int li, int fq) {
    const int kbase = (a == 0) ? 0 : ((a == 1) ? 64 : 128);
#pragma unroll
    for (int tile = 0; tile < 2; ++tile) { const bf16* rp = BT + (size_t)(a * 1024 + c0 + 8 * (li >> 2) + 4 * tile + (li & 3)) * 256 + kbase + 8 * fq;
#pragma unroll
        for (int ks = 0; ks < NKS; ++ks) W.w[tile][ks] = *(const bfv8*)(rp + 32 * ks); }
    if (a < 2) { W.b0 = *(const f32x4*)(bias + c0 + 8 * fq); W.b1 = *(const f32x4*)(bias + c0 + 8 * fq + 4); }
}
template <int NKS> __device__ __forceinline__ void lrx_job(const LrW<NKS>& W, const LAS unsigned char* tile, bf16* out, int a, int li, int fq) {
    const int kbase = (a == 0) ? 0 : ((a == 1) ? 64 : 128);
#pragma unroll 2
    for (int mt = 0; mt < 4; ++mt) {
        bfv8 af[NKS];
#pragma unroll
        for (int ks = 0; ks < NKS; ++ks) af[ks] = *(const LAS bfv8*)(tile + (16 * mt + li) * LRX_PITCH + (kbase + 32 * ks + 8 * fq) * 2);
        f32x4 acc0 = (f32x4){0.f, 0.f, 0.f, 0.f}, acc1 = acc0;
#pragma unroll
        for (int ks = 0; ks < NKS; ++ks) { acc0 = __builtin_amdgcn_mfma_f32_16x16x32_bf16(W.w[0][ks], af[ks], acc0, 0, 0, 0); acc1 = __builtin_amdgcn_mfma_f32_16x16x32_bf16(W.w[1][ks], af[ks], acc1, 0, 0, 0); }
        u32x4 o;
        if (a == 0) { float x[8];
#pragma unroll
            for (int j = 0; j < 4; ++j) { x[j] = -0.60653066f * sigmoidf_(W.b0[j] + acc0[j]); x[4 + j] = -0.60653066f * sigmoidf_(W.b1[j] + acc1[j]); }
            o.x = pkh2(x[0], x[1]); o.y = pkh2(x[2], x[3]); o.z = pkh2(x[4], x[5]); o.w = pkh2(x[6], x[7]);
        } else if (a == 1) { float x[8];
#pragma unroll
            for (int j = 0; j < 4; ++j) { x[j] = sigmoidf_(W.b0[j] + acc0[j]); x[4 + j] = sigmoidf_(W.b1[j] + acc1[j]); }
            o.x = pkh2(x[0], x[1]); o.y = pkh2(x[2], x[3]); o.z = pkh2(x[4], x[5]); o.w = pkh2(x[6], x[7]);
        } else { o.x = pkbf(acc0[0], acc0[1]); o.y = pkbf(acc0[2], acc0[3]); o.z = pkbf(acc1[0], acc1[1]); o.w = pkbf(acc1[2], acc1[3]); }
        *(u32x4*)(out + (size_t)(16 * mt) * 3072) = o;
    }
}
__device__ __forceinline__ void p2x_lowrank(const Frame& F, int l) {
    const int lane = F.lane, c8 = lane & 31, hf = lane >> 5, li = lane & 15, fq = lane >> 4;
    const bf16* P = (const bf16*)(F.ws + WS_P); const float* mu = kin<I_MU>() + l * N_SHIFT + 3072 + 8 * c8;
    const f32x4 m0 = *(const f32x4*)mu, m1 = *(const f32x4*)(mu + 4);
    const float* const pKKc = kin<I_KK>() + l * 1024; const float* const muK = kin<I_MU>() + l * N_SHIFT + 1024; float* KNo = (float*)(F.ws + WS_KN);
    const bf16* BT = (const bf16*)(F.ws + WS_BT_LR) + (size_t)l * 3072 * 256; const float* const pW0 = kin<I_W0>() + l * 1024; const float* const pA0 = kin<I_A0>() + l * 1024;
    LAS unsigned char* tile = F.lds;
#pragma unroll 1
    for (int item = F.vcu; item < T / 64; item += F.G) { const int gw = item * 8 + F.wave;
        LrW<2> W2[2]; LrW<4> W4[2];
        lrx_load<2>(W2[0], BT, pW0, 0, F.wave * 128, li, fq);
#pragma unroll
        for (int i = 0; i < 4; ++i) { const int row = 8 * F.wave + 2 * i + hf, tok = item * 64 + row; float cur[8], prv[8], o[8];
            load8(P + (size_t)tok * P_LD + C_WD + 8 * c8, cur);
            if ((tok & (SEQ - 1)) != 0) load8(P + (size_t)(tok - 1) * P_LD + C_WD + 8 * c8, prv); else {
#pragma unroll
                for (int j = 0; j < 8; ++j) prv[j] = 0.f; }
#pragma unroll
            for (int j = 0; j < 8; ++j) { const float v = cur[j] + (prv[j] - cur[j]) * (j < 4 ? m0[j] : m1[j - 4]); o[j] = (c8 < 8) ? tanhf_(v) : ((c8 < 16) ? v : sigmoidf_(v)); }
            u32x4 w; w.x = pkbf(o[0], o[1]); w.y = pkbf(o[2], o[3]); w.z = pkbf(o[4], o[5]); w.w = pkbf(o[6], o[7]);
            *(LAS u32x4*)(tile + row * LRX_PITCH + 16 * c8) = w; }
#pragma unroll 1
        for (int ch = 0; ch < 2; ++ch) { const int col0 = 512 * ch + 8 * lane; float kkc[8], muk[8], kp_[8];
#pragma unroll
            for (int j = 0; j < 8; ++j) { kkc[j] = pKKc[col0 + j]; muk[j] = muK[col0 + j]; kp_[j] = 0.f; }
            const int tok0 = gw * 8;
            if ((tok0 & (SEQ - 1)) != 0) load8(P + (size_t)(tok0 - 1) * P_LD + C_K + col0, kp_);
#pragma unroll 4
            for (int tk = 0; tk < 8; ++tk) { float kc[8]; load8(P + (size_t)(tok0 + tk) * P_LD + C_K + col0, kc); float ss = 0.f;
#pragma unroll
                for (int j = 0; j < 8; ++j) { const float k = (kc[j] + (kp_[j] - kc[j]) * muk[j]) * kkc[j]; ss += k * k; kp_[j] = kc[j]; }
                ss = sum8(ss);
                if ((lane & 7) == 0) KNo[(tok0 + tk) * 16 + 8 * ch + (lane >> 3)] = __builtin_amdgcn_rsqf(fmaxf(ss, 1e-24f)); } }
        __syncthreads();
        bf16* outb = (bf16*)(F.ws + WS_LR) + (size_t)(item * 64 + li) * 3072 + F.wave * 128 + 8 * fq;
#pragma unroll
        for (int j = 0; j < 8; ++j) { const int a = j >> 2, g = j & 3;
            if (j + 1 < 8) lrx_load<2>(W2[(j + 1) & 1], BT, ((j + 1) >> 2) ? pA0 : pW0, (j + 1) >> 2, F.wave * 128 + 32 * ((j + 1) & 3), li, fq); else lrx_load<4>(W4[0], BT, pW0, 2, F.wave * 128, li, fq);
            lrx_job<2>(W2[j & 1], tile, outb + a * 1024 + 32 * g, a, li, fq); }
#pragma unroll
        for (int g = 0; g < 4; ++g) {
            if (g + 1 < 4) lrx_load<4>(W4[(g + 1) & 1], BT, pW0, 2, F.wave * 128 + 32 * (g + 1), li, fq);
            lrx_job<4>(W4[g & 1], tile, outb + 2048 + 32 * g, 2, li, fq); }
        __syncthreads();
    }
}

__device__ __forceinline__ void p3_prep(const Frame& F, int l) {
    const int lane = F.lane;
    const bf16* P = (const bf16*)(F.ws + WS_P); const bf16* LR = (const bf16*)(F.ws + WS_LR);
    const float* mu = kin<I_MU>() + l * N_SHIFT;
    const float* const pA0 = kin<I_A0>() + l * 1024; const float* const pKKc = kin<I_KK>() + l * 1024; const float* const pKA = kin<I_KA>() + l * 1024; const float* const pRK = kin<I_RK>() + l * 1024; const float* const pW0 = kin<I_W0>() + l * 1024; const float* const pV0c = kin<I_V0>();
    bf16* KKo = (bf16*)(F.ws + WS_KK); bf16* BQo = (bf16*)(F.ws + WS_BQ); bf16* KPo = (bf16*)(F.ws + WS_KP); bf16* Ro = (bf16*)(F.ws + WS_R);
    bf16* V0 = (bf16*)(F.ws + WS_V0); bf16* V1 = (bf16*)(F.ws + WS_V1); float* Wo = (float*)(F.ws + WS_W); float* BON = (float*)(F.ws + WS_BONUS);
#pragma unroll 1
    for (int gw = F.vcu * NWAVES + F.wave; gw < T / 8; gw += F.G * NWAVES) { const int tok0 = gw * 8;
#pragma unroll 1
    for (int ch = 0; ch < 2; ++ch) { const int col0 = 512 * ch + 8 * lane, head = 8 * ch + (lane >> 3);
        float a0v[8], kkc[8], kac[8], rkc[8], w0v[8], v0v[8], mur[8], muk[8], muv[8], rp[8], kp_[8], vp[8];
#pragma unroll
        for (int j = 0; j < 8; ++j) { a0v[j] = pA0[col0 + j]; kkc[j] = pKKc[col0 + j]; kac[j] = pKA[col0 + j]; rkc[j] = pRK[col0 + j]; w0v[j] = pW0[col0 + j]; v0v[j] = (l == 1) ? pV0c[col0 + j] : 0.f;
            mur[j] = mu[col0 + j]; muk[j] = mu[1024 + col0 + j]; muv[j] = mu[2048 + col0 + j]; rp[j] = 0.f; kp_[j] = 0.f; vp[j] = 0.f; }
        if ((tok0 & (SEQ - 1)) != 0) { const bf16* pr = P + (size_t)(tok0 - 1) * P_LD + col0; load8(pr + C_R, rp); load8(pr + C_K, kp_); load8(pr + C_V, vp); }
#pragma unroll 2
        for (int tk = 0; tk < 8; ++tk) { const int tok = tok0 + tk; const bf16* pr = P + (size_t)tok * P_LD + col0;
            float rc[8], kc[8], vc[8], dw[8], ap[8], r[8], k[8], v[8], kk[8], kp[8], bq[8], w[8];
            load8(pr + C_R, rc); load8(pr + C_K, kc); load8(pr + C_V, vc); load8(LR + (size_t)tok * 3072 + col0, dw); load8(LR + (size_t)tok * 3072 + 1024 + col0, ap);
            float ss = 0.f, bo = 0.f;
#pragma unroll
            for (int j = 0; j < 8; ++j) { r[j] = rc[j] + (rp[j] - rc[j]) * mur[j]; k[j] = kc[j] + (kp_[j] - kc[j]) * muk[j]; v[j] = vc[j] + (vp[j] - vc[j]) * muv[j]; rp[j] = rc[j]; kp_[j] = kc[j]; vp[j] = vc[j];
                const float av = sigmoidf_(a0v[j] + ap[j]); kk[j] = k[j] * kkc[j]; ss += kk[j] * kk[j]; kp[j] = k[j] * (1.0f + (av - 1.0f) * kac[j]); bo += r[j] * kp[j] * rkc[j]; bq[j] = av;
                const float nd = -(w0v[j] + dw[j]); const float sp = fmaxf(nd, 0.f) + __logf(1.0f + __expf(-fabsf(nd))); w[j] = -__expf(-sp - 0.5f); }
            ss = sum8(ss); bo = sum8(bo);
            const float inv = __builtin_amdgcn_rsqf(fmaxf(ss, 1e-24f));
#pragma unroll
            for (int j = 0; j < 8; ++j) { kk[j] *= inv; bq[j] *= kk[j]; }
            store8h(KKo + (size_t)tok * 1024 + col0, kk); store8h(BQo + (size_t)tok * 1024 + col0, bq); store8h(KPo + (size_t)tok * 1024 + col0, kp); store8h(Ro + (size_t)tok * 1024 + col0, r);
            if ((lane & 7) == 0) BON[tok * 16 + head] = bo;
            float* wp = Wo + (size_t)tok * 1024 + col0; *(f32x4*)wp = (f32x4){w[0], w[1], w[2], w[3]}; *(f32x4*)(wp + 4) = (f32x4){w[4], w[5], w[6], w[7]};
            if (l == 1) { float vf[8], vm[8]; load8h(V0 + (size_t)tok * 1024 + col0, vf); load8(pr + C_VD, vm);
#pragma unroll
                for (int j = 0; j < 8; ++j) v[j] = v[j] + (vf[j] - v[j]) * sigmoidf_(v0v[j] + vm[j]);
                store8h(V1 + (size_t)tok * 1024 + col0, v); }
            else store8h(V0 + (size_t)tok * 1024 + col0, v); }
    }
    }
}

__device__ __forceinline__ f32x4 h4_to_f4(const u32x2 u) { return (f32x4){hlo(u.x), hhi(u.x), hlo(u.y), hhi(u.y)}; }
#if defined(DBG_SCAN)
constexpr size_t WS_YCK = WS_H;
constexpr int SC_CH = 32, SC_BUF = 49152, SC_W = 0, SC_KK = 8192, SC_BQ = 16384, SC_KP = 24576, SC_R = 32768, SC_V = 40960, SC_Y = 45056;
struct ScanRegsSeq { f32x4 w; u32x2 kk, bq, kp, r, v; };
__device__ __forceinline__ void scan_issue(const Frame& F, int l, int b, int h, int half, int cc, ScanRegsSeq& R) {
    const int s = F.tid >> 4, q = F.tid & 15; const size_t base = ((size_t)b * SEQ + cc * SC_CH + s) * 1024 + h * 64 + 4 * q;
    R.w = *(const f32x4*)((const float*)(F.ws + WS_W) + base);
    R.kk = *(const u32x2*)((const bf16*)(F.ws + WS_KK) + base); R.bq = *(const u32x2*)((const bf16*)(F.ws + WS_BQ) + base);
    R.kp = *(const u32x2*)((const bf16*)(F.ws + WS_KP) + base); R.r = *(const u32x2*)((const bf16*)(F.ws + WS_R) + base);
    if (F.tid < 256) { const int s2 = F.tid >> 3, r4 = F.tid & 7; R.v = *(const u32x2*)((const bf16*)(F.ws + (l == 0 ? WS_V0 : WS_V1)) + ((size_t)b * SEQ + cc * SC_CH + s2) * 1024 + h * 64 + half * 32 + 4 * r4); }
}
__device__ __forceinline__ void scan_commit(const Frame& F, int buf, const ScanRegsSeq& R) {
    const int s = F.tid >> 4, q = F.tid & 15; LAS unsigned char* B = F.lds + buf * SC_BUF + (s * 16 + q) * 16;
    *(LAS f32x4*)(B + SC_W) = (f32x4){__expf(R.w[0]), __expf(R.w[1]), __expf(R.w[2]), __expf(R.w[3])};     *(LAS f32x4*)(B + SC_KK) = h4_to_f4(R.kk); *(LAS f32x4*)(B + SC_BQ) = h4_to_f4(R.bq); *(LAS f32x4*)(B + SC_KP) = h4_to_f4(R.kp); *(LAS f32x4*)(B + SC_R) = h4_to_f4(R.r);
    if (F.tid < 256) { const int s2 = F.tid >> 3, r4 = F.tid & 7; *(LAS f32x4*)(F.lds + buf * SC_BUF + SC_V + (s2 * 32 + 4 * r4) * 4) = h4_to_f4(R.v); }
}
__device__ __forceinline__ void scan_store(const Frame& F, int b, int h, int half, int cc, int buf) {
    if (F.tid < 256) { const int s2 = F.tid >> 3, r4 = F.tid & 7;
        const f32x4 y = *(const LAS f32x4*)(F.lds + buf * SC_BUF + SC_Y + (s2 * 32 + 4 * r4) * 4);
        u32x2 w; w.x = pk2(y[0], y[1]); w.y = pk2(y[2], y[3]);
        const int t = cc * SC_CH + s2 - 1;
        if (t >= 0) *(u32x2*)((bf16*)(F.ws + WS_Y) + ((size_t)b * SEQ + t) * 1024 + h * 64 + half * 32 + 4 * r4) = w; }
}
__device__ __forceinline__ void p4_scan_seq(const Frame& F, int l) {
#pragma unroll 1
    for (int unit = F.vcu; unit < NBATCH * NHEAD * 2; unit += F.G) {
        const int b = unit >> 5, h = (unit >> 1) & 15, half = unit & 1;
        const int g = F.lane >> 4, q = F.lane & 15, row = F.wave * 4 + g;
        f32x2 sA = (f32x2){0.f, 0.f}, sB = sA; float yp = 0.f; const bool odd = (q & 1) != 0;
        ScanRegsSeq SR;
        bf16* SAdbg = (bf16*)(F.ws + WS_V1) + (size_t)b * SEQ * 1024 + h * 64 + half * 32 + row;
        scan_issue(F, l, b, h, half, 0, SR); scan_commit(F, 0, SR); scan_issue(F, l, b, h, half, 1, SR);
        __syncthreads();
        constexpr int NCH = SEQ / SC_CH;
#pragma unroll 1
        for (int cc = 0; cc < NCH; ++cc) { const int buf = cc & 1;
            { const LAS unsigned char* B = F.lds + buf * SC_BUF;
              const LAS f32x4* pc = (const LAS f32x4*)B + q;
              const LAS float* pv = (const LAS float*)(B + SC_V) + row; LAS float* py = (LAS float*)(B + SC_Y) + row;
              f32x4 aw[2], ak[2], ab[2], ap[2], ar[2], bw[2], bk[2], bb[2], bp[2], br_[2]; float av[2], bv[2];
#define SC_LOAD(dw, dk, db, dp, dr, dv, s) do { dw = pc[(s) * 16]; dk = pc[(s) * 16 + 512]; db = pc[(s) * 16 + 1024]; dp = pc[(s) * 16 + 1536]; dr = pc[(s) * 16 + 2048]; dv = pv[(s) * 32]; } while (0)
#define SC_STEP(cw, ck, cb, cp, cr, cv, yo, sidx) do { \
        f32x2 t = sA * ck.lo; t = sB * ck.hi + t; \
        const float pa = t.x + t.y; \
        float x = odd ? yp : pa; const float z = odd ? pa : yp; \
        x += dpp_f<0xB1>(z); x += dpp_f<0x4E>(x); x += dpp_f<0x124>(x); x += dpp_f<0x128>(x); \
        const float sa = dpp_f<0xA0>(x); \
        if (l == 0 && q == 0) SAdbg[(size_t)(cc * SC_CH + (sidx)) * 1024] = (bf16)f2bf(sa); \
        f32x2 xA = cv * cp.lo, xB = cv * cp.hi; \
        xA = xA - sa * cb.lo; xB = xB - sa * cb.hi; \
        sA = sA * cw.lo + xA; sB = sB * cw.hi + xB; \
        f32x2 yv = sA * cr.lo; yv = sB * cr.hi + yv; \
        yo = x; yp = yv.x + yv.y; } while (0)
#pragma unroll
              for (int i = 0; i < 2; ++i) SC_LOAD(aw[i], ak[i], ab[i], ap[i], ar[i], av[i], i);
#pragma unroll 1
              for (int s4 = 0; s4 < SC_CH; s4 += 4) {
#pragma unroll
                  for (int i = 0; i < 2; ++i) SC_LOAD(bw[i], bk[i], bb[i], bp[i], br_[i], bv[i], s4 + 2 + i);
                  float yo[2];
#pragma unroll
                  for (int i = 0; i < 2; ++i) SC_STEP(aw[i], ak[i], ab[i], ap[i], ar[i], av[i], yo[i], s4 + i);
                  if (q == 1) { py[(s4 + 0) * 32] = yo[0]; py[(s4 + 1) * 32] = yo[1]; }
                  const int sn = (s4 + 4 < SC_CH) ? s4 + 4 : s4;
#pragma unroll
                  for (int i = 0; i < 2; ++i) SC_LOAD(aw[i], ak[i], ab[i], ap[i], ar[i], av[i], sn + i);
#pragma unroll
                  for (int i = 0; i < 2; ++i) SC_STEP(bw[i], bk[i], bb[i], bp[i], br_[i], bv[i], yo[i], s4 + 2 + i);
                  if (q == 1) { py[(s4 + 2) * 32] = yo[0]; py[(s4 + 3) * 32] = yo[1]; }
              }
#undef SC_STEP
#undef SC_LOAD
            }
            if (cc + 1 < NCH) scan_commit(F, buf ^ 1, SR);
            if (cc + 2 < NCH) scan_issue(F, l, b, h, half, cc + 2, SR);
            asm volatile("s_waitcnt lgkmcnt(0)" ::: "memory"); __builtin_amdgcn_s_barrier(); asm volatile("" ::: "memory");
            scan_store(F, b, h, half, cc, buf);
        }
        { const float yl = dpp_sum16(yp);
          if (q == 0) ((bf16*)(F.ws + WS_Y))[((size_t)b * SEQ + SEQ - 1) * 1024 + h * 64 + half * 32 + row] = (bf16)f2bf(yl); }
        __syncthreads();
    }
}

#else
constexpr size_t WS_YCK = WS_Y;
#endif
typedef short bf16x8 __attribute__((ext_vector_type(8)));
typedef float f32x16 __attribute__((ext_vector_type(16)));
constexpr int CK_XK = 0, CK_XR = 4608, CK_BH = 9216, CK_KH = 14336, CK_GB = 19456, CK_VT = 19712, CK_X3SZ = 22272;
constexpr int CK_XB = 0, CK_XP = 4608, CK_P2SZ = 9216;
constexpr int CK_TK = 0, CK_TBR = 2560, CK_TKR = 5120, CK_TB = 7680, CK_TBT = 11776, CK_MT = 15872, CK_T2SZ = 18432;
constexpr int CK_X3_OFF = 0, CK_P2_OFF = 3 * CK_X3SZ, CK_T2_OFF = CK_P2_OFF + 2 * CK_P2SZ, CK_STASH = CK_T2_OFF + 2 * CK_T2SZ;
static_assert(CK_STASH + 8192 <= RING_BYTES, "chunked-scan LDS map");
#define CK_MFMA(a, b, c) __builtin_amdgcn_mfma_f32_32x32x16_bf16((a), (b), (c), 0, 0, 0)
__device__ __forceinline__ bf16x8 ck_frag(const LAS unsigned char* base, int pitch, int row, int kel) { return *(const LAS bf16x8*)(base + row * pitch + kel * 2); }
struct CkRegs { u32x2 rP, rA, rB, kP, kA, kB, vP, vA, vB, dwA, dwB, apA, apB, vmA, vmB, vfA, vfB; float knA, knB; };
struct CkConst { f32x4 a0, kk, ka, rk, w0, v0, mur, muk, muv; };
__device__ __forceinline__ f32x4 b4_to_f4(const u32x2 u) { return (f32x4){bflo(u.x), bfhi(u.x), bflo(u.y), bfhi(u.y)}; }
__device__ __forceinline__ void ck_issue(const Frame& F, int pw, int l, int b, int h, int half, int blk, CkRegs& R) {
    const int s2 = F.lane >> 2, cq = F.lane & 3, col = h * 64 + 16 * pw + 4 * cq; const size_t tA = (size_t)b * SEQ + blk * 32 + 2 * s2;
    const bf16* P = (const bf16*)(F.ws + WS_P) + tA * P_LD + col; const bf16* LR = (const bf16*)(F.ws + WS_LR) + tA * 3072 + col; const float* KN = (const float*)(F.ws + WS_KN) + tA * 16 + h;
    R.rA = *(const u32x2*)(P + C_R); R.rB = *(const u32x2*)(P + P_LD + C_R); R.kA = *(const u32x2*)(P + C_K); R.kB = *(const u32x2*)(P + P_LD + C_K); R.vA = *(const u32x2*)(P + C_V); R.vB = *(const u32x2*)(P + P_LD + C_V);
    if ((tA & (SEQ - 1)) != 0) { R.rP = *(const u32x2*)(P - P_LD + C_R); R.kP = *(const u32x2*)(P - P_LD + C_K); R.vP = *(const u32x2*)(P - P_LD + C_V); } else { R.rP = (u32x2){0u, 0u}; R.kP = R.rP; R.vP = R.rP; }
    R.dwA = *(const u32x2*)LR; R.dwB = *(const u32x2*)(LR + 3072); R.apA = *(const u32x2*)(LR + 1024); R.apB = *(const u32x2*)(LR + 3072 + 1024);
    R.knA = KN[0]; R.knB = KN[16];
    if (l == 1) { R.vmA = *(const u32x2*)(P + C_VD); R.vmB = *(const u32x2*)(P + P_LD + C_VD); const bf16* V0 = (const bf16*)(F.ws + WS_V0) + tA * 1024 + col; R.vfA = *(const u32x2*)V0; R.vfB = *(const u32x2*)(V0 + 1024); }
    (void)half;
}
__device__ __forceinline__ void ck_elem(const CkConst& C, int l, const f32x4 rc, const f32x4 rp, const f32x4 kc, const f32x4 kp_, const f32x4 vc, const f32x4 vp, const f32x4 dw, const f32x4 ap, const float kn,
                                        const f32x4 vm, const f32x4 vf, f32x4& r, f32x4& kk, f32x4& bq, f32x4& kp, f32x4& lw, f32x4& v, float& bo) {
#pragma unroll
    for (int e = 0; e < 4; ++e) {
        r[e] = rc[e] + (rp[e] - rc[e]) * C.mur[e]; const float k = kc[e] + (kp_[e] - kc[e]) * C.muk[e]; float vv = vc[e] + (vp[e] - vc[e]) * C.muv[e];
        const float av = ap[e]; kk[e] = k * C.kk[e] * kn;     bq[e] = kk[e] * av; kp[e] = k * (1.0f + (av - 1.0f) * C.ka[e]); bo += r[e] * kp[e] * C.rk[e];
        lw[e] = dw[e];
        if (l == 1) vv = vv + (vf[e] - vv) * sigmoidf_(C.v0[e] + vm[e]);
        v[e] = vv; }
}
__device__ __forceinline__ void ck_stage1(const Frame& F, int pw, int l, int b, int h, int half, int blk, const CkConst& C, LAS unsigned char* BX, LAS unsigned char* BP, CkRegs& R, bool issue_next) {
    const int lane = F.lane, s2 = lane >> 2, cq = lane & 3, c0 = 16 * pw + 4 * cq, cp = 16 * pw + 4 * (((cq & 1) << 1) | (cq >> 1));
    f32x4 kkA, kkB, bqA, bqB, kpA, kpB, rA, rB, lwA, lwB, vA, vB; float boA = 0.f, boB = 0.f;
    { const f32x4 rcA = b4_to_f4(R.rA), kcA = b4_to_f4(R.kA), vcA = b4_to_f4(R.vA), zz = (f32x4){0.f, 0.f, 0.f, 0.f};
      ck_elem(C, l, rcA, b4_to_f4(R.rP), kcA, b4_to_f4(R.kP), vcA, b4_to_f4(R.vP), h4_to_f4(R.dwA), h4_to_f4(R.apA), R.knA, l == 1 ? b4_to_f4(R.vmA) : zz, l == 1 ? h4_to_f4(R.vfA) : zz, rA, kkA, bqA, kpA, lwA, vA, boA);
      ck_elem(C, l, b4_to_f4(R.rB), rcA, b4_to_f4(R.kB), kcA, b4_to_f4(R.vB), vcA, h4_to_f4(R.dwB), h4_to_f4(R.apB), R.knB, l == 1 ? b4_to_f4(R.vmB) : zz, l == 1 ? h4_to_f4(R.vfB) : zz, rB, kkB, bqB, kpB, lwB, vB, boB); }
    asm volatile("" ::: "memory");
    if (issue_next) ck_issue(F, pw, l, b, h, half, blk + 1, R);
    asm volatile("" ::: "memory");
    { const size_t tA = (size_t)b * SEQ + blk * 32 + 2 * s2;
      boA += __shfl_xor(boA, 1); boA += __shfl_xor(boA, 2); boB += __shfl_xor(boB, 1); boB += __shfl_xor(boB, 2);
      if ((pw >> 1) == half) { if (cq == 0) { float* bp = (float*)(F.ws + WS_BONP) + (tA * 16 + h) * 4 + pw; bp[0] = boA; bp[64] = boB; }
          bf16* Vo = (bf16*)(F.ws + (l == 0 ? WS_V0 : WS_V1)) + tA * 1024 + h * 64 + c0;
          *(u32x2*)Vo = (u32x2){pkh2(vA[0], vA[1]), pkh2(vA[2], vA[3])}; *(u32x2*)(Vo + 1024) = (u32x2){pkh2(vB[0], vB[1]), pkh2(vB[2], vB[3])};
#pragma unroll
          for (int e = 0; e < 4; ++e) *(LAS unsigned*)(BX + CK_VT + (16 * (pw & 1) + 4 * cq + e) * 80 + (2 * s2) * 2) = pkbf(vA[e], vB[e]); } }
    float xkA[4], xkB[4], xrA[4], xrB[4], xbA[4], xbB[4], xpA[4], xpB[4], bhA[4], bhB[4], khA[4], khB[4], gb[4];
#pragma unroll
    for (int e = 0; e < 4; ++e) {
        float x = lwA[e] + lwB[e];
#pragma unroll
        for (int d = 4; d < 64; d <<= 1) { const float y = __shfl_up(x, d); if (lane >= d) x += y; }
        const float LB = x, LA = x - lwB[e], L0 = LA - lwA[e], Lt = __shfl(x, 60 + cq);
        const float eL0 = __expf(L0), eLA = __expf(LA), eLB = __expf(LB), iLA = __expf(-LA), iLB = __expf(-LB), tA = __expf(Lt - LA), tB = __expf(Lt - LB);
        xkA[e] = kkA[e] * eL0; xkB[e] = kkB[e] * eLA; xrA[e] = rA[e] * eLA; xrB[e] = rB[e] * eLB;
        xbA[e] = bqA[e] * iLA; xbB[e] = bqB[e] * iLB; xpA[e] = kpA[e] * iLA; xpB[e] = kpB[e] * iLB;
        bhA[e] = bqA[e] * tA; bhB[e] = bqB[e] * tB; khA[e] = kpA[e] * tA; khB[e] = kpB[e] * tB; gb[e] = __expf(Lt);
    }
    const int oA = (2 * s2) * 144 + cp * 2, oB = oA + 144;
    *(LAS u32x2*)(BX + CK_XK + oA) = (u32x2){pkbf(xkA[0], xkA[1]), pkbf(xkA[2], xkA[3])}; *(LAS u32x2*)(BX + CK_XK + oB) = (u32x2){pkbf(xkB[0], xkB[1]), pkbf(xkB[2], xkB[3])};
    *(LAS u32x2*)(BX + CK_XR + oA) = (u32x2){pkbf(xrA[0], xrA[1]), pkbf(xrA[2], xrA[3])}; *(LAS u32x2*)(BX + CK_XR + oB) = (u32x2){pkbf(xrB[0], xrB[1]), pkbf(xrB[2], xrB[3])};
    *(LAS u32x2*)(BP + CK_XB + oA) = (u32x2){pkbf(xbA[0], xbA[1]), pkbf(xbA[2], xbA[3])}; *(LAS u32x2*)(BP + CK_XB + oB) = (u32x2){pkbf(xbB[0], xbB[1]), pkbf(xbB[2], xbB[3])};
    *(LAS u32x2*)(BP + CK_XP + oA) = (u32x2){pkbf(xpA[0], xpA[1]), pkbf(xpA[2], xpA[3])}; *(LAS u32x2*)(BP + CK_XP + oB) = (u32x2){pkbf(xpB[0], xpB[1]), pkbf(xpB[2], xpB[3])};
    const int i0 = 2 * s2, pst = (i0 & 16) | ((i0 & 4) << 1) | ((i0 & 8) >> 1) | (i0 & 3);
#pragma unroll
    for (int e = 0; e < 4; ++e) { *(LAS unsigned*)(BX + CK_BH + (c0 + e) * 80 + pst * 2) = pkbf(bhA[e], bhB[e]); *(LAS unsigned*)(BX + CK_KH + (c0 + e) * 80 + (2 * s2) * 2) = pkbf(khA[e], khB[e]); }
    if (s2 == 0) *(LAS f32x4*)(BX + CK_GB + c0 * 4) = (f32x4){gb[0], gb[1], gb[2], gb[3]};

}
__device__ __forceinline__ void ck_stage2(const Frame& F, int ti, const LAS unsigned char* BX, const LAS unsigned char* BP, LAS unsigned char* BT) {
    const int r = F.lane & 31, hh = F.lane >> 5;
    const LAS unsigned char* Aa = BP + ((ti < 2) ? CK_XB : CK_XP); const LAS unsigned char* Ba = BX + ((ti & 1) ? CK_XR : CK_XK);
    f32x16 acc;
#pragma unroll
    for (int i = 0; i < 16; ++i) acc[i] = 0.f;
#pragma unroll
    for (int ks = 0; ks < 4; ++ks) acc = CK_MFMA(ck_frag(Aa, 144, r, 16 * ks + 8 * hh), ck_frag(Ba, 144, r, 16 * ks + 8 * hh), acc);
    if (ti == 0) {
#pragma unroll
        for (int reg = 0; reg < 16; ++reg) { const int i = (reg & 3) + 8 * (reg >> 2) + 4 * hh; *(LAS float*)(BT + CK_TB + (i * 32 + r) * 4) = (i < r) ? acc[reg] : 0.f; }
#pragma unroll
        for (int m = 0; m < 4; ++m) { f32x4 t;
#pragma unroll
            for (int e = 0; e < 4; ++e) t[e] = (8 * m + 4 * hh + e < r) ? acc[4 * m + e] : 0.f;
            *(LAS f32x4*)(BT + CK_TBT + (r * 32 + 8 * m + 4 * hh) * 4) = t; }
    } else { const int off = (ti == 1) ? CK_TBR : ((ti == 2) ? CK_TK : CK_TKR);
#pragma unroll
        for (int m = 0; m < 4; ++m) { float t[4];
#pragma unroll
            for (int e = 0; e < 4; ++e) { const int i = 8 * m + 4 * hh + e; const bool keep = (ti == 2) ? (i < r) : (i <= r); t[e] = keep ? acc[4 * m + e] : 0.f; }
            const int col = (ti == 1) ? (16 * (m >> 1) + 8 * hh + 4 * (m & 1)) : (8 * m + 4 * hh);
            *(LAS u32x2*)(BT + off + r * 80 + col * 2) = (u32x2){pkbf(t[0], t[1]), pkbf(t[2], t[3])}; }
    }
    if (ti == 0) {
        LDS_WAIT();
        const LAS float* TBT = (const LAS float*)(BT + CK_TBT);
        float x[32];
        int rr = r; asm volatile("" : "+v"(rr));
#pragma unroll
        for (int k = 0; k < 32; ++k) x[k] = (k == rr) ? 1.f : 0.f;
        { f32x4 tc[8], tn[8];
#pragma unroll
          for (int j4 = 0; j4 < 8; ++j4) tc[j4] = *(const LAS f32x4*)(TBT + 31 * 32 + 4 * j4);
#pragma unroll
          for (int kk = 0; kk < 31; ++kk) { const int k = 31 - kk; const float xk = x[k];
              int off = (k - 1) * 32; asm volatile("" : "+v"(off) : "v"(xk));
              if (k - 1 >= 1) {
#pragma unroll
                  for (int j4 = 0; j4 <= (k - 2) / 4; ++j4) tn[j4] = *(const LAS f32x4*)(TBT + off + 4 * j4); }
#pragma unroll
              for (int j4 = 0; j4 <= (k - 1) / 4; ++j4) {
#pragma unroll
                  for (int e = 0; e < 4; ++e) { const int i = 4 * j4 + e; if (i < k) x[i] = __builtin_fmaf(-tc[j4][e], xk, x[i]); } }
#pragma unroll
              for (int j4 = 0; j4 < 8; ++j4) tc[j4] = tn[j4]; } }
        if (hh == 0) {
#pragma unroll
            for (int q = 0; q < 4; ++q) { u32x4 w;
#pragma unroll
                for (int p = 0; p < 4; ++p) { const int e0 = 2 * p, e1 = 2 * p + 1; w[p] = pkbf(x[16 * (q >> 1) + 8 * (e0 >> 2) + 4 * (q & 1) + (e0 & 3)], x[16 * (q >> 1) + 8 * (e1 >> 2) + 4 * (q & 1) + (e1 & 3)]); }
                *(LAS u32x4*)(BT + CK_MT + r * 80 + q * 16) = w; } }
    }
}
#define CK_BAR() do { asm volatile("s_waitcnt lgkmcnt(0)" ::: "memory"); __builtin_amdgcn_s_barrier(); asm volatile("" ::: "memory"); } while (0)
__device__ __forceinline__ void p4_scan(const Frame& F, int l, int probe = 0) {
#pragma unroll 1
    for (int unit = F.vcu; unit < NBATCH * NHEAD * 2; unit += F.G) {
        const int b = unit >> 5, h = (unit >> 1) & 15, half = unit & 1;
        const bool pre = F.wave >= 4, mainw = F.wave == 0;
        const int r = F.lane & 31, hh = F.lane >> 5;
        constexpr int NBLKc = SEQ / 32;
        const int w_ = F.wave;
        if (w_ == 0) {
            f32x16 ST0, ST1;
#pragma unroll
            for (int i = 0; i < 16; ++i) { ST0[i] = 0.f; ST1[i] = 0.f; }
#pragma unroll 1
            for (int blk = -2; blk < NBLKc; ++blk) {
                const LAS unsigned char* BX = F.lds + CK_X3_OFF + ((blk + 3) % 3) * CK_X3SZ; const LAS unsigned char* BT = F.lds + CK_T2_OFF + (blk & 1) * CK_T2SZ;
                bf16x8 SH[2][2], SL[2][2], NUF[2], VF[2]; f32x16 RH, YT;
                if (blk >= 0 && !(probe & 1)) {
#pragma unroll
                for (int c = 0; c < 2; ++c)
#pragma unroll
                    for (int s = 0; s < 2; ++s) { u32x4 ph, pl;
#pragma unroll
                        for (int p = 0; p < 4; ++p) { const float x0 = (c ? ST1 : ST0)[8 * s + 2 * p], x1 = (c ? ST1 : ST0)[8 * s + 2 * p + 1]; const unsigned hp = pkbf(x0, x1);
                            ph[p] = hp;
#if defined(CK_LO)
                            pl[p] = pkbf(x0 - bflo(hp), x1 - bfhi(hp));
#endif
                        }
                        SH[c][s] = __builtin_bit_cast(bf16x8, ph);
#if defined(CK_LO)
                        SL[c][s] = __builtin_bit_cast(bf16x8, pl);
#endif
                    }
                { LAS f32x4* stash = (LAS f32x4*)(F.lds + CK_STASH) + F.lane;
#pragma unroll
                  for (int m = 0; m < 4; ++m) { stash[64 * m] = (f32x4){ST0[4 * m], ST0[4 * m + 1], ST0[4 * m + 2], ST0[4 * m + 3]}; stash[64 * (4 + m)] = (f32x4){ST1[4 * m], ST1[4 * m + 1], ST1[4 * m + 2], ST1[4 * m + 3]}; } }
                VF[0] = ck_frag(BX + CK_VT, 80, r, 8 * hh); VF[1] = ck_frag(BX + CK_VT, 80, r, 16 + 8 * hh);
#pragma unroll
                for (int i = 0; i < 16; ++i) RH[i] = 0.f;
                { bf16x8 ak[2][2], at[2];
#pragma unroll
                  for (int c = 0; c < 2; ++c)
#pragma unroll
                      for (int s = 0; s < 2; ++s) ak[c][s] = ck_frag(BX + CK_XK, 144, r, 32 * c + 16 * s + 8 * hh);
                  at[0] = ck_frag(BT + CK_TK, 80, r, 8 * hh); at[1] = ck_frag(BT + CK_TK, 80, r, 16 + 8 * hh);
#pragma unroll
                  for (int c = 0; c < 2; ++c)
#pragma unroll
                      for (int s = 0; s < 2; ++s) RH = CK_MFMA(ak[c][s], SH[c][s], RH);
#pragma unroll
                  for (int ks = 0; ks < 2; ++ks) RH = CK_MFMA(at[ks], VF[ks], RH); }
                { bf16x8 rb[2];
#pragma unroll
                  for (int s = 0; s < 2; ++s) { u32x4 p4;
#pragma unroll
                      for (int p = 0; p < 4; ++p) p4[p] = pkbf(RH[8 * s + 2 * p], RH[8 * s + 2 * p + 1]);
                      rb[s] = __builtin_bit_cast(bf16x8, p4); }
                  f32x16 UT;
#pragma unroll
                  for (int i = 0; i < 16; ++i) UT[i] = 0.f;
#pragma unroll
                  for (int s = 0; s < 2; ++s) UT = CK_MFMA(ck_frag(BT + CK_MT, 80, r, 16 * s + 8 * hh), rb[s], UT);
#pragma unroll
                  for (int s = 0; s < 2; ++s) { u32x4 p4;
#pragma unroll
                      for (int p = 0; p < 4; ++p) p4[p] = pkbf(UT[8 * s + 2 * p], UT[8 * s + 2 * p + 1]) ^ 0x80008000u;
                      NUF[s] = __builtin_bit_cast(bf16x8, p4); } }
#pragma unroll
                for (int i = 0; i < 16; ++i) YT[i] = 0.f;
                { bf16x8 ar[2][2];
#pragma unroll
                  for (int c = 0; c < 2; ++c)
#pragma unroll
                      for (int s = 0; s < 2; ++s) ar[c][s] = ck_frag(BX + CK_XR, 144, r, 32 * c + 16 * s + 8 * hh);
#pragma unroll
                  for (int c = 0; c < 2; ++c)
#pragma unroll
                      for (int s = 0; s < 2; ++s) YT = CK_MFMA(ar[c][s], SH[c][s], YT); }
                VF[0] = ck_frag(BX + CK_VT, 80, r, 8 * hh); VF[1] = ck_frag(BX + CK_VT, 80, r, 16 + 8 * hh);
                asm volatile("" ::: "memory");
#pragma unroll
                for (int ks = 0; ks < 2; ++ks) { const bf16x8 fbr = ck_frag(BT + CK_TBR, 80, r, 16 * ks + 8 * hh), fkr = ck_frag(BT + CK_TKR, 80, r, 16 * ks + 8 * hh); YT = CK_MFMA(fbr, NUF[ks], YT); YT = CK_MFMA(fkr, VF[ks], YT); }
                { bf16* yo = (bf16*)(F.ws + WS_YCK) + ((size_t)b * SEQ + blk * 32) * 1024 + h * 64 + half * 32 + r;
#pragma unroll
                  for (int reg = 0; reg < 16; ++reg) yo[(size_t)((reg & 3) + 8 * (reg >> 2) + 4 * hh) * 1024] = (bf16)f2bf(YT[reg]); }
                { const LAS f32x4* stash = (const LAS f32x4*)(F.lds + CK_STASH) + F.lane;
#pragma unroll
                  for (int m = 0; m < 4; ++m) { const f32x4 g0 = *(const LAS f32x4*)(BX + CK_GB + (8 * m + 4 * hh) * 4), g1 = *(const LAS f32x4*)(BX + CK_GB + (32 + 8 * m + 4 * hh) * 4);
                    const f32x4 a0 = stash[64 * m] * g0, a1 = stash[64 * (4 + m)] * g1;
#pragma unroll
                    for (int e = 0; e < 4; ++e) { ST0[4 * m + e] = a0[e]; ST1[4 * m + e] = a1[e]; } } }
#pragma unroll
                for (int ks = 0; ks < 2; ++ks) {
                    const bf16x8 b0 = ck_frag(BX + CK_BH, 80, r, 16 * ks + 8 * hh), b1 = ck_frag(BX + CK_BH, 80, 32 + r, 16 * ks + 8 * hh), k0 = ck_frag(BX + CK_KH, 80, r, 16 * ks + 8 * hh), k1 = ck_frag(BX + CK_KH, 80, 32 + r, 16 * ks + 8 * hh);
                    ST0 = CK_MFMA(b0, NUF[ks], ST0); ST1 = CK_MFMA(b1, NUF[ks], ST1); ST0 = CK_MFMA(k0, VF[ks], ST0); ST1 = CK_MFMA(k1, VF[ks], ST1); }
                }
                CK_BAR();
            }
        } else if (w_ == 1 || w_ == 2 || w_ == 3 || w_ == 5) {
            const int pw = (w_ == 5) ? 3 : w_ - 1;
            CkConst CC;
            { const int c = l * 1024 + h * 64 + 16 * pw + 4 * (F.lane & 3); const float* mu = kin<I_MU>() + l * N_SHIFT + h * 64 + 16 * pw + 4 * (F.lane & 3);
              CC.a0 = *(const f32x4*)(kin<I_A0>() + c); CC.kk = *(const f32x4*)(kin<I_KK>() + c); CC.ka = *(const f32x4*)(kin<I_KA>() + c); CC.rk = *(const f32x4*)(kin<I_RK>() + c); CC.w0 = *(const f32x4*)(kin<I_W0>() + c);
              CC.v0 = (l == 1) ? *(const f32x4*)(kin<I_V0>() + (c - 1024)) : (f32x4){0.f, 0.f, 0.f, 0.f}; CC.mur = *(const f32x4*)mu; CC.muk = *(const f32x4*)(mu + 1024); CC.muv = *(const f32x4*)(mu + 2048); }
            CkRegs CR;
            ck_issue(F, pw, l, b, h, half, 0, CR);
#pragma unroll 1
            for (int blk = -2; blk < NBLKc; ++blk) {
                if (blk + 2 < NBLKc && !(probe & 4) && !((probe & 16) && w_ == 5)) ck_stage1(F, pw, l, b, h, half, blk + 2, CC, F.lds + CK_X3_OFF + ((blk + 2 + 3) % 3) * CK_X3SZ, F.lds + CK_P2_OFF + ((blk + 2) & 1) * CK_P2SZ, CR, blk + 3 < NBLKc);
                CK_BAR();
            }
        } else {
#pragma unroll 1
            for (int blk = -2; blk < NBLKc; ++blk) {
                if (blk + 1 >= 0 && blk + 1 < NBLKc) {
                    const LAS unsigned char* BX = F.lds + CK_X3_OFF + ((blk + 1 + 3) % 3) * CK_X3SZ; const LAS unsigned char* BP = F.lds + CK_P2_OFF + ((blk + 1) & 1) * CK_P2SZ; LAS unsigned char* BT = F.lds + CK_T2_OFF + ((blk + 1) & 1) * CK_T2SZ;
                    if (w_ == 4) { if (!(probe & 2)) ck_stage2(F, 0, BX, BP, BT); }
                    else if (probe & 8) {}
                    else if (w_ == 6) { ck_stage2(F, 1, BX, BP, BT); ck_stage2(F, 3, BX, BP, BT); }
                    else ck_stage2(F, 2, BX, BP, BT);
                }
                CK_BAR();
            }
        }
    }
}

__device__ __forceinline__ void p5_post(const Frame& F, int l) {
    const int lane = F.lane;
#if defined(DBG_SCAN)
    if (l == 0) { float d2 = 0.f, n2 = 0.f;
#if defined(DBG_CMP_U)
        const bf16* Ya = (const bf16*)(F.ws + WS_V1); const bf16* Yb = (const bf16*)(F.ws + WS_P) + C_VD; const size_t pb = P_LD;
#else
        const bf16* Ya = (const bf16*)(F.ws + WS_Y); const bf16* Yb = (const bf16*)(F.ws + WS_H); const size_t pb = 1024;
#endif
        for (size_t i = (size_t)(F.vcu * NWAVES * 64 + F.tid); i < (size_t)T * 1024; i += (size_t)F.G * NWAVES * 64) { const int t = (int)((i >> 10) & (SEQ - 1));
            if (t >= DBG_T0 && t < DBG_T1) { const float ya = bflo((unsigned)Ya[i]), yb = bflo((unsigned)Yb[(i >> 10) * pb + (i & 1023)]); d2 += (ya - yb) * (ya - yb); n2 += ya * ya; } }
        d2 = wave_sum(d2); n2 = wave_sum(n2);
        if (lane == 0) { atomicAdd((float*)(F.ws + WS_CTL) + 2048, d2); atomicAdd((float*)(F.ws + WS_CTL) + 2049, n2); }
        __syncthreads(); }
#endif
    const float* const pCW = kin<I_CONVW>() + l * 3 * 1024; const float* const pLNW = kin<I_LNW>() + l * 1024; const float* const pLNB = kin<I_LNB>() + l * 1024;
    const bf16* P = (const bf16*)(F.ws + WS_P); const bf16* Y = (const bf16*)(F.ws + WS_Y); const bf16* LRg = (const bf16*)(F.ws + WS_LR) + 2048;
    const bf16* V = (const bf16*)(F.ws + (l == 0 ? WS_V0 : WS_V1)); const float* BONP = (const float*)(F.ws + WS_BONP); bf16* M = (bf16*)(F.ws + WS_H);
#pragma unroll 1
    for (int gw = F.vcu * NWAVES + F.wave; gw < T / 8; gw += F.G * NWAVES) { const int tok0 = gw * 8;
#pragma unroll 1
    for (int ch = 0; ch < 2; ++ch) { const int col0 = 512 * ch + 8 * lane, head = 8 * ch + (lane >> 3);
        float cw0[8], cw1[8], cw2[8], lnw[8], lnb[8], um1[8], um2[8];
#pragma unroll
        for (int j = 0; j < 8; ++j) { cw0[j] = pCW[col0 + j]; cw1[j] = pCW[1024 + col0 + j]; cw2[j] = pCW[2048 + col0 + j];
            lnw[j] = pLNW[col0 + j]; lnb[j] = pLNB[col0 + j]; um1[j] = 0.f; um2[j] = 0.f; }
        const int t0 = tok0 & (SEQ - 1);
        if (t0 >= 1) { float c1[8], c2[8]; load8(P + (size_t)(tok0 - 1) * P_LD + C_CC + col0, c1); load8(P + (size_t)(tok0 - 1) * P_LD + C_CH + col0, c2);
#pragma unroll
            for (int j = 0; j < 8; ++j) um1[j] = c1[j] * c2[j]; }
        if (t0 >= 2) { float c1[8], c2[8]; load8(P + (size_t)(tok0 - 2) * P_LD + C_CC + col0, c1); load8(P + (size_t)(tok0 - 2) * P_LD + C_CH + col0, c2);
#pragma unroll
            for (int j = 0; j < 8; ++j) um2[j] = c1[j] * c2[j]; }
#pragma unroll 2
        for (int tk = 0; tk < 8; ++tk) { const int tok = tok0 + tk; const bf16* pr = P + (size_t)tok * P_LD + col0;
            float c1[8], c2[8], cb[8], ga[8], gb[8], y[8], v[8], g[8], o[8];
            load8(pr + C_CC, c1); load8(pr + C_CH, c2); load8(pr + C_CB, cb); load8(pr + C_GA, ga); load8(pr + C_GB, gb);
            load8(Y + (size_t)tok * 1024 + col0, y); load8h(V + (size_t)tok * 1024 + col0, v); load8(LRg + (size_t)tok * 3072 + col0, g);
            const f32x4 bo4 = *(const f32x4*)(BONP + ((size_t)tok * 16 + head) * 4); const float bo = (bo4[0] + bo4[1]) + (bo4[2] + bo4[3]);
            float sm = 0.f;
#pragma unroll
            for (int j = 0; j < 8; ++j) sm += y[j];
            const float mean = sum8(sm) * (1.0f / 64.0f); float sq = 0.f;
#pragma unroll
            for (int j = 0; j < 8; ++j) { y[j] -= mean; sq += y[j] * y[j]; }
            const float rstd = __builtin_amdgcn_rsqf(sum8(sq) * (1.0f / 64.0f) + LNX_EPS);
#pragma unroll
            for (int j = 0; j < 8; ++j) { const float u = c1[j] * c2[j]; const float conv = cw0[j] * um2[j] + cw1[j] * um1[j] + cw2[j] * u; um2[j] = um1[j]; um1[j] = u;
                const float yconv = cb[j] * conv; const float yr = ((y[j] * rstd) * lnw[j] + lnb[j] + bo * v[j]) * g[j];
                o[j] = sigmoidf_(ga[j]) * yconv + sigmoidf_(gb[j]) * yr; }
            store8(M + (size_t)tok * 1024 + col0, o); }
    }
    }
}

struct GroupPick { float score, a1, a2; int i1, i2; };
__device__ __forceinline__ GroupPick pick_group(const f32x4 acc, float rstd, const float* br, const float* rb) {
    float aff[4], sel[4];
#pragma unroll
    for (int j = 0; j < 4; ++j) { aff[j] = sigmoidf_(rstd * acc[j] + br[j]); sel[j] = aff[j] + rb[j]; }
    int i1 = 0;
#pragma unroll
    for (int j = 1; j < 4; ++j) if (sel[j] > sel[i1]) i1 = j;
    int i2 = (i1 == 0) ? 1 : 0;
#pragma unroll
    for (int j = 0; j < 4; ++j) if (j != i1 && j != i2 && sel[j] > sel[i2]) i2 = j;
    GroupPick g; g.score = sel[i1] + sel[i2]; g.i1 = i1; g.i2 = i2; g.a1 = aff[i1]; g.a2 = aff[i2];
    float s1 = sel[0], s2 = sel[0]; (void)s1; (void)s2;
    return g;
}
__device__ __forceinline__ void p7_route(const Frame& F, int l, bool dry = false) {
    const int lane = F.lane, li = lane & 15, fq = lane >> 4, w = F.wave;
    LAS float* part = (LAS float*)F.lds;
    LAS float* gml = (LAS float*)(F.lds + 32768);
    LAS unsigned* lcnt = (LAS unsigned*)(F.lds + 65536);
    const float* X = (const float*)(F.ws + WS_X); const bf16* WH = (const bf16*)(F.ws + WS_WRT); const bf16* WL = WH + 32768; const float* const pN2G = kin<I_N2G>() + l * 1024; const float* const pRB = kin<I_RB>();
#pragma unroll 1
    for (int grp = F.vcu; grp < T / 64; grp += F.G) { const int b = grp >> 5;
        if (F.tid < 32) lcnt[F.tid] = 0u;
        { const float* ad = ada_ptr(F, l, b) + 4096; const int c = 2 * F.tid; const f32x2 g = *(const f32x2*)(pN2G + c), s = *(const f32x2*)(ad + c); gml[c] = g.x * (1.0f + s.x); gml[c + 1] = g.y * (1.0f + s.y); }
        bfv8 ah0[4], al0[4], ah1[4], al1[4];
        { const bf16* wh0 = WH + li * 1024 + 128 * w + 8 * fq; const bf16* wl0 = WL + li * 1024 + 128 * w + 8 * fq;
#pragma unroll
          for (int s = 0; s < 4; ++s) { ah0[s] = *(const bfv8*)(wh0 + 32 * s); al0[s] = *(const bfv8*)(wl0 + 32 * s); ah1[s] = *(const bfv8*)(wh0 + 16 * 1024 + 32 * s); al1[s] = *(const bfv8*)(wl0 + 16 * 1024 + 32 * s); } }
        __syncthreads();
#pragma unroll 1
        for (int it = 0; it < 4; ++it) { const int tok0 = grp * 64 + it * 16;
            const float* xp = X + (size_t)(tok0 + li) * 1024 + 128 * w + 8 * fq;
            f32x4 xa[4], xb[4];
#pragma unroll
            for (int s = 0; s < 4; ++s) { xa[s] = *(const f32x4*)(xp + 32 * s); xb[s] = *(const f32x4*)(xp + 32 * s + 4); }
            f32x4 acc0 = (f32x4){0.f, 0.f, 0.f, 0.f}, acc1 = acc0; float ssq = 0.f;
#pragma unroll
            for (int s = 0; s < 4; ++s) {
                const f32x4 ga = *(const LAS f32x4*)(gml + 128 * w + 32 * s + 8 * fq), gb = *(const LAS f32x4*)(gml + 128 * w + 32 * s + 8 * fq + 4);
                ssq += ((xa[s][0] * xa[s][0] + xa[s][1] * xa[s][1]) + (xa[s][2] * xa[s][2] + xa[s][3] * xa[s][3])) + ((xb[s][0] * xb[s][0] + xb[s][1] * xb[s][1]) + (xb[s][2] * xb[s][2] + xb[s][3] * xb[s][3]));
                const f32x4 ya = xa[s] * ga, yb = xb[s] * gb;
                u32x4 ph, pl;
                ph[0] = pkbf(ya[0], ya[1]); ph[1] = pkbf(ya[2], ya[3]); ph[2] = pkbf(yb[0], yb[1]); ph[3] = pkbf(yb[2], yb[3]);
                pl[0] = pkbf(ya[0] - bflo(ph[0]), ya[1] - bfhi(ph[0])); pl[1] = pkbf(ya[2] - bflo(ph[1]), ya[3] - bfhi(ph[1])); pl[2] = pkbf(yb[0] - bflo(ph[2]), yb[1] - bfhi(ph[2])); pl[3] = pkbf(yb[2] - bflo(ph[3]), yb[3] - bfhi(ph[3]));
                const bfv8 bh = __builtin_bit_cast(bfv8, ph), bl = __builtin_bit_cast(bfv8, pl);
                acc0 = __builtin_amdgcn_mfma_f32_16x16x32_bf16(ah0[s], bh, acc0, 0, 0, 0); acc0 = __builtin_amdgcn_mfma_f32_16x16x32_bf16(al0[s], bh, acc0, 0, 0, 0); acc0 = __builtin_amdgcn_mfma_f32_16x16x32_bf16(ah0[s], bl, acc0, 0, 0, 0);
                acc1 = __builtin_amdgcn_mfma_f32_16x16x32_bf16(ah1[s], bh, acc1, 0, 0, 0); acc1 = __builtin_amdgcn_mfma_f32_16x16x32_bf16(al1[s], bh, acc1, 0, 0, 0); acc1 = __builtin_amdgcn_mfma_f32_16x16x32_bf16(ah1[s], bl, acc1, 0, 0, 0);
            }
            ssq += __shfl_xor(ssq, 16); ssq += __shfl_xor(ssq, 32);
            { LAS float* pp = part + (w * 16 + li) * 36; *(LAS f32x4*)(pp + 4 * fq) = acc0; *(LAS f32x4*)(pp + 16 + 4 * fq) = acc1; if (fq == 0) pp[32] = ssq; }
            __syncthreads();
            if (w == 0) {
                f32x4 a0 = (f32x4){0.f, 0.f, 0.f, 0.f}, a1 = a0; float sq = 0.f;
#pragma unroll
                for (int ww = 0; ww < 8; ++ww) { const LAS float* q = part + (ww * 16 + li) * 36; a0 += *(const LAS f32x4*)(q + 4 * fq); a1 += *(const LAS f32x4*)(q + 16 + 4 * fq); sq += q[32]; }
                const float rstd = __builtin_amdgcn_rsqf(sq * (1.0f / 1024.0f) + NORM_EPS);
                const float* br = (const float*)(F.ws + WS_CTL + CTL_BIASR) + (l * 8 + b) * 32;
                const GroupPick ga_ = pick_group(a0, rstd, br + 4 * fq, pRB + 4 * fq), gb_ = pick_group(a1, rstd, br + 16 + 4 * fq, pRB + 16 + 4 * fq);
                const bool useb = gb_.score > ga_.score;
                const GroupPick gm = useb ? gb_ : ga_; const int mygrp = useb ? 4 + fq : fq;
                float bs = gm.score; int bg = mygrp;
#pragma unroll
                for (int off = 16; off < 64; off <<= 1) { const float os = __shfl_xor(bs, off); const int og = __shfl_xor(bg, off); if (os > bs || (os == bs && og < bg)) { bs = os; bg = og; } }
                if (mygrp == bg) { const int tok = tok0 + li; const int e0 = 4 * bg + gm.i1, e1 = 4 * bg + gm.i2; const float inv = 1.0f / (gm.a1 + gm.a2);
                    const int p0 = (int)__hip_atomic_fetch_add(lcnt + e0, 1u, __ATOMIC_RELAXED, __HIP_MEMORY_SCOPE_WORKGROUP), p1 = (int)__hip_atomic_fetch_add(lcnt + e1, 1u, __ATOMIC_RELAXED, __HIP_MEMORY_SCOPE_WORKGROUP);
                    int* EI = (int*)(F.ws + WS_EIDX); int* PO = (int*)(F.ws + WS_POS); float* WT = (float*)(F.ws + WS_WTS);
                    if (!dry) { EI[tok * 2] = e0; EI[tok * 2 + 1] = e1; PO[tok * 2] = p0; PO[tok * 2 + 1] = p1; WT[tok * 2] = gm.a1 * inv; WT[tok * 2 + 1] = gm.a2 * inv; } }
            }
            __syncthreads();
        }
        if (F.tid < 32 && !dry) ((int*)(F.ws + WS_HIST))[(l * 256 + grp) * 32 + F.tid] = (int)lcnt[F.tid];
        __syncthreads();
    }
}

__device__ __forceinline__ void expert_table(const Frame& F, int l, int grp = -1) {
    LAS int* tab = (LAS int*)(F.lds + TAB_OFF); LAS int* red = (LAS int*)F.lds;
    const int* hist = (const int*)(F.ws + WS_HIST) + l * 256 * 32; const int e = F.tid & 31, part = F.tid >> 5;
    int tot = 0, pre = 0;
#pragma unroll 4
    for (int g = part * 16; g < part * 16 + 16; ++g) { const int v = hist[g * 32 + e]; tot += v; pre += (g < grp) ? v : 0; }
    red[part * 32 + e] = tot; red[512 + part * 32 + e] = pre;
    __syncthreads();
    if (F.tid < 64) { int c = 0, pr = 0;
#pragma unroll
        for (int p = 0; p < 16; ++p) { c += red[p * 32 + e]; pr += red[512 + p * 32 + e]; }
        const int padded = (c + 255) & ~255; int inc = padded;
#pragma unroll
        for (int o = 1; o < 32; o <<= 1) { const int v = __shfl_up(inc, o); if (e >= o) inc += v; }
        if (F.lane < 32) { tab[e] = inc - padded; tab[33 + e] = (inc - padded) >> 8; tab[66 + e] = inc - padded + pr; if (e == 31) { tab[32] = inc; tab[65] = inc >> 8; } } }
    __syncthreads();
}

__device__ __forceinline__ void p8_dispatch(const Frame& F, int l) {
    const LAS int* tab = (const LAS int*)(F.lds + TAB_OFF);
    const float* const pN2G = kin<I_N2G>() + l * 1024;
    const int lane = F.lane;
#pragma unroll 1
    for (int gw = F.vcu * NWAVES + F.wave; gw < T / 8; gw += F.G * NWAVES) { const int tok0 = gw * 8, b = tok0 >> 11;
        expert_table(F, l, gw >> 3);
        const float* ad = ada_ptr(F, l, b); f32x4 gm[4], sh[4];
#pragma unroll
        for (int j = 0; j < 4; ++j) { const int c = 4 * lane + 256 * j; gm[j] = *(const f32x4*)(pN2G + c) * (1.0f + *(const f32x4*)(ad + 4096 + c)); sh[j] = *(const f32x4*)(ad + 3072 + c); }
        const float* X = (const float*)(F.ws + WS_X); const int* EI = (const int*)(F.ws + WS_EIDX); const int* PO = (const int*)(F.ws + WS_POS); int* SL = (int*)(F.ws + WS_SLOT); bf16* BUF = (bf16*)(F.ws + WS_BUF);
        for (int tk = 0; tk < 8; ++tk) { const int tok = tok0 + tk; f32x4 v[4]; float ss = 0.f;
#pragma unroll
            for (int j = 0; j < 4; ++j) { v[j] = *(const f32x4*)(X + (size_t)tok * 1024 + 4 * lane + 256 * j); ss += (v[j][0] * v[j][0] + v[j][1] * v[j][1]) + (v[j][2] * v[j][2] + v[j][3] * v[j][3]); }
            const float rstd = __builtin_amdgcn_rsqf(wave_sum(ss) * (1.0f / 1024.0f) + NORM_EPS);
            const int s0 = tab[66 + EI[tok * 2]] + PO[tok * 2], s1 = tab[66 + EI[tok * 2 + 1]] + PO[tok * 2 + 1];
            if (lane == 0) { SL[tok * 2] = s0; SL[tok * 2 + 1] = s1; }
#pragma unroll
            for (int j = 0; j < 4; ++j) { const f32x4 h = v[j] * rstd * gm[j] + sh[j]; u32x2 w; w.x = pk2(h[0], h[1]); w.y = pk2(h[2], h[3]);
                *(u32x2*)(BUF + (size_t)s0 * 1024 + 4 * lane + 256 * j) = w; *(u32x2*)(BUF + (size_t)s1 * 1024 + 4 * lane + 256 * j) = w; } }
    }
}

#ifndef PHMASK
#define PHMASK 0xFFFF
#endif
#define PHM(n) (((PHMASK) >> (n)) & 1)
constexpr int NPHASES = 23;
__global__ void __launch_bounds__(NWAVES * 64, 2) trunk_fwd(Args args) {
    extern __shared__ __attribute__((aligned(16))) unsigned char lds_raw[];
    Frame F;
    F.lds = (LAS unsigned char*)lds_raw;
    F.tid = threadIdx.x; F.lane = F.tid & 63; F.wave = __builtin_amdgcn_readfirstlane(F.tid >> 6);
    F.G = gridDim.x; { const int bx = blockIdx.x; F.vcu = (F.G % 8 == 0) ? (bx % 8) * (F.G / 8) + bx / 8 : bx; }
    GAS unsigned char* const wsbase = (GAS unsigned char*)kin<29>(); F.ws = wsbase; const int vcu0 = F.vcu;
    volatile LAS unsigned* MISC = (volatile LAS unsigned*)(F.lds + MISC_OFF);
    if (F.tid < 32) MISC[F.tid] = 0u;
    __syncthreads();
    const unsigned long long lohi = (unsigned long long)kin<30>(); const int lo = (int)(unsigned)lohi, hi = (int)(unsigned)(lohi >> 32);
    XcdBarrier bar; bar.bar = (unsigned*)(F.ws + WS_CTL) + CW_BAR; bar.x = 0; bar.st = nullptr;
    if (hi - lo > 1) bar = xcd_barrier_post((unsigned*)(F.ws + WS_CTL) + CW_BAR, MISC + 8);
#pragma unroll 1
#if defined(REP_PH)
    for (int phx = lo; phx < hi + REP_N; ++phx) { const int ph = (phx < REP_PH) ? phx : ((phx < REP_PH + REP_N) ? REP_PH : phx - REP_N);
        const bool probe_run = (phx >= REP_PH && phx < REP_PH + REP_N); (void)probe_run;
#else
    for (int ph = lo; ph < hi; ++ph) {
#endif
        { int t_ = threadIdx.x; asm volatile("" : "+v"(t_)); F.tid = t_; F.lane = t_ & 63; F.wave = __builtin_amdgcn_readfirstlane(t_ >> 6);
          GAS unsigned char* w_ = wsbase; asm volatile("" : "+s"(w_)); F.ws = w_; int v_ = vcu0; asm volatile("" : "+s"(v_)); F.vcu = v_; }
        const int l = (ph - 2) / 10, k = (ph >= 2 && ph <= 21) ? (ph - 2) % 10 : -1;
        if (PHM(0) && ph == 0) p0_prologue(F);
        else if (PHM(0) && ph == 1) p0b_ada_reduce(F);
        else if (PHM(1) && ph == 22) p1_norm<2>(F, 1);
        else if (PHM(1) && k == 0) { if (l == 0) p1_norm<0>(F, 0); else p1_norm<1>(F, 1); }
        else if (PHM(3) && k == 2) p2x_lowrank(F, l);
        #if defined(DBG_SCAN)
        else if (PHM(4) && k == 3) { p4_scan_seq(F, l); __syncthreads(); if (l == 0) p4_scan(F, l); }
#elif defined(REP_PH) && defined(REP_DRY)
        else if (PHM(4) && k == 3) p4_scan(F, l, probe_run ? REP_DRY : 0);
#else
        else if (PHM(4) && k == 3) p4_scan(F, l);
#endif
        else if (PHM(5) && k == 4) p5_post(F, l);
        #if defined(REP_PH)
        else if (PHM(7) && k == 6) p7_route(F, l, probe_run);
#else
        else if (PHM(7) && k == 6) p7_route(F, l);
#endif
        else if (PHM(8) && k == 7) p8_dispatch(F, l);
        else if (PHM(2) && (k == 1 || k == 5 || k == 8 || k == 9)) {
            pg8::Gemm g; pg8::UniOrder S; pg8::EpiUni E;
            S.expert = (k >= 8); S.so.init(T, 1024, F.G, (int)blockIdx.x); S.eo = pg8::ExpertOrder{(const PG8_LAS int*)(F.lds + TAB_OFF + 33 * 4), 0, F.G, (int)blockIdx.x};
            E.e0 = pg8::EpiBf16Plain{(bf16*)(F.ws + WS_P), P_LD, -1}; E.e1 = pg8::EpiResid{nullptr, (float*)(F.ws + WS_X), ada_ptr(F, l, 0) + 2048, 6144}; E.e2 = pg8::EpiSwiGLU{(bf16*)(F.ws + WS_HB)};
            if (k == 1) {
                const int N = (l == 0) ? N_IN : P_LD; S.so.init(T, N, F.G, (int)blockIdx.x); E.mode = 0;
                g = pg8::Gemm{(const bf16*)(F.ws + WS_H), (const bf16*)(F.ws + WS_BT_IN) + (size_t)l * P_LD * 1024, T, N, 1024};
            } else if (k == 5) {
                E.mode = 1; E.e1.xin = (l == 0) ? kin<I_X>() : (const float*)(F.ws + WS_X);
                g = pg8::Gemm{(const bf16*)(F.ws + WS_H), (const bf16*)(F.ws + WS_BT_OUT) + (size_t)l * 1024 * 1024, T, 1024, 1024};
            } else {
                expert_table(F, l);
                S.eo.ntiles = ((const LAS int*)(F.lds + TAB_OFF))[65];
                if (k == 8) { E.mode = 2; g = pg8::Gemm{(const bf16*)(F.ws + WS_BUF), (const bf16*)(F.ws + WS_BT_E1) + (size_t)l * 32 * 1024 * 1024, MAXROWS, 32 * 1024, 1024}; }
                else { E.mode = 0; E.e0 = pg8::EpiBf16Plain{(bf16*)(F.ws + WS_YE), 1024, 3}; g = pg8::Gemm{(const bf16*)(F.ws + WS_HB), (const bf16*)(F.ws + WS_BT_E2) + (size_t)l * 32 * 1024 * 512, MAXROWS, 32 * 1024, 512}; }
            }
#if defined(REP_PH) && defined(REP_DRY)
            if (probe_run) E.mode = 3;
#endif
            pg8::gemm_phase<pg8::EpiUni, pg8::UniOrder, true, true>(F.lds, g, S, E);
        }
#if defined(REP_PH)
        if (phx + 1 < hi + REP_N) xcd_barrier(bar);
#else
        if (ph + 1 < hi) xcd_barrier(bar);
#endif
    }
}

extern "C" void kernel_launch(void* const* d_in, const int* in_sizes, int n_in, void* d_out, int out_size, void* d_ws, size_t ws_size, hipStream_t stream) {
    static int grid = 0;
    if (grid == 0) {
        if (n_in != 28 || in_sizes[0] != T * D || out_size != T * D || ws_size < WS_END) { fprintf(stderr, "kernel_launch: unexpected shapes (n_in %d, in0 %d, out %d, ws %zu < %zu?); nothing launched\n", n_in, n_in > 0 ? in_sizes[0] : -1, out_size, ws_size, (size_t)WS_END); grid = -1; return; }
        int dev = 0, cus = 0, per_cu = 0;
        if (hipGetDevice(&dev) != hipSuccess || hipDeviceGetAttribute(&cus, hipDeviceAttributeMultiprocessorCount, dev) != hipSuccess) { fprintf(stderr, "kernel_launch: device query failed\n"); grid = -1; return; }
        if (hipFuncSetAttribute((const void*)trunk_fwd, hipFuncAttributeMaxDynamicSharedMemorySize, LDS_BYTES) != hipSuccess) { fprintf(stderr, "kernel_launch: hipFuncSetAttribute failed\n"); grid = -1; return; }
        if (hipOccupancyMaxActiveBlocksPerMultiprocessor(&per_cu, (const void*)trunk_fwd, NWAVES * 64, LDS_BYTES) != hipSuccess || per_cu < 1) { fprintf(stderr, "kernel_launch: occupancy query says %d blocks per CU\n", per_cu); }
        (void)hipGetLastError();
        grid = cus;
    }
    if (grid < 0) return;
    if (hipMemsetAsync((char*)d_ws + WS_CTL, 0, CTL_ZERO_BYTES, stream) != hipSuccess) { fprintf(stderr, "kernel_launch: memset failed\n"); return; }
    Args a{};
    for (int i = 0; i < 28; ++i) a.p[i] = d_in[i];
    a.p[28] = d_out; a.p[29] = d_ws;
#if MK_ONE_LAUNCH
    a.ph_lo = 0; a.ph_hi = NPHASES;
    void* kargs[] = {&a};
    hipError_t e = hipLaunchCooperativeKernel((const void*)trunk_fwd, dim3(grid), dim3(NWAVES * 64), kargs, LDS_BYTES, stream);
    if (e != hipSuccess) fprintf(stderr, "kernel_launch: cooperative launch failed: %s (grid %d)\n", hipGetErrorString(e), grid);
#else
    for (int p = 0; p < NPHASES; ++p) { a.ph_lo = p; a.ph_hi = p + 1;
        hipLaunchKernelGGL(trunk_fwd, dim3(grid), dim3(NWAVES * 64), LDS_BYTES, stream, a);
        const hipError_t le = hipPeekAtLastError(); if (le != hipSuccess) { fprintf(stderr, "kernel_launch: launch %d failed: %s\n", p, hipGetErrorName(le)); break; } }
#endif
}
```

```cpp
#include <hip/hip_runtime.h>
#include <cstdio>
#include <cstdint>

#ifndef MK_ONE_LAUNCH
#define MK_ONE_LAUNCH 1
#endif

namespace pg8 {
#define PG8_LAS __attribute__((address_space(3)))
typedef unsigned short bf16_t;
typedef short bf16x8 __attribute__((ext_vector_type(8)));
typedef float f32x4 __attribute__((ext_vector_type(4)));
typedef unsigned u32x4 __attribute__((ext_vector_type(4)));
constexpr int BM = 256, BK = 64, HALF = 128, HTB = HALF * BK * 2  , STAGE_BYTES = 8 * HTB, NXCD = 8, WGM = 8;

__host__ __device__ __forceinline__ int lds_byte(int r, int c) { const int st = (r >> 4) * 2 + (c >> 5), rr = r & 15, cc = c & 31, ob = rr * 64 + cc * 2; return st * 1024 + (ob ^ (((ob >> 9) & 1) << 5)); }
__host__ __device__ __forceinline__ void stage_rc(int b, int& R, int& C) { const int st = b / 1024, sb = b % 1024, swz = sb ^ (((sb >> 9) & 1) << 5); R = (st >> 1) * 16 + swz / 64; C = (st & 1) * 32 + (swz % 64) / 2; }
__host__ __device__ __forceinline__ int perm32(int rho) { const int n = rho >> 4, i = rho & 15; return 8 * (i >> 2) + 4 * n + (i & 3); }

struct Unit { int pm, pn; };
struct Gemm { const bf16_t* A; const bf16_t* Bt; int M, N, K; };

struct StaticOrder {
    int nM, nN, nwg, G, c;
    __host__ __device__ void init(int M, int N, int G_, int c_) { nM = M / BM; nN = N / BM; nwg = nM * nN; G = G_; c = c_; }
    __host__ __device__ bool next(int i, Unit& u) const {
        const long L = (long)i * G + c; if (L >= nwg) return false;
        int wgid = (int)L; { const int q = nwg / NXCD, r = nwg % NXCD, xcd = wgid % NXCD, off = wgid / NXCD; wgid = (xcd < r ? xcd * (q + 1) : r * (q + 1) + (xcd - r) * q) + off; }
        const int nig = WGM * nN, gid = wgid / nig, fm = gid * WGM, gsz = (nM - fm) < WGM ? (nM - fm) : WGM;
        u.pm = fm + ((wgid % nig) % gsz); u.pn = (wgid % nig) / gsz; return true;
    }
    __device__ __forceinline__ void a_ready(const Unit&) const {}
    __device__ __forceinline__ void done(const Unit&) const {}
};
__device__ __forceinline__ unsigned cvt_pk_bf16(float lo, float hi) { unsigned r; asm volatile("v_cvt_pk_bf16_f32 %0, %1, %2" : "=v"(r) : "v"(lo), "v"(hi)); return r; }
typedef float f32x2 __attribute__((ext_vector_type(2)));
typedef unsigned u32x2 __attribute__((ext_vector_type(2)));

struct EpiBf16Plain {
    static constexpr bool PERM = true, AFTER_DRAIN = false;
    bf16_t* O; int ldc; int cmask;
    __device__ __forceinline__ void operator()(const f32x4 (&acc)[2][2][4][2], const Unit& u, int wr, int wc, int fr, int fq) const {
        const int row0 = u.pm * BM + wr * 64 + fr; const int col0 = (u.pn & cmask) * BM + wc * 32 + 8 * fq;
#pragma unroll
        for (int ai = 0; ai < 2; ++ai)
#pragma unroll
            for (int m = 0; m < 4; ++m) { bf16_t* rowp = O + (size_t)(row0 + ai * HALF + m * 16) * ldc + col0;
#pragma unroll
                for (int bj = 0; bj < 2; ++bj) { const f32x4 v0 = acc[ai][bj][m][0], v1 = acc[ai][bj][m][1];
                    u32x4 w; w.x = cvt_pk_bf16(v0[0], v0[1]); w.y = cvt_pk_bf16(v0[2], v0[3]); w.z = cvt_pk_bf16(v1[0], v1[1]); w.w = cvt_pk_bf16(v1[2], v1[3]);
                    *(u32x4*)(rowp + bj * HALF) = w; } }
    }
};
struct EpiResid {
    static constexpr bool PERM = false, AFTER_DRAIN = false;
    const float* xin; float* xout; const float* gate;
    int gstride;
    __device__ __forceinline__ void operator()(const f32x4 (&acc)[2][2][4][2], const Unit& u, int wr, int wc, int fr, int fq) const {
        const int row0 = u.pm * BM + wr * 64 + fr, col0 = u.pn * BM + wc * 32 + 4 * fq;
        const float* gp = gate + (size_t)(u.pm >> 3) * gstride;
        f32x4 gv[2][2];
#pragma unroll
        for (int bj = 0; bj < 2; ++bj)
#pragma unroll
            for (int n = 0; n < 2; ++n) gv[bj][n] = *(const f32x4*)(gp + col0 + bj * HALF + n * 16);
#pragma unroll
        for (int ai = 0; ai < 2; ++ai) {
            f32x4 xi[4][2][2];
#pragma unroll
            for (int m = 0; m < 4; ++m) { const size_t ro = (size_t)(row0 + ai * HALF + m * 16) * 1024 + col0;
#pragma unroll
                for (int bj = 0; bj < 2; ++bj)
#pragma unroll
                    for (int n = 0; n < 2; ++n) xi[m][bj][n] = *(const f32x4*)(xin + ro + bj * HALF + n * 16); }
            asm volatile("" ::: "memory");
#pragma unroll
            for (int m = 0; m < 4; ++m) { const size_t ro = (size_t)(row0 + ai * HALF + m * 16) * 1024 + col0;
#pragma unroll
                for (int bj = 0; bj < 2; ++bj)
#pragma unroll
                    for (int n = 0; n < 2; ++n) *(f32x4*)(xout + ro + bj * HALF + n * 16) = xi[m][bj][n] + gv[bj][n] * acc[ai][bj][m][n]; }
            asm volatile("" ::: "memory"); }
    }
};
struct EpiSwiGLU {
    static constexpr bool PERM = false, AFTER_DRAIN = false;
    bf16_t* O;
    __device__ __forceinline__ void operator()(const f32x4 (&acc)[2][2][4][2], const Unit& u, int wr, int wc, int fr, int fq) const {
        const int row0 = u.pm * BM + wr * 64 + fr, col0 = (u.pn & 3) * HALF + wc * 32 + 4 * fq;
#pragma unroll
        for (int ai = 0; ai < 2; ++ai)
#pragma unroll
            for (int m = 0; m < 4; ++m) { bf16_t* rowp = O + (size_t)(row0 + ai * HALF + m * 16) * 512 + col0;
#pragma unroll
                for (int n = 0; n < 2; ++n) { const f32x4 g = acc[ai][0][m][n], up = acc[ai][1][m][n]; f32x4 h;
#pragma unroll
                    for (int j = 0; j < 4; ++j) h[j] = g[j] * __builtin_amdgcn_rcpf(1.0f + __expf(-g[j])) * up[j];
                    u32x2 w; w.x = cvt_pk_bf16(h[0], h[1]); w.y = cvt_pk_bf16(h[2], h[3]);
                    *(u32x2*)(rowp + n * 16) = w; } }
    }
};
struct ExpertOrder {
    const PG8_LAS int* ts; int ntiles, G, c;
    __device__ __forceinline__ bool next(int i, Unit& u) const {
        const int L = i * G + c; if (L >= ntiles * 4) return false;
        const int pm = L >> 2; int e = 0;
#pragma unroll 1
        for (int k = 1; k < 32; ++k) e += (ts[k] <= pm) ? 1 : 0;
        u.pm = pm; u.pn = e * 4 + (L & 3); return true;
    }
    __device__ __forceinline__ void a_ready(const Unit&) const {}
    __device__ __forceinline__ void done(const Unit&) const {}
};

struct UniOrder {
    StaticOrder so; ExpertOrder eo; bool expert;
    __device__ __forceinline__ bool next(int i, Unit& u) const { return expert ? eo.next(i, u) : so.next(i, u); }
    __device__ __forceinline__ void a_ready(const Unit&) const {}
    __device__ __forceinline__ void done(const Unit&) const {}
};
struct EpiUni {
    static constexpr bool AFTER_DRAIN = false;
    int mode; EpiBf16Plain e0; EpiResid e1; EpiSwiGLU e2;
    __device__ __forceinline__ bool perm() const { return mode == 0; }
    __device__ __forceinline__ void operator()(const f32x4 (&acc)[2][2][4][2], const Unit& u, int wr, int wc, int fr, int fq) const {
        if (mode == 0) e0(acc, u, wr, wc, fr, fq); else if (mode == 1) e1(acc, u, wr, wc, fr, fq); else if (mode == 2) e2(acc, u, wr, wc, fr, fq);
    }
};
template <class Epi, class Sched, bool ALIGN_EPI = false, bool SP2 = false>
__device__ __forceinline__ void gemm_phase(PG8_LAS unsigned char* lds, const Gemm g, const Sched& S, const Epi& E) {
    int tid_ = threadIdx.x; asm volatile("" : "+v"(tid_));
    const int tid = tid_, wid = __builtin_amdgcn_readfirstlane(tid >> 6), lane = tid & 63, wr = wid >> 2, wc = wid & 3, fr = lane & 15, fq = lane >> 4;
    const int K = g.K, nt = K / BK;
    unsigned voffA[2], voffB[2];
#pragma unroll
    for (int i = 0; i < 2; ++i) { int R, C; stage_rc(tid * 16 + i * 8192, R, C); const int Rb = E.perm() ? ((R & ~31) + perm32(R & 31)) : R;
        voffA[i] = (unsigned)(R * K + C) * 2u; voffB[i] = (unsigned)(Rb * K + C) * 2u; }
    const size_t kstep = (size_t)(BK * 2);
    const size_t hstep = (size_t)HALF * K * 2;
    const size_t tstep = 2 * hstep;
    const unsigned ldsw = (unsigned)wid * 1024u;
    const int aoff = lds_byte(wr * 64 + fr, fq * 8), boff = lds_byte(wc * 32 + fr, fq * 8);
#define PG8_SA(b, h) (((b) * 2 + (h)) * HTB)
#define PG8_SB(b, h) ((4 + (b) * 2 + (h)) * HTB)
#define PG8_STAGE(bufoff, gbase, voff) do { _Pragma("unroll") for (int _i = 0; _i < 2; ++_i) \
        __builtin_amdgcn_global_load_lds((const unsigned*)((const char*)(gbase) + (voff)[_i]), (PG8_LAS unsigned*)(lds + (bufoff) + ldsw + _i * 8192), 16, 0, 0); } while (0)
#define PG8_LDA(dst, b, h) do { _Pragma("unroll") for (int m = 0; m < 4; ++m) _Pragma("unroll") for (int k = 0; k < 2; ++k) dst[m][k] = *(const PG8_LAS bf16x8*)(lds + PG8_SA(b, h) + aoff + m * 2048 + k * 1024); } while (0)
#define PG8_LDB(dst, b, h) do { _Pragma("unroll") for (int n = 0; n < 2; ++n) _Pragma("unroll") for (int k = 0; k < 2; ++k) dst[n][k] = *(const PG8_LAS bf16x8*)(lds + PG8_SB(b, h) + boff + n * 2048 + k * 1024); } while (0)
#define PG8_MMA(ai, bj, At, Bt) do { __builtin_amdgcn_s_setprio(1); _Pragma("unroll") for (int m = 0; m < 4; ++m) _Pragma("unroll") for (int n = 0; n < 2; ++n) _Pragma("unroll") for (int k = 0; k < 2; ++k) \
        acc[ai][bj][m][n] = __builtin_amdgcn_mfma_f32_16x16x32_bf16(Bt[n][k], At[m][k], acc[ai][bj][m][n], 0, 0, 0); __builtin_amdgcn_s_setprio(0); } while (0)
#define PG8_WAIT_V(n) asm volatile("s_waitcnt vmcnt(" #n ")" ::: "memory")
#define PG8_WAIT_L(n) asm volatile("s_waitcnt lgkmcnt(" #n ")" ::: "memory")
#define PG8_BAR __builtin_amdgcn_s_barrier()
#define PG8_SCHED __builtin_amdgcn_sched_barrier(0)
    Unit cur, nxt; int ui = 0;
    if (!S.next(0, cur)) return;
    f32x4 acc[2][2][4][2];
#pragma unroll
    for (int a = 0; a < 2; ++a)
#pragma unroll
        for (int b = 0; b < 2; ++b)
#pragma unroll
            for (int m = 0; m < 4; ++m)
#pragma unroll
                for (int n = 0; n < 2; ++n) acc[a][b][m][n] = (f32x4){0.f, 0.f, 0.f, 0.f};
    bf16x8 At[4][2], B0[2][2], B1[2][2];
    const char* cA = (const char*)g.A + (size_t)cur.pm * tstep; const char* cB = (const char*)g.Bt + (size_t)cur.pn * tstep;
    S.a_ready(cur);
    if constexpr (SP2) {
        PG8_STAGE(PG8_SB(0, 0), cB, voffB); PG8_STAGE(PG8_SB(0, 1), cB + hstep, voffB); PG8_STAGE(PG8_SA(0, 0), cA, voffA); PG8_STAGE(PG8_SA(0, 1), cA + hstep, voffA);
        if (wr == 1) PG8_BAR;
        PG8_WAIT_V(2); PG8_BAR;
        PG8_STAGE(PG8_SB(1, 0), cB + kstep, voffB); PG8_STAGE(PG8_SA(1, 0), cA + kstep, voffA); PG8_STAGE(PG8_SB(1, 1), cB + hstep + kstep, voffB);
        PG8_WAIT_V(6); PG8_BAR;
    } else {
        PG8_STAGE(PG8_SB(0, 0), cB, voffB); PG8_STAGE(PG8_SA(0, 0), cA, voffA); PG8_STAGE(PG8_SB(0, 1), cB + hstep, voffB); PG8_STAGE(PG8_SA(0, 1), cA + hstep, voffA);
        if (wr == 1) PG8_BAR;
        PG8_WAIT_V(4); PG8_BAR;
        PG8_STAGE(PG8_SB(1, 0), cB + kstep, voffB); PG8_STAGE(PG8_SA(1, 0), cA + kstep, voffA); PG8_STAGE(PG8_SB(1, 1), cB + hstep + kstep, voffB);
        PG8_WAIT_V(6); PG8_BAR;
    }
    for (;;) {
        const bool has_next = S.next(ui + 1, nxt);
        const char* nA = has_next ? (const char*)g.A + (size_t)nxt.pm * tstep : cA; const char* nB = has_next ? (const char*)g.Bt + (size_t)nxt.pn * tstep : cB;
        for (int t = 0; t < nt; t += 2) {
            const bool last = (t == nt - 2);
            const char* a1 = cA + (size_t)(t + 1) * kstep;
            const char* a2 = last ? nA : cA + (size_t)(t + 2) * kstep; const char* b2 = last ? nB : cB + (size_t)(t + 2) * kstep;
            const char* a3 = a2 + kstep; const char* b3 = b2 + kstep;
            if (last && has_next) S.a_ready(nxt);
            if constexpr (SP2) {
            PG8_LDB(B0, 0, 0); PG8_LDB(B1, 0, 1); PG8_SCHED; PG8_LDA(At, 0, 0); PG8_STAGE(PG8_SA(1, 1), a1 + hstep, voffA);
            PG8_WAIT_V(8); PG8_WAIT_L(0); PG8_BAR; PG8_MMA(0, 0, At, B0); PG8_MMA(0, 1, At, B1); PG8_BAR; PG8_SCHED;
            PG8_LDA(At, 0, 1); PG8_STAGE(PG8_SB(0, 0), b2, voffB); PG8_STAGE(PG8_SB(0, 1), b2 + hstep, voffB); PG8_STAGE(PG8_SA(0, 0), a2, voffA);
            PG8_WAIT_V(8); PG8_WAIT_L(0); PG8_BAR; PG8_MMA(1, 0, At, B0); PG8_MMA(1, 1, At, B1); PG8_BAR; PG8_SCHED;
            PG8_LDB(B0, 1, 0); PG8_LDB(B1, 1, 1); PG8_SCHED; PG8_LDA(At, 1, 0); PG8_STAGE(PG8_SA(0, 1), a2 + hstep, voffA);
            PG8_WAIT_V(8); PG8_WAIT_L(0); PG8_BAR; PG8_MMA(0, 0, At, B0); PG8_MMA(0, 1, At, B1); PG8_BAR; PG8_SCHED;
            PG8_LDA(At, 1, 1); PG8_STAGE(PG8_SB(1, 0), b3, voffB); PG8_STAGE(PG8_SB(1, 1), b3 + hstep, voffB); PG8_STAGE(PG8_SA(1, 0), a3, voffA);
            PG8_WAIT_V(8); PG8_WAIT_L(0); PG8_BAR; PG8_MMA(1, 0, At, B0); PG8_MMA(1, 1, At, B1); PG8_BAR; PG8_SCHED;
            } else {
            PG8_LDB(B0, 0, 0); PG8_SCHED; PG8_LDA(At, 0, 0); PG8_STAGE(PG8_SA(1, 1), a1 + hstep, voffA);
            PG8_WAIT_L(8); PG8_BAR; PG8_WAIT_L(0); PG8_MMA(0, 0, At, B0); PG8_BAR; PG8_SCHED;
            PG8_LDB(B1, 0, 1); PG8_STAGE(PG8_SB(0, 0), b2, voffB);
            PG8_BAR; PG8_WAIT_L(0); PG8_MMA(0, 1, At, B1); PG8_BAR;
            PG8_LDA(At, 0, 1); PG8_STAGE(PG8_SA(0, 0), a2, voffA);
            PG8_BAR; PG8_WAIT_L(0); PG8_MMA(1, 0, At, B0); PG8_BAR; PG8_SCHED;
            PG8_STAGE(PG8_SB(0, 1), b2 + hstep, voffB);
            PG8_WAIT_V(6); PG8_BAR; PG8_MMA(1, 1, At, B1); PG8_BAR;
            PG8_LDB(B0, 1, 0); PG8_SCHED; PG8_LDA(At, 1, 0); PG8_STAGE(PG8_SA(0, 1), a2 + hstep, voffA);
            PG8_WAIT_L(8); PG8_BAR; PG8_WAIT_L(0); PG8_MMA(0, 0, At, B0); PG8_BAR; PG8_SCHED;
            PG8_LDB(B1, 1, 1); PG8_STAGE(PG8_SB(1, 0), b3, voffB);
            PG8_BAR; PG8_WAIT_L(0); PG8_MMA(0, 1, At, B1); PG8_BAR;
            PG8_LDA(At, 1, 1); PG8_STAGE(PG8_SA(1, 0), a3, voffA);
            PG8_BAR; PG8_WAIT_L(0); PG8_MMA(1, 0, At, B0); PG8_BAR; PG8_SCHED;
            PG8_STAGE(PG8_SB(1, 1), b3 + hstep, voffB);
            PG8_WAIT_V(6); PG8_BAR; PG8_MMA(1, 1, At, B1); PG8_BAR;
            }
        }
        if constexpr (ALIGN_EPI) { if (wr == 0) PG8_BAR; }
        if constexpr (!Epi::AFTER_DRAIN) { E(acc, cur, wr, wc, fr, fq); S.done(cur); }
        if (!has_next) break;
#pragma unroll
        for (int a = 0; a < 2; ++a)
#pragma unroll
            for (int b = 0; b < 2; ++b)
#pragma unroll
                for (int m = 0; m < 4; ++m)
#pragma unroll
                    for (int n = 0; n < 2; ++n) acc[a][b][m][n] = (f32x4){0.f, 0.f, 0.f, 0.f};
        cur = nxt; cA = nA; cB = nB; ++ui;
        if constexpr (ALIGN_EPI) { if (wr == 1) PG8_BAR; }
    }
    PG8_WAIT_V(0);
    if constexpr (!ALIGN_EPI) { if (wr == 0) PG8_BAR; }
    PG8_BAR;
    if constexpr (Epi::AFTER_DRAIN) { E.fused(acc, cur, wr, wc, fr, fq, lds, wid, lane); S.done(cur); }
#undef PG8_SA
#undef PG8_SB
#undef PG8_STAGE
#undef PG8_LDA
#undef PG8_LDB
#undef PG8_MMA
#undef PG8_WAIT_V
#undef PG8_WAIT_L
#undef PG8_BAR
#undef PG8_SCHED
}
}

constexpr int NWAVES = 8;
constexpr int T = 16384, D = 1024, SEQ = 2048, NBATCH = 8, NHEAD = 16;
constexpr int N_IN = 8448, P_LD = 9472;
constexpr int C_CB = 0, C_CC = 1024, C_CH = 2048, C_GA = 3072, C_GB = 4096, C_R = 5120, C_K = 6144, C_V = 7168, C_WD = 8192, C_AD = 8256, C_GD = 8320, C_VD = 8448;
constexpr int N_SHIFT = 3328, N_EXP = 32, D_EXP = 512;
constexpr int MAXROWS = 40960;
constexpr float NORM_EPS = 1e-6f, LNX_EPS = 64e-5f;

constexpr size_t MiB = 1u << 20;
constexpr size_t WS_CTL = 0, CTL_ZERO_BYTES = 1 * MiB;
constexpr size_t WS_BT_IN = 2 * MiB;
constexpr size_t WS_BT_OUT = 39 * MiB;
constexpr size_t WS_BT_E1 = 43 * MiB;
constexpr size_t WS_BT_E2 = 171 * MiB;
constexpr size_t WS_H = 235 * MiB;
constexpr size_t WS_ALR = WS_H;
constexpr size_t WS_P = 267 * MiB;
constexpr size_t WS_BUF = WS_P, WS_HB = WS_P + 80 * MiB, WS_YE = WS_P + 120 * MiB;
constexpr size_t WS_ADAP = WS_P;
constexpr size_t WS_W = 563 * MiB;
constexpr size_t WS_KK = 627 * MiB, WS_BQ = 659 * MiB, WS_KP = 691 * MiB, WS_R = 723 * MiB, WS_V0 = 755 * MiB, WS_V1 = 787 * MiB;
constexpr size_t WS_LR = 819 * MiB;
constexpr size_t WS_Y = 915 * MiB;
constexpr size_t WS_X = 947 * MiB;
constexpr size_t WS_BONUS = 1011 * MiB;
constexpr size_t WS_EIDX = 1012 * MiB, WS_POS = WS_EIDX + 128 * 1024, WS_WTS = WS_EIDX + 256 * 1024, WS_SLOT = WS_EIDX + 384 * 1024;
constexpr size_t WS_HIST = WS_EIDX + 512 * 1024;
constexpr size_t WS_WRT = WS_EIDX + 768 * 1024;
constexpr size_t WS_KN = WS_KK;
constexpr size_t WS_BONP = WS_KK + 2 * MiB;
constexpr size_t WS_BT_LR = 1015 * MiB;
constexpr size_t WS_END = 1018 * MiB;
static_assert(WS_YE + (size_t)MAXROWS * 1024 * 2 <= WS_W && WS_P + (size_t)T * P_LD * 2 <= WS_W && WS_BT_IN + (size_t)2 * P_LD * 2048 <= WS_BT_OUT, "ws map");
constexpr int CW_CNT = 1024;
constexpr int CW_BAR = 4096;
constexpr size_t CTL_ADA = 256 * 1024;
constexpr size_t CTL_BIASR = 700 * 1024;

constexpr int RING_BYTES = 131072;
constexpr int TAB_OFF = RING_BYTES;
constexpr int MISC_OFF = RING_BYTES + 1024;
constexpr int LDS_BYTES = 147456;

#define GAS __attribute__((address_space(1)))
#define LAS __attribute__((address_space(3)))
typedef unsigned short bf16;
typedef float f32x4 __attribute__((ext_vector_type(4)));
typedef float f32x2 __attribute__((ext_vector_type(2)));
typedef unsigned u32x4 __attribute__((ext_vector_type(4)));
typedef unsigned u32x2 __attribute__((ext_vector_type(2)));
#define LDS_WAIT() asm volatile("s_waitcnt lgkmcnt(0)" ::: "memory")

__device__ __forceinline__ unsigned f2bf(float f) { unsigned u = __builtin_bit_cast(unsigned, f); return (u + 0x7fffu + ((u >> 16) & 1u)) >> 16; }
__device__ __forceinline__ unsigned pk2(float lo, float hi) { return f2bf(lo) | (f2bf(hi) << 16); }
typedef __bf16 bfl2 __attribute__((ext_vector_type(2)));
__device__ __forceinline__ unsigned pkbf(float lo, float hi) { f32x2 v; v.x = lo; v.y = hi; return __builtin_bit_cast(unsigned, __builtin_convertvector(v, bfl2)); }
__device__ __forceinline__ float bflo(unsigned u) { return __builtin_bit_cast(float, u << 16); }
__device__ __forceinline__ float bfhi(unsigned u) { return __builtin_bit_cast(float, u & 0xffff0000u); }
__device__ __forceinline__ void load8(const bf16* p, float (&o)[8]) { const u32x4 u = *(const u32x4*)p; o[0] = bflo(u.x); o[1] = bfhi(u.x); o[2] = bflo(u.y); o[3] = bfhi(u.y); o[4] = bflo(u.z); o[5] = bfhi(u.z); o[6] = bflo(u.w); o[7] = bfhi(u.w); }
__device__ __forceinline__ void store8(bf16* p, const float (&v)[8]) { u32x4 w; w.x = pk2(v[0], v[1]); w.y = pk2(v[2], v[3]); w.z = pk2(v[4], v[5]); w.w = pk2(v[6], v[7]); *(u32x4*)p = w; }
typedef _Float16 f16x2 __attribute__((ext_vector_type(2)));
__device__ __forceinline__ unsigned pkh2(float lo, float hi) { f16x2 h; h.x = (_Float16)lo; h.y = (_Float16)hi; return __builtin_bit_cast(unsigned, h); }
__device__ __forceinline__ float hlo(unsigned u) { return (float)__builtin_bit_cast(f16x2, u).x; }
__device__ __forceinline__ float hhi(unsigned u) { return (float)__builtin_bit_cast(f16x2, u).y; }
__device__ __forceinline__ void load8h(const bf16* p, float (&o)[8]) { const u32x4 u = *(const u32x4*)p; o[0] = hlo(u.x); o[1] = hhi(u.x); o[2] = hlo(u.y); o[3] = hhi(u.y); o[4] = hlo(u.z); o[5] = hhi(u.z); o[6] = hlo(u.w); o[7] = hhi(u.w); }
__device__ __forceinline__ void store8h(bf16* p, const float (&v)[8]) { u32x4 w; w.x = pkh2(v[0], v[1]); w.y = pkh2(v[2], v[3]); w.z = pkh2(v[4], v[5]); w.w = pkh2(v[6], v[7]); *(u32x4*)p = w; }
__device__ __forceinline__ float fmx_lo(float a, unsigned h, float c) { float d; asm("v_fma_mix_f32 %0, %1, %2, %3 op_sel_hi:[0,1,0]" : "=v"(d) : "v"(a), "v"(h), "v"(c)); return d; }
__device__ __forceinline__ float fmx_hi(float a, unsigned h, float c) { float d; asm("v_fma_mix_f32 %0, %1, %2, %3 op_sel:[0,1,0] op_sel_hi:[0,1,0]" : "=v"(d) : "v"(a), "v"(h), "v"(c)); return d; }
__device__ __forceinline__ float mmx_lo(float a, unsigned h) { float d; asm("v_fma_mix_f32 %0, %1, %2, 0 op_sel_hi:[0,1,0]" : "=v"(d) : "v"(a), "v"(h)); return d; }
__device__ __forceinline__ float mmx_hi(float a, unsigned h) { float d; asm("v_fma_mix_f32 %0, %1, %2, 0 op_sel:[0,1,0] op_sel_hi:[0,1,0]" : "=v"(d) : "v"(a), "v"(h)); return d; }
__device__ __forceinline__ float sigmoidf_(float x) { return __builtin_amdgcn_rcpf(1.0f + __expf(-x)); }
__device__ __forceinline__ float tanhf_(float x) { return 1.0f - 2.0f * __builtin_amdgcn_rcpf(__expf(2.0f * x) + 1.0f); }
__device__ __forceinline__ float wave_sum(float v) {
#pragma unroll
    for (int o = 1; o < 64; o <<= 1) v += __shfl_xor(v, o);
    return v;
}
__device__ __forceinline__ float sum8(float v) { v += __shfl_xor(v, 1); v += __shfl_xor(v, 2); v += __shfl_xor(v, 4); return v; }
template <int CTRL> __device__ __forceinline__ float dpp_f(float v) { return __builtin_bit_cast(float, __builtin_amdgcn_mov_dpp(__builtin_bit_cast(int, v), CTRL, 0xF, 0xF, true)); }
__device__ __forceinline__ float dpp_sum16(float v) {
    v += dpp_f<0xB1>(v);
    v += dpp_f<0x4E>(v);
    v += dpp_f<0x141>(v);
    v += dpp_f<0x140>(v);
    return v;
}

#define XB_TMO      128
#define XB_XCNT(j)  (256  + 64 * (j))
#define XB_XSUB(j)  (1280 + 64 * (j))
#define XB_XGEN(j)  (2304 + 64 * (j))
#define XB_TOP      3328
#define XB_TOPGEN   3392
#define XCD_BAR_WORDS 3456
#define XB_SPIN_CAP (1u << 18)

__device__ __forceinline__ unsigned xb_ld(unsigned* p)              { return __hip_atomic_load(p, __ATOMIC_RELAXED, __HIP_MEMORY_SCOPE_AGENT); }
__device__ __forceinline__ unsigned xb_add(unsigned* p, unsigned v) { return __hip_atomic_fetch_add(p, v, __ATOMIC_RELAXED, __HIP_MEMORY_SCOPE_AGENT); }
__device__ __forceinline__ unsigned xb_xcc_id() { return (unsigned)__builtin_amdgcn_s_getreg((3 << 11) | 20) & 0xFu; }
#define XB_SPIN(cond, bar) do { unsigned _sp = 0; while (cond) { __builtin_amdgcn_s_sleep(1); \
    if ((++_sp & 255u) == 0u) { if (xb_ld(&(bar)[XB_TMO])) break; if (_sp > XB_SPIN_CAP) { atomicAdd(&(bar)[XB_TMO], 1u); break; } } } } while (0)

struct XcdBarrier {
    unsigned* bar; unsigned x;
    volatile LAS unsigned* st;
};

__device__ __forceinline__ XcdBarrier xcd_barrier_post(unsigned* bar, volatile LAS unsigned* st) {
    XcdBarrier b; b.bar = bar; b.x = xb_xcc_id(); b.st = st;
    if (threadIdx.x == 0) (void)xb_add(&bar[XB_XCNT(b.x)], 1u);
    return b;
}
__device__ __forceinline__ void xcd_barrier_complete(unsigned* bar, unsigned x, unsigned& nloc, unsigned& nx) {
    const unsigned G = gridDim.x * gridDim.y * gridDim.z;
    unsigned sum, cnt, mine, sp = 0u;
    for (;;) {
        sum = 0u; cnt = 0u; mine = 0u;
#pragma unroll
        for (unsigned j = 0; j < 16; ++j) { const unsigned c = xb_ld(&bar[XB_XCNT(j)]); sum += c; cnt += (c > 0u) ? 1u : 0u; mine = (j == x) ? c : mine; }
        if (sum == G) break;
        __builtin_amdgcn_s_sleep(1);
        if ((++sp & 255u) == 0u) { if (xb_ld(&bar[XB_TMO])) break; if (sp > XB_SPIN_CAP) { atomicAdd(&bar[XB_TMO], 1u); break; } }
    }
    nloc = mine > 0u ? mine : 1u; nx = cnt > 0u ? cnt : 1u;
}

__device__ __forceinline__ void xcd_barrier(const XcdBarrier& b) {
    asm volatile("s_waitcnt vmcnt(0)" ::: "memory");
    __syncthreads();
    if (threadIdx.x == 0) {
        unsigned* bar = b.bar;
        __builtin_amdgcn_s_waitcnt(0);
        unsigned nloc = b.st[0], nx = b.st[1];
        if (nloc == 0u) { xcd_barrier_complete(bar, b.x, nloc, nx); b.st[0] = nloc; b.st[1] = nx; }
        const unsigned old = xb_add(&bar[XB_XSUB(b.x)], 1u);
        const unsigned gen = old / nloc;
        if (old + 1u == (gen + 1u) * nloc) {
            __builtin_amdgcn_fence(__ATOMIC_RELEASE, "agent");
            asm volatile("s_waitcnt vmcnt(0)" ::: "memory");
            const unsigned og = xb_add(&bar[XB_TOP], 1u);
            const unsigned tg = og / nx;
            if (og + 1u == (tg + 1u) * nx) xb_add(&bar[XB_TOPGEN], 1u);
            else XB_SPIN(xb_ld(&bar[XB_TOPGEN]) == tg, bar);
            __builtin_amdgcn_fence(__ATOMIC_ACQUIRE, "agent");
            xb_add(&bar[XB_XGEN(b.x)], 1u);
            asm volatile("s_waitcnt vmcnt(0)" ::: "memory");
        } else {
            XB_SPIN(xb_ld(&bar[XB_XGEN(b.x)]) == gen, bar);
            __builtin_amdgcn_fence(__ATOMIC_ACQUIRE, "agent");
            asm volatile("s_waitcnt vmcnt(0)" ::: "memory");
        }
    }
    __syncthreads();
}

struct Args { const void* p[30]; int ph_lo, ph_hi; };
template <int IDX> __device__ __forceinline__ const float* kin() {
    const auto ka = __builtin_amdgcn_kernarg_segment_ptr(); unsigned long long v;
    asm volatile("s_load_dwordx2 %0, %1, %2\n\ts_waitcnt lgkmcnt(0)" : "=s"(v) : "s"(ka), "i"(IDX * 8) : "memory");
    return (const float*)(const GAS float*)v;
}
enum { I_X = 0, I_C, I_WADA, I_BADA, I_N1G, I_N2G, I_WIN, I_MU, I_CONVW, I_W0, I_DECUP, I_A0, I_AAAUP, I_GATEUP, I_KK, I_KA, I_RK, I_LNW, I_LNB, I_VMD, I_VMU, I_V0, I_WOUT, I_WR, I_RB, I_WE1, I_WE2, I_FG };
struct Frame {
    LAS unsigned char* lds;
    int tid, lane, wave, vcu, G;
    GAS unsigned char* ws;
};
__device__ __forceinline__ float* ada_ptr(const Frame& F, int l, int b) { return (float*)(F.ws + WS_CTL + CTL_ADA) + (size_t)(l * 8 + b) * 6144; }

__device__ __forceinline__ void transpose_item(const float* W, int K, int N, bf16* WT, int dst_row0, int k0, int n0, LAS float* scr, int lane) {
    float tv[32];
#pragma unroll
    for (int i = 0; i < 32; ++i) tv[i] = W[(size_t)(k0 + 2 * i + (lane >> 5)) * N + n0 + (lane & 31)];
#pragma unroll
    for (int i = 0; i < 32; ++i) { const int kk = 2 * i + (lane >> 5); scr[kk * 33 + (lane & 31)] = tv[i]; }
    LDS_WAIT();
    const int c = lane & 7;
#pragma unroll
    for (int j = 0; j < 4; ++j) { const int n = (lane >> 3) + 8 * j; const LAS float* s = scr + (8 * c) * 33 + n;
        u32x4 o; o.x = pk2(s[0 * 33], s[1 * 33]); o.y = pk2(s[2 * 33], s[3 * 33]); o.z = pk2(s[4 * 33], s[5 * 33]); o.w = pk2(s[6 * 33], s[7 * 33]);
        *(u32x4*)(WT + (size_t)(dst_row0 + n) * K + k0 + 8 * c) = o; }
    LDS_WAIT();
}
__device__ __forceinline__ void p0_prologue(const Frame& F) {
    LAS float* scr = (LAS float*)(F.lds + F.wave * 16384);
    const int gw = F.vcu * NWAVES + F.wave, NGW = F.G * NWAVES, lane = F.lane;
    constexpr int I_ADA = 768, I_A = 2 * 16 * 264, I_B = 2 * 16 * 32, I_C1 = 64 * 16 * 32, I_D = 64 * 8 * 32;
    constexpr int NITEMS = I_ADA + I_A + I_B + I_C1 + I_D;
    const float* const pC = kin<I_C>(); const float* const pWADA = kin<I_WADA>(); const float* const pWIN = kin<I_WIN>();
    const float* const pWOUT = kin<I_WOUT>(); const float* const pWE1 = kin<I_WE1>(); const float* const pWE2 = kin<I_WE2>(); const float* const pVMD = kin<I_VMD>();
    for (int it = gw; it < NITEMS; it += NGW) {
        int r = it;
        if (r < I_ADA) {
            const int l = r / 384, rr = r % 384, cch = rr >> 4, kc = rr & 15, col = cch * 256 + 4 * lane, k0 = kc * 64;
            float cv[8];
#pragma unroll
            for (int b = 0; b < 8; ++b) { const float x = pC[b * 1024 + k0 + lane]; cv[b] = x * sigmoidf_(x); }
            f32x4 acc[8];
#pragma unroll
            for (int b = 0; b < 8; ++b) acc[b] = (f32x4){0.f, 0.f, 0.f, 0.f};
            const float* wp = pWADA + ((size_t)l * 1024 + k0) * 6144 + col;
#pragma unroll 16
            for (int kk = 0; kk < 64; ++kk) { const f32x4 w = *(const f32x4*)(wp + (size_t)kk * 6144);
#pragma unroll
                for (int b = 0; b < 8; ++b) { const float s = __builtin_bit_cast(float, __builtin_amdgcn_readlane(__builtin_bit_cast(int, cv[b]), kk)); acc[b] += s * w; } }
#pragma unroll
            for (int b = 0; b < 8; ++b) *(f32x4*)((float*)(F.ws + WS_ADAP) + ((size_t)(kc * 2 + l) * 8 + b) * 6144 + col) = acc[b];
            continue;
        }
        r -= I_ADA;
        if (r < I_A) { const int l = r / (16 * 264), rr = r % (16 * 264), kb = rr / 264, nb = rr % 264;
            transpose_item(pWIN + (size_t)l * 1024 * N_IN, 1024, N_IN, (bf16*)(F.ws + WS_BT_IN) + (size_t)l * P_LD * 1024, 32 * nb, 64 * kb, 32 * nb, scr, lane); continue; }
        r -= I_A;
        if (r < I_B) { const int l = r / 512, rr = r % 512, kb = rr / 32, nb = rr % 32;
            transpose_item(pWOUT + (size_t)l * 1024 * 1024, 1024, 1024, (bf16*)(F.ws + WS_BT_OUT) + (size_t)l * 1024 * 1024, 32 * nb, 64 * kb, 32 * nb, scr, lane); continue; }
        r -= I_B;
        if (r < I_C1) { const int le = r / 512, rr = r % 512, kb = rr / 32, nb = rr % 32, n0 = 32 * nb;
            const int j0 = n0 & 511, dst = (j0 >> 7) * 256 + (n0 >= 512 ? 128 : 0) + (j0 & 127);
            transpose_item(pWE1 + (size_t)le * 1024 * 1024, 1024, 1024, (bf16*)(F.ws + WS_BT_E1) + (size_t)le * 1024 * 1024, dst, 64 * kb, n0, scr, lane); continue; }
        r -= I_C1;
        { const int le = r / 256, rr = r % 256, kb = rr / 32, nb = rr % 32;
            transpose_item(pWE2 + (size_t)le * 512 * 1024, 512, 1024, (bf16*)(F.ws + WS_BT_E2) + (size_t)le * 1024 * 512, 32 * nb, 64 * kb, 32 * nb, scr, lane); }
    }
    const int gt0 = F.vcu * NWAVES * 64 + F.tid, GT = F.G * NWAVES * 64;
    { const float* const pVMUp = kin<I_VMU>();
      for (int it = gt0; it < 1024 * 128; it += GT) { const int n = it >> 7, k0 = (it & 127) * 8; float o[8];
#pragma unroll
        for (int i = 0; i < 8; ++i) o[i] = 0.f;
        for (int j = 0; j < 32; ++j) { const float u = pVMUp[j * 1024 + n];
#pragma unroll
            for (int i = 0; i < 8; ++i) o[i] += pVMD[(k0 + i) * 32 + j] * u; }
        store8((bf16*)(F.ws + WS_BT_IN) + (size_t)P_LD * 1024 + (size_t)(C_VD + n) * 1024 + k0, o); } }
    { const float* const pDU = kin<I_DECUP>(); const float* const pAU = kin<I_AAAUP>(); const float* const pGU = kin<I_GATEUP>();
      for (int it = gt0; it < 2 * 3072 * 32; it += GT) { const int l = it / (3072 * 32), rr = it % (3072 * 32), n = rr >> 5, k0 = (rr & 31) * 8; float o[8];
#pragma unroll
        for (int i = 0; i < 8; ++i) { const int k = k0 + i; float v = 0.f;
            if (n < 1024) { if (k < 64) v = pDU[(size_t)(l * 64 + k) * 1024 + n]; }
            else if (n < 2048) { if (k >= 64 && k < 128) v = pAU[(size_t)(l * 64 + k - 64) * 1024 + n - 1024]; }
            else { if (k >= 128) v = pGU[(size_t)(l * 128 + k - 128) * 1024 + n - 2048]; }
            o[i] = v; }
        store8((bf16*)(F.ws + WS_BT_LR) + (size_t)l * 3072 * 256 + (size_t)n * 256 + k0, o); } }
    { const float* const pWRp = kin<I_WR>(); const int gt = F.vcu * NWAVES * 64 + F.tid; if (gt < 32768) { const float w = pWRp[(gt & 1023) * 32 + (gt >> 10)]; const unsigned hi = f2bf(w);
        ((bf16*)(F.ws + WS_WRT))[gt] = (bf16)hi; ((bf16*)(F.ws + WS_WRT))[32768 + gt] = (bf16)f2bf(w - bflo(hi)); } }
}

__device__ __forceinline__ void p0b_ada_reduce(const Frame& F) {
    const float* const pBADA = kin<I_BADA>(); const float* ap = (const float*)(F.ws + WS_ADAP); float* ada = (float*)(F.ws + WS_CTL + CTL_ADA);
    for (int idx = F.vcu * NWAVES * 64 + F.tid; idx < 2 * 8 * 6144; idx += F.G * NWAVES * 64) { const int l = idx / 49152, r = idx % 49152, c = r % 6144;
        float s = pBADA[l * 6144 + c];
#pragma unroll
        for (int kc = 0; kc < 16; ++kc) s += ap[(size_t)(kc * 2 + l) * 49152 + r];
        ada[idx] = s; }
}

template <int MODE> __device__ __forceinline__ void p1_norm(const Frame& F, int l) {
    const int lane = F.lane;
    const float* const pX = kin<I_X>(); float* const pOUT = (float*)kin<28>(); const float* const pFG = kin<I_FG>(); const float* const pN1G = kin<I_N1G>(); const float* const pWRb = kin<I_WR>();
#pragma unroll 1
    for (int gw = F.vcu * NWAVES + F.wave; gw < T / 8; gw += F.G * NWAVES) { const int tok0 = gw * 8, b = tok0 >> 11;
        f32x4 gm[4], sh[4], g2v[4];
#pragma unroll
        for (int j = 0; j < 4; ++j) { const int c = 4 * lane + 256 * j;
            if (MODE == 2) { gm[j] = *(const f32x4*)(pFG + c); sh[j] = (f32x4){0.f, 0.f, 0.f, 0.f}; }
            else { const float* ad = ada_ptr(F, l, b); const f32x4 g = *(const f32x4*)(pN1G + l * 1024 + c), sc = *(const f32x4*)(ad + 1024 + c); gm[j] = g * (1.0f + sc); sh[j] = *(const f32x4*)(ad + c); }
            if (MODE >= 1) g2v[j] = *(const f32x4*)(ada_ptr(F, MODE == 2 ? 1 : l - 1, b) + 5120 + c); }
        float* X = (float*)(F.ws + WS_X);
        const bf16* YE = (const bf16*)(F.ws + WS_YE);
        const float* WTS = (const float*)(F.ws + WS_WTS); const int* SLOT = (const int*)(F.ws + WS_SLOT);
#pragma unroll 1
        for (int tb = 0; tb < 8; tb += 4) {
            f32x4 v[4][4];
#pragma unroll
            for (int t = 0; t < 4; ++t) { const float* xs = (MODE == 0 ? pX : X) + (size_t)(tok0 + tb + t) * 1024;
#pragma unroll
                for (int j = 0; j < 4; ++j) v[t][j] = *(const f32x4*)(xs + 4 * lane + 256 * j); }
            if (MODE >= 1) {
                float w0[4], w1[4]; int s0[4], s1[4]; u32x2 y0[4][4], y1[4][4];
#pragma unroll
                for (int t = 0; t < 4; ++t) { const int tok = tok0 + tb + t; w0[t] = WTS[tok * 2]; w1[t] = WTS[tok * 2 + 1]; s0[t] = SLOT[tok * 2]; s1[t] = SLOT[tok * 2 + 1]; }
#pragma unroll
                for (int t = 0; t < 4; ++t)
#pragma unroll
                    for (int j = 0; j < 4; ++j) { y0[t][j] = *(const u32x2*)(YE + (size_t)s0[t] * 1024 + 4 * lane + 256 * j); y1[t][j] = *(const u32x2*)(YE + (size_t)s1[t] * 1024 + 4 * lane + 256 * j); }
#pragma unroll
                for (int t = 0; t < 4; ++t)
#pragma unroll
                    for (int j = 0; j < 4; ++j) { const u32x2 a = y0[t][j], c = y1[t][j];
                        f32x4 m; m[0] = w0[t] * bflo(a.x) + w1[t] * bflo(c.x); m[1] = w0[t] * bfhi(a.x) + w1[t] * bfhi(c.x); m[2] = w0[t] * bflo(a.y) + w1[t] * bflo(c.y); m[3] = w0[t] * bfhi(a.y) + w1[t] * bfhi(c.y);
                        v[t][j] += g2v[j] * m; if (MODE == 1) *(f32x4*)(X + (size_t)(tok0 + tb + t) * 1024 + 4 * lane + 256 * j) = v[t][j]; }
            }
            float ss[4];
#pragma unroll
            for (int t = 0; t < 4; ++t) { ss[t] = 0.f;
#pragma unroll
                for (int j = 0; j < 4; ++j) ss[t] += (v[t][j][0] * v[t][j][0] + v[t][j][1] * v[t][j][1]) + (v[t][j][2] * v[t][j][2] + v[t][j][3] * v[t][j][3]); }
#pragma unroll
            for (int o = 1; o < 64; o <<= 1) {
#pragma unroll
                for (int t = 0; t < 4; ++t) ss[t] += __shfl_xor(ss[t], o); }
#pragma unroll
            for (int t = 0; t < 4; ++t) { const int tok = tok0 + tb + t;
                const float rstd = __builtin_amdgcn_rsqf(ss[t] * (1.0f / 1024.0f) + NORM_EPS);
#pragma unroll
                for (int j = 0; j < 4; ++j) { const f32x4 h = v[t][j] * rstd * gm[j] + sh[j];
                    if (MODE == 2) *(f32x4*)(pOUT + (size_t)tok * 1024 + 4 * lane + 256 * j) = h;
                    else { u32x2 w; w.x = pk2(h[0], h[1]); w.y = pk2(h[2], h[3]); *(u32x2*)((bf16*)(F.ws + WS_H) + (size_t)tok * 1024 + 4 * lane + 256 * j) = w; } } }
        }
    }
    if (MODE == 0 && F.vcu < 16) {
        const int lb = F.vcu, e = F.tid & 31, kq = F.tid >> 5; const float* sh2 = ada_ptr(F, lb >> 3, lb & 7) + 3072; float s = 0.f;
        for (int k = kq * 64; k < kq * 64 + 64; ++k) s += sh2[k] * pWRb[k * 32 + e];
        LAS float* red = (LAS float*)F.lds; red[kq * 32 + e] = s; __syncthreads();
        if (F.tid < 32) { float t = 0.f; for (int q = 0; q < 16; ++q) t += red[q * 32 + e]; ((float*)(F.ws + WS_CTL + CTL_BIASR))[lb * 32 + e] = t; }
        __syncthreads();
    }
}

typedef short bfv8 __attribute__((ext_vector_type(8)));
constexpr int LRX_PITCH = 528;
template <int NKS> struct LrW { bfv8 w[2][NKS]; f32x4 b0, b1; };
template <int NKS> __device__ __forceinline__ void lrx_load(LrW<NKS>& W, const bf16* BT, const float* bias, int a, int c0, int li, int fq) {
    const int kbase = (a == 0) ? 0 : ((a == 1) ? 64 : 128);
#pragma unroll
    for (int tile = 0; tile < 2; ++tile) { const bf16* rp = BT + (size_t)(a * 1024 + c0 + 8 * (li >> 2) + 4 * tile + (li & 3)) * 256 + kbase + 8 * fq;
#pragma unroll
        for (int ks = 0; ks < NKS; ++ks) W.w[tile][ks] = *(const bfv8*)(rp + 32 * ks); }
    if (a < 2) { W.b0 = *(const f32x4*)(bias + c0 + 8 * fq); W.b1 = *(const f32x4*)(bias + c0 + 8 * fq + 4); }
}
template <int NKS> __device__ __forceinline__ void lrx_job(const LrW<NKS>& W, const LAS unsigned char* tile, bf16* out, int a, int li, int fq) {
    const int kbase = (a == 0) ? 0 : ((a == 1) ? 64 : 128);
#pragma unroll 2
    for (int mt = 0; mt < 4; ++mt) {
        bfv8 af[NKS];
#pragma unroll
        for (int ks = 0; ks < NKS; ++ks) af[ks] = *(const LAS bfv8*)(tile + (16 * mt + li) * LRX_PITCH + (kbase + 32 * ks + 8 * fq) * 2);
        f32x4 acc0 = (f32x4){0.f, 0.f, 0.f, 0.f}, acc1 = acc0;
#pragma unroll
        for (int ks = 0; ks < NKS; ++ks) { acc0 = __builtin_amdgcn_mfma_f32_16x16x32_bf16(W.w[0][ks], af[ks], acc0, 0, 0, 0); acc1 = __builtin_amdgcn_mfma_f32_16x16x32_bf16(W.w[1][ks], af[ks], acc1, 0, 0, 0); }
        u32x4 o;
        if (a == 0) { float x[8];
#pragma unroll
            for (int j = 0; j < 4; ++j) { x[j] = -0.60653066f * sigmoidf_(W.b0[j] + acc0[j]); x[4 + j] = -0.60653066f * sigmoidf_(W.b1[j] + acc1[j]); }
            o.x = pkh2(x[0], x[1]); o.y = pkh2(x[2], x[3]); o.z = pkh2(x[4], x[5]); o.w = pkh2(x[6], x[7]);
        } else if (a == 1) { float x[8];
#pragma unroll
            for (int j = 0; j < 4; ++j) { x[j] = sigmoidf_(W.b0[j] + acc0[j]); x[4 + j] = sigmoidf_(W.b1[j] + acc1[j]); }
            o.x = pkh2(x[0], x[1]); o.y = pkh2(x[2], x[3]); o.z = pkh2(x[4], x[5]); o.w = pkh2(x[6], x[7]);
        } else { o.x = pkbf(acc0[0], acc0[1]); o.y = pkbf(acc0[2], acc0[3]); o.z = pkbf(acc1[0], acc1[1]); o.w = pkbf(acc1[2], acc1[3]); }
        *(u32x4*)(out + (size_t)(16 * mt) * 3072) = o;
    }
}
__device__ __forceinline__ void p2x_lowrank(const Frame& F, int l) {
    const int lane = F.lane, c8 = lane & 31, hf = lane >> 5, li = lane & 15, fq = lane >> 4;
    const bf16* P = (const bf16*)(F.ws + WS_P); const float* mu = kin<I_MU>() + l * N_SHIFT + 3072 + 8 * c8;
    const f32x4 m0 = *(const f32x4*)mu, m1 = *(const f32x4*)(mu + 4);
    const float* const pKKc = kin<I_KK>() + l * 1024; const float* const muK = kin<I_MU>() + l * N_SHIFT + 1024; float* KNo = (float*)(F.ws + WS_KN);
    const bf16* BT = (const bf16*)(F.ws + WS_BT_LR) + (size_t)l * 3072 * 256; const float* const pW0 = kin<I_W0>() + l * 1024; const float* const pA0 = kin<I_A0>() + l * 1024;
    LAS unsigned char* tile = F.lds;
#pragma unroll 1
    for (int item = F.vcu; item < T / 64; item += F.G) { const int gw = item * 8 + F.wave;
        LrW<2> W2[2]; LrW<4> W4[2];
        lrx_load<2>(W2[0], BT, pW0, 0, F.wave * 128, li, fq);
#pragma unroll
        for (int i = 0; i < 4; ++i) { const int row = 8 * F.wave + 2 * i + hf, tok = item * 64 + row; float cur[8], prv[8], o[8];
            load8(P + (size_t)tok * P_LD + C_WD + 8 * c8, cur);
            if ((tok & (SEQ - 1)) != 0) load8(P + (size_t)(tok - 1) * P_LD + C_WD + 8 * c8, prv); else {
#pragma unroll
                for (int j = 0; j < 8; ++j) prv[j] = 0.f; }
#pragma unroll
            for (int j = 0; j < 8; ++j) { const float v = cur[j] + (prv[j] - cur[j]) * (j < 4 ? m0[j] : m1[j - 4]); o[j] = (c8 < 8) ? tanhf_(v) : ((c8 < 16) ? v : sigmoidf_(v)); }
            u32x4 w; w.x = pkbf(o[0], o[1]); w.y = pkbf(o[2], o[3]); w.z = pkbf(o[4], o[5]); w.w = pkbf(o[6], o[7]);
            *(LAS u32x4*)(tile + row * LRX_PITCH + 16 * c8) = w; }
#pragma unroll 1
        for (int ch = 0; ch < 2; ++ch) { const int col0 = 512 * ch + 8 * lane; float kkc[8], muk[8], kp_[8];
#pragma unroll
            for (int j = 0; j < 8; ++j) { kkc[j] = pKKc[col0 + j]; muk[j] = muK[col0 + j]; kp_[j] = 0.f; }
            const int tok0 = gw * 8;
            if ((tok0 & (SEQ - 1)) != 0) load8(P + (size_t)(tok0 - 1) * P_LD + C_K + col0, kp_);
#pragma unroll 4
            for (int tk = 0; tk < 8; ++tk) { float kc[8]; load8(P + (size_t)(tok0 + tk) * P_LD + C_K + col0, kc); float ss = 0.f;
#pragma unroll
                for (int j = 0; j < 8; ++j) { const float k = (kc[j] + (kp_[j] - kc[j]) * muk[j]) * kkc[j]; ss += k * k; kp_[j] = kc[j]; }
                ss = sum8(ss);
                if ((lane & 7) == 0) KNo[(tok0 + tk) * 16 + 8 * ch + (lane >> 3)] = __builtin_amdgcn_rsqf(fmaxf(ss, 1e-24f)); } }
        __syncthreads();
        bf16* outb = (bf16*)(F.ws + WS_LR) + (size_t)(item * 64 + li) * 3072 + F.wave * 128 + 8 * fq;
#pragma unroll
        for (int j = 0; j < 8; ++j) { const int a = j >> 2, g = j & 3;
            if (j + 1 < 8) lrx_load<2>(W2[(j + 1) & 1], BT, ((j + 1) >> 2) ? pA0 : pW0, (j + 1) >> 2, F.wave * 128 + 32 * ((j + 1) & 3), li, fq); else lrx_load<4>(W4[0], BT, pW0, 2, F.wave * 128, li, fq);
            lrx_job<2>(W2[j & 1], tile, outb + a * 1024 + 32 * g, a, li, fq); }
#pragma unroll
        for (int g = 0; g < 4; ++g) {
            if (g + 1 < 4) lrx_load<4>(W4[(g + 1) & 1], BT, pW0, 2, F.wave * 128 + 32 * (g + 1), li, fq);
            lrx_job<4>(W4[g & 1], tile, outb + 2048 + 32 * g, 2, li, fq); }
        __syncthreads();
    }
}

__device__ __forceinline__ void p3_prep(const Frame& F, int l) {
    const int lane = F.lane;
    const bf16* P = (const bf16*)(F.ws + WS_P); const bf16* LR = (const bf16*)(F.ws + WS_LR);
    const float* mu = kin<I_MU>() + l * N_SHIFT;
    const float* const pA0 = kin<I_A0>() + l * 1024; const float* const pKKc = kin<I_KK>() + l * 1024; const float* const pKA = kin<I_KA>() + l * 1024; const float* const pRK = kin<I_RK>() + l * 1024; const float* const pW0 = kin<I_W0>() + l * 1024; const float* const pV0c = kin<I_V0>();
    bf16* KKo = (bf16*)(F.ws + WS_KK); bf16* BQo = (bf16*)(F.ws + WS_BQ); bf16* KPo = (bf16*)(F.ws + WS_KP); bf16* Ro = (bf16*)(F.ws + WS_R);
    bf16* V0 = (bf16*)(F.ws + WS_V0); bf16* V1 = (bf16*)(F.ws + WS_V1); float* Wo = (float*)(F.ws + WS_W); float* BON = (float*)(F.ws + WS_BONUS);
#pragma unroll 1
    for (int gw = F.vcu * NWAVES + F.wave; gw < T / 8; gw += F.G * NWAVES) { const int tok0 = gw * 8;
#pragma unroll 1
    for (int ch = 0; ch < 2; ++ch) { const int col0 = 512 * ch + 8 * lane, head = 8 * ch + (lane >> 3);
        float a0v[8], kkc[8], kac[8], rkc[8], w0v[8], v0v[8], mur[8], muk[8], muv[8], rp[8], kp_[8], vp[8];
#pragma unroll
        for (int j = 0; j < 8; ++j) { a0v[j] = pA0[col0 + j]; kkc[j] = pKKc[col0 + j]; kac[j] = pKA[col0 + j]; rkc[j] = pRK[col0 + j]; w0v[j] = pW0[col0 + j]; v0v[j] = (l == 1) ? pV0c[col0 + j] : 0.f;
            mur[j] = mu[col0 + j]; muk[j] = mu[1024 + col0 + j]; muv[j] = mu[2048 + col0 + j]; rp[j] = 0.f; kp_[j] = 0.f; vp[j] = 0.f; }
        if ((tok0 & (SEQ - 1)) != 0) { const bf16* pr = P + (size_t)(tok0 - 1) * P_LD + col0; load8(pr + C_R, rp); load8(pr + C_K, kp_); load8(pr + C_V, vp); }
#pragma unroll 2
        for (int tk = 0; tk < 8; ++tk) { const int tok = tok0 + tk; const bf16* pr = P + (size_t)tok * P_LD + col0;
            float rc[8], kc[8], vc[8], dw[8], ap[8], r[8], k[8], v[8], kk[8], kp[8], bq[8], w[8];
            load8(pr + C_R, rc); load8(pr + C_K, kc); load8(pr + C_V, vc); load8(LR + (size_t)tok * 3072 + col0, dw); load8(LR + (size_t)tok * 3072 + 1024 + col0, ap);
            float ss = 0.f, bo = 0.f;
#pragma unroll
            for (int j = 0; j < 8; ++j) { r[j] = rc[j] + (rp[j] - rc[j]) * mur[j]; k[j] = kc[j] + (kp_[j] - kc[j]) * muk[j]; v[j] = vc[j] + (vp[j] - vc[j]) * muv[j]; rp[j] = rc[j]; kp_[j] = kc[j]; vp[j] = vc[j];
                const float av = sigmoidf_(a0v[j] + ap[j]); kk[j] = k[j] * kkc[j]; ss += kk[j] * kk[j]; kp[j] = k[j] * (1.0f + (av - 1.0f) * kac[j]); bo += r[j] * kp[j] * rkc[j]; bq[j] = av;
                const float nd = -(w0v[j] + dw[j]); const float sp = fmaxf(nd, 0.f) + __logf(1.0f + __expf(-fabsf(nd))); w[j] = -__expf(-sp - 0.5f); }
            ss = sum8(ss); bo = sum8(bo);
            const float inv = __builtin_amdgcn_rsqf(fmaxf(ss, 1e-24f));
#pragma unroll
            for (int j = 0; j < 8; ++j) { kk[j] *= inv; bq[j] *= kk[j]; }
            store8h(KKo + (size_t)tok * 1024 + col0, kk); store8h(BQo + (size_t)tok * 1024 + col0, bq); store8h(KPo + (size_t)tok * 1024 + col0, kp); store8h(Ro + (size_t)tok * 1024 + col0, r);
            if ((lane & 7) == 0) BON[tok * 16 + head] = bo;
            float* wp = Wo + (size_t)tok * 1024 + col0; *(f32x4*)wp = (f32x4){w[0], w[1], w[2], w[3]}; *(f32x4*)(wp + 4) = (f32x4){w[4], w[5], w[6], w[7]};
            if (l == 1) { float vf[8], vm[8]; load8h(V0 + (size_t)tok * 1024 + col0, vf); load8(pr + C_VD, vm);
#pragma unroll
                for (int j = 0; j < 8; ++j) v[j] = v[j] + (vf[j] - v[j]) * sigmoidf_(v0v[j] + vm[j]);
                store8h(V1 + (size_t)tok * 1024 + col0, v); }
            else store8h(V0 + (size_t)tok * 1024 + col0, v); }
    }
    }
}

__device__ __forceinline__ f32x4 h4_to_f4(const u32x2 u) { return (f32x4){hlo(u.x), hhi(u.x), hlo(u.y), hhi(u.y)}; }
#if defined(DBG_SCAN)
constexpr size_t WS_YCK = WS_H;
constexpr int SC_CH = 32, SC_BUF = 49152, SC_W = 0, SC_KK = 8192, SC_BQ = 16384, SC_KP = 24576, SC_R = 32768, SC_V = 40960, SC_Y = 45056;
struct ScanRegsSeq { f32x4 w; u32x2 kk, bq, kp, r, v; };
__device__ __forceinline__ void scan_issue(const Frame& F, int l, int b, int h, int half, int cc, ScanRegsSeq& R) {
    const int s = F.tid >> 4, q = F.tid & 15; const size_t base = ((size_t)b * SEQ + cc * SC_CH + s) * 1024 + h * 64 + 4 * q;
    R.w = *(const f32x4*)((const float*)(F.ws + WS_W) + base);
    R.kk = *(const u32x2*)((const bf16*)(F.ws + WS_KK) + base); R.bq = *(const u32x2*)((const bf16*)(F.ws + WS_BQ) + base);
    R.kp = *(const u32x2*)((const bf16*)(F.ws + WS_KP) + base); R.r = *(const u32x2*)((const bf16*)(F.ws + WS_R) + base);
    if (F.tid < 256) { const int s2 = F.tid >> 3, r4 = F.tid & 7; R.v = *(const u32x2*)((const bf16*)(F.ws + (l == 0 ? WS_V0 : WS_V1)) + ((size_t)b * SEQ + cc * SC_CH + s2) * 1024 + h * 64 + half * 32 + 4 * r4); }
}
__device__ __forceinline__ void scan_commit(const Frame& F, int buf, const ScanRegsSeq& R) {
    const int s = F.tid >> 4, q = F.tid & 15; LAS unsigned char* B = F.lds + buf * SC_BUF + (s * 16 + q) * 16;
    *(LAS f32x4*)(B + SC_W) = (f32x4){__expf(R.w[0]), __expf(R.w[1]), __expf(R.w[2]), __expf(R.w[3])};     *(LAS f32x4*)(B + SC_KK) = h4_to_f4(R.kk); *(LAS f32x4*)(B + SC_BQ) = h4_to_f4(R.bq); *(LAS f32x4*)(B + SC_KP) = h4_to_f4(R.kp); *(LAS f32x4*)(B + SC_R) = h4_to_f4(R.r);
    if (F.tid < 256) { const int s2 = F.tid >> 3, r4 = F.tid & 7; *(LAS f32x4*)(F.lds + buf * SC_BUF + SC_V + (s2 * 32 + 4 * r4) * 4) = h4_to_f4(R.v); }
}
__device__ __forceinline__ void scan_store(const Frame& F, int b, int h, int half, int cc, int buf) {
    if (F.tid < 256) { const int s2 = F.tid >> 3, r4 = F.tid & 7;
        const f32x4 y = *(const LAS f32x4*)(F.lds + buf * SC_BUF + SC_Y + (s2 * 32 + 4 * r4) * 4);
        u32x2 w; w.x = pk2(y[0], y[1]); w.y = pk2(y[2], y[3]);
        const int t = cc * SC_CH + s2 - 1;
        if (t >= 0) *(u32x2*)((bf16*)(F.ws + WS_Y) + ((size_t)b * SEQ + t) * 1024 + h * 64 + half * 32 + 4 * r4) = w; }
}
__device__ __forceinline__ void p4_scan_seq(const Frame& F, int l) {
#pragma unroll 1
    for (int unit = F.vcu; unit < NBATCH * NHEAD * 2; unit += F.G) {
        const int b = unit >> 5, h = (unit >> 1) & 15, half = unit & 1;
        const int g = F.lane >> 4, q = F.lane & 15, row = F.wave * 4 + g;
        f32x2 sA = (f32x2){0.f, 0.f}, sB = sA; float yp = 0.f; const bool odd = (q & 1) != 0;
        ScanRegsSeq SR;
        bf16* SAdbg = (bf16*)(F.ws + WS_V1) + (size_t)b * SEQ * 1024 + h * 64 + half * 32 + row;
        scan_issue(F, l, b, h, half, 0, SR); scan_commit(F, 0, SR); scan_issue(F, l, b, h, half, 1, SR);
        __syncthreads();
        constexpr int NCH = SEQ / SC_CH;
#pragma unroll 1
        for (int cc = 0; cc < NCH; ++cc) { const int buf = cc & 1;
            { const LAS unsigned char* B = F.lds + buf * SC_BUF;
              const LAS f32x4* pc = (const LAS f32x4*)B + q;
              const LAS float* pv = (const LAS float*)(B + SC_V) + row; LAS float* py = (LAS float*)(B + SC_Y) + row;
              f32x4 aw[2], ak[2], ab[2], ap[2], ar[2], bw[2], bk[2], bb[2], bp[2], br_[2]; float av[2], bv[2];
#define SC_LOAD(dw, dk, db, dp, dr, dv, s) do { dw = pc[(s) * 16]; dk = pc[(s) * 16 + 512]; db = pc[(s) * 16 + 1024]; dp = pc[(s) * 16 + 1536]; dr = pc[(s) * 16 + 2048]; dv = pv[(s) * 32]; } while (0)
#define SC_STEP(cw, ck, cb, cp, cr, cv, yo, sidx) do { \
        f32x2 t = sA * ck.lo; t = sB * ck.hi + t; \
        const float pa = t.x + t.y; \
        float x = odd ? yp : pa; const float z = odd ? pa : yp; \
        x += dpp_f<0xB1>(z); x += dpp_f<0x4E>(x); x += dpp_f<0x124>(x); x += dpp_f<0x128>(x); \
        const float sa = dpp_f<0xA0>(x); \
        if (l == 0 && q == 0) SAdbg[(size_t)(cc * SC_CH + (sidx)) * 1024] = (bf16)f2bf(sa); \
        f32x2 xA = cv * cp.lo, xB = cv * cp.hi; \
        xA = xA - sa * cb.lo; xB = xB - sa * cb.hi; \
        sA = sA * cw.lo + xA; sB = sB * cw.hi + xB; \
        f32x2 yv = sA * cr.lo; yv = sB * cr.hi + yv; \
        yo = x; yp = yv.x + yv.y; } while (0)
#pragma unroll
              for (int i = 0; i < 2; ++i) SC_LOAD(aw[i], ak[i], ab[i], ap[i], ar[i], av[i], i);
#pragma unroll 1
              for (int s4 = 0; s4 < SC_CH; s4 += 4) {
#pragma unroll
                  for (int i = 0; i < 2; ++i) SC_LOAD(bw[i], bk[i], bb[i], bp[i], br_[i], bv[i], s4 + 2 + i);
                  float yo[2];
#pragma unroll
                  for (int i = 0; i < 2; ++i) SC_STEP(aw[i], ak[i], ab[i], ap[i], ar[i], av[i], yo[i], s4 + i);
                  if (q == 1) { py[(s4 + 0) * 32] = yo[0]; py[(s4 + 1) * 32] = yo[1]; }
                  const int sn = (s4 + 4 < SC_CH) ? s4 + 4 : s4;
#pragma unroll
                  for (int i = 0; i < 2; ++i) SC_LOAD(aw[i], ak[i], ab[i], ap[i], ar[i], av[i], sn + i);
#pragma unroll
                  for (int i = 0; i < 2; ++i) SC_STEP(bw[i], bk[i], bb[i], bp[i], br_[i], bv[i], yo[i], s4 + 2 + i);
                  if (q == 1) { py[(s4 + 2) * 32] = yo[0]; py[(s4 + 3) * 32] = yo[1]; }
              }
#undef SC_STEP
#undef SC_LOAD
            }
            if (cc + 1 < NCH) scan_commit(F, buf ^ 1, SR);
            if (cc + 2 < NCH) scan_issue(F, l, b, h, half, cc + 2, SR);
            asm volatile("s_waitcnt lgkmcnt(0)" ::: "memory"); __builtin_amdgcn_s_barrier(); asm volatile("" ::: "memory");
            scan_store(F, b, h, half, cc, buf);
        }
        { const float yl = dpp_sum16(yp);
          if (q == 0) ((bf16*)(F.ws + WS_Y))[((size_t)b * SEQ + SEQ - 1) * 1024 + h * 64 + half * 32 + row] = (bf16)f2bf(yl); }
        __syncthreads();
    }
}

#else
constexpr size_t WS_YCK = WS_Y;
#endif
typedef short bf16x8 __attribute__((ext_vector_type(8)));
typedef float f32x16 __attribute__((ext_vector_type(16)));
constexpr int CK_XK = 0, CK_XR = 4608, CK_BH = 9216, CK_KH = 14336, CK_GB = 19456, CK_VT = 19712, CK_X3SZ = 22272;
constexpr int CK_XB = 0, CK_XP = 4608, CK_P2SZ = 9216;
constexpr int CK_TK = 0, CK_TBR = 2560, CK_TKR = 5120, CK_T12 = 7680, CK_TBT = 11776, CK_MT = 15872, CK_T2SZ = 18432;
constexpr int CK_X3_OFF = 0, CK_P2_OFF = 3 * CK_X3SZ, CK_T2_OFF = CK_P2_OFF + 2 * CK_P2SZ, CK_STASH = CK_T2_OFF + 2 * CK_T2SZ;
static_assert(CK_STASH + 8192 <= RING_BYTES, "chunked-scan LDS map");
#define CK_MFMA(a, b, c) __builtin_amdgcn_mfma_f32_32x32x16_bf16((a), (b), (c), 0, 0, 0)
__device__ __forceinline__ bf16x8 ck_frag(const LAS unsigned char* base, int pitch, int row, int kel) { return *(const LAS bf16x8*)(base + row * pitch + kel * 2); }
struct CkRegs { u32x2 rP, rA, rB, kP, kA, kB, vP, vA, vB, dwA, dwB, apA, apB, vmA, vmB, vfA, vfB; float knA, knB; };
struct CkConst { f32x4 a0, kk, ka, rk, w0, v0, mur, muk, muv; };
__device__ __forceinline__ f32x4 b4_to_f4(const u32x2 u) { return (f32x4){bflo(u.x), bfhi(u.x), bflo(u.y), bfhi(u.y)}; }
__device__ __forceinline__ void ck_issue(const Frame& F, int pw, int l, int b, int h, int half, int blk, CkRegs& R) {
    const int s2 = F.lane >> 2, cq = F.lane & 3, col = h * 64 + 16 * pw + 4 * cq; const size_t tA = (size_t)b * SEQ + blk * 32 + 2 * s2;
    const bf16* P = (const bf16*)(F.ws + WS_P) + tA * P_LD + col; const bf16* LR = (const bf16*)(F.ws + WS_LR) + tA * 3072 + col; const float* KN = (const float*)(F.ws + WS_KN) + tA * 16 + h;
    R.rA = *(const u32x2*)(P + C_R); R.rB = *(const u32x2*)(P + P_LD + C_R); R.kA = *(const u32x2*)(P + C_K); R.kB = *(const u32x2*)(P + P_LD + C_K); R.vA = *(const u32x2*)(P + C_V); R.vB = *(const u32x2*)(P + P_LD + C_V);
    if ((tA & (SEQ - 1)) != 0) { R.rP = *(const u32x2*)(P - P_LD + C_R); R.kP = *(const u32x2*)(P - P_LD + C_K); R.vP = *(const u32x2*)(P - P_LD + C_V); } else { R.rP = (u32x2){0u, 0u}; R.kP = R.rP; R.vP = R.rP; }
    R.dwA = *(const u32x2*)LR; R.dwB = *(const u32x2*)(LR + 3072); R.apA = *(const u32x2*)(LR + 1024); R.apB = *(const u32x2*)(LR + 3072 + 1024);
    R.knA = KN[0]; R.knB = KN[16];
    if (l == 1) { R.vmA = *(const u32x2*)(P + C_VD); R.vmB = *(const u32x2*)(P + P_LD + C_VD); const bf16* V0 = (const bf16*)(F.ws + WS_V0) + tA * 1024 + col; R.vfA = *(const u32x2*)V0; R.vfB = *(const u32x2*)(V0 + 1024); }
    (void)half;
}
__device__ __forceinline__ void ck_elem(const CkConst& C, int l, const f32x4 rc, const f32x4 rp, const f32x4 kc, const f32x4 kp_, const f32x4 vc, const f32x4 vp, const f32x4 dw, const f32x4 ap, const float kn,
                                        const f32x4 vm, const f32x4 vf, f32x4& r, f32x4& kk, f32x4& bq, f32x4& kp, f32x4& lw, f32x4& v, float& bo) {
#pragma unroll
    for (int e = 0; e < 4; ++e) {
        r[e] = rc[e] + (rp[e] - rc[e]) * C.mur[e]; const float k = kc[e] + (kp_[e] - kc[e]) * C.muk[e]; float vv = vc[e] + (vp[e] - vc[e]) * C.muv[e];
        const float av = ap[e]; kk[e] = k * C.kk[e] * kn;     bq[e] = kk[e] * av; kp[e] = k * (1.0f + (av - 1.0f) * C.ka[e]); bo += r[e] * kp[e] * C.rk[e];
        lw[e] = dw[e];
        if (l == 1) vv = vv + (vf[e] - vv) * sigmoidf_(C.v0[e] + vm[e]);
        v[e] = vv; }
}
__device__ __forceinline__ void ck_stage1(const Frame& F, int pw, int l, int b, int h, int half, int blk, const CkConst& C, LAS unsigned char* BX, LAS unsigned char* BP, CkRegs& R, bool issue_next) {
    const int lane = F.lane, s2 = lane >> 2, cq = lane & 3, c0 = 16 * pw + 4 * cq, cp = 16 * pw + 4 * (((cq & 1) << 1) | (cq >> 1));
    f32x4 kkA, kkB, bqA, bqB, kpA, kpB, rA, rB, lwA, lwB, vA, vB; float boA = 0.f, boB = 0.f;
    { const f32x4 rcA = b4_to_f4(R.rA), kcA = b4_to_f4(R.kA), vcA = b4_to_f4(R.vA), zz = (f32x4){0.f, 0.f, 0.f, 0.f};
      ck_elem(C, l, rcA, b4_to_f4(R.rP), kcA, b4_to_f4(R.kP), vcA, b4_to_f4(R.vP), h4_to_f4(R.dwA), h4_to_f4(R.apA), R.knA, l == 1 ? b4_to_f4(R.vmA) : zz, l == 1 ? h4_to_f4(R.vfA) : zz, rA, kkA, bqA, kpA, lwA, vA, boA);
      ck_elem(C, l, b4_to_f4(R.rB), rcA, b4_to_f4(R.kB), kcA, b4_to_f4(R.vB), vcA, h4_to_f4(R.dwB), h4_to_f4(R.apB), R.knB, l == 1 ? b4_to_f4(R.vmB) : zz, l == 1 ? h4_to_f4(R.vfB) : zz, rB, kkB, bqB, kpB, lwB, vB, boB); }
    asm volatile("" ::: "memory");
    if (issue_next) ck_issue(F, pw, l, b, h, half, blk + 1, R);
    asm volatile("" ::: "memory");
    { const size_t tA = (size_t)b * SEQ + blk * 32 + 2 * s2;
      boA += __shfl_xor(boA, 1); boA += __shfl_xor(boA, 2); boB += __shfl_xor(boB, 1); boB += __shfl_xor(boB, 2);
      if ((pw >> 1) == half) { if (cq == 0) { float* bp = (float*)(F.ws + WS_BONP) + (tA * 16 + h) * 4 + pw; bp[0] = boA; bp[64] = boB; }
          bf16* Vo = (bf16*)(F.ws + (l == 0 ? WS_V0 : WS_V1)) + tA * 1024 + h * 64 + c0;
          *(u32x2*)Vo = (u32x2){pkh2(vA[0], vA[1]), pkh2(vA[2], vA[3])}; *(u32x2*)(Vo + 1024) = (u32x2){pkh2(vB[0], vB[1]), pkh2(vB[2], vB[3])};
#pragma unroll
          for (int e = 0; e < 4; ++e) *(LAS unsigned*)(BX + CK_VT + (16 * (pw & 1) + 4 * cq + e) * 80 + (2 * s2) * 2) = pkbf(vA[e], vB[e]); } }
    float xkA[4], xkB[4], xrA[4], xrB[4], xbA[4], xbB[4], xpA[4], xpB[4], bhA[4], bhB[4], khA[4], khB[4], gb[4];
    float xs[4], Tr[4][4];
#pragma unroll
    for (int e = 0; e < 4; ++e) { lwA[e] *= 1.44269504f; lwB[e] *= 1.44269504f; float x = lwA[e] + lwB[e]; x += dpp_f<0x114>(x); x += dpp_f<0x118>(x); xs[e] = x; }
#pragma unroll
    for (int e = 0; e < 4; ++e)
#pragma unroll
        for (int rw = 0; rw < 4; ++rw) Tr[e][rw] = __shfl(xs[e], 16 * rw + 12 + cq);
    { const int row = lane >> 4; const float m0 = row > 0 ? 1.f : 0.f, m1 = row > 1 ? 1.f : 0.f, m2 = row > 2 ? 1.f : 0.f;
#pragma unroll
    for (int e = 0; e < 4; ++e) {
        const float LB = xs[e] + (m0 * Tr[e][0] + m1 * Tr[e][1] + m2 * Tr[e][2]), LA = LB - lwB[e], L0 = LA - lwA[e], Lt = (Tr[e][0] + Tr[e][1]) + (Tr[e][2] + Tr[e][3]);
        const float eL0 = __builtin_amdgcn_exp2f(L0), eLA = __builtin_amdgcn_exp2f(LA), eLB = __builtin_amdgcn_exp2f(LB), iLA = __builtin_amdgcn_exp2f(-LA), iLB = __builtin_amdgcn_exp2f(-LB), eLt = __builtin_amdgcn_exp2f(Lt), tA = eLt * iLA, tB = eLt * iLB;
        xkA[e] = kkA[e] * eL0; xkB[e] = kkB[e] * eLA; xrA[e] = rA[e] * eLA; xrB[e] = rB[e] * eLB;
        xbA[e] = bqA[e] * iLA; xbB[e] = bqB[e] * iLB; xpA[e] = kpA[e] * iLA; xpB[e] = kpB[e] * iLB;
        bhA[e] = bqA[e] * tA; bhB[e] = bqB[e] * tB; khA[e] = kpA[e] * tA; khB[e] = kpB[e] * tB; gb[e] = eLt;
    } }
    const int oA = (2 * s2) * 144 + cp * 2, oB = oA + 144;
    *(LAS u32x2*)(BX + CK_XK + oA) = (u32x2){pkbf(xkA[0], xkA[1]), pkbf(xkA[2], xkA[3])}; *(LAS u32x2*)(BX + CK_XK + oB) = (u32x2){pkbf(xkB[0], xkB[1]), pkbf(xkB[2], xkB[3])};
    *(LAS u32x2*)(BX + CK_XR + oA) = (u32x2){pkbf(xrA[0], xrA[1]), pkbf(xrA[2], xrA[3])}; *(LAS u32x2*)(BX + CK_XR + oB) = (u32x2){pkbf(xrB[0], xrB[1]), pkbf(xrB[2], xrB[3])};
    *(LAS u32x2*)(BP + CK_XB + oA) = (u32x2){pkbf(xbA[0], xbA[1]), pkbf(xbA[2], xbA[3])}; *(LAS u32x2*)(BP + CK_XB + oB) = (u32x2){pkbf(xbB[0], xbB[1]), pkbf(xbB[2], xbB[3])};
    *(LAS u32x2*)(BP + CK_XP + oA) = (u32x2){pkbf(xpA[0], xpA[1]), pkbf(xpA[2], xpA[3])}; *(LAS u32x2*)(BP + CK_XP + oB) = (u32x2){pkbf(xpB[0], xpB[1]), pkbf(xpB[2], xpB[3])};
    const int i0 = 2 * s2, pst = (i0 & 16) | ((i0 & 4) << 1) | ((i0 & 8) >> 1) | (i0 & 3);
#pragma unroll
    for (int e = 0; e < 4; ++e) { *(LAS unsigned*)(BX + CK_BH + (c0 + e) * 80 + pst * 2) = pkbf(bhA[e], bhB[e]); *(LAS unsigned*)(BX + CK_KH + (c0 + e) * 80 + (2 * s2) * 2) = pkbf(khA[e], khB[e]); }
    if (s2 == 0) *(LAS f32x4*)(BX + CK_GB + c0 * 4) = (f32x4){gb[0], gb[1], gb[2], gb[3]};

}
__device__ __forceinline__ void ck_stage2(const Frame& F, int ti, const LAS unsigned char* BX, const LAS unsigned char* BP, LAS unsigned char* BT) {
    const int r = F.lane & 31, hh = F.lane >> 5;
    const LAS unsigned char* Aa = BP + ((ti < 2) ? CK_XB : CK_XP); const LAS unsigned char* Ba = BX + ((ti & 1) ? CK_XR : CK_XK);
    f32x16 acc;
#pragma unroll
    for (int i = 0; i < 16; ++i) acc[i] = 0.f;
#pragma unroll
    for (int ks = 0; ks < 4; ++ks) acc = CK_MFMA(ck_frag(Aa, 144, r, 16 * ks + 8 * hh), ck_frag(Ba, 144, r, 16 * ks + 8 * hh), acc);
    if (ti == 0) {
        { const u32x4 z = (u32x4){0u, 0u, 0u, 0u}, w = (u32x4){pkbf(acc[0], acc[1]), pkbf(acc[2], acc[3]), pkbf(acc[4], acc[5]), pkbf(acc[6], acc[7])};
          *(LAS u32x4*)(BT + CK_T12 + r * 80 + 16 * hh) = (r >= 16) ? w : z; }
#pragma unroll
        for (int m = 0; m < 4; ++m) { f32x4 t;
#pragma unroll
            for (int e = 0; e < 4; ++e) t[e] = (8 * m + 4 * hh + e < r) ? acc[4 * m + e] : 0.f;
            *(LAS f32x4*)(BT + CK_TBT + (r * 32 + 8 * m + 4 * hh) * 4) = t; }
    } else { const int off = (ti == 1) ? CK_TBR : ((ti == 2) ? CK_TK : CK_TKR);
#pragma unroll
        for (int m = 0; m < 4; ++m) { float t[4];
#pragma unroll
            for (int e = 0; e < 4; ++e) { const int i = 8 * m + 4 * hh + e; const bool keep = (ti == 2) ? (i < r) : (i <= r); t[e] = keep ? acc[4 * m + e] : 0.f; }
            const int col = (ti == 1) ? (16 * (m >> 1) + 8 * hh + 4 * (m & 1)) : (8 * m + 4 * hh);
            *(LAS u32x2*)(BT + off + r * 80 + col * 2) = (u32x2){pkbf(t[0], t[1]), pkbf(t[2], t[3])}; }
    }
    if (ti == 0) {
        LDS_WAIT();
        const int qb = (r >> 4) & 1;
        const LAS float* TBT = (const LAS float*)(BT + CK_TBT) + (16 * qb) * 32 + 16 * qb;
        float x[16];
        int cc = r & 15; asm volatile("" : "+v"(cc));
#pragma unroll
        for (int k = 0; k < 16; ++k) x[k] = (k == cc) ? 1.f : 0.f;
        { f32x4 tc[4], tn[4];
#pragma unroll
          for (int j4 = 0; j4 < 4; ++j4) tc[j4] = *(const LAS f32x4*)(TBT + 15 * 32 + 4 * j4);
#pragma unroll
          for (int kk = 0; kk < 15; ++kk) { const int k = 15 - kk; const float xk = x[k];
              int off = (k - 1) * 32; asm volatile("" : "+v"(off) : "v"(xk));
              if (k - 1 >= 1) {
#pragma unroll
                  for (int j4 = 0; j4 <= (k - 2) / 4; ++j4) tn[j4] = *(const LAS f32x4*)(TBT + off + 4 * j4); }
#pragma unroll
              for (int j4 = 0; j4 <= (k - 1) / 4; ++j4) {
#pragma unroll
                  for (int e = 0; e < 4; ++e) { const int i = 4 * j4 + e; if (i < k) x[i] = __builtin_fmaf(-tc[j4][e], xk, x[i]); } }
#pragma unroll
              for (int j4 = 0; j4 < 4; ++j4) tc[j4] = tn[j4]; } }
        if (hh == 0) { const u32x4 z = (u32x4){0u, 0u, 0u, 0u};
            const u32x4 w0 = (u32x4){pkbf(x[0], x[1]), pkbf(x[2], x[3]), pkbf(x[8], x[9]), pkbf(x[10], x[11])}, w1 = (u32x4){pkbf(x[4], x[5]), pkbf(x[6], x[7]), pkbf(x[12], x[13]), pkbf(x[14], x[15])};
            LAS unsigned char* row = BT + CK_MT + r * 80;
            *(LAS u32x4*)(row + 32 * qb) = w0; *(LAS u32x4*)(row + 32 * qb + 16) = w1; *(LAS u32x4*)(row + 32 * (1 - qb)) = z; *(LAS u32x4*)(row + 32 * (1 - qb) + 16) = z; }
    }
}
#define CK_BAR() do { asm volatile("s_waitcnt lgkmcnt(0)" ::: "memory"); __builtin_amdgcn_s_barrier(); asm volatile("" ::: "memory"); } while (0)
__device__ __forceinline__ void p4_scan(const Frame& F, int l, int probe = 0) {
#pragma unroll 1
    for (int unit = F.vcu; unit < NBATCH * NHEAD * 2; unit += F.G) {
        const int b = unit >> 5, h = (unit >> 1) & 15, half = unit & 1;
        const bool pre = F.wave >= 4, mainw = F.wave == 0;
        const int r = F.lane & 31, hh = F.lane >> 5;
        constexpr int NBLKc = SEQ / 32;
        const int w_ = F.wave;
        if (w_ == 0) {
            f32x16 ST0, ST1;
#pragma unroll
            for (int i = 0; i < 16; ++i) { ST0[i] = 0.f; ST1[i] = 0.f; }
#pragma unroll 1
            for (int blk = -2; blk < NBLKc; ++blk) {
                const LAS unsigned char* BX = F.lds + CK_X3_OFF + ((blk + 3) % 3) * CK_X3SZ; const LAS unsigned char* BT = F.lds + CK_T2_OFF + (blk & 1) * CK_T2SZ;
                bf16x8 SH[2][2], SL[2][2], NUF[2], VF[2]; f32x16 RH, YT;
                if (blk >= 0 && !(probe & 1)) {
#pragma unroll
                for (int c = 0; c < 2; ++c)
#pragma unroll
                    for (int s = 0; s < 2; ++s) { u32x4 ph, pl;
#pragma unroll
                        for (int p = 0; p < 4; ++p) { const float x0 = (c ? ST1 : ST0)[8 * s + 2 * p], x1 = (c ? ST1 : ST0)[8 * s + 2 * p + 1]; const unsigned hp = pkbf(x0, x1);
                            ph[p] = hp;
#if defined(CK_LO)
                            pl[p] = pkbf(x0 - bflo(hp), x1 - bfhi(hp));
#endif
                        }
                        SH[c][s] = __builtin_bit_cast(bf16x8, ph);
#if defined(CK_LO)
                        SL[c][s] = __builtin_bit_cast(bf16x8, pl);
#endif
                    }
                { LAS f32x4* stash = (LAS f32x4*)(F.lds + CK_STASH) + F.lane;
#pragma unroll
                  for (int m = 0; m < 4; ++m) { stash[64 * m] = (f32x4){ST0[4 * m], ST0[4 * m + 1], ST0[4 * m + 2], ST0[4 * m + 3]}; stash[64 * (4 + m)] = (f32x4){ST1[4 * m], ST1[4 * m + 1], ST1[4 * m + 2], ST1[4 * m + 3]}; } }
                VF[0] = ck_frag(BX + CK_VT, 80, r, 8 * hh); VF[1] = ck_frag(BX + CK_VT, 80, r, 16 + 8 * hh);
#pragma unroll
                for (int i = 0; i < 16; ++i) RH[i] = 0.f;
                { bf16x8 ak[2][2], at[2];
#pragma unroll
                  for (int c = 0; c < 2; ++c)
#pragma unroll
                      for (int s = 0; s < 2; ++s) ak[c][s] = ck_frag(BX + CK_XK, 144, r, 32 * c + 16 * s + 8 * hh);
                  at[0] = ck_frag(BT + CK_TK, 80, r, 8 * hh); at[1] = ck_frag(BT + CK_TK, 80, r, 16 + 8 * hh);
#pragma unroll
                  for (int c = 0; c < 2; ++c)
#pragma unroll
                      for (int s = 0; s < 2; ++s) RH = CK_MFMA(ak[c][s], SH[c][s], RH);
#pragma unroll
                  for (int ks = 0; ks < 2; ++ks) RH = CK_MFMA(at[ks], VF[ks], RH); }
                { const bf16x8 mt0 = ck_frag(BT + CK_MT, 80, r, 8 * hh), mt1 = ck_frag(BT + CK_MT, 80, r, 16 + 8 * hh), t12 = ck_frag(BT + CK_T12, 80, r, 8 * hh);
                  u32x4 p4;
#pragma unroll
                  for (int p = 0; p < 4; ++p) p4[p] = pkbf(RH[2 * p], RH[2 * p + 1]);
                  f32x16 UT;
#pragma unroll
                  for (int i = 0; i < 16; ++i) UT[i] = 0.f;
                  UT = CK_MFMA(mt0, __builtin_bit_cast(bf16x8, p4), UT);
#pragma unroll
                  for (int p = 0; p < 4; ++p) p4[p] = pkbf(UT[2 * p], UT[2 * p + 1]) ^ 0x80008000u;
                  NUF[0] = __builtin_bit_cast(bf16x8, p4);
                  RH = CK_MFMA(t12, NUF[0], RH);
#pragma unroll
                  for (int p = 0; p < 4; ++p) p4[p] = pkbf(RH[8 + 2 * p], RH[8 + 2 * p + 1]);
                  UT = CK_MFMA(mt1, __builtin_bit_cast(bf16x8, p4), UT);
#pragma unroll
                  for (int p = 0; p < 4; ++p) p4[p] = pkbf(UT[8 + 2 * p], UT[8 + 2 * p + 1]) ^ 0x80008000u;
                  NUF[1] = __builtin_bit_cast(bf16x8, p4); }
#pragma unroll
                for (int i = 0; i < 16; ++i) YT[i] = 0.f;
                { bf16x8 ar[2][2];
#pragma unroll
                  for (int c = 0; c < 2; ++c)
#pragma unroll
                      for (int s = 0; s < 2; ++s) ar[c][s] = ck_frag(BX + CK_XR, 144, r, 32 * c + 16 * s + 8 * hh);
#pragma unroll
                  for (int c = 0; c < 2; ++c)
#pragma unroll
                      for (int s = 0; s < 2; ++s) YT = CK_MFMA(ar[c][s], SH[c][s], YT); }
                VF[0] = ck_frag(BX + CK_VT, 80, r, 8 * hh); VF[1] = ck_frag(BX + CK_VT, 80, r, 16 + 8 * hh);
                asm volatile("" ::: "memory");
#pragma unroll
                for (int ks = 0; ks < 2; ++ks) { const bf16x8 fbr = ck_frag(BT + CK_TBR, 80, r, 16 * ks + 8 * hh), fkr = ck_frag(BT + CK_TKR, 80, r, 16 * ks + 8 * hh); YT = CK_MFMA(fbr, NUF[ks], YT); YT = CK_MFMA(fkr, VF[ks], YT); }
                { bf16* yo = (bf16*)(F.ws + WS_YCK) + ((size_t)b * SEQ + blk * 32) * 1024 + h * 64 + half * 32 + r;
#pragma unroll
                  for (int reg = 0; reg < 16; ++reg) yo[(size_t)((reg & 3) + 8 * (reg >> 2) + 4 * hh) * 1024] = (bf16)f2bf(YT[reg]); }
                { const LAS f32x4* stash = (const LAS f32x4*)(F.lds + CK_STASH) + F.lane;
#pragma unroll
                  for (int m = 0; m < 4; ++m) { const f32x4 g0 = *(const LAS f32x4*)(BX + CK_GB + (8 * m + 4 * hh) * 4), g1 = *(const LAS f32x4*)(BX + CK_GB + (32 + 8 * m + 4 * hh) * 4);
                    const f32x4 a0 = stash[64 * m] * g0, a1 = stash[64 * (4 + m)] * g1;
#pragma unroll
                    for (int e = 0; e < 4; ++e) { ST0[4 * m + e] = a0[e]; ST1[4 * m + e] = a1[e]; } } }
#pragma unroll
                for (int ks = 0; ks < 2; ++ks) {
                    const bf16x8 b0 = ck_frag(BX + CK_BH, 80, r, 16 * ks + 8 * hh), b1 = ck_frag(BX + CK_BH, 80, 32 + r, 16 * ks + 8 * hh), k0 = ck_frag(BX + CK_KH, 80, r, 16 * ks + 8 * hh), k1 = ck_frag(BX + CK_KH, 80, 32 + r, 16 * ks + 8 * hh);
                    ST0 = CK_MFMA(b0, NUF[ks], ST0); ST1 = CK_MFMA(b1, NUF[ks], ST1); ST0 = CK_MFMA(k0, VF[ks], ST0); ST1 = CK_MFMA(k1, VF[ks], ST1); }
                }
                CK_BAR();
            }
        } else if (w_ == 1 || w_ == 2 || w_ == 3 || w_ == 5) {
            const int pw = (w_ == 5) ? 3 : w_ - 1;
            CkConst CC;
            { const int c = l * 1024 + h * 64 + 16 * pw + 4 * (F.lane & 3); const float* mu = kin<I_MU>() + l * N_SHIFT + h * 64 + 16 * pw + 4 * (F.lane & 3);
              CC.a0 = *(const f32x4*)(kin<I_A0>() + c); CC.kk = *(const f32x4*)(kin<I_KK>() + c); CC.ka = *(const f32x4*)(kin<I_KA>() + c); CC.rk = *(const f32x4*)(kin<I_RK>() + c); CC.w0 = *(const f32x4*)(kin<I_W0>() + c);
              CC.v0 = (l == 1) ? *(const f32x4*)(kin<I_V0>() + (c - 1024)) : (f32x4){0.f, 0.f, 0.f, 0.f}; CC.mur = *(const f32x4*)mu; CC.muk = *(const f32x4*)(mu + 1024); CC.muv = *(const f32x4*)(mu + 2048); }
            CkRegs CR;
            ck_issue(F, pw, l, b, h, half, 0, CR);
#pragma unroll 1
            for (int blk = -2; blk < NBLKc; ++blk) {
                if (blk + 2 < NBLKc && !(probe & 4) && !((probe & 16) && w_ == 5)) ck_stage1(F, pw, l, b, h, half, blk + 2, CC, F.lds + CK_X3_OFF + ((blk + 2 + 3) % 3) * CK_X3SZ, F.lds + CK_P2_OFF + ((blk + 2) & 1) * CK_P2SZ, CR, blk + 3 < NBLKc);
                CK_BAR();
            }
        } else {
#pragma unroll 1
            for (int blk = -2; blk < NBLKc; ++blk) {
                if (blk + 1 >= 0 && blk + 1 < NBLKc) {
                    const LAS unsigned char* BX = F.lds + CK_X3_OFF + ((blk + 1 + 3) % 3) * CK_X3SZ; const LAS unsigned char* BP = F.lds + CK_P2_OFF + ((blk + 1) & 1) * CK_P2SZ; LAS unsigned char* BT = F.lds + CK_T2_OFF + ((blk + 1) & 1) * CK_T2SZ;
                    if (w_ == 4) { if (!(probe & 2)) ck_stage2(F, 0, BX, BP, BT); }
                    else if (probe & 8) {}
                    else if (w_ == 6) { ck_stage2(F, 1, BX, BP, BT); ck_stage2(F, 3, BX, BP, BT); }
                    else ck_stage2(F, 2, BX, BP, BT);
                }
                CK_BAR();
            }
        }
    }
}

__device__ __forceinline__ void p5_post(const Frame& F, int l) {
    const int lane = F.lane;
#if defined(DBG_SCAN)
    if (l == 0) { float d2 = 0.f, n2 = 0.f;
#if defined(DBG_CMP_U)
        const bf16* Ya = (const bf16*)(F.ws + WS_V1); const bf16* Yb = (const bf16*)(F.ws + WS_P) + C_VD; const size_t pb = P_LD;
#else
        const bf16* Ya = (const bf16*)(F.ws + WS_Y); const bf16* Yb = (const bf16*)(F.ws + WS_H); const size_t pb = 1024;
#endif
        for (size_t i = (size_t)(F.vcu * NWAVES * 64 + F.tid); i < (size_t)T * 1024; i += (size_t)F.G * NWAVES * 64) { const int t = (int)((i >> 10) & (SEQ - 1));
            if (t >= DBG_T0 && t < DBG_T1) { const float ya = bflo((unsigned)Ya[i]), yb = bflo((unsigned)Yb[(i >> 10) * pb + (i & 1023)]); d2 += (ya - yb) * (ya - yb); n2 += ya * ya; } }
        d2 = wave_sum(d2); n2 = wave_sum(n2);
        if (lane == 0) { atomicAdd((float*)(F.ws + WS_CTL) + 2048, d2); atomicAdd((float*)(F.ws + WS_CTL) + 2049, n2); }
        __syncthreads(); }
#endif
    const float* const pCW = kin<I_CONVW>() + l * 3 * 1024; const float* const pLNW = kin<I_LNW>() + l * 1024; const float* const pLNB = kin<I_LNB>() + l * 1024;
    const bf16* P = (const bf16*)(F.ws + WS_P); const bf16* Y = (const bf16*)(F.ws + WS_Y); const bf16* LRg = (const bf16*)(F.ws + WS_LR) + 2048;
    const bf16* V = (const bf16*)(F.ws + (l == 0 ? WS_V0 : WS_V1)); const float* BONP = (const float*)(F.ws + WS_BONP); bf16* M = (bf16*)(F.ws + WS_H);
#pragma unroll 1
    for (int gw = F.vcu * NWAVES + F.wave; gw < T / 8; gw += F.G * NWAVES) { const int tok0 = gw * 8;
#pragma unroll 1
    for (int ch = 0; ch < 2; ++ch) { const int col0 = 512 * ch + 8 * lane, head = 8 * ch + (lane >> 3);
        float cw0[8], cw1[8], cw2[8], lnw[8], lnb[8], um1[8], um2[8];
#pragma unroll
        for (int j = 0; j < 8; ++j) { cw0[j] = pCW[col0 + j]; cw1[j] = pCW[1024 + col0 + j]; cw2[j] = pCW[2048 + col0 + j];
            lnw[j] = pLNW[col0 + j]; lnb[j] = pLNB[col0 + j]; um1[j] = 0.f; um2[j] = 0.f; }
        const int t0 = tok0 & (SEQ - 1);
        if (t0 >= 1) { float c1[8], c2[8]; load8(P + (size_t)(tok0 - 1) * P_LD + C_CC + col0, c1); load8(P + (size_t)(tok0 - 1) * P_LD + C_CH + col0, c2);
#pragma unroll
            for (int j = 0; j < 8; ++j) um1[j] = c1[j] * c2[j]; }
        if (t0 >= 2) { float c1[8], c2[8]; load8(P + (size_t)(tok0 - 2) * P_LD + C_CC + col0, c1); load8(P + (size_t)(tok0 - 2) * P_LD + C_CH + col0, c2);
#pragma unroll
            for (int j = 0; j < 8; ++j) um2[j] = c1[j] * c2[j]; }
#pragma unroll 2
        for (int tk = 0; tk < 8; ++tk) { const int tok = tok0 + tk; const bf16* pr = P + (size_t)tok * P_LD + col0;
            float c1[8], c2[8], cb[8], ga[8], gb[8], y[8], v[8], g[8], o[8];
            load8(pr + C_CC, c1); load8(pr + C_CH, c2); load8(pr + C_CB, cb); load8(pr + C_GA, ga); load8(pr + C_GB, gb);
            load8(Y + (size_t)tok * 1024 + col0, y); load8h(V + (size_t)tok * 1024 + col0, v); load8(LRg + (size_t)tok * 3072 + col0, g);
            const f32x4 bo4 = *(const f32x4*)(BONP + ((size_t)tok * 16 + head) * 4); const float bo = (bo4[0] + bo4[1]) + (bo4[2] + bo4[3]);
            float sm = 0.f;
#pragma unroll
            for (int j = 0; j < 8; ++j) sm += y[j];
            const float mean = sum8(sm) * (1.0f / 64.0f); float sq = 0.f;
#pragma unroll
            for (int j = 0; j < 8; ++j) { y[j] -= mean; sq += y[j] * y[j]; }
            const float rstd = __builtin_amdgcn_rsqf(sum8(sq) * (1.0f / 64.0f) + LNX_EPS);
#pragma unroll
            for (int j = 0; j < 8; ++j) { const float u = c1[j] * c2[j]; const float conv = cw0[j] * um2[j] + cw1[j] * um1[j] + cw2[j] * u; um2[j] = um1[j]; um1[j] = u;
                const float yconv = cb[j] * conv; const float yr = ((y[j] * rstd) * lnw[j] + lnb[j] + bo * v[j]) * g[j];
                o[j] = sigmoidf_(ga[j]) * yconv + sigmoidf_(gb[j]) * yr; }
            store8(M + (size_t)tok * 1024 + col0, o); }
    }
    }
}

struct GroupPick { float score, a1, a2; int i1, i2; };
__device__ __forceinline__ GroupPick pick_group(const f32x4 acc, float rstd, const float* br, const float* rb) {
    float aff[4], sel[4];
#pragma unroll
    for (int j = 0; j < 4; ++j) { aff[j] = sigmoidf_(rstd * acc[j] + br[j]); sel[j] = aff[j] + rb[j]; }
    int i1 = 0;
#pragma unroll
    for (int j = 1; j < 4; ++j) if (sel[j] > sel[i1]) i1 = j;
    int i2 = (i1 == 0) ? 1 : 0;
#pragma unroll
    for (int j = 0; j < 4; ++j) if (j != i1 && j != i2 && sel[j] > sel[i2]) i2 = j;
    GroupPick g; g.score = sel[i1] + sel[i2]; g.i1 = i1; g.i2 = i2; g.a1 = aff[i1]; g.a2 = aff[i2];
    float s1 = sel[0], s2 = sel[0]; (void)s1; (void)s2;
    return g;
}
__device__ __forceinline__ void p7_route(const Frame& F, int l, bool dry = false) {
    const int lane = F.lane, li = lane & 15, fq = lane >> 4, w = F.wave;
    LAS float* part = (LAS float*)F.lds;
    LAS float* gml = (LAS float*)(F.lds + 32768);
    LAS unsigned* lcnt = (LAS unsigned*)(F.lds + 65536);
    const float* X = (const float*)(F.ws + WS_X); const bf16* WH = (const bf16*)(F.ws + WS_WRT); const bf16* WL = WH + 32768; const float* const pN2G = kin<I_N2G>() + l * 1024; const float* const pRB = kin<I_RB>();
#pragma unroll 1
    for (int grp = F.vcu; grp < T / 64; grp += F.G) { const int b = grp >> 5;
        if (F.tid < 32) lcnt[F.tid] = 0u;
        { const float* ad = ada_ptr(F, l, b) + 4096; const int c = 2 * F.tid; const f32x2 g = *(const f32x2*)(pN2G + c), s = *(const f32x2*)(ad + c); gml[c] = g.x * (1.0f + s.x); gml[c + 1] = g.y * (1.0f + s.y); }
        bfv8 ah0[4], al0[4], ah1[4], al1[4];
        { const bf16* wh0 = WH + li * 1024 + 128 * w + 8 * fq; const bf16* wl0 = WL + li * 1024 + 128 * w + 8 * fq;
#pragma unroll
          for (int s = 0; s < 4; ++s) { ah0[s] = *(const bfv8*)(wh0 + 32 * s); al0[s] = *(const bfv8*)(wl0 + 32 * s); ah1[s] = *(const bfv8*)(wh0 + 16 * 1024 + 32 * s); al1[s] = *(const bfv8*)(wl0 + 16 * 1024 + 32 * s); } }
        __syncthreads();
#pragma unroll 1
        for (int it = 0; it < 4; ++it) { const int tok0 = grp * 64 + it * 16;
            const float* xp = X + (size_t)(tok0 + li) * 1024 + 128 * w + 8 * fq;
            f32x4 xa[4], xb[4];
#pragma unroll
            for (int s = 0; s < 4; ++s) { xa[s] = *(const f32x4*)(xp + 32 * s); xb[s] = *(const f32x4*)(xp + 32 * s + 4); }
            f32x4 acc0 = (f32x4){0.f, 0.f, 0.f, 0.f}, acc1 = acc0; float ssq = 0.f;
#pragma unroll
            for (int s = 0; s < 4; ++s) {
                const f32x4 ga = *(const LAS f32x4*)(gml + 128 * w + 32 * s + 8 * fq), gb = *(const LAS f32x4*)(gml + 128 * w + 32 * s + 8 * fq + 4);
                ssq += ((xa[s][0] * xa[s][0] + xa[s][1] * xa[s][1]) + (xa[s][2] * xa[s][2] + xa[s][3] * xa[s][3])) + ((xb[s][0] * xb[s][0] + xb[s][1] * xb[s][1]) + (xb[s][2] * xb[s][2] + xb[s][3] * xb[s][3]));
                const f32x4 ya = xa[s] * ga, yb = xb[s] * gb;
                u32x4 ph, pl;
                ph[0] = pkbf(ya[0], ya[1]); ph[1] = pkbf(ya[2], ya[3]); ph[2] = pkbf(yb[0], yb[1]); ph[3] = pkbf(yb[2], yb[3]);
                pl[0] = pkbf(ya[0] - bflo(ph[0]), ya[1] - bfhi(ph[0])); pl[1] = pkbf(ya[2] - bflo(ph[1]), ya[3] - bfhi(ph[1])); pl[2] = pkbf(yb[0] - bflo(ph[2]), yb[1] - bfhi(ph[2])); pl[3] = pkbf(yb[2] - bflo(ph[3]), yb[3] - bfhi(ph[3]));
                const bfv8 bh = __builtin_bit_cast(bfv8, ph), bl = __builtin_bit_cast(bfv8, pl);
                acc0 = __builtin_amdgcn_mfma_f32_16x16x32_bf16(ah0[s], bh, acc0, 0, 0, 0); acc0 = __builtin_amdgcn_mfma_f32_16x16x32_bf16(al0[s], bh, acc0, 0, 0, 0); acc0 = __builtin_amdgcn_mfma_f32_16x16x32_bf16(ah0[s], bl, acc0, 0, 0, 0);
                acc1 = __builtin_amdgcn_mfma_f32_16x16x32_bf16(ah1[s], bh, acc1, 0, 0, 0); acc1 = __builtin_amdgcn_mfma_f32_16x16x32_bf16(al1[s], bh, acc1, 0, 0, 0); acc1 = __builtin_amdgcn_mfma_f32_16x16x32_bf16(ah1[s], bl, acc1, 0, 0, 0);
            }
            ssq += __shfl_xor(ssq, 16); ssq += __shfl_xor(ssq, 32);
            { LAS float* pp = part + (w * 16 + li) * 36; *(LAS f32x4*)(pp + 4 * fq) = acc0; *(LAS f32x4*)(pp + 16 + 4 * fq) = acc1; if (fq == 0) pp[32] = ssq; }
            __syncthreads();
            if (w == 0) {
                f32x4 a0 = (f32x4){0.f, 0.f, 0.f, 0.f}, a1 = a0; float sq = 0.f;
#pragma unroll
                for (int ww = 0; ww < 8; ++ww) { const LAS float* q = part + (ww * 16 + li) * 36; a0 += *(const LAS f32x4*)(q + 4 * fq); a1 += *(const LAS f32x4*)(q + 16 + 4 * fq); sq += q[32]; }
                const float rstd = __builtin_amdgcn_rsqf(sq * (1.0f / 1024.0f) + NORM_EPS);
                const float* br = (const float*)(F.ws + WS_CTL + CTL_BIASR) + (l * 8 + b) * 32;
                const GroupPick ga_ = pick_group(a0, rstd, br + 4 * fq, pRB + 4 * fq), gb_ = pick_group(a1, rstd, br + 16 + 4 * fq, pRB + 16 + 4 * fq);
                const bool useb = gb_.score > ga_.score;
                const GroupPick gm = useb ? gb_ : ga_; const int mygrp = useb ? 4 + fq : fq;
                float bs = gm.score; int bg = mygrp;
#pragma unroll
                for (int off = 16; off < 64; off <<= 1) { const float os = __shfl_xor(bs, off); const int og = __shfl_xor(bg, off); if (os > bs || (os == bs && og < bg)) { bs = os; bg = og; } }
                if (mygrp == bg) { const int tok = tok0 + li; const int e0 = 4 * bg + gm.i1, e1 = 4 * bg + gm.i2; const float inv = 1.0f / (gm.a1 + gm.a2);
                    const int p0 = (int)__hip_atomic_fetch_add(lcnt + e0, 1u, __ATOMIC_RELAXED, __HIP_MEMORY_SCOPE_WORKGROUP), p1 = (int)__hip_atomic_fetch_add(lcnt + e1, 1u, __ATOMIC_RELAXED, __HIP_MEMORY_SCOPE_WORKGROUP);
                    int* EI = (int*)(F.ws + WS_EIDX); int* PO = (int*)(F.ws + WS_POS); float* WT = (float*)(F.ws + WS_WTS);
                    if (!dry) { EI[tok * 2] = e0; EI[tok * 2 + 1] = e1; PO[tok * 2] = p0; PO[tok * 2 + 1] = p1; WT[tok * 2] = gm.a1 * inv; WT[tok * 2 + 1] = gm.a2 * inv; } }
            }
            __syncthreads();
        }
        if (F.tid < 32 && !dry) ((int*)(F.ws + WS_HIST))[(l * 256 + grp) * 32 + F.tid] = (int)lcnt[F.tid];
        __syncthreads();
    }
}

__device__ __forceinline__ void expert_table(const Frame& F, int l, int grp = -1) {
    LAS int* tab = (LAS int*)(F.lds + TAB_OFF); LAS int* red = (LAS int*)F.lds;
    const int* hist = (const int*)(F.ws + WS_HIST) + l * 256 * 32; const int e = F.tid & 31, part = F.tid >> 5;
    int tot = 0, pre = 0;
#pragma unroll 4
    for (int g = part * 16; g < part * 16 + 16; ++g) { const int v = hist[g * 32 + e]; tot += v; pre += (g < grp) ? v : 0; }
    red[part * 32 + e] = tot; red[512 + part * 32 + e] = pre;
    __syncthreads();
    if (F.tid < 64) { int c = 0, pr = 0;
#pragma unroll
        for (int p = 0; p < 16; ++p) { c += red[p * 32 + e]; pr += red[512 + p * 32 + e]; }
        const int padded = (c + 255) & ~255; int inc = padded;
#pragma unroll
        for (int o = 1; o < 32; o <<= 1) { const int v = __shfl_up(inc, o); if (e >= o) inc += v; }
        if (F.lane < 32) { tab[e] = inc - padded; tab[33 + e] = (inc - padded) >> 8; tab[66 + e] = inc - padded + pr; if (e == 31) { tab[32] = inc; tab[65] = inc >> 8; } } }
    __syncthreads();
}

__device__ __forceinline__ void p8_dispatch(const Frame& F, int l) {
    const LAS int* tab = (const LAS int*)(F.lds + TAB_OFF);
    const float* const pN2G = kin<I_N2G>() + l * 1024;
    const int lane = F.lane;
#pragma unroll 1
    for (int gw = F.vcu * NWAVES + F.wave; gw < T / 8; gw += F.G * NWAVES) { const int tok0 = gw * 8, b = tok0 >> 11;
        expert_table(F, l, gw >> 3);
        const float* ad = ada_ptr(F, l, b); f32x4 gm[4], sh[4];
#pragma unroll
        for (int j = 0; j < 4; ++j) { const int c = 4 * lane + 256 * j; gm[j] = *(const f32x4*)(pN2G + c) * (1.0f + *(const f32x4*)(ad + 4096 + c)); sh[j] = *(const f32x4*)(ad + 3072 + c); }
        const float* X = (const float*)(F.ws + WS_X); const int* EI = (const int*)(F.ws + WS_EIDX); const int* PO = (const int*)(F.ws + WS_POS); int* SL = (int*)(F.ws + WS_SLOT); bf16* BUF = (bf16*)(F.ws + WS_BUF);
#pragma unroll 1
        for (int tb = 0; tb < 8; tb += 4) {
            f32x4 v[4][4]; int e0[4], e1[4], q0[4], q1[4]; float ss[4];
#pragma unroll
            for (int t = 0; t < 4; ++t) { const int tok = tok0 + tb + t;
#pragma unroll
                for (int j = 0; j < 4; ++j) v[t][j] = *(const f32x4*)(X + (size_t)tok * 1024 + 4 * lane + 256 * j);
                e0[t] = EI[tok * 2]; e1[t] = EI[tok * 2 + 1]; q0[t] = PO[tok * 2]; q1[t] = PO[tok * 2 + 1]; }
#pragma unroll
            for (int t = 0; t < 4; ++t) { ss[t] = 0.f;
#pragma unroll
                for (int j = 0; j < 4; ++j) ss[t] += (v[t][j][0] * v[t][j][0] + v[t][j][1] * v[t][j][1]) + (v[t][j][2] * v[t][j][2] + v[t][j][3] * v[t][j][3]); }
#pragma unroll
            for (int o = 1; o < 64; o <<= 1) {
#pragma unroll
                for (int t = 0; t < 4; ++t) ss[t] += __shfl_xor(ss[t], o); }
#pragma unroll
            for (int t = 0; t < 4; ++t) { const int tok = tok0 + tb + t;
                const float rstd = __builtin_amdgcn_rsqf(ss[t] * (1.0f / 1024.0f) + NORM_EPS);
                const int s0 = tab[66 + e0[t]] + q0[t], s1 = tab[66 + e1[t]] + q1[t];
                if (lane == 0) { SL[tok * 2] = s0; SL[tok * 2 + 1] = s1; }
#pragma unroll
                for (int j = 0; j < 4; ++j) { const f32x4 h = v[t][j] * rstd * gm[j] + sh[j]; u32x2 w; w.x = pk2(h[0], h[1]); w.y = pk2(h[2], h[3]);
                    *(u32x2*)(BUF + (size_t)s0 * 1024 + 4 * lane + 256 * j) = w; *(u32x2*)(BUF + (size_t)s1 * 1024 + 4 * lane + 256 * j) = w; } }
        }
    }
}

#ifndef PHMASK
#define PHMASK 0xFFFF
#endif
#define PHM(n) (((PHMASK) >> (n)) & 1)
constexpr int NPHASES = 23;
__global__ void __launch_bounds__(NWAVES * 64, 2) trunk_fwd(Args args) {
    extern __shared__ __attribute__((aligned(16))) unsigned char lds_raw[];
    Frame F;
    F.lds = (LAS unsigned char*)lds_raw;
    F.tid = threadIdx.x; F.lane = F.tid & 63; F.wave = __builtin_amdgcn_readfirstlane(F.tid >> 6);
    F.G = gridDim.x; { const int bx = blockIdx.x; F.vcu = (F.G % 8 == 0) ? (bx % 8) * (F.G / 8) + bx / 8 : bx; }
    GAS unsigned char* const wsbase = (GAS unsigned char*)kin<29>(); F.ws = wsbase; const int vcu0 = F.vcu;
    volatile LAS unsigned* MISC = (volatile LAS unsigned*)(F.lds + MISC_OFF);
    if (F.tid < 32) MISC[F.tid] = 0u;
    __syncthreads();
    const unsigned long long lohi = (unsigned long long)kin<30>(); const int lo = (int)(unsigned)lohi, hi = (int)(unsigned)(lohi >> 32);
    XcdBarrier bar; bar.bar = (unsigned*)(F.ws + WS_CTL) + CW_BAR; bar.x = 0; bar.st = nullptr;
    if (hi - lo > 1) bar = xcd_barrier_post((unsigned*)(F.ws + WS_CTL) + CW_BAR, MISC + 8);
#pragma unroll 1
#if defined(REP_PH)
    for (int phx = lo; phx < hi + REP_N; ++phx) { const int ph = (phx < REP_PH) ? phx : ((phx < REP_PH + REP_N) ? REP_PH : phx - REP_N);
        const bool probe_run = (phx >= REP_PH && phx < REP_PH + REP_N); (void)probe_run;
#else
    for (int ph = lo; ph < hi; ++ph) {
#endif
        { int t_ = threadIdx.x; asm volatile("" : "+v"(t_)); F.tid = t_; F.lane = t_ & 63; F.wave = __builtin_amdgcn_readfirstlane(t_ >> 6);
          GAS unsigned char* w_ = wsbase; asm volatile("" : "+s"(w_)); F.ws = w_; int v_ = vcu0; asm volatile("" : "+s"(v_)); F.vcu = v_; }
        const int l = (ph - 2) / 10, k = (ph >= 2 && ph <= 21) ? (ph - 2) % 10 : -1;
        if (PHM(0) && ph == 0) p0_prologue(F);
        else if (PHM(0) && ph == 1) p0b_ada_reduce(F);
        else if (PHM(1) && ph == 22) p1_norm<2>(F, 1);
        else if (PHM(1) && k == 0) { if (l == 0) p1_norm<0>(F, 0); else p1_norm<1>(F, 1); }
        else if (PHM(3) && k == 2) p2x_lowrank(F, l);
        #if defined(DBG_SCAN)
        else if (PHM(4) && k == 3) { p4_scan_seq(F, l); __syncthreads(); if (l == 0) p4_scan(F, l); }
#elif defined(REP_PH) && defined(REP_DRY)
        else if (PHM(4) && k == 3) p4_scan(F, l, probe_run ? REP_DRY : 0);
#else
        else if (PHM(4) && k == 3) p4_scan(F, l);
#endif
        else if (PHM(5) && k == 4) p5_post(F, l);
        #if defined(REP_PH)
        else if (PHM(7) && k == 6) p7_route(F, l, probe_run);
#else
        else if (PHM(7) && k == 6) p7_route(F, l);
#endif
        else if (PHM(8) && k == 7) p8_dispatch(F, l);
        else if (PHM(2) && (k == 1 || k == 5 || k == 8 || k == 9)) {
            pg8::Gemm g; pg8::UniOrder S; pg8::EpiUni E;
            S.expert = (k >= 8); S.so.init(T, 1024, F.G, (int)blockIdx.x); S.eo = pg8::ExpertOrder{(const PG8_LAS int*)(F.lds + TAB_OFF + 33 * 4), 0, F.G, (int)blockIdx.x};
            E.e0 = pg8::EpiBf16Plain{(bf16*)(F.ws + WS_P), P_LD, -1}; E.e1 = pg8::EpiResid{nullptr, (float*)(F.ws + WS_X), ada_ptr(F, l, 0) + 2048, 6144}; E.e2 = pg8::EpiSwiGLU{(bf16*)(F.ws + WS_HB)};
            if (k == 1) {
                const int N = (l == 0) ? N_IN : P_LD; S.so.init(T, N, F.G, (int)blockIdx.x); E.mode = 0;
                g = pg8::Gemm{(const bf16*)(F.ws + WS_H), (const bf16*)(F.ws + WS_BT_IN) + (size_t)l * P_LD * 1024, T, N, 1024};
            } else if (k == 5) {
                E.mode = 1; E.e1.xin = (l == 0) ? kin<I_X>() : (const float*)(F.ws + WS_X);
                g = pg8::Gemm{(const bf16*)(F.ws + WS_H), (const bf16*)(F.ws + WS_BT_OUT) + (size_t)l * 1024 * 1024, T, 1024, 1024};
            } else {
                expert_table(F, l);
                S.eo.ntiles = ((const LAS int*)(F.lds + TAB_OFF))[65];
                if (k == 8) { E.mode = 2; g = pg8::Gemm{(const bf16*)(F.ws + WS_BUF), (const bf16*)(F.ws + WS_BT_E1) + (size_t)l * 32 * 1024 * 1024, MAXROWS, 32 * 1024, 1024}; }
                else { E.mode = 0; E.e0 = pg8::EpiBf16Plain{(bf16*)(F.ws + WS_YE), 1024, 3}; g = pg8::Gemm{(const bf16*)(F.ws + WS_HB), (const bf16*)(F.ws + WS_BT_E2) + (size_t)l * 32 * 1024 * 512, MAXROWS, 32 * 1024, 512}; }
            }
#if defined(REP_PH) && defined(REP_DRY)
            if (probe_run) E.mode = 3;
#endif
            pg8::gemm_phase<pg8::EpiUni, pg8::UniOrder, true, true>(F.lds, g, S, E);
        }
#if defined(REP_PH)
        if (phx + 1 < hi + REP_N) xcd_barrier(bar);
#else
        if (ph + 1 < hi) xcd_barrier(bar);
#endif
    }
}

extern "C" void kernel_launch(void* const* d_in, const int* in_sizes, int n_in, void* d_out, int out_size, void* d_ws, size_t ws_size, hipStream_t stream) {
    static int grid = 0;
    if (grid == 0) {
        if (n_in != 28 || in_sizes[0] != T * D || out_size != T * D || ws_size < WS_END) { fprintf(stderr, "kernel_launch: unexpected shapes (n_in %d, in0 %d, out %d, ws %zu < %zu?); nothing launched\n", n_in, n_in > 0 ? in_sizes[0] : -1, out_size, ws_size, (size_t)WS_END); grid = -1; return; }
        int dev = 0, cus = 0, per_cu = 0;
        if (hipGetDevice(&dev) != hipSuccess || hipDeviceGetAttribute(&cus, hipDeviceAttributeMultiprocessorCount, dev) != hipSuccess) { fprintf(stderr, "kernel_launch: device query failed\n"); grid = -1; return; }
        if (hipFuncSetAttribute((const void*)trunk_fwd, hipFuncAttributeMaxDynamicSharedMemorySize, LDS_BYTES) != hipSuccess) { fprintf(stderr, "kernel_launch: hipFuncSetAttribute failed\n"); grid = -1; return; }
        if (hipOccupancyMaxActiveBlocksPerMultiprocessor(&per_cu, (const void*)trunk_fwd, NWAVES * 64, LDS_BYTES) != hipSuccess || per_cu < 1) { fprintf(stderr, "kernel_launch: occupancy query says %d blocks per CU\n", per_cu); }
        (void)hipGetLastError();
        grid = cus;
    }
    if (grid < 0) return;
    if (hipMemsetAsync((char*)d_ws + WS_CTL, 0, CTL_ZERO_BYTES, stream) != hipSuccess) { fprintf(stderr, "kernel_launch: memset failed\n"); return; }
    Args a{};
    for (int i = 0; i < 28; ++i) a.p[i] = d_in[i];
    a.p[28] = d_out; a.p[29] = d_ws;
#if MK_ONE_LAUNCH
    a.ph_lo = 0; a.ph_hi = NPHASES;
    void* kargs[] = {&a};
    hipError_t e = hipLaunchCooperativeKernel((const void*)trunk_fwd, dim3(grid), dim3(NWAVES * 64), kargs, LDS_BYTES, stream);
    if (e != hipSuccess) fprintf(stderr, "kernel_launch: cooperative launch failed: %s (grid %d)\n", hipGetErrorString(e), grid);
#else
    for (int p = 0; p < NPHASES; ++p) { a.ph_lo = p; a.ph_hi = p + 1;
        hipLaunchKernelGGL(trunk_fwd, dim3(grid), dim3(NWAVES * 64), LDS_BYTES, stream, a);
        const hipError_t le = hipPeekAtLastError(); if (le != hipSuccess) { fprintf(stderr, "kernel_launch: launch %d failed: %s\n", p, hipGetErrorName(le)); break; } }
#endif
}
```

```cpp
#include <hip/hip_runtime.h>
#include <cstdio>
#include <cstdint>

#ifndef MK_ONE_LAUNCH
#define MK_ONE_LAUNCH 1
#endif

namespace pg8 {
#define PG8_LAS __attribute__((address_space(3)))
typedef unsigned short bf16_t;
typedef short bf16x8 __attribute__((ext_vector_type(8)));
typedef float f32x4 __attribute__((ext_vector_type(4)));
typedef unsigned u32x4 __attribute__((ext_vector_type(4)));
constexpr int BM = 256, BK = 64, HALF = 128, HTB = HALF * BK * 2  , STAGE_BYTES = 8 * HTB, NXCD = 8, WGM = 8;

__host__ __device__ __forceinline__ int lds_byte(int r, int c) { const int st = (r >> 4) * 2 + (c >> 5), rr = r & 15, cc = c & 31, ob = rr * 64 + cc * 2; return st * 1024 + (ob ^ (((ob >> 9) & 1) << 5)); }
__host__ __device__ __forceinline__ void stage_rc(int b, int& R, int& C) { const int st = b / 1024, sb = b % 1024, swz = sb ^ (((sb >> 9) & 1) << 5); R = (st >> 1) * 16 + swz / 64; C = (st & 1) * 32 + (swz % 64) / 2; }
__host__ __device__ __forceinline__ int perm32(int rho) { const int n = rho >> 4, i = rho & 15; return 8 * (i >> 2) + 4 * n + (i & 3); }

struct Unit { int pm, pn; };
struct Gemm { const bf16_t* A; const bf16_t* Bt; int M, N, K; };

struct StaticOrder {
    int nM, nN, nwg, G, c;
    __host__ __device__ void init(int M, int N, int G_, int c_) { nM = M / BM; nN = N / BM; nwg = nM * nN; G = G_; c = c_; }
    __host__ __device__ bool next(int i, Unit& u) const {
        const long L = (long)i * G + c; if (L >= nwg) return false;
        int wgid = (int)L; { const int q = nwg / NXCD, r = nwg % NXCD, xcd = wgid % NXCD, off = wgid / NXCD; wgid = (xcd < r ? xcd * (q + 1) : r * (q + 1) + (xcd - r) * q) + off; }
        const int nig = WGM * nN, gid = wgid / nig, fm = gid * WGM, gsz = (nM - fm) < WGM ? (nM - fm) : WGM;
        u.pm = fm + ((wgid % nig) % gsz); u.pn = (wgid % nig) / gsz; return true;
    }
    __device__ __forceinline__ void a_ready(const Unit&) const {}
    __device__ __forceinline__ void done(const Unit&) const {}
};
__device__ __forceinline__ unsigned cvt_pk_bf16(float lo, float hi) { unsigned r; asm volatile("v_cvt_pk_bf16_f32 %0, %1, %2" : "=v"(r) : "v"(lo), "v"(hi)); return r; }
typedef float f32x2 __attribute__((ext_vector_type(2)));
typedef unsigned u32x2 __attribute__((ext_vector_type(2)));

struct EpiBf16Plain {
    static constexpr bool PERM = true, AFTER_DRAIN = false;
    bf16_t* O; int ldc; int cmask;
    __device__ __forceinline__ void operator()(const f32x4 (&acc)[2][2][4][2], const Unit& u, int wr, int wc, int fr, int fq) const {
        const int row0 = u.pm * BM + wr * 64 + fr; const int col0 = (u.pn & cmask) * BM + wc * 32 + 8 * fq;
#pragma unroll
        for (int ai = 0; ai < 2; ++ai)
#pragma unroll
            for (int m = 0; m < 4; ++m) { bf16_t* rowp = O + (size_t)(row0 + ai * HALF + m * 16) * ldc + col0;
#pragma unroll
                for (int bj = 0; bj < 2; ++bj) { const f32x4 v0 = acc[ai][bj][m][0], v1 = acc[ai][bj][m][1];
                    u32x4 w; w.x = cvt_pk_bf16(v0[0], v0[1]); w.y = cvt_pk_bf16(v0[2], v0[3]); w.z = cvt_pk_bf16(v1[0], v1[1]); w.w = cvt_pk_bf16(v1[2], v1[3]);
                    *(u32x4*)(rowp + bj * HALF) = w; } }
    }
};
struct EpiResid {
    static constexpr bool PERM = false, AFTER_DRAIN = false;
    const float* xin; float* xout; const float* gate;
    int gstride;
    __device__ __forceinline__ void operator()(const f32x4 (&acc)[2][2][4][2], const Unit& u, int wr, int wc, int fr, int fq) const {
        const int row0 = u.pm * BM + wr * 64 + fr, col0 = u.pn * BM + wc * 32 + 4 * fq;
        const float* gp = gate + (size_t)(u.pm >> 3) * gstride;
        f32x4 gv[2][2];
#pragma unroll
        for (int bj = 0; bj < 2; ++bj)
#pragma unroll
            for (int n = 0; n < 2; ++n) gv[bj][n] = *(const f32x4*)(gp + col0 + bj * HALF + n * 16);
#pragma unroll
        for (int ai = 0; ai < 2; ++ai) {
            f32x4 xi[4][2][2];
#pragma unroll
            for (int m = 0; m < 4; ++m) { const size_t ro = (size_t)(row0 + ai * HALF + m * 16) * 1024 + col0;
#pragma unroll
                for (int bj = 0; bj < 2; ++bj)
#pragma unroll
                    for (int n = 0; n < 2; ++n) xi[m][bj][n] = *(const f32x4*)(xin + ro + bj * HALF + n * 16); }
            asm volatile("" ::: "memory");
#pragma unroll
            for (int m = 0; m < 4; ++m) { const size_t ro = (size_t)(row0 + ai * HALF + m * 16) * 1024 + col0;
#pragma unroll
                for (int bj = 0; bj < 2; ++bj)
#pragma unroll
                    for (int n = 0; n < 2; ++n) *(f32x4*)(xout + ro + bj * HALF + n * 16) = xi[m][bj][n] + gv[bj][n] * acc[ai][bj][m][n]; }
            asm volatile("" ::: "memory"); }
    }
};
struct EpiSwiGLU {
    static constexpr bool PERM = false, AFTER_DRAIN = false;
    bf16_t* O;
    __device__ __forceinline__ void operator()(const f32x4 (&acc)[2][2][4][2], const Unit& u, int wr, int wc, int fr, int fq) const {
        const int row0 = u.pm * BM + wr * 64 + fr, col0 = (u.pn & 3) * HALF + wc * 32 + 4 * fq;
#pragma unroll
        for (int ai = 0; ai < 2; ++ai)
#pragma unroll
            for (int m = 0; m < 4; ++m) { bf16_t* rowp = O + (size_t)(row0 + ai * HALF + m * 16) * 512 + col0;
#pragma unroll
                for (int n = 0; n < 2; ++n) { const f32x4 g = acc[ai][0][m][n], up = acc[ai][1][m][n]; f32x4 h;
#pragma unroll
                    for (int j = 0; j < 4; ++j) h[j] = g[j] * __builtin_amdgcn_rcpf(1.0f + __expf(-g[j])) * up[j];
                    u32x2 w; w.x = cvt_pk_bf16(h[0], h[1]); w.y = cvt_pk_bf16(h[2], h[3]);
                    *(u32x2*)(rowp + n * 16) = w; } }
    }
};
struct ExpertOrder {
    const PG8_LAS int* ts; int ntiles, G, c;
    __device__ __forceinline__ bool next(int i, Unit& u) const {
        const int L = i * G + c; if (L >= ntiles * 4) return false;
        const int pm = L >> 2; int e = 0;
#pragma unroll 1
        for (int k = 1; k < 32; ++k) e += (ts[k] <= pm) ? 1 : 0;
        u.pm = pm; u.pn = e * 4 + (L & 3); return true;
    }
    __device__ __forceinline__ void a_ready(const Unit&) const {}
    __device__ __forceinline__ void done(const Unit&) const {}
};

struct UniOrder {
    StaticOrder so; ExpertOrder eo; bool expert;
    __device__ __forceinline__ bool next(int i, Unit& u) const { return expert ? eo.next(i, u) : so.next(i, u); }
    __device__ __forceinline__ void a_ready(const Unit&) const {}
    __device__ __forceinline__ void done(const Unit&) const {}
};
struct EpiUni {
    static constexpr bool AFTER_DRAIN = false;
    int mode; EpiBf16Plain e0; EpiResid e1; EpiSwiGLU e2;
    __device__ __forceinline__ bool perm() const { return mode == 0; }
    __device__ __forceinline__ void operator()(const f32x4 (&acc)[2][2][4][2], const Unit& u, int wr, int wc, int fr, int fq) const {
        if (mode == 0) e0(acc, u, wr, wc, fr, fq); else if (mode == 1) e1(acc, u, wr, wc, fr, fq); else if (mode == 2) e2(acc, u, wr, wc, fr, fq);
    }
};
template <class Epi, class Sched, bool ALIGN_EPI = false, bool SP2 = false>
__device__ __forceinline__ void gemm_phase(PG8_LAS unsigned char* lds, const Gemm g, const Sched& S, const Epi& E) {
    int tid_ = threadIdx.x; asm volatile("" : "+v"(tid_));
    const int tid = tid_, wid = __builtin_amdgcn_readfirstlane(tid >> 6), lane = tid & 63, wr = wid >> 2, wc = wid & 3, fr = lane & 15, fq = lane >> 4;
    const int K = g.K, nt = K / BK;
    unsigned voffA[2], voffB[2];
#pragma unroll
    for (int i = 0; i < 2; ++i) { int R, C; stage_rc(tid * 16 + i * 8192, R, C); const int Rb = E.perm() ? ((R & ~31) + perm32(R & 31)) : R;
        voffA[i] = (unsigned)(R * K + C) * 2u; voffB[i] = (unsigned)(Rb * K + C) * 2u; }
    const size_t kstep = (size_t)(BK * 2);
    const size_t hstep = (size_t)HALF * K * 2;
    const size_t tstep = 2 * hstep;
    const unsigned ldsw = (unsigned)wid * 1024u;
    const int aoff = lds_byte(wr * 64 + fr, fq * 8), boff = lds_byte(wc * 32 + fr, fq * 8);
#define PG8_SA(b, h) (((b) * 2 + (h)) * HTB)
#define PG8_SB(b, h) ((4 + (b) * 2 + (h)) * HTB)
#define PG8_STAGE(bufoff, gbase, voff) do { _Pragma("unroll") for (int _i = 0; _i < 2; ++_i) \
        __builtin_amdgcn_global_load_lds((const unsigned*)((const char*)(gbase) + (voff)[_i]), (PG8_LAS unsigned*)(lds + (bufoff) + ldsw + _i * 8192), 16, 0, 0); } while (0)
#define PG8_LDA(dst, b, h) do { _Pragma("unroll") for (int m = 0; m < 4; ++m) _Pragma("unroll") for (int k = 0; k < 2; ++k) dst[m][k] = *(const PG8_LAS bf16x8*)(lds + PG8_SA(b, h) + aoff + m * 2048 + k * 1024); } while (0)
#define PG8_LDB(dst, b, h) do { _Pragma("unroll") for (int n = 0; n < 2; ++n) _Pragma("unroll") for (int k = 0; k < 2; ++k) dst[n][k] = *(const PG8_LAS bf16x8*)(lds + PG8_SB(b, h) + boff + n * 2048 + k * 1024); } while (0)
#define PG8_MMA(ai, bj, At, Bt) do { __builtin_amdgcn_s_setprio(1); _Pragma("unroll") for (int m = 0; m < 4; ++m) _Pragma("unroll") for (int n = 0; n < 2; ++n) _Pragma("unroll") for (int k = 0; k < 2; ++k) \
        acc[ai][bj][m][n] = __builtin_amdgcn_mfma_f32_16x16x32_bf16(Bt[n][k], At[m][k], acc[ai][bj][m][n], 0, 0, 0); __builtin_amdgcn_s_setprio(0); } while (0)
#define PG8_WAIT_V(n) asm volatile("s_waitcnt vmcnt(" #n ")" ::: "memory")
#define PG8_WAIT_L(n) asm volatile("s_waitcnt lgkmcnt(" #n ")" ::: "memory")
#define PG8_BAR __builtin_amdgcn_s_barrier()
#define PG8_SCHED __builtin_amdgcn_sched_barrier(0)
    Unit cur, nxt; int ui = 0;
    if (!S.next(0, cur)) return;
    f32x4 acc[2][2][4][2];
#pragma unroll
    for (int a = 0; a < 2; ++a)
#pragma unroll
        for (int b = 0; b < 2; ++b)
#pragma unroll
            for (int m = 0; m < 4; ++m)
#pragma unroll
                for (int n = 0; n < 2; ++n) acc[a][b][m][n] = (f32x4){0.f, 0.f, 0.f, 0.f};
    bf16x8 At[4][2], B0[2][2], B1[2][2];
    const char* cA = (const char*)g.A + (size_t)cur.pm * tstep; const char* cB = (const char*)g.Bt + (size_t)cur.pn * tstep;
    S.a_ready(cur);
    if constexpr (SP2) {
        PG8_STAGE(PG8_SB(0, 0), cB, voffB); PG8_STAGE(PG8_SB(0, 1), cB + hstep, voffB); PG8_STAGE(PG8_SA(0, 0), cA, voffA); PG8_STAGE(PG8_SA(0, 1), cA + hstep, voffA);
        if (wr == 1) PG8_BAR;
        PG8_WAIT_V(2); PG8_BAR;
        PG8_STAGE(PG8_SB(1, 0), cB + kstep, voffB); PG8_STAGE(PG8_SA(1, 0), cA + kstep, voffA); PG8_STAGE(PG8_SB(1, 1), cB + hstep + kstep, voffB);
        PG8_WAIT_V(6); PG8_BAR;
    } else {
        PG8_STAGE(PG8_SB(0, 0), cB, voffB); PG8_STAGE(PG8_SA(0, 0), cA, voffA); PG8_STAGE(PG8_SB(0, 1), cB + hstep, voffB); PG8_STAGE(PG8_SA(0, 1), cA + hstep, voffA);
        if (wr == 1) PG8_BAR;
        PG8_WAIT_V(4); PG8_BAR;
        PG8_STAGE(PG8_SB(1, 0), cB + kstep, voffB); PG8_STAGE(PG8_SA(1, 0), cA + kstep, voffA); PG8_STAGE(PG8_SB(1, 1), cB + hstep + kstep, voffB);
        PG8_WAIT_V(6); PG8_BAR;
    }
    for (;;) {
        const bool has_next = S.next(ui + 1, nxt);
        const char* nA = has_next ? (const char*)g.A + (size_t)nxt.pm * tstep : cA; const char* nB = has_next ? (const char*)g.Bt + (size_t)nxt.pn * tstep : cB;
        for (int t = 0; t < nt; t += 2) {
            const bool last = (t == nt - 2);
            const char* a1 = cA + (size_t)(t + 1) * kstep;
            const char* a2 = last ? nA : cA + (size_t)(t + 2) * kstep; const char* b2 = last ? nB : cB + (size_t)(t + 2) * kstep;
            const char* a3 = a2 + kstep; const char* b3 = b2 + kstep;
            if (last && has_next) S.a_ready(nxt);
            if constexpr (SP2) {
            PG8_LDB(B0, 0, 0); PG8_LDB(B1, 0, 1); PG8_SCHED; PG8_LDA(At, 0, 0); PG8_STAGE(PG8_SA(1, 1), a1 + hstep, voffA);
            PG8_WAIT_V(8); PG8_WAIT_L(0); PG8_BAR; PG8_MMA(0, 0, At, B0); PG8_MMA(0, 1, At, B1); PG8_BAR; PG8_SCHED;
            PG8_LDA(At, 0, 1); PG8_STAGE(PG8_SB(0, 0), b2, voffB); PG8_STAGE(PG8_SB(0, 1), b2 + hstep, voffB); PG8_STAGE(PG8_SA(0, 0), a2, voffA);
            PG8_WAIT_V(8); PG8_WAIT_L(0); PG8_BAR; PG8_MMA(1, 0, At, B0); PG8_MMA(1, 1, At, B1); PG8_BAR; PG8_SCHED;
            PG8_LDB(B0, 1, 0); PG8_LDB(B1, 1, 1); PG8_SCHED; PG8_LDA(At, 1, 0); PG8_STAGE(PG8_SA(0, 1), a2 + hstep, voffA);
            PG8_WAIT_V(8); PG8_WAIT_L(0); PG8_BAR; PG8_MMA(0, 0, At, B0); PG8_MMA(0, 1, At, B1); PG8_BAR; PG8_SCHED;
            PG8_LDA(At, 1, 1); PG8_STAGE(PG8_SB(1, 0), b3, voffB); PG8_STAGE(PG8_SB(1, 1), b3 + hstep, voffB); PG8_STAGE(PG8_SA(1, 0), a3, voffA);
            PG8_WAIT_V(8); PG8_WAIT_L(0); PG8_BAR; PG8_MMA(1, 0, At, B0); PG8_MMA(1, 1, At, B1); PG8_BAR; PG8_SCHED;
            } else {
            PG8_LDB(B0, 0, 0); PG8_SCHED; PG8_LDA(At, 0, 0); PG8_STAGE(PG8_SA(1, 1), a1 + hstep, voffA);
            PG8_WAIT_L(8); PG8_BAR; PG8_WAIT_L(0); PG8_MMA(0, 0, At, B0); PG8_BAR; PG8_SCHED;
            PG8_LDB(B1, 0, 1); PG8_STAGE(PG8_SB(0, 0), b2, voffB);
            PG8_BAR; PG8_WAIT_L(0); PG8_MMA(0, 1, At, B1); PG8_BAR;
            PG8_LDA(At, 0, 1); PG8_STAGE(PG8_SA(0, 0), a2, voffA);
            PG8_BAR; PG8_WAIT_L(0); PG8_MMA(1, 0, At, B0); PG8_BAR; PG8_SCHED;
            PG8_STAGE(PG8_SB(0, 1), b2 + hstep, voffB);
            PG8_WAIT_V(6); PG8_BAR; PG8_MMA(1, 1, At, B1); PG8_BAR;
            PG8_LDB(B0, 1, 0); PG8_SCHED; PG8_LDA(At, 1, 0); PG8_STAGE(PG8_SA(0, 1), a2 + hstep, voffA);
            PG8_WAIT_L(8); PG8_BAR; PG8_WAIT_L(0); PG8_MMA(0, 0, At, B0); PG8_BAR; PG8_SCHED;
            PG8_LDB(B1, 1, 1); PG8_STAGE(PG8_SB(1, 0), b3, voffB);
            PG8_BAR; PG8_WAIT_L(0); PG8_MMA(0, 1, At, B1); PG8_BAR;
            PG8_LDA(At, 1, 1); PG8_STAGE(PG8_SA(1, 0), a3, voffA);
            PG8_BAR; PG8_WAIT_L(0); PG8_MMA(1, 0, At, B0); PG8_BAR; PG8_SCHED;
            PG8_STAGE(PG8_SB(1, 1), b3 + hstep, voffB);
            PG8_WAIT_V(6); PG8_BAR; PG8_MMA(1, 1, At, B1); PG8_BAR;
            }
        }
        if constexpr (ALIGN_EPI) { if (wr == 0) PG8_BAR; }
        if constexpr (!Epi::AFTER_DRAIN) { E(acc, cur, wr, wc, fr, fq); S.done(cur); }
        if (!has_next) break;
#pragma unroll
        for (int a = 0; a < 2; ++a)
#pragma unroll
            for (int b = 0; b < 2; ++b)
#pragma unroll
                for (int m = 0; m < 4; ++m)
#pragma unroll
                    for (int n = 0; n < 2; ++n) acc[a][b][m][n] = (f32x4){0.f, 0.f, 0.f, 0.f};
        cur = nxt; cA = nA; cB = nB; ++ui;
        if constexpr (ALIGN_EPI) { if (wr == 1) PG8_BAR; }
    }
    PG8_WAIT_V(0);
    if constexpr (!ALIGN_EPI) { if (wr == 0) PG8_BAR; }
    PG8_BAR;
    if constexpr (Epi::AFTER_DRAIN) { E.fused(acc, cur, wr, wc, fr, fq, lds, wid, lane); S.done(cur); }
#undef PG8_SA
#undef PG8_SB
#undef PG8_STAGE
#undef PG8_LDA
#undef PG8_LDB
#undef PG8_MMA
#undef PG8_WAIT_V
#undef PG8_WAIT_L
#undef PG8_BAR
#undef PG8_SCHED
}
}

constexpr int NWAVES = 8;
constexpr int T = 16384, D = 1024, SEQ = 2048, NBATCH = 8, NHEAD = 16;
constexpr int N_IN = 8448, N_IN1 = 8704, P_LD = 9472;
constexpr int C_CB = 0, C_CC = 1024, C_CH = 2048, C_GA = 3072, C_GB = 4096, C_R = 5120, C_K = 6144, C_V = 7168, C_WD = 8192, C_AD = 8256, C_GD = 8320, C_VD = 8448;
constexpr int N_SHIFT = 3328, N_EXP = 32, D_EXP = 512;
constexpr int MAXROWS = 40960;
constexpr float NORM_EPS = 1e-6f, LNX_EPS = 64e-5f;

constexpr size_t MiB = 1u << 20;
constexpr size_t WS_CTL = 0, CTL_ZERO_BYTES = 1 * MiB;
constexpr size_t WS_BT_IN = 2 * MiB;
constexpr size_t WS_BT_OUT = 39 * MiB;
constexpr size_t WS_BT_E1 = 43 * MiB;
constexpr size_t WS_BT_E2 = 171 * MiB;
constexpr size_t WS_H = 235 * MiB;
constexpr size_t WS_ALR = WS_H;
constexpr size_t WS_P = 267 * MiB;
constexpr size_t WS_BUF = WS_P, WS_HB = WS_P + 80 * MiB, WS_YE = WS_P + 120 * MiB;
constexpr size_t WS_ADAP = WS_P;
constexpr size_t WS_W = 563 * MiB;
constexpr size_t WS_KK = 627 * MiB, WS_BQ = 659 * MiB, WS_KP = 691 * MiB, WS_R = 723 * MiB, WS_V0 = 755 * MiB, WS_V1 = 787 * MiB;
constexpr size_t WS_LR = 819 * MiB;
constexpr size_t WS_Y = 915 * MiB;
constexpr size_t WS_X = 947 * MiB;
constexpr size_t WS_BONUS = 1011 * MiB;
constexpr size_t WS_EIDX = 1012 * MiB, WS_POS = WS_EIDX + 128 * 1024, WS_WTS = WS_EIDX + 256 * 1024, WS_SLOT = WS_EIDX + 384 * 1024;
constexpr size_t WS_HIST = WS_EIDX + 512 * 1024;
constexpr size_t WS_WRT = WS_EIDX + 768 * 1024;
constexpr size_t WS_VG = WS_BQ;
constexpr size_t WS_VU = WS_KP;
constexpr size_t WS_KN = WS_KK;
constexpr size_t WS_BONP = WS_KK + 2 * MiB;
constexpr size_t WS_BT_LR = 1015 * MiB;
constexpr size_t WS_END = 1018 * MiB;
static_assert(WS_YE + (size_t)MAXROWS * 1024 * 2 <= WS_W && WS_P + (size_t)T * P_LD * 2 <= WS_W && WS_BT_IN + (size_t)2 * P_LD * 2048 <= WS_BT_OUT, "ws map");
constexpr int CW_CNT = 1024;
constexpr int CW_BAR = 4096;
constexpr size_t CTL_ADA = 256 * 1024;
constexpr size_t CTL_BIASR = 700 * 1024;

constexpr int RING_BYTES = 131072;
constexpr int TAB_OFF = RING_BYTES;
constexpr int MISC_OFF = RING_BYTES + 1024;
constexpr int LDS_BYTES = 147456;

#define GAS __attribute__((address_space(1)))
#define LAS __attribute__((address_space(3)))
typedef unsigned short bf16;
typedef float f32x4 __attribute__((ext_vector_type(4)));
typedef float f32x2 __attribute__((ext_vector_type(2)));
typedef unsigned u32x4 __attribute__((ext_vector_type(4)));
typedef unsigned u32x2 __attribute__((ext_vector_type(2)));
#define LDS_WAIT() asm volatile("s_waitcnt lgkmcnt(0)" ::: "memory")

__device__ __forceinline__ unsigned f2bf(float f) { unsigned u = __builtin_bit_cast(unsigned, f); return (u + 0x7fffu + ((u >> 16) & 1u)) >> 16; }
__device__ __forceinline__ unsigned pk2(float lo, float hi) { return f2bf(lo) | (f2bf(hi) << 16); }
typedef __bf16 bfl2 __attribute__((ext_vector_type(2)));
__device__ __forceinline__ unsigned pkbf(float lo, float hi) { f32x2 v; v.x = lo; v.y = hi; return __builtin_bit_cast(unsigned, __builtin_convertvector(v, bfl2)); }
__device__ __forceinline__ float bflo(unsigned u) { return __builtin_bit_cast(float, u << 16); }
__device__ __forceinline__ float bfhi(unsigned u) { return __builtin_bit_cast(float, u & 0xffff0000u); }
__device__ __forceinline__ void load8(const bf16* p, float (&o)[8]) { const u32x4 u = *(const u32x4*)p; o[0] = bflo(u.x); o[1] = bfhi(u.x); o[2] = bflo(u.y); o[3] = bfhi(u.y); o[4] = bflo(u.z); o[5] = bfhi(u.z); o[6] = bflo(u.w); o[7] = bfhi(u.w); }
__device__ __forceinline__ void store8(bf16* p, const float (&v)[8]) { u32x4 w; w.x = pk2(v[0], v[1]); w.y = pk2(v[2], v[3]); w.z = pk2(v[4], v[5]); w.w = pk2(v[6], v[7]); *(u32x4*)p = w; }
typedef _Float16 f16x2 __attribute__((ext_vector_type(2)));
__device__ __forceinline__ unsigned pkh2(float lo, float hi) { f16x2 h; h.x = (_Float16)lo; h.y = (_Float16)hi; return __builtin_bit_cast(unsigned, h); }
__device__ __forceinline__ float hlo(unsigned u) { return (float)__builtin_bit_cast(f16x2, u).x; }
__device__ __forceinline__ float hhi(unsigned u) { return (float)__builtin_bit_cast(f16x2, u).y; }
__device__ __forceinline__ void load8h(const bf16* p, float (&o)[8]) { const u32x4 u = *(const u32x4*)p; o[0] = hlo(u.x); o[1] = hhi(u.x); o[2] = hlo(u.y); o[3] = hhi(u.y); o[4] = hlo(u.z); o[5] = hhi(u.z); o[6] = hlo(u.w); o[7] = hhi(u.w); }
__device__ __forceinline__ void store8h(bf16* p, const float (&v)[8]) { u32x4 w; w.x = pkh2(v[0], v[1]); w.y = pkh2(v[2], v[3]); w.z = pkh2(v[4], v[5]); w.w = pkh2(v[6], v[7]); *(u32x4*)p = w; }
__device__ __forceinline__ float fmx_lo(float a, unsigned h, float c) { float d; asm("v_fma_mix_f32 %0, %1, %2, %3 op_sel_hi:[0,1,0]" : "=v"(d) : "v"(a), "v"(h), "v"(c)); return d; }
__device__ __forceinline__ float fmx_hi(float a, unsigned h, float c) { float d; asm("v_fma_mix_f32 %0, %1, %2, %3 op_sel:[0,1,0] op_sel_hi:[0,1,0]" : "=v"(d) : "v"(a), "v"(h), "v"(c)); return d; }
__device__ __forceinline__ float mmx_lo(float a, unsigned h) { float d; asm("v_fma_mix_f32 %0, %1, %2, 0 op_sel_hi:[0,1,0]" : "=v"(d) : "v"(a), "v"(h)); return d; }
__device__ __forceinline__ float mmx_hi(float a, unsigned h) { float d; asm("v_fma_mix_f32 %0, %1, %2, 0 op_sel:[0,1,0] op_sel_hi:[0,1,0]" : "=v"(d) : "v"(a), "v"(h)); return d; }
__device__ __forceinline__ float sigmoidf_(float x) { return __builtin_amdgcn_rcpf(1.0f + __expf(-x)); }
__device__ __forceinline__ float tanhf_(float x) { return 1.0f - 2.0f * __builtin_amdgcn_rcpf(__expf(2.0f * x) + 1.0f); }
__device__ __forceinline__ float wave_sum(float v) {
#pragma unroll
    for (int o = 1; o < 64; o <<= 1) v += __shfl_xor(v, o);
    return v;
}
__device__ __forceinline__ float sum8(float v) { v += __shfl_xor(v, 1); v += __shfl_xor(v, 2); v += __shfl_xor(v, 4); return v; }
template <int CTRL> __device__ __forceinline__ float dpp_f(float v) { return __builtin_bit_cast(float, __builtin_amdgcn_mov_dpp(__builtin_bit_cast(int, v), CTRL, 0xF, 0xF, true)); }
__device__ __forceinline__ float dpp_sum16(float v) {
    v += dpp_f<0xB1>(v);
    v += dpp_f<0x4E>(v);
    v += dpp_f<0x141>(v);
    v += dpp_f<0x140>(v);
    return v;
}

#define XB_TMO      128
#define XB_XCNT(j)  (256  + 64 * (j))
#define XB_XSUB(j)  (1280 + 64 * (j))
#define XB_XGEN(j)  (2304 + 64 * (j))
#define XB_TOP      3328
#define XB_TOPGEN   3392
#define XCD_BAR_WORDS 3456
#define XB_SPIN_CAP (1u << 18)

__device__ __forceinline__ unsigned xb_ld(unsigned* p)              { return __hip_atomic_load(p, __ATOMIC_RELAXED, __HIP_MEMORY_SCOPE_AGENT); }
__device__ __forceinline__ unsigned xb_add(unsigned* p, unsigned v) { return __hip_atomic_fetch_add(p, v, __ATOMIC_RELAXED, __HIP_MEMORY_SCOPE_AGENT); }
__device__ __forceinline__ unsigned xb_xcc_id() { return (unsigned)__builtin_amdgcn_s_getreg((3 << 11) | 20) & 0xFu; }
#define XB_SPIN(cond, bar) do { unsigned _sp = 0; while (cond) { __builtin_amdgcn_s_sleep(1); \
    if ((++_sp & 255u) == 0u) { if (xb_ld(&(bar)[XB_TMO])) break; if (_sp > XB_SPIN_CAP) { atomicAdd(&(bar)[XB_TMO], 1u); break; } } } } while (0)

struct XcdBarrier {
    unsigned* bar; unsigned x;
    volatile LAS unsigned* st;
};

__device__ __forceinline__ XcdBarrier xcd_barrier_post(unsigned* bar, volatile LAS unsigned* st) {
    XcdBarrier b; b.bar = bar; b.x = xb_xcc_id(); b.st = st;
    if (threadIdx.x == 0) (void)xb_add(&bar[XB_XCNT(b.x)], 1u);
    return b;
}
__device__ __forceinline__ void xcd_barrier_complete(unsigned* bar, unsigned x, unsigned& nloc, unsigned& nx) {
    const unsigned G = gridDim.x * gridDim.y * gridDim.z;
    unsigned sum, cnt, mine, sp = 0u;
    for (;;) {
        sum = 0u; cnt = 0u; mine = 0u;
#pragma unroll
        for (unsigned j = 0; j < 16; ++j) { const unsigned c = xb_ld(&bar[XB_XCNT(j)]); sum += c; cnt += (c > 0u) ? 1u : 0u; mine = (j == x) ? c : mine; }
        if (sum == G) break;
        __builtin_amdgcn_s_sleep(1);
        if ((++sp & 255u) == 0u) { if (xb_ld(&bar[XB_TMO])) break; if (sp > XB_SPIN_CAP) { atomicAdd(&bar[XB_TMO], 1u); break; } }
    }
    nloc = mine > 0u ? mine : 1u; nx = cnt > 0u ? cnt : 1u;
}

__device__ __forceinline__ void xcd_barrier(const XcdBarrier& b) {
    asm volatile("s_waitcnt vmcnt(0)" ::: "memory");
    __syncthreads();
    if (threadIdx.x == 0) {
        unsigned* bar = b.bar;
        __builtin_amdgcn_s_waitcnt(0);
        unsigned nloc = b.st[0], nx = b.st[1];
        if (nloc == 0u) { xcd_barrier_complete(bar, b.x, nloc, nx); b.st[0] = nloc; b.st[1] = nx; }
        const unsigned old = xb_add(&bar[XB_XSUB(b.x)], 1u);
        const unsigned gen = old / nloc;
        if (old + 1u == (gen + 1u) * nloc) {
            __builtin_amdgcn_fence(__ATOMIC_RELEASE, "agent");
            asm volatile("s_waitcnt vmcnt(0)" ::: "memory");
            const unsigned og = xb_add(&bar[XB_TOP], 1u);
            const unsigned tg = og / nx;
            if (og + 1u == (tg + 1u) * nx) xb_add(&bar[XB_TOPGEN], 1u);
            else XB_SPIN(xb_ld(&bar[XB_TOPGEN]) == tg, bar);
            __builtin_amdgcn_fence(__ATOMIC_ACQUIRE, "agent");
            xb_add(&bar[XB_XGEN(b.x)], 1u);
            asm volatile("s_waitcnt vmcnt(0)" ::: "memory");
        } else {
            XB_SPIN(xb_ld(&bar[XB_XGEN(b.x)]) == gen, bar);
            __builtin_amdgcn_fence(__ATOMIC_ACQUIRE, "agent");
            asm volatile("s_waitcnt vmcnt(0)" ::: "memory");
        }
    }
    __syncthreads();
}

struct Args { const void* p[30]; int ph_lo, ph_hi; };
template <int IDX> __device__ __forceinline__ const float* kin() {
    const auto ka = __builtin_amdgcn_kernarg_segment_ptr(); unsigned long long v;
    asm volatile("s_load_dwordx2 %0, %1, %2\n\ts_waitcnt lgkmcnt(0)" : "=s"(v) : "s"(ka), "i"(IDX * 8) : "memory");
    return (const float*)(const GAS float*)v;
}
enum { I_X = 0, I_C, I_WADA, I_BADA, I_N1G, I_N2G, I_WIN, I_MU, I_CONVW, I_W0, I_DECUP, I_A0, I_AAAUP, I_GATEUP, I_KK, I_KA, I_RK, I_LNW, I_LNB, I_VMD, I_VMU, I_V0, I_WOUT, I_WR, I_RB, I_WE1, I_WE2, I_FG };
struct Frame {
    LAS unsigned char* lds;
    int tid, lane, wave, vcu, G;
    GAS unsigned char* ws;
};
__device__ __forceinline__ float* ada_ptr(const Frame& F, int l, int b) { return (float*)(F.ws + WS_CTL + CTL_ADA) + (size_t)(l * 8 + b) * 6144; }

__device__ __forceinline__ void transpose_item(const float* W, int K, int N, bf16* WT, int dst_row0, int k0, int n0, LAS float* scr, int lane) {
    float tv[32];
#pragma unroll
    for (int i = 0; i < 32; ++i) tv[i] = W[(size_t)(k0 + 2 * i + (lane >> 5)) * N + n0 + (lane & 31)];
#pragma unroll
    for (int i = 0; i < 32; ++i) { const int kk = 2 * i + (lane >> 5); scr[kk * 33 + (lane & 31)] = tv[i]; }
    LDS_WAIT();
    const int c = lane & 7;
#pragma unroll
    for (int j = 0; j < 4; ++j) { const int n = (lane >> 3) + 8 * j; const LAS float* s = scr + (8 * c) * 33 + n;
        u32x4 o; o.x = pk2(s[0 * 33], s[1 * 33]); o.y = pk2(s[2 * 33], s[3 * 33]); o.z = pk2(s[4 * 33], s[5 * 33]); o.w = pk2(s[6 * 33], s[7 * 33]);
        *(u32x4*)(WT + (size_t)(dst_row0 + n) * K + k0 + 8 * c) = o; }
    LDS_WAIT();
}
__device__ __forceinline__ void p0_prologue(const Frame& F) {
    LAS float* scr = (LAS float*)(F.lds + F.wave * 16384);
    const int gw = F.vcu * NWAVES + F.wave, NGW = F.G * NWAVES, lane = F.lane;
    constexpr int I_ADA = 768, I_A = 2 * 16 * 264, I_B = 2 * 16 * 32, I_C1 = 64 * 16 * 32, I_D = 64 * 8 * 32;
    constexpr int NITEMS = I_ADA + I_A + I_B + I_C1 + I_D;
    const float* const pC = kin<I_C>(); const float* const pWADA = kin<I_WADA>(); const float* const pWIN = kin<I_WIN>();
    const float* const pWOUT = kin<I_WOUT>(); const float* const pWE1 = kin<I_WE1>(); const float* const pWE2 = kin<I_WE2>(); const float* const pVMD = kin<I_VMD>();
    for (int it = gw; it < NITEMS; it += NGW) {
        int r = it;
        if (r < I_ADA) {
            const int l = r / 384, rr = r % 384, cch = rr >> 4, kc = rr & 15, col = cch * 256 + 4 * lane, k0 = kc * 64;
            float cv[8];
#pragma unroll
            for (int b = 0; b < 8; ++b) { const float x = pC[b * 1024 + k0 + lane]; cv[b] = x * sigmoidf_(x); }
            f32x4 acc[8];
#pragma unroll
            for (int b = 0; b < 8; ++b) acc[b] = (f32x4){0.f, 0.f, 0.f, 0.f};
            const float* wp = pWADA + ((size_t)l * 1024 + k0) * 6144 + col;
#pragma unroll 16
            for (int kk = 0; kk < 64; ++kk) { const f32x4 w = *(const f32x4*)(wp + (size_t)kk * 6144);
#pragma unroll
                for (int b = 0; b < 8; ++b) { const float s = __builtin_bit_cast(float, __builtin_amdgcn_readlane(__builtin_bit_cast(int, cv[b]), kk)); acc[b] += s * w; } }
#pragma unroll
            for (int b = 0; b < 8; ++b) *(f32x4*)((float*)(F.ws + WS_ADAP) + ((size_t)(kc * 2 + l) * 8 + b) * 6144 + col) = acc[b];
            continue;
        }
        r -= I_ADA;
        if (r < I_A) { const int l = r / (16 * 264), rr = r % (16 * 264), kb = rr / 264, nb = rr % 264;
            transpose_item(pWIN + (size_t)l * 1024 * N_IN, 1024, N_IN, (bf16*)(F.ws + WS_BT_IN) + (size_t)l * P_LD * 1024, 32 * nb, 64 * kb, 32 * nb, scr, lane); continue; }
        r -= I_A;
        if (r < I_B) { const int l = r / 512, rr = r % 512, kb = rr / 32, nb = rr % 32;
            transpose_item(pWOUT + (size_t)l * 1024 * 1024, 1024, 1024, (bf16*)(F.ws + WS_BT_OUT) + (size_t)l * 1024 * 1024, 32 * nb, 64 * kb, 32 * nb, scr, lane); continue; }
        r -= I_B;
        if (r < I_C1) { const int le = r / 512, rr = r % 512, kb = rr / 32, nb = rr % 32, n0 = 32 * nb;
            const int j0 = n0 & 511, dst = (j0 >> 7) * 256 + (n0 >= 512 ? 128 : 0) + (j0 & 127);
            transpose_item(pWE1 + (size_t)le * 1024 * 1024, 1024, 1024, (bf16*)(F.ws + WS_BT_E1) + (size_t)le * 1024 * 1024, dst, 64 * kb, n0, scr, lane); continue; }
        r -= I_C1;
        { const int le = r / 256, rr = r % 256, kb = rr / 32, nb = rr % 32;
            transpose_item(pWE2 + (size_t)le * 512 * 1024, 512, 1024, (bf16*)(F.ws + WS_BT_E2) + (size_t)le * 1024 * 512, 32 * nb, 64 * kb, 32 * nb, scr, lane); }
    }
    const int gt0 = F.vcu * NWAVES * 64 + F.tid, GT = F.G * NWAVES * 64;
    { const float* const pVMUp = kin<I_VMU>();
      for (int it = gt0; it < 256 * 128; it += GT) { const int n = it >> 7, k0 = (it & 127) * 8; float o[8];
#pragma unroll
        for (int i = 0; i < 8; ++i) o[i] = (n < 32) ? pVMD[(k0 + i) * 32 + n] : 0.f;
        store8((bf16*)(F.ws + WS_BT_IN) + (size_t)P_LD * 1024 + (size_t)(C_VD + n) * 1024 + k0, o); }
      for (int it = gt0; it < 1024 * 4; it += GT) { const int n = it >> 2, j0 = (it & 3) * 8; float o[8];
#pragma unroll
        for (int i = 0; i < 8; ++i) o[i] = pVMUp[(j0 + i) * 1024 + n];
        store8((bf16*)(F.ws + WS_VU) + (size_t)n * 32 + j0, o); } }
    { const float* const pDU = kin<I_DECUP>(); const float* const pAU = kin<I_AAAUP>(); const float* const pGU = kin<I_GATEUP>();
      for (int it = gt0; it < 2 * 3072 * 32; it += GT) { const int l = it / (3072 * 32), rr = it % (3072 * 32), n = rr >> 5, k0 = (rr & 31) * 8; float o[8];
#pragma unroll
        for (int i = 0; i < 8; ++i) { const int k = k0 + i; float v = 0.f;
            if (n < 1024) { if (k < 64) v = pDU[(size_t)(l * 64 + k) * 1024 + n]; }
            else if (n < 2048) { if (k >= 64 && k < 128) v = pAU[(size_t)(l * 64 + k - 64) * 1024 + n - 1024]; }
            else { if (k >= 128) v = pGU[(size_t)(l * 128 + k - 128) * 1024 + n - 2048]; }
            o[i] = v; }
        store8((bf16*)(F.ws + WS_BT_LR) + (size_t)l * 3072 * 256 + (size_t)n * 256 + k0, o); } }
    { const float* const pWRp = kin<I_WR>(); const int gt = F.vcu * NWAVES * 64 + F.tid; if (gt < 32768) { const float w = pWRp[(gt & 1023) * 32 + (gt >> 10)]; const unsigned hi = f2bf(w);
        ((bf16*)(F.ws + WS_WRT))[gt] = (bf16)hi; ((bf16*)(F.ws + WS_WRT))[32768 + gt] = (bf16)f2bf(w - bflo(hi)); } }
}

__device__ __forceinline__ void p0b_ada_reduce(const Frame& F) {
    const float* const pBADA = kin<I_BADA>(); const float* ap = (const float*)(F.ws + WS_ADAP); float* ada = (float*)(F.ws + WS_CTL + CTL_ADA);
    for (int idx = F.vcu * NWAVES * 64 + F.tid; idx < 2 * 8 * 6144; idx += F.G * NWAVES * 64) { const int l = idx / 49152, r = idx % 49152, c = r % 6144;
        float s = pBADA[l * 6144 + c];
#pragma unroll
        for (int kc = 0; kc < 16; ++kc) s += ap[(size_t)(kc * 2 + l) * 49152 + r];
        ada[idx] = s; }
}

template <int MODE> __device__ __forceinline__ void p1_norm(const Frame& F, int l) {
    const int lane = F.lane;
    const float* const pX = kin<I_X>(); float* const pOUT = (float*)kin<28>(); const float* const pFG = kin<I_FG>(); const float* const pN1G = kin<I_N1G>(); const float* const pWRb = kin<I_WR>();
#pragma unroll 1
    for (int gw = F.vcu * NWAVES + F.wave; gw < T / 8; gw += F.G * NWAVES) { const int tok0 = gw * 8, b = tok0 >> 11;
        f32x4 gm[4], sh[4], g2v[4];
#pragma unroll
        for (int j = 0; j < 4; ++j) { const int c = 4 * lane + 256 * j;
            if (MODE == 2) { gm[j] = *(const f32x4*)(pFG + c); sh[j] = (f32x4){0.f, 0.f, 0.f, 0.f}; }
            else { const float* ad = ada_ptr(F, l, b); const f32x4 g = *(const f32x4*)(pN1G + l * 1024 + c), sc = *(const f32x4*)(ad + 1024 + c); gm[j] = g * (1.0f + sc); sh[j] = *(const f32x4*)(ad + c); }
            if (MODE >= 1) g2v[j] = *(const f32x4*)(ada_ptr(F, MODE == 2 ? 1 : l - 1, b) + 5120 + c); }
        float* X = (float*)(F.ws + WS_X);
        const bf16* YE = (const bf16*)(F.ws + WS_YE);
        const float* WTS = (const float*)(F.ws + WS_WTS); const int* SLOT = (const int*)(F.ws + WS_SLOT);
#pragma unroll 1
        for (int tb = 0; tb < 8; tb += 4) {
            f32x4 v[4][4];
#pragma unroll
            for (int t = 0; t < 4; ++t) { const float* xs = (MODE == 0 ? pX : X) + (size_t)(tok0 + tb + t) * 1024;
#pragma unroll
                for (int j = 0; j < 4; ++j) v[t][j] = *(const f32x4*)(xs + 4 * lane + 256 * j); }
            if (MODE >= 1) {
                float w0[4], w1[4]; int s0[4], s1[4]; u32x2 y0[4][4], y1[4][4];
#pragma unroll
                for (int t = 0; t < 4; ++t) { const int tok = tok0 + tb + t; w0[t] = WTS[tok * 2]; w1[t] = WTS[tok * 2 + 1]; s0[t] = SLOT[tok * 2]; s1[t] = SLOT[tok * 2 + 1]; }
#pragma unroll
                for (int t = 0; t < 4; ++t)
#pragma unroll
                    for (int j = 0; j < 4; ++j) { y0[t][j] = *(const u32x2*)(YE + (size_t)s0[t] * 1024 + 4 * lane + 256 * j); y1[t][j] = *(const u32x2*)(YE + (size_t)s1[t] * 1024 + 4 * lane + 256 * j); }
#pragma unroll
                for (int t = 0; t < 4; ++t)
#pragma unroll
                    for (int j = 0; j < 4; ++j) { const u32x2 a = y0[t][j], c = y1[t][j];
                        f32x4 m; m[0] = w0[t] * bflo(a.x) + w1[t] * bflo(c.x); m[1] = w0[t] * bfhi(a.x) + w1[t] * bfhi(c.x); m[2] = w0[t] * bflo(a.y) + w1[t] * bflo(c.y); m[3] = w0[t] * bfhi(a.y) + w1[t] * bfhi(c.y);
                        v[t][j] += g2v[j] * m; if (MODE == 1) *(f32x4*)(X + (size_t)(tok0 + tb + t) * 1024 + 4 * lane + 256 * j) = v[t][j]; }
            }
            float ss[4];
#pragma unroll
            for (int t = 0; t < 4; ++t) { ss[t] = 0.f;
#pragma unroll
                for (int j = 0; j < 4; ++j) ss[t] += (v[t][j][0] * v[t][j][0] + v[t][j][1] * v[t][j][1]) + (v[t][j][2] * v[t][j][2] + v[t][j][3] * v[t][j][3]); }
#pragma unroll
            for (int o = 1; o < 64; o <<= 1) {
#pragma unroll
                for (int t = 0; t < 4; ++t) ss[t] += __shfl_xor(ss[t], o); }
#pragma unroll
            for (int t = 0; t < 4; ++t) { const int tok = tok0 + tb + t;
                const float rstd = __builtin_amdgcn_rsqf(ss[t] * (1.0f / 1024.0f) + NORM_EPS);
#pragma unroll
                for (int j = 0; j < 4; ++j) { const f32x4 h = v[t][j] * rstd * gm[j] + sh[j];
                    if (MODE == 2) *(f32x4*)(pOUT + (size_t)tok * 1024 + 4 * lane + 256 * j) = h;
                    else { u32x2 w; w.x = pk2(h[0], h[1]); w.y = pk2(h[2], h[3]); *(u32x2*)((bf16*)(F.ws + WS_H) + (size_t)tok * 1024 + 4 * lane + 256 * j) = w; } } }
        }
    }
    if (MODE == 0 && F.vcu < 16) {
        const int lb = F.vcu, e = F.tid & 31, kq = F.tid >> 5; const float* sh2 = ada_ptr(F, lb >> 3, lb & 7) + 3072; float s = 0.f;
        for (int k = kq * 64; k < kq * 64 + 64; ++k) s += sh2[k] * pWRb[k * 32 + e];
        LAS float* red = (LAS float*)F.lds; red[kq * 32 + e] = s; __syncthreads();
        if (F.tid < 32) { float t = 0.f; for (int q = 0; q < 16; ++q) t += red[q * 32 + e]; ((float*)(F.ws + WS_CTL + CTL_BIASR))[lb * 32 + e] = t; }
        __syncthreads();
    }
}

typedef short bfv8 __attribute__((ext_vector_type(8)));
constexpr int LRX_PITCH = 592;
template <int NKS> struct LrW { bfv8 w[2][NKS]; f32x4 b0, b1; };
template <int NKS> __device__ __forceinline__ void lrx_load(LrW<NKS>& W, const bf16* wrow0, int wpitch, const float* bias, int li, int fq) {
#pragma unroll
    for (int tile = 0; tile < 2; ++tile) { const bf16* rp = wrow0 + (size_t)(8 * (li >> 2) + 4 * tile + (li & 3)) * wpitch + 8 * fq;
#pragma unroll
        for (int ks = 0; ks < NKS; ++ks) W.w[tile][ks] = *(const bfv8*)(rp + 32 * ks); }
    if (bias) { W.b0 = *(const f32x4*)(bias + 8 * fq); W.b1 = *(const f32x4*)(bias + 8 * fq + 4); }
}
template <int NKS, int MODE> __device__ __forceinline__ void lrx_job(const LrW<NKS>& W, const LAS unsigned char* tile, int kcol, bf16* out, int ostride, int li, int fq) {
#pragma unroll 2
    for (int mt = 0; mt < 4; ++mt) {
        bfv8 af[NKS];
#pragma unroll
        for (int ks = 0; ks < NKS; ++ks) af[ks] = *(const LAS bfv8*)(tile + (16 * mt + li) * LRX_PITCH + (kcol + 32 * ks + 8 * fq) * 2);
        f32x4 acc0 = (f32x4){0.f, 0.f, 0.f, 0.f}, acc1 = acc0;
#pragma unroll
        for (int ks = 0; ks < NKS; ++ks) { acc0 = __builtin_amdgcn_mfma_f32_16x16x32_bf16(W.w[0][ks], af[ks], acc0, 0, 0, 0); acc1 = __builtin_amdgcn_mfma_f32_16x16x32_bf16(W.w[1][ks], af[ks], acc1, 0, 0, 0); }
        u32x4 o;
        if (MODE == 0) { float x[8];
#pragma unroll
            for (int j = 0; j < 4; ++j) { x[j] = -0.60653066f * sigmoidf_(W.b0[j] + acc0[j]); x[4 + j] = -0.60653066f * sigmoidf_(W.b1[j] + acc1[j]); }
            o.x = pkh2(x[0], x[1]); o.y = pkh2(x[2], x[3]); o.z = pkh2(x[4], x[5]); o.w = pkh2(x[6], x[7]);
        } else if (MODE == 1) { float x[8];
#pragma unroll
            for (int j = 0; j < 4; ++j) { x[j] = sigmoidf_(W.b0[j] + acc0[j]); x[4 + j] = sigmoidf_(W.b1[j] + acc1[j]); }
            o.x = pkh2(x[0], x[1]); o.y = pkh2(x[2], x[3]); o.z = pkh2(x[4], x[5]); o.w = pkh2(x[6], x[7]);
        } else { o.x = pkbf(acc0[0], acc0[1]); o.y = pkbf(acc0[2], acc0[3]); o.z = pkbf(acc1[0], acc1[1]); o.w = pkbf(acc1[2], acc1[3]); }
        *(u32x4*)(out + (size_t)(16 * mt) * ostride) = o;
    }
}
__device__ __forceinline__ void p2x_lowrank(const Frame& F, int l) {
    const int lane = F.lane, c8 = lane & 31, hf = lane >> 5, li = lane & 15, fq = lane >> 4;
    const bf16* P = (const bf16*)(F.ws + WS_P); const float* mu = kin<I_MU>() + l * N_SHIFT + 3072 + 8 * c8;
    const f32x4 m0 = *(const f32x4*)mu, m1 = *(const f32x4*)(mu + 4);
    const float* const pKKc = kin<I_KK>() + l * 1024; const float* const muK = kin<I_MU>() + l * N_SHIFT + 1024; float* KNo = (float*)(F.ws + WS_KN);
    const bf16* BT = (const bf16*)(F.ws + WS_BT_LR) + (size_t)l * 3072 * 256; const bf16* BTV = (const bf16*)(F.ws + WS_VU);
    const float* const pW0 = kin<I_W0>() + l * 1024; const float* const pA0 = kin<I_A0>() + l * 1024; const float* const pV0 = kin<I_V0>();
    LAS unsigned char* tile = F.lds;
    const int cw = F.wave * 128;
#pragma unroll 1
    for (int item = F.vcu; item < T / 64; item += F.G) { const int gw = item * 8 + F.wave;
        LrW<2> W2[2]; LrW<4> W4[2]; LrW<1> W1[2];
        lrx_load<2>(W2[0], BT + (size_t)cw * 256, 256, pW0 + cw, li, fq);
#pragma unroll
        for (int i = 0; i < 4; ++i) { const int row = 8 * F.wave + 2 * i + hf, tok = item * 64 + row; float cur[8], prv[8], o[8];
            load8(P + (size_t)tok * P_LD + C_WD + 8 * c8, cur);
            if ((tok & (SEQ - 1)) != 0) load8(P + (size_t)(tok - 1) * P_LD + C_WD + 8 * c8, prv); else {
#pragma unroll
                for (int j = 0; j < 8; ++j) prv[j] = 0.f; }
#pragma unroll
            for (int j = 0; j < 8; ++j) { const float v = cur[j] + (prv[j] - cur[j]) * (j < 4 ? m0[j] : m1[j - 4]); o[j] = (c8 < 8) ? tanhf_(v) : ((c8 < 16) ? v : sigmoidf_(v)); }
            u32x4 w; w.x = pkbf(o[0], o[1]); w.y = pkbf(o[2], o[3]); w.z = pkbf(o[4], o[5]); w.w = pkbf(o[6], o[7]);
            *(LAS u32x4*)(tile + row * LRX_PITCH + 16 * c8) = w; }
        if (l == 1 && F.tid < 256) { const int row = F.tid >> 2, ch = F.tid & 3;
            *(LAS u32x4*)(tile + row * LRX_PITCH + 512 + 16 * ch) = *(const u32x4*)(P + (size_t)(item * 64 + row) * P_LD + C_VD + 8 * ch); }
#pragma unroll 1
        for (int ch = 0; ch < 2; ++ch) { const int col0 = 512 * ch + 8 * lane; float kkc[8], muk[8], kp_[8];
#pragma unroll
            for (int j = 0; j < 8; ++j) { kkc[j] = pKKc[col0 + j]; muk[j] = muK[col0 + j]; kp_[j] = 0.f; }
            const int tok0 = gw * 8;
            if ((tok0 & (SEQ - 1)) != 0) load8(P + (size_t)(tok0 - 1) * P_LD + C_K + col0, kp_);
#pragma unroll 4
            for (int tk = 0; tk < 8; ++tk) { float kc[8]; load8(P + (size_t)(tok0 + tk) * P_LD + C_K + col0, kc); float ss = 0.f;
#pragma unroll
                for (int j = 0; j < 8; ++j) { const float k = (kc[j] + (kp_[j] - kc[j]) * muk[j]) * kkc[j]; ss += k * k; kp_[j] = kc[j]; }
                ss = sum8(ss);
                if ((lane & 7) == 0) KNo[(tok0 + tk) * 16 + 8 * ch + (lane >> 3)] = __builtin_amdgcn_rsqf(fmaxf(ss, 1e-24f)); } }
        __syncthreads();
        bf16* outb = (bf16*)(F.ws + WS_LR) + (size_t)(item * 64 + li) * 3072 + cw + 8 * fq;
#pragma unroll
        for (int j = 0; j < 8; ++j) { const int a = j >> 2, g = j & 3, jn = j + 1, an = jn >> 2, gn = jn & 3;
            if (jn < 8) lrx_load<2>(W2[jn & 1], BT + (size_t)(an * 1024 + cw + 32 * gn) * 256 + 64 * an, 256, (an ? pA0 : pW0) + cw + 32 * gn, li, fq);
            else lrx_load<4>(W4[0], BT + (size_t)(2048 + cw) * 256 + 128, 256, nullptr, li, fq);
            if (a == 0) lrx_job<2, 0>(W2[j & 1], tile, 0, outb + 32 * g, 3072, li, fq); else lrx_job<2, 1>(W2[j & 1], tile, 64, outb + 1024 + 32 * g, 3072, li, fq); }
#pragma unroll
        for (int g = 0; g < 4; ++g) {
            if (g + 1 < 4) lrx_load<4>(W4[(g + 1) & 1], BT + (size_t)(2048 + cw + 32 * (g + 1)) * 256 + 128, 256, nullptr, li, fq);
            else if (l == 1) lrx_load<1>(W1[0], BTV + (size_t)cw * 32, 32, pV0 + cw, li, fq);
            lrx_job<4, 2>(W4[g & 1], tile, 128, outb + 2048 + 32 * g, 3072, li, fq); }
        if (l == 1) { bf16* outv = (bf16*)(F.ws + WS_VG) + (size_t)(item * 64 + li) * 1024 + cw + 8 * fq;
#pragma unroll
            for (int g = 0; g < 4; ++g) {
                if (g + 1 < 4) lrx_load<1>(W1[(g + 1) & 1], BTV + (size_t)(cw + 32 * (g + 1)) * 32, 32, pV0 + cw + 32 * (g + 1), li, fq);
                lrx_job<1, 1>(W1[g & 1], tile, 256, outv + 32 * g, 1024, li, fq); } }
        __syncthreads();
    }
}

__device__ __forceinline__ f32x4 h4_to_f4(const u32x2 u) { return (f32x4){hlo(u.x), hhi(u.x), hlo(u.y), hhi(u.y)}; }
constexpr size_t WS_YCK = WS_Y;
typedef short bf16x8 __attribute__((ext_vector_type(8)));
typedef float f32x16 __attribute__((ext_vector_type(16)));
constexpr int CK_XK = 0, CK_XR = 4608, CK_BH = 9216, CK_KH = 14336, CK_GB = 19456, CK_VT = 19712, CK_X3SZ = 22272;
constexpr int CK_XB = 0, CK_XP = 4608, CK_P2SZ = 9216;
constexpr int CK_TK = 0, CK_TBR = 2560, CK_TKR = 5120, CK_T12 = 7680, CK_TBT = 11776, CK_MT = 15872, CK_T2SZ = 18432;
constexpr int CK_X3_OFF = 0, CK_P2_OFF = 3 * CK_X3SZ, CK_T2_OFF = CK_P2_OFF + 2 * CK_P2SZ, CK_STASH = CK_T2_OFF + 2 * CK_T2SZ;
static_assert(CK_STASH + 8192 <= RING_BYTES, "chunked-scan LDS map");
#define CK_MFMA(a, b, c) __builtin_amdgcn_mfma_f32_32x32x16_bf16((a), (b), (c), 0, 0, 0)
__device__ __forceinline__ bf16x8 ck_frag(const LAS unsigned char* base, int pitch, int row, int kel) { return *(const LAS bf16x8*)(base + row * pitch + kel * 2); }
struct CkRegs { u32x2 rP, rA, rB, kP, kA, kB, vP, vA, vB, dwA, dwB, apA, apB, vmA, vmB, vfA, vfB; float knA, knB; };
struct CkConst { f32x4 a0, kk, ka, rk, w0, v0, mur, muk, muv; };
__device__ __forceinline__ f32x4 b4_to_f4(const u32x2 u) { return (f32x4){bflo(u.x), bfhi(u.x), bflo(u.y), bfhi(u.y)}; }
__device__ __forceinline__ void ck_issue(const Frame& F, int pw, int l, int b, int h, int half, int blk, CkRegs& R) {
    const int s2 = F.lane >> 2, cq = F.lane & 3, col = h * 64 + 16 * pw + 4 * cq; const size_t tA = (size_t)b * SEQ + blk * 32 + 2 * s2;
    const bf16* P = (const bf16*)(F.ws + WS_P) + tA * P_LD + col; const bf16* LR = (const bf16*)(F.ws + WS_LR) + tA * 3072 + col; const float* KN = (const float*)(F.ws + WS_KN) + tA * 16 + h;
    R.rA = *(const u32x2*)(P + C_R); R.rB = *(const u32x2*)(P + P_LD + C_R); R.kA = *(const u32x2*)(P + C_K); R.kB = *(const u32x2*)(P + P_LD + C_K); R.vA = *(const u32x2*)(P + C_V); R.vB = *(const u32x2*)(P + P_LD + C_V);
    if ((tA & (SEQ - 1)) != 0) { R.rP = *(const u32x2*)(P - P_LD + C_R); R.kP = *(const u32x2*)(P - P_LD + C_K); R.vP = *(const u32x2*)(P - P_LD + C_V); } else { R.rP = (u32x2){0u, 0u}; R.kP = R.rP; R.vP = R.rP; }
    R.dwA = *(const u32x2*)LR; R.dwB = *(const u32x2*)(LR + 3072); R.apA = *(const u32x2*)(LR + 1024); R.apB = *(const u32x2*)(LR + 3072 + 1024);
    R.knA = KN[0]; R.knB = KN[16];
    if (l == 1) { const bf16* VG = (const bf16*)(F.ws + WS_VG) + tA * 1024 + col; R.vmA = *(const u32x2*)VG; R.vmB = *(const u32x2*)(VG + 1024); const bf16* V0 = (const bf16*)(F.ws + WS_V0) + tA * 1024 + col; R.vfA = *(const u32x2*)V0; R.vfB = *(const u32x2*)(V0 + 1024); }
    (void)half;
}
__device__ __forceinline__ void ck_elem(const CkConst& C, int l, const f32x4 rc, const f32x4 rp, const f32x4 kc, const f32x4 kp_, const f32x4 vc, const f32x4 vp, const f32x4 dw, const f32x4 ap, const float kn,
                                        const f32x4 vm, const f32x4 vf, f32x4& r, f32x4& kk, f32x4& bq, f32x4& kp, f32x4& lw, f32x4& v, float& bo) {
#pragma unroll
    for (int e = 0; e < 4; ++e) {
        r[e] = rc[e] + (rp[e] - rc[e]) * C.mur[e]; const float k = kc[e] + (kp_[e] - kc[e]) * C.muk[e]; float vv = vc[e] + (vp[e] - vc[e]) * C.muv[e];
        const float av = ap[e]; kk[e] = k * C.kk[e] * kn;     bq[e] = kk[e] * av; kp[e] = k * (1.0f + (av - 1.0f) * C.ka[e]); bo += r[e] * kp[e] * C.rk[e];
        lw[e] = dw[e];
        if (l == 1) vv = vv + (vf[e] - vv) * vm[e];
        v[e] = vv; }
}
__device__ __forceinline__ void ck_stage1(const Frame& F, int pw, int l, int b, int h, int half, int blk, const CkConst& C, LAS unsigned char* BX, LAS unsigned char* BP, CkRegs& R, bool issue_next) {
    const int lane = F.lane, s2 = lane >> 2, cq = lane & 3, c0 = 16 * pw + 4 * cq, cp = 16 * pw + 4 * (((cq & 1) << 1) | (cq >> 1));
    f32x4 kkA, kkB, bqA, bqB, kpA, kpB, rA, rB, lwA, lwB, vA, vB; float boA = 0.f, boB = 0.f;
    { const f32x4 rcA = b4_to_f4(R.rA), kcA = b4_to_f4(R.kA), vcA = b4_to_f4(R.vA), zz = (f32x4){0.f, 0.f, 0.f, 0.f};
      ck_elem(C, l, rcA, b4_to_f4(R.rP), kcA, b4_to_f4(R.kP), vcA, b4_to_f4(R.vP), h4_to_f4(R.dwA), h4_to_f4(R.apA), R.knA, l == 1 ? h4_to_f4(R.vmA) : zz, l == 1 ? h4_to_f4(R.vfA) : zz, rA, kkA, bqA, kpA, lwA, vA, boA);
      ck_elem(C, l, b4_to_f4(R.rB), rcA, b4_to_f4(R.kB), kcA, b4_to_f4(R.vB), vcA, h4_to_f4(R.dwB), h4_to_f4(R.apB), R.knB, l == 1 ? h4_to_f4(R.vmB) : zz, l == 1 ? h4_to_f4(R.vfB) : zz, rB, kkB, bqB, kpB, lwB, vB, boB); }
    asm volatile("" ::: "memory");
    if (issue_next) ck_issue(F, pw, l, b, h, half, blk + 1, R);
    asm volatile("" ::: "memory");
    { const size_t tA = (size_t)b * SEQ + blk * 32 + 2 * s2;
      boA += __shfl_xor(boA, 1); boA += __shfl_xor(boA, 2); boB += __shfl_xor(boB, 1); boB += __shfl_xor(boB, 2);
      if ((pw >> 1) == half) { if (cq == 0) { float* bp = (float*)(F.ws + WS_BONP) + (tA * 16 + h) * 4 + pw; bp[0] = boA; bp[64] = boB; }
          bf16* Vo = (bf16*)(F.ws + (l == 0 ? WS_V0 : WS_V1)) + tA * 1024 + h * 64 + c0;
          *(u32x2*)Vo = (u32x2){pkh2(vA[0], vA[1]), pkh2(vA[2], vA[3])}; *(u32x2*)(Vo + 1024) = (u32x2){pkh2(vB[0], vB[1]), pkh2(vB[2], vB[3])};
#pragma unroll
          for (int e = 0; e < 4; ++e) *(LAS unsigned*)(BX + CK_VT + (16 * (pw & 1) + 4 * cq + e) * 80 + (2 * s2) * 2) = pkbf(vA[e], vB[e]); } }
    float xkA[4], xkB[4], xrA[4], xrB[4], xbA[4], xbB[4], xpA[4], xpB[4], bhA[4], bhB[4], khA[4], khB[4], gb[4];
    float xs[4], Tr[4][4];
#pragma unroll
    for (int e = 0; e < 4; ++e) { lwA[e] *= 1.44269504f; lwB[e] *= 1.44269504f; float x = lwA[e] + lwB[e]; x += dpp_f<0x114>(x); x += dpp_f<0x118>(x); xs[e] = x; }
#pragma unroll
    for (int e = 0; e < 4; ++e)
#pragma unroll
        for (int rw = 0; rw < 4; ++rw) Tr[e][rw] = __shfl(xs[e], 16 * rw + 12 + cq);
    { const int row = lane >> 4; const float m0 = row > 0 ? 1.f : 0.f, m1 = row > 1 ? 1.f : 0.f, m2 = row > 2 ? 1.f : 0.f;
#pragma unroll
    for (int e = 0; e < 4; ++e) {
        const float LB = xs[e] + (m0 * Tr[e][0] + m1 * Tr[e][1] + m2 * Tr[e][2]), LA = LB - lwB[e], L0 = LA - lwA[e], Lt = (Tr[e][0] + Tr[e][1]) + (Tr[e][2] + Tr[e][3]);
        const float eL0 = __builtin_amdgcn_exp2f(L0), eLA = __builtin_amdgcn_exp2f(LA), eLB = __builtin_amdgcn_exp2f(LB), iLA = __builtin_amdgcn_exp2f(-LA), iLB = __builtin_amdgcn_exp2f(-LB), eLt = __builtin_amdgcn_exp2f(Lt), tA = eLt * iLA, tB = eLt * iLB;
        xkA[e] = kkA[e] * eL0; xkB[e] = kkB[e] * eLA; xrA[e] = rA[e] * eLA; xrB[e] = rB[e] * eLB;
        xbA[e] = bqA[e] * iLA; xbB[e] = bqB[e] * iLB; xpA[e] = kpA[e] * iLA; xpB[e] = kpB[e] * iLB;
        bhA[e] = bqA[e] * tA; bhB[e] = bqB[e] * tB; khA[e] = kpA[e] * tA; khB[e] = kpB[e] * tB; gb[e] = eLt;
    } }
    const int oA = (2 * s2) * 144 + cp * 2, oB = oA + 144;
    *(LAS u32x2*)(BX + CK_XK + oA) = (u32x2){pkbf(xkA[0], xkA[1]), pkbf(xkA[2], xkA[3])}; *(LAS u32x2*)(BX + CK_XK + oB) = (u32x2){pkbf(xkB[0], xkB[1]), pkbf(xkB[2], xkB[3])};
    *(LAS u32x2*)(BX + CK_XR + oA) = (u32x2){pkbf(xrA[0], xrA[1]), pkbf(xrA[2], xrA[3])}; *(LAS u32x2*)(BX + CK_XR + oB) = (u32x2){pkbf(xrB[0], xrB[1]), pkbf(xrB[2], xrB[3])};
    *(LAS u32x2*)(BP + CK_XB + oA) = (u32x2){pkbf(xbA[0], xbA[1]), pkbf(xbA[2], xbA[3])}; *(LAS u32x2*)(BP + CK_XB + oB) = (u32x2){pkbf(xbB[0], xbB[1]), pkbf(xbB[2], xbB[3])};
    *(LAS u32x2*)(BP + CK_XP + oA) = (u32x2){pkbf(xpA[0], xpA[1]), pkbf(xpA[2], xpA[3])}; *(LAS u32x2*)(BP + CK_XP + oB) = (u32x2){pkbf(xpB[0], xpB[1]), pkbf(xpB[2], xpB[3])};
    const int i0 = 2 * s2, pst = (i0 & 16) | ((i0 & 4) << 1) | ((i0 & 8) >> 1) | (i0 & 3);
#pragma unroll
    for (int e = 0; e < 4; ++e) { *(LAS unsigned*)(BX + CK_BH + (c0 + e) * 80 + pst * 2) = pkbf(bhA[e], bhB[e]); *(LAS unsigned*)(BX + CK_KH + (c0 + e) * 80 + (2 * s2) * 2) = pkbf(khA[e], khB[e]); }
    if (s2 == 0) *(LAS f32x4*)(BX + CK_GB + c0 * 4) = (f32x4){gb[0], gb[1], gb[2], gb[3]};

}
__device__ __forceinline__ void ck_stage2(const Frame& F, int ti, const LAS unsigned char* BX, const LAS unsigned char* BP, LAS unsigned char* BT) {
    const int r = F.lane & 31, hh = F.lane >> 5;
    const LAS unsigned char* Aa = BP + ((ti < 2) ? CK_XB : CK_XP); const LAS unsigned char* Ba = BX + ((ti & 1) ? CK_XR : CK_XK);
    f32x16 acc;
#pragma unroll
    for (int i = 0; i < 16; ++i) acc[i] = 0.f;
#pragma unroll
    for (int ks = 0; ks < 4; ++ks) acc = CK_MFMA(ck_frag(Aa, 144, r, 16 * ks + 8 * hh), ck_frag(Ba, 144, r, 16 * ks + 8 * hh), acc);
    if (ti == 0) {
        { const u32x4 z = (u32x4){0u, 0u, 0u, 0u}, w = (u32x4){pkbf(acc[0], acc[1]), pkbf(acc[2], acc[3]), pkbf(acc[4], acc[5]), pkbf(acc[6], acc[7])};
          *(LAS u32x4*)(BT + CK_T12 + r * 80 + 16 * hh) = (r >= 16) ? w : z; }
#pragma unroll
        for (int m = 0; m < 4; ++m) { f32x4 t;
#pragma unroll
            for (int e = 0; e < 4; ++e) t[e] = (8 * m + 4 * hh + e < r) ? acc[4 * m + e] : 0.f;
            *(LAS f32x4*)(BT + CK_TBT + (r * 32 + 8 * m + 4 * hh) * 4) = t; }
    } else { const int off = (ti == 1) ? CK_TBR : ((ti == 2) ? CK_TK : CK_TKR);
#pragma unroll
        for (int m = 0; m < 4; ++m) { float t[4];
#pragma unroll
            for (int e = 0; e < 4; ++e) { const int i = 8 * m + 4 * hh + e; const bool keep = (ti == 2) ? (i < r) : (i <= r); t[e] = keep ? acc[4 * m + e] : 0.f; }
            const int col = (ti == 1) ? (16 * (m >> 1) + 8 * hh + 4 * (m & 1)) : (8 * m + 4 * hh);
            *(LAS u32x2*)(BT + off + r * 80 + col * 2) = (u32x2){pkbf(t[0], t[1]), pkbf(t[2], t[3])}; }
    }
    if (ti == 0) {
        LDS_WAIT();
        const int qb = (r >> 4) & 1;
        const LAS float* TBT = (const LAS float*)(BT + CK_TBT) + (16 * qb) * 32 + 16 * qb;
        float x[16];
        int cc = r & 15; asm volatile("" : "+v"(cc));
#pragma unroll
        for (int k = 0; k < 16; ++k) x[k] = (k == cc) ? 1.f : 0.f;
        { f32x4 tc[4], tn[4];
#pragma unroll
          for (int j4 = 0; j4 < 4; ++j4) tc[j4] = *(const LAS f32x4*)(TBT + 15 * 32 + 4 * j4);
#pragma unroll
          for (int kk = 0; kk < 15; ++kk) { const int k = 15 - kk; const float xk = x[k];
              int off = (k - 1) * 32; asm volatile("" : "+v"(off) : "v"(xk));
              if (k - 1 >= 1) {
#pragma unroll
                  for (int j4 = 0; j4 <= (k - 2) / 4; ++j4) tn[j4] = *(const LAS f32x4*)(TBT + off + 4 * j4); }
#pragma unroll
              for (int j4 = 0; j4 <= (k - 1) / 4; ++j4) {
#pragma unroll
                  for (int e = 0; e < 4; ++e) { const int i = 4 * j4 + e; if (i < k) x[i] = __builtin_fmaf(-tc[j4][e], xk, x[i]); } }
#pragma unroll
              for (int j4 = 0; j4 < 4; ++j4) tc[j4] = tn[j4]; } }
        if (hh == 0) { const u32x4 z = (u32x4){0u, 0u, 0u, 0u};
            const u32x4 w0 = (u32x4){pkbf(x[0], x[1]), pkbf(x[2], x[3]), pkbf(x[8], x[9]), pkbf(x[10], x[11])}, w1 = (u32x4){pkbf(x[4], x[5]), pkbf(x[6], x[7]), pkbf(x[12], x[13]), pkbf(x[14], x[15])};
            LAS unsigned char* row = BT + CK_MT + r * 80;
            *(LAS u32x4*)(row + 32 * qb) = w0; *(LAS u32x4*)(row + 32 * qb + 16) = w1; *(LAS u32x4*)(row + 32 * (1 - qb)) = z; *(LAS u32x4*)(row + 32 * (1 - qb) + 16) = z; }
    }
}
#define CK_BAR() do { asm volatile("s_waitcnt lgkmcnt(0)" ::: "memory"); __builtin_amdgcn_s_barrier(); asm volatile("" ::: "memory"); } while (0)
__device__ __forceinline__ void p4_scan(const Frame& F, int l, int probe = 0) {
#pragma unroll 1
    for (int unit = F.vcu; unit < NBATCH * NHEAD * 2; unit += F.G) {
        const int b = unit >> 5, h = (unit >> 1) & 15, half = unit & 1;
        const bool pre = F.wave >= 4, mainw = F.wave == 0;
        const int r = F.lane & 31, hh = F.lane >> 5;
        constexpr int NBLKc = SEQ / 32;
        const int w_ = F.wave;
        if (w_ == 0) {
            f32x16 ST0, ST1;
#pragma unroll
            for (int i = 0; i < 16; ++i) { ST0[i] = 0.f; ST1[i] = 0.f; }
#pragma unroll 1
            for (int blk = -2; blk < NBLKc; ++blk) {
                const LAS unsigned char* BX = F.lds + CK_X3_OFF + ((blk + 3) % 3) * CK_X3SZ; const LAS unsigned char* BT = F.lds + CK_T2_OFF + (blk & 1) * CK_T2SZ;
                bf16x8 SH[2][2], SL[2][2], NUF[2], VF[2]; f32x16 RH, YT;
                if (blk >= 0 && !(probe & 1)) {
#pragma unroll
                for (int c = 0; c < 2; ++c)
#pragma unroll
                    for (int s = 0; s < 2; ++s) { u32x4 ph, pl;
#pragma unroll
                        for (int p = 0; p < 4; ++p) { const float x0 = (c ? ST1 : ST0)[8 * s + 2 * p], x1 = (c ? ST1 : ST0)[8 * s + 2 * p + 1]; const unsigned hp = pkbf(x0, x1);
                            ph[p] = hp;
#if defined(CK_LO)
                            pl[p] = pkbf(x0 - bflo(hp), x1 - bfhi(hp));
#endif
                        }
                        SH[c][s] = __builtin_bit_cast(bf16x8, ph);
#if defined(CK_LO)
                        SL[c][s] = __builtin_bit_cast(bf16x8, pl);
#endif
                    }
                { LAS f32x4* stash = (LAS f32x4*)(F.lds + CK_STASH) + F.lane;
#pragma unroll
                  for (int m = 0; m < 4; ++m) { stash[64 * m] = (f32x4){ST0[4 * m], ST0[4 * m + 1], ST0[4 * m + 2], ST0[4 * m + 3]}; stash[64 * (4 + m)] = (f32x4){ST1[4 * m], ST1[4 * m + 1], ST1[4 * m + 2], ST1[4 * m + 3]}; } }
                VF[0] = ck_frag(BX + CK_VT, 80, r, 8 * hh); VF[1] = ck_frag(BX + CK_VT, 80, r, 16 + 8 * hh);
#pragma unroll
                for (int i = 0; i < 16; ++i) RH[i] = 0.f;
                { bf16x8 ak[2][2], at[2];
#pragma unroll
                  for (int c = 0; c < 2; ++c)
#pragma unroll
                      for (int s = 0; s < 2; ++s) ak[c][s] = ck_frag(BX + CK_XK, 144, r, 32 * c + 16 * s + 8 * hh);
                  at[0] = ck_frag(BT + CK_TK, 80, r, 8 * hh); at[1] = ck_frag(BT + CK_TK, 80, r, 16 + 8 * hh);
#pragma unroll
                  for (int c = 0; c < 2; ++c)
#pragma unroll
                      for (int s = 0; s < 2; ++s) RH = CK_MFMA(ak[c][s], SH[c][s], RH);
#pragma unroll
                  for (int ks = 0; ks < 2; ++ks) RH = CK_MFMA(at[ks], VF[ks], RH); }
                { const bf16x8 mt0 = ck_frag(BT + CK_MT, 80, r, 8 * hh), mt1 = ck_frag(BT + CK_MT, 80, r, 16 + 8 * hh), t12 = ck_frag(BT + CK_T12, 80, r, 8 * hh);
                  u32x4 p4;
#pragma unroll
                  for (int p = 0; p < 4; ++p) p4[p] = pkbf(RH[2 * p], RH[2 * p + 1]);
                  f32x16 UT;
#pragma unroll
                  for (int i = 0; i < 16; ++i) UT[i] = 0.f;
                  UT = CK_MFMA(mt0, __builtin_bit_cast(bf16x8, p4), UT);
#pragma unroll
                  for (int p = 0; p < 4; ++p) p4[p] = pkbf(UT[2 * p], UT[2 * p + 1]) ^ 0x80008000u;
                  NUF[0] = __builtin_bit_cast(bf16x8, p4);
                  RH = CK_MFMA(t12, NUF[0], RH);
#pragma unroll
                  for (int p = 0; p < 4; ++p) p4[p] = pkbf(RH[8 + 2 * p], RH[8 + 2 * p + 1]);
                  UT = CK_MFMA(mt1, __builtin_bit_cast(bf16x8, p4), UT);
#pragma unroll
                  for (int p = 0; p < 4; ++p) p4[p] = pkbf(UT[8 + 2 * p], UT[8 + 2 * p + 1]) ^ 0x80008000u;
                  NUF[1] = __builtin_bit_cast(bf16x8, p4); }
#pragma unroll
                for (int i = 0; i < 16; ++i) YT[i] = 0.f;
                { bf16x8 ar[2][2];
#pragma unroll
                  for (int c = 0; c < 2; ++c)
#pragma unroll
                      for (int s = 0; s < 2; ++s) ar[c][s] = ck_frag(BX + CK_XR, 144, r, 32 * c + 16 * s + 8 * hh);
#pragma unroll
                  for (int c = 0; c < 2; ++c)
#pragma unroll
                      for (int s = 0; s < 2; ++s) YT = CK_MFMA(ar[c][s], SH[c][s], YT); }
                VF[0] = ck_frag(BX + CK_VT, 80, r, 8 * hh); VF[1] = ck_frag(BX + CK_VT, 80, r, 16 + 8 * hh);
                asm volatile("" ::: "memory");
#pragma unroll
                for (int ks = 0; ks < 2; ++ks) { const bf16x8 fbr = ck_frag(BT + CK_TBR, 80, r, 16 * ks + 8 * hh), fkr = ck_frag(BT + CK_TKR, 80, r, 16 * ks + 8 * hh); YT = CK_MFMA(fbr, NUF[ks], YT); YT = CK_MFMA(fkr, VF[ks], YT); }
                { bf16* yo = (bf16*)(F.ws + WS_YCK) + ((size_t)b * SEQ + blk * 32) * 1024 + h * 64 + half * 32 + r;
#pragma unroll
                  for (int reg = 0; reg < 16; ++reg) yo[(size_t)((reg & 3) + 8 * (reg >> 2) + 4 * hh) * 1024] = (bf16)f2bf(YT[reg]); }
                { const LAS f32x4* stash = (const LAS f32x4*)(F.lds + CK_STASH) + F.lane;
#pragma unroll
                  for (int m = 0; m < 4; ++m) { const f32x4 g0 = *(const LAS f32x4*)(BX + CK_GB + (8 * m + 4 * hh) * 4), g1 = *(const LAS f32x4*)(BX + CK_GB + (32 + 8 * m + 4 * hh) * 4);
                    const f32x4 a0 = stash[64 * m] * g0, a1 = stash[64 * (4 + m)] * g1;
#pragma unroll
                    for (int e = 0; e < 4; ++e) { ST0[4 * m + e] = a0[e]; ST1[4 * m + e] = a1[e]; } } }
#pragma unroll
                for (int ks = 0; ks < 2; ++ks) {
                    const bf16x8 b0 = ck_frag(BX + CK_BH, 80, r, 16 * ks + 8 * hh), b1 = ck_frag(BX + CK_BH, 80, 32 + r, 16 * ks + 8 * hh), k0 = ck_frag(BX + CK_KH, 80, r, 16 * ks + 8 * hh), k1 = ck_frag(BX + CK_KH, 80, 32 + r, 16 * ks + 8 * hh);
                    ST0 = CK_MFMA(b0, NUF[ks], ST0); ST1 = CK_MFMA(b1, NUF[ks], ST1); ST0 = CK_MFMA(k0, VF[ks], ST0); ST1 = CK_MFMA(k1, VF[ks], ST1); }
                }
                CK_BAR();
            }
        } else if (w_ >= 1 && w_ <= 4) {
            const int pw = w_ - 1;
            CkConst CC;
            { const int c = l * 1024 + h * 64 + 16 * pw + 4 * (F.lane & 3); const float* mu = kin<I_MU>() + l * N_SHIFT + h * 64 + 16 * pw + 4 * (F.lane & 3);
              CC.a0 = *(const f32x4*)(kin<I_A0>() + c); CC.kk = *(const f32x4*)(kin<I_KK>() + c); CC.ka = *(const f32x4*)(kin<I_KA>() + c); CC.rk = *(const f32x4*)(kin<I_RK>() + c); CC.w0 = *(const f32x4*)(kin<I_W0>() + c);
              CC.v0 = (l == 1) ? *(const f32x4*)(kin<I_V0>() + (c - 1024)) : (f32x4){0.f, 0.f, 0.f, 0.f}; CC.mur = *(const f32x4*)mu; CC.muk = *(const f32x4*)(mu + 1024); CC.muv = *(const f32x4*)(mu + 2048); }
            CkRegs CR;
            ck_issue(F, pw, l, b, h, half, 0, CR);
#pragma unroll 1
            for (int blk = -2; blk < NBLKc; ++blk) {
                if (blk + 2 < NBLKc && !(probe & 4) && !((probe & 16) && w_ == 4)) ck_stage1(F, pw, l, b, h, half, blk + 2, CC, F.lds + CK_X3_OFF + ((blk + 2 + 3) % 3) * CK_X3SZ, F.lds + CK_P2_OFF + ((blk + 2) & 1) * CK_P2SZ, CR, blk + 3 < NBLKc);
                CK_BAR();
            }
        } else {
#pragma unroll 1
            for (int blk = -2; blk < NBLKc; ++blk) {
                if (blk + 1 >= 0 && blk + 1 < NBLKc) {
                    const LAS unsigned char* BX = F.lds + CK_X3_OFF + ((blk + 1 + 3) % 3) * CK_X3SZ; const LAS unsigned char* BP = F.lds + CK_P2_OFF + ((blk + 1) & 1) * CK_P2SZ; LAS unsigned char* BT = F.lds + CK_T2_OFF + ((blk + 1) & 1) * CK_T2SZ;
                    if (w_ == 5) { if (!(probe & 2)) ck_stage2(F, 0, BX, BP, BT); }
                    else if (probe & 8) {}
                    else if (w_ == 6) { ck_stage2(F, 1, BX, BP, BT); ck_stage2(F, 3, BX, BP, BT); }
                    else ck_stage2(F, 2, BX, BP, BT);
                }
                CK_BAR();
            }
        }
    }
}

__device__ __forceinline__ void p5_post(const Frame& F, int l) {
    const int lane = F.lane;
    const float* const pCW = kin<I_CONVW>() + l * 3 * 1024; const float* const pLNW = kin<I_LNW>() + l * 1024; const float* const pLNB = kin<I_LNB>() + l * 1024;
    const bf16* P = (const bf16*)(F.ws + WS_P); const bf16* Y = (const bf16*)(F.ws + WS_Y); const bf16* LRg = (const bf16*)(F.ws + WS_LR) + 2048;
    const bf16* V = (const bf16*)(F.ws + (l == 0 ? WS_V0 : WS_V1)); const float* BONP = (const float*)(F.ws + WS_BONP); bf16* M = (bf16*)(F.ws + WS_H);
#pragma unroll 1
    for (int gw = F.vcu * NWAVES + F.wave; gw < T / 8; gw += F.G * NWAVES) { const int tok0 = gw * 8;
#pragma unroll 1
    for (int ch = 0; ch < 2; ++ch) { const int col0 = 512 * ch + 8 * lane, head = 8 * ch + (lane >> 3);
        float cw0[8], cw1[8], cw2[8], lnw[8], lnb[8], um1[8], um2[8];
#pragma unroll
        for (int j = 0; j < 8; ++j) { cw0[j] = pCW[col0 + j]; cw1[j] = pCW[1024 + col0 + j]; cw2[j] = pCW[2048 + col0 + j];
            lnw[j] = pLNW[col0 + j]; lnb[j] = pLNB[col0 + j]; um1[j] = 0.f; um2[j] = 0.f; }
        const int t0 = tok0 & (SEQ - 1);
        if (t0 >= 1) { float c1[8], c2[8]; load8(P + (size_t)(tok0 - 1) * P_LD + C_CC + col0, c1); load8(P + (size_t)(tok0 - 1) * P_LD + C_CH + col0, c2);
#pragma unroll
            for (int j = 0; j < 8; ++j) um1[j] = c1[j] * c2[j]; }
        if (t0 >= 2) { float c1[8], c2[8]; load8(P + (size_t)(tok0 - 2) * P_LD + C_CC + col0, c1); load8(P + (size_t)(tok0 - 2) * P_LD + C_CH + col0, c2);
#pragma unroll
            for (int j = 0; j < 8; ++j) um2[j] = c1[j] * c2[j]; }
#pragma unroll 2
        for (int tk = 0; tk < 8; ++tk) { const int tok = tok0 + tk; const bf16* pr = P + (size_t)tok * P_LD + col0;
            float c1[8], c2[8], cb[8], ga[8], gb[8], y[8], v[8], g[8], o[8];
            load8(pr + C_CC, c1); load8(pr + C_CH, c2); load8(pr + C_CB, cb); load8(pr + C_GA, ga); load8(pr + C_GB, gb);
            load8(Y + (size_t)tok * 1024 + col0, y); load8h(V + (size_t)tok * 1024 + col0, v); load8(LRg + (size_t)tok * 3072 + col0, g);
            const f32x4 bo4 = *(const f32x4*)(BONP + ((size_t)tok * 16 + head) * 4); const float bo = (bo4[0] + bo4[1]) + (bo4[2] + bo4[3]);
            float sm = 0.f;
#pragma unroll
            for (int j = 0; j < 8; ++j) sm += y[j];
            const float mean = sum8(sm) * (1.0f / 64.0f); float sq = 0.f;
#pragma unroll
            for (int j = 0; j < 8; ++j) { y[j] -= mean; sq += y[j] * y[j]; }
            const float rstd = __builtin_amdgcn_rsqf(sum8(sq) * (1.0f / 64.0f) + LNX_EPS);
#pragma unroll
            for (int j = 0; j < 8; ++j) { const float u = c1[j] * c2[j]; const float conv = cw0[j] * um2[j] + cw1[j] * um1[j] + cw2[j] * u; um2[j] = um1[j]; um1[j] = u;
                const float yconv = cb[j] * conv; const float yr = ((y[j] * rstd) * lnw[j] + lnb[j] + bo * v[j]) * g[j];
                o[j] = sigmoidf_(ga[j]) * yconv + sigmoidf_(gb[j]) * yr; }
            store8(M + (size_t)tok * 1024 + col0, o); }
    }
    }
}

struct GroupPick { float score, a1, a2; int i1, i2; };
__device__ __forceinline__ GroupPick pick_group(const f32x4 acc, float rstd, const float* br, const float* rb) {
    float aff[4], sel[4];
#pragma unroll
    for (int j = 0; j < 4; ++j) { aff[j] = sigmoidf_(rstd * acc[j] + br[j]); sel[j] = aff[j] + rb[j]; }
    int i1 = 0;
#pragma unroll
    for (int j = 1; j < 4; ++j) if (sel[j] > sel[i1]) i1 = j;
    int i2 = (i1 == 0) ? 1 : 0;
#pragma unroll
    for (int j = 0; j < 4; ++j) if (j != i1 && j != i2 && sel[j] > sel[i2]) i2 = j;
    GroupPick g; g.score = sel[i1] + sel[i2]; g.i1 = i1; g.i2 = i2; g.a1 = aff[i1]; g.a2 = aff[i2];
    float s1 = sel[0], s2 = sel[0]; (void)s1; (void)s2;
    return g;
}
__device__ __forceinline__ void p7_route(const Frame& F, int l, bool dry = false) {
    const int lane = F.lane, li = lane & 15, fq = lane >> 4, w = F.wave;
    LAS float* part = (LAS float*)F.lds;
    LAS float* gml = (LAS float*)(F.lds + 32768);
    LAS unsigned* lcnt = (LAS unsigned*)(F.lds + 65536);
    const float* X = (const float*)(F.ws + WS_X); const bf16* WH = (const bf16*)(F.ws + WS_WRT); const bf16* WL = WH + 32768; const float* const pN2G = kin<I_N2G>() + l * 1024; const float* const pRB = kin<I_RB>();
#pragma unroll 1
    for (int grp = F.vcu; grp < T / 64; grp += F.G) { const int b = grp >> 5;
        if (F.tid < 32) lcnt[F.tid] = 0u;
        { const float* ad = ada_ptr(F, l, b) + 4096; const int c = 2 * F.tid; const f32x2 g = *(const f32x2*)(pN2G + c), s = *(const f32x2*)(ad + c); gml[c] = g.x * (1.0f + s.x); gml[c + 1] = g.y * (1.0f + s.y); }
        bfv8 ah0[4], al0[4], ah1[4], al1[4];
        { const bf16* wh0 = WH + li * 1024 + 128 * w + 8 * fq; const bf16* wl0 = WL + li * 1024 + 128 * w + 8 * fq;
#pragma unroll
          for (int s = 0; s < 4; ++s) { ah0[s] = *(const bfv8*)(wh0 + 32 * s); al0[s] = *(const bfv8*)(wl0 + 32 * s); ah1[s] = *(const bfv8*)(wh0 + 16 * 1024 + 32 * s); al1[s] = *(const bfv8*)(wl0 + 16 * 1024 + 32 * s); } }
        __syncthreads();
#pragma unroll 1
        for (int it = 0; it < 4; ++it) { const int tok0 = grp * 64 + it * 16;
            const float* xp = X + (size_t)(tok0 + li) * 1024 + 128 * w + 8 * fq;
            f32x4 xa[4], xb[4];
#pragma unroll
            for (int s = 0; s < 4; ++s) { xa[s] = *(const f32x4*)(xp + 32 * s); xb[s] = *(const f32x4*)(xp + 32 * s + 4); }
            f32x4 acc0 = (f32x4){0.f, 0.f, 0.f, 0.f}, acc1 = acc0; float ssq = 0.f;
#pragma unroll
            for (int s = 0; s < 4; ++s) {
                const f32x4 ga = *(const LAS f32x4*)(gml + 128 * w + 32 * s + 8 * fq), gb = *(const LAS f32x4*)(gml + 128 * w + 32 * s + 8 * fq + 4);
                ssq += ((xa[s][0] * xa[s][0] + xa[s][1] * xa[s][1]) + (xa[s][2] * xa[s][2] + xa[s][3] * xa[s][3])) + ((xb[s][0] * xb[s][0] + xb[s][1] * xb[s][1]) + (xb[s][2] * xb[s][2] + xb[s][3] * xb[s][3]));
                const f32x4 ya = xa[s] * ga, yb = xb[s] * gb;
                u32x4 ph, pl;
                ph[0] = pkbf(ya[0], ya[1]); ph[1] = pkbf(ya[2], ya[3]); ph[2] = pkbf(yb[0], yb[1]); ph[3] = pkbf(yb[2], yb[3]);
                pl[0] = pkbf(ya[0] - bflo(ph[0]), ya[1] - bfhi(ph[0])); pl[1] = pkbf(ya[2] - bflo(ph[1]), ya[3] - bfhi(ph[1])); pl[2] = pkbf(yb[0] - bflo(ph[2]), yb[1] - bfhi(ph[2])); pl[3] = pkbf(yb[2] - bflo(ph[3]), yb[3] - bfhi(ph[3]));
                const bfv8 bh = __builtin_bit_cast(bfv8, ph), bl = __builtin_bit_cast(bfv8, pl);
                acc0 = __builtin_amdgcn_mfma_f32_16x16x32_bf16(ah0[s], bh, acc0, 0, 0, 0); acc0 = __builtin_amdgcn_mfma_f32_16x16x32_bf16(al0[s], bh, acc0, 0, 0, 0); acc0 = __builtin_amdgcn_mfma_f32_16x16x32_bf16(ah0[s], bl, acc0, 0, 0, 0);
                acc1 = __builtin_amdgcn_mfma_f32_16x16x32_bf16(ah1[s], bh, acc1, 0, 0, 0); acc1 = __builtin_amdgcn_mfma_f32_16x16x32_bf16(al1[s], bh, acc1, 0, 0, 0); acc1 = __builtin_amdgcn_mfma_f32_16x16x32_bf16(ah1[s], bl, acc1, 0, 0, 0);
            }
            ssq += __shfl_xor(ssq, 16); ssq += __shfl_xor(ssq, 32);
            { LAS float* pp = part + (w * 16 + li) * 36; *(LAS f32x4*)(pp + 4 * fq) = acc0; *(LAS f32x4*)(pp + 16 + 4 * fq) = acc1; if (fq == 0) pp[32] = ssq; }
            __syncthreads();
            if (w == 0) {
                f32x4 a0 = (f32x4){0.f, 0.f, 0.f, 0.f}, a1 = a0; float sq = 0.f;
#pragma unroll
                for (int ww = 0; ww < 8; ++ww) { const LAS float* q = part + (ww * 16 + li) * 36; a0 += *(const LAS f32x4*)(q + 4 * fq); a1 += *(const LAS f32x4*)(q + 16 + 4 * fq); sq += q[32]; }
                const float rstd = __builtin_amdgcn_rsqf(sq * (1.0f / 1024.0f) + NORM_EPS);
                const float* br = (const float*)(F.ws + WS_CTL + CTL_BIASR) + (l * 8 + b) * 32;
                const GroupPick ga_ = pick_group(a0, rstd, br + 4 * fq, pRB + 4 * fq), gb_ = pick_group(a1, rstd, br + 16 + 4 * fq, pRB + 16 + 4 * fq);
                const bool useb = gb_.score > ga_.score;
                const GroupPick gm = useb ? gb_ : ga_; const int mygrp = useb ? 4 + fq : fq;
                float bs = gm.score; int bg = mygrp;
#pragma unroll
                for (int off = 16; off < 64; off <<= 1) { const float os = __shfl_xor(bs, off); const int og = __shfl_xor(bg, off); if (os > bs || (os == bs && og < bg)) { bs = os; bg = og; } }
                if (mygrp == bg) { const int tok = tok0 + li; const int e0 = 4 * bg + gm.i1, e1 = 4 * bg + gm.i2; const float inv = 1.0f / (gm.a1 + gm.a2);
                    const int p0 = (int)__hip_atomic_fetch_add(lcnt + e0, 1u, __ATOMIC_RELAXED, __HIP_MEMORY_SCOPE_WORKGROUP), p1 = (int)__hip_atomic_fetch_add(lcnt + e1, 1u, __ATOMIC_RELAXED, __HIP_MEMORY_SCOPE_WORKGROUP);
                    int* EI = (int*)(F.ws + WS_EIDX); int* PO = (int*)(F.ws + WS_POS); float* WT = (float*)(F.ws + WS_WTS);
                    if (!dry) { EI[tok * 2] = e0; EI[tok * 2 + 1] = e1; PO[tok * 2] = p0; PO[tok * 2 + 1] = p1; WT[tok * 2] = gm.a1 * inv; WT[tok * 2 + 1] = gm.a2 * inv; } }
            }
            __syncthreads();
        }
        if (F.tid < 32 && !dry) ((int*)(F.ws + WS_HIST))[(l * 256 + grp) * 32 + F.tid] = (int)lcnt[F.tid];
        __syncthreads();
    }
}

__device__ __forceinline__ void expert_table(const Frame& F, int l, int grp = -1) {
    LAS int* tab = (LAS int*)(F.lds + TAB_OFF); LAS int* red = (LAS int*)F.lds;
    const int* hist = (const int*)(F.ws + WS_HIST) + l * 256 * 32; const int e = F.tid & 31, part = F.tid >> 5;
    int tot = 0, pre = 0;
#pragma unroll 4
    for (int g = part * 16; g < part * 16 + 16; ++g) { const int v = hist[g * 32 + e]; tot += v; pre += (g < grp) ? v : 0; }
    red[part * 32 + e] = tot; red[512 + part * 32 + e] = pre;
    __syncthreads();
    if (F.tid < 64) { int c = 0, pr = 0;
#pragma unroll
        for (int p = 0; p < 16; ++p) { c += red[p * 32 + e]; pr += red[512 + p * 32 + e]; }
        const int padded = (c + 255) & ~255; int inc = padded;
#pragma unroll
        for (int o = 1; o < 32; o <<= 1) { const int v = __shfl_up(inc, o); if (e >= o) inc += v; }
        if (F.lane < 32) { tab[e] = inc - padded; tab[33 + e] = (inc - padded) >> 8; tab[66 + e] = inc - padded + pr; if (e == 31) { tab[32] = inc; tab[65] = inc >> 8; } } }
    __syncthreads();
}

__device__ __forceinline__ void p8_dispatch(const Frame& F, int l) {
    const LAS int* tab = (const LAS int*)(F.lds + TAB_OFF);
    const float* const pN2G = kin<I_N2G>() + l * 1024;
    const int lane = F.lane;
#pragma unroll 1
    for (int gw = F.vcu * NWAVES + F.wave; gw < T / 8; gw += F.G * NWAVES) { const int tok0 = gw * 8, b = tok0 >> 11;
        expert_table(F, l, gw >> 3);
        const float* ad = ada_ptr(F, l, b); f32x4 gm[4], sh[4];
#pragma unroll
        for (int j = 0; j < 4; ++j) { const int c = 4 * lane + 256 * j; gm[j] = *(const f32x4*)(pN2G + c) * (1.0f + *(const f32x4*)(ad + 4096 + c)); sh[j] = *(const f32x4*)(ad + 3072 + c); }
        const float* X = (const float*)(F.ws + WS_X); const int* EI = (const int*)(F.ws + WS_EIDX); const int* PO = (const int*)(F.ws + WS_POS); int* SL = (int*)(F.ws + WS_SLOT); bf16* BUF = (bf16*)(F.ws + WS_BUF);
#pragma unroll 1
        for (int tb = 0; tb < 8; tb += 4) {
            f32x4 v[4][4]; int e0[4], e1[4], q0[4], q1[4]; float ss[4];
#pragma unroll
            for (int t = 0; t < 4; ++t) { const int tok = tok0 + tb + t;
#pragma unroll
                for (int j = 0; j < 4; ++j) v[t][j] = *(const f32x4*)(X + (size_t)tok * 1024 + 4 * lane + 256 * j);
                e0[t] = EI[tok * 2]; e1[t] = EI[tok * 2 + 1]; q0[t] = PO[tok * 2]; q1[t] = PO[tok * 2 + 1]; }
#pragma unroll
            for (int t = 0; t < 4; ++t) { ss[t] = 0.f;
#pragma unroll
                for (int j = 0; j < 4; ++j) ss[t] += (v[t][j][0] * v[t][j][0] + v[t][j][1] * v[t][j][1]) + (v[t][j][2] * v[t][j][2] + v[t][j][3] * v[t][j][3]); }
#pragma unroll
            for (int o = 1; o < 64; o <<= 1) {
#pragma unroll
                for (int t = 0; t < 4; ++t) ss[t] += __shfl_xor(ss[t], o); }
#pragma unroll
            for (int t = 0; t < 4; ++t) { const int tok = tok0 + tb + t;
                const float rstd = __builtin_amdgcn_rsqf(ss[t] * (1.0f / 1024.0f) + NORM_EPS);
                const int s0 = tab[66 + e0[t]] + q0[t], s1 = tab[66 + e1[t]] + q1[t];
                if (lane == 0) { SL[tok * 2] = s0; SL[tok * 2 + 1] = s1; }
#pragma unroll
                for (int j = 0; j < 4; ++j) { const f32x4 h = v[t][j] * rstd * gm[j] + sh[j]; u32x2 w; w.x = pk2(h[0], h[1]); w.y = pk2(h[2], h[3]);
                    *(u32x2*)(BUF + (size_t)s0 * 1024 + 4 * lane + 256 * j) = w; *(u32x2*)(BUF + (size_t)s1 * 1024 + 4 * lane + 256 * j) = w; } }
        }
    }
}

#ifndef PHMASK
#define PHMASK 0xFFFF
#endif
#define PHM(n) (((PHMASK) >> (n)) & 1)
constexpr int NPHASES = 23;
__global__ void __launch_bounds__(NWAVES * 64, 2) trunk_fwd(Args args) {
    extern __shared__ __attribute__((aligned(16))) unsigned char lds_raw[];
    Frame F;
    F.lds = (LAS unsigned char*)lds_raw;
    F.tid = threadIdx.x; F.lane = F.tid & 63; F.wave = __builtin_amdgcn_readfirstlane(F.tid >> 6);
    F.G = gridDim.x; { const int bx = blockIdx.x; F.vcu = (F.G % 8 == 0) ? (bx % 8) * (F.G / 8) + bx / 8 : bx; }
    GAS unsigned char* const wsbase = (GAS unsigned char*)kin<29>(); F.ws = wsbase; const int vcu0 = F.vcu;
    volatile LAS unsigned* MISC = (volatile LAS unsigned*)(F.lds + MISC_OFF);
    if (F.tid < 32) MISC[F.tid] = 0u;
    __syncthreads();
    const unsigned long long lohi = (unsigned long long)kin<30>(); const int lo = (int)(unsigned)lohi, hi = (int)(unsigned)(lohi >> 32);
    XcdBarrier bar; bar.bar = (unsigned*)(F.ws + WS_CTL) + CW_BAR; bar.x = 0; bar.st = nullptr;
    if (hi - lo > 1) bar = xcd_barrier_post((unsigned*)(F.ws + WS_CTL) + CW_BAR, MISC + 8);
#pragma unroll 1
#if defined(REP_PH)
    for (int phx = lo; phx < hi + REP_N; ++phx) { const int ph = (phx < REP_PH) ? phx : ((phx < REP_PH + REP_N) ? REP_PH : phx - REP_N);
        const bool probe_run = (phx >= REP_PH && phx < REP_PH + REP_N); (void)probe_run;
#else
    for (int ph = lo; ph < hi; ++ph) {
#endif
        { int t_ = threadIdx.x; asm volatile("" : "+v"(t_)); F.tid = t_; F.lane = t_ & 63; F.wave = __builtin_amdgcn_readfirstlane(t_ >> 6);
          GAS unsigned char* w_ = wsbase; asm volatile("" : "+s"(w_)); F.ws = w_; int v_ = vcu0; asm volatile("" : "+s"(v_)); F.vcu = v_; }
        const int l = (ph - 2) / 10, k = (ph >= 2 && ph <= 21) ? (ph - 2) % 10 : -1;
        if (PHM(0) && ph == 0) p0_prologue(F);
        else if (PHM(0) && ph == 1) p0b_ada_reduce(F);
        else if (PHM(1) && ph == 22) p1_norm<2>(F, 1);
        else if (PHM(1) && k == 0) { if (l == 0) p1_norm<0>(F, 0); else p1_norm<1>(F, 1); }
        else if (PHM(3) && k == 2) p2x_lowrank(F, l);
#if defined(REP_PH) && defined(REP_DRY)
        else if (PHM(4) && k == 3) p4_scan(F, l, probe_run ? REP_DRY : 0);
#else
        else if (PHM(4) && k == 3) p4_scan(F, l);
#endif
        else if (PHM(5) && k == 4) p5_post(F, l);
        #if defined(REP_PH)
        else if (PHM(7) && k == 6) p7_route(F, l, probe_run);
#else
        else if (PHM(7) && k == 6) p7_route(F, l);
#endif
        else if (PHM(8) && k == 7) p8_dispatch(F, l);
        else if (PHM(2) && (k == 1 || k == 5 || k == 8 || k == 9)) {
            pg8::Gemm g; pg8::UniOrder S; pg8::EpiUni E;
            S.expert = (k >= 8); S.so.init(T, 1024, F.G, (int)blockIdx.x); S.eo = pg8::ExpertOrder{(const PG8_LAS int*)(F.lds + TAB_OFF + 33 * 4), 0, F.G, (int)blockIdx.x};
            E.e0 = pg8::EpiBf16Plain{(bf16*)(F.ws + WS_P), P_LD, -1}; E.e1 = pg8::EpiResid{nullptr, (float*)(F.ws + WS_X), ada_ptr(F, l, 0) + 2048, 6144}; E.e2 = pg8::EpiSwiGLU{(bf16*)(F.ws + WS_HB)};
            if (k == 1) {
                const int N = (l == 0) ? N_IN : N_IN1; S.so.init(T, N, F.G, (int)blockIdx.x); E.mode = 0;
                g = pg8::Gemm{(const bf16*)(F.ws + WS_H), (const bf16*)(F.ws + WS_BT_IN) + (size_t)l * P_LD * 1024, T, N, 1024};
            } else if (k == 5) {
                E.mode = 1; E.e1.xin = (l == 0) ? kin<I_X>() : (const float*)(F.ws + WS_X);
                g = pg8::Gemm{(const bf16*)(F.ws + WS_H), (const bf16*)(F.ws + WS_BT_OUT) + (size_t)l * 1024 * 1024, T, 1024, 1024};
            } else {
                expert_table(F, l);
                S.eo.ntiles = ((const LAS int*)(F.lds + TAB_OFF))[65];
                if (k == 8) { E.mode = 2; g = pg8::Gemm{(const bf16*)(F.ws + WS_BUF), (const bf16*)(F.ws + WS_BT_E1) + (size_t)l * 32 * 1024 * 1024, MAXROWS, 32 * 1024, 1024}; }
                else { E.mode = 0; E.e0 = pg8::EpiBf16Plain{(bf16*)(F.ws + WS_YE), 1024, 3}; g = pg8::Gemm{(const bf16*)(F.ws + WS_HB), (const bf16*)(F.ws + WS_BT_E2) + (size_t)l * 32 * 1024 * 512, MAXROWS, 32 * 1024, 512}; }
            }
#if defined(REP_PH) && defined(REP_DRY)
            if (probe_run) E.mode = 3;
#endif
            pg8::gemm_phase<pg8::EpiUni, pg8::UniOrder, true, true>(F.lds, g, S, E);
        }
#if defined(REP_PH)
        if (phx + 1 < hi + REP_N) xcd_barrier(bar);
#else
        if (ph + 1 < hi) xcd_barrier(bar);
#endif
    }
}

extern "C" void kernel_launch(void* const* d_in, const int* in_sizes, int n_in, void* d_out, int out_size, void* d_ws, size_t ws_size, hipStream_t stream) {
    static int grid = 0;
    if (grid == 0) {
        if (n_in != 28 || in_sizes[0] != T * D || out_size != T * D || ws_size < WS_END) { fprintf(stderr, "kernel_launch: unexpected shapes (n_in %d, in0 %d, out %d, ws %zu < %zu?); nothing launched\n", n_in, n_in > 0 ? in_sizes[0] : -1, out_size, ws_size, (size_t)WS_END); grid = -1; return; }
        int dev = 0, cus = 0, per_cu = 0;
        if (hipGetDevice(&dev) != hipSuccess || hipDeviceGetAttribute(&cus, hipDeviceAttributeMultiprocessorCount, dev) != hipSuccess) { fprintf(stderr, "kernel_launch: device query failed\n"); grid = -1; return; }
        if (hipFuncSetAttribute((const void*)trunk_fwd, hipFuncAttributeMaxDynamicSharedMemorySize, LDS_BYTES) != hipSuccess) { fprintf(stderr, "kernel_launch: hipFuncSetAttribute failed\n"); grid = -1; return; }
        if (hipOccupancyMaxActiveBlocksPerMultiprocessor(&per_cu, (const void*)trunk_fwd, NWAVES * 64, LDS_BYTES) != hipSuccess || per_cu < 1) { fprintf(stderr, "kernel_launch: occupancy query says %d blocks per CU\n", per_cu); }
        (void)hipGetLastError();
        grid = cus;
    }
    if (grid < 0) return;
    if (hipMemsetAsync((char*)d_ws + WS_CTL, 0, CTL_ZERO_BYTES, stream) != hipSuccess) { fprintf(stderr, "kernel_launch: memset failed\n"); return; }
    Args a{};
    for (int i = 0; i < 28; ++i) a.p[i] = d_in[i];
    a.p[28] = d_out; a.p[29] = d_ws;
#if MK_ONE_LAUNCH
    a.ph_lo = 0; a.ph_hi = NPHASES;
    void* kargs[] = {&a};
    hipError_t e = hipLaunchCooperativeKernel((const void*)trunk_fwd, dim3(grid), dim3(NWAVES * 64), kargs, LDS_BYTES, stream);
    if (e != hipSuccess) fprintf(stderr, "kernel_launch: cooperative launch failed: %s (grid %d)\n", hipGetErrorString(e), grid);
#else
    for (int p = 0; p < NPHASES; ++p) { a.ph_lo = p; a.ph_hi = p + 1;
        hipLaunchKernelGGL(trunk_fwd, dim3(grid), dim3(NWAVES * 64), LDS_BYTES, stream, a);
        const hipError_t le = hipPeekAtLastError(); if (le != hipSuccess) { fprintf(stderr, "kernel_launch: launch %d failed: %s\n", p, hipGetErrorName(le)); break; } }
#endif
}
```

```cpp
#include <hip/hip_runtime.h>
#include <cstdio>
#include <cstdint>

#ifndef MK_ONE_LAUNCH
#define MK_ONE_LAUNCH 1
#endif

namespace pg8 {
#define PG8_LAS __attribute__((address_space(3)))
typedef unsigned short bf16_t;
typedef short bf16x8 __attribute__((ext_vector_type(8)));
typedef float f32x4 __attribute__((ext_vector_type(4)));
typedef unsigned u32x4 __attribute__((ext_vector_type(4)));
constexpr int BM = 256, BK = 64, HALF = 128, HTB = HALF * BK * 2  , STAGE_BYTES = 8 * HTB, NXCD = 8, WGM = 8;

__host__ __device__ __forceinline__ int lds_byte(int r, int c) { const int st = (r >> 4) * 2 + (c >> 5), rr = r & 15, cc = c & 31, ob = rr * 64 + cc * 2; return st * 1024 + (ob ^ (((ob >> 9) & 1) << 5)); }
__host__ __device__ __forceinline__ void stage_rc(int b, int& R, int& C) { const int st = b / 1024, sb = b % 1024, swz = sb ^ (((sb >> 9) & 1) << 5); R = (st >> 1) * 16 + swz / 64; C = (st & 1) * 32 + (swz % 64) / 2; }
__host__ __device__ __forceinline__ int perm32(int rho) { const int n = rho >> 4, i = rho & 15; return 8 * (i >> 2) + 4 * n + (i & 3); }

struct Unit { int pm, pn; };
struct Gemm { const bf16_t* A; const bf16_t* Bt; int M, N, K; };

struct StaticOrder {
    int nM, nN, nwg, G, c;
    __host__ __device__ void init(int M, int N, int G_, int c_) { nM = M / BM; nN = N / BM; nwg = nM * nN; G = G_; c = c_; }
    __host__ __device__ bool next(int i, Unit& u) const {
        const long L = (long)i * G + c; if (L >= nwg) return false;
        int wgid = (int)L; { const int q = nwg / NXCD, r = nwg % NXCD, xcd = wgid % NXCD, off = wgid / NXCD; wgid = (xcd < r ? xcd * (q + 1) : r * (q + 1) + (xcd - r) * q) + off; }
        const int nig = WGM * nN, gid = wgid / nig, fm = gid * WGM, gsz = (nM - fm) < WGM ? (nM - fm) : WGM;
        u.pm = fm + ((wgid % nig) % gsz); u.pn = (wgid % nig) / gsz; return true;
    }
    __device__ __forceinline__ void a_ready(const Unit&) const {}
    __device__ __forceinline__ void done(const Unit&) const {}
};
__device__ __forceinline__ unsigned cvt_pk_bf16(float lo, float hi) { unsigned r; asm volatile("v_cvt_pk_bf16_f32 %0, %1, %2" : "=v"(r) : "v"(lo), "v"(hi)); return r; }
typedef float f32x2 __attribute__((ext_vector_type(2)));
typedef unsigned u32x2 __attribute__((ext_vector_type(2)));

struct EpiBf16Plain {
    static constexpr bool PERM = true, AFTER_DRAIN = false;
    bf16_t* O; int ldc; int cmask;
    __device__ __forceinline__ void operator()(const f32x4 (&acc)[2][2][4][2], const Unit& u, int wr, int wc, int fr, int fq) const {
        const int row0 = u.pm * BM + wr * 64 + fr; const int col0 = (u.pn & cmask) * BM + wc * 32 + 8 * fq;
#pragma unroll
        for (int ai = 0; ai < 2; ++ai)
#pragma unroll
            for (int m = 0; m < 4; ++m) { bf16_t* rowp = O + (size_t)(row0 + ai * HALF + m * 16) * ldc + col0;
#pragma unroll
                for (int bj = 0; bj < 2; ++bj) { const f32x4 v0 = acc[ai][bj][m][0], v1 = acc[ai][bj][m][1];
                    u32x4 w; w.x = cvt_pk_bf16(v0[0], v0[1]); w.y = cvt_pk_bf16(v0[2], v0[3]); w.z = cvt_pk_bf16(v1[0], v1[1]); w.w = cvt_pk_bf16(v1[2], v1[3]);
                    *(u32x4*)(rowp + bj * HALF) = w; } }
    }
};
struct EpiResid {
    static constexpr bool PERM = false, AFTER_DRAIN = false;
    const float* xin; float* xout; const float* gate;
    int gstride;
    __device__ __forceinline__ void operator()(const f32x4 (&acc)[2][2][4][2], const Unit& u, int wr, int wc, int fr, int fq) const {
        const int row0 = u.pm * BM + wr * 64 + fr, col0 = u.pn * BM + wc * 32 + 4 * fq;
        const float* gp = gate + (size_t)(u.pm >> 3) * gstride;
        f32x4 gv[2][2];
#pragma unroll
        for (int bj = 0; bj < 2; ++bj)
#pragma unroll
            for (int n = 0; n < 2; ++n) gv[bj][n] = *(const f32x4*)(gp + col0 + bj * HALF + n * 16);
#pragma unroll
        for (int ai = 0; ai < 2; ++ai) {
            f32x4 xi[4][2][2];
#pragma unroll
            for (int m = 0; m < 4; ++m) { const size_t ro = (size_t)(row0 + ai * HALF + m * 16) * 1024 + col0;
#pragma unroll
                for (int bj = 0; bj < 2; ++bj)
#pragma unroll
                    for (int n = 0; n < 2; ++n) xi[m][bj][n] = *(const f32x4*)(xin + ro + bj * HALF + n * 16); }
            asm volatile("" ::: "memory");
#pragma unroll
            for (int m = 0; m < 4; ++m) { const size_t ro = (size_t)(row0 + ai * HALF + m * 16) * 1024 + col0;
#pragma unroll
                for (int bj = 0; bj < 2; ++bj)
#pragma unroll
                    for (int n = 0; n < 2; ++n) *(f32x4*)(xout + ro + bj * HALF + n * 16) = xi[m][bj][n] + gv[bj][n] * acc[ai][bj][m][n]; }
            asm volatile("" ::: "memory"); }
    }
};
struct EpiSwiGLU {
    static constexpr bool PERM = false, AFTER_DRAIN = false;
    bf16_t* O;
    __device__ __forceinline__ void operator()(const f32x4 (&acc)[2][2][4][2], const Unit& u, int wr, int wc, int fr, int fq) const {
        const int row0 = u.pm * BM + wr * 64 + fr, col0 = (u.pn & 3) * HALF + wc * 32 + 4 * fq;
#pragma unroll
        for (int ai = 0; ai < 2; ++ai)
#pragma unroll
            for (int m = 0; m < 4; ++m) { bf16_t* rowp = O + (size_t)(row0 + ai * HALF + m * 16) * 512 + col0;
#pragma unroll
                for (int n = 0; n < 2; ++n) { const f32x4 g = acc[ai][0][m][n], up = acc[ai][1][m][n]; f32x4 h;
#pragma unroll
                    for (int j = 0; j < 4; ++j) h[j] = g[j] * __builtin_amdgcn_rcpf(1.0f + __expf(-g[j])) * up[j];
                    u32x2 w; w.x = cvt_pk_bf16(h[0], h[1]); w.y = cvt_pk_bf16(h[2], h[3]);
                    *(u32x2*)(rowp + n * 16) = w; } }
    }
};
struct ExpertOrder {
    const PG8_LAS int* ts; int ntiles, G, c;
    __device__ __forceinline__ bool next(int i, Unit& u) const {
        const int L = i * G + c; if (L >= ntiles * 4) return false;
        const int pm = L >> 2; int e = 0;
#pragma unroll 1
        for (int k = 1; k < 32; ++k) e += (ts[k] <= pm) ? 1 : 0;
        u.pm = pm; u.pn = e * 4 + (L & 3); return true;
    }
    __device__ __forceinline__ void a_ready(const Unit&) const {}
    __device__ __forceinline__ void done(const Unit&) const {}
};

struct UniOrder {
    StaticOrder so; ExpertOrder eo; bool expert;
    __device__ __forceinline__ bool next(int i, Unit& u) const { return expert ? eo.next(i, u) : so.next(i, u); }
    __device__ __forceinline__ void a_ready(const Unit&) const {}
    __device__ __forceinline__ void done(const Unit&) const {}
};
struct EpiUni {
    static constexpr bool AFTER_DRAIN = false;
    int mode; EpiBf16Plain e0; EpiResid e1; EpiSwiGLU e2;
    __device__ __forceinline__ bool perm() const { return mode == 0; }
    __device__ __forceinline__ void operator()(const f32x4 (&acc)[2][2][4][2], const Unit& u, int wr, int wc, int fr, int fq) const {
        if (mode == 0) e0(acc, u, wr, wc, fr, fq); else if (mode == 1) e1(acc, u, wr, wc, fr, fq); else if (mode == 2) e2(acc, u, wr, wc, fr, fq);
    }
};
template <class Epi, class Sched, bool ALIGN_EPI = false, bool SP2 = false>
__device__ __forceinline__ void gemm_phase(PG8_LAS unsigned char* lds, const Gemm g, const Sched& S, const Epi& E) {
    int tid_ = threadIdx.x; asm volatile("" : "+v"(tid_));
    const int tid = tid_, wid = __builtin_amdgcn_readfirstlane(tid >> 6), lane = tid & 63, wr = wid >> 2, wc = wid & 3, fr = lane & 15, fq = lane >> 4;
    const int K = g.K, nt = K / BK;
    unsigned voffA[2], voffB[2];
#pragma unroll
    for (int i = 0; i < 2; ++i) { int R, C; stage_rc(tid * 16 + i * 8192, R, C); const int Rb = E.perm() ? ((R & ~31) + perm32(R & 31)) : R;
        voffA[i] = (unsigned)(R * K + C) * 2u; voffB[i] = (unsigned)(Rb * K + C) * 2u; }
    const size_t kstep = (size_t)(BK * 2);
    const size_t hstep = (size_t)HALF * K * 2;
    const size_t tstep = 2 * hstep;
    const unsigned ldsw = (unsigned)wid * 1024u;
    const int aoff = lds_byte(wr * 64 + fr, fq * 8), boff = lds_byte(wc * 32 + fr, fq * 8);
#define PG8_SA(b, h) (((b) * 2 + (h)) * HTB)
#define PG8_SB(b, h) ((4 + (b) * 2 + (h)) * HTB)
#define PG8_STAGE(bufoff, gbase, voff) do { _Pragma("unroll") for (int _i = 0; _i < 2; ++_i) \
        __builtin_amdgcn_global_load_lds((const unsigned*)((const char*)(gbase) + (voff)[_i]), (PG8_LAS unsigned*)(lds + (bufoff) + ldsw + _i * 8192), 16, 0, 0); } while (0)
#define PG8_LDA(dst, b, h) do { _Pragma("unroll") for (int m = 0; m < 4; ++m) _Pragma("unroll") for (int k = 0; k < 2; ++k) dst[m][k] = *(const PG8_LAS bf16x8*)(lds + PG8_SA(b, h) + aoff + m * 2048 + k * 1024); } while (0)
#define PG8_LDB(dst, b, h) do { _Pragma("unroll") for (int n = 0; n < 2; ++n) _Pragma("unroll") for (int k = 0; k < 2; ++k) dst[n][k] = *(const PG8_LAS bf16x8*)(lds + PG8_SB(b, h) + boff + n * 2048 + k * 1024); } while (0)
#define PG8_MMA(ai, bj, At, Bt) do { __builtin_amdgcn_s_setprio(1); _Pragma("unroll") for (int m = 0; m < 4; ++m) _Pragma("unroll") for (int n = 0; n < 2; ++n) _Pragma("unroll") for (int k = 0; k < 2; ++k) \
        acc[ai][bj][m][n] = __builtin_amdgcn_mfma_f32_16x16x32_bf16(Bt[n][k], At[m][k], acc[ai][bj][m][n], 0, 0, 0); __builtin_amdgcn_s_setprio(0); } while (0)
#define PG8_WAIT_V(n) asm volatile("s_waitcnt vmcnt(" #n ")" ::: "memory")
#define PG8_WAIT_L(n) asm volatile("s_waitcnt lgkmcnt(" #n ")" ::: "memory")
#define PG8_BAR __builtin_amdgcn_s_barrier()
#define PG8_SCHED __builtin_amdgcn_sched_barrier(0)
    Unit cur, nxt; int ui = 0;
    if (!S.next(0, cur)) return;
    f32x4 acc[2][2][4][2];
#pragma unroll
    for (int a = 0; a < 2; ++a)
#pragma unroll
        for (int b = 0; b < 2; ++b)
#pragma unroll
            for (int m = 0; m < 4; ++m)
#pragma unroll
                for (int n = 0; n < 2; ++n) acc[a][b][m][n] = (f32x4){0.f, 0.f, 0.f, 0.f};
    bf16x8 At[4][2], B0[2][2], B1[2][2];
    const char* cA = (const char*)g.A + (size_t)cur.pm * tstep; const char* cB = (const char*)g.Bt + (size_t)cur.pn * tstep;
    S.a_ready(cur);
    if constexpr (SP2) {
        PG8_STAGE(PG8_SB(0, 0), cB, voffB); PG8_STAGE(PG8_SB(0, 1), cB + hstep, voffB); PG8_STAGE(PG8_SA(0, 0), cA, voffA); PG8_STAGE(PG8_SA(0, 1), cA + hstep, voffA);
        if (wr == 1) PG8_BAR;
        PG8_WAIT_V(2); PG8_BAR;
        PG8_STAGE(PG8_SB(1, 0), cB + kstep, voffB); PG8_STAGE(PG8_SA(1, 0), cA + kstep, voffA); PG8_STAGE(PG8_SB(1, 1), cB + hstep + kstep, voffB);
        PG8_WAIT_V(6); PG8_BAR;
    } else {
        PG8_STAGE(PG8_SB(0, 0), cB, voffB); PG8_STAGE(PG8_SA(0, 0), cA, voffA); PG8_STAGE(PG8_SB(0, 1), cB + hstep, voffB); PG8_STAGE(PG8_SA(0, 1), cA + hstep, voffA);
        if (wr == 1) PG8_BAR;
        PG8_WAIT_V(4); PG8_BAR;
        PG8_STAGE(PG8_SB(1, 0), cB + kstep, voffB); PG8_STAGE(PG8_SA(1, 0), cA + kstep, voffA); PG8_STAGE(PG8_SB(1, 1), cB + hstep + kstep, voffB);
        PG8_WAIT_V(6); PG8_BAR;
    }
    for (;;) {
        const bool has_next = S.next(ui + 1, nxt);
        const char* nA = has_next ? (const char*)g.A + (size_t)nxt.pm * tstep : cA; const char* nB = has_next ? (const char*)g.Bt + (size_t)nxt.pn * tstep : cB;
        for (int t = 0; t < nt; t += 2) {
            const bool last = (t == nt - 2);
            const char* a1 = cA + (size_t)(t + 1) * kstep;
            const char* a2 = last ? nA : cA + (size_t)(t + 2) * kstep; const char* b2 = last ? nB : cB + (size_t)(t + 2) * kstep;
            const char* a3 = a2 + kstep; const char* b3 = b2 + kstep;
            if (last && has_next) S.a_ready(nxt);
            if constexpr (SP2) {
            PG8_LDB(B0, 0, 0); PG8_LDB(B1, 0, 1); PG8_SCHED; PG8_LDA(At, 0, 0); PG8_STAGE(PG8_SA(1, 1), a1 + hstep, voffA);
            PG8_WAIT_V(8); PG8_WAIT_L(0); PG8_BAR; PG8_MMA(0, 0, At, B0); PG8_MMA(0, 1, At, B1); PG8_BAR; PG8_SCHED;
            PG8_LDA(At, 0, 1); PG8_STAGE(PG8_SB(0, 0), b2, voffB); PG8_STAGE(PG8_SB(0, 1), b2 + hstep, voffB); PG8_STAGE(PG8_SA(0, 0), a2, voffA);
            PG8_WAIT_V(8); PG8_WAIT_L(0); PG8_BAR; PG8_MMA(1, 0, At, B0); PG8_MMA(1, 1, At, B1); PG8_BAR; PG8_SCHED;
            PG8_LDB(B0, 1, 0); PG8_LDB(B1, 1, 1); PG8_SCHED; PG8_LDA(At, 1, 0); PG8_STAGE(PG8_SA(0, 1), a2 + hstep, voffA);
            PG8_WAIT_V(8); PG8_WAIT_L(0); PG8_BAR; PG8_MMA(0, 0, At, B0); PG8_MMA(0, 1, At, B1); PG8_BAR; PG8_SCHED;
            PG8_LDA(At, 1, 1); PG8_STAGE(PG8_SB(1, 0), b3, voffB); PG8_STAGE(PG8_SB(1, 1), b3 + hstep, voffB); PG8_STAGE(PG8_SA(1, 0), a3, voffA);
            PG8_WAIT_V(8); PG8_WAIT_L(0); PG8_BAR; PG8_MMA(1, 0, At, B0); PG8_MMA(1, 1, At, B1); PG8_BAR; PG8_SCHED;
            } else {
            PG8_LDB(B0, 0, 0); PG8_SCHED; PG8_LDA(At, 0, 0); PG8_STAGE(PG8_SA(1, 1), a1 + hstep, voffA);
            PG8_WAIT_L(8); PG8_BAR; PG8_WAIT_L(0); PG8_MMA(0, 0, At, B0); PG8_BAR; PG8_SCHED;
            PG8_LDB(B1, 0, 1); PG8_STAGE(PG8_SB(0, 0), b2, voffB);
            PG8_BAR; PG8_WAIT_L(0); PG8_MMA(0, 1, At, B1); PG8_BAR;
            PG8_LDA(At, 0, 1); PG8_STAGE(PG8_SA(0, 0), a2, voffA);
            PG8_BAR; PG8_WAIT_L(0); PG8_MMA(1, 0, At, B0); PG8_BAR; PG8_SCHED;
            PG8_STAGE(PG8_SB(0, 1), b2 + hstep, voffB);
            PG8_WAIT_V(6); PG8_BAR; PG8_MMA(1, 1, At, B1); PG8_BAR;
            PG8_LDB(B0, 1, 0); PG8_SCHED; PG8_LDA(At, 1, 0); PG8_STAGE(PG8_SA(0, 1), a2 + hstep, voffA);
            PG8_WAIT_L(8); PG8_BAR; PG8_WAIT_L(0); PG8_MMA(0, 0, At, B0); PG8_BAR; PG8_SCHED;
            PG8_LDB(B1, 1, 1); PG8_STAGE(PG8_SB(1, 0), b3, voffB);
            PG8_BAR; PG8_WAIT_L(0); PG8_MMA(0, 1, At, B1); PG8_BAR;
            PG8_LDA(At, 1, 1); PG8_STAGE(PG8_SA(1, 0), a3, voffA);
            PG8_BAR; PG8_WAIT_L(0); PG8_MMA(1, 0, At, B0); PG8_BAR; PG8_SCHED;
            PG8_STAGE(PG8_SB(1, 1), b3 + hstep, voffB);
            PG8_WAIT_V(6); PG8_BAR; PG8_MMA(1, 1, At, B1); PG8_BAR;
            }
        }
        if constexpr (ALIGN_EPI) { if (wr == 0) PG8_BAR; }
        if constexpr (!Epi::AFTER_DRAIN) { E(acc, cur, wr, wc, fr, fq); S.done(cur); }
        if (!has_next) break;
#pragma unroll
        for (int a = 0; a < 2; ++a)
#pragma unroll
            for (int b = 0; b < 2; ++b)
#pragma unroll
                for (int m = 0; m < 4; ++m)
#pragma unroll
                    for (int n = 0; n < 2; ++n) acc[a][b][m][n] = (f32x4){0.f, 0.f, 0.f, 0.f};
        cur = nxt; cA = nA; cB = nB; ++ui;
        if constexpr (ALIGN_EPI) { if (wr == 1) PG8_BAR; }
    }
    PG8_WAIT_V(0);
    if constexpr (!ALIGN_EPI) { if (wr == 0) PG8_BAR; }
    PG8_BAR;
    if constexpr (Epi::AFTER_DRAIN) { E.fused(acc, cur, wr, wc, fr, fq, lds, wid, lane); S.done(cur); }
#undef PG8_SA
#undef PG8_SB
#undef PG8_STAGE
#undef PG8_LDA
#undef PG8_LDB
#undef PG8_MMA
#undef PG8_WAIT_V
#undef PG8_WAIT_L
#undef PG8_BAR
#undef PG8_SCHED
}
}

constexpr int NWAVES = 8;
constexpr int T = 16384, D = 1024, SEQ = 2048, NBATCH = 8, NHEAD = 16;
constexpr int N_IN = 8448, N_IN1 = 8704, P_LD = 9472;
constexpr int C_CB = 0, C_CC = 1024, C_CH = 2048, C_GA = 3072, C_GB = 4096, C_R = 5120, C_K = 6144, C_V = 7168, C_WD = 8192, C_AD = 8256, C_GD = 8320, C_VD = 8448;
constexpr int N_SHIFT = 3328, N_EXP = 32, D_EXP = 512;
constexpr int MAXROWS = 40960;
constexpr float NORM_EPS = 1e-6f, LNX_EPS = 64e-5f;

constexpr size_t MiB = 1u << 20;
constexpr size_t WS_CTL = 0, CTL_ZERO_BYTES = 1 * MiB;
constexpr size_t WS_BT_IN = 2 * MiB;
constexpr size_t WS_BT_OUT = 39 * MiB;
constexpr size_t WS_BT_E1 = 43 * MiB;
constexpr size_t WS_BT_E2 = 171 * MiB;
constexpr size_t WS_H = 235 * MiB;
constexpr size_t WS_ALR = WS_H;
constexpr size_t WS_P = 267 * MiB;
constexpr size_t WS_BUF = WS_P, WS_HB = WS_P + 80 * MiB, WS_YE = WS_P + 120 * MiB;
constexpr size_t WS_ADAP = WS_P;
constexpr size_t WS_W = 563 * MiB;
constexpr size_t WS_KK = 627 * MiB, WS_BQ = 659 * MiB, WS_KP = 691 * MiB, WS_R = 723 * MiB, WS_V0 = 755 * MiB, WS_V1 = 787 * MiB;
constexpr size_t WS_LR = 819 * MiB;
constexpr size_t WS_Y = 915 * MiB;
constexpr size_t WS_X = 947 * MiB;
constexpr size_t WS_BONUS = 1011 * MiB;
constexpr size_t WS_EIDX = 1012 * MiB, WS_POS = WS_EIDX + 128 * 1024, WS_WTS = WS_EIDX + 256 * 1024, WS_SLOT = WS_EIDX + 384 * 1024;
constexpr size_t WS_HIST = WS_EIDX + 512 * 1024;
constexpr size_t WS_WRT = WS_EIDX + 768 * 1024;
constexpr size_t WS_VG = WS_BQ;
constexpr size_t WS_VU = WS_KP;
constexpr size_t WS_KN = WS_KK;
constexpr size_t WS_BONP = WS_KK + 2 * MiB;
constexpr size_t WS_BT_LR = 1015 * MiB;
constexpr size_t WS_END = 1018 * MiB;
static_assert(WS_YE + (size_t)MAXROWS * 1024 * 2 <= WS_W && WS_P + (size_t)T * P_LD * 2 <= WS_W && WS_BT_IN + (size_t)2 * P_LD * 2048 <= WS_BT_OUT, "ws map");
constexpr int CW_CNT = 1024;
constexpr int CW_BAR = 4096;
constexpr size_t CTL_ADA = 256 * 1024;
constexpr size_t CTL_BIASR = 700 * 1024;

constexpr int RING_BYTES = 131072;
constexpr int TAB_OFF = RING_BYTES;
constexpr int MISC_OFF = RING_BYTES + 1024;
constexpr int LDS_BYTES = 147456;

#define GAS __attribute__((address_space(1)))
#define LAS __attribute__((address_space(3)))
typedef unsigned short bf16;
typedef float f32x4 __attribute__((ext_vector_type(4)));
typedef float f32x2 __attribute__((ext_vector_type(2)));
typedef unsigned u32x4 __attribute__((ext_vector_type(4)));
typedef unsigned u32x2 __attribute__((ext_vector_type(2)));
#define LDS_WAIT() asm volatile("s_waitcnt lgkmcnt(0)" ::: "memory")

__device__ __forceinline__ unsigned f2bf(float f) { unsigned u = __builtin_bit_cast(unsigned, f); return (u + 0x7fffu + ((u >> 16) & 1u)) >> 16; }
__device__ __forceinline__ unsigned pk2(float lo, float hi) { return f2bf(lo) | (f2bf(hi) << 16); }
typedef __bf16 bfl2 __attribute__((ext_vector_type(2)));
__device__ __forceinline__ unsigned pkbf(float lo, float hi) { f32x2 v; v.x = lo; v.y = hi; return __builtin_bit_cast(unsigned, __builtin_convertvector(v, bfl2)); }
__device__ __forceinline__ float bflo(unsigned u) { return __builtin_bit_cast(float, u << 16); }
__device__ __forceinline__ float bfhi(unsigned u) { return __builtin_bit_cast(float, u & 0xffff0000u); }
__device__ __forceinline__ void load8(const bf16* p, float (&o)[8]) { const u32x4 u = *(const u32x4*)p; o[0] = bflo(u.x); o[1] = bfhi(u.x); o[2] = bflo(u.y); o[3] = bfhi(u.y); o[4] = bflo(u.z); o[5] = bfhi(u.z); o[6] = bflo(u.w); o[7] = bfhi(u.w); }
__device__ __forceinline__ void store8(bf16* p, const float (&v)[8]) { u32x4 w; w.x = pk2(v[0], v[1]); w.y = pk2(v[2], v[3]); w.z = pk2(v[4], v[5]); w.w = pk2(v[6], v[7]); *(u32x4*)p = w; }
typedef _Float16 f16x2 __attribute__((ext_vector_type(2)));
__device__ __forceinline__ unsigned pkh2(float lo, float hi) { f16x2 h; h.x = (_Float16)lo; h.y = (_Float16)hi; return __builtin_bit_cast(unsigned, h); }
__device__ __forceinline__ float hlo(unsigned u) { return (float)__builtin_bit_cast(f16x2, u).x; }
__device__ __forceinline__ float hhi(unsigned u) { return (float)__builtin_bit_cast(f16x2, u).y; }
__device__ __forceinline__ void load8h(const bf16* p, float (&o)[8]) { const u32x4 u = *(const u32x4*)p; o[0] = hlo(u.x); o[1] = hhi(u.x); o[2] = hlo(u.y); o[3] = hhi(u.y); o[4] = hlo(u.z); o[5] = hhi(u.z); o[6] = hlo(u.w); o[7] = hhi(u.w); }
__device__ __forceinline__ void store8h(bf16* p, const float (&v)[8]) { u32x4 w; w.x = pkh2(v[0], v[1]); w.y = pkh2(v[2], v[3]); w.z = pkh2(v[4], v[5]); w.w = pkh2(v[6], v[7]); *(u32x4*)p = w; }
__device__ __forceinline__ float fmx_lo(float a, unsigned h, float c) { float d; asm("v_fma_mix_f32 %0, %1, %2, %3 op_sel_hi:[0,1,0]" : "=v"(d) : "v"(a), "v"(h), "v"(c)); return d; }
__device__ __forceinline__ float fmx_hi(float a, unsigned h, float c) { float d; asm("v_fma_mix_f32 %0, %1, %2, %3 op_sel:[0,1,0] op_sel_hi:[0,1,0]" : "=v"(d) : "v"(a), "v"(h), "v"(c)); return d; }
__device__ __forceinline__ float mmx_lo(float a, unsigned h) { float d; asm("v_fma_mix_f32 %0, %1, %2, 0 op_sel_hi:[0,1,0]" : "=v"(d) : "v"(a), "v"(h)); return d; }
__device__ __forceinline__ float mmx_hi(float a, unsigned h) { float d; asm("v_fma_mix_f32 %0, %1, %2, 0 op_sel:[0,1,0] op_sel_hi:[0,1,0]" : "=v"(d) : "v"(a), "v"(h)); return d; }
__device__ __forceinline__ float sigmoidf_(float x) { return __builtin_amdgcn_rcpf(1.0f + __expf(-x)); }
__device__ __forceinline__ float tanhf_(float x) { return 1.0f - 2.0f * __builtin_amdgcn_rcpf(__expf(2.0f * x) + 1.0f); }
__device__ __forceinline__ float wave_sum(float v) {
#pragma unroll
    for (int o = 1; o < 64; o <<= 1) v += __shfl_xor(v, o);
    return v;
}
__device__ __forceinline__ float sum8(float v) { v += __shfl_xor(v, 1); v += __shfl_xor(v, 2); v += __shfl_xor(v, 4); return v; }
template <int CTRL> __device__ __forceinline__ float dpp_f(float v) { return __builtin_bit_cast(float, __builtin_amdgcn_mov_dpp(__builtin_bit_cast(int, v), CTRL, 0xF, 0xF, true)); }
__device__ __forceinline__ float dpp_sum16(float v) {
    v += dpp_f<0xB1>(v);
    v += dpp_f<0x4E>(v);
    v += dpp_f<0x141>(v);
    v += dpp_f<0x140>(v);
    return v;
}

#define XB_TMO      128
#define XB_XCNT(j)  (256  + 64 * (j))
#define XB_XSUB(j)  (1280 + 64 * (j))
#define XB_XGEN(j)  (2304 + 64 * (j))
#define XB_TOP      3328
#define XB_TOPGEN   3392
#define XCD_BAR_WORDS 3456
#define XB_SPIN_CAP (1u << 18)

__device__ __forceinline__ unsigned xb_ld(unsigned* p)              { return __hip_atomic_load(p, __ATOMIC_RELAXED, __HIP_MEMORY_SCOPE_AGENT); }
__device__ __forceinline__ unsigned xb_add(unsigned* p, unsigned v) { return __hip_atomic_fetch_add(p, v, __ATOMIC_RELAXED, __HIP_MEMORY_SCOPE_AGENT); }
__device__ __forceinline__ unsigned xb_xcc_id() { return (unsigned)__builtin_amdgcn_s_getreg((3 << 11) | 20) & 0xFu; }
#define XB_SPIN(cond, bar) do { unsigned _sp = 0; while (cond) { __builtin_amdgcn_s_sleep(1); \
    if ((++_sp & 255u) == 0u) { if (xb_ld(&(bar)[XB_TMO])) break; if (_sp > XB_SPIN_CAP) { atomicAdd(&(bar)[XB_TMO], 1u); break; } } } } while (0)

struct XcdBarrier {
    unsigned* bar; unsigned x;
    volatile LAS unsigned* st;
};

__device__ __forceinline__ XcdBarrier xcd_barrier_post(unsigned* bar, volatile LAS unsigned* st) {
    XcdBarrier b; b.bar = bar; b.x = xb_xcc_id(); b.st = st;
    if (threadIdx.x == 0) (void)xb_add(&bar[XB_XCNT(b.x)], 1u);
    return b;
}
__device__ __forceinline__ void xcd_barrier_complete(unsigned* bar, unsigned x, unsigned& nloc, unsigned& nx) {
    const unsigned G = gridDim.x * gridDim.y * gridDim.z;
    unsigned sum, cnt, mine, sp = 0u;
    for (;;) {
        sum = 0u; cnt = 0u; mine = 0u;
#pragma unroll
        for (unsigned j = 0; j < 16; ++j) { const unsigned c = xb_ld(&bar[XB_XCNT(j)]); sum += c; cnt += (c > 0u) ? 1u : 0u; mine = (j == x) ? c : mine; }
        if (sum == G) break;
        __builtin_amdgcn_s_sleep(1);
        if ((++sp & 255u) == 0u) { if (xb_ld(&bar[XB_TMO])) break; if (sp > XB_SPIN_CAP) { atomicAdd(&bar[XB_TMO], 1u); break; } }
    }
    nloc = mine > 0u ? mine : 1u; nx = cnt > 0u ? cnt : 1u;
}

__device__ __forceinline__ void xcd_barrier(const XcdBarrier& b) {
    asm volatile("s_waitcnt vmcnt(0)" ::: "memory");
    __syncthreads();
    if (threadIdx.x == 0) {
        unsigned* bar = b.bar;
        __builtin_amdgcn_s_waitcnt(0);
        unsigned nloc = b.st[0], nx = b.st[1];
        if (nloc == 0u) { xcd_barrier_complete(bar, b.x, nloc, nx); b.st[0] = nloc; b.st[1] = nx; }
        const unsigned old = xb_add(&bar[XB_XSUB(b.x)], 1u);
        const unsigned gen = old / nloc;
        if (old + 1u == (gen + 1u) * nloc) {
            __builtin_amdgcn_fence(__ATOMIC_RELEASE, "agent");
            asm volatile("s_waitcnt vmcnt(0)" ::: "memory");
            const unsigned og = xb_add(&bar[XB_TOP], 1u);
            const unsigned tg = og / nx;
            if (og + 1u == (tg + 1u) * nx) xb_add(&bar[XB_TOPGEN], 1u);
            else XB_SPIN(xb_ld(&bar[XB_TOPGEN]) == tg, bar);
            __builtin_amdgcn_fence(__ATOMIC_ACQUIRE, "agent");
            xb_add(&bar[XB_XGEN(b.x)], 1u);
            asm volatile("s_waitcnt vmcnt(0)" ::: "memory");
        } else {
            XB_SPIN(xb_ld(&bar[XB_XGEN(b.x)]) == gen, bar);
            __builtin_amdgcn_fence(__ATOMIC_ACQUIRE, "agent");
            asm volatile("s_waitcnt vmcnt(0)" ::: "memory");
        }
    }
    __syncthreads();
}

struct Args { const void* p[30]; int ph_lo, ph_hi; };
template <int IDX> __device__ __forceinline__ const float* kin() {
    const auto ka = __builtin_amdgcn_kernarg_segment_ptr(); unsigned long long v;
    asm volatile("s_load_dwordx2 %0, %1, %2\n\ts_waitcnt lgkmcnt(0)" : "=s"(v) : "s"(ka), "i"(IDX * 8) : "memory");
    return (const float*)(const GAS float*)v;
}
enum { I_X = 0, I_C, I_WADA, I_BADA, I_N1G, I_N2G, I_WIN, I_MU, I_CONVW, I_W0, I_DECUP, I_A0, I_AAAUP, I_GATEUP, I_KK, I_KA, I_RK, I_LNW, I_LNB, I_VMD, I_VMU, I_V0, I_WOUT, I_WR, I_RB, I_WE1, I_WE2, I_FG };
struct Frame {
    LAS unsigned char* lds;
    int tid, lane, wave, vcu, G;
    GAS unsigned char* ws;
};
__device__ __forceinline__ float* ada_ptr(const Frame& F, int l, int b) { return (float*)(F.ws + WS_CTL + CTL_ADA) + (size_t)(l * 8 + b) * 6144; }

__device__ __forceinline__ void transpose_item(const float* W, int K, int N, bf16* WT, int dst_row0, int k0, int n0, LAS float* scr, int lane) {
    float tv[32];
#pragma unroll
    for (int i = 0; i < 32; ++i) tv[i] = W[(size_t)(k0 + 2 * i + (lane >> 5)) * N + n0 + (lane & 31)];
#pragma unroll
    for (int i = 0; i < 32; ++i) { const int kk = 2 * i + (lane >> 5); scr[kk * 33 + (lane & 31)] = tv[i]; }
    LDS_WAIT();
    const int c = lane & 7;
#pragma unroll
    for (int j = 0; j < 4; ++j) { const int n = (lane >> 3) + 8 * j; const LAS float* s = scr + (8 * c) * 33 + n;
        u32x4 o; o.x = pk2(s[0 * 33], s[1 * 33]); o.y = pk2(s[2 * 33], s[3 * 33]); o.z = pk2(s[4 * 33], s[5 * 33]); o.w = pk2(s[6 * 33], s[7 * 33]);
        *(u32x4*)(WT + (size_t)(dst_row0 + n) * K + k0 + 8 * c) = o; }
    LDS_WAIT();
}
__device__ __forceinline__ void p0_prologue(const Frame& F) {
    LAS float* scr = (LAS float*)(F.lds + F.wave * 16384);
    const int gw = F.vcu * NWAVES + F.wave, NGW = F.G * NWAVES, lane = F.lane;
    constexpr int I_ADA = 768, I_A = 2 * 16 * 264, I_B = 2 * 16 * 32, I_C1 = 64 * 16 * 32, I_D = 64 * 8 * 32;
    constexpr int NITEMS = I_ADA + I_A + I_B + I_C1 + I_D;
    const float* const pC = kin<I_C>(); const float* const pWADA = kin<I_WADA>(); const float* const pWIN = kin<I_WIN>();
    const float* const pWOUT = kin<I_WOUT>(); const float* const pWE1 = kin<I_WE1>(); const float* const pWE2 = kin<I_WE2>(); const float* const pVMD = kin<I_VMD>();
    for (int it = gw; it < NITEMS; it += NGW) {
        int r = it;
        if (r < I_ADA) {
            const int l = r / 384, rr = r % 384, cch = rr >> 4, kc = rr & 15, col = cch * 256 + 4 * lane, k0 = kc * 64;
            float cv[8];
#pragma unroll
            for (int b = 0; b < 8; ++b) { const float x = pC[b * 1024 + k0 + lane]; cv[b] = x * sigmoidf_(x); }
            f32x4 acc[8];
#pragma unroll
            for (int b = 0; b < 8; ++b) acc[b] = (f32x4){0.f, 0.f, 0.f, 0.f};
            const float* wp = pWADA + ((size_t)l * 1024 + k0) * 6144 + col;
#pragma unroll 16
            for (int kk = 0; kk < 64; ++kk) { const f32x4 w = *(const f32x4*)(wp + (size_t)kk * 6144);
#pragma unroll
                for (int b = 0; b < 8; ++b) { const float s = __builtin_bit_cast(float, __builtin_amdgcn_readlane(__builtin_bit_cast(int, cv[b]), kk)); acc[b] += s * w; } }
#pragma unroll
            for (int b = 0; b < 8; ++b) *(f32x4*)((float*)(F.ws + WS_ADAP) + ((size_t)(kc * 2 + l) * 8 + b) * 6144 + col) = acc[b];
            continue;
        }
        r -= I_ADA;
        if (r < I_A) { const int l = r / (16 * 264), rr = r % (16 * 264), kb = rr / 264, nb = rr % 264;
            transpose_item(pWIN + (size_t)l * 1024 * N_IN, 1024, N_IN, (bf16*)(F.ws + WS_BT_IN) + (size_t)l * P_LD * 1024, 32 * nb, 64 * kb, 32 * nb, scr, lane); continue; }
        r -= I_A;
        if (r < I_B) { const int l = r / 512, rr = r % 512, kb = rr / 32, nb = rr % 32;
            transpose_item(pWOUT + (size_t)l * 1024 * 1024, 1024, 1024, (bf16*)(F.ws + WS_BT_OUT) + (size_t)l * 1024 * 1024, 32 * nb, 64 * kb, 32 * nb, scr, lane); continue; }
        r -= I_B;
        if (r < I_C1) { const int le = r / 512, rr = r % 512, kb = rr / 32, nb = rr % 32, n0 = 32 * nb;
            const int j0 = n0 & 511, dst = (j0 >> 7) * 256 + (n0 >= 512 ? 128 : 0) + (j0 & 127);
            transpose_item(pWE1 + (size_t)le * 1024 * 1024, 1024, 1024, (bf16*)(F.ws + WS_BT_E1) + (size_t)le * 1024 * 1024, dst, 64 * kb, n0, scr, lane); continue; }
        r -= I_C1;
        { const int le = r / 256, rr = r % 256, kb = rr / 32, nb = rr % 32;
            transpose_item(pWE2 + (size_t)le * 512 * 1024, 512, 1024, (bf16*)(F.ws + WS_BT_E2) + (size_t)le * 1024 * 512, 32 * nb, 64 * kb, 32 * nb, scr, lane); }
    }
    const int gt0 = F.vcu * NWAVES * 64 + F.tid, GT = F.G * NWAVES * 64;
    { const float* const pVMUp = kin<I_VMU>();
      for (int it = gt0; it < 256 * 128; it += GT) { const int n = it >> 7, k0 = (it & 127) * 8; float o[8];
#pragma unroll
        for (int i = 0; i < 8; ++i) o[i] = (n < 32) ? pVMD[(k0 + i) * 32 + n] : 0.f;
        store8((bf16*)(F.ws + WS_BT_IN) + (size_t)P_LD * 1024 + (size_t)(C_VD + n) * 1024 + k0, o); }
      for (int it = gt0; it < 1024 * 4; it += GT) { const int n = it >> 2, j0 = (it & 3) * 8; float o[8];
#pragma unroll
        for (int i = 0; i < 8; ++i) o[i] = pVMUp[(j0 + i) * 1024 + n];
        store8((bf16*)(F.ws + WS_VU) + (size_t)n * 32 + j0, o); } }
    { const float* const pDU = kin<I_DECUP>(); const float* const pAU = kin<I_AAAUP>(); const float* const pGU = kin<I_GATEUP>();
      for (int it = gt0; it < 2 * 3072 * 32; it += GT) { const int l = it / (3072 * 32), rr = it % (3072 * 32), n = rr >> 5, k0 = (rr & 31) * 8; float o[8];
#pragma unroll
        for (int i = 0; i < 8; ++i) { const int k = k0 + i; float v = 0.f;
            if (n < 1024) { if (k < 64) v = pDU[(size_t)(l * 64 + k) * 1024 + n]; }
            else if (n < 2048) { if (k >= 64 && k < 128) v = pAU[(size_t)(l * 64 + k - 64) * 1024 + n - 1024]; }
            else { if (k >= 128) v = pGU[(size_t)(l * 128 + k - 128) * 1024 + n - 2048]; }
            o[i] = v; }
        store8((bf16*)(F.ws + WS_BT_LR) + (size_t)l * 3072 * 256 + (size_t)n * 256 + k0, o); } }
    { const float* const pWRp = kin<I_WR>(); const int gt = F.vcu * NWAVES * 64 + F.tid; if (gt < 32768) { const float w = pWRp[(gt & 1023) * 32 + (gt >> 10)]; const unsigned hi = f2bf(w);
        ((bf16*)(F.ws + WS_WRT))[gt] = (bf16)hi; ((bf16*)(F.ws + WS_WRT))[32768 + gt] = (bf16)f2bf(w - bflo(hi)); } }
}

__device__ __forceinline__ void p0b_ada_reduce(const Frame& F) {
    const float* const pBADA = kin<I_BADA>(); const float* ap = (const float*)(F.ws + WS_ADAP); float* ada = (float*)(F.ws + WS_CTL + CTL_ADA);
    for (int idx = F.vcu * NWAVES * 64 + F.tid; idx < 2 * 8 * 6144; idx += F.G * NWAVES * 64) { const int l = idx / 49152, r = idx % 49152, c = r % 6144;
        float s = pBADA[l * 6144 + c];
#pragma unroll
        for (int kc = 0; kc < 16; ++kc) s += ap[(size_t)(kc * 2 + l) * 49152 + r];
        ada[idx] = s; }
}

template <int MODE> __device__ __forceinline__ void p1_norm(const Frame& F, int l) {
    const int lane = F.lane;
    const float* const pX = kin<I_X>(); float* const pOUT = (float*)kin<28>(); const float* const pFG = kin<I_FG>(); const float* const pN1G = kin<I_N1G>(); const float* const pWRb = kin<I_WR>();
#pragma unroll 1
    for (int gw = F.vcu * NWAVES + F.wave; gw < T / 8; gw += F.G * NWAVES) { const int tok0 = gw * 8, b = tok0 >> 11;
        f32x4 gm[4], sh[4], g2v[4];
#pragma unroll
        for (int j = 0; j < 4; ++j) { const int c = 4 * lane + 256 * j;
            if (MODE == 2) { gm[j] = *(const f32x4*)(pFG + c); sh[j] = (f32x4){0.f, 0.f, 0.f, 0.f}; }
            else { const float* ad = ada_ptr(F, l, b); const f32x4 g = *(const f32x4*)(pN1G + l * 1024 + c), sc = *(const f32x4*)(ad + 1024 + c); gm[j] = g * (1.0f + sc); sh[j] = *(const f32x4*)(ad + c); }
            if (MODE >= 1) g2v[j] = *(const f32x4*)(ada_ptr(F, MODE == 2 ? 1 : l - 1, b) + 5120 + c); }
        float* X = (float*)(F.ws + WS_X);
        const bf16* YE = (const bf16*)(F.ws + WS_YE);
        const float* WTS = (const float*)(F.ws + WS_WTS); const int* SLOT = (const int*)(F.ws + WS_SLOT);
#pragma unroll 1
        for (int tb = 0; tb < 8; tb += 4) {
            f32x4 v[4][4];
#pragma unroll
            for (int t = 0; t < 4; ++t) { const float* xs = (MODE == 0 ? pX : X) + (size_t)(tok0 + tb + t) * 1024;
#pragma unroll
                for (int j = 0; j < 4; ++j) v[t][j] = *(const f32x4*)(xs + 4 * lane + 256 * j); }
            if (MODE >= 1) {
                float w0[4], w1[4]; int s0[4], s1[4]; u32x2 y0[4][4], y1[4][4];
#pragma unroll
                for (int t = 0; t < 4; ++t) { const int tok = tok0 + tb + t; w0[t] = WTS[tok * 2]; w1[t] = WTS[tok * 2 + 1]; s0[t] = SLOT[tok * 2]; s1[t] = SLOT[tok * 2 + 1]; }
#pragma unroll
                for (int t = 0; t < 4; ++t)
#pragma unroll
                    for (int j = 0; j < 4; ++j) { y0[t][j] = *(const u32x2*)(YE + (size_t)s0[t] * 1024 + 4 * lane + 256 * j); y1[t][j] = *(const u32x2*)(YE + (size_t)s1[t] * 1024 + 4 * lane + 256 * j); }
#pragma unroll
                for (int t = 0; t < 4; ++t)
#pragma unroll
                    for (int j = 0; j < 4; ++j) { const u32x2 a = y0[t][j], c = y1[t][j];
                        f32x4 m; m[0] = w0[t] * bflo(a.x) + w1[t] * bflo(c.x); m[1] = w0[t] * bfhi(a.x) + w1[t] * bfhi(c.x); m[2] = w0[t] * bflo(a.y) + w1[t] * bflo(c.y); m[3] = w0[t] * bfhi(a.y) + w1[t] * bfhi(c.y);
                        v[t][j] += g2v[j] * m; if (MODE == 1) *(f32x4*)(X + (size_t)(tok0 + tb + t) * 1024 + 4 * lane + 256 * j) = v[t][j]; }
            }
            float ss[4];
#pragma unroll
            for (int t = 0; t < 4; ++t) { ss[t] = 0.f;
#pragma unroll
                for (int j = 0; j < 4; ++j) ss[t] += (v[t][j][0] * v[t][j][0] + v[t][j][1] * v[t][j][1]) + (v[t][j][2] * v[t][j][2] + v[t][j][3] * v[t][j][3]); }
#pragma unroll
            for (int o = 1; o < 64; o <<= 1) {
#pragma unroll
                for (int t = 0; t < 4; ++t) ss[t] += __shfl_xor(ss[t], o); }
#pragma unroll
            for (int t = 0; t < 4; ++t) { const int tok = tok0 + tb + t;
                const float rstd = __builtin_amdgcn_rsqf(ss[t] * (1.0f / 1024.0f) + NORM_EPS);
#pragma unroll
                for (int j = 0; j < 4; ++j) { const f32x4 h = v[t][j] * rstd * gm[j] + sh[j];
                    if (MODE == 2) *(f32x4*)(pOUT + (size_t)tok * 1024 + 4 * lane + 256 * j) = h;
                    else { u32x2 w; w.x = pk2(h[0], h[1]); w.y = pk2(h[2], h[3]); *(u32x2*)((bf16*)(F.ws + WS_H) + (size_t)tok * 1024 + 4 * lane + 256 * j) = w; } } }
        }
    }
    if (MODE == 0 && F.vcu < 16) {
        const int lb = F.vcu, e = F.tid & 31, kq = F.tid >> 5; const float* sh2 = ada_ptr(F, lb >> 3, lb & 7) + 3072 + kq * 64; const float* wr = pWRb + (size_t)kq * 64 * 32 + e; float s = 0.f;
#pragma unroll 1
        for (int k0 = 0; k0 < 64; k0 += 32) { float a[32], w[32];
#pragma unroll
            for (int i = 0; i < 32; ++i) { a[i] = sh2[k0 + i]; w[i] = wr[(k0 + i) * 32]; }
#pragma unroll
            for (int i = 0; i < 32; ++i) s += a[i] * w[i]; }
        LAS float* red = (LAS float*)F.lds; red[kq * 32 + e] = s; __syncthreads();
        if (F.tid < 32) { float t = 0.f; for (int q = 0; q < 16; ++q) t += red[q * 32 + e]; ((float*)(F.ws + WS_CTL + CTL_BIASR))[lb * 32 + e] = t; }
        __syncthreads();
    }
}

typedef short bfv8 __attribute__((ext_vector_type(8)));
constexpr int LRX_PITCH = 592;
template <int NKS> struct LrW { bfv8 w[2][NKS]; f32x4 b0, b1; };
template <int NKS> __device__ __forceinline__ void lrx_load(LrW<NKS>& W, const bf16* wrow0, int wpitch, const float* bias, int li, int fq) {
#pragma unroll
    for (int tile = 0; tile < 2; ++tile) { const bf16* rp = wrow0 + (size_t)(8 * (li >> 2) + 4 * tile + (li & 3)) * wpitch + 8 * fq;
#pragma unroll
        for (int ks = 0; ks < NKS; ++ks) W.w[tile][ks] = *(const bfv8*)(rp + 32 * ks); }
    if (bias) { W.b0 = *(const f32x4*)(bias + 8 * fq); W.b1 = *(const f32x4*)(bias + 8 * fq + 4); }
}
template <int NKS, int MODE> __device__ __forceinline__ void lrx_job(const LrW<NKS>& W, const LAS unsigned char* tile, int kcol, bf16* out, int ostride, int li, int fq) {
#pragma unroll 2
    for (int mt = 0; mt < 4; ++mt) {
        bfv8 af[NKS];
#pragma unroll
        for (int ks = 0; ks < NKS; ++ks) af[ks] = *(const LAS bfv8*)(tile + (16 * mt + li) * LRX_PITCH + (kcol + 32 * ks + 8 * fq) * 2);
        f32x4 acc0 = (f32x4){0.f, 0.f, 0.f, 0.f}, acc1 = acc0;
#pragma unroll
        for (int ks = 0; ks < NKS; ++ks) { acc0 = __builtin_amdgcn_mfma_f32_16x16x32_bf16(W.w[0][ks], af[ks], acc0, 0, 0, 0); acc1 = __builtin_amdgcn_mfma_f32_16x16x32_bf16(W.w[1][ks], af[ks], acc1, 0, 0, 0); }
        u32x4 o;
        if (MODE == 0) { float x[8];
#pragma unroll
            for (int j = 0; j < 4; ++j) { x[j] = -0.60653066f * sigmoidf_(W.b0[j] + acc0[j]); x[4 + j] = -0.60653066f * sigmoidf_(W.b1[j] + acc1[j]); }
            o.x = pkh2(x[0], x[1]); o.y = pkh2(x[2], x[3]); o.z = pkh2(x[4], x[5]); o.w = pkh2(x[6], x[7]);
        } else if (MODE == 1) { float x[8];
#pragma unroll
            for (int j = 0; j < 4; ++j) { x[j] = sigmoidf_(W.b0[j] + acc0[j]); x[4 + j] = sigmoidf_(W.b1[j] + acc1[j]); }
            o.x = pkh2(x[0], x[1]); o.y = pkh2(x[2], x[3]); o.z = pkh2(x[4], x[5]); o.w = pkh2(x[6], x[7]);
        } else { o.x = pkbf(acc0[0], acc0[1]); o.y = pkbf(acc0[2], acc0[3]); o.z = pkbf(acc1[0], acc1[1]); o.w = pkbf(acc1[2], acc1[3]); }
        *(u32x4*)(out + (size_t)(16 * mt) * ostride) = o;
    }
}
__device__ __forceinline__ void p2x_lowrank(const Frame& F, int l) {
    const int lane = F.lane, c8 = lane & 31, hf = lane >> 5, li = lane & 15, fq = lane >> 4;
    const bf16* P = (const bf16*)(F.ws + WS_P); const float* mu = kin<I_MU>() + l * N_SHIFT + 3072 + 8 * c8;
    const f32x4 m0 = *(const f32x4*)mu, m1 = *(const f32x4*)(mu + 4);
    const float* const pKKc = kin<I_KK>() + l * 1024; const float* const muK = kin<I_MU>() + l * N_SHIFT + 1024; float* KNo = (float*)(F.ws + WS_KN);
    const bf16* BT = (const bf16*)(F.ws + WS_BT_LR) + (size_t)l * 3072 * 256; const bf16* BTV = (const bf16*)(F.ws + WS_VU);
    const float* const pW0 = kin<I_W0>() + l * 1024; const float* const pA0 = kin<I_A0>() + l * 1024; const float* const pV0 = kin<I_V0>();
    LAS unsigned char* tile = F.lds;
    const int cw = F.wave * 128;
#pragma unroll 1
    for (int item = F.vcu; item < T / 64; item += F.G) { const int gw = item * 8 + F.wave;
        LrW<2> W2[2]; LrW<4> W4[2]; LrW<1> W1[2];
        lrx_load<2>(W2[0], BT + (size_t)cw * 256, 256, pW0 + cw, li, fq);
#pragma unroll
        for (int i = 0; i < 4; ++i) { const int row = 8 * F.wave + 2 * i + hf, tok = item * 64 + row; float cur[8], prv[8], o[8];
            load8(P + (size_t)tok * P_LD + C_WD + 8 * c8, cur);
            if ((tok & (SEQ - 1)) != 0) load8(P + (size_t)(tok - 1) * P_LD + C_WD + 8 * c8, prv); else {
#pragma unroll
                for (int j = 0; j < 8; ++j) prv[j] = 0.f; }
#pragma unroll
            for (int j = 0; j < 8; ++j) { const float v = cur[j] + (prv[j] - cur[j]) * (j < 4 ? m0[j] : m1[j - 4]); o[j] = (c8 < 8) ? tanhf_(v) : ((c8 < 16) ? v : sigmoidf_(v)); }
            u32x4 w; w.x = pkbf(o[0], o[1]); w.y = pkbf(o[2], o[3]); w.z = pkbf(o[4], o[5]); w.w = pkbf(o[6], o[7]);
            *(LAS u32x4*)(tile + row * LRX_PITCH + 16 * c8) = w; }
        if (l == 1 && F.tid < 256) { const int row = F.tid >> 2, ch = F.tid & 3;
            *(LAS u32x4*)(tile + row * LRX_PITCH + 512 + 16 * ch) = *(const u32x4*)(P + (size_t)(item * 64 + row) * P_LD + C_VD + 8 * ch); }
#pragma unroll 1
        for (int ch = 0; ch < 2; ++ch) { const int col0 = 512 * ch + 8 * lane; float kkc[8], muk[8], kp_[8];
#pragma unroll
            for (int j = 0; j < 8; ++j) { kkc[j] = pKKc[col0 + j]; muk[j] = muK[col0 + j]; kp_[j] = 0.f; }
            const int tok0 = gw * 8;
            if ((tok0 & (SEQ - 1)) != 0) load8(P + (size_t)(tok0 - 1) * P_LD + C_K + col0, kp_);
#pragma unroll 4
            for (int tk = 0; tk < 8; ++tk) { float kc[8]; load8(P + (size_t)(tok0 + tk) * P_LD + C_K + col0, kc); float ss = 0.f;
#pragma unroll
                for (int j = 0; j < 8; ++j) { const float k = (kc[j] + (kp_[j] - kc[j]) * muk[j]) * kkc[j]; ss += k * k; kp_[j] = kc[j]; }
                ss = sum8(ss);
                if ((lane & 7) == 0) KNo[(tok0 + tk) * 16 + 8 * ch + (lane >> 3)] = __builtin_amdgcn_rsqf(fmaxf(ss, 1e-24f)); } }
        __syncthreads();
        bf16* outb = (bf16*)(F.ws + WS_LR) + (size_t)(item * 64 + li) * 3072 + cw + 8 * fq;
#pragma unroll
        for (int j = 0; j < 8; ++j) { const int a = j >> 2, g = j & 3, jn = j + 1, an = jn >> 2, gn = jn & 3;
            if (jn < 8) lrx_load<2>(W2[jn & 1], BT + (size_t)(an * 1024 + cw + 32 * gn) * 256 + 64 * an, 256, (an ? pA0 : pW0) + cw + 32 * gn, li, fq);
            else lrx_load<4>(W4[0], BT + (size_t)(2048 + cw) * 256 + 128, 256, nullptr, li, fq);
            if (a == 0) lrx_job<2, 0>(W2[j & 1], tile, 0, outb + 32 * g, 3072, li, fq); else lrx_job<2, 1>(W2[j & 1], tile, 64, outb + 1024 + 32 * g, 3072, li, fq); }
#pragma unroll
        for (int g = 0; g < 4; ++g) {
            if (g + 1 < 4) lrx_load<4>(W4[(g + 1) & 1], BT + (size_t)(2048 + cw + 32 * (g + 1)) * 256 + 128, 256, nullptr, li, fq);
            else if (l == 1) lrx_load<1>(W1[0], BTV + (size_t)cw * 32, 32, pV0 + cw, li, fq);
            lrx_job<4, 2>(W4[g & 1], tile, 128, outb + 2048 + 32 * g, 3072, li, fq); }
        if (l == 1) { bf16* outv = (bf16*)(F.ws + WS_VG) + (size_t)(item * 64 + li) * 1024 + cw + 8 * fq;
#pragma unroll
            for (int g = 0; g < 4; ++g) {
                if (g + 1 < 4) lrx_load<1>(W1[(g + 1) & 1], BTV + (size_t)(cw + 32 * (g + 1)) * 32, 32, pV0 + cw + 32 * (g + 1), li, fq);
                lrx_job<1, 1>(W1[g & 1], tile, 256, outv + 32 * g, 1024, li, fq); } }
        __syncthreads();
    }
}

__device__ __forceinline__ f32x4 h4_to_f4(const u32x2 u) { return (f32x4){hlo(u.x), hhi(u.x), hlo(u.y), hhi(u.y)}; }
constexpr size_t WS_YCK = WS_Y;
typedef short bf16x8 __attribute__((ext_vector_type(8)));
typedef float f32x16 __attribute__((ext_vector_type(16)));
constexpr int CK_XK = 0, CK_XR = 4608, CK_BH = 9216, CK_KH = 14336, CK_GB = 19456, CK_VT = 19712, CK_X3SZ = 22272;
constexpr int CK_XB = 0, CK_XP = 4608, CK_P2SZ = 9216;
constexpr int CK_TK = 0, CK_TBR = 2560, CK_TKR = 5120, CK_T12 = 7680, CK_TBT = 11776, CK_MT = 15872, CK_T2SZ = 18432;
constexpr int CK_X3_OFF = 0, CK_P2_OFF = 3 * CK_X3SZ, CK_T2_OFF = CK_P2_OFF + 2 * CK_P2SZ, CK_STASH = CK_T2_OFF + 2 * CK_T2SZ;
static_assert(CK_STASH + 8192 <= RING_BYTES, "chunked-scan LDS map");
#define CK_MFMA(a, b, c) __builtin_amdgcn_mfma_f32_32x32x16_bf16((a), (b), (c), 0, 0, 0)
__device__ __forceinline__ bf16x8 ck_frag(const LAS unsigned char* base, int pitch, int row, int kel) { return *(const LAS bf16x8*)(base + row * pitch + kel * 2); }
struct CkRegs { u32x2 rP, rA, rB, kP, kA, kB, vP, vA, vB, dwA, dwB, apA, apB, vmA, vmB, vfA, vfB; float knA, knB; };
struct CkConst { f32x4 a0, kk, ka, rk, w0, v0, mur, muk, muv; };
__device__ __forceinline__ f32x4 b4_to_f4(const u32x2 u) { return (f32x4){bflo(u.x), bfhi(u.x), bflo(u.y), bfhi(u.y)}; }
__device__ __forceinline__ void ck_issue(const Frame& F, int pw, int l, int b, int h, int half, int blk, CkRegs& R) {
    const int s2 = F.lane >> 2, cq = F.lane & 3, col = h * 64 + 16 * pw + 4 * cq; const size_t tA = (size_t)b * SEQ + blk * 32 + 2 * s2;
    const bf16* P = (const bf16*)(F.ws + WS_P) + tA * P_LD + col; const bf16* LR = (const bf16*)(F.ws + WS_LR) + tA * 3072 + col; const float* KN = (const float*)(F.ws + WS_KN) + tA * 16 + h;
    R.rA = *(const u32x2*)(P + C_R); R.rB = *(const u32x2*)(P + P_LD + C_R); R.kA = *(const u32x2*)(P + C_K); R.kB = *(const u32x2*)(P + P_LD + C_K); R.vA = *(const u32x2*)(P + C_V); R.vB = *(const u32x2*)(P + P_LD + C_V);
    if ((tA & (SEQ - 1)) != 0) { R.rP = *(const u32x2*)(P - P_LD + C_R); R.kP = *(const u32x2*)(P - P_LD + C_K); R.vP = *(const u32x2*)(P - P_LD + C_V); } else { R.rP = (u32x2){0u, 0u}; R.kP = R.rP; R.vP = R.rP; }
    R.dwA = *(const u32x2*)LR; R.dwB = *(const u32x2*)(LR + 3072); R.apA = *(const u32x2*)(LR + 1024); R.apB = *(const u32x2*)(LR + 3072 + 1024);
    R.knA = KN[0]; R.knB = KN[16];
    if (l == 1) { const bf16* VG = (const bf16*)(F.ws + WS_VG) + tA * 1024 + col; R.vmA = *(const u32x2*)VG; R.vmB = *(const u32x2*)(VG + 1024); const bf16* V0 = (const bf16*)(F.ws + WS_V0) + tA * 1024 + col; R.vfA = *(const u32x2*)V0; R.vfB = *(const u32x2*)(V0 + 1024); }
    (void)half;
}
__device__ __forceinline__ void ck_elem(const CkConst& C, int l, const f32x4 rc, const f32x4 rp, const f32x4 kc, const f32x4 kp_, const f32x4 vc, const f32x4 vp, const f32x4 dw, const f32x4 ap, const float kn,
                                        const f32x4 vm, const f32x4 vf, f32x4& r, f32x4& kk, f32x4& bq, f32x4& kp, f32x4& lw, f32x4& v, float& bo) {
#pragma unroll
    for (int e = 0; e < 4; ++e) {
        r[e] = rc[e] + (rp[e] - rc[e]) * C.mur[e]; const float k = kc[e] + (kp_[e] - kc[e]) * C.muk[e]; float vv = vc[e] + (vp[e] - vc[e]) * C.muv[e];
        const float av = ap[e]; kk[e] = k * C.kk[e] * kn;     bq[e] = kk[e] * av; kp[e] = k * (1.0f + (av - 1.0f) * C.ka[e]); bo += r[e] * kp[e] * C.rk[e];
        lw[e] = dw[e];
        if (l == 1) vv = vv + (vf[e] - vv) * vm[e];
        v[e] = vv; }
}
__device__ __forceinline__ void ck_stage1(const Frame& F, int pw, int l, int b, int h, int half, int blk, const CkConst& C, LAS unsigned char* BX, LAS unsigned char* BP, CkRegs& R, bool issue_next) {
    const int lane = F.lane, s2 = lane >> 2, cq = lane & 3, c0 = 16 * pw + 4 * cq, cp = 16 * pw + 4 * (((cq & 1) << 1) | (cq >> 1));
    f32x4 kkA, kkB, bqA, bqB, kpA, kpB, rA, rB, lwA, lwB, vA, vB; float boA = 0.f, boB = 0.f;
    { const f32x4 rcA = b4_to_f4(R.rA), kcA = b4_to_f4(R.kA), vcA = b4_to_f4(R.vA), zz = (f32x4){0.f, 0.f, 0.f, 0.f};
      ck_elem(C, l, rcA, b4_to_f4(R.rP), kcA, b4_to_f4(R.kP), vcA, b4_to_f4(R.vP), h4_to_f4(R.dwA), h4_to_f4(R.apA), R.knA, l == 1 ? h4_to_f4(R.vmA) : zz, l == 1 ? h4_to_f4(R.vfA) : zz, rA, kkA, bqA, kpA, lwA, vA, boA);
      ck_elem(C, l, b4_to_f4(R.rB), rcA, b4_to_f4(R.kB), kcA, b4_to_f4(R.vB), vcA, h4_to_f4(R.dwB), h4_to_f4(R.apB), R.knB, l == 1 ? h4_to_f4(R.vmB) : zz, l == 1 ? h4_to_f4(R.vfB) : zz, rB, kkB, bqB, kpB, lwB, vB, boB); }
    asm volatile("" ::: "memory");
    if (issue_next) ck_issue(F, pw, l, b, h, half, blk + 1, R);
    asm volatile("" ::: "memory");
    { const size_t tA = (size_t)b * SEQ + blk * 32 + 2 * s2;
      boA += __shfl_xor(boA, 1); boA += __shfl_xor(boA, 2); boB += __shfl_xor(boB, 1); boB += __shfl_xor(boB, 2);
      if ((pw >> 1) == half) { if (cq == 0) { float* bp = (float*)(F.ws + WS_BONP) + (tA * 16 + h) * 4 + pw; bp[0] = boA; bp[64] = boB; }
          bf16* Vo = (bf16*)(F.ws + (l == 0 ? WS_V0 : WS_V1)) + tA * 1024 + h * 64 + c0;
          *(u32x2*)Vo = (u32x2){pkh2(vA[0], vA[1]), pkh2(vA[2], vA[3])}; *(u32x2*)(Vo + 1024) = (u32x2){pkh2(vB[0], vB[1]), pkh2(vB[2], vB[3])};
#pragma unroll
          for (int e = 0; e < 4; ++e) *(LAS unsigned*)(BX + CK_VT + (16 * (pw & 1) + 4 * cq + e) * 80 + (2 * s2) * 2) = pkbf(vA[e], vB[e]); } }
    float xkA[4], xkB[4], xrA[4], xrB[4], xbA[4], xbB[4], xpA[4], xpB[4], bhA[4], bhB[4], khA[4], khB[4], gb[4];
    float xs[4], Tr[4][4];
#pragma unroll
    for (int e = 0; e < 4; ++e) { lwA[e] *= 1.44269504f; lwB[e] *= 1.44269504f; float x = lwA[e] + lwB[e]; x += dpp_f<0x114>(x); x += dpp_f<0x118>(x); xs[e] = x; }
#pragma unroll
    for (int e = 0; e < 4; ++e)
#pragma unroll
        for (int rw = 0; rw < 4; ++rw) Tr[e][rw] = __shfl(xs[e], 16 * rw + 12 + cq);
    { const int row = lane >> 4; const float m0 = row > 0 ? 1.f : 0.f, m1 = row > 1 ? 1.f : 0.f, m2 = row > 2 ? 1.f : 0.f;
#pragma unroll
    for (int e = 0; e < 4; ++e) {
        const float LB = xs[e] + (m0 * Tr[e][0] + m1 * Tr[e][1] + m2 * Tr[e][2]), LA = LB - lwB[e], L0 = LA - lwA[e], Lt = (Tr[e][0] + Tr[e][1]) + (Tr[e][2] + Tr[e][3]);
        const float eL0 = __builtin_amdgcn_exp2f(L0), eLA = __builtin_amdgcn_exp2f(LA), eLB = __builtin_amdgcn_exp2f(LB), iLA = __builtin_amdgcn_exp2f(-LA), iLB = __builtin_amdgcn_exp2f(-LB), eLt = __builtin_amdgcn_exp2f(Lt), tA = eLt * iLA, tB = eLt * iLB;
        xkA[e] = kkA[e] * eL0; xkB[e] = kkB[e] * eLA; xrA[e] = rA[e] * eLA; xrB[e] = rB[e] * eLB;
        xbA[e] = bqA[e] * iLA; xbB[e] = bqB[e] * iLB; xpA[e] = kpA[e] * iLA; xpB[e] = kpB[e] * iLB;
        bhA[e] = bqA[e] * tA; bhB[e] = bqB[e] * tB; khA[e] = kpA[e] * tA; khB[e] = kpB[e] * tB; gb[e] = eLt;
    } }
    const int oA = (2 * s2) * 144 + cp * 2, oB = oA + 144;
    *(LAS u32x2*)(BX + CK_XK + oA) = (u32x2){pkbf(xkA[0], xkA[1]), pkbf(xkA[2], xkA[3])}; *(LAS u32x2*)(BX + CK_XK + oB) = (u32x2){pkbf(xkB[0], xkB[1]), pkbf(xkB[2], xkB[3])};
    *(LAS u32x2*)(BX + CK_XR + oA) = (u32x2){pkbf(xrA[0], xrA[1]), pkbf(xrA[2], xrA[3])}; *(LAS u32x2*)(BX + CK_XR + oB) = (u32x2){pkbf(xrB[0], xrB[1]), pkbf(xrB[2], xrB[3])};
    *(LAS u32x2*)(BP + CK_XB + oA) = (u32x2){pkbf(xbA[0], xbA[1]), pkbf(xbA[2], xbA[3])}; *(LAS u32x2*)(BP + CK_XB + oB) = (u32x2){pkbf(xbB[0], xbB[1]), pkbf(xbB[2], xbB[3])};
    *(LAS u32x2*)(BP + CK_XP + oA) = (u32x2){pkbf(xpA[0], xpA[1]), pkbf(xpA[2], xpA[3])}; *(LAS u32x2*)(BP + CK_XP + oB) = (u32x2){pkbf(xpB[0], xpB[1]), pkbf(xpB[2], xpB[3])};
    const int i0 = 2 * s2, pst = (i0 & 16) | ((i0 & 4) << 1) | ((i0 & 8) >> 1) | (i0 & 3);
#pragma unroll
    for (int e = 0; e < 4; ++e) { *(LAS unsigned*)(BX + CK_BH + (c0 + e) * 80 + pst * 2) = pkbf(bhA[e], bhB[e]); *(LAS unsigned*)(BX + CK_KH + (c0 + e) * 80 + (2 * s2) * 2) = pkbf(khA[e], khB[e]); }
    if (s2 == 0) *(LAS f32x4*)(BX + CK_GB + c0 * 4) = (f32x4){gb[0], gb[1], gb[2], gb[3]};

}
__device__ __forceinline__ void ck_stage2(const Frame& F, int ti, const LAS unsigned char* BX, const LAS unsigned char* BP, LAS unsigned char* BT) {
    const int r = F.lane & 31, hh = F.lane >> 5;
    const LAS unsigned char* Aa = BP + ((ti < 2) ? CK_XB : CK_XP); const LAS unsigned char* Ba = BX + ((ti & 1) ? CK_XR : CK_XK);
    f32x16 acc;
#pragma unroll
    for (int i = 0; i < 16; ++i) acc[i] = 0.f;
#pragma unroll
    for (int ks = 0; ks < 4; ++ks) acc = CK_MFMA(ck_frag(Aa, 144, r, 16 * ks + 8 * hh), ck_frag(Ba, 144, r, 16 * ks + 8 * hh), acc);
    if (ti == 0) {
        { const u32x4 z = (u32x4){0u, 0u, 0u, 0u}, w = (u32x4){pkbf(acc[0], acc[1]), pkbf(acc[2], acc[3]), pkbf(acc[4], acc[5]), pkbf(acc[6], acc[7])};
          *(LAS u32x4*)(BT + CK_T12 + r * 80 + 16 * hh) = (r >= 16) ? w : z; }
#pragma unroll
        for (int m = 0; m < 4; ++m) { f32x4 t;
#pragma unroll
            for (int e = 0; e < 4; ++e) t[e] = (8 * m + 4 * hh + e < r) ? acc[4 * m + e] : 0.f;
            *(LAS f32x4*)(BT + CK_TBT + (r * 32 + 8 * m + 4 * hh) * 4) = t; }
    } else { const int off = (ti == 1) ? CK_TBR : ((ti == 2) ? CK_TK : CK_TKR);
#pragma unroll
        for (int m = 0; m < 4; ++m) { float t[4];
#pragma unroll
            for (int e = 0; e < 4; ++e) { const int i = 8 * m + 4 * hh + e; const bool keep = (ti == 2) ? (i < r) : (i <= r); t[e] = keep ? acc[4 * m + e] : 0.f; }
            const int col = (ti == 1) ? (16 * (m >> 1) + 8 * hh + 4 * (m & 1)) : (8 * m + 4 * hh);
            *(LAS u32x2*)(BT + off + r * 80 + col * 2) = (u32x2){pkbf(t[0], t[1]), pkbf(t[2], t[3])}; }
    }
    if (ti == 0) {
        LDS_WAIT();
        const int qb = (r >> 4) & 1;
        const LAS float* TBT = (const LAS float*)(BT + CK_TBT) + (16 * qb) * 32 + 16 * qb;
        float x[16];
        int cc = r & 15; asm volatile("" : "+v"(cc));
#pragma unroll
        for (int k = 0; k < 16; ++k) x[k] = (k == cc) ? 1.f : 0.f;
        { f32x4 tc[4], tn[4];
#pragma unroll
          for (int j4 = 0; j4 < 4; ++j4) tc[j4] = *(const LAS f32x4*)(TBT + 15 * 32 + 4 * j4);
#pragma unroll
          for (int kk = 0; kk < 15; ++kk) { const int k = 15 - kk; const float xk = x[k];
              int off = (k - 1) * 32; asm volatile("" : "+v"(off) : "v"(xk));
              if (k - 1 >= 1) {
#pragma unroll
                  for (int j4 = 0; j4 <= (k - 2) / 4; ++j4) tn[j4] = *(const LAS f32x4*)(TBT + off + 4 * j4); }
#pragma unroll
              for (int j4 = 0; j4 <= (k - 1) / 4; ++j4) {
#pragma unroll
                  for (int e = 0; e < 4; ++e) { const int i = 4 * j4 + e; if (i < k) x[i] = __builtin_fmaf(-tc[j4][e], xk, x[i]); } }
#pragma unroll
              for (int j4 = 0; j4 < 4; ++j4) tc[j4] = tn[j4]; } }
        if (hh == 0) { const u32x4 z = (u32x4){0u, 0u, 0u, 0u};
            const u32x4 w0 = (u32x4){pkbf(x[0], x[1]), pkbf(x[2], x[3]), pkbf(x[8], x[9]), pkbf(x[10], x[11])}, w1 = (u32x4){pkbf(x[4], x[5]), pkbf(x[6], x[7]), pkbf(x[12], x[13]), pkbf(x[14], x[15])};
            LAS unsigned char* row = BT + CK_MT + r * 80;
            *(LAS u32x4*)(row + 32 * qb) = w0; *(LAS u32x4*)(row + 32 * qb + 16) = w1; *(LAS u32x4*)(row + 32 * (1 - qb)) = z; *(LAS u32x4*)(row + 32 * (1 - qb) + 16) = z; }
    }
}
#define CK_BAR() do { asm volatile("s_waitcnt lgkmcnt(0)" ::: "memory"); __builtin_amdgcn_s_barrier(); asm volatile("" ::: "memory"); } while (0)
__device__ __forceinline__ void p4_scan(const Frame& F, int l, int probe = 0) {
#pragma unroll 1
    for (int unit = F.vcu; unit < NBATCH * NHEAD * 2; unit += F.G) {
        const int b = unit >> 5, h = (unit >> 1) & 15, half = unit & 1;
        const bool pre = F.wave >= 4, mainw = F.wave == 0;
        const int r = F.lane & 31, hh = F.lane >> 5;
        constexpr int NBLKc = SEQ / 32;
        const int w_ = F.wave;
        if (w_ == 0) {
            f32x16 ST0, ST1;
#pragma unroll
            for (int i = 0; i < 16; ++i) { ST0[i] = 0.f; ST1[i] = 0.f; }
#pragma unroll 1
            for (int blk = -2; blk < NBLKc; ++blk) {
                const LAS unsigned char* BX = F.lds + CK_X3_OFF + ((blk + 3) % 3) * CK_X3SZ; const LAS unsigned char* BT = F.lds + CK_T2_OFF + (blk & 1) * CK_T2SZ;
                bf16x8 SH[2][2], SL[2][2], NUF[2], VF[2]; f32x16 RH, YT;
                if (blk >= 0 && !(probe & 1)) {
#pragma unroll
                for (int c = 0; c < 2; ++c)
#pragma unroll
                    for (int s = 0; s < 2; ++s) { u32x4 ph, pl;
#pragma unroll
                        for (int p = 0; p < 4; ++p) { const float x0 = (c ? ST1 : ST0)[8 * s + 2 * p], x1 = (c ? ST1 : ST0)[8 * s + 2 * p + 1]; const unsigned hp = pkbf(x0, x1);
                            ph[p] = hp;
#if defined(CK_LO)
                            pl[p] = pkbf(x0 - bflo(hp), x1 - bfhi(hp));
#endif
                        }
                        SH[c][s] = __builtin_bit_cast(bf16x8, ph);
#if defined(CK_LO)
                        SL[c][s] = __builtin_bit_cast(bf16x8, pl);
#endif
                    }
                { LAS f32x4* stash = (LAS f32x4*)(F.lds + CK_STASH) + F.lane;
#pragma unroll
                  for (int m = 0; m < 4; ++m) { stash[64 * m] = (f32x4){ST0[4 * m], ST0[4 * m + 1], ST0[4 * m + 2], ST0[4 * m + 3]}; stash[64 * (4 + m)] = (f32x4){ST1[4 * m], ST1[4 * m + 1], ST1[4 * m + 2], ST1[4 * m + 3]}; } }
                VF[0] = ck_frag(BX + CK_VT, 80, r, 8 * hh); VF[1] = ck_frag(BX + CK_VT, 80, r, 16 + 8 * hh);
#pragma unroll
                for (int i = 0; i < 16; ++i) RH[i] = 0.f;
                { bf16x8 ak[2][2], at[2];
#pragma unroll
                  for (int c = 0; c < 2; ++c)
#pragma unroll
                      for (int s = 0; s < 2; ++s) ak[c][s] = ck_frag(BX + CK_XK, 144, r, 32 * c + 16 * s + 8 * hh);
                  at[0] = ck_frag(BT + CK_TK, 80, r, 8 * hh); at[1] = ck_frag(BT + CK_TK, 80, r, 16 + 8 * hh);
#pragma unroll
                  for (int c = 0; c < 2; ++c)
#pragma unroll
                      for (int s = 0; s < 2; ++s) RH = CK_MFMA(ak[c][s], SH[c][s], RH);
#pragma unroll
                  for (int ks = 0; ks < 2; ++ks) RH = CK_MFMA(at[ks], VF[ks], RH); }
                { const bf16x8 mt0 = ck_frag(BT + CK_MT, 80, r, 8 * hh), mt1 = ck_frag(BT + CK_MT, 80, r, 16 + 8 * hh), t12 = ck_frag(BT + CK_T12, 80, r, 8 * hh);
                  u32x4 p4;
#pragma unroll
                  for (int p = 0; p < 4; ++p) p4[p] = pkbf(RH[2 * p], RH[2 * p + 1]);
                  f32x16 UT;
#pragma unroll
                  for (int i = 0; i < 16; ++i) UT[i] = 0.f;
                  UT = CK_MFMA(mt0, __builtin_bit_cast(bf16x8, p4), UT);
#pragma unroll
                  for (int p = 0; p < 4; ++p) p4[p] = pkbf(UT[2 * p], UT[2 * p + 1]) ^ 0x80008000u;
                  NUF[0] = __builtin_bit_cast(bf16x8, p4);
                  RH = CK_MFMA(t12, NUF[0], RH);
#pragma unroll
                  for (int p = 0; p < 4; ++p) p4[p] = pkbf(RH[8 + 2 * p], RH[8 + 2 * p + 1]);
                  UT = CK_MFMA(mt1, __builtin_bit_cast(bf16x8, p4), UT);
#pragma unroll
                  for (int p = 0; p < 4; ++p) p4[p] = pkbf(UT[8 + 2 * p], UT[8 + 2 * p + 1]) ^ 0x80008000u;
                  NUF[1] = __builtin_bit_cast(bf16x8, p4); }
#pragma unroll
                for (int i = 0; i < 16; ++i) YT[i] = 0.f;
                { bf16x8 ar[2][2];
#pragma unroll
                  for (int c = 0; c < 2; ++c)
#pragma unroll
                      for (int s = 0; s < 2; ++s) ar[c][s] = ck_frag(BX + CK_XR, 144, r, 32 * c + 16 * s + 8 * hh);
#pragma unroll
                  for (int c = 0; c < 2; ++c)
#pragma unroll
                      for (int s = 0; s < 2; ++s) YT = CK_MFMA(ar[c][s], SH[c][s], YT); }
                VF[0] = ck_frag(BX + CK_VT, 80, r, 8 * hh); VF[1] = ck_frag(BX + CK_VT, 80, r, 16 + 8 * hh);
                asm volatile("" ::: "memory");
#pragma unroll
                for (int ks = 0; ks < 2; ++ks) { const bf16x8 fbr = ck_frag(BT + CK_TBR, 80, r, 16 * ks + 8 * hh), fkr = ck_frag(BT + CK_TKR, 80, r, 16 * ks + 8 * hh); YT = CK_MFMA(fbr, NUF[ks], YT); YT = CK_MFMA(fkr, VF[ks], YT); }
                { bf16* yo = (bf16*)(F.ws + WS_YCK) + ((size_t)b * SEQ + blk * 32) * 1024 + h * 64 + half * 32 + r;
#pragma unroll
                  for (int reg = 0; reg < 16; ++reg) yo[(size_t)((reg & 3) + 8 * (reg >> 2) + 4 * hh) * 1024] = (bf16)f2bf(YT[reg]); }
                { const LAS f32x4* stash = (const LAS f32x4*)(F.lds + CK_STASH) + F.lane;
#pragma unroll
                  for (int m = 0; m < 4; ++m) { const f32x4 g0 = *(const LAS f32x4*)(BX + CK_GB + (8 * m + 4 * hh) * 4), g1 = *(const LAS f32x4*)(BX + CK_GB + (32 + 8 * m + 4 * hh) * 4);
                    const f32x4 a0 = stash[64 * m] * g0, a1 = stash[64 * (4 + m)] * g1;
#pragma unroll
                    for (int e = 0; e < 4; ++e) { ST0[4 * m + e] = a0[e]; ST1[4 * m + e] = a1[e]; } } }
#pragma unroll
                for (int ks = 0; ks < 2; ++ks) {
                    const bf16x8 b0 = ck_frag(BX + CK_BH, 80, r, 16 * ks + 8 * hh), b1 = ck_frag(BX + CK_BH, 80, 32 + r, 16 * ks + 8 * hh), k0 = ck_frag(BX + CK_KH, 80, r, 16 * ks + 8 * hh), k1 = ck_frag(BX + CK_KH, 80, 32 + r, 16 * ks + 8 * hh);
                    ST0 = CK_MFMA(b0, NUF[ks], ST0); ST1 = CK_MFMA(b1, NUF[ks], ST1); ST0 = CK_MFMA(k0, VF[ks], ST0); ST1 = CK_MFMA(k1, VF[ks], ST1); }
                }
                CK_BAR();
            }
        } else if (w_ >= 1 && w_ <= 4) {
            const int pw = w_ - 1;
            CkConst CC;
            { const int c = l * 1024 + h * 64 + 16 * pw + 4 * (F.lane & 3); const float* mu = kin<I_MU>() + l * N_SHIFT + h * 64 + 16 * pw + 4 * (F.lane & 3);
              CC.a0 = *(const f32x4*)(kin<I_A0>() + c); CC.kk = *(const f32x4*)(kin<I_KK>() + c); CC.ka = *(const f32x4*)(kin<I_KA>() + c); CC.rk = *(const f32x4*)(kin<I_RK>() + c); CC.w0 = *(const f32x4*)(kin<I_W0>() + c);
              CC.v0 = (l == 1) ? *(const f32x4*)(kin<I_V0>() + (c - 1024)) : (f32x4){0.f, 0.f, 0.f, 0.f}; CC.mur = *(const f32x4*)mu; CC.muk = *(const f32x4*)(mu + 1024); CC.muv = *(const f32x4*)(mu + 2048); }
            CkRegs CR;
            ck_issue(F, pw, l, b, h, half, 0, CR);
#pragma unroll 1
            for (int blk = -2; blk < NBLKc; ++blk) {
                if (blk + 2 < NBLKc && !(probe & 4) && !((probe & 16) && w_ == 4)) ck_stage1(F, pw, l, b, h, half, blk + 2, CC, F.lds + CK_X3_OFF + ((blk + 2 + 3) % 3) * CK_X3SZ, F.lds + CK_P2_OFF + ((blk + 2) & 1) * CK_P2SZ, CR, blk + 3 < NBLKc);
                CK_BAR();
            }
        } else {
#pragma unroll 1
            for (int blk = -2; blk < NBLKc; ++blk) {
                if (blk + 1 >= 0 && blk + 1 < NBLKc) {
                    const LAS unsigned char* BX = F.lds + CK_X3_OFF + ((blk + 1 + 3) % 3) * CK_X3SZ; const LAS unsigned char* BP = F.lds + CK_P2_OFF + ((blk + 1) & 1) * CK_P2SZ; LAS unsigned char* BT = F.lds + CK_T2_OFF + ((blk + 1) & 1) * CK_T2SZ;
                    if (w_ == 5) { if (!(probe & 2)) ck_stage2(F, 0, BX, BP, BT); }
                    else if (probe & 8) {}
                    else if (w_ == 6) { ck_stage2(F, 1, BX, BP, BT); ck_stage2(F, 3, BX, BP, BT); }
                    else ck_stage2(F, 2, BX, BP, BT);
                }
                CK_BAR();
            }
        }
    }
}

__device__ __forceinline__ void p5_post(const Frame& F, int l) {
    const int lane = F.lane;
    const float* const pCW = kin<I_CONVW>() + l * 3 * 1024; const float* const pLNW = kin<I_LNW>() + l * 1024; const float* const pLNB = kin<I_LNB>() + l * 1024;
    const bf16* P = (const bf16*)(F.ws + WS_P); const bf16* Y = (const bf16*)(F.ws + WS_Y); const bf16* LRg = (const bf16*)(F.ws + WS_LR) + 2048;
    const bf16* V = (const bf16*)(F.ws + (l == 0 ? WS_V0 : WS_V1)); const float* BONP = (const float*)(F.ws + WS_BONP); bf16* M = (bf16*)(F.ws + WS_H);
#pragma unroll 1
    for (int gw = F.vcu * NWAVES + F.wave; gw < T / 8; gw += F.G * NWAVES) { const int tok0 = gw * 8;
#pragma unroll 1
    for (int ch = 0; ch < 2; ++ch) { const int col0 = 512 * ch + 8 * lane, head = 8 * ch + (lane >> 3);
        float cw0[8], cw1[8], cw2[8], lnw[8], lnb[8], um1[8], um2[8];
#pragma unroll
        for (int j = 0; j < 8; ++j) { cw0[j] = pCW[col0 + j]; cw1[j] = pCW[1024 + col0 + j]; cw2[j] = pCW[2048 + col0 + j];
            lnw[j] = pLNW[col0 + j]; lnb[j] = pLNB[col0 + j]; um1[j] = 0.f; um2[j] = 0.f; }
        const int t0 = tok0 & (SEQ - 1);
        if (t0 >= 1) { float c1[8], c2[8]; load8(P + (size_t)(tok0 - 1) * P_LD + C_CC + col0, c1); load8(P + (size_t)(tok0 - 1) * P_LD + C_CH + col0, c2);
#pragma unroll
            for (int j = 0; j < 8; ++j) um1[j] = c1[j] * c2[j]; }
        if (t0 >= 2) { float c1[8], c2[8]; load8(P + (size_t)(tok0 - 2) * P_LD + C_CC + col0, c1); load8(P + (size_t)(tok0 - 2) * P_LD + C_CH + col0, c2);
#pragma unroll
            for (int j = 0; j < 8; ++j) um2[j] = c1[j] * c2[j]; }
#pragma unroll 2
        for (int tk = 0; tk < 8; ++tk) { const int tok = tok0 + tk; const bf16* pr = P + (size_t)tok * P_LD + col0;
            float c1[8], c2[8], cb[8], ga[8], gb[8], y[8], v[8], g[8], o[8];
            load8(pr + C_CC, c1); load8(pr + C_CH, c2); load8(pr + C_CB, cb); load8(pr + C_GA, ga); load8(pr + C_GB, gb);
            load8(Y + (size_t)tok * 1024 + col0, y); load8h(V + (size_t)tok * 1024 + col0, v); load8(LRg + (size_t)tok * 3072 + col0, g);
            const f32x4 bo4 = *(const f32x4*)(BONP + ((size_t)tok * 16 + head) * 4); const float bo = (bo4[0] + bo4[1]) + (bo4[2] + bo4[3]);
            float sm = 0.f;
#pragma unroll
            for (int j = 0; j < 8; ++j) sm += y[j];
            const float mean = sum8(sm) * (1.0f / 64.0f); float sq = 0.f;
#pragma unroll
            for (int j = 0; j < 8; ++j) { y[j] -= mean; sq += y[j] * y[j]; }
            const float rstd = __builtin_amdgcn_rsqf(sum8(sq) * (1.0f / 64.0f) + LNX_EPS);
#pragma unroll
            for (int j = 0; j < 8; ++j) { const float u = c1[j] * c2[j]; const float conv = cw0[j] * um2[j] + cw1[j] * um1[j] + cw2[j] * u; um2[j] = um1[j]; um1[j] = u;
                const float yconv = cb[j] * conv; const float yr = ((y[j] * rstd) * lnw[j] + lnb[j] + bo * v[j]) * g[j];
                o[j] = sigmoidf_(ga[j]) * yconv + sigmoidf_(gb[j]) * yr; }
            store8(M + (size_t)tok * 1024 + col0, o); }
    }
    }
}

struct GroupPick { float score, a1, a2; int i1, i2; };
__device__ __forceinline__ GroupPick pick_group(const f32x4 acc, float rstd, const float* br, const float* rb) {
    float aff[4], sel[4];
#pragma unroll
    for (int j = 0; j < 4; ++j) { aff[j] = sigmoidf_(rstd * acc[j] + br[j]); sel[j] = aff[j] + rb[j]; }
    int i1 = 0;
#pragma unroll
    for (int j = 1; j < 4; ++j) if (sel[j] > sel[i1]) i1 = j;
    int i2 = (i1 == 0) ? 1 : 0;
#pragma unroll
    for (int j = 0; j < 4; ++j) if (j != i1 && j != i2 && sel[j] > sel[i2]) i2 = j;
    GroupPick g; g.score = sel[i1] + sel[i2]; g.i1 = i1; g.i2 = i2; g.a1 = aff[i1]; g.a2 = aff[i2];
    float s1 = sel[0], s2 = sel[0]; (void)s1; (void)s2;
    return g;
}
__device__ __forceinline__ void p7_route(const Frame& F, int l, bool dry = false) {
    const int lane = F.lane, li = lane & 15, fq = lane >> 4, w = F.wave;
    LAS float* part = (LAS float*)F.lds;
    LAS float* gml = (LAS float*)(F.lds + 32768);
    LAS unsigned* lcnt = (LAS unsigned*)(F.lds + 65536);
    const float* X = (const float*)(F.ws + WS_X); const bf16* WH = (const bf16*)(F.ws + WS_WRT); const bf16* WL = WH + 32768; const float* const pN2G = kin<I_N2G>() + l * 1024; const float* const pRB = kin<I_RB>();
#pragma unroll 1
    for (int grp = F.vcu; grp < T / 64; grp += F.G) { const int b = grp >> 5;
        if (F.tid < 32) lcnt[F.tid] = 0u;
        { const float* ad = ada_ptr(F, l, b) + 4096; const int c = 2 * F.tid; const f32x2 g = *(const f32x2*)(pN2G + c), s = *(const f32x2*)(ad + c); gml[c] = g.x * (1.0f + s.x); gml[c + 1] = g.y * (1.0f + s.y); }
        bfv8 ah0[4], al0[4], ah1[4], al1[4];
        { const bf16* wh0 = WH + li * 1024 + 128 * w + 8 * fq; const bf16* wl0 = WL + li * 1024 + 128 * w + 8 * fq;
#pragma unroll
          for (int s = 0; s < 4; ++s) { ah0[s] = *(const bfv8*)(wh0 + 32 * s); al0[s] = *(const bfv8*)(wl0 + 32 * s); ah1[s] = *(const bfv8*)(wh0 + 16 * 1024 + 32 * s); al1[s] = *(const bfv8*)(wl0 + 16 * 1024 + 32 * s); } }
        __syncthreads();
#pragma unroll 1
        for (int it = 0; it < 4; ++it) { const int tok0 = grp * 64 + it * 16;
            const float* xp = X + (size_t)(tok0 + li) * 1024 + 128 * w + 8 * fq;
            f32x4 xa[4], xb[4];
#pragma unroll
            for (int s = 0; s < 4; ++s) { xa[s] = *(const f32x4*)(xp + 32 * s); xb[s] = *(const f32x4*)(xp + 32 * s + 4); }
            f32x4 acc0 = (f32x4){0.f, 0.f, 0.f, 0.f}, acc1 = acc0; float ssq = 0.f;
#pragma unroll
            for (int s = 0; s < 4; ++s) {
                const f32x4 ga = *(const LAS f32x4*)(gml + 128 * w + 32 * s + 8 * fq), gb = *(const LAS f32x4*)(gml + 128 * w + 32 * s + 8 * fq + 4);
                ssq += ((xa[s][0] * xa[s][0] + xa[s][1] * xa[s][1]) + (xa[s][2] * xa[s][2] + xa[s][3] * xa[s][3])) + ((xb[s][0] * xb[s][0] + xb[s][1] * xb[s][1]) + (xb[s][2] * xb[s][2] + xb[s][3] * xb[s][3]));
                const f32x4 ya = xa[s] * ga, yb = xb[s] * gb;
                u32x4 ph, pl;
                ph[0] = pkbf(ya[0], ya[1]); ph[1] = pkbf(ya[2], ya[3]); ph[2] = pkbf(yb[0], yb[1]); ph[3] = pkbf(yb[2], yb[3]);
                pl[0] = pkbf(ya[0] - bflo(ph[0]), ya[1] - bfhi(ph[0])); pl[1] = pkbf(ya[2] - bflo(ph[1]), ya[3] - bfhi(ph[1])); pl[2] = pkbf(yb[0] - bflo(ph[2]), yb[1] - bfhi(ph[2])); pl[3] = pkbf(yb[2] - bflo(ph[3]), yb[3] - bfhi(ph[3]));
                const bfv8 bh = __builtin_bit_cast(bfv8, ph), bl = __builtin_bit_cast(bfv8, pl);
                acc0 = __builtin_amdgcn_mfma_f32_16x16x32_bf16(ah0[s], bh, acc0, 0, 0, 0); acc0 = __builtin_amdgcn_mfma_f32_16x16x32_bf16(al0[s], bh, acc0, 0, 0, 0); acc0 = __builtin_amdgcn_mfma_f32_16x16x32_bf16(ah0[s], bl, acc0, 0, 0, 0);
                acc1 = __builtin_amdgcn_mfma_f32_16x16x32_bf16(ah1[s], bh, acc1, 0, 0, 0); acc1 = __builtin_amdgcn_mfma_f32_16x16x32_bf16(al1[s], bh, acc1, 0, 0, 0); acc1 = __builtin_amdgcn_mfma_f32_16x16x32_bf16(ah1[s], bl, acc1, 0, 0, 0);
            }
            ssq += __shfl_xor(ssq, 16); ssq += __shfl_xor(ssq, 32);
            { LAS float* pp = part + (w * 16 + li) * 36; *(LAS f32x4*)(pp + 4 * fq) = acc0; *(LAS f32x4*)(pp + 16 + 4 * fq) = acc1; if (fq == 0) pp[32] = ssq; }
            __syncthreads();
            if (w == 0) {
                f32x4 a0 = (f32x4){0.f, 0.f, 0.f, 0.f}, a1 = a0; float sq = 0.f;
#pragma unroll
                for (int ww = 0; ww < 8; ++ww) { const LAS float* q = part + (ww * 16 + li) * 36; a0 += *(const LAS f32x4*)(q + 4 * fq); a1 += *(const LAS f32x4*)(q + 16 + 4 * fq); sq += q[32]; }
                const float rstd = __builtin_amdgcn_rsqf(sq * (1.0f / 1024.0f) + NORM_EPS);
                const float* br = (const float*)(F.ws + WS_CTL + CTL_BIASR) + (l * 8 + b) * 32;
                const GroupPick ga_ = pick_group(a0, rstd, br + 4 * fq, pRB + 4 * fq), gb_ = pick_group(a1, rstd, br + 16 + 4 * fq, pRB + 16 + 4 * fq);
                const bool useb = gb_.score > ga_.score;
                const GroupPick gm = useb ? gb_ : ga_; const int mygrp = useb ? 4 + fq : fq;
                float bs = gm.score; int bg = mygrp;
#pragma unroll
                for (int off = 16; off < 64; off <<= 1) { const float os = __shfl_xor(bs, off); const int og = __shfl_xor(bg, off); if (os > bs || (os == bs && og < bg)) { bs = os; bg = og; } }
                if (mygrp == bg) { const int tok = tok0 + li; const int e0 = 4 * bg + gm.i1, e1 = 4 * bg + gm.i2; const float inv = 1.0f / (gm.a1 + gm.a2);
                    const int p0 = (int)__hip_atomic_fetch_add(lcnt + e0, 1u, __ATOMIC_RELAXED, __HIP_MEMORY_SCOPE_WORKGROUP), p1 = (int)__hip_atomic_fetch_add(lcnt + e1, 1u, __ATOMIC_RELAXED, __HIP_MEMORY_SCOPE_WORKGROUP);
                    int* EI = (int*)(F.ws + WS_EIDX); int* PO = (int*)(F.ws + WS_POS); float* WT = (float*)(F.ws + WS_WTS);
                    if (!dry) { EI[tok * 2] = e0; EI[tok * 2 + 1] = e1; PO[tok * 2] = p0; PO[tok * 2 + 1] = p1; WT[tok * 2] = gm.a1 * inv; WT[tok * 2 + 1] = gm.a2 * inv; } }
            }
            __syncthreads();
        }
        if (F.tid < 32 && !dry) ((int*)(F.ws + WS_HIST))[(l * 256 + grp) * 32 + F.tid] = (int)lcnt[F.tid];
        __syncthreads();
    }
}

__device__ __forceinline__ void expert_table(const Frame& F, int l, int grp = -1) {
    LAS int* tab = (LAS int*)(F.lds + TAB_OFF); LAS int* red = (LAS int*)F.lds;
    const int* hist = (const int*)(F.ws + WS_HIST) + l * 256 * 32; const int e = F.tid & 31, part = F.tid >> 5;
    int tot = 0, pre = 0;
    { int hv[16];
#pragma unroll
      for (int i = 0; i < 16; ++i) hv[i] = hist[(part * 16 + i) * 32 + e];
#pragma unroll
      for (int i = 0; i < 16; ++i) { tot += hv[i]; pre += (part * 16 + i < grp) ? hv[i] : 0; } }
    red[part * 32 + e] = tot; red[512 + part * 32 + e] = pre;
    __syncthreads();
    if (F.tid < 64) { int c = 0, pr = 0;
#pragma unroll
        for (int p = 0; p < 16; ++p) { c += red[p * 32 + e]; pr += red[512 + p * 32 + e]; }
        const int padded = (c + 255) & ~255; int inc = padded;
#pragma unroll
        for (int o = 1; o < 32; o <<= 1) { const int v = __shfl_up(inc, o); if (e >= o) inc += v; }
        if (F.lane < 32) { tab[e] = inc - padded; tab[33 + e] = (inc - padded) >> 8; tab[66 + e] = inc - padded + pr; if (e == 31) { tab[32] = inc; tab[65] = inc >> 8; } } }
    __syncthreads();
}

__device__ __forceinline__ void p8_dispatch(const Frame& F, int l) {
    const LAS int* tab = (const LAS int*)(F.lds + TAB_OFF);
    const float* const pN2G = kin<I_N2G>() + l * 1024;
    const int lane = F.lane;
#pragma unroll 1
    for (int gw = F.vcu * NWAVES + F.wave; gw < T / 8; gw += F.G * NWAVES) { const int tok0 = gw * 8, b = tok0 >> 11;
        expert_table(F, l, gw >> 3);
        const float* ad = ada_ptr(F, l, b); f32x4 gm[4], sh[4];
#pragma unroll
        for (int j = 0; j < 4; ++j) { const int c = 4 * lane + 256 * j; gm[j] = *(const f32x4*)(pN2G + c) * (1.0f + *(const f32x4*)(ad + 4096 + c)); sh[j] = *(const f32x4*)(ad + 3072 + c); }
        const float* X = (const float*)(F.ws + WS_X); const int* EI = (const int*)(F.ws + WS_EIDX); const int* PO = (const int*)(F.ws + WS_POS); int* SL = (int*)(F.ws + WS_SLOT); bf16* BUF = (bf16*)(F.ws + WS_BUF);
#pragma unroll 1
        for (int tb = 0; tb < 8; tb += 4) {
            f32x4 v[4][4]; int e0[4], e1[4], q0[4], q1[4]; float ss[4];
#pragma unroll
            for (int t = 0; t < 4; ++t) { const int tok = tok0 + tb + t;
#pragma unroll
                for (int j = 0; j < 4; ++j) v[t][j] = *(const f32x4*)(X + (size_t)tok * 1024 + 4 * lane + 256 * j);
                e0[t] = EI[tok * 2]; e1[t] = EI[tok * 2 + 1]; q0[t] = PO[tok * 2]; q1[t] = PO[tok * 2 + 1]; }
#pragma unroll
            for (int t = 0; t < 4; ++t) { ss[t] = 0.f;
#pragma unroll
                for (int j = 0; j < 4; ++j) ss[t] += (v[t][j][0] * v[t][j][0] + v[t][j][1] * v[t][j][1]) + (v[t][j][2] * v[t][j][2] + v[t][j][3] * v[t][j][3]); }
#pragma unroll
            for (int o = 1; o < 64; o <<= 1) {
#pragma unroll
                for (int t = 0; t < 4; ++t) ss[t] += __shfl_xor(ss[t], o); }
#pragma unroll
            for (int t = 0; t < 4; ++t) { const int tok = tok0 + tb + t;
                const float rstd = __builtin_amdgcn_rsqf(ss[t] * (1.0f / 1024.0f) + NORM_EPS);
                const int s0 = tab[66 + e0[t]] + q0[t], s1 = tab[66 + e1[t]] + q1[t];
                if (lane == 0) { SL[tok * 2] = s0; SL[tok * 2 + 1] = s1; }
#pragma unroll
                for (int j = 0; j < 4; ++j) { const f32x4 h = v[t][j] * rstd * gm[j] + sh[j]; u32x2 w; w.x = pk2(h[0], h[1]); w.y = pk2(h[2], h[3]);
                    *(u32x2*)(BUF + (size_t)s0 * 1024 + 4 * lane + 256 * j) = w; *(u32x2*)(BUF + (size_t)s1 * 1024 + 4 * lane + 256 * j) = w; } }
        }
    }
}

#ifndef PHMASK
#define PHMASK 0xFFFF
#endif
#define PHM(n) (((PHMASK) >> (n)) & 1)
constexpr int NPHASES = 23;
__global__ void __launch_bounds__(NWAVES * 64, 2) trunk_fwd(Args args) {
    extern __shared__ __attribute__((aligned(16))) unsigned char lds_raw[];
    Frame F;
    F.lds = (LAS unsigned char*)lds_raw;
    F.tid = threadIdx.x; F.lane = F.tid & 63; F.wave = __builtin_amdgcn_readfirstlane(F.tid >> 6);
    F.G = gridDim.x; { const int bx = blockIdx.x; F.vcu = (F.G % 8 == 0) ? (bx % 8) * (F.G / 8) + bx / 8 : bx; }
    GAS unsigned char* const wsbase = (GAS unsigned char*)kin<29>(); F.ws = wsbase; const int vcu0 = F.vcu;
    volatile LAS unsigned* MISC = (volatile LAS unsigned*)(F.lds + MISC_OFF);
    if (F.tid < 32) MISC[F.tid] = 0u;
    __syncthreads();
    const unsigned long long lohi = (unsigned long long)kin<30>(); const int lo = (int)(unsigned)lohi, hi = (int)(unsigned)(lohi >> 32);
    XcdBarrier bar; bar.bar = (unsigned*)(F.ws + WS_CTL) + CW_BAR; bar.x = 0; bar.st = nullptr;
    if (hi - lo > 1) bar = xcd_barrier_post((unsigned*)(F.ws + WS_CTL) + CW_BAR, MISC + 8);
#pragma unroll 1
#if defined(REP_PH)
    for (int phx = lo; phx < hi + REP_N; ++phx) { const int ph = (phx < REP_PH) ? phx : ((phx < REP_PH + REP_N) ? REP_PH : phx - REP_N);
        const bool probe_run = (phx >= REP_PH && phx < REP_PH + REP_N); (void)probe_run;
#else
    for (int ph = lo; ph < hi; ++ph) {
#endif
        { int t_ = threadIdx.x; asm volatile("" : "+v"(t_)); F.tid = t_; F.lane = t_ & 63; F.wave = __builtin_amdgcn_readfirstlane(t_ >> 6);
          GAS unsigned char* w_ = wsbase; asm volatile("" : "+s"(w_)); F.ws = w_; int v_ = vcu0; asm volatile("" : "+s"(v_)); F.vcu = v_; }
        const int l = (ph - 2) / 10, k = (ph >= 2 && ph <= 21) ? (ph - 2) % 10 : -1;
        if (PHM(0) && ph == 0) p0_prologue(F);
        else if (PHM(0) && ph == 1) p0b_ada_reduce(F);
        else if (PHM(1) && ph == 22) p1_norm<2>(F, 1);
        else if (PHM(1) && k == 0) { if (l == 0) p1_norm<0>(F, 0); else p1_norm<1>(F, 1); }
        else if (PHM(3) && k == 2) p2x_lowrank(F, l);
#if defined(REP_PH) && defined(REP_DRY)
        else if (PHM(4) && k == 3) p4_scan(F, l, probe_run ? REP_DRY : 0);
#else
        else if (PHM(4) && k == 3) p4_scan(F, l);
#endif
        else if (PHM(5) && k == 4) p5_post(F, l);
        #if defined(REP_PH)
        else if (PHM(7) && k == 6) p7_route(F, l, probe_run);
#else
        else if (PHM(7) && k == 6) p7_route(F, l);
#endif
        else if (PHM(8) && k == 7) p8_dispatch(F, l);
        else if (PHM(2) && (k == 1 || k == 5 || k == 8 || k == 9)) {
            pg8::Gemm g; pg8::UniOrder S; pg8::EpiUni E;
            S.expert = (k >= 8); S.so.init(T, 1024, F.G, (int)blockIdx.x); S.eo = pg8::ExpertOrder{(const PG8_LAS int*)(F.lds + TAB_OFF + 33 * 4), 0, F.G, (int)blockIdx.x};
            E.e0 = pg8::EpiBf16Plain{(bf16*)(F.ws + WS_P), P_LD, -1}; E.e1 = pg8::EpiResid{nullptr, (float*)(F.ws + WS_X), ada_ptr(F, l, 0) + 2048, 6144}; E.e2 = pg8::EpiSwiGLU{(bf16*)(F.ws + WS_HB)};
            if (k == 1) {
                const int N = (l == 0) ? N_IN : N_IN1; S.so.init(T, N, F.G, (int)blockIdx.x); E.mode = 0;
                g = pg8::Gemm{(const bf16*)(F.ws + WS_H), (const bf16*)(F.ws + WS_BT_IN) + (size_t)l * P_LD * 1024, T, N, 1024};
            } else if (k == 5) {
                E.mode = 1; E.e1.xin = (l == 0) ? kin<I_X>() : (const float*)(F.ws + WS_X);
                g = pg8::Gemm{(const bf16*)(F.ws + WS_H), (const bf16*)(F.ws + WS_BT_OUT) + (size_t)l * 1024 * 1024, T, 1024, 1024};
            } else {
                expert_table(F, l);
                S.eo.ntiles = ((const LAS int*)(F.lds + TAB_OFF))[65];
                if (k == 8) { E.mode = 2; g = pg8::Gemm{(const bf16*)(F.ws + WS_BUF), (const bf16*)(F.ws + WS_BT_E1) + (size_t)l * 32 * 1024 * 1024, MAXROWS, 32 * 1024, 1024}; }
                else { E.mode = 0; E.e0 = pg8::EpiBf16Plain{(bf16*)(F.ws + WS_YE), 1024, 3}; g = pg8::Gemm{(const bf16*)(F.ws + WS_HB), (const bf16*)(F.ws + WS_BT_E2) + (size_t)l * 32 * 1024 * 512, MAXROWS, 32 * 1024, 512}; }
            }
#if defined(REP_PH) && defined(REP_DRY)
            if (probe_run) E.mode = 3;
#endif
            pg8::gemm_phase<pg8::EpiUni, pg8::UniOrder, true, true>(F.lds, g, S, E);
        }
#if defined(REP_PH)
        if (phx + 1 < hi + REP_N) xcd_barrier(bar);
#else
        if (ph + 1 < hi) xcd_barrier(bar);
#endif
    }
}

extern "C" void kernel_launch(void* const* d_in, const int* in_sizes, int n_in, void* d_out, int out_size, void* d_ws, size_t ws_size, hipStream_t stream) {
    static int grid = 0;
    if (grid == 0) {
        if (n_in != 28 || in_sizes[0] != T * D || out_size != T * D || ws_size < WS_END) { fprintf(stderr, "kernel_launch: unexpected shapes (n_in %d, in0 %d, out %d, ws %zu < %zu?); nothing launched\n", n_in, n_in > 0 ? in_sizes[0] : -1, out_size, ws_size, (size_t)WS_END); grid = -1; return; }
        int dev = 0, cus = 0, per_cu = 0;
        if (hipGetDevice(&dev) != hipSuccess || hipDeviceGetAttribute(&cus, hipDeviceAttributeMultiprocessorCount, dev) != hipSuccess) { fprintf(stderr, "kernel_launch: device query failed\n"); grid = -1; return; }
        if (hipFuncSetAttribute((const void*)trunk_fwd, hipFuncAttributeMaxDynamicSharedMemorySize, LDS_BYTES) != hipSuccess) { fprintf(stderr, "kernel_launch: hipFuncSetAttribute failed\n"); grid = -1; return; }
        if (hipOccupancyMaxActiveBlocksPerMultiprocessor(&per_cu, (const void*)trunk_fwd, NWAVES * 64, LDS_BYTES) != hipSuccess || per_cu < 1) { fprintf(stderr, "kernel_launch: occupancy query says %d blocks per CU\n", per_cu); }
        (void)hipGetLastError();
        grid = cus;
    }
    if (grid < 0) return;
    if (hipMemsetAsync((char*)d_ws + WS_CTL, 0, CTL_ZERO_BYTES, stream) != hipSuccess) { fprintf(stderr, "kernel_launch: memset failed\n"); return; }
    Args a{};
    for (int i = 0; i < 28; ++i) a.p[i] = d_in[i];
    a.p[28] = d_out; a.p[29] = d_ws;
#if MK_ONE_LAUNCH
    a.ph_lo = 0; a.ph_hi = NPHASES;
    void* kargs[] = {&a};
    hipError_t e = hipLaunchCooperativeKernel((const void*)trunk_fwd, dim3(grid), dim3(NWAVES * 64), kargs, LDS_BYTES, stream);
    if (e != hipSuccess) fprintf(stderr, "kernel_launch: cooperative launch failed: %s (grid %d)\n", hipGetErrorString(e), grid);
#else
    for (int p = 0; p < NPHASES; ++p) { a.ph_lo = p; a.ph_hi = p + 1;
        hipLaunchKernelGGL(trunk_fwd, dim3(grid), dim3(NWAVES * 64), LDS_BYTES, stream, a);
        const hipError_t le = hipPeekAtLastError(); if (le != hipSuccess) { fprintf(stderr, "kernel_launch: launch %d failed: %s\n", p, hipGetErrorName(le)); break; } }
#endif
}
```

```cpp
#include <hip/hip_runtime.h>
#include <cstdio>
#include <cstdint>

#ifndef MK_ONE_LAUNCH
#define MK_ONE_LAUNCH 1
#endif

namespace pg8 {
#define PG8_LAS __attribute__((address_space(3)))
typedef unsigned short bf16_t;
typedef short bf16x8 __attribute__((ext_vector_type(8)));
typedef float f32x4 __attribute__((ext_vector_type(4)));
typedef unsigned u32x4 __attribute__((ext_vector_type(4)));
constexpr int BM = 256, BK = 64, HALF = 128, HTB = HALF * BK * 2  , STAGE_BYTES = 8 * HTB, NXCD = 8, WGM = 8;

__host__ __device__ __forceinline__ int lds_byte(int r, int c) { const int st = (r >> 4) * 2 + (c >> 5), rr = r & 15, cc = c & 31, ob = rr * 64 + cc * 2; return st * 1024 + (ob ^ (((ob >> 9) & 1) << 5)); }
__host__ __device__ __forceinline__ void stage_rc(int b, int& R, int& C) { const int st = b / 1024, sb = b % 1024, swz = sb ^ (((sb >> 9) & 1) << 5); R = (st >> 1) * 16 + swz / 64; C = (st & 1) * 32 + (swz % 64) / 2; }
__host__ __device__ __forceinline__ int perm32(int rho) { const int n = rho >> 4, i = rho & 15; return 8 * (i >> 2) + 4 * n + (i & 3); }

struct Unit { int pm, pn; };
struct Gemm { const bf16_t* A; const bf16_t* Bt; int M, N, K; };

struct StaticOrder {
    int nM, nN, nwg, G, c;
    __host__ __device__ void init(int M, int N, int G_, int c_) { nM = M / BM; nN = N / BM; nwg = nM * nN; G = G_; c = c_; }
    __host__ __device__ bool next(int i, Unit& u) const {
        const long L = (long)i * G + c; if (L >= nwg) return false;
        int wgid = (int)L; { const int q = nwg / NXCD, r = nwg % NXCD, xcd = wgid % NXCD, off = wgid / NXCD; wgid = (xcd < r ? xcd * (q + 1) : r * (q + 1) + (xcd - r) * q) + off; }
        const int nig = WGM * nN, gid = wgid / nig, fm = gid * WGM, gsz = (nM - fm) < WGM ? (nM - fm) : WGM;
        u.pm = fm + ((wgid % nig) % gsz); u.pn = (wgid % nig) / gsz; return true;
    }
    __device__ __forceinline__ void a_ready(const Unit&) const {}
    __device__ __forceinline__ void done(const Unit&) const {}
};
__device__ __forceinline__ unsigned cvt_pk_bf16(float lo, float hi) { unsigned r; asm volatile("v_cvt_pk_bf16_f32 %0, %1, %2" : "=v"(r) : "v"(lo), "v"(hi)); return r; }
typedef float f32x2 __attribute__((ext_vector_type(2)));
typedef unsigned u32x2 __attribute__((ext_vector_type(2)));

struct EpiBf16Plain {
    static constexpr bool PERM = true, AFTER_DRAIN = false;
    bf16_t* O; int ldc; int cmask; int npair; int cbase;
    __device__ __forceinline__ void operator()(const f32x4 (&acc)[2][2][4][2], const Unit& u, int wr, int wc, int fr, int fq) const {
        const int row0 = u.pm * BM + wr * 64 + fr;
        if (u.pn < npair) { const int col0 = u.pn * HALF + wc * 32 + 8 * fq; const bool gated = u.pn >= 8;
#pragma unroll
            for (int ai = 0; ai < 2; ++ai)
#pragma unroll
                for (int m = 0; m < 4; ++m) { float f[8];
#pragma unroll
                    for (int n = 0; n < 2; ++n)
#pragma unroll
                        for (int j = 0; j < 4; ++j) { const float a = acc[ai][0][m][n][j], b = acc[ai][1][m][n][j]; f[4 * n + j] = a * (gated ? __builtin_amdgcn_rcpf(1.0f + __expf(-b)) : b); }
                    u32x4 w; w.x = cvt_pk_bf16(f[0], f[1]); w.y = cvt_pk_bf16(f[2], f[3]); w.z = cvt_pk_bf16(f[4], f[5]); w.w = cvt_pk_bf16(f[6], f[7]);
                    *(u32x4*)(O + (size_t)(row0 + ai * HALF + m * 16) * ldc + col0) = w; }
            return; }
        const int col0 = cbase + ((u.pn - npair) & cmask) * BM + wc * 32 + 8 * fq;
#pragma unroll
        for (int ai = 0; ai < 2; ++ai)
#pragma unroll
            for (int m = 0; m < 4; ++m) { bf16_t* rowp = O + (size_t)(row0 + ai * HALF + m * 16) * ldc + col0;
#pragma unroll
                for (int bj = 0; bj < 2; ++bj) { const f32x4 v0 = acc[ai][bj][m][0], v1 = acc[ai][bj][m][1];
                    u32x4 w; w.x = cvt_pk_bf16(v0[0], v0[1]); w.y = cvt_pk_bf16(v0[2], v0[3]); w.z = cvt_pk_bf16(v1[0], v1[1]); w.w = cvt_pk_bf16(v1[2], v1[3]);
                    *(u32x4*)(rowp + bj * HALF) = w; } }
    }
};
struct EpiResid {
    static constexpr bool PERM = false, AFTER_DRAIN = false;
    const float* xin; float* xout; const float* gate;
    int gstride;
    __device__ __forceinline__ void operator()(const f32x4 (&acc)[2][2][4][2], const Unit& u, int wr, int wc, int fr, int fq) const {
        const int row0 = u.pm * BM + wr * 64 + fr, col0 = u.pn * BM + wc * 32 + 4 * fq;
        const float* gp = gate + (size_t)(u.pm >> 3) * gstride;
        f32x4 gv[2][2];
#pragma unroll
        for (int bj = 0; bj < 2; ++bj)
#pragma unroll
            for (int n = 0; n < 2; ++n) gv[bj][n] = *(const f32x4*)(gp + col0 + bj * HALF + n * 16);
#pragma unroll
        for (int ai = 0; ai < 2; ++ai) {
            f32x4 xi[4][2][2];
#pragma unroll
            for (int m = 0; m < 4; ++m) { const size_t ro = (size_t)(row0 + ai * HALF + m * 16) * 1024 + col0;
#pragma unroll
                for (int bj = 0; bj < 2; ++bj)
#pragma unroll
                    for (int n = 0; n < 2; ++n) xi[m][bj][n] = *(const f32x4*)(xin + ro + bj * HALF + n * 16); }
            asm volatile("" ::: "memory");
#pragma unroll
            for (int m = 0; m < 4; ++m) { const size_t ro = (size_t)(row0 + ai * HALF + m * 16) * 1024 + col0;
#pragma unroll
                for (int bj = 0; bj < 2; ++bj)
#pragma unroll
                    for (int n = 0; n < 2; ++n) *(f32x4*)(xout + ro + bj * HALF + n * 16) = xi[m][bj][n] + gv[bj][n] * acc[ai][bj][m][n]; }
            asm volatile("" ::: "memory"); }
    }
};
struct EpiSwiGLU {
    static constexpr bool PERM = false, AFTER_DRAIN = false;
    bf16_t* O;
    __device__ __forceinline__ void operator()(const f32x4 (&acc)[2][2][4][2], const Unit& u, int wr, int wc, int fr, int fq) const {
        const int row0 = u.pm * BM + wr * 64 + fr, col0 = (u.pn & 3) * HALF + wc * 32 + 4 * fq;
#pragma unroll
        for (int ai = 0; ai < 2; ++ai)
#pragma unroll
            for (int m = 0; m < 4; ++m) { bf16_t* rowp = O + (size_t)(row0 + ai * HALF + m * 16) * 512 + col0;
#pragma unroll
                for (int n = 0; n < 2; ++n) { const f32x4 g = acc[ai][0][m][n], up = acc[ai][1][m][n]; f32x4 h;
#pragma unroll
                    for (int j = 0; j < 4; ++j) h[j] = g[j] * __builtin_amdgcn_rcpf(1.0f + __expf(-g[j])) * up[j];
                    u32x2 w; w.x = cvt_pk_bf16(h[0], h[1]); w.y = cvt_pk_bf16(h[2], h[3]);
                    *(u32x2*)(rowp + n * 16) = w; } }
    }
};
struct ExpertOrder {
    const PG8_LAS int* ts; int ntiles, G, c;
    __device__ __forceinline__ bool next(int i, Unit& u) const {
        const int L = i * G + c; if (L >= ntiles * 4) return false;
        const int pm = L >> 2; int e = 0;
#pragma unroll 1
        for (int k = 1; k < 32; ++k) e += (ts[k] <= pm) ? 1 : 0;
        u.pm = pm; u.pn = e * 4 + (L & 3); return true;
    }
    __device__ __forceinline__ void a_ready(const Unit&) const {}
    __device__ __forceinline__ void done(const Unit&) const {}
};

struct UniOrder {
    StaticOrder so; ExpertOrder eo; bool expert;
    __device__ __forceinline__ bool next(int i, Unit& u) const { return expert ? eo.next(i, u) : so.next(i, u); }
    __device__ __forceinline__ void a_ready(const Unit&) const {}
    __device__ __forceinline__ void done(const Unit&) const {}
};
struct EpiUni {
    static constexpr bool AFTER_DRAIN = false;
    int mode; EpiBf16Plain e0; EpiResid e1; EpiSwiGLU e2;
    __device__ __forceinline__ bool perm() const { return mode == 0; }
    __device__ __forceinline__ void operator()(const f32x4 (&acc)[2][2][4][2], const Unit& u, int wr, int wc, int fr, int fq) const {
        if (mode == 0) e0(acc, u, wr, wc, fr, fq); else if (mode == 1) e1(acc, u, wr, wc, fr, fq); else if (mode == 2) e2(acc, u, wr, wc, fr, fq);
    }
};
template <class Epi, class Sched, bool ALIGN_EPI = false, bool SP2 = false>
__device__ __forceinline__ void gemm_phase(PG8_LAS unsigned char* lds, const Gemm g, const Sched& S, const Epi& E) {
    int tid_ = threadIdx.x; asm volatile("" : "+v"(tid_));
    const int tid = tid_, wid = __builtin_amdgcn_readfirstlane(tid >> 6), lane = tid & 63, wr = wid >> 2, wc = wid & 3, fr = lane & 15, fq = lane >> 4;
    const int K = g.K, nt = K / BK;
    unsigned voffA[2], voffB[2];
#pragma unroll
    for (int i = 0; i < 2; ++i) { int R, C; stage_rc(tid * 16 + i * 8192, R, C); const int Rb = E.perm() ? ((R & ~31) + perm32(R & 31)) : R;
        voffA[i] = (unsigned)(R * K + C) * 2u; voffB[i] = (unsigned)(Rb * K + C) * 2u; }
    const size_t kstep = (size_t)(BK * 2);
    const size_t hstep = (size_t)HALF * K * 2;
    const size_t tstep = 2 * hstep;
    const unsigned ldsw = (unsigned)wid * 1024u;
    const int aoff = lds_byte(wr * 64 + fr, fq * 8), boff = lds_byte(wc * 32 + fr, fq * 8);
#define PG8_SA(b, h) (((b) * 2 + (h)) * HTB)
#define PG8_SB(b, h) ((4 + (b) * 2 + (h)) * HTB)
#define PG8_STAGE(bufoff, gbase, voff) do { _Pragma("unroll") for (int _i = 0; _i < 2; ++_i) \
        __builtin_amdgcn_global_load_lds((const unsigned*)((const char*)(gbase) + (voff)[_i]), (PG8_LAS unsigned*)(lds + (bufoff) + ldsw + _i * 8192), 16, 0, 0); } while (0)
#define PG8_LDA(dst, b, h) do { _Pragma("unroll") for (int m = 0; m < 4; ++m) _Pragma("unroll") for (int k = 0; k < 2; ++k) dst[m][k] = *(const PG8_LAS bf16x8*)(lds + PG8_SA(b, h) + aoff + m * 2048 + k * 1024); } while (0)
#define PG8_LDB(dst, b, h) do { _Pragma("unroll") for (int n = 0; n < 2; ++n) _Pragma("unroll") for (int k = 0; k < 2; ++k) dst[n][k] = *(const PG8_LAS bf16x8*)(lds + PG8_SB(b, h) + boff + n * 2048 + k * 1024); } while (0)
#define PG8_MMA(ai, bj, At, Bt) do { __builtin_amdgcn_s_setprio(1); _Pragma("unroll") for (int m = 0; m < 4; ++m) _Pragma("unroll") for (int n = 0; n < 2; ++n) _Pragma("unroll") for (int k = 0; k < 2; ++k) \
        acc[ai][bj][m][n] = __builtin_amdgcn_mfma_f32_16x16x32_bf16(Bt[n][k], At[m][k], acc[ai][bj][m][n], 0, 0, 0); __builtin_amdgcn_s_setprio(0); } while (0)
#define PG8_WAIT_V(n) asm volatile("s_waitcnt vmcnt(" #n ")" ::: "memory")
#define PG8_WAIT_L(n) asm volatile("s_waitcnt lgkmcnt(" #n ")" ::: "memory")
#define PG8_BAR __builtin_amdgcn_s_barrier()
#define PG8_SCHED __builtin_amdgcn_sched_barrier(0)
    Unit cur, nxt; int ui = 0;
    if (!S.next(0, cur)) return;
    f32x4 acc[2][2][4][2];
#pragma unroll
    for (int a = 0; a < 2; ++a)
#pragma unroll
        for (int b = 0; b < 2; ++b)
#pragma unroll
            for (int m = 0; m < 4; ++m)
#pragma unroll
                for (int n = 0; n < 2; ++n) acc[a][b][m][n] = (f32x4){0.f, 0.f, 0.f, 0.f};
    bf16x8 At[4][2], B0[2][2], B1[2][2];
    const char* cA = (const char*)g.A + (size_t)cur.pm * tstep; const char* cB = (const char*)g.Bt + (size_t)cur.pn * tstep;
    S.a_ready(cur);
    if constexpr (SP2) {
        PG8_STAGE(PG8_SB(0, 0), cB, voffB); PG8_STAGE(PG8_SB(0, 1), cB + hstep, voffB); PG8_STAGE(PG8_SA(0, 0), cA, voffA); PG8_STAGE(PG8_SA(0, 1), cA + hstep, voffA);
        if (wr == 1) PG8_BAR;
        PG8_WAIT_V(2); PG8_BAR;
        PG8_STAGE(PG8_SB(1, 0), cB + kstep, voffB); PG8_STAGE(PG8_SA(1, 0), cA + kstep, voffA); PG8_STAGE(PG8_SB(1, 1), cB + hstep + kstep, voffB);
        PG8_WAIT_V(6); PG8_BAR;
    } else {
        PG8_STAGE(PG8_SB(0, 0), cB, voffB); PG8_STAGE(PG8_SA(0, 0), cA, voffA); PG8_STAGE(PG8_SB(0, 1), cB + hstep, voffB); PG8_STAGE(PG8_SA(0, 1), cA + hstep, voffA);
        if (wr == 1) PG8_BAR;
        PG8_WAIT_V(4); PG8_BAR;
        PG8_STAGE(PG8_SB(1, 0), cB + kstep, voffB); PG8_STAGE(PG8_SA(1, 0), cA + kstep, voffA); PG8_STAGE(PG8_SB(1, 1), cB + hstep + kstep, voffB);
        PG8_WAIT_V(6); PG8_BAR;
    }
    for (;;) {
        const bool has_next = S.next(ui + 1, nxt);
        const char* nA = has_next ? (const char*)g.A + (size_t)nxt.pm * tstep : cA; const char* nB = has_next ? (const char*)g.Bt + (size_t)nxt.pn * tstep : cB;
        for (int t = 0; t < nt; t += 2) {
            const bool last = (t == nt - 2);
            const char* a1 = cA + (size_t)(t + 1) * kstep;
            const char* a2 = last ? nA : cA + (size_t)(t + 2) * kstep; const char* b2 = last ? nB : cB + (size_t)(t + 2) * kstep;
            const char* a3 = a2 + kstep; const char* b3 = b2 + kstep;
            if (last && has_next) S.a_ready(nxt);
            if constexpr (SP2) {
            PG8_LDB(B0, 0, 0); PG8_LDB(B1, 0, 1); PG8_SCHED; PG8_LDA(At, 0, 0); PG8_STAGE(PG8_SA(1, 1), a1 + hstep, voffA);
            PG8_WAIT_V(8); PG8_WAIT_L(0); PG8_BAR; PG8_MMA(0, 0, At, B0); PG8_MMA(0, 1, At, B1); PG8_BAR; PG8_SCHED;
            PG8_LDA(At, 0, 1); PG8_STAGE(PG8_SB(0, 0), b2, voffB); PG8_STAGE(PG8_SB(0, 1), b2 + hstep, voffB); PG8_STAGE(PG8_SA(0, 0), a2, voffA);
            PG8_WAIT_V(8); PG8_WAIT_L(0); PG8_BAR; PG8_MMA(1, 0, At, B0); PG8_MMA(1, 1, At, B1); PG8_BAR; PG8_SCHED;
            PG8_LDB(B0, 1, 0); PG8_LDB(B1, 1, 1); PG8_SCHED; PG8_LDA(At, 1, 0); PG8_STAGE(PG8_SA(0, 1), a2 + hstep, voffA);
            PG8_WAIT_V(8); PG8_WAIT_L(0); PG8_BAR; PG8_MMA(0, 0, At, B0); PG8_MMA(0, 1, At, B1); PG8_BAR; PG8_SCHED;
            PG8_LDA(At, 1, 1); PG8_STAGE(PG8_SB(1, 0), b3, voffB); PG8_STAGE(PG8_SB(1, 1), b3 + hstep, voffB); PG8_STAGE(PG8_SA(1, 0), a3, voffA);
            PG8_WAIT_V(8); PG8_WAIT_L(0); PG8_BAR; PG8_MMA(1, 0, At, B0); PG8_MMA(1, 1, At, B1); PG8_BAR; PG8_SCHED;
            } else {
            PG8_LDB(B0, 0, 0); PG8_SCHED; PG8_LDA(At, 0, 0); PG8_STAGE(PG8_SA(1, 1), a1 + hstep, voffA);
            PG8_WAIT_L(8); PG8_BAR; PG8_WAIT_L(0); PG8_MMA(0, 0, At, B0); PG8_BAR; PG8_SCHED;
            PG8_LDB(B1, 0, 1); PG8_STAGE(PG8_SB(0, 0), b2, voffB);
            PG8_BAR; PG8_WAIT_L(0); PG8_MMA(0, 1, At, B1); PG8_BAR;
            PG8_LDA(At, 0, 1); PG8_STAGE(PG8_SA(0, 0), a2, voffA);
            PG8_BAR; PG8_WAIT_L(0); PG8_MMA(1, 0, At, B0); PG8_BAR; PG8_SCHED;
            PG8_STAGE(PG8_SB(0, 1), b2 + hstep, voffB);
            PG8_WAIT_V(6); PG8_BAR; PG8_MMA(1, 1, At, B1); PG8_BAR;
            PG8_LDB(B0, 1, 0); PG8_SCHED; PG8_LDA(At, 1, 0); PG8_STAGE(PG8_SA(0, 1), a2 + hstep, voffA);
            PG8_WAIT_L(8); PG8_BAR; PG8_WAIT_L(0); PG8_MMA(0, 0, At, B0); PG8_BAR; PG8_SCHED;
            PG8_LDB(B1, 1, 1); PG8_STAGE(PG8_SB(1, 0), b3, voffB);
            PG8_BAR; PG8_WAIT_L(0); PG8_MMA(0, 1, At, B1); PG8_BAR;
            PG8_LDA(At, 1, 1); PG8_STAGE(PG8_SA(1, 0), a3, voffA);
            PG8_BAR; PG8_WAIT_L(0); PG8_MMA(1, 0, At, B0); PG8_BAR; PG8_SCHED;
            PG8_STAGE(PG8_SB(1, 1), b3 + hstep, voffB);
            PG8_WAIT_V(6); PG8_BAR; PG8_MMA(1, 1, At, B1); PG8_BAR;
            }
        }
        if constexpr (ALIGN_EPI) { if (wr == 0) PG8_BAR; }
        if constexpr (!Epi::AFTER_DRAIN) { E(acc, cur, wr, wc, fr, fq); S.done(cur); }
        if (!has_next) break;
#pragma unroll
        for (int a = 0; a < 2; ++a)
#pragma unroll
            for (int b = 0; b < 2; ++b)
#pragma unroll
                for (int m = 0; m < 4; ++m)
#pragma unroll
                    for (int n = 0; n < 2; ++n) acc[a][b][m][n] = (f32x4){0.f, 0.f, 0.f, 0.f};
        cur = nxt; cA = nA; cB = nB; ++ui;
        if constexpr (ALIGN_EPI) { if (wr == 1) PG8_BAR; }
    }
    PG8_WAIT_V(0);
    if constexpr (!ALIGN_EPI) { if (wr == 0) PG8_BAR; }
    PG8_BAR;
    if constexpr (Epi::AFTER_DRAIN) { E.fused(acc, cur, wr, wc, fr, fq, lds, wid, lane); S.done(cur); }
#undef PG8_SA
#undef PG8_SB
#undef PG8_STAGE
#undef PG8_LDA
#undef PG8_LDB
#undef PG8_MMA
#undef PG8_WAIT_V
#undef PG8_WAIT_L
#undef PG8_BAR
#undef PG8_SCHED
}
}

constexpr int NWAVES = 8;
constexpr int T = 16384, D = 1024, SEQ = 2048, NBATCH = 8, NHEAD = 16;
constexpr int N_IN = 8448, N_IN1 = 8704, BT_LD = 8704, P_LD = 6656;
constexpr int C_U = 0, C_GCB = 1024, C_GB = 2048, C_R = 3072, C_K = 4096, C_V = 5120, C_WD = 6144, C_AD = 6208, C_GD = 6272, C_VD = 6400, G1_NPAIR = 16, G1_CBASE = 2048, G1_VDROW = 8448;
constexpr int N_SHIFT = 3328, N_EXP = 32, D_EXP = 512;
constexpr int MAXROWS = 40960;
constexpr float NORM_EPS = 1e-6f, LNX_EPS = 64e-5f;

constexpr size_t MiB = 1u << 20;
constexpr size_t WS_CTL = 0, CTL_ZERO_BYTES = 1 * MiB;
constexpr size_t WS_BT_IN = 2 * MiB;
constexpr size_t WS_BT_OUT = 39 * MiB;
constexpr size_t WS_BT_E1 = 43 * MiB;
constexpr size_t WS_BT_E2 = 171 * MiB;
constexpr size_t WS_H = 235 * MiB;
constexpr size_t WS_ALR = WS_H;
constexpr size_t WS_P = 267 * MiB;
constexpr size_t WS_BUF = WS_P, WS_HB = WS_P + 80 * MiB, WS_YE = WS_P + 120 * MiB;
constexpr size_t WS_ADAP = WS_P;
constexpr size_t WS_W = 563 * MiB;
constexpr size_t WS_KK = 627 * MiB, WS_BQ = 659 * MiB, WS_KP = 691 * MiB, WS_R = 723 * MiB, WS_V0 = 755 * MiB, WS_V1 = 787 * MiB;
constexpr size_t WS_LR = 819 * MiB;
constexpr size_t WS_Y = 915 * MiB;
constexpr size_t WS_X = 947 * MiB;
constexpr size_t WS_BONUS = 1011 * MiB;
constexpr size_t WS_EIDX = 1012 * MiB, WS_POS = WS_EIDX + 128 * 1024, WS_WTS = WS_EIDX + 256 * 1024, WS_SLOT = WS_EIDX + 384 * 1024;
constexpr size_t WS_HIST = WS_EIDX + 512 * 1024;
constexpr size_t WS_WRT = WS_EIDX + 768 * 1024;
constexpr size_t WS_VG = WS_BQ;
constexpr size_t WS_VU = WS_KP;
constexpr size_t WS_KN = WS_KK;
constexpr size_t WS_BONP = WS_KK + 2 * MiB;
constexpr size_t WS_BT_LR = 1015 * MiB;
constexpr size_t WS_END = 1018 * MiB;
static_assert(WS_YE + (size_t)MAXROWS * 1024 * 2 <= WS_W && WS_P + (size_t)T * P_LD * 2 <= WS_W && WS_BT_IN + (size_t)2 * BT_LD * 2048 <= WS_BT_OUT, "ws map");
constexpr int CW_CNT = 1024;
constexpr int CW_BAR = 4096;
constexpr size_t CTL_ADA = 256 * 1024;
constexpr size_t CTL_BIASR = 700 * 1024;

constexpr int RING_BYTES = 131072;
constexpr int TAB_OFF = RING_BYTES;
constexpr int MISC_OFF = RING_BYTES + 1024;
constexpr int LDS_BYTES = 147456;

#define GAS __attribute__((address_space(1)))
#define LAS __attribute__((address_space(3)))
typedef unsigned short bf16;
typedef float f32x4 __attribute__((ext_vector_type(4)));
typedef float f32x2 __attribute__((ext_vector_type(2)));
typedef unsigned u32x4 __attribute__((ext_vector_type(4)));
typedef unsigned u32x2 __attribute__((ext_vector_type(2)));
#define LDS_WAIT() asm volatile("s_waitcnt lgkmcnt(0)" ::: "memory")

__device__ __forceinline__ unsigned f2bf(float f) { unsigned u = __builtin_bit_cast(unsigned, f); return (u + 0x7fffu + ((u >> 16) & 1u)) >> 16; }
__device__ __forceinline__ unsigned pk2(float lo, float hi) { return f2bf(lo) | (f2bf(hi) << 16); }
typedef __bf16 bfl2 __attribute__((ext_vector_type(2)));
__device__ __forceinline__ unsigned pkbf(float lo, float hi) { f32x2 v; v.x = lo; v.y = hi; return __builtin_bit_cast(unsigned, __builtin_convertvector(v, bfl2)); }
__device__ __forceinline__ float bflo(unsigned u) { return __builtin_bit_cast(float, u << 16); }
__device__ __forceinline__ float bfhi(unsigned u) { return __builtin_bit_cast(float, u & 0xffff0000u); }
__device__ __forceinline__ void load8(const bf16* p, float (&o)[8]) { const u32x4 u = *(const u32x4*)p; o[0] = bflo(u.x); o[1] = bfhi(u.x); o[2] = bflo(u.y); o[3] = bfhi(u.y); o[4] = bflo(u.z); o[5] = bfhi(u.z); o[6] = bflo(u.w); o[7] = bfhi(u.w); }
__device__ __forceinline__ void store8(bf16* p, const float (&v)[8]) { u32x4 w; w.x = pk2(v[0], v[1]); w.y = pk2(v[2], v[3]); w.z = pk2(v[4], v[5]); w.w = pk2(v[6], v[7]); *(u32x4*)p = w; }
typedef _Float16 f16x2 __attribute__((ext_vector_type(2)));
__device__ __forceinline__ unsigned pkh2(float lo, float hi) { f16x2 h; h.x = (_Float16)lo; h.y = (_Float16)hi; return __builtin_bit_cast(unsigned, h); }
__device__ __forceinline__ float hlo(unsigned u) { return (float)__builtin_bit_cast(f16x2, u).x; }
__device__ __forceinline__ float hhi(unsigned u) { return (float)__builtin_bit_cast(f16x2, u).y; }
__device__ __forceinline__ void load8h(const bf16* p, float (&o)[8]) { const u32x4 u = *(const u32x4*)p; o[0] = hlo(u.x); o[1] = hhi(u.x); o[2] = hlo(u.y); o[3] = hhi(u.y); o[4] = hlo(u.z); o[5] = hhi(u.z); o[6] = hlo(u.w); o[7] = hhi(u.w); }
__device__ __forceinline__ void store8h(bf16* p, const float (&v)[8]) { u32x4 w; w.x = pkh2(v[0], v[1]); w.y = pkh2(v[2], v[3]); w.z = pkh2(v[4], v[5]); w.w = pkh2(v[6], v[7]); *(u32x4*)p = w; }
__device__ __forceinline__ float fmx_lo(float a, unsigned h, float c) { float d; asm("v_fma_mix_f32 %0, %1, %2, %3 op_sel_hi:[0,1,0]" : "=v"(d) : "v"(a), "v"(h), "v"(c)); return d; }
__device__ __forceinline__ float fmx_hi(float a, unsigned h, float c) { float d; asm("v_fma_mix_f32 %0, %1, %2, %3 op_sel:[0,1,0] op_sel_hi:[0,1,0]" : "=v"(d) : "v"(a), "v"(h), "v"(c)); return d; }
__device__ __forceinline__ float mmx_lo(float a, unsigned h) { float d; asm("v_fma_mix_f32 %0, %1, %2, 0 op_sel_hi:[0,1,0]" : "=v"(d) : "v"(a), "v"(h)); return d; }
__device__ __forceinline__ float mmx_hi(float a, unsigned h) { float d; asm("v_fma_mix_f32 %0, %1, %2, 0 op_sel:[0,1,0] op_sel_hi:[0,1,0]" : "=v"(d) : "v"(a), "v"(h)); return d; }
__device__ __forceinline__ float sigmoidf_(float x) { return __builtin_amdgcn_rcpf(1.0f + __expf(-x)); }
__device__ __forceinline__ float tanhf_(float x) { return 1.0f - 2.0f * __builtin_amdgcn_rcpf(__expf(2.0f * x) + 1.0f); }
__device__ __forceinline__ float wave_sum(float v) {
#pragma unroll
    for (int o = 1; o < 64; o <<= 1) v += __shfl_xor(v, o);
    return v;
}
__device__ __forceinline__ float sum8(float v) { v += __shfl_xor(v, 1); v += __shfl_xor(v, 2); v += __shfl_xor(v, 4); return v; }
template <int CTRL> __device__ __forceinline__ float dpp_f(float v) { return __builtin_bit_cast(float, __builtin_amdgcn_mov_dpp(__builtin_bit_cast(int, v), CTRL, 0xF, 0xF, true)); }
__device__ __forceinline__ float dpp_sum16(float v) {
    v += dpp_f<0xB1>(v);
    v += dpp_f<0x4E>(v);
    v += dpp_f<0x141>(v);
    v += dpp_f<0x140>(v);
    return v;
}

#define XB_TMO      128
#define XB_XCNT(j)  (256  + 64 * (j))
#define XB_XSUB(j)  (1280 + 64 * (j))
#define XB_XGEN(j)  (2304 + 64 * (j))
#define XB_TOP      3328
#define XB_TOPGEN   3392
#define XCD_BAR_WORDS 3456
#define XB_SPIN_CAP (1u << 18)

__device__ __forceinline__ unsigned xb_ld(unsigned* p)              { return __hip_atomic_load(p, __ATOMIC_RELAXED, __HIP_MEMORY_SCOPE_AGENT); }
__device__ __forceinline__ unsigned xb_add(unsigned* p, unsigned v) { return __hip_atomic_fetch_add(p, v, __ATOMIC_RELAXED, __HIP_MEMORY_SCOPE_AGENT); }
__device__ __forceinline__ unsigned xb_xcc_id() { return (unsigned)__builtin_amdgcn_s_getreg((3 << 11) | 20) & 0xFu; }
#define XB_SPIN(cond, bar) do { unsigned _sp = 0; while (cond) { __builtin_amdgcn_s_sleep(1); \
    if ((++_sp & 255u) == 0u) { if (xb_ld(&(bar)[XB_TMO])) break; if (_sp > XB_SPIN_CAP) { atomicAdd(&(bar)[XB_TMO], 1u); break; } } } } while (0)

struct XcdBarrier {
    unsigned* bar; unsigned x;
    volatile LAS unsigned* st;
};

__device__ __forceinline__ XcdBarrier xcd_barrier_post(unsigned* bar, volatile LAS unsigned* st) {
    XcdBarrier b; b.bar = bar; b.x = xb_xcc_id(); b.st = st;
    if (threadIdx.x == 0) (void)xb_add(&bar[XB_XCNT(b.x)], 1u);
    return b;
}
__device__ __forceinline__ void xcd_barrier_complete(unsigned* bar, unsigned x, unsigned& nloc, unsigned& nx) {
    const unsigned G = gridDim.x * gridDim.y * gridDim.z;
    unsigned sum, cnt, mine, sp = 0u;
    for (;;) {
        sum = 0u; cnt = 0u; mine = 0u;
#pragma unroll
        for (unsigned j = 0; j < 16; ++j) { const unsigned c = xb_ld(&bar[XB_XCNT(j)]); sum += c; cnt += (c > 0u) ? 1u : 0u; mine = (j == x) ? c : mine; }
        if (sum == G) break;
        __builtin_amdgcn_s_sleep(1);
        if ((++sp & 255u) == 0u) { if (xb_ld(&bar[XB_TMO])) break; if (sp > XB_SPIN_CAP) { atomicAdd(&bar[XB_TMO], 1u); break; } }
    }
    nloc = mine > 0u ? mine : 1u; nx = cnt > 0u ? cnt : 1u;
}

__device__ __forceinline__ void xcd_barrier(const XcdBarrier& b) {
    asm volatile("s_waitcnt vmcnt(0)" ::: "memory");
    __syncthreads();
    if (threadIdx.x == 0) {
        unsigned* bar = b.bar;
        __builtin_amdgcn_s_waitcnt(0);
        unsigned nloc = b.st[0], nx = b.st[1];
        if (nloc == 0u) { xcd_barrier_complete(bar, b.x, nloc, nx); b.st[0] = nloc; b.st[1] = nx; }
        const unsigned old = xb_add(&bar[XB_XSUB(b.x)], 1u);
        const unsigned gen = old / nloc;
        if (old + 1u == (gen + 1u) * nloc) {
            __builtin_amdgcn_fence(__ATOMIC_RELEASE, "agent");
            asm volatile("s_waitcnt vmcnt(0)" ::: "memory");
            const unsigned og = xb_add(&bar[XB_TOP], 1u);
            const unsigned tg = og / nx;
            if (og + 1u == (tg + 1u) * nx) xb_add(&bar[XB_TOPGEN], 1u);
            else XB_SPIN(xb_ld(&bar[XB_TOPGEN]) == tg, bar);
            __builtin_amdgcn_fence(__ATOMIC_ACQUIRE, "agent");
            xb_add(&bar[XB_XGEN(b.x)], 1u);
            asm volatile("s_waitcnt vmcnt(0)" ::: "memory");
        } else {
            XB_SPIN(xb_ld(&bar[XB_XGEN(b.x)]) == gen, bar);
            __builtin_amdgcn_fence(__ATOMIC_ACQUIRE, "agent");
            asm volatile("s_waitcnt vmcnt(0)" ::: "memory");
        }
    }
    __syncthreads();
}

struct Args { const void* p[30]; int ph_lo, ph_hi; };
template <int IDX> __device__ __forceinline__ const float* kin() {
    const auto ka = __builtin_amdgcn_kernarg_segment_ptr(); unsigned long long v;
    asm volatile("s_load_dwordx2 %0, %1, %2\n\ts_waitcnt lgkmcnt(0)" : "=s"(v) : "s"(ka), "i"(IDX * 8) : "memory");
    return (const float*)(const GAS float*)v;
}
enum { I_X = 0, I_C, I_WADA, I_BADA, I_N1G, I_N2G, I_WIN, I_MU, I_CONVW, I_W0, I_DECUP, I_A0, I_AAAUP, I_GATEUP, I_KK, I_KA, I_RK, I_LNW, I_LNB, I_VMD, I_VMU, I_V0, I_WOUT, I_WR, I_RB, I_WE1, I_WE2, I_FG };
struct Frame {
    LAS unsigned char* lds;
    int tid, lane, wave, vcu, G;
    GAS unsigned char* ws;
};
__device__ __forceinline__ float* ada_ptr(const Frame& F, int l, int b) { return (float*)(F.ws + WS_CTL + CTL_ADA) + (size_t)(l * 8 + b) * 6144; }

struct TItem { const float* src; bf16* dst; int N, K; };
__device__ __forceinline__ void t_load(const TItem& d, float (&tv)[32], int lane) {
#pragma unroll
    for (int i = 0; i < 32; ++i) tv[i] = d.src[(size_t)(2 * i + (lane >> 5)) * d.N + (lane & 31)];
}
__device__ __forceinline__ void t_store(const TItem& d, const float (&tv)[32], LAS float* scr, int lane) {
#pragma unroll
    for (int i = 0; i < 32; ++i) { const int kk = 2 * i + (lane >> 5); scr[kk * 33 + (lane & 31)] = tv[i]; }
    LDS_WAIT();
    const int c = lane & 7;
#pragma unroll
    for (int j = 0; j < 4; ++j) { const int n = (lane >> 3) + 8 * j; const LAS float* s = scr + (8 * c) * 33 + n;
        u32x4 o; o.x = pk2(s[0 * 33], s[1 * 33]); o.y = pk2(s[2 * 33], s[3 * 33]); o.z = pk2(s[4 * 33], s[5 * 33]); o.w = pk2(s[6 * 33], s[7 * 33]);
        *(u32x4*)(d.dst + (size_t)n * d.K + 8 * c) = o; }
    LDS_WAIT();
}
__device__ __forceinline__ void p0_prologue(const Frame& F) {
    LAS float* scr = (LAS float*)(F.lds + F.wave * 16384);
    const int gw = F.vcu * NWAVES + F.wave, NGW = F.G * NWAVES, lane = F.lane;
    constexpr int I_ADA = 768, I_A = 2 * 16 * 264, I_B = 2 * 16 * 32, I_C1 = 64 * 16 * 32, I_D = 64 * 8 * 32;
    constexpr int NT = I_A + I_B + I_C1 + I_D;
    const float* const pC = kin<I_C>(); const float* const pWADA = kin<I_WADA>(); const float* const pWIN = kin<I_WIN>();
    const float* const pWOUT = kin<I_WOUT>(); const float* const pWE1 = kin<I_WE1>(); const float* const pWE2 = kin<I_WE2>(); const float* const pVMD = kin<I_VMD>();
    for (int r = gw; r < I_ADA; r += NGW) {
            const int l = r / 384, rr = r % 384, cch = rr >> 4, kc = rr & 15, col = cch * 256 + 4 * lane, k0 = kc * 64;
            float cv[8];
#pragma unroll
            for (int b = 0; b < 8; ++b) { const float x = pC[b * 1024 + k0 + lane]; cv[b] = x * sigmoidf_(x); }
            f32x4 acc[8];
#pragma unroll
            for (int b = 0; b < 8; ++b) acc[b] = (f32x4){0.f, 0.f, 0.f, 0.f};
            const float* wp = pWADA + ((size_t)l * 1024 + k0) * 6144 + col;
#pragma unroll 16
            for (int kk = 0; kk < 64; ++kk) { const f32x4 w = *(const f32x4*)(wp + (size_t)kk * 6144);
#pragma unroll
                for (int b = 0; b < 8; ++b) { const float s = __builtin_bit_cast(float, __builtin_amdgcn_readlane(__builtin_bit_cast(int, cv[b]), kk)); acc[b] += s * w; } }
#pragma unroll
            for (int b = 0; b < 8; ++b) *(f32x4*)((float*)(F.ws + WS_ADAP) + ((size_t)(kc * 2 + l) * 8 + b) * 6144 + col) = acc[b];
    }
    auto decode = [&](int r, TItem& d) {
        if (r < I_A) { const int l = r / (16 * 264), rr = r % (16 * 264), kb = rr / 264, nb = rr % 264;
            const int n0 = 32 * nb; int dstr = n0;
            if (n0 < 4096) { const int blk = n0 >> 10, j = n0 & 1023; dstr = ((j >> 7) + ((blk == 0 || blk == 3) ? 8 : 0)) * 256 + ((blk >= 2) ? 128 : 0) + (j & 127); }
            d.N = N_IN; d.K = 1024; d.src = pWIN + (size_t)l * 1024 * N_IN + (size_t)(64 * kb) * N_IN + n0; d.dst = (bf16*)(F.ws + WS_BT_IN) + (size_t)l * BT_LD * 1024 + (size_t)dstr * 1024 + 64 * kb; return; }
        r -= I_A;
        if (r < I_B) { const int l = r / 512, rr = r % 512, kb = rr / 32, nb = rr % 32;
            d.N = 1024; d.K = 1024; d.src = pWOUT + (size_t)l * 1024 * 1024 + (size_t)(64 * kb) * 1024 + 32 * nb; d.dst = (bf16*)(F.ws + WS_BT_OUT) + (size_t)l * 1024 * 1024 + (size_t)(32 * nb) * 1024 + 64 * kb; return; }
        r -= I_B;
        if (r < I_C1) { const int le = r / 512, rr = r % 512, kb = rr / 32, nb = rr % 32, n0 = 32 * nb;
            const int j0 = n0 & 511, dstr = (j0 >> 7) * 256 + (n0 >= 512 ? 128 : 0) + (j0 & 127);
            d.N = 1024; d.K = 1024; d.src = pWE1 + (size_t)le * 1024 * 1024 + (size_t)(64 * kb) * 1024 + n0; d.dst = (bf16*)(F.ws + WS_BT_E1) + (size_t)le * 1024 * 1024 + (size_t)dstr * 1024 + 64 * kb; return; }
        r -= I_C1;
        { const int le = r / 256, rr = r % 256, kb = rr / 32, nb = rr % 32;
            d.N = 1024; d.K = 512; d.src = pWE2 + (size_t)le * 512 * 1024 + (size_t)(64 * kb) * 1024 + 32 * nb; d.dst = (bf16*)(F.ws + WS_BT_E2) + (size_t)le * 1024 * 512 + (size_t)(32 * nb) * 512 + 64 * kb; }
    };
    { int r = gw - I_ADA; if (r < 0) r += NGW;
      float tvA[32], tvB[32]; TItem dA, dB;
      if (r < NT) { decode(r, dA); t_load(dA, tvA, lane);
#pragma unroll 1
          for (;;) {
              r += NGW; const bool hB = r < NT; if (hB) { decode(r, dB); t_load(dB, tvB, lane); }
              t_store(dA, tvA, scr, lane);
              if (!hB) break;
              r += NGW; const bool hA = r < NT; if (hA) { decode(r, dA); t_load(dA, tvA, lane); }
              t_store(dB, tvB, scr, lane);
              if (!hA) break;
          } } }
    const int gt0 = F.vcu * NWAVES * 64 + F.tid, GT = F.G * NWAVES * 64;
    { const float* const pVMUp = kin<I_VMU>();
      for (int it = gt0; it < 256 * 128; it += GT) { const int n = it >> 7, k0 = (it & 127) * 8; float o[8];
#pragma unroll
        for (int i = 0; i < 8; ++i) o[i] = (n < 32) ? pVMD[(k0 + i) * 32 + n] : 0.f;
        store8((bf16*)(F.ws + WS_BT_IN) + (size_t)BT_LD * 1024 + (size_t)(G1_VDROW + n) * 1024 + k0, o); }
      for (int it = gt0; it < 1024 * 4; it += GT) { const int n = it >> 2, j0 = (it & 3) * 8; float o[8];
#pragma unroll
        for (int i = 0; i < 8; ++i) o[i] = pVMUp[(j0 + i) * 1024 + n];
        store8((bf16*)(F.ws + WS_VU) + (size_t)n * 32 + j0, o); } }
    { const float* const pDU = kin<I_DECUP>(); const float* const pAU = kin<I_AAAUP>(); const float* const pGU = kin<I_GATEUP>();
      for (int it = gt0; it < 2 * 3072 * 32; it += GT) { const int l = it / (3072 * 32), rr = it % (3072 * 32), n = rr >> 5, k0 = (rr & 31) * 8; float o[8];
#pragma unroll
        for (int i = 0; i < 8; ++i) { const int k = k0 + i; float v = 0.f;
            if (n < 1024) { if (k < 64) v = pDU[(size_t)(l * 64 + k) * 1024 + n]; }
            else if (n < 2048) { if (k >= 64 && k < 128) v = pAU[(size_t)(l * 64 + k - 64) * 1024 + n - 1024]; }
            else { if (k >= 128) v = pGU[(size_t)(l * 128 + k - 128) * 1024 + n - 2048]; }
            o[i] = v; }
        store8((bf16*)(F.ws + WS_BT_LR) + (size_t)l * 3072 * 256 + (size_t)n * 256 + k0, o); } }
    { const float* const pWRp = kin<I_WR>(); const int gt = F.vcu * NWAVES * 64 + F.tid; if (gt < 32768) { const float w = pWRp[(gt & 1023) * 32 + (gt >> 10)]; const unsigned hi = f2bf(w);
        ((bf16*)(F.ws + WS_WRT))[gt] = (bf16)hi; ((bf16*)(F.ws + WS_WRT))[32768 + gt] = (bf16)f2bf(w - bflo(hi)); } }
}

__device__ __forceinline__ void p0b_ada_reduce(const Frame& F) {
    const float* const pBADA = kin<I_BADA>(); const float* ap = (const float*)(F.ws + WS_ADAP); float* ada = (float*)(F.ws + WS_CTL + CTL_ADA);
    for (int idx = F.vcu * NWAVES * 64 + F.tid; idx < 2 * 8 * 6144; idx += F.G * NWAVES * 64) { const int l = idx / 49152, r = idx % 49152, c = r % 6144;
        float s = pBADA[l * 6144 + c];
#pragma unroll
        for (int kc = 0; kc < 16; ++kc) s += ap[(size_t)(kc * 2 + l) * 49152 + r];
        ada[idx] = s; }
}

template <int MODE> __device__ __forceinline__ void p1_norm(const Frame& F, int l) {
    const int lane = F.lane;
    const float* const pX = kin<I_X>(); float* const pOUT = (float*)kin<28>(); const float* const pFG = kin<I_FG>(); const float* const pN1G = kin<I_N1G>(); const float* const pWRb = kin<I_WR>();
#pragma unroll 1
    for (int gw = F.vcu * NWAVES + F.wave; gw < T / 8; gw += F.G * NWAVES) { const int tok0 = gw * 8, b = tok0 >> 11;
        f32x4 gm[4], sh[4], g2v[4];
#pragma unroll
        for (int j = 0; j < 4; ++j) { const int c = 4 * lane + 256 * j;
            if (MODE == 2) { gm[j] = *(const f32x4*)(pFG + c); sh[j] = (f32x4){0.f, 0.f, 0.f, 0.f}; }
            else { const float* ad = ada_ptr(F, l, b); const f32x4 g = *(const f32x4*)(pN1G + l * 1024 + c), sc = *(const f32x4*)(ad + 1024 + c); gm[j] = g * (1.0f + sc); sh[j] = *(const f32x4*)(ad + c); }
            if (MODE >= 1) g2v[j] = *(const f32x4*)(ada_ptr(F, MODE == 2 ? 1 : l - 1, b) + 5120 + c); }
        float* X = (float*)(F.ws + WS_X);
        const bf16* YE = (const bf16*)(F.ws + WS_YE);
        const float* WTS = (const float*)(F.ws + WS_WTS); const int* SLOT = (const int*)(F.ws + WS_SLOT);
#pragma unroll 1
        for (int tb = 0; tb < 8; tb += 4) {
            f32x4 v[4][4];
#pragma unroll
            for (int t = 0; t < 4; ++t) { const float* xs = (MODE == 0 ? pX : X) + (size_t)(tok0 + tb + t) * 1024;
#pragma unroll
                for (int j = 0; j < 4; ++j) v[t][j] = *(const f32x4*)(xs + 4 * lane + 256 * j); }
            if (MODE >= 1) {
                float w0[4], w1[4]; int s0[4], s1[4]; u32x2 y0[4][4], y1[4][4];
#pragma unroll
                for (int t = 0; t < 4; ++t) { const int tok = tok0 + tb + t; w0[t] = WTS[tok * 2]; w1[t] = WTS[tok * 2 + 1]; s0[t] = SLOT[tok * 2]; s1[t] = SLOT[tok * 2 + 1]; }
#pragma unroll
                for (int t = 0; t < 4; ++t)
#pragma unroll
                    for (int j = 0; j < 4; ++j) { y0[t][j] = *(const u32x2*)(YE + (size_t)s0[t] * 1024 + 4 * lane + 256 * j); y1[t][j] = *(const u32x2*)(YE + (size_t)s1[t] * 1024 + 4 * lane + 256 * j); }
#pragma unroll
                for (int t = 0; t < 4; ++t)
#pragma unroll
                    for (int j = 0; j < 4; ++j) { const u32x2 a = y0[t][j], c = y1[t][j];
                        f32x4 m; m[0] = w0[t] * bflo(a.x) + w1[t] * bflo(c.x); m[1] = w0[t] * bfhi(a.x) + w1[t] * bfhi(c.x); m[2] = w0[t] * bflo(a.y) + w1[t] * bflo(c.y); m[3] = w0[t] * bfhi(a.y) + w1[t] * bfhi(c.y);
                        v[t][j] += g2v[j] * m; if (MODE == 1) *(f32x4*)(X + (size_t)(tok0 + tb + t) * 1024 + 4 * lane + 256 * j) = v[t][j]; }
            }
            float ss[4];
#pragma unroll
            for (int t = 0; t < 4; ++t) { ss[t] = 0.f;
#pragma unroll
                for (int j = 0; j < 4; ++j) ss[t] += (v[t][j][0] * v[t][j][0] + v[t][j][1] * v[t][j][1]) + (v[t][j][2] * v[t][j][2] + v[t][j][3] * v[t][j][3]); }
#pragma unroll
            for (int o = 1; o < 64; o <<= 1) {
#pragma unroll
                for (int t = 0; t < 4; ++t) ss[t] += __shfl_xor(ss[t], o); }
#pragma unroll
            for (int t = 0; t < 4; ++t) { const int tok = tok0 + tb + t;
                const float rstd = __builtin_amdgcn_rsqf(ss[t] * (1.0f / 1024.0f) + NORM_EPS);
#pragma unroll
                for (int j = 0; j < 4; ++j) { const f32x4 h = v[t][j] * rstd * gm[j] + sh[j];
                    if (MODE == 2) *(f32x4*)(pOUT + (size_t)tok * 1024 + 4 * lane + 256 * j) = h;
                    else { u32x2 w; w.x = pk2(h[0], h[1]); w.y = pk2(h[2], h[3]); *(u32x2*)((bf16*)(F.ws + WS_H) + (size_t)tok * 1024 + 4 * lane + 256 * j) = w; } } }
        }
    }
    if (MODE == 0 && F.vcu < 16) {
        const int lb = F.vcu, e = F.tid & 31, kq = F.tid >> 5; const float* sh2 = ada_ptr(F, lb >> 3, lb & 7) + 3072 + kq * 64; const float* wr = pWRb + (size_t)kq * 64 * 32 + e; float s = 0.f;
#pragma unroll 1
        for (int k0 = 0; k0 < 64; k0 += 32) { float a[32], w[32];
#pragma unroll
            for (int i = 0; i < 32; ++i) { a[i] = sh2[k0 + i]; w[i] = wr[(k0 + i) * 32]; }
#pragma unroll
            for (int i = 0; i < 32; ++i) s += a[i] * w[i]; }
        LAS float* red = (LAS float*)F.lds; red[kq * 32 + e] = s; __syncthreads();
        if (F.tid < 32) { float t = 0.f; for (int q = 0; q < 16; ++q) t += red[q * 32 + e]; ((float*)(F.ws + WS_CTL + CTL_BIASR))[lb * 32 + e] = t; }
        __syncthreads();
    }
}

typedef short bfv8 __attribute__((ext_vector_type(8)));
constexpr int LRX_PITCH = 592;
template <int NKS> struct LrW { bfv8 w[2][NKS]; f32x4 b0, b1; };
template <int NKS> __device__ __forceinline__ void lrx_load(LrW<NKS>& W, const bf16* wrow0, int wpitch, const float* bias, int li, int fq) {
#pragma unroll
    for (int tile = 0; tile < 2; ++tile) { const bf16* rp = wrow0 + (size_t)(8 * (li >> 2) + 4 * tile + (li & 3)) * wpitch + 8 * fq;
#pragma unroll
        for (int ks = 0; ks < NKS; ++ks) W.w[tile][ks] = *(const bfv8*)(rp + 32 * ks); }
    if (bias) { W.b0 = *(const f32x4*)(bias + 8 * fq); W.b1 = *(const f32x4*)(bias + 8 * fq + 4); }
}
template <int NKS, int MODE> __device__ __forceinline__ void lrx_job(const LrW<NKS>& W, const LAS unsigned char* tile, int kcol, bf16* out, int ostride, int li, int fq) {
#pragma unroll 2
    for (int mt = 0; mt < 4; ++mt) {
        bfv8 af[NKS];
#pragma unroll
        for (int ks = 0; ks < NKS; ++ks) af[ks] = *(const LAS bfv8*)(tile + (16 * mt + li) * LRX_PITCH + (kcol + 32 * ks + 8 * fq) * 2);
        f32x4 acc0 = (f32x4){0.f, 0.f, 0.f, 0.f}, acc1 = acc0;
#pragma unroll
        for (int ks = 0; ks < NKS; ++ks) { acc0 = __builtin_amdgcn_mfma_f32_16x16x32_bf16(W.w[0][ks], af[ks], acc0, 0, 0, 0); acc1 = __builtin_amdgcn_mfma_f32_16x16x32_bf16(W.w[1][ks], af[ks], acc1, 0, 0, 0); }
        u32x4 o;
        if (MODE == 0) { float x[8];
#pragma unroll
            for (int j = 0; j < 4; ++j) { x[j] = -0.60653066f * sigmoidf_(W.b0[j] + acc0[j]); x[4 + j] = -0.60653066f * sigmoidf_(W.b1[j] + acc1[j]); }
            o.x = pkh2(x[0], x[1]); o.y = pkh2(x[2], x[3]); o.z = pkh2(x[4], x[5]); o.w = pkh2(x[6], x[7]);
        } else if (MODE == 1) { float x[8];
#pragma unroll
            for (int j = 0; j < 4; ++j) { x[j] = sigmoidf_(W.b0[j] + acc0[j]); x[4 + j] = sigmoidf_(W.b1[j] + acc1[j]); }
            o.x = pkh2(x[0], x[1]); o.y = pkh2(x[2], x[3]); o.z = pkh2(x[4], x[5]); o.w = pkh2(x[6], x[7]);
        } else { o.x = pkbf(acc0[0], acc0[1]); o.y = pkbf(acc0[2], acc0[3]); o.z = pkbf(acc1[0], acc1[1]); o.w = pkbf(acc1[2], acc1[3]); }
        *(u32x4*)(out + (size_t)(16 * mt) * ostride) = o;
    }
}
__device__ __forceinline__ void p2x_lowrank(const Frame& F, int l) {
    const int lane = F.lane, c8 = lane & 31, hf = lane >> 5, li = lane & 15, fq = lane >> 4;
    const bf16* P = (const bf16*)(F.ws + WS_P); const float* mu = kin<I_MU>() + l * N_SHIFT + 3072 + 8 * c8;
    const f32x4 m0 = *(const f32x4*)mu, m1 = *(const f32x4*)(mu + 4);
    const float* const pKKc = kin<I_KK>() + l * 1024; const float* const muK = kin<I_MU>() + l * N_SHIFT + 1024; float* KNo = (float*)(F.ws + WS_KN);
    const bf16* BT = (const bf16*)(F.ws + WS_BT_LR) + (size_t)l * 3072 * 256; const bf16* BTV = (const bf16*)(F.ws + WS_VU);
    const float* const pW0 = kin<I_W0>() + l * 1024; const float* const pA0 = kin<I_A0>() + l * 1024; const float* const pV0 = kin<I_V0>();
    LAS unsigned char* tile = F.lds;
    const int cw = F.wave * 128;
#pragma unroll 1
    for (int item = F.vcu; item < T / 64; item += F.G) { const int gw = item * 8 + F.wave;
        LrW<2> W2[2]; LrW<4> W4[2]; LrW<1> W1[2];
        lrx_load<2>(W2[0], BT + (size_t)cw * 256, 256, pW0 + cw, li, fq);
#pragma unroll
        for (int i = 0; i < 4; ++i) { const int row = 8 * F.wave + 2 * i + hf, tok = item * 64 + row; float cur[8], prv[8], o[8];
            load8(P + (size_t)tok * P_LD + C_WD + 8 * c8, cur);
            if ((tok & (SEQ - 1)) != 0) load8(P + (size_t)(tok - 1) * P_LD + C_WD + 8 * c8, prv); else {
#pragma unroll
                for (int j = 0; j < 8; ++j) prv[j] = 0.f; }
#pragma unroll
            for (int j = 0; j < 8; ++j) { const float v = cur[j] + (prv[j] - cur[j]) * (j < 4 ? m0[j] : m1[j - 4]); o[j] = (c8 < 8) ? tanhf_(v) : ((c8 < 16) ? v : sigmoidf_(v)); }
            u32x4 w; w.x = pkbf(o[0], o[1]); w.y = pkbf(o[2], o[3]); w.z = pkbf(o[4], o[5]); w.w = pkbf(o[6], o[7]);
            *(LAS u32x4*)(tile + row * LRX_PITCH + 16 * c8) = w; }
        if (l == 1 && F.tid < 256) { const int row = F.tid >> 2, ch = F.tid & 3;
            *(LAS u32x4*)(tile + row * LRX_PITCH + 512 + 16 * ch) = *(const u32x4*)(P + (size_t)(item * 64 + row) * P_LD + C_VD + 8 * ch); }
#pragma unroll 1
        for (int ch = 0; ch < 2; ++ch) { const int col0 = 512 * ch + 8 * lane; float kkc[8], muk[8], kp_[8];
#pragma unroll
            for (int j = 0; j < 8; ++j) { kkc[j] = pKKc[col0 + j]; muk[j] = muK[col0 + j]; kp_[j] = 0.f; }
            const int tok0 = gw * 8;
            if ((tok0 & (SEQ - 1)) != 0) load8(P + (size_t)(tok0 - 1) * P_LD + C_K + col0, kp_);
#pragma unroll 4
            for (int tk = 0; tk < 8; ++tk) { float kc[8]; load8(P + (size_t)(tok0 + tk) * P_LD + C_K + col0, kc); float ss = 0.f;
#pragma unroll
                for (int j = 0; j < 8; ++j) { const float k = (kc[j] + (kp_[j] - kc[j]) * muk[j]) * kkc[j]; ss += k * k; kp_[j] = kc[j]; }
                ss = sum8(ss);
                if ((lane & 7) == 0) KNo[(tok0 + tk) * 16 + 8 * ch + (lane >> 3)] = __builtin_amdgcn_rsqf(fmaxf(ss, 1e-24f)); } }
        __syncthreads();
        bf16* outb = (bf16*)(F.ws + WS_LR) + (size_t)(item * 64 + li) * 3072 + cw + 8 * fq;
#pragma unroll
        for (int j = 0; j < 8; ++j) { const int a = j >> 2, g = j & 3, jn = j + 1, an = jn >> 2, gn = jn & 3;
            if (jn < 8) lrx_load<2>(W2[jn & 1], BT + (size_t)(an * 1024 + cw + 32 * gn) * 256 + 64 * an, 256, (an ? pA0 : pW0) + cw + 32 * gn, li, fq);
            else lrx_load<4>(W4[0], BT + (size_t)(2048 + cw) * 256 + 128, 256, nullptr, li, fq);
            if (a == 0) lrx_job<2, 0>(W2[j & 1], tile, 0, outb + 32 * g, 3072, li, fq); else lrx_job<2, 1>(W2[j & 1], tile, 64, outb + 1024 + 32 * g, 3072, li, fq); }
#pragma unroll
        for (int g = 0; g < 4; ++g) {
            if (g + 1 < 4) lrx_load<4>(W4[(g + 1) & 1], BT + (size_t)(2048 + cw + 32 * (g + 1)) * 256 + 128, 256, nullptr, li, fq);
            else if (l == 1) lrx_load<1>(W1[0], BTV + (size_t)cw * 32, 32, pV0 + cw, li, fq);
            lrx_job<4, 2>(W4[g & 1], tile, 128, outb + 2048 + 32 * g, 3072, li, fq); }
        if (l == 1) { bf16* outv = (bf16*)(F.ws + WS_VG) + (size_t)(item * 64 + li) * 1024 + cw + 8 * fq;
#pragma unroll
            for (int g = 0; g < 4; ++g) {
                if (g + 1 < 4) lrx_load<1>(W1[(g + 1) & 1], BTV + (size_t)(cw + 32 * (g + 1)) * 32, 32, pV0 + cw + 32 * (g + 1), li, fq);
                lrx_job<1, 1>(W1[g & 1], tile, 256, outv + 32 * g, 1024, li, fq); } }
        __syncthreads();
    }
}

__device__ __forceinline__ f32x4 h4_to_f4(const u32x2 u) { return (f32x4){hlo(u.x), hhi(u.x), hlo(u.y), hhi(u.y)}; }
constexpr size_t WS_YCK = WS_Y;
typedef short bf16x8 __attribute__((ext_vector_type(8)));
typedef float f32x16 __attribute__((ext_vector_type(16)));
constexpr int CK_XK = 0, CK_XR = 4608, CK_BH = 9216, CK_KH = 14336, CK_GB = 19456, CK_VT = 19712, CK_X3SZ = 22272;
constexpr int CK_XB = 0, CK_XP = 4608, CK_P2SZ = 9216;
constexpr int CK_TK = 0, CK_TBR = 2560, CK_TKR = 5120, CK_T12 = 7680, CK_TBT = 11776, CK_MT = 15872, CK_T2SZ = 18432;
constexpr int CK_X3_OFF = 0, CK_P2_OFF = 3 * CK_X3SZ, CK_T2_OFF = CK_P2_OFF + 2 * CK_P2SZ, CK_STASH = CK_T2_OFF + 2 * CK_T2SZ;
static_assert(CK_STASH + 8192 <= RING_BYTES, "chunked-scan LDS map");
#define CK_MFMA(a, b, c) __builtin_amdgcn_mfma_f32_32x32x16_bf16((a), (b), (c), 0, 0, 0)
__device__ __forceinline__ bf16x8 ck_frag(const LAS unsigned char* base, int pitch, int row, int kel) { return *(const LAS bf16x8*)(base + row * pitch + kel * 2); }
struct CkRegs { u32x2 rP, rA, rB, kP, kA, kB, vP, vA, vB, dwA, dwB, apA, apB, vmA, vmB, vfA, vfB; float knA, knB; };
struct CkConst { f32x4 a0, kk, ka, rk, w0, v0, mur, muk, muv; };
__device__ __forceinline__ f32x4 b4_to_f4(const u32x2 u) { return (f32x4){bflo(u.x), bfhi(u.x), bflo(u.y), bfhi(u.y)}; }
__device__ __forceinline__ void ck_issue(const Frame& F, int pw, int l, int b, int h, int half, int blk, CkRegs& R) {
    const int s2 = F.lane >> 2, cq = F.lane & 3, col = h * 64 + 16 * pw + 4 * cq; const size_t tA = (size_t)b * SEQ + blk * 32 + 2 * s2;
    const bf16* P = (const bf16*)(F.ws + WS_P) + tA * P_LD + col; const bf16* LR = (const bf16*)(F.ws + WS_LR) + tA * 3072 + col; const float* KN = (const float*)(F.ws + WS_KN) + tA * 16 + h;
    R.rA = *(const u32x2*)(P + C_R); R.rB = *(const u32x2*)(P + P_LD + C_R); R.kA = *(const u32x2*)(P + C_K); R.kB = *(const u32x2*)(P + P_LD + C_K); R.vA = *(const u32x2*)(P + C_V); R.vB = *(const u32x2*)(P + P_LD + C_V);
    if ((tA & (SEQ - 1)) != 0) { R.rP = *(const u32x2*)(P - P_LD + C_R); R.kP = *(const u32x2*)(P - P_LD + C_K); R.vP = *(const u32x2*)(P - P_LD + C_V); } else { R.rP = (u32x2){0u, 0u}; R.kP = R.rP; R.vP = R.rP; }
    R.dwA = *(const u32x2*)LR; R.dwB = *(const u32x2*)(LR + 3072); R.apA = *(const u32x2*)(LR + 1024); R.apB = *(const u32x2*)(LR + 3072 + 1024);
    R.knA = KN[0]; R.knB = KN[16];
    if (l == 1) { const bf16* VG = (const bf16*)(F.ws + WS_VG) + tA * 1024 + col; R.vmA = *(const u32x2*)VG; R.vmB = *(const u32x2*)(VG + 1024); const bf16* V0 = (const bf16*)(F.ws + WS_V0) + tA * 1024 + col; R.vfA = *(const u32x2*)V0; R.vfB = *(const u32x2*)(V0 + 1024); }
    (void)half;
}
__device__ __forceinline__ void ck_elem(const CkConst& C, int l, const f32x4 rc, const f32x4 rp, const f32x4 kc, const f32x4 kp_, const f32x4 vc, const f32x4 vp, const f32x4 dw, const f32x4 ap, const float kn,
                                        const f32x4 vm, const f32x4 vf, f32x4& r, f32x4& kk, f32x4& bq, f32x4& kp, f32x4& lw, f32x4& v, float& bo) {
#pragma unroll
    for (int e = 0; e < 4; ++e) {
        r[e] = rc[e] + (rp[e] - rc[e]) * C.mur[e]; const float k = kc[e] + (kp_[e] - kc[e]) * C.muk[e]; float vv = vc[e] + (vp[e] - vc[e]) * C.muv[e];
        const float av = ap[e]; kk[e] = k * C.kk[e] * kn;     bq[e] = kk[e] * av; kp[e] = k * (1.0f + (av - 1.0f) * C.ka[e]); bo += r[e] * kp[e] * C.rk[e];
        lw[e] = dw[e];
        if (l == 1) vv = vv + (vf[e] - vv) * vm[e];
        v[e] = vv; }
}
__device__ __forceinline__ void ck_stage1(const Frame& F, int pw, int l, int b, int h, int half, int blk, const CkConst& C, LAS unsigned char* BX, LAS unsigned char* BP, CkRegs& R, bool issue_next) {
    const int lane = F.lane, s2 = lane >> 2, cq = lane & 3, c0 = 16 * pw + 4 * cq, cp = 16 * pw + 4 * (((cq & 1) << 1) | (cq >> 1));
    f32x4 kkA, kkB, bqA, bqB, kpA, kpB, rA, rB, lwA, lwB, vA, vB; float boA = 0.f, boB = 0.f;
    { const f32x4 rcA = b4_to_f4(R.rA), kcA = b4_to_f4(R.kA), vcA = b4_to_f4(R.vA), zz = (f32x4){0.f, 0.f, 0.f, 0.f};
      ck_elem(C, l, rcA, b4_to_f4(R.rP), kcA, b4_to_f4(R.kP), vcA, b4_to_f4(R.vP), h4_to_f4(R.dwA), h4_to_f4(R.apA), R.knA, l == 1 ? h4_to_f4(R.vmA) : zz, l == 1 ? h4_to_f4(R.vfA) : zz, rA, kkA, bqA, kpA, lwA, vA, boA);
      ck_elem(C, l, b4_to_f4(R.rB), rcA, b4_to_f4(R.kB), kcA, b4_to_f4(R.vB), vcA, h4_to_f4(R.dwB), h4_to_f4(R.apB), R.knB, l == 1 ? h4_to_f4(R.vmB) : zz, l == 1 ? h4_to_f4(R.vfB) : zz, rB, kkB, bqB, kpB, lwB, vB, boB); }
    asm volatile("" ::: "memory");
    if (issue_next) ck_issue(F, pw, l, b, h, half, blk + 1, R);
    asm volatile("" ::: "memory");
    { const size_t tA = (size_t)b * SEQ + blk * 32 + 2 * s2;
      boA += __shfl_xor(boA, 1); boA += __shfl_xor(boA, 2); boB += __shfl_xor(boB, 1); boB += __shfl_xor(boB, 2);
      if ((pw >> 1) == half) { if (cq == 0) { float* bp = (float*)(F.ws + WS_BONP) + (tA * 16 + h) * 4 + pw; bp[0] = boA; bp[64] = boB; }
          bf16* Vo = (bf16*)(F.ws + (l == 0 ? WS_V0 : WS_V1)) + tA * 1024 + h * 64 + c0;
          *(u32x2*)Vo = (u32x2){pkh2(vA[0], vA[1]), pkh2(vA[2], vA[3])}; *(u32x2*)(Vo + 1024) = (u32x2){pkh2(vB[0], vB[1]), pkh2(vB[2], vB[3])};
#pragma unroll
          for (int e = 0; e < 4; ++e) *(LAS unsigned*)(BX + CK_VT + (16 * (pw & 1) + 4 * cq + e) * 80 + (2 * s2) * 2) = pkbf(vA[e], vB[e]); } }
    float xkA[4], xkB[4], xrA[4], xrB[4], xbA[4], xbB[4], xpA[4], xpB[4], bhA[4], bhB[4], khA[4], khB[4], gb[4];
    float xs[4], Tr[4][4];
#pragma unroll
    for (int e = 0; e < 4; ++e) { lwA[e] *= 1.44269504f; lwB[e] *= 1.44269504f; float x = lwA[e] + lwB[e]; x += dpp_f<0x114>(x); x += dpp_f<0x118>(x); xs[e] = x; }
#pragma unroll
    for (int e = 0; e < 4; ++e)
#pragma unroll
        for (int rw = 0; rw < 4; ++rw) Tr[e][rw] = __shfl(xs[e], 16 * rw + 12 + cq);
    { const int row = lane >> 4; const float m0 = row > 0 ? 1.f : 0.f, m1 = row > 1 ? 1.f : 0.f, m2 = row > 2 ? 1.f : 0.f;
#pragma unroll
    for (int e = 0; e < 4; ++e) {
        const float LB = xs[e] + (m0 * Tr[e][0] + m1 * Tr[e][1] + m2 * Tr[e][2]), LA = LB - lwB[e], L0 = LA - lwA[e], Lt = (Tr[e][0] + Tr[e][1]) + (Tr[e][2] + Tr[e][3]);
        const float eL0 = __builtin_amdgcn_exp2f(L0), eLA = __builtin_amdgcn_exp2f(LA), eLB = __builtin_amdgcn_exp2f(LB), iLA = __builtin_amdgcn_exp2f(-LA), iLB = __builtin_amdgcn_exp2f(-LB), eLt = __builtin_amdgcn_exp2f(Lt), tA = eLt * iLA, tB = eLt * iLB;
        xkA[e] = kkA[e] * eL0; xkB[e] = kkB[e] * eLA; xrA[e] = rA[e] * eLA; xrB[e] = rB[e] * eLB;
        xbA[e] = bqA[e] * iLA; xbB[e] = bqB[e] * iLB; xpA[e] = kpA[e] * iLA; xpB[e] = kpB[e] * iLB;
        bhA[e] = bqA[e] * tA; bhB[e] = bqB[e] * tB; khA[e] = kpA[e] * tA; khB[e] = kpB[e] * tB; gb[e] = eLt;
    } }
    const int oA = (2 * s2) * 144 + cp * 2, oB = oA + 144;
    *(LAS u32x2*)(BX + CK_XK + oA) = (u32x2){pkbf(xkA[0], xkA[1]), pkbf(xkA[2], xkA[3])}; *(LAS u32x2*)(BX + CK_XK + oB) = (u32x2){pkbf(xkB[0], xkB[1]), pkbf(xkB[2], xkB[3])};
    *(LAS u32x2*)(BX + CK_XR + oA) = (u32x2){pkbf(xrA[0], xrA[1]), pkbf(xrA[2], xrA[3])}; *(LAS u32x2*)(BX + CK_XR + oB) = (u32x2){pkbf(xrB[0], xrB[1]), pkbf(xrB[2], xrB[3])};
    *(LAS u32x2*)(BP + CK_XB + oA) = (u32x2){pkbf(xbA[0], xbA[1]), pkbf(xbA[2], xbA[3])}; *(LAS u32x2*)(BP + CK_XB + oB) = (u32x2){pkbf(xbB[0], xbB[1]), pkbf(xbB[2], xbB[3])};
    *(LAS u32x2*)(BP + CK_XP + oA) = (u32x2){pkbf(xpA[0], xpA[1]), pkbf(xpA[2], xpA[3])}; *(LAS u32x2*)(BP + CK_XP + oB) = (u32x2){pkbf(xpB[0], xpB[1]), pkbf(xpB[2], xpB[3])};
    const int i0 = 2 * s2, pst = (i0 & 16) | ((i0 & 4) << 1) | ((i0 & 8) >> 1) | (i0 & 3);
#pragma unroll
    for (int e = 0; e < 4; ++e) { *(LAS unsigned*)(BX + CK_BH + (c0 + e) * 80 + pst * 2) = pkbf(bhA[e], bhB[e]); *(LAS unsigned*)(BX + CK_KH + (c0 + e) * 80 + (2 * s2) * 2) = pkbf(khA[e], khB[e]); }
    if (s2 == 0) *(LAS f32x4*)(BX + CK_GB + c0 * 4) = (f32x4){gb[0], gb[1], gb[2], gb[3]};

}
__device__ __forceinline__ void ck_stage2(const Frame& F, int ti, const LAS unsigned char* BX, const LAS unsigned char* BP, LAS unsigned char* BT) {
    const int r = F.lane & 31, hh = F.lane >> 5;
    const LAS unsigned char* Aa = BP + ((ti < 2) ? CK_XB : CK_XP); const LAS unsigned char* Ba = BX + ((ti & 1) ? CK_XR : CK_XK);
    f32x16 acc;
#pragma unroll
    for (int i = 0; i < 16; ++i) acc[i] = 0.f;
#pragma unroll
    for (int ks = 0; ks < 4; ++ks) acc = CK_MFMA(ck_frag(Aa, 144, r, 16 * ks + 8 * hh), ck_frag(Ba, 144, r, 16 * ks + 8 * hh), acc);
    if (ti == 0) {
        { const u32x4 z = (u32x4){0u, 0u, 0u, 0u}, w = (u32x4){pkbf(acc[0], acc[1]), pkbf(acc[2], acc[3]), pkbf(acc[4], acc[5]), pkbf(acc[6], acc[7])};
          *(LAS u32x4*)(BT + CK_T12 + r * 80 + 16 * hh) = (r >= 16) ? w : z; }
#pragma unroll
        for (int m = 0; m < 4; ++m) { f32x4 t;
#pragma unroll
            for (int e = 0; e < 4; ++e) t[e] = (8 * m + 4 * hh + e < r) ? acc[4 * m + e] : 0.f;
            *(LAS f32x4*)(BT + CK_TBT + (r * 32 + 8 * m + 4 * hh) * 4) = t; }
    } else { const int off = (ti == 1) ? CK_TBR : ((ti == 2) ? CK_TK : CK_TKR);
#pragma unroll
        for (int m = 0; m < 4; ++m) { float t[4];
#pragma unroll
            for (int e = 0; e < 4; ++e) { const int i = 8 * m + 4 * hh + e; const bool keep = (ti == 2) ? (i < r) : (i <= r); t[e] = keep ? acc[4 * m + e] : 0.f; }
            const int col = (ti == 1) ? (16 * (m >> 1) + 8 * hh + 4 * (m & 1)) : (8 * m + 4 * hh);
            *(LAS u32x2*)(BT + off + r * 80 + col * 2) = (u32x2){pkbf(t[0], t[1]), pkbf(t[2], t[3])}; }
    }
    if (ti == 0) {
        LDS_WAIT();
        const int qb = (r >> 4) & 1;
        const LAS float* TBT = (const LAS float*)(BT + CK_TBT) + (16 * qb) * 32 + 16 * qb;
        float x[16];
        int cc = r & 15; asm volatile("" : "+v"(cc));
#pragma unroll
        for (int k = 0; k < 16; ++k) x[k] = (k == cc) ? 1.f : 0.f;
        { f32x4 tc[4], tn[4];
#pragma unroll
          for (int j4 = 0; j4 < 4; ++j4) tc[j4] = *(const LAS f32x4*)(TBT + 15 * 32 + 4 * j4);
#pragma unroll
          for (int kk = 0; kk < 15; ++kk) { const int k = 15 - kk; const float xk = x[k];
              int off = (k - 1) * 32; asm volatile("" : "+v"(off) : "v"(xk));
              if (k - 1 >= 1) {
#pragma unroll
                  for (int j4 = 0; j4 <= (k - 2) / 4; ++j4) tn[j4] = *(const LAS f32x4*)(TBT + off + 4 * j4); }
#pragma unroll
              for (int j4 = 0; j4 <= (k - 1) / 4; ++j4) {
#pragma unroll
                  for (int e = 0; e < 4; ++e) { const int i = 4 * j4 + e; if (i < k) x[i] = __builtin_fmaf(-tc[j4][e], xk, x[i]); } }
#pragma unroll
              for (int j4 = 0; j4 < 4; ++j4) tc[j4] = tn[j4]; } }
        if (hh == 0) { const u32x4 z = (u32x4){0u, 0u, 0u, 0u};
            const u32x4 w0 = (u32x4){pkbf(x[0], x[1]), pkbf(x[2], x[3]), pkbf(x[8], x[9]), pkbf(x[10], x[11])}, w1 = (u32x4){pkbf(x[4], x[5]), pkbf(x[6], x[7]), pkbf(x[12], x[13]), pkbf(x[14], x[15])};
            LAS unsigned char* row = BT + CK_MT + r * 80;
            *(LAS u32x4*)(row + 32 * qb) = w0; *(LAS u32x4*)(row + 32 * qb + 16) = w1; *(LAS u32x4*)(row + 32 * (1 - qb)) = z; *(LAS u32x4*)(row + 32 * (1 - qb) + 16) = z; }
    }
}
#define CK_BAR() do { asm volatile("s_waitcnt lgkmcnt(0)" ::: "memory"); __builtin_amdgcn_s_barrier(); asm volatile("" ::: "memory"); } while (0)
__device__ __forceinline__ void p4_scan(const Frame& F, int l, int probe = 0) {
#pragma unroll 1
    for (int unit = F.vcu; unit < NBATCH * NHEAD * 2; unit += F.G) {
        const int b = unit >> 5, h = (unit >> 1) & 15, half = unit & 1;
        const bool pre = F.wave >= 4, mainw = F.wave == 0;
        const int r = F.lane & 31, hh = F.lane >> 5;
        constexpr int NBLKc = SEQ / 32;
        const int w_ = F.wave;
        if (w_ == 0) {
            f32x16 ST0, ST1;
#pragma unroll
            for (int i = 0; i < 16; ++i) { ST0[i] = 0.f; ST1[i] = 0.f; }
#pragma unroll 1
            for (int blk = -2; blk < NBLKc; ++blk) {
                const LAS unsigned char* BX = F.lds + CK_X3_OFF + ((blk + 3) % 3) * CK_X3SZ; const LAS unsigned char* BT = F.lds + CK_T2_OFF + (blk & 1) * CK_T2SZ;
                bf16x8 SH[2][2], SL[2][2], NUF[2], VF[2]; f32x16 RH, YT;
                if (blk >= 0 && !(probe & 1)) {
#pragma unroll
                for (int c = 0; c < 2; ++c)
#pragma unroll
                    for (int s = 0; s < 2; ++s) { u32x4 ph, pl;
#pragma unroll
                        for (int p = 0; p < 4; ++p) { const float x0 = (c ? ST1 : ST0)[8 * s + 2 * p], x1 = (c ? ST1 : ST0)[8 * s + 2 * p + 1]; const unsigned hp = pkbf(x0, x1);
                            ph[p] = hp;
#if defined(CK_LO)
                            pl[p] = pkbf(x0 - bflo(hp), x1 - bfhi(hp));
#endif
                        }
                        SH[c][s] = __builtin_bit_cast(bf16x8, ph);
#if defined(CK_LO)
                        SL[c][s] = __builtin_bit_cast(bf16x8, pl);
#endif
                    }
                { LAS f32x4* stash = (LAS f32x4*)(F.lds + CK_STASH) + F.lane;
#pragma unroll
                  for (int m = 0; m < 4; ++m) { stash[64 * m] = (f32x4){ST0[4 * m], ST0[4 * m + 1], ST0[4 * m + 2], ST0[4 * m + 3]}; stash[64 * (4 + m)] = (f32x4){ST1[4 * m], ST1[4 * m + 1], ST1[4 * m + 2], ST1[4 * m + 3]}; } }
                VF[0] = ck_frag(BX + CK_VT, 80, r, 8 * hh); VF[1] = ck_frag(BX + CK_VT, 80, r, 16 + 8 * hh);
#pragma unroll
                for (int i = 0; i < 16; ++i) RH[i] = 0.f;
                { bf16x8 ak[2][2], at[2];
#pragma unroll
                  for (int c = 0; c < 2; ++c)
#pragma unroll
                      for (int s = 0; s < 2; ++s) ak[c][s] = ck_frag(BX + CK_XK, 144, r, 32 * c + 16 * s + 8 * hh);
                  at[0] = ck_frag(BT + CK_TK, 80, r, 8 * hh); at[1] = ck_frag(BT + CK_TK, 80, r, 16 + 8 * hh);
#pragma unroll
                  for (int c = 0; c < 2; ++c)
#pragma unroll
                      for (int s = 0; s < 2; ++s) RH = CK_MFMA(ak[c][s], SH[c][s], RH);
#pragma unroll
                  for (int ks = 0; ks < 2; ++ks) RH = CK_MFMA(at[ks], VF[ks], RH); }
                { const bf16x8 mt0 = ck_frag(BT + CK_MT, 80, r, 8 * hh), mt1 = ck_frag(BT + CK_MT, 80, r, 16 + 8 * hh), t12 = ck_frag(BT + CK_T12, 80, r, 8 * hh);
                  u32x4 p4;
#pragma unroll
                  for (int p = 0; p < 4; ++p) p4[p] = pkbf(RH[2 * p], RH[2 * p + 1]);
                  f32x16 UT;
#pragma unroll
                  for (int i = 0; i < 16; ++i) UT[i] = 0.f;
                  UT = CK_MFMA(mt0, __builtin_bit_cast(bf16x8, p4), UT);
#pragma unroll
                  for (int p = 0; p < 4; ++p) p4[p] = pkbf(UT[2 * p], UT[2 * p + 1]) ^ 0x80008000u;
                  NUF[0] = __builtin_bit_cast(bf16x8, p4);
                  RH = CK_MFMA(t12, NUF[0], RH);
#pragma unroll
                  for (int p = 0; p < 4; ++p) p4[p] = pkbf(RH[8 + 2 * p], RH[8 + 2 * p + 1]);
                  UT = CK_MFMA(mt1, __builtin_bit_cast(bf16x8, p4), UT);
#pragma unroll
                  for (int p = 0; p < 4; ++p) p4[p] = pkbf(UT[8 + 2 * p], UT[8 + 2 * p + 1]) ^ 0x80008000u;
                  NUF[1] = __builtin_bit_cast(bf16x8, p4); }
#pragma unroll
                for (int i = 0; i < 16; ++i) YT[i] = 0.f;
                { bf16x8 ar[2][2];
#pragma unroll
                  for (int c = 0; c < 2; ++c)
#pragma unroll
                      for (int s = 0; s < 2; ++s) ar[c][s] = ck_frag(BX + CK_XR, 144, r, 32 * c + 16 * s + 8 * hh);
#pragma unroll
                  for (int c = 0; c < 2; ++c)
#pragma unroll
                      for (int s = 0; s < 2; ++s) YT = CK_MFMA(ar[c][s], SH[c][s], YT); }
                VF[0] = ck_frag(BX + CK_VT, 80, r, 8 * hh); VF[1] = ck_frag(BX + CK_VT, 80, r, 16 + 8 * hh);
                asm volatile("" ::: "memory");
#pragma unroll
                for (int ks = 0; ks < 2; ++ks) { const bf16x8 fbr = ck_frag(BT + CK_TBR, 80, r, 16 * ks + 8 * hh), fkr = ck_frag(BT + CK_TKR, 80, r, 16 * ks + 8 * hh); YT = CK_MFMA(fbr, NUF[ks], YT); YT = CK_MFMA(fkr, VF[ks], YT); }
                { bf16* yo = (bf16*)(F.ws + WS_YCK) + ((size_t)b * SEQ + blk * 32) * 1024 + h * 64 + half * 32 + r;
#pragma unroll
                  for (int reg = 0; reg < 16; ++reg) yo[(size_t)((reg & 3) + 8 * (reg >> 2) + 4 * hh) * 1024] = (bf16)f2bf(YT[reg]); }
                { const LAS f32x4* stash = (const LAS f32x4*)(F.lds + CK_STASH) + F.lane;
#pragma unroll
                  for (int m = 0; m < 4; ++m) { const f32x4 g0 = *(const LAS f32x4*)(BX + CK_GB + (8 * m + 4 * hh) * 4), g1 = *(const LAS f32x4*)(BX + CK_GB + (32 + 8 * m + 4 * hh) * 4);
                    const f32x4 a0 = stash[64 * m] * g0, a1 = stash[64 * (4 + m)] * g1;
#pragma unroll
                    for (int e = 0; e < 4; ++e) { ST0[4 * m + e] = a0[e]; ST1[4 * m + e] = a1[e]; } } }
#pragma unroll
                for (int ks = 0; ks < 2; ++ks) {
                    const bf16x8 b0 = ck_frag(BX + CK_BH, 80, r, 16 * ks + 8 * hh), b1 = ck_frag(BX + CK_BH, 80, 32 + r, 16 * ks + 8 * hh), k0 = ck_frag(BX + CK_KH, 80, r, 16 * ks + 8 * hh), k1 = ck_frag(BX + CK_KH, 80, 32 + r, 16 * ks + 8 * hh);
                    ST0 = CK_MFMA(b0, NUF[ks], ST0); ST1 = CK_MFMA(b1, NUF[ks], ST1); ST0 = CK_MFMA(k0, VF[ks], ST0); ST1 = CK_MFMA(k1, VF[ks], ST1); }
                }
                CK_BAR();
            }
        } else if (w_ >= 1 && w_ <= 4) {
            const int pw = w_ - 1;
            CkConst CC;
            { const int c = l * 1024 + h * 64 + 16 * pw + 4 * (F.lane & 3); const float* mu = kin<I_MU>() + l * N_SHIFT + h * 64 + 16 * pw + 4 * (F.lane & 3);
              CC.a0 = *(const f32x4*)(kin<I_A0>() + c); CC.kk = *(const f32x4*)(kin<I_KK>() + c); CC.ka = *(const f32x4*)(kin<I_KA>() + c); CC.rk = *(const f32x4*)(kin<I_RK>() + c); CC.w0 = *(const f32x4*)(kin<I_W0>() + c);
              CC.v0 = (l == 1) ? *(const f32x4*)(kin<I_V0>() + (c - 1024)) : (f32x4){0.f, 0.f, 0.f, 0.f}; CC.mur = *(const f32x4*)mu; CC.muk = *(const f32x4*)(mu + 1024); CC.muv = *(const f32x4*)(mu + 2048); }
            CkRegs CR;
            ck_issue(F, pw, l, b, h, half, 0, CR);
#pragma unroll 1
            for (int blk = -2; blk < NBLKc; ++blk) {
                if (blk + 2 < NBLKc && !(probe & 4) && !((probe & 16) && w_ == 4)) ck_stage1(F, pw, l, b, h, half, blk + 2, CC, F.lds + CK_X3_OFF + ((blk + 2 + 3) % 3) * CK_X3SZ, F.lds + CK_P2_OFF + ((blk + 2) & 1) * CK_P2SZ, CR, blk + 3 < NBLKc);
                CK_BAR();
            }
        } else {
#pragma unroll 1
            for (int blk = -2; blk < NBLKc; ++blk) {
                if (blk + 1 >= 0 && blk + 1 < NBLKc) {
                    const LAS unsigned char* BX = F.lds + CK_X3_OFF + ((blk + 1 + 3) % 3) * CK_X3SZ; const LAS unsigned char* BP = F.lds + CK_P2_OFF + ((blk + 1) & 1) * CK_P2SZ; LAS unsigned char* BT = F.lds + CK_T2_OFF + ((blk + 1) & 1) * CK_T2SZ;
                    if (w_ == 5) { if (!(probe & 2)) ck_stage2(F, 0, BX, BP, BT); }
                    else if (probe & 8) {}
                    else if (w_ == 6) { ck_stage2(F, 1, BX, BP, BT); ck_stage2(F, 3, BX, BP, BT); }
                    else ck_stage2(F, 2, BX, BP, BT);
                }
                CK_BAR();
            }
        }
    }
}

__device__ __forceinline__ void p5_post(const Frame& F, int l) {
    const int lane = F.lane;
    const float* const pCW = kin<I_CONVW>() + l * 3 * 1024; const float* const pLNW = kin<I_LNW>() + l * 1024; const float* const pLNB = kin<I_LNB>() + l * 1024;
    const bf16* P = (const bf16*)(F.ws + WS_P); const bf16* Y = (const bf16*)(F.ws + WS_Y); const bf16* LRg = (const bf16*)(F.ws + WS_LR) + 2048;
    const bf16* V = (const bf16*)(F.ws + (l == 0 ? WS_V0 : WS_V1)); const float* BONP = (const float*)(F.ws + WS_BONP); bf16* M = (bf16*)(F.ws + WS_H);
#pragma unroll 1
    for (int gw = F.vcu * NWAVES + F.wave; gw < T / 8; gw += F.G * NWAVES) { const int tok0 = gw * 8;
#pragma unroll 1
    for (int ch = 0; ch < 2; ++ch) { const int col0 = 512 * ch + 8 * lane, head = 8 * ch + (lane >> 3);
        float cw0[8], cw1[8], cw2[8], lnw[8], lnb[8], um1[8], um2[8];
#pragma unroll
        for (int j = 0; j < 8; ++j) { cw0[j] = pCW[col0 + j]; cw1[j] = pCW[1024 + col0 + j]; cw2[j] = pCW[2048 + col0 + j];
            lnw[j] = pLNW[col0 + j]; lnb[j] = pLNB[col0 + j]; um1[j] = 0.f; um2[j] = 0.f; }
        const int t0 = tok0 & (SEQ - 1);
        if (t0 >= 1) load8(P + (size_t)(tok0 - 1) * P_LD + C_U + col0, um1);
        if (t0 >= 2) load8(P + (size_t)(tok0 - 2) * P_LD + C_U + col0, um2);
#pragma unroll 2
        for (int tk = 0; tk < 8; ++tk) { const int tok = tok0 + tk; const bf16* pr = P + (size_t)tok * P_LD + col0;
            float uu[8], gc[8], gb[8], y[8], v[8], g[8], o[8];
            load8(pr + C_U, uu); load8(pr + C_GCB, gc); load8(pr + C_GB, gb);
            load8(Y + (size_t)tok * 1024 + col0, y); load8h(V + (size_t)tok * 1024 + col0, v); load8(LRg + (size_t)tok * 3072 + col0, g);
            const f32x4 bo4 = *(const f32x4*)(BONP + ((size_t)tok * 16 + head) * 4); const float bo = (bo4[0] + bo4[1]) + (bo4[2] + bo4[3]);
            float sm = 0.f;
#pragma unroll
            for (int j = 0; j < 8; ++j) sm += y[j];
            const float mean = sum8(sm) * (1.0f / 64.0f); float sq = 0.f;
#pragma unroll
            for (int j = 0; j < 8; ++j) { y[j] -= mean; sq += y[j] * y[j]; }
            const float rstd = __builtin_amdgcn_rsqf(sum8(sq) * (1.0f / 64.0f) + LNX_EPS);
#pragma unroll
            for (int j = 0; j < 8; ++j) { const float u = uu[j]; const float conv = cw0[j] * um2[j] + cw1[j] * um1[j] + cw2[j] * u; um2[j] = um1[j]; um1[j] = u;
                const float yr = ((y[j] * rstd) * lnw[j] + lnb[j] + bo * v[j]) * g[j];
                o[j] = gc[j] * conv + sigmoidf_(gb[j]) * yr; }
            store8(M + (size_t)tok * 1024 + col0, o); }
    }
    }
}

struct GroupPick { float score, a1, a2; int i1, i2; };
__device__ __forceinline__ GroupPick pick_group(const f32x4 acc, float rstd, const float* br, const float* rb) {
    float aff[4], sel[4];
#pragma unroll
    for (int j = 0; j < 4; ++j) { aff[j] = sigmoidf_(rstd * acc[j] + br[j]); sel[j] = aff[j] + rb[j]; }
    int i1 = 0;
#pragma unroll
    for (int j = 1; j < 4; ++j) if (sel[j] > sel[i1]) i1 = j;
    int i2 = (i1 == 0) ? 1 : 0;
#pragma unroll
    for (int j = 0; j < 4; ++j) if (j != i1 && j != i2 && sel[j] > sel[i2]) i2 = j;
    GroupPick g; g.score = sel[i1] + sel[i2]; g.i1 = i1; g.i2 = i2; g.a1 = aff[i1]; g.a2 = aff[i2];
    float s1 = sel[0], s2 = sel[0]; (void)s1; (void)s2;
    return g;
}
__device__ __forceinline__ void p7_route(const Frame& F, int l, bool dry = false) {
    const int lane = F.lane, li = lane & 15, fq = lane >> 4, w = F.wave;
    LAS float* part = (LAS float*)F.lds;
    LAS float* gml = (LAS float*)(F.lds + 32768);
    LAS unsigned* lcnt = (LAS unsigned*)(F.lds + 65536);
    const float* X = (const float*)(F.ws + WS_X); const bf16* WH = (const bf16*)(F.ws + WS_WRT); const bf16* WL = WH + 32768; const float* const pN2G = kin<I_N2G>() + l * 1024; const float* const pRB = kin<I_RB>();
#pragma unroll 1
    for (int grp = F.vcu; grp < T / 64; grp += F.G) { const int b = grp >> 5;
        if (F.tid < 32) lcnt[F.tid] = 0u;
        { const float* ad = ada_ptr(F, l, b) + 4096; const int c = 2 * F.tid; const f32x2 g = *(const f32x2*)(pN2G + c), s = *(const f32x2*)(ad + c); gml[c] = g.x * (1.0f + s.x); gml[c + 1] = g.y * (1.0f + s.y); }
        bfv8 ah0[4], al0[4], ah1[4], al1[4];
        { const bf16* wh0 = WH + li * 1024 + 128 * w + 8 * fq; const bf16* wl0 = WL + li * 1024 + 128 * w + 8 * fq;
#pragma unroll
          for (int s = 0; s < 4; ++s) { ah0[s] = *(const bfv8*)(wh0 + 32 * s); al0[s] = *(const bfv8*)(wl0 + 32 * s); ah1[s] = *(const bfv8*)(wh0 + 16 * 1024 + 32 * s); al1[s] = *(const bfv8*)(wl0 + 16 * 1024 + 32 * s); } }
        __syncthreads();
#pragma unroll 1
        for (int it = 0; it < 4; ++it) { const int tok0 = grp * 64 + it * 16;
            const float* xp = X + (size_t)(tok0 + li) * 1024 + 128 * w + 8 * fq;
            f32x4 xa[4], xb[4];
#pragma unroll
            for (int s = 0; s < 4; ++s) { xa[s] = *(const f32x4*)(xp + 32 * s); xb[s] = *(const f32x4*)(xp + 32 * s + 4); }
            f32x4 acc0 = (f32x4){0.f, 0.f, 0.f, 0.f}, acc1 = acc0; float ssq = 0.f;
#pragma unroll
            for (int s = 0; s < 4; ++s) {
                const f32x4 ga = *(const LAS f32x4*)(gml + 128 * w + 32 * s + 8 * fq), gb = *(const LAS f32x4*)(gml + 128 * w + 32 * s + 8 * fq + 4);
                ssq += ((xa[s][0] * xa[s][0] + xa[s][1] * xa[s][1]) + (xa[s][2] * xa[s][2] + xa[s][3] * xa[s][3])) + ((xb[s][0] * xb[s][0] + xb[s][1] * xb[s][1]) + (xb[s][2] * xb[s][2] + xb[s][3] * xb[s][3]));
                const f32x4 ya = xa[s] * ga, yb = xb[s] * gb;
                u32x4 ph, pl;
                ph[0] = pkbf(ya[0], ya[1]); ph[1] = pkbf(ya[2], ya[3]); ph[2] = pkbf(yb[0], yb[1]); ph[3] = pkbf(yb[2], yb[3]);
                pl[0] = pkbf(ya[0] - bflo(ph[0]), ya[1] - bfhi(ph[0])); pl[1] = pkbf(ya[2] - bflo(ph[1]), ya[3] - bfhi(ph[1])); pl[2] = pkbf(yb[0] - bflo(ph[2]), yb[1] - bfhi(ph[2])); pl[3] = pkbf(yb[2] - bflo(ph[3]), yb[3] - bfhi(ph[3]));
                const bfv8 bh = __builtin_bit_cast(bfv8, ph), bl = __builtin_bit_cast(bfv8, pl);
                acc0 = __builtin_amdgcn_mfma_f32_16x16x32_bf16(ah0[s], bh, acc0, 0, 0, 0); acc0 = __builtin_amdgcn_mfma_f32_16x16x32_bf16(al0[s], bh, acc0, 0, 0, 0); acc0 = __builtin_amdgcn_mfma_f32_16x16x32_bf16(ah0[s], bl, acc0, 0, 0, 0);
                acc1 = __builtin_amdgcn_mfma_f32_16x16x32_bf16(ah1[s], bh, acc1, 0, 0, 0); acc1 = __builtin_amdgcn_mfma_f32_16x16x32_bf16(al1[s], bh, acc1, 0, 0, 0); acc1 = __builtin_amdgcn_mfma_f32_16x16x32_bf16(ah1[s], bl, acc1, 0, 0, 0);
            }
            ssq += __shfl_xor(ssq, 16); ssq += __shfl_xor(ssq, 32);
            { LAS float* pp = part + (w * 16 + li) * 36; *(LAS f32x4*)(pp + 4 * fq) = acc0; *(LAS f32x4*)(pp + 16 + 4 * fq) = acc1; if (fq == 0) pp[32] = ssq; }
            __syncthreads();
            if (w == 0) {
                f32x4 a0 = (f32x4){0.f, 0.f, 0.f, 0.f}, a1 = a0; float sq = 0.f;
#pragma unroll
                for (int ww = 0; ww < 8; ++ww) { const LAS float* q = part + (ww * 16 + li) * 36; a0 += *(const LAS f32x4*)(q + 4 * fq); a1 += *(const LAS f32x4*)(q + 16 + 4 * fq); sq += q[32]; }
                const float rstd = __builtin_amdgcn_rsqf(sq * (1.0f / 1024.0f) + NORM_EPS);
                const float* br = (const float*)(F.ws + WS_CTL + CTL_BIASR) + (l * 8 + b) * 32;
                const GroupPick ga_ = pick_group(a0, rstd, br + 4 * fq, pRB + 4 * fq), gb_ = pick_group(a1, rstd, br + 16 + 4 * fq, pRB + 16 + 4 * fq);
                const bool useb = gb_.score > ga_.score;
                const GroupPick gm = useb ? gb_ : ga_; const int mygrp = useb ? 4 + fq : fq;
                float bs = gm.score; int bg = mygrp;
#pragma unroll
                for (int off = 16; off < 64; off <<= 1) { const float os = __shfl_xor(bs, off); const int og = __shfl_xor(bg, off); if (os > bs || (os == bs && og < bg)) { bs = os; bg = og; } }
                if (mygrp == bg) { const int tok = tok0 + li; const int e0 = 4 * bg + gm.i1, e1 = 4 * bg + gm.i2; const float inv = 1.0f / (gm.a1 + gm.a2);
                    const int p0 = (int)__hip_atomic_fetch_add(lcnt + e0, 1u, __ATOMIC_RELAXED, __HIP_MEMORY_SCOPE_WORKGROUP), p1 = (int)__hip_atomic_fetch_add(lcnt + e1, 1u, __ATOMIC_RELAXED, __HIP_MEMORY_SCOPE_WORKGROUP);
                    int* EI = (int*)(F.ws + WS_EIDX); int* PO = (int*)(F.ws + WS_POS); float* WT = (float*)(F.ws + WS_WTS);
                    if (!dry) { EI[tok * 2] = e0; EI[tok * 2 + 1] = e1; PO[tok * 2] = p0; PO[tok * 2 + 1] = p1; WT[tok * 2] = gm.a1 * inv; WT[tok * 2 + 1] = gm.a2 * inv; } }
            }
            __syncthreads();
        }
        if (F.tid < 32 && !dry) ((int*)(F.ws + WS_HIST))[(l * 256 + grp) * 32 + F.tid] = (int)lcnt[F.tid];
        __syncthreads();
    }
}

__device__ __forceinline__ void expert_table(const Frame& F, int l, int grp = -1) {
    LAS int* tab = (LAS int*)(F.lds + TAB_OFF); LAS int* red = (LAS int*)F.lds;
    const int* hist = (const int*)(F.ws + WS_HIST) + l * 256 * 32; const int e = F.tid & 31, part = F.tid >> 5;
    int tot = 0, pre = 0;
    { int hv[16];
#pragma unroll
      for (int i = 0; i < 16; ++i) hv[i] = hist[(part * 16 + i) * 32 + e];
#pragma unroll
      for (int i = 0; i < 16; ++i) { tot += hv[i]; pre += (part * 16 + i < grp) ? hv[i] : 0; } }
    red[part * 32 + e] = tot; red[512 + part * 32 + e] = pre;
    __syncthreads();
    if (F.tid < 64) { int c = 0, pr = 0;
#pragma unroll
        for (int p = 0; p < 16; ++p) { c += red[p * 32 + e]; pr += red[512 + p * 32 + e]; }
        const int padded = (c + 255) & ~255; int inc = padded;
#pragma unroll
        for (int o = 1; o < 32; o <<= 1) { const int v = __shfl_up(inc, o); if (e >= o) inc += v; }
        if (F.lane < 32) { tab[e] = inc - padded; tab[33 + e] = (inc - padded) >> 8; tab[66 + e] = inc - padded + pr; if (e == 31) { tab[32] = inc; tab[65] = inc >> 8; } } }
    __syncthreads();
}

__device__ __forceinline__ void p8_dispatch(const Frame& F, int l) {
    const LAS int* tab = (const LAS int*)(F.lds + TAB_OFF);
    const float* const pN2G = kin<I_N2G>() + l * 1024;
    const int lane = F.lane;
#pragma unroll 1
    for (int gw = F.vcu * NWAVES + F.wave; gw < T / 8; gw += F.G * NWAVES) { const int tok0 = gw * 8, b = tok0 >> 11;
        expert_table(F, l, gw >> 3);
        const float* ad = ada_ptr(F, l, b); f32x4 gm[4], sh[4];
#pragma unroll
        for (int j = 0; j < 4; ++j) { const int c = 4 * lane + 256 * j; gm[j] = *(const f32x4*)(pN2G + c) * (1.0f + *(const f32x4*)(ad + 4096 + c)); sh[j] = *(const f32x4*)(ad + 3072 + c); }
        const float* X = (const float*)(F.ws + WS_X); const int* EI = (const int*)(F.ws + WS_EIDX); const int* PO = (const int*)(F.ws + WS_POS); int* SL = (int*)(F.ws + WS_SLOT); bf16* BUF = (bf16*)(F.ws + WS_BUF);
#pragma unroll 1
        for (int tb = 0; tb < 8; tb += 4) {
            f32x4 v[4][4]; int e0[4], e1[4], q0[4], q1[4]; float ss[4];
#pragma unroll
            for (int t = 0; t < 4; ++t) { const int tok = tok0 + tb + t;
#pragma unroll
                for (int j = 0; j < 4; ++j) v[t][j] = *(const f32x4*)(X + (size_t)tok * 1024 + 4 * lane + 256 * j);
                e0[t] = EI[tok * 2]; e1[t] = EI[tok * 2 + 1]; q0[t] = PO[tok * 2]; q1[t] = PO[tok * 2 + 1]; }
#pragma unroll
            for (int t = 0; t < 4; ++t) { ss[t] = 0.f;
#pragma unroll
                for (int j = 0; j < 4; ++j) ss[t] += (v[t][j][0] * v[t][j][0] + v[t][j][1] * v[t][j][1]) + (v[t][j][2] * v[t][j][2] + v[t][j][3] * v[t][j][3]); }
#pragma unroll
            for (int o = 1; o < 64; o <<= 1) {
#pragma unroll
                for (int t = 0; t < 4; ++t) ss[t] += __shfl_xor(ss[t], o); }
#pragma unroll
            for (int t = 0; t < 4; ++t) { const int tok = tok0 + tb + t;
                const float rstd = __builtin_amdgcn_rsqf(ss[t] * (1.0f / 1024.0f) + NORM_EPS);
                const int s0 = tab[66 + e0[t]] + q0[t], s1 = tab[66 + e1[t]] + q1[t];
                if (lane == 0) { SL[tok * 2] = s0; SL[tok * 2 + 1] = s1; }
#pragma unroll
                for (int j = 0; j < 4; ++j) { const f32x4 h = v[t][j] * rstd * gm[j] + sh[j]; u32x2 w; w.x = pk2(h[0], h[1]); w.y = pk2(h[2], h[3]);
                    *(u32x2*)(BUF + (size_t)s0 * 1024 + 4 * lane + 256 * j) = w; *(u32x2*)(BUF + (size_t)s1 * 1024 + 4 * lane + 256 * j) = w; } }
        }
    }
}

#ifndef PHMASK
#define PHMASK 0xFFFF
#endif
#define PHM(n) (((PHMASK) >> (n)) & 1)
constexpr int NPHASES = 23;
__global__ void __launch_bounds__(NWAVES * 64, 2) trunk_fwd(Args args) {
    extern __shared__ __attribute__((aligned(16))) unsigned char lds_raw[];
    Frame F;
    F.lds = (LAS unsigned char*)lds_raw;
    F.tid = threadIdx.x; F.lane = F.tid & 63; F.wave = __builtin_amdgcn_readfirstlane(F.tid >> 6);
    F.G = gridDim.x; { const int bx = blockIdx.x; F.vcu = (F.G % 8 == 0) ? (bx % 8) * (F.G / 8) + bx / 8 : bx; }
    GAS unsigned char* const wsbase = (GAS unsigned char*)kin<29>(); F.ws = wsbase; const int vcu0 = F.vcu;
    volatile LAS unsigned* MISC = (volatile LAS unsigned*)(F.lds + MISC_OFF);
    if (F.tid < 32) MISC[F.tid] = 0u;
    __syncthreads();
    const unsigned long long lohi = (unsigned long long)kin<30>(); const int lo = (int)(unsigned)lohi, hi = (int)(unsigned)(lohi >> 32);
    XcdBarrier bar; bar.bar = (unsigned*)(F.ws + WS_CTL) + CW_BAR; bar.x = 0; bar.st = nullptr;
    if (hi - lo > 1) bar = xcd_barrier_post((unsigned*)(F.ws + WS_CTL) + CW_BAR, MISC + 8);
#pragma unroll 1
#if defined(REP_PH)
    for (int phx = lo; phx < hi + REP_N; ++phx) { const int ph = (phx < REP_PH) ? phx : ((phx < REP_PH + REP_N) ? REP_PH : phx - REP_N);
        const bool probe_run = (phx >= REP_PH && phx < REP_PH + REP_N); (void)probe_run;
#else
    for (int ph = lo; ph < hi; ++ph) {
#endif
        { int t_ = threadIdx.x; asm volatile("" : "+v"(t_)); F.tid = t_; F.lane = t_ & 63; F.wave = __builtin_amdgcn_readfirstlane(t_ >> 6);
          GAS unsigned char* w_ = wsbase; asm volatile("" : "+s"(w_)); F.ws = w_; int v_ = vcu0; asm volatile("" : "+s"(v_)); F.vcu = v_; }
        const int l = (ph - 2) / 10, k = (ph >= 2 && ph <= 21) ? (ph - 2) % 10 : -1;
        if (PHM(0) && ph == 0) p0_prologue(F);
        else if (PHM(0) && ph == 1) p0b_ada_reduce(F);
        else if (PHM(1) && ph == 22) p1_norm<2>(F, 1);
        else if (PHM(1) && k == 0) { if (l == 0) p1_norm<0>(F, 0); else p1_norm<1>(F, 1); }
        else if (PHM(3) && k == 2) p2x_lowrank(F, l);
#if defined(REP_PH) && defined(REP_DRY)
        else if (PHM(4) && k == 3) p4_scan(F, l, probe_run ? REP_DRY : 0);
#else
        else if (PHM(4) && k == 3) p4_scan(F, l);
#endif
        else if (PHM(5) && k == 4) p5_post(F, l);
        #if defined(REP_PH)
        else if (PHM(7) && k == 6) p7_route(F, l, probe_run);
#else
        else if (PHM(7) && k == 6) p7_route(F, l);
#endif
        else if (PHM(8) && k == 7) p8_dispatch(F, l);
        else if (PHM(2) && (k == 1 || k == 5 || k == 8 || k == 9)) {
            pg8::Gemm g; pg8::UniOrder S; pg8::EpiUni E;
            S.expert = (k >= 8); S.so.init(T, 1024, F.G, (int)blockIdx.x); S.eo = pg8::ExpertOrder{(const PG8_LAS int*)(F.lds + TAB_OFF + 33 * 4), 0, F.G, (int)blockIdx.x};
            E.e0 = pg8::EpiBf16Plain{(bf16*)(F.ws + WS_P), P_LD, -1, G1_NPAIR, G1_CBASE}; E.e1 = pg8::EpiResid{nullptr, (float*)(F.ws + WS_X), ada_ptr(F, l, 0) + 2048, 6144}; E.e2 = pg8::EpiSwiGLU{(bf16*)(F.ws + WS_HB)};
            if (k == 1) {
                const int N = (l == 0) ? N_IN : N_IN1; S.so.init(T, N, F.G, (int)blockIdx.x); E.mode = 0;
                g = pg8::Gemm{(const bf16*)(F.ws + WS_H), (const bf16*)(F.ws + WS_BT_IN) + (size_t)l * BT_LD * 1024, T, N, 1024};
            } else if (k == 5) {
                E.mode = 1; E.e1.xin = (l == 0) ? kin<I_X>() : (const float*)(F.ws + WS_X);
                g = pg8::Gemm{(const bf16*)(F.ws + WS_H), (const bf16*)(F.ws + WS_BT_OUT) + (size_t)l * 1024 * 1024, T, 1024, 1024};
            } else {
                expert_table(F, l);
                S.eo.ntiles = ((const LAS int*)(F.lds + TAB_OFF))[65];
                if (k == 8) { E.mode = 2; g = pg8::Gemm{(const bf16*)(F.ws + WS_BUF), (const bf16*)(F.ws + WS_BT_E1) + (size_t)l * 32 * 1024 * 1024, MAXROWS, 32 * 1024, 1024}; }
                else { E.mode = 0; E.e0 = pg8::EpiBf16Plain{(bf16*)(F.ws + WS_YE), 1024, 3, 0, 0}; g = pg8::Gemm{(const bf16*)(F.ws + WS_HB), (const bf16*)(F.ws + WS_BT_E2) + (size_t)l * 32 * 1024 * 512, MAXROWS, 32 * 1024, 512}; }
            }
#if defined(REP_PH) && defined(REP_DRY)
            if (probe_run) E.mode = 3;
#endif
            pg8::gemm_phase<pg8::EpiUni, pg8::UniOrder, true, true>(F.lds, g, S, E);
        }
#if defined(REP_PH)
        if (phx + 1 < hi + REP_N) xcd_barrier(bar);
#else
        if (ph + 1 < hi) xcd_barrier(bar);
#endif
    }
}

extern "C" void kernel_launch(void* const* d_in, const int* in_sizes, int n_in, void* d_out, int out_size, void* d_ws, size_t ws_size, hipStream_t stream) {
    static int grid = 0;
    if (grid == 0) {
        if (n_in != 28 || in_sizes[0] != T * D || out_size != T * D || ws_size < WS_END) { fprintf(stderr, "kernel_launch: unexpected shapes (n_in %d, in0 %d, out %d, ws %zu < %zu?); nothing launched\n", n_in, n_in > 0 ? in_sizes[0] : -1, out_size, ws_size, (size_t)WS_END); grid = -1; return; }
        int dev = 0, cus = 0, per_cu = 0;
        if (hipGetDevice(&dev) != hipSuccess || hipDeviceGetAttribute(&cus, hipDeviceAttributeMultiprocessorCount, dev) != hipSuccess) { fprintf(stderr, "kernel_launch: device query failed\n"); grid = -1; return; }
        if (hipFuncSetAttribute((const void*)trunk_fwd, hipFuncAttributeMaxDynamicSharedMemorySize, LDS_BYTES) != hipSuccess) { fprintf(stderr, "kernel_launch: hipFuncSetAttribute failed\n"); grid = -1; return; }
        if (hipOccupancyMaxActiveBlocksPerMultiprocessor(&per_cu, (const void*)trunk_fwd, NWAVES * 64, LDS_BYTES) != hipSuccess || per_cu < 1) { fprintf(stderr, "kernel_launch: occupancy query says %d blocks per CU\n", per_cu); }
        (void)hipGetLastError();
        grid = cus;
    }
    if (grid < 0) return;
    if (hipMemsetAsync((char*)d_ws + WS_CTL, 0, CTL_ZERO_BYTES, stream) != hipSuccess) { fprintf(stderr, "kernel_launch: memset failed\n"); return; }
    Args a{};
    for (int i = 0; i < 28; ++i) a.p[i] = d_in[i];
    a.p[28] = d_out; a.p[29] = d_ws;
#if MK_ONE_LAUNCH
    a.ph_lo = 0; a.ph_hi = NPHASES;
    void* kargs[] = {&a};
    hipError_t e = hipLaunchCooperativeKernel((const void*)trunk_fwd, dim3(grid), dim3(NWAVES * 64), kargs, LDS_BYTES, stream);
    if (e != hipSuccess) fprintf(stderr, "kernel_launch: cooperative launch failed: %s (grid %d)\n", hipGetErrorString(e), grid);
#else
    for (int p = 0; p < NPHASES; ++p) { a.ph_lo = p; a.ph_hi = p + 1;
        hipLaunchKernelGGL(trunk_fwd, dim3(grid), dim3(NWAVES * 64), LDS_BYTES, stream, a);
        const hipError_t le = hipPeekAtLastError(); if (le != hipSuccess) { fprintf(stderr, "kernel_launch: launch %d failed: %s\n", p, hipGetErrorName(le)); break; } }
#endif
}
```
